# Optimizing an MI355X kernel written in HIP

```python
import jax, jax.numpy as jnp
from jax import lax
import numpy as np

D_MODEL = 2048
BATCH = 8
SEQ = 2048
DEPTH = 1

CHUNK = 64
NORM_EPS = 1e-6
RWKV_HEADS = 16
RWKV_HEAD_DIM = 64
RWKV_DIM = RWKV_HEADS * RWKV_HEAD_DIM
DECAY_LORA = 96
AAA_LORA = 96
GATE_LORA = 256
GN_EPS = 64e-5
RWKV_SIZES = (RWKV_DIM, RWKV_DIM, RWKV_DIM, DECAY_LORA, AAA_LORA, GATE_LORA)
RWKV_COLS = 3 * RWKV_DIM + DECAY_LORA + AAA_LORA + GATE_LORA
MLSTM_HEADS = 4
MLSTM_QK_DIM = 128
MLSTM_V_DIM = 256
MLSTM_QK = MLSTM_HEADS * MLSTM_QK_DIM
MLSTM_DIM = MLSTM_HEADS * MLSTM_V_DIM
CONV_WIDTH = 4
GATE_SOFTCAP = 15.0
MLSTM_SIZES = (MLSTM_QK, MLSTM_QK, MLSTM_DIM, MLSTM_HEADS, MLSTM_HEADS, MLSTM_DIM)
MLSTM_COLS = 2 * MLSTM_QK + 2 * MLSTM_DIM + 2 * MLSTM_HEADS
N_BRANCHES = 2
GATE_COLS = N_BRANCHES * D_MODEL
IN_COLS = RWKV_COLS + MLSTM_COLS + GATE_COLS
N_EXPERTS = 32
TOP_K = 4
EXPERT_FF = 2048
SWIGLU_LIMIT = 7.0
SWIGLU_ALPHA = 1.702
EXPERT_BLOCK = 256

kernel_name = "hybrid_rwkv7_mlstm_moe_block"


def rmsnorm(x, w):
    xf = x.astype(jnp.float32)
    y = xf * lax.rsqrt(jnp.mean(xf * xf, axis=-1, keepdims=True) + NORM_EPS)
    return (y * w.astype(jnp.float32)).astype(x.dtype)


def split_cols(t, sizes):
    out, off = [], 0
    for s in sizes:
        out.append(t[..., off:off + s])
        off += s
    return out


def token_shift(p):
    return jnp.pad(p, ((0, 0), (1, 0), (0, 0)))[:, :-1]


def causal_depthwise_conv(u, w):
    return lax.conv_general_dilated(
        u, w[:, None, :].astype(u.dtype), window_strides=(1,),
        padding=[(CONV_WIDTH - 1, 0)], dimension_numbers=("NWC", "WIO", "NWC"),
        feature_group_count=u.shape[-1])


def rwkv7_time_mix(p, mu, w0, w_up, a0, a_up, g_up, k_k, k_a, r_k, ln_w, ln_b):
    Bsz, S, _ = p.shape
    H, N = RWKV_HEADS, RWKV_HEAD_DIM
    p = p.astype(jnp.float32)
    p = p + (token_shift(p) - p) * mu
    r, k, v, wd, ad, gd = split_cols(p, RWKV_SIZES)
    w_log = -jax.nn.softplus(-(w0 + jnp.tanh(wd) @ w_up)) - 0.5
    decay = jnp.exp(-jnp.exp(w_log))
    a = jax.nn.sigmoid(a0 + ad @ a_up)
    g = jax.nn.sigmoid(gd) @ g_up
    heads = lambda t: t.reshape(Bsz, S, H, N)
    kk = heads(k * k_k)
    kk = kk / jnp.maximum(jnp.sqrt(jnp.sum(kk * kk, axis=-1, keepdims=True)), 1e-12)
    k = k * (1.0 + (a - 1.0) * k_a)
    r_h, k_h, v_h, w_h, a_h = heads(r), heads(k), heads(v), heads(decay), heads(a)

    def step(state, xs):
        r_t, w_t, k_t, v_t, kk_t, a_t = xs
        sa = jnp.einsum("bhvk,bhk->bhv", state, -kk_t)
        state = (state * w_t[:, :, None, :]
                 + sa[..., None] * (kk_t * a_t)[:, :, None, :]
                 + v_t[..., None] * k_t[:, :, None, :])
        return state, jnp.einsum("bhvk,bhk->bhv", state, r_t)

    tm = lambda t: jnp.moveaxis(t, 1, 0)
    s0 = jnp.zeros((Bsz, H, N, N), jnp.float32)
    _, y = lax.scan(step, s0, (tm(r_h), tm(w_h), tm(k_h), tm(v_h), tm(kk), tm(a_h)))
    y = jnp.moveaxis(y, 0, 1)
    mean = jnp.mean(y, axis=-1, keepdims=True)
    var = jnp.mean(jnp.square(y - mean), axis=-1, keepdims=True)
    y = ((y - mean) * lax.rsqrt(var + GN_EPS)).reshape(Bsz, S, RWKV_DIM) * ln_w + ln_b
    bonus = jnp.sum(r_h * k_h * r_k, axis=-1, keepdims=True) * v_h
    return (y + bonus.reshape(Bsz, S, RWKV_DIM)) * g


def mlstm_chunkwise(q, k, v, log_i, log_f):
    Bsz, S, H, DK = q.shape
    DV = v.shape[-1]
    NC = S // CHUNK

    def to_chunks(t):
        t = t.reshape(Bsz, NC, CHUNK, H, *t.shape[3:])
        return jnp.moveaxis(t, (1, 3), (0, 2))

    causal = jnp.tril(jnp.ones((CHUNK, CHUNK), bool))

    def step(carry, xs):
        C, n, m = carry
        qc, kc, vc, li, lf = xs
        b = jnp.cumsum(lf, axis=-1)
        Dm = jnp.where(causal, b[..., :, None] - b[..., None, :] + li[..., None, :], -jnp.inf)
        inter = b + m[..., None]
        m_t = jnp.maximum(inter, jnp.max(Dm, axis=-1))
        s = jnp.einsum("bhtd,bhjd->bhtj", qc, kc) * jnp.exp(Dm - m_t[..., None])
        w_inter = jnp.exp(inter - m_t)
        num = (jnp.einsum("bhtj,bhjv->bhtv", s, vc)
               + w_inter[..., None] * jnp.einsum("bhtd,bhdv->bhtv", qc, C))
        den = jnp.sum(s, axis=-1) + w_inter * jnp.einsum("bhtd,bhd->bht", qc, n)
        h = num / jnp.maximum(jnp.abs(den), jnp.exp(-m_t))[..., None]
        g_tot = b[..., -1]
        a = li + g_tot[..., None] - b
        m_new = jnp.maximum(g_tot + m, jnp.max(a, axis=-1))
        dec = jnp.exp(g_tot + m - m_new)
        wk = jnp.exp(a - m_new[..., None])
        C_new = dec[..., None, None] * C + jnp.einsum("bhl,bhld,bhlv->bhdv", wk, kc, vc)
        n_new = dec[..., None] * n + jnp.einsum("bhl,bhld->bhd", wk, kc)
        return (C_new, n_new, m_new), h

    init = (jnp.zeros((Bsz, H, DK, DV), jnp.float32), jnp.zeros((Bsz, H, DK), jnp.float32),
            jnp.zeros((Bsz, H), jnp.float32))
    _, h = lax.scan(step, init, (to_chunks(q), to_chunks(k), to_chunks(v),
                                 to_chunks(log_i), to_chunks(log_f)))
    return jnp.moveaxis(h, (0, 2), (1, 3)).reshape(Bsz, S, H, DV)


def mlstm_branch(p, conv_w, i_b, f_b, norm_w):
    Bsz, S, _ = p.shape
    H = MLSTM_HEADS
    p = p.astype(jnp.float32)
    q, k, v, i_raw, f_raw, o_raw = split_cols(p, MLSTM_SIZES)
    qk = jax.nn.silu(causal_depthwise_conv(jnp.concatenate([q, k], axis=-1), conv_w))
    q, k = qk[..., :MLSTM_QK], qk[..., MLSTM_QK:]
    i_pre = GATE_SOFTCAP * jnp.tanh((i_raw + i_b) / GATE_SOFTCAP)
    f_pre = GATE_SOFTCAP * jnp.tanh((f_raw + f_b) / GATE_SOFTCAP)
    h = mlstm_chunkwise(q.reshape(Bsz, S, H, MLSTM_QK_DIM) * (MLSTM_QK_DIM ** -0.5),
                        k.reshape(Bsz, S, H, MLSTM_QK_DIM),
                        v.reshape(Bsz, S, H, MLSTM_V_DIM),
                        i_pre, jax.nn.log_sigmoid(f_pre))
    h = h * lax.rsqrt(jnp.mean(h * h, axis=-1, keepdims=True) + NORM_EPS)
    return h.reshape(Bsz, S, MLSTM_DIM) * norm_w * jax.nn.sigmoid(o_raw)


def moe_ffn(h, router_w, router_b, w_gu, b_gu, w_down, b_down):
    Bsz, S, D = h.shape
    T = Bsz * S
    TK = T * TOP_K
    NB = -(-TK // EXPERT_BLOCK) + N_EXPERTS
    P = NB * EXPERT_BLOCK
    xt = h.reshape(T, D)
    logits = xt.astype(jnp.float32) @ router_w.astype(jnp.float32) + router_b.astype(jnp.float32)
    top_logits, top_idx = lax.top_k(logits, TOP_K)
    top_w = jax.nn.softmax(top_logits, axis=-1)
    flat_e = top_idx.reshape(TK).astype(jnp.int32)
    flat_tok = jnp.repeat(jnp.arange(T, dtype=jnp.int32), TOP_K)
    flat_w = top_w.reshape(TK)
    se, stok, sw = lax.sort((flat_e, flat_tok, flat_w), num_keys=1, is_stable=True)
    counts = jnp.zeros(N_EXPERTS, jnp.int32).at[flat_e].add(1)
    start = jnp.cumsum(counts) - counts
    padded = (counts + EXPERT_BLOCK - 1) // EXPERT_BLOCK * EXPERT_BLOCK
    pad_end = jnp.cumsum(padded)
    dest = (pad_end - padded)[se] + jnp.arange(TK, dtype=jnp.int32) - start[se]
    row_tok = jnp.zeros(P, jnp.int32).at[dest].set(stok)
    row_w = jnp.zeros(P, jnp.float32).at[dest].set(sw)
    block_e = jnp.minimum(
        jnp.searchsorted(pad_end, jnp.arange(NB, dtype=jnp.int32) * EXPERT_BLOCK, side="right"),
        N_EXPERTS - 1)

    def expert_block(args):
        tok, wt, e = args
        xb = xt[tok].astype(jnp.float32)
        gu = xb @ w_gu[e] + b_gu[e]
        gate = jnp.minimum(gu[:, :EXPERT_FF], SWIGLU_LIMIT)
        up = jnp.clip(gu[:, EXPERT_FF:], -SWIGLU_LIMIT, SWIGLU_LIMIT)
        act = (up + 1.0) * gate * jax.nn.sigmoid(SWIGLU_ALPHA * gate)
        return ((act @ w_down[e] + b_down[e]) * wt[:, None]).astype(jnp.float32)

    ys = lax.map(expert_block, (row_tok.reshape(NB, EXPERT_BLOCK),
                                row_w.reshape(NB, EXPERT_BLOCK), block_e))
    out = jnp.zeros((T, D), jnp.float32).at[row_tok].add(ys.reshape(P, D))
    return out.reshape(Bsz, S, D)


def setup_inputs(seed: int = 0) -> dict:
    key = jax.random.key(seed)
    ks = iter(jax.random.split(key, 40))
    nrm = lambda shape, scale: jax.random.normal(next(ks), shape, jnp.float32) * scale
    uni = lambda shape, lo, hi: jax.random.uniform(next(ks), shape, jnp.float32, lo, hi)
    L, D = DEPTH, D_MODEL
    return {
        "x": nrm((BATCH, SEQ, D), 1.0),
        "norm1_w": 1.0 + nrm((L, D), 0.02),
        "w_in": nrm((L, D, IN_COLS), D ** -0.5),
        "b_gate": nrm((L, GATE_COLS), 0.1),
        "rwkv_mu": uni((L, RWKV_COLS), 0.0, 1.0),
        "rwkv_w0": uni((L, RWKV_DIM), -6.0, -1.0),
        "rwkv_w_up": nrm((L, DECAY_LORA, RWKV_DIM), 0.3 * DECAY_LORA ** -0.5),
        "rwkv_a0": nrm((L, RWKV_DIM), 0.1),
        "rwkv_a_up": nrm((L, AAA_LORA, RWKV_DIM), 0.3 * AAA_LORA ** -0.5),
        "rwkv_g_up": nrm((L, GATE_LORA, RWKV_DIM), GATE_LORA ** -0.5),
        "rwkv_k_k": 0.85 + nrm((L, RWKV_DIM), 0.05),
        "rwkv_k_a": 1.0 + nrm((L, RWKV_DIM), 0.05),
        "rwkv_r_k": nrm((L, RWKV_HEADS, RWKV_HEAD_DIM), 0.1),
        "rwkv_ln_w": 1.0 + nrm((L, RWKV_DIM), 0.02),
        "rwkv_ln_b": nrm((L, RWKV_DIM), 0.02),
        "mlstm_conv_w": nrm((L, CONV_WIDTH, 2 * MLSTM_QK), CONV_WIDTH ** -0.5),
        "mlstm_i_b": nrm((L, MLSTM_HEADS), 0.1),
        "mlstm_f_b": jnp.linspace(3.0, 6.0, MLSTM_HEADS, dtype=jnp.float32)[None] + nrm((L, MLSTM_HEADS), 0.1),
        "mlstm_norm_w": 1.0 + nrm((L, MLSTM_DIM), 0.02),
        "w_branch_a": nrm((L, RWKV_DIM, D), RWKV_DIM ** -0.5),
        "w_branch_b": nrm((L, MLSTM_DIM, D), MLSTM_DIM ** -0.5),
        "w_out": nrm((L, D, D), D ** -0.5),
        "norm2_w": 1.0 + nrm((L, D), 0.02),
        "router_w": nrm((L, D, N_EXPERTS), D ** -0.5),
        "router_b": nrm((L, N_EXPERTS), 0.01),
        "w_gu": nrm((L, N_EXPERTS, D, 2 * EXPERT_FF), D ** -0.5),
        "b_gu": nrm((L, N_EXPERTS, 2 * EXPERT_FF), 0.01),
        "w_down": nrm((L, N_EXPERTS, EXPERT_FF, D), EXPERT_FF ** -0.5),
        "b_down": nrm((L, N_EXPERTS, D), 0.01),
        "final_norm_w": 1.0 + nrm((D,), 0.02),
    }


def reference(x, norm1_w, w_in, b_gate, rwkv_mu, rwkv_w0, rwkv_w_up, rwkv_a0, rwkv_a_up,
              rwkv_g_up, rwkv_k_k, rwkv_k_a, rwkv_r_k, rwkv_ln_w, rwkv_ln_b, mlstm_conv_w,
              mlstm_i_b, mlstm_f_b, mlstm_norm_w, w_branch_a, w_branch_b, w_out, norm2_w,
              router_w, router_b, w_gu, b_gu, w_down, b_down, final_norm_w):
    for l in range(DEPTH):
        hn = rmsnorm(x, norm1_w[l])
        proj = hn @ w_in[l]
        p_rwkv = proj[..., :RWKV_COLS]
        p_mlstm = proj[..., RWKV_COLS:RWKV_COLS + MLSTM_COLS]
        p_gate = proj[..., RWKV_COLS + MLSTM_COLS:]
        o_a = rwkv7_time_mix(p_rwkv, rwkv_mu[l], rwkv_w0[l], rwkv_w_up[l], rwkv_a0[l],
                             rwkv_a_up[l], rwkv_g_up[l], rwkv_k_k[l], rwkv_k_a[l], rwkv_r_k[l],
                             rwkv_ln_w[l], rwkv_ln_b[l])
        o_b = mlstm_branch(p_mlstm, mlstm_conv_w[l], mlstm_i_b[l], mlstm_f_b[l], mlstm_norm_w[l])
        y_a = o_a @ w_branch_a[l]
        y_b = o_b @ w_branch_b[l]
        gates = jax.nn.sigmoid(p_gate.astype(jnp.float32) + b_gate[l])
        merged = gates[..., :D_MODEL] * y_a + gates[..., D_MODEL:] * y_b
        x = x + (merged @ w_out[l]).astype(x.dtype)
        x = x + moe_ffn(rmsnorm(x, norm2_w[l]), router_w[l], router_b[l], w_gu[l], b_gu[l],
                        w_down[l], b_down[l]).astype(x.dtype)
    return rmsnorm(x, final_norm_w)
```

```cpp
#include <hip/hip_runtime.h>
#include <cstdio>
#include <cstdint>
#define MK_N_LAUNCHES 13
namespace pg8 {
#define PG8_LAS __attribute__((address_space(3)))
typedef unsigned short bf16_t;
typedef short bf16x8 __attribute__((ext_vector_type(8)));
typedef float f32x4 __attribute__((ext_vector_type(4)));
typedef unsigned u32x4 __attribute__((ext_vector_type(4)));
constexpr int BM = 256, BK = 64, HALF = 128, HTB = HALF * BK * 2  , STAGE_BYTES = 8 * HTB, NXCD = 8, WGM = 8;

__host__ __device__ __forceinline__ int lds_byte(int r, int c) { const int st = (r >> 4) * 2 + (c >> 5), rr = r & 15, cc = c & 31, ob = rr * 64 + cc * 2; return st * 1024 + (ob ^ (((ob >> 9) & 1) << 5)); }
__host__ __device__ __forceinline__ void stage_rc(int b, int& R, int& C) { const int st = b / 1024, sb = b % 1024, swz = sb ^ (((sb >> 9) & 1) << 5); R = (st >> 1) * 16 + swz / 64; C = (st & 1) * 32 + (swz % 64) / 2; }
__host__ __device__ __forceinline__ int perm32(int rho) { const int n = rho >> 4, i = rho & 15; return 8 * (i >> 2) + 4 * n + (i & 3); }

struct Unit { int pm, pn; };
struct Gemm { const bf16_t* A; const bf16_t* Bt; int M, N, K; };

struct StaticOrder {
    int nM, nN, nwg, G, c;
    __host__ __device__ void init(int M, int N, int G_, int c_) { nM = M / BM; nN = N / BM; nwg = nM * nN; G = G_; c = c_; }
    __host__ __device__ bool next(int i, Unit& u) const {
        const long L = (long)i * G + c; if (L >= nwg) return false;
        int wgid = (int)L; { const int q = nwg / NXCD, r = nwg % NXCD, xcd = wgid % NXCD, off = wgid / NXCD; wgid = (xcd < r ? xcd * (q + 1) : r * (q + 1) + (xcd - r) * q) + off; }
        const int nig = WGM * nN, gid = wgid / nig, fm = gid * WGM, gsz = (nM - fm) < WGM ? (nM - fm) : WGM;
        u.pm = fm + ((wgid % nig) % gsz); u.pn = (wgid % nig) / gsz; return true;
    }
    __device__ __forceinline__ void a_ready(const Unit&) const {}
    __device__ __forceinline__ void done(const Unit&) const {}
    __device__ __forceinline__ size_t a_off(const Unit& u, size_t tstep) const { return (size_t)u.pm * tstep; }
    __device__ __forceinline__ size_t b_off(const Unit& u, size_t tstep) const { return (size_t)u.pn * tstep; }
};
__device__ __forceinline__ unsigned cvt_pk_bf16(float lo, float hi) { unsigned r; asm volatile("v_cvt_pk_bf16_f32 %0, %1, %2" : "=v"(r) : "v"(lo), "v"(hi)); return r; }
template <class Epi, class Sched, bool ALIGN_EPI = false, bool SP2 = false>
__device__ __forceinline__ void gemm_phase(PG8_LAS unsigned char* lds, const Gemm g, const Sched& S, const Epi& E) {
    const int tid = threadIdx.x, wid = __builtin_amdgcn_readfirstlane(tid >> 6), lane = tid & 63, wr = wid >> 2, wc = wid & 3, fr = lane & 15, fq = lane >> 4;
    const int K = g.K, nt = K / BK;
    unsigned voffA[2], voffB[2];
#pragma unroll
    for (int i = 0; i < 2; ++i) { int R, C; stage_rc(tid * 16 + i * 8192, R, C); const int Rb = Epi::PERM ? ((R & ~31) + perm32(R & 31)) : R;
        voffA[i] = (unsigned)(R * K + C) * 2u; voffB[i] = (unsigned)(Rb * K + C) * 2u; }
    const size_t kstep = (size_t)(BK * 2);
    const size_t hstep = (size_t)HALF * K * 2;
    const size_t tstep = 2 * hstep;
    const unsigned ldsw = (unsigned)wid * 1024u;
    const int aoff = lds_byte(wr * 64 + fr, fq * 8), boff = lds_byte(wc * 32 + fr, fq * 8);
#define PG8_SA(b, h) (((b) * 2 + (h)) * HTB)
#define PG8_SB(b, h) ((4 + (b) * 2 + (h)) * HTB)
#define PG8_STAGE(bufoff, gbase, voff) do { _Pragma("unroll") for (int _i = 0; _i < 2; ++_i) \
        __builtin_amdgcn_global_load_lds((const unsigned*)((const char*)(gbase) + (voff)[_i]), (PG8_LAS unsigned*)(lds + (bufoff) + ldsw + _i * 8192), 16, 0, 0); } while (0)
#define PG8_LDA(dst, b, h) do { _Pragma("unroll") for (int m = 0; m < 4; ++m) _Pragma("unroll") for (int k = 0; k < 2; ++k) dst[m][k] = *(const PG8_LAS bf16x8*)(lds + PG8_SA(b, h) + aoff + m * 2048 + k * 1024); } while (0)
#define PG8_LDB(dst, b, h) do { _Pragma("unroll") for (int n = 0; n < 2; ++n) _Pragma("unroll") for (int k = 0; k < 2; ++k) dst[n][k] = *(const PG8_LAS bf16x8*)(lds + PG8_SB(b, h) + boff + n * 2048 + k * 1024); } while (0)
#define PG8_MMA(ai, bj, At, Bt) do { __builtin_amdgcn_s_setprio(1); _Pragma("unroll") for (int m = 0; m < 4; ++m) _Pragma("unroll") for (int n = 0; n < 2; ++n) _Pragma("unroll") for (int k = 0; k < 2; ++k) \
        acc[ai][bj][m][n] = __builtin_amdgcn_mfma_f32_16x16x32_bf16(Bt[n][k], At[m][k], acc[ai][bj][m][n], 0, 0, 0); __builtin_amdgcn_s_setprio(0); } while (0)
#define PG8_WAIT_V(n) asm volatile("s_waitcnt vmcnt(" #n ")" ::: "memory")
#define PG8_WAIT_L(n) asm volatile("s_waitcnt lgkmcnt(" #n ")" ::: "memory")
#define PG8_BAR __builtin_amdgcn_s_barrier()
#define PG8_SCHED __builtin_amdgcn_sched_barrier(0)
    Unit cur, nxt; int ui = 0;
    if (!S.next(0, cur)) return;
    f32x4 acc[2][2][4][2];
#pragma unroll
    for (int a = 0; a < 2; ++a)
#pragma unroll
        for (int b = 0; b < 2; ++b)
#pragma unroll
            for (int m = 0; m < 4; ++m)
#pragma unroll
                for (int n = 0; n < 2; ++n) acc[a][b][m][n] = (f32x4){0.f, 0.f, 0.f, 0.f};
    bf16x8 At[4][2], B0[2][2], B1[2][2];
    const char* cA = (const char*)g.A + S.a_off(cur, tstep); const char* cB = (const char*)g.Bt + S.b_off(cur, tstep);
    S.a_ready(cur);
    if constexpr (SP2) {
        PG8_STAGE(PG8_SB(0, 0), cB, voffB); PG8_STAGE(PG8_SB(0, 1), cB + hstep, voffB); PG8_STAGE(PG8_SA(0, 0), cA, voffA); PG8_STAGE(PG8_SA(0, 1), cA + hstep, voffA);
        if (wr == 1) PG8_BAR;
        PG8_WAIT_V(2); PG8_BAR;
        PG8_STAGE(PG8_SB(1, 0), cB + kstep, voffB); PG8_STAGE(PG8_SA(1, 0), cA + kstep, voffA); PG8_STAGE(PG8_SB(1, 1), cB + hstep + kstep, voffB);
        PG8_WAIT_V(6); PG8_BAR;
    } else {
        PG8_STAGE(PG8_SB(0, 0), cB, voffB); PG8_STAGE(PG8_SA(0, 0), cA, voffA); PG8_STAGE(PG8_SB(0, 1), cB + hstep, voffB); PG8_STAGE(PG8_SA(0, 1), cA + hstep, voffA);
        if (wr == 1) PG8_BAR;
        PG8_WAIT_V(4); PG8_BAR;
        PG8_STAGE(PG8_SB(1, 0), cB + kstep, voffB); PG8_STAGE(PG8_SA(1, 0), cA + kstep, voffA); PG8_STAGE(PG8_SB(1, 1), cB + hstep + kstep, voffB);
        PG8_WAIT_V(6); PG8_BAR;
    }
    for (;;) {
        const bool has_next = S.next(ui + 1, nxt);
        const char* nA = has_next ? (const char*)g.A + S.a_off(nxt, tstep) : cA; const char* nB = has_next ? (const char*)g.Bt + S.b_off(nxt, tstep) : cB;
        for (int t = 0; t < nt; t += 2) {
            const bool last = (t == nt - 2);
            const char* a1 = cA + (size_t)(t + 1) * kstep;
            const char* a2 = last ? nA : cA + (size_t)(t + 2) * kstep; const char* b2 = last ? nB : cB + (size_t)(t + 2) * kstep;
            const char* a3 = a2 + kstep; const char* b3 = b2 + kstep;
            if (last && has_next) S.a_ready(nxt);
            if constexpr (SP2) {
            PG8_LDB(B0, 0, 0); PG8_LDB(B1, 0, 1); PG8_SCHED; PG8_LDA(At, 0, 0); PG8_STAGE(PG8_SA(1, 1), a1 + hstep, voffA);
            PG8_WAIT_V(8); PG8_WAIT_L(0); PG8_BAR; PG8_MMA(0, 0, At, B0); PG8_MMA(0, 1, At, B1); PG8_BAR; PG8_SCHED;
            PG8_LDA(At, 0, 1); PG8_STAGE(PG8_SB(0, 0), b2, voffB); PG8_STAGE(PG8_SB(0, 1), b2 + hstep, voffB); PG8_STAGE(PG8_SA(0, 0), a2, voffA);
            PG8_WAIT_V(8); PG8_WAIT_L(0); PG8_BAR; PG8_MMA(1, 0, At, B0); PG8_MMA(1, 1, At, B1); PG8_BAR; PG8_SCHED;
            PG8_LDB(B0, 1, 0); PG8_LDB(B1, 1, 1); PG8_SCHED; PG8_LDA(At, 1, 0); PG8_STAGE(PG8_SA(0, 1), a2 + hstep, voffA);
            PG8_WAIT_V(8); PG8_WAIT_L(0); PG8_BAR; PG8_MMA(0, 0, At, B0); PG8_MMA(0, 1, At, B1); PG8_BAR; PG8_SCHED;
            PG8_LDA(At, 1, 1); PG8_STAGE(PG8_SB(1, 0), b3, voffB); PG8_STAGE(PG8_SB(1, 1), b3 + hstep, voffB); PG8_STAGE(PG8_SA(1, 0), a3, voffA);
            PG8_WAIT_V(8); PG8_WAIT_L(0); PG8_BAR; PG8_MMA(1, 0, At, B0); PG8_MMA(1, 1, At, B1); PG8_BAR; PG8_SCHED;
            } else {
            PG8_LDB(B0, 0, 0); PG8_SCHED; PG8_LDA(At, 0, 0); PG8_STAGE(PG8_SA(1, 1), a1 + hstep, voffA);
            PG8_WAIT_L(8); PG8_BAR; PG8_WAIT_L(0); PG8_MMA(0, 0, At, B0); PG8_BAR; PG8_SCHED;
            PG8_LDB(B1, 0, 1); PG8_STAGE(PG8_SB(0, 0), b2, voffB);
            PG8_BAR; PG8_WAIT_L(0); PG8_MMA(0, 1, At, B1); PG8_BAR;
            PG8_LDA(At, 0, 1); PG8_STAGE(PG8_SA(0, 0), a2, voffA);
            PG8_BAR; PG8_WAIT_L(0); PG8_MMA(1, 0, At, B0); PG8_BAR; PG8_SCHED;
            PG8_STAGE(PG8_SB(0, 1), b2 + hstep, voffB);
            PG8_WAIT_V(6); PG8_BAR; PG8_MMA(1, 1, At, B1); PG8_BAR;
            PG8_LDB(B0, 1, 0); PG8_SCHED; PG8_LDA(At, 1, 0); PG8_STAGE(PG8_SA(0, 1), a2 + hstep, voffA);
            PG8_WAIT_L(8); PG8_BAR; PG8_WAIT_L(0); PG8_MMA(0, 0, At, B0); PG8_BAR; PG8_SCHED;
            PG8_LDB(B1, 1, 1); PG8_STAGE(PG8_SB(1, 0), b3, voffB);
            PG8_BAR; PG8_WAIT_L(0); PG8_MMA(0, 1, At, B1); PG8_BAR;
            PG8_LDA(At, 1, 1); PG8_STAGE(PG8_SA(1, 0), a3, voffA);
            PG8_BAR; PG8_WAIT_L(0); PG8_MMA(1, 0, At, B0); PG8_BAR; PG8_SCHED;
            PG8_STAGE(PG8_SB(1, 1), b3 + hstep, voffB);
            PG8_WAIT_V(6); PG8_BAR; PG8_MMA(1, 1, At, B1); PG8_BAR;
            }
        }
        if constexpr (ALIGN_EPI) { if (wr == 0) PG8_BAR; }
        if constexpr (!Epi::AFTER_DRAIN) { E(acc, cur, wr, wc, fr, fq); S.done(cur); }
        if (!has_next) break;
#pragma unroll
        for (int a = 0; a < 2; ++a)
#pragma unroll
            for (int b = 0; b < 2; ++b)
#pragma unroll
                for (int m = 0; m < 4; ++m)
#pragma unroll
                    for (int n = 0; n < 2; ++n) acc[a][b][m][n] = (f32x4){0.f, 0.f, 0.f, 0.f};
        cur = nxt; cA = nA; cB = nB; ++ui;
        if constexpr (ALIGN_EPI) { if (wr == 1) PG8_BAR; }
    }
    PG8_WAIT_V(0);
    if constexpr (!ALIGN_EPI) { if (wr == 0) PG8_BAR; }
    PG8_BAR;
    if constexpr (Epi::AFTER_DRAIN) { E.fused(acc, cur, wr, wc, fr, fq, lds, wid, lane); S.done(cur); }
#undef PG8_SA
#undef PG8_SB
#undef PG8_STAGE
#undef PG8_LDA
#undef PG8_LDB
#undef PG8_MMA
#undef PG8_WAIT_V
#undef PG8_WAIT_L
#undef PG8_BAR
#undef PG8_SCHED
}
}

#ifndef MK_N_LAUNCHES
#define MK_N_LAUNCHES 1
#endif
#define GAS __attribute__((address_space(1)))
#define LAS __attribute__((address_space(3)))
typedef unsigned short bf16;
typedef unsigned v4u __attribute__((ext_vector_type(4)));
typedef unsigned v2u __attribute__((ext_vector_type(2)));
typedef float f32x4 __attribute__((ext_vector_type(4)));
typedef float f32x2 __attribute__((ext_vector_type(2)));

constexpr int NWAVES = 8, NTHR = 512;
constexpr int NPH = 13;
constexpr int D = 2048, BATCH = 8, SEQ = 2048, T = BATCH * SEQ;
constexpr int NIN = 10696, NINP = 10752;
constexpr int MLO = 3520, GTO = 6600;
constexpr int RH = 16, RD = 1024;
constexpr int MH = 4;
constexpr int NE = 32, FF = 2048, ECAP = 16384, PMAX = 65536 + NE * 256, MTMAX = PMAX / 256;
constexpr float NORM_EPS = 1e-6f, GN_EPS = 64e-5f;
constexpr size_t MiB = 1u << 20;
constexpr size_t WS_CTL = 0, CTL_ZERO_BYTES = 1 * MiB;
constexpr size_t WS_WIN = 1 * MiB, WS_WA = 43 * MiB, WS_WB = 47 * MiB, WS_WO = 51 * MiB, WS_WL = 59 * MiB;
constexpr size_t WS_RLIST = 62 * MiB, WS_RW = 64 * MiB;
constexpr size_t WS_WGU = 66 * MiB, WS_WDN = 578 * MiB, WS_HN = 834 * MiB, WS_P = 898 * MiB, WS_LIN = 1234 * MiB, WS_WAG = 1250 * MiB;
constexpr size_t WS_YRAW = 1442 * MiB, WS_HRAW = 1506 * MiB, WS_OA = 1570 * MiB, WS_OB = 1602 * MiB, WS_TMP = 1634 * MiB, WS_MRG = 1762 * MiB;
constexpr size_t WS_X1 = 1826 * MiB, WS_XB = 1954 * MiB, WS_ACT = 2242 * MiB, WS_YS = 2530 * MiB, WS_END = 2786 * MiB;
constexpr int CW_BAR = 4096;
constexpr int CW_CNT = 16384;
constexpr int RING_BYTES = 131072, MISC_OFF = RING_BYTES, LDS_BYTES = RING_BYTES + 8192;
constexpr int MI_TILE_E = 64, MI_TILE_I0 = 64 + 320, MI_CNT = 64 + 640, MI_POFF = MI_CNT + 32, MI_CST = MI_POFF + 32, MI_MT = MI_CST + 40;

#define LDS_WAIT() asm volatile("s_waitcnt lgkmcnt(0)" ::: "memory")
#define VM_WAIT() asm volatile("s_waitcnt vmcnt(0)" ::: "memory")
__device__ __forceinline__ float bf2f(bf16 v) { return __uint_as_float(((unsigned)v) << 16); }
__device__ __forceinline__ unsigned f2bf(float f) { unsigned u = __float_as_uint(f); return (u + 0x7fffu + ((u >> 16) & 1u)) >> 16; }
__device__ __forceinline__ unsigned pk2(float lo, float hi) { return f2bf(lo) | (f2bf(hi) << 16); }
__device__ __forceinline__ float wave_sum(float v) {
#pragma unroll
    for (int o = 1; o < 64; o <<= 1) v += __shfl_xor(v, o);
    return v;
}
__device__ __forceinline__ float sigm(float x) { return 1.f / (1.f + __expf(-x)); }
template <int CTRL> __device__ __forceinline__ float dppf(float x) { return __builtin_bit_cast(float, __builtin_amdgcn_mov_dpp(__builtin_bit_cast(int, x), CTRL, 0xf, 0xf, true)); }
__device__ __forceinline__ float allreduce16(float x) { x += dppf<0x128>(x); x += dppf<0x124>(x); x += dppf<0x4E>(x); x += dppf<0xB1>(x); return x; }

#define XB_TMO      128
#define XB_XCNT(j)  (256  + 64 * (j))
#define XB_XSUB(j)  (1280 + 64 * (j))
#define XB_XGEN(j)  (2304 + 64 * (j))
#define XB_TOP      3328
#define XB_TOPGEN   3392
#define XCD_BAR_WORDS 3456
#define XB_SPIN_CAP (1u << 18)
__device__ __forceinline__ unsigned xb_ld(unsigned* p)              { return __hip_atomic_load(p, __ATOMIC_RELAXED, __HIP_MEMORY_SCOPE_AGENT); }
__device__ __forceinline__ unsigned xb_add(unsigned* p, unsigned v) { return __hip_atomic_fetch_add(p, v, __ATOMIC_RELAXED, __HIP_MEMORY_SCOPE_AGENT); }
__device__ __forceinline__ unsigned xb_xcc_id() { return (unsigned)__builtin_amdgcn_s_getreg((3 << 11) | 20) & 0xFu; }
#define XB_SPIN(cond, bar) do { unsigned _sp = 0; while (cond) { __builtin_amdgcn_s_sleep(1); \
    if ((++_sp & 255u) == 0u) { if (xb_ld(&(bar)[XB_TMO])) break; if (_sp > XB_SPIN_CAP) { atomicAdd(&(bar)[XB_TMO], 1u); break; } } } } while (0)
struct XcdBarrier { unsigned* bar; unsigned x; volatile LAS unsigned* st; };
__device__ __forceinline__ XcdBarrier xcd_barrier_post(unsigned* bar, volatile LAS unsigned* st) {
    XcdBarrier b; b.bar = bar; b.x = xb_xcc_id(); b.st = st;
    if (threadIdx.x == 0) (void)xb_add(&bar[XB_XCNT(b.x)], 1u);
    return b;
}
__device__ __forceinline__ void xcd_barrier_complete(unsigned* bar, unsigned x, unsigned& nloc, unsigned& nx) {
    const unsigned G = gridDim.x * gridDim.y * gridDim.z;
    unsigned sum, cnt, mine, sp = 0u;
    for (;;) {
        sum = 0u; cnt = 0u; mine = 0u;
#pragma unroll
        for (unsigned j = 0; j < 16; ++j) { const unsigned c = xb_ld(&bar[XB_XCNT(j)]); sum += c; cnt += (c > 0u) ? 1u : 0u; mine = (j == x) ? c : mine; }
        if (sum == G) break;
        __builtin_amdgcn_s_sleep(1);
        if ((++sp & 255u) == 0u) { if (xb_ld(&bar[XB_TMO])) break; if (sp > XB_SPIN_CAP) { atomicAdd(&bar[XB_TMO], 1u); break; } }
    }
    nloc = mine > 0u ? mine : 1u; nx = cnt > 0u ? cnt : 1u;
}
__device__ __forceinline__ void xcd_barrier(const XcdBarrier& b) {
    asm volatile("s_waitcnt vmcnt(0)" ::: "memory");
    __syncthreads();
    if (threadIdx.x == 0) {
        unsigned* bar = b.bar;
        __builtin_amdgcn_s_waitcnt(0);
        unsigned nloc = b.st[0], nx = b.st[1];
        if (nloc == 0u) { xcd_barrier_complete(bar, b.x, nloc, nx); b.st[0] = nloc; b.st[1] = nx; }
        const unsigned old = xb_add(&bar[XB_XSUB(b.x)], 1u);
        const unsigned gen = old / nloc;
        if (old + 1u == (gen + 1u) * nloc) {
            __builtin_amdgcn_fence(__ATOMIC_RELEASE, "agent");
            asm volatile("s_waitcnt vmcnt(0)" ::: "memory");
            const unsigned og = xb_add(&bar[XB_TOP], 1u);
            const unsigned tg = og / nx;
            if (og + 1u == (tg + 1u) * nx) xb_add(&bar[XB_TOPGEN], 1u);
            else XB_SPIN(xb_ld(&bar[XB_TOPGEN]) == tg, bar);
            __builtin_amdgcn_fence(__ATOMIC_ACQUIRE, "agent");
            xb_add(&bar[XB_XGEN(b.x)], 1u);
            asm volatile("s_waitcnt vmcnt(0)" ::: "memory");
        } else {
            XB_SPIN(xb_ld(&bar[XB_XGEN(b.x)]) == gen, bar);
            __builtin_amdgcn_fence(__ATOMIC_ACQUIRE, "agent");
            asm volatile("s_waitcnt vmcnt(0)" ::: "memory");
        }
    }
    __syncthreads();
}

struct Args { const float* in[30]; float* out; unsigned char* ws; int ph_lo, ph_hi; };
enum { I_X = 0, I_N1W, I_WIN, I_BGATE, I_MU, I_W0, I_WUP, I_A0, I_AUP, I_GUP, I_KK, I_KA, I_RK, I_LNW, I_LNB, I_CONVW, I_IB, I_FB, I_MNW, I_WBA, I_WBB, I_WOUT, I_N2W, I_RTW, I_RTB, I_WGU, I_BGU, I_WDN, I_BDN, I_FNW };

struct Frame {
    LAS unsigned char* lds; volatile LAS unsigned* MISC; unsigned* ctl;
    int tid, lane, wave, G, bid;
    const float* const* in; float* out; unsigned char* ws;
};

using pg8::Unit; using pg8::HALF; using pg8::BM;
struct EpiBf16Plain {
    static constexpr bool PERM = true, AFTER_DRAIN = false;
    bf16* O; int ldc;
    __device__ __forceinline__ void operator()(const f32x4 (&acc)[2][2][4][2], const Unit& u, int wr, int wc, int fr, int fq) const {
        const int row0 = u.pm * BM + wr * 64 + fr, col0 = u.pn * BM + wc * 32 + 8 * fq;
#pragma unroll
        for (int ai = 0; ai < 2; ++ai)
#pragma unroll
            for (int m = 0; m < 4; ++m) { bf16* rowp = O + (size_t)(row0 + ai * HALF + m * 16) * ldc + col0;
#pragma unroll
                for (int bj = 0; bj < 2; ++bj) { const f32x4 v0 = acc[ai][bj][m][0], v1 = acc[ai][bj][m][1];
                    v4u w; w.x = pg8::cvt_pk_bf16(v0[0], v0[1]); w.y = pg8::cvt_pk_bf16(v0[2], v0[3]); w.z = pg8::cvt_pk_bf16(v1[0], v1[1]); w.w = pg8::cvt_pk_bf16(v1[2], v1[3]);
                    *(v4u*)(rowp + bj * HALF) = w; } }
    }
};
struct EpiLora {
    static constexpr bool PERM = false, AFTER_DRAIN = false;
    float* O; const float* w0; const float* a0;
    __device__ __forceinline__ void operator()(const f32x4 (&acc)[2][2][4][2], const Unit& u, int wr, int wc, int fr, int fq) const {
        const int row0 = u.pm * BM + wr * 64 + fr, col0 = u.pn * BM + wc * 32 + 4 * fq, seg = u.pn >> 2;
        f32x4 bv[2][2];
#pragma unroll
        for (int bj = 0; bj < 2; ++bj)
#pragma unroll
            for (int n = 0; n < 2; ++n) { const int c = col0 + bj * HALF + n * 16;
                bv[bj][n] = seg == 0 ? *(const f32x4*)(w0 + c) : (seg == 1 ? *(const f32x4*)(a0 + (c - 1024)) : (f32x4){0.f, 0.f, 0.f, 0.f}); }
#pragma unroll
        for (int ai = 0; ai < 2; ++ai)
#pragma unroll
            for (int m = 0; m < 4; ++m) { float* rowp = O + (size_t)(row0 + ai * HALF + m * 16) * 3072 + col0;
#pragma unroll
                for (int bj = 0; bj < 2; ++bj)
#pragma unroll
                    for (int n = 0; n < 2; ++n) { f32x4 v = acc[ai][bj][m][n] + bv[bj][n];
                        if (seg == 0) {
#pragma unroll
                            for (int j = 0; j < 4; ++j) { const float x = v[j]; const float wl = fminf(x, 0.f) - log1pf(__expf(-fabsf(x))) - 0.5f; v[j] = __expf(-__expf(wl)); } }
                        else if (seg == 1) {
#pragma unroll
                            for (int j = 0; j < 4; ++j) v[j] = sigm(v[j]); }
                        *(f32x4*)(rowp + bj * HALF + n * 16) = v; } }
    }
};
struct EpiGateA {
    static constexpr bool PERM = true, AFTER_DRAIN = false;
    float* TMP; const bf16* P; const float* bg;
    __device__ __forceinline__ void operator()(const f32x4 (&acc)[2][2][4][2], const Unit& u, int wr, int wc, int fr, int fq) const {
        const int row0 = u.pm * BM + wr * 64 + fr, col0 = u.pn * BM + wc * 32 + 8 * fq;
#pragma unroll
        for (int ai = 0; ai < 2; ++ai)
#pragma unroll
            for (int m = 0; m < 4; ++m) { const size_t r = (size_t)(row0 + ai * HALF + m * 16);
#pragma unroll
                for (int bj = 0; bj < 2; ++bj) { const int c = col0 + bj * HALF;
                    const v4u pg = *(const v4u*)(P + r * NINP + GTO + c); const f32x4 b0 = *(const f32x4*)(bg + c), b1 = *(const f32x4*)(bg + c + 4);
                    f32x4 g0, g1;
                    g0[0] = sigm(__uint_as_float(pg.x << 16) + b0[0]); g0[1] = sigm(__uint_as_float(pg.x & 0xffff0000u) + b0[1]);
                    g0[2] = sigm(__uint_as_float(pg.y << 16) + b0[2]); g0[3] = sigm(__uint_as_float(pg.y & 0xffff0000u) + b0[3]);
                    g1[0] = sigm(__uint_as_float(pg.z << 16) + b1[0]); g1[1] = sigm(__uint_as_float(pg.z & 0xffff0000u) + b1[1]);
                    g1[2] = sigm(__uint_as_float(pg.w << 16) + b1[2]); g1[3] = sigm(__uint_as_float(pg.w & 0xffff0000u) + b1[3]);
                    *(f32x4*)(TMP + r * D + c) = g0 * acc[ai][bj][m][0]; *(f32x4*)(TMP + r * D + c + 4) = g1 * acc[ai][bj][m][1]; } }
    }
};
struct EpiGateB {
    static constexpr bool PERM = true, AFTER_DRAIN = false;
    const float* TMP; bf16* MRG; const bf16* P; const float* bg;
    __device__ __forceinline__ void operator()(const f32x4 (&acc)[2][2][4][2], const Unit& u, int wr, int wc, int fr, int fq) const {
        const int row0 = u.pm * BM + wr * 64 + fr, col0 = u.pn * BM + wc * 32 + 8 * fq;
#pragma unroll
        for (int ai = 0; ai < 2; ++ai)
#pragma unroll
            for (int m = 0; m < 4; ++m) { const size_t r = (size_t)(row0 + ai * HALF + m * 16);
#pragma unroll
                for (int bj = 0; bj < 2; ++bj) { const int c = col0 + bj * HALF;
                    const v4u pg = *(const v4u*)(P + r * NINP + GTO + D + c); const f32x4 b0 = *(const f32x4*)(bg + D + c), b1 = *(const f32x4*)(bg + D + c + 4);
                    const f32x4 t0 = *(const f32x4*)(TMP + r * D + c), t1 = *(const f32x4*)(TMP + r * D + c + 4);
                    f32x4 g0, g1;
                    g0[0] = sigm(__uint_as_float(pg.x << 16) + b0[0]); g0[1] = sigm(__uint_as_float(pg.x & 0xffff0000u) + b0[1]);
                    g0[2] = sigm(__uint_as_float(pg.y << 16) + b0[2]); g0[3] = sigm(__uint_as_float(pg.y & 0xffff0000u) + b0[3]);
                    g1[0] = sigm(__uint_as_float(pg.z << 16) + b1[0]); g1[1] = sigm(__uint_as_float(pg.z & 0xffff0000u) + b1[1]);
                    g1[2] = sigm(__uint_as_float(pg.w << 16) + b1[2]); g1[3] = sigm(__uint_as_float(pg.w & 0xffff0000u) + b1[3]);
                    const f32x4 v0 = t0 + g0 * acc[ai][bj][m][0], v1 = t1 + g1 * acc[ai][bj][m][1];
                    v4u w; w.x = pg8::cvt_pk_bf16(v0[0], v0[1]); w.y = pg8::cvt_pk_bf16(v0[2], v0[3]); w.z = pg8::cvt_pk_bf16(v1[0], v1[1]); w.w = pg8::cvt_pk_bf16(v1[2], v1[3]);
                    *(v4u*)(MRG + r * D + c) = w; } }
    }
};
struct EpiResid {
    static constexpr bool PERM = false, AFTER_DRAIN = false;
    const float* X; float* O;
    __device__ __forceinline__ void operator()(const f32x4 (&acc)[2][2][4][2], const Unit& u, int wr, int wc, int fr, int fq) const {
        const int row0 = u.pm * BM + wr * 64 + fr, col0 = u.pn * BM + wc * 32 + 4 * fq;
#pragma unroll
        for (int ai = 0; ai < 2; ++ai)
#pragma unroll
            for (int m = 0; m < 4; ++m) { const size_t off = (size_t)(row0 + ai * HALF + m * 16) * D + col0;
#pragma unroll
                for (int bj = 0; bj < 2; ++bj)
#pragma unroll
                    for (int n = 0; n < 2; ++n) *(f32x4*)(O + off + bj * HALF + n * 16) = *(const f32x4*)(X + off + bj * HALF + n * 16) + acc[ai][bj][m][n]; }
    }
};
struct MoeOrder : pg8::StaticOrder {
    const LAS int* tile_e; size_t estride;
    __device__ __forceinline__ size_t b_off(const Unit& u, size_t tstep) const { return (size_t)tile_e[u.pm] * estride + (size_t)u.pn * tstep; }
};
struct EpiSwiGLU {
    static constexpr bool PERM = true, AFTER_DRAIN = false;
    bf16* ACT; const float* bgu; const LAS int* tile_e;
    __device__ __forceinline__ void operator()(const f32x4 (&acc)[2][2][4][2], const Unit& u, int wr, int wc, int fr, int fq) const {
        const int row0 = u.pm * BM + wr * 64 + fr, colg = u.pn * 128 + wc * 32 + 8 * fq; const int e = tile_e[u.pm];
        const float* bp = bgu + (size_t)e * 4096 + colg;
        const f32x4 bg0 = *(const f32x4*)(bp), bg1 = *(const f32x4*)(bp + 4), bu0 = *(const f32x4*)(bp + 2048), bu1 = *(const f32x4*)(bp + 2052);
#pragma unroll
        for (int ai = 0; ai < 2; ++ai)
#pragma unroll
            for (int m = 0; m < 4; ++m) { const size_t r = (size_t)(row0 + ai * HALF + m * 16);
                const f32x4 ga = acc[ai][0][m][0] + bg0, gb = acc[ai][0][m][1] + bg1, ua = acc[ai][1][m][0] + bu0, ub = acc[ai][1][m][1] + bu1;
                float o[8];
#pragma unroll
                for (int j = 0; j < 4; ++j) { const float g = fminf(ga[j], 7.f), up = fminf(fmaxf(ua[j], -7.f), 7.f); o[j] = (up + 1.f) * g * sigm(1.702f * g);
                                              const float g2 = fminf(gb[j], 7.f), up2 = fminf(fmaxf(ub[j], -7.f), 7.f); o[4 + j] = (up2 + 1.f) * g2 * sigm(1.702f * g2); }
                v4u w; w.x = pg8::cvt_pk_bf16(o[0], o[1]); w.y = pg8::cvt_pk_bf16(o[2], o[3]); w.z = pg8::cvt_pk_bf16(o[4], o[5]); w.w = pg8::cvt_pk_bf16(o[6], o[7]);
                *(v4u*)(ACT + r * FF + colg) = w; }
    }
};
struct EpiDown {
    static constexpr bool PERM = true, AFTER_DRAIN = false;
    bf16* YS; const float* bdn; const int* rlist; const float* rw; const LAS int* tile_e; const LAS int* tile_i0; const LAS int* cnt;
    __device__ __forceinline__ void operator()(const f32x4 (&acc)[2][2][4][2], const Unit& u, int wr, int wc, int fr, int fq) const {
        const int e = tile_e[u.pm], i0 = tile_i0[u.pm], ce = cnt[e]; const int col0 = u.pn * BM + wc * 32 + 8 * fq;
        const float* bp = bdn + (size_t)e * D + col0;
        f32x4 bv[2][2];
#pragma unroll
        for (int bj = 0; bj < 2; ++bj) { bv[bj][0] = *(const f32x4*)(bp + bj * HALF); bv[bj][1] = *(const f32x4*)(bp + bj * HALF + 4); }
#pragma unroll
        for (int ai = 0; ai < 2; ++ai)
#pragma unroll
            for (int m = 0; m < 4; ++m) { const int i = i0 + ai * HALF + wr * 64 + m * 16 + fr;
                if (i < ce) { const int dst = rlist[e * ECAP + i]; const float w = rw[e * ECAP + i]; bf16* rowp = YS + (size_t)dst * D + col0;
#pragma unroll
                    for (int bj = 0; bj < 2; ++bj) { const f32x4 v0 = (acc[ai][bj][m][0] + bv[bj][0]) * w, v1 = (acc[ai][bj][m][1] + bv[bj][1]) * w;
                        v4u o; o.x = pg8::cvt_pk_bf16(v0[0], v0[1]); o.y = pg8::cvt_pk_bf16(v0[2], v0[3]); o.z = pg8::cvt_pk_bf16(v1[0], v1[1]); o.w = pg8::cvt_pk_bf16(v1[2], v1[3]);
                        *(v4u*)(rowp + bj * HALF) = o; } } }
    }
};

__device__ __forceinline__ void transpose_item(const float* __restrict__ W, int N, int k0, int n0, bf16* WT, int dst_row0, int ldk, LAS float* scr, int lane) {
    const int n = n0 + (lane & 31); const bool ok = n < N;
#pragma unroll 8
    for (int i = 0; i < 32; ++i) { const int kk = 2 * i + (lane >> 5); scr[kk * 33 + (lane & 31)] = ok ? W[(size_t)(k0 + kk) * N + n] : 0.f; }
    LDS_WAIT(); asm volatile("" ::: "memory");
    const int c = lane & 7;
#pragma unroll
    for (int j = 0; j < 4; ++j) { const int nn = (lane >> 3) + 8 * j; const LAS float* s = scr + (8 * c) * 33 + nn;
        v4u o; o.x = pk2(s[0 * 33], s[1 * 33]); o.y = pk2(s[2 * 33], s[3 * 33]); o.z = pk2(s[4 * 33], s[5 * 33]); o.w = pk2(s[6 * 33], s[7 * 33]);
        *(v4u*)(WT + (size_t)(dst_row0 + nn) * ldk + k0 + 8 * c) = o; }
    LDS_WAIT(); asm volatile("" ::: "memory");
}
__device__ __forceinline__ void p0_prologue(Frame& F) {
    LAS float* scr = (LAS float*)(F.lds + F.wave * 16384);
    const int gw = F.bid * NWAVES + F.wave, NGW = F.G * NWAVES;
    bf16* WIN_T = (bf16*)(F.ws + WS_WIN); bf16* WA_T = (bf16*)(F.ws + WS_WA); bf16* WB_T = (bf16*)(F.ws + WS_WB); bf16* WO_T = (bf16*)(F.ws + WS_WO);
    bf16* WGU_T = (bf16*)(F.ws + WS_WGU); bf16* WDN_T = (bf16*)(F.ws + WS_WDN); bf16* WL_T = (bf16*)(F.ws + WS_WL); bf16* HN = (bf16*)(F.ws + WS_HN);
    constexpr int NB_WIN = (NIN + 31) / 32;
    constexpr int I_WINc = 32 * NB_WIN, I_BR = 16 * 64, I_WO = 32 * 64, I_GU = NE * 32 * 128, I_DN = NE * 32 * 64;
    constexpr int NITEMS = I_WINc + 2 * I_BR + I_WO + I_GU + I_DN;
    for (int it = gw; it < NITEMS; it += NGW) {
        int r = it;
        if (r < I_WINc) { const int kb = r / NB_WIN, nb = r % NB_WIN; transpose_item(F.in[I_WIN], NIN, kb * 64, nb * 32, WIN_T, nb * 32, D, scr, F.lane); continue; } r -= I_WINc;
        if (r < I_BR) { const int kb = r >> 6, nb = r & 63; transpose_item(F.in[I_WBA], D, kb * 64, nb * 32, WA_T, nb * 32, RD, scr, F.lane); continue; } r -= I_BR;
        if (r < I_BR) { const int kb = r >> 6, nb = r & 63; transpose_item(F.in[I_WBB], D, kb * 64, nb * 32, WB_T, nb * 32, RD, scr, F.lane); continue; } r -= I_BR;
        if (r < I_WO) { const int kb = r >> 6, nb = r & 63; transpose_item(F.in[I_WOUT], D, kb * 64, nb * 32, WO_T, nb * 32, D, scr, F.lane); continue; } r -= I_WO;
        if (r < I_GU) { const int e = r >> 12, q = r & 4095, kb = q >> 7, nb = q & 127, n0 = nb * 32;
            const int dst = n0 < FF ? ((n0 >> 7) * 256 + (n0 & 127)) : (((n0 - FF) >> 7) * 256 + 128 + ((n0 - FF) & 127));
            transpose_item(F.in[I_WGU] + (size_t)e * D * 2 * FF, 2 * FF, kb * 64, n0, WGU_T + (size_t)e * 2 * FF * D, dst, D, scr, F.lane); continue; } r -= I_GU;
        { const int e = r >> 11, q = r & 2047, kb = q >> 6, nb = q & 63;
            transpose_item(F.in[I_WDN] + (size_t)e * FF * D, D, kb * 64, nb * 32, WDN_T + (size_t)e * D * FF, nb * 32, FF, scr, F.lane); }
    }
    { const int gt = F.bid * NTHR + F.tid, NGT = F.G * NTHR; constexpr int Z0 = NB_WIN * 32 * D, Z1 = NINP * D;
      for (int i = Z0 + gt * 8; i < Z1; i += NGT * 8) *(v4u*)(WIN_T + i) = (v4u){0u, 0u, 0u, 0u}; }
    { const int gt = F.bid * NTHR + F.tid, NGT = F.G * NTHR;
      for (int i = gt; i < 3072 * 512; i += NGT) { const int n = i >> 9, k = i & 511; float v = 0.f;
          if (n < 1024) { if (k < 96) v = F.in[I_WUP][k * RD + n]; }
          else if (n < 2048) { if (k >= 128 && k < 224) v = F.in[I_AUP][(k - 128) * RD + (n - 1024)]; }
          else { if (k >= 256) v = F.in[I_GUP][(k - 256) * RD + (n - 2048)]; }
          WL_T[i] = (bf16)f2bf(v); } }
    const float* x = F.in[I_X]; const float* nw = F.in[I_N1W];
    for (int m = gw; m < T; m += NGW) {
        const f32x4* xr = (const f32x4*)(x + (size_t)m * D) + F.lane; f32x4 v[8]; float s = 0.f;
#pragma unroll
        for (int j = 0; j < 8; ++j) { v[j] = xr[64 * j]; s += (v[j][0] * v[j][0] + v[j][1] * v[j][1]) + (v[j][2] * v[j][2] + v[j][3] * v[j][3]); }
        const float rstd = 1.f / sqrtf(wave_sum(s) * (1.f / D) + NORM_EPS);
        v2u* o8 = (v2u*)(HN + (size_t)m * D) + F.lane;
#pragma unroll
        for (int j = 0; j < 8; ++j) { const f32x4 w = ((const f32x4*)nw)[F.lane + 64 * j]; v2u o; o.x = pk2(v[j][0] * rstd * w[0], v[j][1] * rstd * w[1]); o.y = pk2(v[j][2] * rstd * w[2], v[j][3] * rstd * w[3]); o8[64 * j] = o; }
    }
}

__device__ __forceinline__ void p2_lora_in(Frame& F) {
    const bf16* P = (const bf16*)(F.ws + WS_P); bf16* LIN = (bf16*)(F.ws + WS_LIN); const float* mu = F.in[I_MU];
    const int gt = F.bid * NTHR + F.tid, NGT = F.G * NTHR;
    for (int i = gt; i < T * 512; i += NGT) { const int t = i >> 9, c = i & 511; int col = -1, kind = 0;
        if (c < 96) { col = 3072 + c; kind = 0; } else if (c >= 128 && c < 224) { col = 3168 + (c - 128); kind = 1; } else if (c >= 256) { col = 3264 + (c - 256); kind = 2; }
        float v = 0.f;
        if (col >= 0) { const float p = bf2f(P[(size_t)t * NINP + col]); const float pp = (t & (SEQ - 1)) ? bf2f(P[(size_t)(t - 1) * NINP + col]) : 0.f;
            const float x = p + (pp - p) * mu[col]; v = kind == 0 ? tanhf(x) : (kind == 1 ? x : sigm(x)); }
        LIN[i] = (bf16)f2bf(v); }
}

__device__ __forceinline__ void rwkv_scan_unit(Frame& F, int unit) {
    const int b = unit >> 5, h = (unit >> 1) & 15, half = unit & 1;
    const bf16* P = (const bf16*)(F.ws + WS_P); const float* WAG = (const float*)(F.ws + WS_WAG); float* YRAW = (float*)(F.ws + WS_YRAW);
    LAS float* sR = (LAS float*)F.lds; LAS float* sW = sR + 2048; LAS float* sK = sW + 2048; LAS float* sNK = sK + 2048; LAS float* sB = sNK + 2048; LAS float* sV = sB + 2048; LAS float* sY = sV + 1024;
    const int tid = F.tid, r = tid >> 4, s = tid & 15, c = F.lane, col = h * 64 + c;
    const float mu_r = F.in[I_MU][col], mu_k = F.in[I_MU][1024 + col], mu_v = F.in[I_MU][2048 + col], kkc = F.in[I_KK][col], kac = F.in[I_KA][col];
    float S0 = 0.f, S1 = 0.f, S2 = 0.f, S3 = 0.f;
    for (int ch = 0; ch < SEQ / 32; ++ch) {
        for (int tt = F.wave; tt < 32; tt += NWAVES) {
            const int t = ch * 32 + tt; const size_t tk = (size_t)b * SEQ + t; const bf16* prow = P + tk * NINP;
            const float pr = bf2f(prow[col]), pk = bf2f(prow[1024 + col]), pv = bf2f(prow[2048 + col]);
            float qr = 0.f, qk = 0.f, qv = 0.f; if (t > 0) { const bf16* pp = prow - NINP; qr = bf2f(pp[col]); qk = bf2f(pp[1024 + col]); qv = bf2f(pp[2048 + col]); }
            const float rr = pr + (qr - pr) * mu_r, k1 = pk + (qk - pk) * mu_k, vv = pv + (qv - pv) * mu_v;
            const float w = WAG[tk * 3072 + col], a = WAG[tk * 3072 + 1024 + col];
            const float kkr = k1 * kkc; const float nrm = sqrtf(wave_sum(kkr * kkr)); const float kkn = kkr / fmaxf(nrm, 1e-12f);
            sR[tt * 64 + c] = rr; sW[tt * 64 + c] = w; sK[tt * 64 + c] = k1 * (1.f + (a - 1.f) * kac); sNK[tt * 64 + c] = -kkn; sB[tt * 64 + c] = kkn * a;
            if ((c >> 5) == half) sV[tt * 32 + (c & 31)] = vv;
        }
        __syncthreads();
        for (int tt = 0; tt < 32; ++tt) {
            const f32x4 R4 = *(const LAS f32x4*)(sR + tt * 64 + 4 * s), W4 = *(const LAS f32x4*)(sW + tt * 64 + 4 * s), K4 = *(const LAS f32x4*)(sK + tt * 64 + 4 * s);
            const f32x4 N4 = *(const LAS f32x4*)(sNK + tt * 64 + 4 * s), B4 = *(const LAS f32x4*)(sB + tt * 64 + 4 * s); const float v = sV[tt * 32 + r];
            float sa = (S0 * N4[0] + S1 * N4[1]) + (S2 * N4[2] + S3 * N4[3]); sa = allreduce16(sa);
            S0 = S0 * W4[0] + (sa * B4[0] + v * K4[0]); S1 = S1 * W4[1] + (sa * B4[1] + v * K4[1]); S2 = S2 * W4[2] + (sa * B4[2] + v * K4[2]); S3 = S3 * W4[3] + (sa * B4[3] + v * K4[3]);
            float y = (S0 * R4[0] + S1 * R4[1]) + (S2 * R4[2] + S3 * R4[3]); y = allreduce16(y);
            if (s == 0) sY[tt * 32 + r] = y;
        }
        __syncthreads();
        for (int i = tid; i < 1024; i += NTHR) { const int tt = i >> 5, rr = i & 31; YRAW[((size_t)b * SEQ + ch * 32 + tt) * RD + h * 64 + half * 32 + rr] = sY[i]; }
    }
    __syncthreads();
}

__device__ __forceinline__ void mlstm_scan_unit(Frame& F, int unit) {
    const int b = unit >> 5, mh = (unit >> 3) & 3, sl = unit & 7;
    const bf16* P = (const bf16*)(F.ws + WS_P); float* HRAW = (float*)(F.ws + WS_HRAW);
    const float* cw = F.in[I_CONVW];
    LAS float* sq = (LAS float*)F.lds;
    LAS float* sk = sq + 64 * 132;
    LAS float* sv = sk + 64 * 132;
    LAS float* sS = sv + 64 * 32;
    LAS float* sC = sS + 64 * 65;
    LAS float* sn = sC + 128 * 32;
    LAS float* sli = sn + 128; LAS float* slf = sli + 64; LAS float* sb = slf + 64; LAS float* spm = sb + 64; LAS float* swk = spm + 64;
    const int tid = F.tid;
    for (int i = tid; i < 128 * 32; i += NTHR) sC[i] = 0.f;
    if (tid < 128) sn[tid] = 0.f;
    float mstate = 0.f;
    const float ib = F.in[I_IB][mh], fb = F.in[I_FB][mh];
    __syncthreads();
    for (int ch = 0; ch < SEQ / 64; ++ch) {
        const int t0 = ch * 64; const size_t tk0 = (size_t)b * SEQ + t0;
        for (int i = tid; i < 64 * 128; i += NTHR) { const int t = i >> 7, d = i & 127; const int cq = mh * 128 + d, ck = 512 + mh * 128 + d;
            float aq = 0.f, ak = 0.f;
#pragma unroll
            for (int j = 0; j < 4; ++j) { const int ts = t0 + t - 3 + j; if (ts >= 0) { const bf16* pr = P + ((size_t)b * SEQ + ts) * NINP + MLO; aq += bf2f(pr[cq]) * cw[j * 1024 + cq]; ak += bf2f(pr[ck]) * cw[j * 1024 + ck]; } }
            sq[t * 132 + d] = aq * sigm(aq) * 0.08838834764831845f; sk[t * 132 + d] = ak * sigm(ak); }
        for (int i = tid; i < 64 * 32; i += NTHR) { const int t = i >> 5, dd = i & 31; sv[i] = bf2f(P[(tk0 + t) * NINP + MLO + 1024 + mh * 256 + sl * 32 + dd]); }
        if (tid < 64) { const bf16* pr = P + (tk0 + tid) * NINP + MLO + 2048; const float ir = bf2f(pr[mh]), fr_ = bf2f(pr[4 + mh]);
            const float ip = 15.f * tanhf((ir + ib) * (1.f / 15.f)), fp = 15.f * tanhf((fr_ + fb) * (1.f / 15.f));
            sli[tid] = ip; slf[tid] = fminf(fp, 0.f) - log1pf(__expf(-fabsf(fp))); }
        __syncthreads();
        if (tid == 0) { float acc = 0.f, pm = -INFINITY; for (int t = 0; t < 64; ++t) { acc += slf[t]; sb[t] = acc; pm = fmaxf(pm, sli[t] - acc); spm[t] = pm; } }
        __syncthreads();
        const float gtot = sb[63], pmall = spm[63]; const float mnew = gtot + fmaxf(mstate, pmall); const float dec = __expf(gtot + mstate - mnew);
        if (tid < 64) swk[tid] = __expf(sli[tid] + gtot - sb[tid] - mnew);
        for (int i = tid; i < 64 * 64; i += NTHR) { const int t = i >> 6, j = i & 63; float v = 0.f;
            if (j <= t) { float d = 0.f; const LAS f32x4* q4 = (const LAS f32x4*)(sq + t * 132); const LAS f32x4* k4 = (const LAS f32x4*)(sk + j * 132);
#pragma unroll 8
                for (int kk = 0; kk < 32; ++kk) { const f32x4 a = q4[kk], bb = k4[kk]; d += (a[0] * bb[0] + a[1] * bb[1]) + (a[2] * bb[2] + a[3] * bb[3]); }
                const float mt = sb[t] + fmaxf(mstate, spm[t]); v = d * __expf(sb[t] - sb[j] + sli[j] - mt); }
            sS[t * 65 + j] = v; }
        __syncthreads();
        for (int i = tid; i < 64 * 32; i += NTHR) { const int t = i >> 5, dd = i & 31; float a1 = 0.f, rs = 0.f, a2 = 0.f, qn = 0.f;
            for (int j = 0; j <= t; ++j) { const float s_ = sS[t * 65 + j]; a1 += s_ * sv[j * 32 + dd]; rs += s_; }
            for (int kk = 0; kk < 128; ++kk) { const float q_ = sq[t * 132 + kk]; a2 += q_ * sC[kk * 32 + dd]; qn += q_ * sn[kk]; }
            const float mx = fmaxf(mstate, spm[t]); const float wi = __expf(mstate - mx); const float mt = sb[t] + mx;
            const float num = a1 + wi * a2, den = rs + wi * qn;
            HRAW[(tk0 + t) * RD + mh * 256 + sl * 32 + dd] = num / fmaxf(fabsf(den), __expf(-mt)); }
        __syncthreads();
        for (int i = tid; i < 128 * 32; i += NTHR) { const int kk = i >> 5, dd = i & 31; float a = 0.f;
            for (int j = 0; j < 64; ++j) a += swk[j] * sk[j * 132 + kk] * sv[j * 32 + dd];
            sC[i] = dec * sC[i] + a; }
        if (tid < 128) { float a = 0.f; for (int j = 0; j < 64; ++j) a += swk[j] * sk[j * 132 + tid]; sn[tid] = dec * sn[tid] + a; }
        mstate = mnew;
        __syncthreads();
    }
}

__device__ __forceinline__ void p5_finalize(Frame& F) {
    const bf16* P = (const bf16*)(F.ws + WS_P); const float* WAG = (const float*)(F.ws + WS_WAG); const float* YRAW = (const float*)(F.ws + WS_YRAW); const float* HRAW = (const float*)(F.ws + WS_HRAW);
    bf16* OA = (bf16*)(F.ws + WS_OA); bf16* OB = (bf16*)(F.ws + WS_OB);
    const int gw = F.bid * NWAVES + F.wave, NGW = F.G * NWAVES, c = F.lane;
    const float* mu = F.in[I_MU];
    for (int q = gw; q < T * RH; q += NGW) { const int tk = q >> 4, h = q & 15, col = h * 64 + c; const bf16* prow = P + (size_t)tk * NINP;
        const float pr = bf2f(prow[col]), pk = bf2f(prow[1024 + col]), pv = bf2f(prow[2048 + col]);
        float qr = 0.f, qk = 0.f, qv = 0.f; if (tk & (SEQ - 1)) { const bf16* pp = prow - NINP; qr = bf2f(pp[col]); qk = bf2f(pp[1024 + col]); qv = bf2f(pp[2048 + col]); }
        const float rr = pr + (qr - pr) * mu[col], k1 = pk + (qk - pk) * mu[1024 + col], vv = pv + (qv - pv) * mu[2048 + col];
        const float a = WAG[(size_t)tk * 3072 + 1024 + col], g = WAG[(size_t)tk * 3072 + 2048 + col];
        const float kmod = k1 * (1.f + (a - 1.f) * F.in[I_KA][col]);
        const float bonus = wave_sum(rr * kmod * F.in[I_RK][col]) * vv;
        const float y = YRAW[(size_t)tk * RD + col]; const float mean = wave_sum(y) * (1.f / 64.f); const float dlt = y - mean; const float var = wave_sum(dlt * dlt) * (1.f / 64.f);
        const float yn = dlt * (1.f / sqrtf(var + GN_EPS)) * F.in[I_LNW][col] + F.in[I_LNB][col];
        OA[(size_t)tk * RD + col] = (bf16)f2bf((yn + bonus) * g); }
    for (int q = gw; q < T * MH; q += NGW) { const int tk = q >> 2, mh = q & 3, d0 = mh * 256 + 4 * c;
        const f32x4 hv = *(const f32x4*)(HRAW + (size_t)tk * RD + d0); const float ss = wave_sum((hv[0] * hv[0] + hv[1] * hv[1]) + (hv[2] * hv[2] + hv[3] * hv[3]));
        const float rs = 1.f / sqrtf(ss * (1.f / 256.f) + NORM_EPS); const v2u po = *(const v2u*)(P + (size_t)tk * NINP + MLO + 2056 + d0); const f32x4 nw = *(const f32x4*)(F.in[I_MNW] + d0);
        const float o0 = hv[0] * rs * nw[0] * sigm(__uint_as_float(po.x << 16)), o1 = hv[1] * rs * nw[1] * sigm(__uint_as_float(po.x & 0xffff0000u));
        const float o2 = hv[2] * rs * nw[2] * sigm(__uint_as_float(po.y << 16)), o3 = hv[3] * rs * nw[3] * sigm(__uint_as_float(po.y & 0xffff0000u));
        v2u o; o.x = pk2(o0, o1); o.y = pk2(o2, o3); *(v2u*)(OB + (size_t)tk * RD + d0) = o; }
}

__device__ __forceinline__ void p8_route(Frame& F) {
    const float* X1 = (const float*)(F.ws + WS_X1); bf16* H2 = (bf16*)(F.ws + WS_HN); int* RLIST = (int*)(F.ws + WS_RLIST); float* RWT = (float*)(F.ws + WS_RW);
    const float* nw = F.in[I_N2W]; const float* rtw = F.in[I_RTW]; const float* rtb = F.in[I_RTB];
    const int gw = F.bid * NWAVES + F.wave, NGW = F.G * NWAVES;
    for (int m = gw; m < T; m += NGW) {
        const f32x4* xr = (const f32x4*)(X1 + (size_t)m * D) + F.lane; f32x4 v[8]; float s = 0.f;
#pragma unroll
        for (int j = 0; j < 8; ++j) { v[j] = xr[64 * j]; s += (v[j][0] * v[j][0] + v[j][1] * v[j][1]) + (v[j][2] * v[j][2] + v[j][3] * v[j][3]); }
        const float rstd = 1.f / sqrtf(wave_sum(s) * (1.f / D) + NORM_EPS);
        v2u* o8 = (v2u*)(H2 + (size_t)m * D) + F.lane;
        float lg[32];
#pragma unroll
        for (int e = 0; e < 32; ++e) lg[e] = 0.f;
#pragma unroll
        for (int j = 0; j < 8; ++j) { const f32x4 w = ((const f32x4*)nw)[F.lane + 64 * j]; f32x4 hv = v[j] * rstd * w; v2u o; o.x = pk2(hv[0], hv[1]); o.y = pk2(hv[2], hv[3]); o8[64 * j] = o;
#pragma unroll
            for (int cc = 0; cc < 4; ++cc) { const f32x4* wr = (const f32x4*)(rtw + (size_t)(4 * F.lane + 256 * j + cc) * NE);
#pragma unroll
                for (int e4 = 0; e4 < 8; ++e4) { const f32x4 ww = wr[e4]; lg[4 * e4 + 0] += hv[cc] * ww[0]; lg[4 * e4 + 1] += hv[cc] * ww[1]; lg[4 * e4 + 2] += hv[cc] * ww[2]; lg[4 * e4 + 3] += hv[cc] * ww[3]; } } }
#pragma unroll
        for (int e = 0; e < 32; ++e) lg[e] = wave_sum(lg[e]) + rtb[e];
        unsigned used = 0u; int idx[4]; float val[4];
#pragma unroll
        for (int s4 = 0; s4 < 4; ++s4) { float best = -INFINITY; int bi = 0;
#pragma unroll
            for (int e = 0; e < 32; ++e) { const bool ok = !((used >> e) & 1u) && (lg[e] > best); best = ok ? lg[e] : best; bi = ok ? e : bi; }
            used |= 1u << bi; idx[s4] = bi; val[s4] = best; }
        const float e1 = __expf(val[1] - val[0]), e2 = __expf(val[2] - val[0]), e3 = __expf(val[3] - val[0]); const float inv = 1.f / (1.f + e1 + e2 + e3);
        if (F.lane < 4) { const int my_e = F.lane == 0 ? idx[0] : (F.lane == 1 ? idx[1] : (F.lane == 2 ? idx[2] : idx[3]));
            const float my_w = (F.lane == 0 ? 1.f : (F.lane == 1 ? e1 : (F.lane == 2 ? e2 : e3))) * inv;
            const unsigned pos = atomicAdd(F.ctl + CW_CNT + 64 * my_e, 1u);
            RLIST[my_e * ECAP + pos] = m * 4 + F.lane; RWT[my_e * ECAP + pos] = my_w; }
    }
}

__device__ __forceinline__ void build_moe_tables(Frame& F) {
    LAS int* MI = (LAS int*)F.MISC;
    __syncthreads();
    if (F.tid == 0) { int mt = 0, cs = 0;
        for (int e = 0; e < NE; ++e) { const int c = (int)__hip_atomic_load(F.ctl + CW_CNT + 64 * e, __ATOMIC_RELAXED, __HIP_MEMORY_SCOPE_AGENT); MI[MI_CNT + e] = c; MI[MI_POFF + e] = mt * 256; MI[MI_CST + e] = cs; cs += c;
            const int nt = (c + 255) >> 8; for (int i = 0; i < nt; ++i) { MI[MI_TILE_E + mt + i] = e; MI[MI_TILE_I0 + mt + i] = i * 256; } mt += nt; }
        MI[MI_CST + NE] = cs; MI[MI_MT] = mt; }
    __syncthreads();
}
__device__ __forceinline__ void p9_gather(Frame& F) {
    build_moe_tables(F);
    const LAS int* MI = (const LAS int*)F.MISC; const bf16* H2 = (const bf16*)(F.ws + WS_HN); bf16* XB = (bf16*)(F.ws + WS_XB); const int* RLIST = (const int*)(F.ws + WS_RLIST);
    const int gw = F.bid * NWAVES + F.wave, NGW = F.G * NWAVES, total = MI[MI_CST + NE];
    for (int q = gw; q < total; q += NGW) { int e = 0;
        for (int k = 1; k < NE; ++k) e = (MI[MI_CST + k] <= q) ? k : e;
        const int i = q - MI[MI_CST + e]; const int tok = RLIST[e * ECAP + i] >> 2;
        const v4u* src = (const v4u*)(H2 + (size_t)tok * D) + F.lane; v4u* dst = (v4u*)(XB + (size_t)(MI[MI_POFF + e] + i) * D) + F.lane;
#pragma unroll
        for (int j = 0; j < 4; ++j) dst[64 * j] = src[64 * j]; }
}
__device__ __forceinline__ void p12_final(Frame& F) {
    const float* X1 = (const float*)(F.ws + WS_X1); const bf16* YS = (const bf16*)(F.ws + WS_YS); const float* fw = F.in[I_FNW];
    const int gw = F.bid * NWAVES + F.wave, NGW = F.G * NWAVES;
    for (int m = gw; m < T; m += NGW) {
        const f32x4* xr = (const f32x4*)(X1 + (size_t)m * D) + F.lane; f32x4 v[8]; float s = 0.f;
#pragma unroll
        for (int j = 0; j < 8; ++j) { v[j] = xr[64 * j];
#pragma unroll
            for (int sl = 0; sl < 4; ++sl) { const v2u y = ((const v2u*)(YS + ((size_t)m * 4 + sl) * D))[F.lane + 64 * j];
                v[j][0] += __uint_as_float(y.x << 16); v[j][1] += __uint_as_float(y.x & 0xffff0000u); v[j][2] += __uint_as_float(y.y << 16); v[j][3] += __uint_as_float(y.y & 0xffff0000u); }
            s += (v[j][0] * v[j][0] + v[j][1] * v[j][1]) + (v[j][2] * v[j][2] + v[j][3] * v[j][3]); }
        const float rstd = 1.f / sqrtf(wave_sum(s) * (1.f / D) + NORM_EPS);
        f32x4* orow = (f32x4*)(F.out + (size_t)m * D) + F.lane;
#pragma unroll
        for (int j = 0; j < 8; ++j) { const f32x4 w = ((const f32x4*)fw)[F.lane + 64 * j]; orow[64 * j] = v[j] * rstd * w; }
    }
}

__global__ void __launch_bounds__(NTHR, 2) mk_fwd(Args args) {
    extern __shared__ __attribute__((aligned(16))) unsigned char lds[];
    Frame F;
    F.lds = (LAS unsigned char*)lds; F.MISC = (volatile LAS unsigned*)(F.lds + MISC_OFF);
    F.tid = threadIdx.x; F.lane = F.tid & 63; F.wave = __builtin_amdgcn_readfirstlane(F.tid >> 6); F.G = gridDim.x; F.bid = blockIdx.x;
    F.in = args.in; F.out = args.out; F.ws = args.ws; F.ctl = (unsigned*)(args.ws + WS_CTL);
    for (int u = F.tid; u < (LDS_BYTES - MISC_OFF) / 4; u += NTHR) ((LAS unsigned*)(F.lds + MISC_OFF))[u] = 0u;
    __syncthreads();
    XcdBarrier bar; bar.bar = F.ctl + CW_BAR; bar.x = 0; bar.st = nullptr;
    if (MK_N_LAUNCHES == 1) bar = xcd_barrier_post(F.ctl + CW_BAR, F.MISC + 8);
    const int lo = args.ph_lo, hi = args.ph_hi;
#define IN(k) (lo <= (k) && (k) < hi)
#define SEAM(k) do { if (IN(k) && IN((k) + 1)) xcd_barrier(bar); } while (0)
    LAS unsigned char* ring = F.lds;
    const LAS int* MI = (const LAS int*)F.MISC;

    if (IN(0)) { p0_prologue(F); } SEAM(0);
    if (IN(1)) {
        pg8::Gemm g{(const bf16*)(F.ws + WS_HN), (const bf16*)(F.ws + WS_WIN), T, NINP, D}; pg8::StaticOrder S; S.init(T, NINP, F.G, F.bid);
        EpiBf16Plain E{(bf16*)(F.ws + WS_P), NINP};
        pg8::gemm_phase<EpiBf16Plain, pg8::StaticOrder, true, true>(ring, g, S, E);
    } SEAM(1);
    if (IN(2)) { p2_lora_in(F); } SEAM(2);
    if (IN(3)) {
        pg8::Gemm g{(const bf16*)(F.ws + WS_LIN), (const bf16*)(F.ws + WS_WL), T, 3072, 512}; pg8::StaticOrder S; S.init(T, 3072, F.G, F.bid);
        EpiLora E{(float*)(F.ws + WS_WAG), F.in[I_W0], F.in[I_A0]};
        pg8::gemm_phase<EpiLora, pg8::StaticOrder, true, true>(ring, g, S, E);
    } SEAM(3);
    if (IN(4)) {
        for (int u = F.bid; u < 256; u += F.G) rwkv_scan_unit(F, u);
        for (int u = F.bid; u < 256; u += F.G) mlstm_scan_unit(F, u);
    } SEAM(4);
    if (IN(5)) { p5_finalize(F); } SEAM(5);
    if (IN(6)) {
        { pg8::Gemm g{(const bf16*)(F.ws + WS_OA), (const bf16*)(F.ws + WS_WA), T, D, RD}; pg8::StaticOrder S; S.init(T, D, F.G, F.bid);
          EpiGateA E{(float*)(F.ws + WS_TMP), (const bf16*)(F.ws + WS_P), F.in[I_BGATE]};
          pg8::gemm_phase<EpiGateA, pg8::StaticOrder, true, true>(ring, g, S, E); }
        VM_WAIT(); __syncthreads();
        { pg8::Gemm g{(const bf16*)(F.ws + WS_OB), (const bf16*)(F.ws + WS_WB), T, D, RD}; pg8::StaticOrder S; S.init(T, D, F.G, F.bid);
          EpiGateB E{(const float*)(F.ws + WS_TMP), (bf16*)(F.ws + WS_MRG), (const bf16*)(F.ws + WS_P), F.in[I_BGATE]};
          pg8::gemm_phase<EpiGateB, pg8::StaticOrder, true, true>(ring, g, S, E); }
    } SEAM(6);
    if (IN(7)) {
        pg8::Gemm g{(const bf16*)(F.ws + WS_MRG), (const bf16*)(F.ws + WS_WO), T, D, D}; pg8::StaticOrder S; S.init(T, D, F.G, F.bid);
        EpiResid E{F.in[I_X], (float*)(F.ws + WS_X1)};
        pg8::gemm_phase<EpiResid, pg8::StaticOrder, true, true>(ring, g, S, E);
    } SEAM(7);
    if (IN(8)) { p8_route(F); } SEAM(8);
    if (IN(9)) { p9_gather(F); } SEAM(9);
    if (IN(10)) {
        build_moe_tables(F);
        const int mt = MI[MI_MT];
        pg8::Gemm g{(const bf16*)(F.ws + WS_XB), (const bf16*)(F.ws + WS_WGU), mt * 256, 2 * FF, D};
        MoeOrder S; S.init(mt * 256, 2 * FF, F.G, F.bid); S.tile_e = MI + MI_TILE_E; S.estride = (size_t)2 * FF * D * 2;
        EpiSwiGLU E{(bf16*)(F.ws + WS_ACT), F.in[I_BGU], MI + MI_TILE_E};
        pg8::gemm_phase<EpiSwiGLU, MoeOrder, true, true>(ring, g, S, E);
    } SEAM(10);
    if (IN(11)) {
        build_moe_tables(F);
        const int mt = MI[MI_MT];
        pg8::Gemm g{(const bf16*)(F.ws + WS_ACT), (const bf16*)(F.ws + WS_WDN), mt * 256, D, FF};
        MoeOrder S; S.init(mt * 256, D, F.G, F.bid); S.tile_e = MI + MI_TILE_E; S.estride = (size_t)D * FF * 2;
        EpiDown E{(bf16*)(F.ws + WS_YS), F.in[I_BDN], (const int*)(F.ws + WS_RLIST), (const float*)(F.ws + WS_RW), MI + MI_TILE_E, MI + MI_TILE_I0, MI + MI_CNT};
        pg8::gemm_phase<EpiDown, MoeOrder, true, true>(ring, g, S, E);
    } SEAM(11);
    if (IN(12)) { p12_final(F); }
#undef IN
#undef SEAM
}

extern "C" void kernel_launch(void* const* d_in, const int* in_sizes, int n_in, void* d_out, int out_size, void* d_ws, size_t ws_size, hipStream_t stream) {
    static int grid = 0;
    if (grid == 0) {
        if (n_in != 30 || out_size != T * D || ws_size < WS_END) { fprintf(stderr, "kernel_launch: unexpected problem (n_in %d, out %d, ws %zu)\n", n_in, out_size, ws_size); grid = -1; return; }
        int dev = 0, cus = 0, per_cu = 0;
        if (hipGetDevice(&dev) != hipSuccess || hipDeviceGetAttribute(&cus, hipDeviceAttributeMultiprocessorCount, dev) != hipSuccess) { grid = -1; return; }
        if (hipFuncSetAttribute((const void*)mk_fwd, hipFuncAttributeMaxDynamicSharedMemorySize, LDS_BYTES) != hipSuccess) { fprintf(stderr, "kernel_launch: hipFuncSetAttribute failed\n"); grid = -1; return; }
        if (hipOccupancyMaxActiveBlocksPerMultiprocessor(&per_cu, (const void*)mk_fwd, NTHR, LDS_BYTES) != hipSuccess || per_cu < 1) fprintf(stderr, "kernel_launch: occupancy query says %d\n", per_cu);
        (void)hipGetLastError();
        grid = cus;
    }
    if (grid < 0) return;
    if (hipMemsetAsync((char*)d_ws + WS_CTL, 0, CTL_ZERO_BYTES, stream) != hipSuccess) return;
    Args a{};
    for (int i = 0; i < 30; ++i) a.in[i] = (const float*)d_in[i];
    a.out = (float*)d_out; a.ws = (unsigned char*)d_ws;
    for (int li = 0; li < MK_N_LAUNCHES; ++li) {
        a.ph_lo = (MK_N_LAUNCHES == 1) ? 0 : li; a.ph_hi = (MK_N_LAUNCHES == 1) ? NPH : li + 1;
        hipLaunchKernelGGL(mk_fwd, dim3(grid), dim3(NTHR), LDS_BYTES, stream, a);
        const hipError_t le = hipPeekAtLastError();
        if (le != hipSuccess) { fprintf(stderr, "kernel_launch: launch %d failed: %s\n", li, hipGetErrorName(le)); break; }
    }
}
```

```cpp
#include <hip/hip_runtime.h>
#include <cstdio>
#include <cstdint>
#define MK_N_LAUNCHES 1
#define PROBE_PHASE -1
namespace pg8 {
#define PG8_LAS __attribute__((address_space(3)))
typedef unsigned short bf16_t;
typedef short bf16x8 __attribute__((ext_vector_type(8)));
typedef float f32x4 __attribute__((ext_vector_type(4)));
typedef unsigned u32x4 __attribute__((ext_vector_type(4)));
constexpr int BM = 256, BK = 64, HALF = 128, HTB = HALF * BK * 2  , STAGE_BYTES = 8 * HTB, NXCD = 8, WGM = 8;

__host__ __device__ __forceinline__ int lds_byte(int r, int c) { const int st = (r >> 4) * 2 + (c >> 5), rr = r & 15, cc = c & 31, ob = rr * 64 + cc * 2; return st * 1024 + (ob ^ (((ob >> 9) & 1) << 5)); }
__host__ __device__ __forceinline__ void stage_rc(int b, int& R, int& C) { const int st = b / 1024, sb = b % 1024, swz = sb ^ (((sb >> 9) & 1) << 5); R = (st >> 1) * 16 + swz / 64; C = (st & 1) * 32 + (swz % 64) / 2; }
__host__ __device__ __forceinline__ int perm32(int rho) { const int n = rho >> 4, i = rho & 15; return 8 * (i >> 2) + 4 * n + (i & 3); }

struct Unit { int pm, pn, ord; };
struct Gemm { const bf16_t* A; const bf16_t* Bt; int M, N, K; };

struct StaticOrder {
    int nM, nN, nwg, G, c;
    __host__ __device__ void init(int M, int N, int G_, int c_) { nM = M / BM; nN = N / BM; nwg = nM * nN; G = G_; c = c_; }
    __host__ __device__ bool next(int i, Unit& u) const {
        const long L = (long)i * G + c; if (L >= nwg) return false;
        int wgid = (int)L; { const int q = nwg / NXCD, r = nwg % NXCD, xcd = wgid % NXCD, off = wgid / NXCD; wgid = (xcd < r ? xcd * (q + 1) : r * (q + 1) + (xcd - r) * q) + off; }
        const int nig = WGM * nN, gid = wgid / nig, fm = gid * WGM, gsz = (nM - fm) < WGM ? (nM - fm) : WGM;
        u.pm = fm + ((wgid % nig) % gsz); u.pn = (wgid % nig) / gsz; u.ord = i; return true;
    }
    __device__ __forceinline__ void a_ready(const Unit&) const {}
    static constexpr bool GATHER = false;
    __device__ __forceinline__ void fill_all() const {}
    __device__ __forceinline__ unsigned row_off(int, int) const { return 0u; }
    __device__ __forceinline__ void done(const Unit&) const {}
    __device__ __forceinline__ size_t a_off(const Unit& u, size_t tstep) const { return (size_t)u.pm * tstep; }
    __device__ __forceinline__ size_t b_off(const Unit& u, size_t tstep) const { return (size_t)u.pn * tstep; }
};
__device__ __forceinline__ unsigned cvt_pk_bf16(float lo, float hi) { unsigned r; asm volatile("v_cvt_pk_bf16_f32 %0, %1, %2" : "=v"(r) : "v"(lo), "v"(hi)); return r; }
typedef int v8i32 __attribute__((ext_vector_type(8)));
typedef int v4i32 __attribute__((ext_vector_type(4)));
__device__ __forceinline__ v8i32 cat8(bf16x8 lo, bf16x8 hi) { const v4i32 a = __builtin_bit_cast(v4i32, lo), b = __builtin_bit_cast(v4i32, hi); return __builtin_shufflevector(a, b, 0, 1, 2, 3, 4, 5, 6, 7); }
template <class Epi, class Sched, bool ALIGN_EPI = false, bool SP2 = false, bool FP8 = false>
__device__ __forceinline__ void gemm_phase(PG8_LAS unsigned char* lds, const Gemm g, const Sched& S, const Epi& E) {
    const int tid = threadIdx.x, wid = __builtin_amdgcn_readfirstlane(tid >> 6), lane = tid & 63, wr = wid >> 2, wc = wid & 3, fr = lane & 15, fq = lane >> 4;
    const int K = g.K, nt = K / BK;
    unsigned voffA[2], voffB[2];
#pragma unroll
    for (int i = 0; i < 2; ++i) { int R, C; stage_rc(tid * 16 + i * 8192, R, C); const int Rb = Epi::PERM ? ((R & ~31) + perm32(R & 31)) : R;
        voffA[i] = (unsigned)(R * K + C) * 2u; voffB[i] = (unsigned)(Rb * K + C) * 2u; }
    unsigned voffA1[2]; int rselA[2]; unsigned cselA[2];
#pragma unroll
    for (int i = 0; i < 2; ++i) { int R, C; stage_rc(tid * 16 + i * 8192, R, C); rselA[i] = R; cselA[i] = (unsigned)C * 2u; voffA1[i] = voffA[i]; }
    const size_t kstep = (size_t)(BK * 2);
    const size_t hstep = (size_t)HALF * K * 2;
    const size_t tstep = 2 * hstep;
    const size_t hstepA = Sched::GATHER ? (size_t)0 : hstep;
#define PG8_ROWS(_u) do { _Pragma("unroll") for (int _i = 0; _i < 2; ++_i) { voffA[_i] = S.row_off((_u), rselA[_i]) + cselA[_i]; voffA1[_i] = S.row_off((_u), HALF + rselA[_i]) + cselA[_i]; } } while (0)
    const unsigned ldsw = (unsigned)wid * 1024u;
    const int aoff = lds_byte(wr * 64 + fr, fq * 8), boff = lds_byte(wc * 32 + fr, fq * 8);
#define PG8_SA(b, h) (((b) * 2 + (h)) * HTB)
#define PG8_SB(b, h) ((4 + (b) * 2 + (h)) * HTB)
#define PG8_STAGE(bufoff, gbase, voff) do { _Pragma("unroll") for (int _i = 0; _i < 2; ++_i) \
        __builtin_amdgcn_global_load_lds((const unsigned*)((const char*)(gbase) + (voff)[_i]), (PG8_LAS unsigned*)(lds + (bufoff) + ldsw + _i * 8192), 16, 0, 0); } while (0)
#define PG8_LDA(dst, b, h) do { if constexpr (FP8) { _Pragma("unroll") for (int m = 0; m < 4; ++m) dst##8[m] = cat8(*(const PG8_LAS bf16x8*)(lds + PG8_SA(b, h) + aoff + m * 2048), *(const PG8_LAS bf16x8*)(lds + PG8_SA(b, h) + aoff + m * 2048 + 1024)); } \
        else { _Pragma("unroll") for (int m = 0; m < 4; ++m) _Pragma("unroll") for (int k = 0; k < 2; ++k) dst[m][k] = *(const PG8_LAS bf16x8*)(lds + PG8_SA(b, h) + aoff + m * 2048 + k * 1024); } } while (0)
#define PG8_LDB(dst, b, h) do { if constexpr (FP8) { _Pragma("unroll") for (int n = 0; n < 2; ++n) dst##8[n] = cat8(*(const PG8_LAS bf16x8*)(lds + PG8_SB(b, h) + boff + n * 2048), *(const PG8_LAS bf16x8*)(lds + PG8_SB(b, h) + boff + n * 2048 + 1024)); } \
        else { _Pragma("unroll") for (int n = 0; n < 2; ++n) _Pragma("unroll") for (int k = 0; k < 2; ++k) dst[n][k] = *(const PG8_LAS bf16x8*)(lds + PG8_SB(b, h) + boff + n * 2048 + k * 1024); } } while (0)
#define PG8_MMA(ai, bj, At, Bt) do { __builtin_amdgcn_s_setprio(1); if constexpr (FP8) { _Pragma("unroll") for (int m = 0; m < 4; ++m) _Pragma("unroll") for (int n = 0; n < 2; ++n) \
        asm volatile("v_mfma_scale_f32_16x16x128_f8f6f4 %0, %1, %2, %0, %3, %3 op_sel_hi:[0,0,0]" : "+v"(acc[ai][bj][m][n]) : "v"(Bt##8[n]), "v"(At##8[m]), "v"(f8scale)); } else { \
        _Pragma("unroll") for (int m = 0; m < 4; ++m) _Pragma("unroll") for (int n = 0; n < 2; ++n) _Pragma("unroll") for (int k = 0; k < 2; ++k) \
        acc[ai][bj][m][n] = __builtin_amdgcn_mfma_f32_16x16x32_bf16(Bt[n][k], At[m][k], acc[ai][bj][m][n], 0, 0, 0); } __builtin_amdgcn_s_setprio(0); } while (0)
#define PG8_WAIT_V(n) asm volatile("s_waitcnt vmcnt(" #n ")" ::: "memory")
#define PG8_WAIT_L(n) asm volatile("s_waitcnt lgkmcnt(" #n ")" ::: "memory")
#define PG8_BAR __builtin_amdgcn_s_barrier()
#define PG8_SCHED __builtin_amdgcn_sched_barrier(0)
    Unit cur, nxt; int ui = 0;
    if (!S.next(0, cur)) return;
    f32x4 acc[2][2][4][2];
#pragma unroll
    for (int a = 0; a < 2; ++a)
#pragma unroll
        for (int b = 0; b < 2; ++b)
#pragma unroll
            for (int m = 0; m < 4; ++m)
#pragma unroll
                for (int n = 0; n < 2; ++n) acc[a][b][m][n] = (f32x4){0.f, 0.f, 0.f, 0.f};
    const int f8scale = 0x7f7f7f7f;
    bf16x8 At[4][2], B0[2][2], B1[2][2]; v8i32 At8[4], B08[2], B18[2];
    const char* cA = (const char*)g.A + S.a_off(cur, tstep); const char* cB = (const char*)g.Bt + S.b_off(cur, tstep);
    S.a_ready(cur);
    if constexpr (Sched::GATHER) { S.fill_all(); asm volatile("s_waitcnt vmcnt(0) lgkmcnt(0)" ::: "memory"); __builtin_amdgcn_s_barrier(); asm volatile("" ::: "memory"); PG8_ROWS(0); }
    if constexpr (SP2) {
        PG8_STAGE(PG8_SB(0, 0), cB, voffB); PG8_STAGE(PG8_SB(0, 1), cB + hstep, voffB); PG8_STAGE(PG8_SA(0, 0), cA, voffA); PG8_STAGE(PG8_SA(0, 1), cA + hstepA, voffA1);
        if (wr == 1) PG8_BAR;
        PG8_WAIT_V(2); PG8_BAR;
        PG8_STAGE(PG8_SB(1, 0), cB + kstep, voffB); PG8_STAGE(PG8_SA(1, 0), cA + kstep, voffA); PG8_STAGE(PG8_SB(1, 1), cB + hstep + kstep, voffB);
        PG8_WAIT_V(6); PG8_BAR;
    } else {
        PG8_STAGE(PG8_SB(0, 0), cB, voffB); PG8_STAGE(PG8_SA(0, 0), cA, voffA); PG8_STAGE(PG8_SB(0, 1), cB + hstep, voffB); PG8_STAGE(PG8_SA(0, 1), cA + hstepA, voffA1);
        if (wr == 1) PG8_BAR;
        PG8_WAIT_V(4); PG8_BAR;
        PG8_STAGE(PG8_SB(1, 0), cB + kstep, voffB); PG8_STAGE(PG8_SA(1, 0), cA + kstep, voffA); PG8_STAGE(PG8_SB(1, 1), cB + hstep + kstep, voffB);
        PG8_WAIT_V(6); PG8_BAR;
    }
    for (;;) {
        const bool has_next = S.next(ui + 1, nxt);
        const char* nA = has_next ? (const char*)g.A + S.a_off(nxt, tstep) : cA; const char* nB = has_next ? (const char*)g.Bt + S.b_off(nxt, tstep) : cB;
        for (int t = 0; t < nt; t += 2) {
            const bool last = (t == nt - 2);
            const char* a1 = cA + (size_t)(t + 1) * kstep;
            const char* a2 = last ? nA : cA + (size_t)(t + 2) * kstep; const char* b2 = last ? nB : cB + (size_t)(t + 2) * kstep;
            const char* a3 = a2 + kstep; const char* b3 = b2 + kstep;
            if (last && has_next) S.a_ready(nxt);
            if constexpr (SP2) {
            PG8_LDB(B0, 0, 0); PG8_LDB(B1, 0, 1); PG8_SCHED; PG8_LDA(At, 0, 0); PG8_STAGE(PG8_SA(1, 1), a1 + hstepA, voffA1);
            PG8_WAIT_V(8); PG8_WAIT_L(0); PG8_BAR; PG8_MMA(0, 0, At, B0); PG8_MMA(0, 1, At, B1); PG8_BAR; PG8_SCHED;
            if constexpr (Sched::GATHER) { if (last && has_next) PG8_ROWS(ui + 1); }
            PG8_LDA(At, 0, 1); PG8_STAGE(PG8_SB(0, 0), b2, voffB); PG8_STAGE(PG8_SB(0, 1), b2 + hstep, voffB); PG8_STAGE(PG8_SA(0, 0), a2, voffA);
            PG8_WAIT_V(8); PG8_WAIT_L(0); PG8_BAR; PG8_MMA(1, 0, At, B0); PG8_MMA(1, 1, At, B1); PG8_BAR; PG8_SCHED;
            PG8_LDB(B0, 1, 0); PG8_LDB(B1, 1, 1); PG8_SCHED; PG8_LDA(At, 1, 0); PG8_STAGE(PG8_SA(0, 1), a2 + hstepA, voffA1);
            PG8_WAIT_V(8); PG8_WAIT_L(0); PG8_BAR; PG8_MMA(0, 0, At, B0); PG8_MMA(0, 1, At, B1); PG8_BAR; PG8_SCHED;
            PG8_LDA(At, 1, 1); PG8_STAGE(PG8_SB(1, 0), b3, voffB); PG8_STAGE(PG8_SB(1, 1), b3 + hstep, voffB); PG8_STAGE(PG8_SA(1, 0), a3, voffA);
            PG8_WAIT_V(8); PG8_WAIT_L(0); PG8_BAR; PG8_MMA(1, 0, At, B0); PG8_MMA(1, 1, At, B1); PG8_BAR; PG8_SCHED;
            } else {
            PG8_LDB(B0, 0, 0); PG8_SCHED; PG8_LDA(At, 0, 0); PG8_STAGE(PG8_SA(1, 1), a1 + hstepA, voffA1);
            PG8_WAIT_L(8); PG8_BAR; PG8_WAIT_L(0); PG8_MMA(0, 0, At, B0); PG8_BAR; PG8_SCHED;
            PG8_LDB(B1, 0, 1); PG8_STAGE(PG8_SB(0, 0), b2, voffB);
            PG8_BAR; PG8_WAIT_L(0); PG8_MMA(0, 1, At, B1); PG8_BAR;
            PG8_LDA(At, 0, 1); PG8_STAGE(PG8_SA(0, 0), a2, voffA);
            PG8_BAR; PG8_WAIT_L(0); PG8_MMA(1, 0, At, B0); PG8_BAR; PG8_SCHED;
            PG8_STAGE(PG8_SB(0, 1), b2 + hstep, voffB);
            PG8_WAIT_V(6); PG8_BAR; PG8_MMA(1, 1, At, B1); PG8_BAR;
            PG8_LDB(B0, 1, 0); PG8_SCHED; PG8_LDA(At, 1, 0); PG8_STAGE(PG8_SA(0, 1), a2 + hstepA, voffA1);
            PG8_WAIT_L(8); PG8_BAR; PG8_WAIT_L(0); PG8_MMA(0, 0, At, B0); PG8_BAR; PG8_SCHED;
            PG8_LDB(B1, 1, 1); PG8_STAGE(PG8_SB(1, 0), b3, voffB);
            PG8_BAR; PG8_WAIT_L(0); PG8_MMA(0, 1, At, B1); PG8_BAR;
            PG8_LDA(At, 1, 1); PG8_STAGE(PG8_SA(1, 0), a3, voffA);
            PG8_BAR; PG8_WAIT_L(0); PG8_MMA(1, 0, At, B0); PG8_BAR; PG8_SCHED;
            PG8_STAGE(PG8_SB(1, 1), b3 + hstep, voffB);
            PG8_WAIT_V(6); PG8_BAR; PG8_MMA(1, 1, At, B1); PG8_BAR;
            }
        }
        if constexpr (ALIGN_EPI) { if (wr == 0) PG8_BAR; }
        if constexpr (FP8) { asm volatile("s_nop 15\n\ts_nop 15" ::: "memory"); }
        if constexpr (!Epi::AFTER_DRAIN) { E(acc, cur, wr, wc, fr, fq); S.done(cur); }
        if (!has_next) break;
#pragma unroll
        for (int a = 0; a < 2; ++a)
#pragma unroll
            for (int b = 0; b < 2; ++b)
#pragma unroll
                for (int m = 0; m < 4; ++m)
#pragma unroll
                    for (int n = 0; n < 2; ++n) acc[a][b][m][n] = (f32x4){0.f, 0.f, 0.f, 0.f};
        cur = nxt; cA = nA; cB = nB; ++ui;
        if constexpr (ALIGN_EPI) { if (wr == 1) PG8_BAR; }
    }
    PG8_WAIT_V(0);
    if constexpr (!ALIGN_EPI) { if (wr == 0) PG8_BAR; }
    PG8_BAR;
    if constexpr (Epi::AFTER_DRAIN) { E.fused(acc, cur, wr, wc, fr, fq, lds, wid, lane); S.done(cur); }
#undef PG8_ROWS
#undef PG8_SA
#undef PG8_SB
#undef PG8_STAGE
#undef PG8_LDA
#undef PG8_LDB
#undef PG8_MMA
#undef PG8_WAIT_V
#undef PG8_WAIT_L
#undef PG8_BAR
#undef PG8_SCHED
}
}

#ifndef MK_N_LAUNCHES
#define MK_N_LAUNCHES 1
#endif
#define GAS __attribute__((address_space(1)))
#define LAS __attribute__((address_space(3)))
typedef unsigned short bf16;
typedef unsigned v4u __attribute__((ext_vector_type(4)));
typedef unsigned v2u __attribute__((ext_vector_type(2)));
typedef float f32x4 __attribute__((ext_vector_type(4)));
typedef float f32x2 __attribute__((ext_vector_type(2)));

constexpr int NWAVES = 8, NTHR = 512;
constexpr int NPH = 13;
constexpr int D = 2048, BATCH = 8, SEQ = 2048, T = BATCH * SEQ;
constexpr int NIN = 10696, NINP = 10752;
constexpr int MLO = 3520, GTO = 6600;
constexpr int RH = 16, RD = 1024;
constexpr int MH = 4;
constexpr int NE = 32, FF = 2048, ECAP = 16384, PMAX = 65536 + NE * 256, MTMAX = PMAX / 256;
constexpr float NORM_EPS = 1e-6f, GN_EPS = 64e-5f;
constexpr size_t MiB = 1u << 20;
constexpr size_t WS_CTL = 0, CTL_ZERO_BYTES = 1 * MiB;
constexpr size_t WS_WIN = 1 * MiB, WS_WA = 43 * MiB, WS_WB = 47 * MiB, WS_WO = 51 * MiB, WS_WL = 59 * MiB;
constexpr size_t WS_RLIST = 62 * MiB, WS_RW = 64 * MiB, WS_RWS = 2787 * MiB;
constexpr size_t WS_WGU = 66 * MiB, WS_WDN = 578 * MiB, WS_HN = 834 * MiB, WS_P = 898 * MiB, WS_LIN = 1234 * MiB, WS_WAG = 1250 * MiB;
constexpr size_t WS_YRAW = 1442 * MiB, WS_HRAW = 1506 * MiB, WS_OA = 1570 * MiB, WS_OB = 1602 * MiB, WS_TMP = 1634 * MiB, WS_MRG = 1762 * MiB;
constexpr size_t WS_QKC = WS_TMP, WS_GLF = WS_TMP + 64 * MiB;
constexpr size_t WS_X1 = 1826 * MiB, WS_XB = 1954 * MiB, WS_ACT = 2242 * MiB, WS_YS = 2530 * MiB, WS_END = 2788 * MiB;
constexpr int CW_BAR = 4096;
constexpr int CW_CVNEXT = 8192, CW_P1DONE = 8192 + 64;
constexpr int NCV = 32;
constexpr int CW_CNT = 16384;
constexpr int RING_BYTES = 131072, MISC_OFF = RING_BYTES, LDS_BYTES = RING_BYTES + 8192 + 20 * 1024;
constexpr int MI_TILE_E = 64, MI_TILE_I0 = 64 + 320, MI_CNT = 64 + 640, MI_POFF = MI_CNT + 32, MI_CST = MI_POFF + 32, MI_MT = MI_CST + 40, MI_ROWOFF = 2048;

#define LDS_WAIT() asm volatile("s_waitcnt lgkmcnt(0)" ::: "memory")
#define VM_WAIT() asm volatile("s_waitcnt vmcnt(0)" ::: "memory")
__device__ __forceinline__ float bf2f(bf16 v) { return __uint_as_float(((unsigned)v) << 16); }
__device__ __forceinline__ unsigned f2bf(float f) { unsigned u = __float_as_uint(f); return (u + 0x7fffu + ((u >> 16) & 1u)) >> 16; }
typedef __bf16 bf16x2_t __attribute__((ext_vector_type(2)));
__device__ __forceinline__ unsigned pk2(float lo, float hi) { const f32x2 v = {lo, hi}; const bf16x2_t b = __builtin_convertvector(v, bf16x2_t); return __builtin_bit_cast(unsigned, b); }
__device__ __forceinline__ unsigned pk4f8(float a, float b, float c, float d) { int r = 0; r = __builtin_amdgcn_cvt_pk_fp8_f32(a, b, r, false); r = __builtin_amdgcn_cvt_pk_fp8_f32(c, d, r, true); return (unsigned)r; }
constexpr float F8_SX = 8.f, F8_SW = 256.f, F8_SA = 4.f;
__device__ __forceinline__ float wave_sum(float v) {
#pragma unroll
    for (int o = 1; o < 64; o <<= 1) v += __shfl_xor(v, o);
    return v;
}
#define UNP4(v) ((f32x4){__uint_as_float((v).x << 16), __uint_as_float((v).x & 0xffff0000u), __uint_as_float((v).y << 16), __uint_as_float((v).y & 0xffff0000u)})
__device__ __forceinline__ float sigm(float x) { return __builtin_amdgcn_rcpf(1.f + __expf(-x)); }
template <int CTRL> __device__ __forceinline__ float dppf(float x) { return __builtin_bit_cast(float, __builtin_amdgcn_mov_dpp(__builtin_bit_cast(int, x), CTRL, 0xf, 0xf, true)); }
__device__ __forceinline__ float allreduce16(float x) { x += dppf<0x128>(x); x += dppf<0x124>(x); x += dppf<0x4E>(x); x += dppf<0xB1>(x); return x; }

#define XB_TMO      128
#define XB_XCNT(j)  (256  + 64 * (j))
#define XB_XSUB(j)  (1280 + 64 * (j))
#define XB_XGEN(j)  (2304 + 64 * (j))
#define XB_TOP      3328
#define XB_TOPGEN   3392
#define XCD_BAR_WORDS 3456
#define XB_SPIN_CAP (1u << 18)
__device__ __forceinline__ unsigned xb_ld(unsigned* p)              { return __hip_atomic_load(p, __ATOMIC_RELAXED, __HIP_MEMORY_SCOPE_AGENT); }
__device__ __forceinline__ unsigned xb_add(unsigned* p, unsigned v) { return __hip_atomic_fetch_add(p, v, __ATOMIC_RELAXED, __HIP_MEMORY_SCOPE_AGENT); }
__device__ __forceinline__ unsigned xb_xcc_id() { return (unsigned)__builtin_amdgcn_s_getreg((3 << 11) | 20) & 0xFu; }
#define XB_SPIN(cond, bar) do { unsigned _sp = 0; while (cond) { __builtin_amdgcn_s_sleep(1); \
    if ((++_sp & 255u) == 0u) { if (xb_ld(&(bar)[XB_TMO])) break; if (_sp > XB_SPIN_CAP) { atomicAdd(&(bar)[XB_TMO], 1u); break; } } } } while (0)
struct XcdBarrier { unsigned* bar; unsigned x; volatile LAS unsigned* st; };
__device__ __forceinline__ XcdBarrier xcd_barrier_post(unsigned* bar, volatile LAS unsigned* st) {
    XcdBarrier b; b.bar = bar; b.x = xb_xcc_id(); b.st = st;
    if (threadIdx.x == 0) (void)xb_add(&bar[XB_XCNT(b.x)], 1u);
    return b;
}
__device__ __forceinline__ void xcd_barrier_complete(unsigned* bar, unsigned x, unsigned& nloc, unsigned& nx) {
    const unsigned G = gridDim.x * gridDim.y * gridDim.z;
    unsigned sum, cnt, mine, sp = 0u;
    for (;;) {
        sum = 0u; cnt = 0u; mine = 0u;
#pragma unroll
        for (unsigned j = 0; j < 16; ++j) { const unsigned c = xb_ld(&bar[XB_XCNT(j)]); sum += c; cnt += (c > 0u) ? 1u : 0u; mine = (j == x) ? c : mine; }
        if (sum == G) break;
        __builtin_amdgcn_s_sleep(1);
        if ((++sp & 255u) == 0u) { if (xb_ld(&bar[XB_TMO])) break; if (sp > XB_SPIN_CAP) { atomicAdd(&bar[XB_TMO], 1u); break; } }
    }
    nloc = mine > 0u ? mine : 1u; nx = cnt > 0u ? cnt : 1u;
}
__device__ __forceinline__ void xcd_barrier(const XcdBarrier& b) {
    asm volatile("s_waitcnt vmcnt(0)" ::: "memory");
    __syncthreads();
    if (threadIdx.x == 0) {
        unsigned* bar = b.bar;
        __builtin_amdgcn_s_waitcnt(0);
        unsigned nloc = b.st[0], nx = b.st[1];
        if (nloc == 0u) { xcd_barrier_complete(bar, b.x, nloc, nx); b.st[0] = nloc; b.st[1] = nx; }
        const unsigned old = xb_add(&bar[XB_XSUB(b.x)], 1u);
        const unsigned gen = old / nloc;
        if (old + 1u == (gen + 1u) * nloc) {
            __builtin_amdgcn_fence(__ATOMIC_RELEASE, "agent");
            asm volatile("s_waitcnt vmcnt(0)" ::: "memory");
            const unsigned og = xb_add(&bar[XB_TOP], 1u);
            const unsigned tg = og / nx;
            if (og + 1u == (tg + 1u) * nx) xb_add(&bar[XB_TOPGEN], 1u);
            else XB_SPIN(xb_ld(&bar[XB_TOPGEN]) == tg, bar);
            __builtin_amdgcn_fence(__ATOMIC_ACQUIRE, "agent");
            xb_add(&bar[XB_XGEN(b.x)], 1u);
            asm volatile("s_waitcnt vmcnt(0)" ::: "memory");
        } else {
            XB_SPIN(xb_ld(&bar[XB_XGEN(b.x)]) == gen, bar);
            __builtin_amdgcn_fence(__ATOMIC_ACQUIRE, "agent");
            asm volatile("s_waitcnt vmcnt(0)" ::: "memory");
        }
    }
    __syncthreads();
}

struct Args { const float* in[30]; float* out; unsigned char* ws; int ph_lo, ph_hi; };
enum { I_X = 0, I_N1W, I_WIN, I_BGATE, I_MU, I_W0, I_WUP, I_A0, I_AUP, I_GUP, I_KK, I_KA, I_RK, I_LNW, I_LNB, I_CONVW, I_IB, I_FB, I_MNW, I_WBA, I_WBB, I_WOUT, I_N2W, I_RTW, I_RTB, I_WGU, I_BGU, I_WDN, I_BDN, I_FNW };

struct Frame {
    LAS unsigned char* lds; volatile LAS unsigned* MISC; unsigned* ctl;
    int tid, lane, wave, G, bid;
    const float* const* in; float* out; unsigned char* ws;
};

using pg8::Unit; using pg8::HALF; using pg8::BM;
struct EpiBf16Plain {
    static constexpr bool PERM = true, AFTER_DRAIN = false;
    bf16* O; int ldc;
    __device__ __forceinline__ void operator()(const f32x4 (&acc)[2][2][4][2], const Unit& u, int wr, int wc, int fr, int fq) const {
        const int row0 = u.pm * BM + wr * 64 + fr, col0 = u.pn * BM + wc * 32 + 8 * fq;
#pragma unroll
        for (int ai = 0; ai < 2; ++ai)
#pragma unroll
            for (int m = 0; m < 4; ++m) { bf16* rowp = O + (size_t)(row0 + ai * HALF + m * 16) * ldc + col0;
#pragma unroll
                for (int bj = 0; bj < 2; ++bj) { const f32x4 v0 = acc[ai][bj][m][0], v1 = acc[ai][bj][m][1];
                    v4u w; w.x = pg8::cvt_pk_bf16(v0[0], v0[1]); w.y = pg8::cvt_pk_bf16(v0[2], v0[3]); w.z = pg8::cvt_pk_bf16(v1[0], v1[1]); w.w = pg8::cvt_pk_bf16(v1[2], v1[3]);
                    *(v4u*)(rowp + bj * HALF) = w; } }
    }
};
struct EpiLora {
    static constexpr bool PERM = false, AFTER_DRAIN = false;
    float* O; const float* w0; const float* a0;
    __device__ __forceinline__ void operator()(const f32x4 (&acc)[2][2][4][2], const Unit& u, int wr, int wc, int fr, int fq) const {
        const int row0 = u.pm * BM + wr * 64 + fr, col0 = u.pn * BM + wc * 32 + 4 * fq, seg = u.pn >> 2;
        f32x4 bv[2][2];
#pragma unroll
        for (int bj = 0; bj < 2; ++bj)
#pragma unroll
            for (int n = 0; n < 2; ++n) { const int c = col0 + bj * HALF + n * 16;
                bv[bj][n] = seg == 0 ? *(const f32x4*)(w0 + c) : (seg == 1 ? *(const f32x4*)(a0 + (c - 1024)) : (f32x4){0.f, 0.f, 0.f, 0.f}); }
#pragma unroll
        for (int ai = 0; ai < 2; ++ai)
#pragma unroll
            for (int m = 0; m < 4; ++m) { float* rowp = O + (size_t)(row0 + ai * HALF + m * 16) * 3072 + col0;
#pragma unroll
                for (int bj = 0; bj < 2; ++bj)
#pragma unroll
                    for (int n = 0; n < 2; ++n) { f32x4 v = acc[ai][bj][m][n] + bv[bj][n];
                        if (seg == 0) {
#pragma unroll
                            for (int j = 0; j < 4; ++j) v[j] = -0.6065306597126334f * sigm(v[j]); }
                        else if (seg == 1) {
#pragma unroll
                            for (int j = 0; j < 4; ++j) v[j] = sigm(v[j]); }
                        *(f32x4*)(rowp + bj * HALF + n * 16) = v; } }
    }
};
struct EpiGateA {
    static constexpr bool PERM = true, AFTER_DRAIN = false;
    float* TMP; const bf16* P; const float* bg;
    __device__ __forceinline__ void operator()(const f32x4 (&acc)[2][2][4][2], const Unit& u, int wr, int wc, int fr, int fq) const {
        const int row0 = u.pm * BM + wr * 64 + fr, col0 = u.pn * BM + wc * 32 + 8 * fq;
#pragma unroll
        for (int ai = 0; ai < 2; ++ai)
#pragma unroll
            for (int m = 0; m < 4; ++m) { const size_t r = (size_t)(row0 + ai * HALF + m * 16);
#pragma unroll
                for (int bj = 0; bj < 2; ++bj) { const int c = col0 + bj * HALF;
                    const v4u pg = *(const v4u*)(P + r * NINP + GTO + c); const f32x4 b0 = *(const f32x4*)(bg + c), b1 = *(const f32x4*)(bg + c + 4);
                    f32x4 g0, g1;
                    g0[0] = sigm(__uint_as_float(pg.x << 16) + b0[0]); g0[1] = sigm(__uint_as_float(pg.x & 0xffff0000u) + b0[1]);
                    g0[2] = sigm(__uint_as_float(pg.y << 16) + b0[2]); g0[3] = sigm(__uint_as_float(pg.y & 0xffff0000u) + b0[3]);
                    g1[0] = sigm(__uint_as_float(pg.z << 16) + b1[0]); g1[1] = sigm(__uint_as_float(pg.z & 0xffff0000u) + b1[1]);
                    g1[2] = sigm(__uint_as_float(pg.w << 16) + b1[2]); g1[3] = sigm(__uint_as_float(pg.w & 0xffff0000u) + b1[3]);
                    *(f32x4*)(TMP + r * D + c) = g0 * acc[ai][bj][m][0]; *(f32x4*)(TMP + r * D + c + 4) = g1 * acc[ai][bj][m][1]; } }
    }
};
struct EpiGateB {
    static constexpr bool PERM = true, AFTER_DRAIN = false;
    const float* TMP; bf16* MRG; const bf16* P; const float* bg;
    __device__ __forceinline__ void operator()(const f32x4 (&acc)[2][2][4][2], const Unit& u, int wr, int wc, int fr, int fq) const {
        const int row0 = u.pm * BM + wr * 64 + fr, col0 = u.pn * BM + wc * 32 + 8 * fq;
#pragma unroll
        for (int ai = 0; ai < 2; ++ai)
#pragma unroll
            for (int m = 0; m < 4; ++m) { const size_t r = (size_t)(row0 + ai * HALF + m * 16);
#pragma unroll
                for (int bj = 0; bj < 2; ++bj) { const int c = col0 + bj * HALF;
                    const v4u pg = *(const v4u*)(P + r * NINP + GTO + D + c); const f32x4 b0 = *(const f32x4*)(bg + D + c), b1 = *(const f32x4*)(bg + D + c + 4);
                    const f32x4 t0 = *(const f32x4*)(TMP + r * D + c), t1 = *(const f32x4*)(TMP + r * D + c + 4);
                    f32x4 g0, g1;
                    g0[0] = sigm(__uint_as_float(pg.x << 16) + b0[0]); g0[1] = sigm(__uint_as_float(pg.x & 0xffff0000u) + b0[1]);
                    g0[2] = sigm(__uint_as_float(pg.y << 16) + b0[2]); g0[3] = sigm(__uint_as_float(pg.y & 0xffff0000u) + b0[3]);
                    g1[0] = sigm(__uint_as_float(pg.z << 16) + b1[0]); g1[1] = sigm(__uint_as_float(pg.z & 0xffff0000u) + b1[1]);
                    g1[2] = sigm(__uint_as_float(pg.w << 16) + b1[2]); g1[3] = sigm(__uint_as_float(pg.w & 0xffff0000u) + b1[3]);
                    const f32x4 v0 = t0 + g0 * acc[ai][bj][m][0], v1 = t1 + g1 * acc[ai][bj][m][1];
                    v4u w; w.x = pg8::cvt_pk_bf16(v0[0], v0[1]); w.y = pg8::cvt_pk_bf16(v0[2], v0[3]); w.z = pg8::cvt_pk_bf16(v1[0], v1[1]); w.w = pg8::cvt_pk_bf16(v1[2], v1[3]);
                    *(v4u*)(MRG + r * D + c) = w; } }
    }
};
struct EpiResid {
    static constexpr bool PERM = false, AFTER_DRAIN = false;
    const float* X; float* O;
    __device__ __forceinline__ void operator()(const f32x4 (&acc)[2][2][4][2], const Unit& u, int wr, int wc, int fr, int fq) const {
        const int row0 = u.pm * BM + wr * 64 + fr, col0 = u.pn * BM + wc * 32 + 4 * fq;
#pragma unroll
        for (int ai = 0; ai < 2; ++ai)
#pragma unroll
            for (int m = 0; m < 4; ++m) { const size_t off = (size_t)(row0 + ai * HALF + m * 16) * D + col0;
#pragma unroll
                for (int bj = 0; bj < 2; ++bj)
#pragma unroll
                    for (int n = 0; n < 2; ++n) *(f32x4*)(O + off + bj * HALF + n * 16) = *(const f32x4*)(X + off + bj * HALF + n * 16) + acc[ai][bj][m][n]; }
    }
};
struct MoeOrder : pg8::StaticOrder {
    const LAS int* tile_e; size_t estride;
    __device__ __forceinline__ size_t b_off(const Unit& u, size_t tstep) const { return (size_t)tile_e[u.pm] * estride + (size_t)u.pn * tstep; }
};
struct MoeGatherOrder : MoeOrder {
    static constexpr bool GATHER = true;
    const LAS int* tile_i0; const LAS int* cnt; const int* rlist; LAS unsigned* rowoff; unsigned rowbytes;
    __device__ __forceinline__ size_t a_off(const Unit&, size_t) const { return 0; }
    __device__ __forceinline__ void fill_all() const { const int tid = threadIdx.x, r = tid & 255;
        for (int u0 = tid >> 8; ; u0 += 6) { Unit ua, ub, uc; const bool va = next(u0, ua), vb = next(u0 + 2, ub), vc = next(u0 + 4, uc); if (!va) break;
            int ta = 0, tb = 0, tc = 0;
            { const int e = tile_e[ua.pm], i = tile_i0[ua.pm] + r; if (i < cnt[e]) ta = rlist[e * ECAP + i]; }
            if (vb) { const int e = tile_e[ub.pm], i = tile_i0[ub.pm] + r; if (i < cnt[e]) tb = rlist[e * ECAP + i]; }
            if (vc) { const int e = tile_e[uc.pm], i = tile_i0[uc.pm] + r; if (i < cnt[e]) tc = rlist[e * ECAP + i]; }
            rowoff[u0 * 256 + r] = (unsigned)(ta >> 2) * rowbytes; if (vb) rowoff[(u0 + 2) * 256 + r] = (unsigned)(tb >> 2) * rowbytes; if (vc) rowoff[(u0 + 4) * 256 + r] = (unsigned)(tc >> 2) * rowbytes; } }
    __device__ __forceinline__ unsigned row_off(int ui, int r) const { return rowoff[ui * 256 + r]; }
};
struct EpiSwiGLU {
    static constexpr bool PERM = true, AFTER_DRAIN = false;
    unsigned char* ACT; const float* bgu; const LAS int* tile_e;
    __device__ __forceinline__ void operator()(const f32x4 (&acc)[2][2][4][2], const Unit& u, int wr, int wc, int fr, int fq) const {
        const int row0 = u.pm * BM + wr * 64 + fr, colg = u.pn * 128 + wc * 32 + 8 * fq; const int e = tile_e[u.pm];
        const float* bp = bgu + (size_t)e * 4096 + colg;
        const f32x4 bg0 = *(const f32x4*)(bp), bg1 = *(const f32x4*)(bp + 4), bu0 = *(const f32x4*)(bp + 2048), bu1 = *(const f32x4*)(bp + 2052);
#pragma unroll
        for (int ai = 0; ai < 2; ++ai)
#pragma unroll
            for (int m = 0; m < 4; ++m) { const size_t r = (size_t)(row0 + ai * HALF + m * 16);
                constexpr float DS = 1.f / (F8_SX * F8_SW);
                const f32x4 ga = acc[ai][0][m][0] * DS + bg0, gb = acc[ai][0][m][1] * DS + bg1, ua = acc[ai][1][m][0] * DS + bu0, ub = acc[ai][1][m][1] * DS + bu1;
                float o[8];
#pragma unroll
                for (int j = 0; j < 4; ++j) { const float g = fminf(ga[j], 7.f), up = fminf(fmaxf(ua[j], -7.f), 7.f); o[j] = F8_SA * (up + 1.f) * g * sigm(1.702f * g);
                                              const float g2 = fminf(gb[j], 7.f), up2 = fminf(fmaxf(ub[j], -7.f), 7.f); o[4 + j] = F8_SA * (up2 + 1.f) * g2 * sigm(1.702f * g2); }
                v2u w; w.x = pk4f8(o[0], o[1], o[2], o[3]); w.y = pk4f8(o[4], o[5], o[6], o[7]);
                *(v2u*)(ACT + r * FF + colg) = w; }
    }
};
struct EpiDown {
    static constexpr bool PERM = true, AFTER_DRAIN = false;
    bf16* YS; const float* bdn; const LAS int* tile_e; const LAS int* rowdst; const LAS float* rowwt;
    __device__ __forceinline__ void operator()(const f32x4 (&acc)[2][2][4][2], const Unit& u, int wr, int wc, int fr, int fq) const {
        const int e = tile_e[u.pm]; const int col0 = u.pn * BM + wc * 32 + 8 * fq;
        const float* bp = bdn + (size_t)e * D + col0; constexpr float DS = 1.f / (F8_SA * F8_SW);
#pragma unroll
        for (int bj = 0; bj < 2; ++bj) { const f32x4 b0 = *(const f32x4*)(bp + bj * HALF), b1 = *(const f32x4*)(bp + bj * HALF + 4);
#pragma unroll
            for (int ai = 0; ai < 2; ++ai)
#pragma unroll
                for (int m = 0; m < 4; ++m) { const int r = u.ord * 256 + ai * HALF + wr * 64 + m * 16 + fr;
                    const int dst = rowdst[r]; const float w = rowwt[r];
                    const f32x4 v0 = (acc[ai][bj][m][0] * DS + b0) * w, v1 = (acc[ai][bj][m][1] * DS + b1) * w;
                    v4u o; o.x = pg8::cvt_pk_bf16(v0[0], v0[1]); o.y = pg8::cvt_pk_bf16(v0[2], v0[3]); o.z = pg8::cvt_pk_bf16(v1[0], v1[1]); o.w = pg8::cvt_pk_bf16(v1[2], v1[3]);
                    *(v4u*)(YS + (size_t)dst * D + col0 + bj * HALF) = o; } }
    }
};
template <class Sched> __device__ __forceinline__ void fill_down_tables(Frame& F, const Sched& S, LAS int* rowdst, LAS float* rowwt) {
    const LAS int* MI = (const LAS int*)F.MISC; const int* rlist = (const int*)(F.ws + WS_RLIST); const float* rw = (const float*)(F.ws + WS_RW);
    const int r = F.tid & 255;
    for (int u0 = F.tid >> 8; ; u0 += 4) { Unit ua, ub; const bool va = S.next(u0, ua), vb = S.next(u0 + 2, ub); if (!va) break;
        int da = T * 4, db = T * 4; float wa = 0.f, wb = 0.f;
        { const int e = MI[MI_TILE_E + ua.pm], i = MI[MI_TILE_I0 + ua.pm] + r; if (i < MI[MI_CNT + e]) { da = rlist[e * ECAP + i]; wa = rw[e * ECAP + i]; } }
        if (vb) { const int e = MI[MI_TILE_E + ub.pm], i = MI[MI_TILE_I0 + ub.pm] + r; if (i < MI[MI_CNT + e]) { db = rlist[e * ECAP + i]; wb = rw[e * ECAP + i]; } }
        rowdst[u0 * 256 + r] = da; rowwt[u0 * 256 + r] = wa; if (vb) { rowdst[(u0 + 2) * 256 + r] = db; rowwt[(u0 + 2) * 256 + r] = wb; } }
    __syncthreads();
}

__device__ __forceinline__ void transpose_item(const float* __restrict__ W, int N, int k0, int n0, bf16* WT, int dst_row0, int ldk, LAS float* scr, int lane) {
    const int n = n0 + (lane & 31); const bool ok = n < N;
#pragma unroll 8
    for (int i = 0; i < 32; ++i) { const int kk = 2 * i + (lane >> 5); scr[kk * 33 + (lane & 31)] = ok ? W[(size_t)(k0 + kk) * N + n] : 0.f; }
    LDS_WAIT(); asm volatile("" ::: "memory");
    const int c = lane & 7;
#pragma unroll
    for (int j = 0; j < 4; ++j) { const int nn = (lane >> 3) + 8 * j; const LAS float* s = scr + (8 * c) * 33 + nn;
        v4u o; o.x = pk2(s[0 * 33], s[1 * 33]); o.y = pk2(s[2 * 33], s[3 * 33]); o.z = pk2(s[4 * 33], s[5 * 33]); o.w = pk2(s[6 * 33], s[7 * 33]);
        *(v4u*)(WT + (size_t)(dst_row0 + nn) * ldk + k0 + 8 * c) = o; }
    LDS_WAIT(); asm volatile("" ::: "memory");
}
__device__ __forceinline__ void transpose_item_f8(const float* __restrict__ W, int N, int k0, int n0, unsigned char* WT, int dst_row0, int ldk, LAS float* scr, int lane) {
#pragma unroll 8
    for (int i = 0; i < 32; ++i) { const int kk = 2 * i + (lane >> 5); scr[kk * 33 + (lane & 31)] = W[(size_t)(k0 + kk) * N + n0 + (lane & 31)] * F8_SW; }
    LDS_WAIT(); asm volatile("" ::: "memory");
#pragma unroll
    for (int j = 0; j < 2; ++j) { const int ch = lane + 64 * j, nn = ch >> 2, c = ch & 3; const LAS float* s = scr + (16 * c) * 33 + nn;
        v4u o; o.x = pk4f8(s[0 * 33], s[1 * 33], s[2 * 33], s[3 * 33]); o.y = pk4f8(s[4 * 33], s[5 * 33], s[6 * 33], s[7 * 33]);
        o.z = pk4f8(s[8 * 33], s[9 * 33], s[10 * 33], s[11 * 33]); o.w = pk4f8(s[12 * 33], s[13 * 33], s[14 * 33], s[15 * 33]);
        *(v4u*)(WT + (size_t)(dst_row0 + nn) * ldk + k0 + 16 * c) = o; }
    LDS_WAIT(); asm volatile("" ::: "memory");
}
__device__ __forceinline__ void p0_prologue(Frame& F) {
    LAS float* scr = (LAS float*)(F.lds + F.wave * 16384);
    const int gw = F.bid * NWAVES + F.wave, NGW = F.G * NWAVES;
    bf16* WIN_T = (bf16*)(F.ws + WS_WIN); bf16* WA_T = (bf16*)(F.ws + WS_WA); bf16* WB_T = (bf16*)(F.ws + WS_WB); bf16* WO_T = (bf16*)(F.ws + WS_WO);
    bf16* WGU_T = (bf16*)(F.ws + WS_WGU); bf16* WDN_T = (bf16*)(F.ws + WS_WDN); bf16* WL_T = (bf16*)(F.ws + WS_WL); bf16* HN = (bf16*)(F.ws + WS_HN);
    constexpr int NB_WIN = (NIN + 31) / 32;
    constexpr int I_WINc = 32 * NB_WIN, I_BR = 16 * 64, I_WO = 32 * 64, I_GU = NE * 32 * 128, I_DN = NE * 32 * 64;
    constexpr int NITEMS = I_WINc;
    for (int it = gw; it < NITEMS; it += NGW) {
        int r = it;
        { const int kb = r / NB_WIN, nb = r % NB_WIN; transpose_item(F.in[I_WIN], NIN, kb * 64, nb * 32, WIN_T, nb * 32, D, scr, F.lane); }
    }
    { const int gt = F.bid * NTHR + F.tid, NGT = F.G * NTHR; constexpr int Z0 = NB_WIN * 32 * D, Z1 = NINP * D;
      for (int i = Z0 + gt * 8; i < Z1; i += NGT * 8) *(v4u*)(WIN_T + i) = (v4u){0u, 0u, 0u, 0u}; }
    { const int gt = F.bid * NTHR + F.tid, NGT = F.G * NTHR;
      for (int i = gt; i < 3072 * 512; i += NGT) { const int n = i >> 9, k = i & 511; float v = 0.f;
          if (n < 1024) { if (k < 96) v = F.in[I_WUP][k * RD + n]; }
          else if (n < 2048) { if (k >= 128 && k < 224) v = F.in[I_AUP][(k - 128) * RD + (n - 1024)]; }
          else { if (k >= 256) v = F.in[I_GUP][(k - 256) * RD + (n - 2048)]; }
          WL_T[i] = (bf16)f2bf(v); } }
    { const int gt = F.bid * NTHR + F.tid, NGT = F.G * NTHR; float* RWS = (float*)(F.ws + WS_RWS);
      for (int i = gt; i < D * NE; i += NGT) RWS[i] = F.in[I_N2W][i >> 5] * F.in[I_RTW][i]; }
    const float* x = F.in[I_X]; const float* nw = F.in[I_N1W];
    for (int m = gw; m < T; m += NGW) {
        const f32x4* xr = (const f32x4*)(x + (size_t)m * D) + F.lane; f32x4 v[8]; float s = 0.f;
#pragma unroll
        for (int j = 0; j < 8; ++j) { v[j] = xr[64 * j]; s += (v[j][0] * v[j][0] + v[j][1] * v[j][1]) + (v[j][2] * v[j][2] + v[j][3] * v[j][3]); }
        const float rstd = __builtin_amdgcn_rsqf(wave_sum(s) * (1.f / D) + NORM_EPS);
        v2u* o8 = (v2u*)(HN + (size_t)m * D) + F.lane;
#pragma unroll
        for (int j = 0; j < 8; ++j) { const f32x4 w = ((const f32x4*)nw)[F.lane + 64 * j]; v2u o; o.x = pk2(v[j][0] * rstd * w[0], v[j][1] * rstd * w[1]); o.y = pk2(v[j][2] * rstd * w[2], v[j][3] * rstd * w[3]); o8[64 * j] = o; }
    }
}

__device__ __forceinline__ void p2_lora_in(Frame& F) {
    const bf16* __restrict__ P = (const bf16*)(F.ws + WS_P); bf16* __restrict__ LIN = (bf16*)(F.ws + WS_LIN); const float* __restrict__ mu = F.in[I_MU];
    const int gt = F.bid * NTHR + F.tid, NGT = F.G * NTHR;
#pragma unroll 2
    for (int i = gt; i < T * 64; i += NGT) { const int t = i >> 6, g = i & 63; int col = -1, kind = 0;
        if (g < 12) { col = 3072 + 8 * g; kind = 0; } else if (g >= 16 && g < 28) { col = 3168 + 8 * (g - 16); kind = 1; } else if (g >= 32) { col = 3264 + 8 * (g - 32); kind = 2; }
        v4u o = (v4u){0u, 0u, 0u, 0u};
        if (col >= 0) { const v4u pc = *(const v4u*)(P + (size_t)t * NINP + col); v4u pp = (v4u){0u, 0u, 0u, 0u}; if (t & (SEQ - 1)) pp = *(const v4u*)(P + (size_t)(t - 1) * NINP + col);
            const f32x4 m0 = *(const f32x4*)(mu + col), m1 = *(const f32x4*)(mu + col + 4);
            const unsigned pcs[4] = {pc.x, pc.y, pc.z, pc.w}, pps[4] = {pp.x, pp.y, pp.z, pp.w}; float x[8];
#pragma unroll
            for (int k = 0; k < 4; ++k) { const float c0 = __uint_as_float(pcs[k] << 16), c1 = __uint_as_float(pcs[k] & 0xffff0000u), q0 = __uint_as_float(pps[k] << 16), q1 = __uint_as_float(pps[k] & 0xffff0000u);
                const float ma = k < 2 ? m0[2 * k] : m1[2 * k - 4], mb = k < 2 ? m0[2 * k + 1] : m1[2 * k - 3];
                x[2 * k] = c0 + (q0 - c0) * ma; x[2 * k + 1] = c1 + (q1 - c1) * mb; }
#pragma unroll
            for (int k = 0; k < 8; ++k) x[k] = kind == 0 ? tanhf(x[k]) : (kind == 1 ? x[k] : sigm(x[k]));
            o.x = pk2(x[0], x[1]); o.y = pk2(x[2], x[3]); o.z = pk2(x[4], x[5]); o.w = pk2(x[6], x[7]); }
        *(v4u*)(LIN + (size_t)t * 512 + 8 * g) = o; }
    { bf16* __restrict__ QKC = (bf16*)(F.ws + WS_QKC); const float* __restrict__ cw = F.in[I_CONVW];
      for (int i = gt; i < T * 128; i += NGT) { const int t = i >> 7, c0 = 8 * (i & 127); const int sq = t & (SEQ - 1); float acc[8];
#pragma unroll
          for (int k = 0; k < 8; ++k) acc[k] = 0.f;
#pragma unroll
          for (int j = 0; j < 4; ++j) { if (sq - 3 + j >= 0) { const v4u pv = *(const v4u*)(P + (size_t)(t - 3 + j) * NINP + MLO + c0); const f32x4 w0 = *(const f32x4*)(cw + j * 1024 + c0), w1 = *(const f32x4*)(cw + j * 1024 + c0 + 4);
                  acc[0] += __uint_as_float(pv.x << 16) * w0[0]; acc[1] += __uint_as_float(pv.x & 0xffff0000u) * w0[1]; acc[2] += __uint_as_float(pv.y << 16) * w0[2]; acc[3] += __uint_as_float(pv.y & 0xffff0000u) * w0[3];
                  acc[4] += __uint_as_float(pv.z << 16) * w1[0]; acc[5] += __uint_as_float(pv.z & 0xffff0000u) * w1[1]; acc[6] += __uint_as_float(pv.w << 16) * w1[2]; acc[7] += __uint_as_float(pv.w & 0xffff0000u) * w1[3]; } }
          const float sc = c0 < 512 ? 0.08838834764831845f : 1.f;
#pragma unroll
          for (int k = 0; k < 8; ++k) acc[k] = acc[k] * sigm(acc[k]) * sc;
          v4u o; o.x = pk2(acc[0], acc[1]); o.y = pk2(acc[2], acc[3]); o.z = pk2(acc[4], acc[5]); o.w = pk2(acc[6], acc[7]); *(v4u*)(QKC + (size_t)t * 1024 + c0) = o; } }
    { float* __restrict__ GLF = (float*)(F.ws + WS_GLF); const int gw = F.bid * NWAVES + F.wave, NGW = F.G * NWAVES, lane = F.lane;
      for (int q = gw; q < (T / 64) * 4; q += NGW) { const int chk = q >> 2, mh = q & 3; const size_t t = (size_t)chk * 64 + lane; const bf16* pr = P + t * NINP + MLO + 2048;
          const float ip = 15.f * tanhf((bf2f(pr[mh]) + F.in[I_IB][mh]) * (1.f / 15.f)), fp = 15.f * tanhf((bf2f(pr[4 + mh]) + F.in[I_FB][mh]) * (1.f / 15.f));
          float bc = fminf(fp, 0.f) - log1pf(__expf(-fabsf(fp)));
#pragma unroll
          for (int o = 1; o < 64; o <<= 1) { const float t_ = __shfl_up(bc, o); if (lane >= o) bc += t_; }
          const float u = ip - bc; float pm = u;
#pragma unroll
          for (int o = 1; o < 64; o <<= 1) { const float t_ = __shfl_up(pm, o); if (lane >= o) pm = fmaxf(pm, t_); }
          *(f32x4*)(GLF + t * 16 + 4 * mh) = (f32x4){bc, u, pm, 0.f}; } }
}

typedef short s16x8 __attribute__((ext_vector_type(8)));
typedef short s16x4 __attribute__((ext_vector_type(4)));
__device__ __forceinline__ unsigned long long pack4bf(f32x4 v) { return (unsigned long long)pk2(v[0], v[1]) | ((unsigned long long)pk2(v[2], v[3]) << 32); }
__device__ __forceinline__ s16x8 tr_frag(const LAS bf16* img, int stride, int r0, int c0, int fr) {
    const LAS bf16* p0 = img + (r0 + (fr >> 2)) * stride + c0 + 4 * (fr & 3);
    const s16x4 lo = __builtin_bit_cast(s16x4, __builtin_amdgcn_ds_read_tr16_b64_v4i16((LAS s16x4*)p0));
    const s16x4 hi = __builtin_bit_cast(s16x4, __builtin_amdgcn_ds_read_tr16_b64_v4i16((LAS s16x4*)(p0 + 4 * stride)));
    return __builtin_shufflevector(lo, hi, 0, 1, 2, 3, 4, 5, 6, 7);
}

__device__ __forceinline__ void rw_bar(LAS unsigned* cnt, unsigned& target, int lane);
__device__ __forceinline__ void rwkv_chunk_unit(Frame& F, int unit, LAS unsigned char* regB, LAS unsigned* bcnt, unsigned& btarget) {
    const int b = unit >> 5, h = (unit >> 1) & 15, half = unit & 1;
    const bf16* P = (const bf16*)(F.ws + WS_P); const float* WAG = (const float*)(F.ws + WS_WAG); float* YRAW = (float*)(F.ws + WS_YRAW);
    constexpr int KS = 72, LS = 40;
    LAS bf16* At = (LAS bf16*)F.lds; LAS bf16* Bt = At + 32 * KS; LAS bf16* Kt = Bt + 32 * KS; LAS bf16* Rt = Kt + 32 * KS;
    LAS bf16* Vv = Rt + 32 * KS;
    LAS bf16* Sb = Vv + 32 * LS;
    LAS bf16* G2b = Sb + 32 * KS; LAS bf16* G3b = G2b + 32 * LS; LAS bf16* G4b = G3b + 32 * LS;
    LAS bf16* Pwb = G4b + 32 * LS;
    LAS bf16* Acb = Pwb + 2 * 32 * LS;
    LAS bf16* RHt = (LAS bf16*)regB;
    LAS bf16* Ubt = RHt + 32 * LS;
    LAS float* lwf = (LAS float*)(Ubt + 32 * LS);
    LAS float* csf = lwf + 2048;
    LAS float* gtf = csf + 2048;
    LAS float* glf = gtf + 256;
    const int tid = F.tid, lane = F.lane, w = F.wave, fr = lane & 15, fq = lane >> 4;
    const int ts = tid >> 4, cs = tid & 15, c0 = h * 64 + 4 * cs;
    const int sk = tid & 63, sq = tid >> 6;
    const f32x4 mu_r = *(const f32x4*)(F.in[I_MU] + c0), mu_k = *(const f32x4*)(F.in[I_MU] + 1024 + c0), mu_v = *(const f32x4*)(F.in[I_MU] + 2048 + c0);
    const f32x4 kkc = *(const f32x4*)(F.in[I_KK] + c0), kac = *(const f32x4*)(F.in[I_KA] + c0);
    for (int i = tid; i < 32 * KS; i += 256) Sb[i] = 0;
    v2u cr[2], ck[2], cv[2], qr[2], qk[2], qv[2]; f32x4 w4[2], a4[2];
#define RC_LOAD(ch) do { _Pragma("unroll") for (int p_ = 0; p_ < 2; ++p_) { const int t_ = (ch) * 32 + ts + 16 * p_; const size_t tk_ = (size_t)b * SEQ + t_; const bf16* pr_ = P + tk_ * NINP + c0; \
        cr[p_] = *(const v2u*)(pr_); ck[p_] = *(const v2u*)(pr_ + 1024); cv[p_] = *(const v2u*)(pr_ + 2048); \
        if (t_ > 0) { qr[p_] = *(const v2u*)(pr_ - NINP); qk[p_] = *(const v2u*)(pr_ - NINP + 1024); qv[p_] = *(const v2u*)(pr_ - NINP + 2048); } else { qr[p_] = (v2u){0u, 0u}; qk[p_] = qr[p_]; qv[p_] = qr[p_]; } \
        w4[p_] = *(const f32x4*)(WAG + tk_ * 3072 + c0); a4[p_] = *(const f32x4*)(WAG + tk_ * 3072 + 1024 + c0); } } while (0)
    const int mi = w >> 1, nj = w & 1;
    f32x4 st[2]; st[0] = (f32x4){0.f, 0.f, 0.f, 0.f}; st[1] = st[0];
    RC_LOAD(0);
    rw_bar(bcnt, btarget, lane);
    for (int ch = 0; ch < SEQ / 32; ++ch) {
        f32x4 rr[2], kmod[2], vv[2], kkn[2], lw[2], al[2];
#pragma unroll
        for (int p_ = 0; p_ < 2; ++p_) { const f32x4 pr4 = UNP4(cr[p_]), pk4 = UNP4(ck[p_]), pv4 = UNP4(cv[p_]), qr4 = UNP4(qr[p_]), qk4 = UNP4(qk[p_]), qv4 = UNP4(qv[p_]); lw[p_] = w4[p_]; al[p_] = a4[p_];
            rr[p_] = pr4 + (qr4 - pr4) * mu_r; const f32x4 k1 = pk4 + (qk4 - pk4) * mu_k; vv[p_] = pv4 + (qv4 - pv4) * mu_v;
            const f32x4 kkr = k1 * kkc; const float nrm = __builtin_amdgcn_rsqf(fmaxf(allreduce16((kkr[0] * kkr[0] + kkr[1] * kkr[1]) + (kkr[2] * kkr[2] + kkr[3] * kkr[3])), 1e-24f));
            kkn[p_] = kkr * nrm; kmod[p_] = k1 * (1.f + (al[p_] - 1.f) * kac);
            *(LAS f32x4*)(lwf + (ts + 16 * p_) * 64 + 4 * cs) = lw[p_]; }
        if (ch + 1 < SEQ / 32) RC_LOAD(ch + 1);
        rw_bar(bcnt, btarget, lane);
        float cc[8];
#pragma unroll
        for (int i = 0; i < 8; ++i) cc[i] = lwf[(8 * sq + i) * 64 + sk] + (i ? cc[i - 1] : 0.f);
        gtf[sq * 64 + sk] = cc[7];
        rw_bar(bcnt, btarget, lane);
        { float off = 0.f;
#pragma unroll
          for (int q = 0; q < 3; ++q) off += (q < sq) ? gtf[q * 64 + sk] : 0.f;
#pragma unroll
          for (int i = 0; i < 8; ++i) csf[(8 * sq + i) * 64 + sk] = off + cc[i]; }
        rw_bar(bcnt, btarget, lane);
#pragma unroll
        for (int p_ = 0; p_ < 2; ++p_) { const int t = ts + 16 * p_; const f32x4 cg = *(const LAS f32x4*)(csf + t * 64 + 4 * cs); f32x4 g, gp, gi;
#pragma unroll
          for (int j = 0; j < 4; ++j) { g[j] = __expf(cg[j]); gp[j] = __expf(cg[j] - lw[p_][j]); gi[j] = __expf(-cg[j]); }
          *(LAS unsigned long long*)(At + t * KS + 4 * cs) = pack4bf(-(kkn[p_] * gp)); *(LAS unsigned long long*)(Bt + t * KS + 4 * cs) = pack4bf(kkn[p_] * al[p_] * gi);
          *(LAS unsigned long long*)(Kt + t * KS + 4 * cs) = pack4bf(kmod[p_] * gi); *(LAS unsigned long long*)(Rt + t * KS + 4 * cs) = pack4bf(rr[p_] * g);
          if ((cs >> 3) == half) *(LAS unsigned long long*)(Vv + t * LS + 4 * (cs & 7)) = pack4bf(vv[p_]);
          if (t == 31) *(LAS f32x4*)(glf + 4 * cs) = g; }
        rw_bar(bcnt, btarget, lane);
        f32x4 accT, pwT;
        { const int t = 16 * mi + fr, jb = 16 * nj + 4 * fq;
          f32x4 g1 = (f32x4){0.f, 0.f, 0.f, 0.f}, g2 = g1, g3 = g1, g4 = g1;
#pragma unroll
          for (int ks = 0; ks < 2; ++ks) { const s16x8 bj = *(const LAS s16x8*)(Bt + (16 * nj + fr) * KS + 32 * ks + 8 * fq), kj = *(const LAS s16x8*)(Kt + (16 * nj + fr) * KS + 32 * ks + 8 * fq);
              const s16x8 at = *(const LAS s16x8*)(At + (16 * mi + fr) * KS + 32 * ks + 8 * fq), rt = *(const LAS s16x8*)(Rt + (16 * mi + fr) * KS + 32 * ks + 8 * fq);
              g1 = __builtin_amdgcn_mfma_f32_16x16x32_bf16(bj, at, g1, 0, 0, 0); g2 = __builtin_amdgcn_mfma_f32_16x16x32_bf16(kj, at, g2, 0, 0, 0);
              g3 = __builtin_amdgcn_mfma_f32_16x16x32_bf16(bj, rt, g3, 0, 0, 0); g4 = __builtin_amdgcn_mfma_f32_16x16x32_bf16(kj, rt, g4, 0, 0, 0); }
#pragma unroll
          for (int rg_ = 0; rg_ < 4; ++rg_) { const int j = jb + rg_; g1[rg_] = (j < t) ? g1[rg_] : 0.f; g2[rg_] = (j < t) ? g2[rg_] : 0.f; g3[rg_] = (j <= t) ? g3[rg_] : 0.f; g4[rg_] = (j <= t) ? g4[rg_] : 0.f; }
          pwT = g1; *(LAS unsigned long long*)(Pwb + t * LS + jb) = pack4bf(g1);
#pragma unroll
          for (int rg_ = 0; rg_ < 4; ++rg_) accT[rg_] = g1[rg_] + ((jb + rg_ == t) ? 1.f : 0.f);
          *(LAS unsigned long long*)(Acb + 32 * LS + t * LS + jb) = pack4bf(accT);
          *(LAS unsigned long long*)(G2b + t * LS + jb) = pack4bf(g2); *(LAS unsigned long long*)(G3b + t * LS + jb) = pack4bf(g3); *(LAS unsigned long long*)(G4b + t * LS + jb) = pack4bf(g4); }
        rw_bar(bcnt, btarget, lane);
        f32x4 yv = (f32x4){0.f, 0.f, 0.f, 0.f};
#pragma unroll
        for (int s = 0; s < 5; ++s) { const LAS bf16* Pr = Pwb + (s & 1) * 32 * LS; LAS bf16* Pn = Pwb + ((s + 1) & 1) * 32 * LS; const LAS bf16* Ar = Acb + (s & 1) * 32 * LS; LAS bf16* An = Acb + ((s + 1) & 1) * 32 * LS;
            const s16x8 xrow = *(const LAS s16x8*)(Pr + (16 * mi + fr) * LS + 8 * fq);
            if (s < 4) { f32x4 z = (f32x4){0.f, 0.f, 0.f, 0.f}; z = __builtin_amdgcn_mfma_f32_16x16x32_bf16(tr_frag(Pr, LS, 8 * fq, 16 * nj, fr), xrow, z, 0, 0, 0);
                         *(LAS unsigned long long*)(Pn + (16 * mi + fr) * LS + 16 * nj + 4 * fq) = pack4bf(z); }
            if (s >= 1) { accT = __builtin_amdgcn_mfma_f32_16x16x32_bf16(tr_frag(Ar, LS, 8 * fq, 16 * nj, fr), xrow, accT, 0, 0, 0);
                          *(LAS unsigned long long*)(An + (16 * mi + fr) * LS + 16 * nj + 4 * fq) = pack4bf(accT); }
            if (s == 0) {
                f32x4 z = (f32x4){0.f, 0.f, 0.f, 0.f};
#pragma unroll
                for (int ks = 0; ks < 2; ++ks) { const s16x8 sb = *(const LAS s16x8*)(Sb + (16 * nj + fr) * KS + 32 * ks + 8 * fq);
                    z = __builtin_amdgcn_mfma_f32_16x16x32_bf16(*(const LAS s16x8*)(At + (16 * mi + fr) * KS + 32 * ks + 8 * fq), sb, z, 0, 0, 0);
                    yv = __builtin_amdgcn_mfma_f32_16x16x32_bf16(*(const LAS s16x8*)(Rt + (16 * mi + fr) * KS + 32 * ks + 8 * fq), sb, yv, 0, 0, 0); }
                const s16x8 vt_ = tr_frag(Vv, LS, 8 * fq, 16 * nj, fr);
                z = __builtin_amdgcn_mfma_f32_16x16x32_bf16(*(const LAS s16x8*)(G2b + (16 * mi + fr) * LS + 8 * fq), vt_, z, 0, 0, 0);
                yv = __builtin_amdgcn_mfma_f32_16x16x32_bf16(*(const LAS s16x8*)(G4b + (16 * mi + fr) * LS + 8 * fq), vt_, yv, 0, 0, 0);
                *(LAS unsigned long long*)(RHt + (16 * nj + fr) * LS + 16 * mi + 4 * fq) = pack4bf(z); }
            rw_bar(bcnt, btarget, lane); }
        { f32x4 z = (f32x4){0.f, 0.f, 0.f, 0.f};
          z = __builtin_amdgcn_mfma_f32_16x16x32_bf16(*(const LAS s16x8*)(Acb + 32 * LS + (16 * mi + fr) * LS + 8 * fq), *(const LAS s16x8*)(RHt + (16 * nj + fr) * LS + 8 * fq), z, 0, 0, 0);
          *(LAS unsigned long long*)(Ubt + (16 * nj + fr) * LS + 16 * mi + 4 * fq) = pack4bf(z); }
        rw_bar(bcnt, btarget, lane);
        { yv = __builtin_amdgcn_mfma_f32_16x16x32_bf16(*(const LAS s16x8*)(G3b + (16 * mi + fr) * LS + 8 * fq), *(const LAS s16x8*)(Ubt + (16 * nj + fr) * LS + 8 * fq), yv, 0, 0, 0);
          float* yp = YRAW + ((size_t)b * SEQ + ch * 32 + 16 * mi + 4 * fq) * RD + h * 64 + half * 32 + 16 * nj + fr;
#pragma unroll
          for (int rg_ = 0; rg_ < 4; ++rg_) yp[(size_t)rg_ * RD] = yv[rg_]; }
        { const int kt = w; const s16x8 bt_ = tr_frag(Bt, KS, 8 * fq, 16 * kt, fr), kt_ = tr_frag(Kt, KS, 8 * fq, 16 * kt, fr); const f32x4 gl4 = *(const LAS f32x4*)(glf + 16 * kt + 4 * fq);
#pragma unroll
          for (int vt = 0; vt < 2; ++vt) {
              st[vt] = __builtin_amdgcn_mfma_f32_16x16x32_bf16(bt_, *(const LAS s16x8*)(Ubt + (16 * vt + fr) * LS + 8 * fq), st[vt], 0, 0, 0);
              st[vt] = __builtin_amdgcn_mfma_f32_16x16x32_bf16(kt_, tr_frag(Vv, LS, 8 * fq, 16 * vt, fr), st[vt], 0, 0, 0);
              st[vt] = st[vt] * gl4;
              *(LAS unsigned long long*)(Sb + (16 * vt + fr) * KS + 16 * kt + 4 * fq) = pack4bf(st[vt]); } }
        rw_bar(bcnt, btarget, lane);
    }
#undef RC_LOAD
}

__device__ __forceinline__ float allreduce8(float x) { x += dppf<0x141>(x); x += dppf<0xB1>(x); x += dppf<0x4E>(x); return x; }
__device__ __forceinline__ void rw_bar(LAS unsigned* cnt, unsigned& target, int lane) {
    asm volatile("s_waitcnt lgkmcnt(0)" ::: "memory");
    if (lane == 0) __hip_atomic_fetch_add(cnt, 1u, __ATOMIC_RELAXED, __HIP_MEMORY_SCOPE_WORKGROUP);
    target += 4u;
    while ((unsigned)__builtin_amdgcn_readfirstlane((int)__hip_atomic_load(cnt, __ATOMIC_RELAXED, __HIP_MEMORY_SCOPE_WORKGROUP)) < target) __builtin_amdgcn_s_sleep(1);
    asm volatile("" ::: "memory");
}
__device__ __forceinline__ void rwkv_scan_unit(Frame& F, int unit, LAS unsigned* bcnt, unsigned& btarget) {
    const int b = unit >> 5, h = (unit >> 1) & 15, half = unit & 1;
    const bf16* P = (const bf16*)(F.ws + WS_P); const float* WAG = (const float*)(F.ws + WS_WAG); float* YRAW = (float*)(F.ws + WS_YRAW);
    LAS float* base = (LAS float*)F.lds;
    constexpr int BUF = 5 * 2048 + 1024;
    LAS float* sYb = base + 2 * BUF;
    const int tid = F.tid, lane = F.lane, r = tid >> 3, s = tid & 7, ts = tid >> 4, cs = tid & 15;
    const int c0 = h * 64 + 4 * cs;
    const f32x4 mu_r = *(const f32x4*)(F.in[I_MU] + c0), mu_k = *(const f32x4*)(F.in[I_MU] + 1024 + c0), mu_v = *(const f32x4*)(F.in[I_MU] + 2048 + c0);
    const f32x4 kkc = *(const f32x4*)(F.in[I_KK] + c0), kac = *(const f32x4*)(F.in[I_KA] + c0);
    v2u cr[2], ck[2], cv[2], qr[2], qk[2], qv[2]; f32x4 w4[2], a4[2];
#define RW_LOAD(ch) do { _Pragma("unroll") for (int p_ = 0; p_ < 2; ++p_) { const int t_ = (ch) * 32 + ts + 16 * p_; const size_t tk_ = (size_t)b * SEQ + t_; const bf16* pr_ = P + tk_ * NINP + c0; \
        cr[p_] = *(const v2u*)(pr_); ck[p_] = *(const v2u*)(pr_ + 1024); cv[p_] = *(const v2u*)(pr_ + 2048); \
        if (t_ > 0) { qr[p_] = *(const v2u*)(pr_ - NINP); qk[p_] = *(const v2u*)(pr_ - NINP + 1024); qv[p_] = *(const v2u*)(pr_ - NINP + 2048); } else { qr[p_] = (v2u){0u, 0u}; qk[p_] = qr[p_]; qv[p_] = qr[p_]; } \
        w4[p_] = *(const f32x4*)(WAG + tk_ * 3072 + c0); a4[p_] = *(const f32x4*)(WAG + tk_ * 3072 + 1024 + c0); } } while (0)
#define RW_XFORM(bufp) do { LAS float* bp_ = (bufp); _Pragma("unroll") for (int p_ = 0; p_ < 2; ++p_) { const int row_ = ts + 16 * p_; \
        const f32x4 pr4 = UNP4(cr[p_]), pk4 = UNP4(ck[p_]), pv4 = UNP4(cv[p_]), qr4 = UNP4(qr[p_]), qk4 = UNP4(qk[p_]), qv4 = UNP4(qv[p_]); \
        const f32x4 rr = pr4 + (qr4 - pr4) * mu_r, k1 = pk4 + (qk4 - pk4) * mu_k, vv = pv4 + (qv4 - pv4) * mu_v; \
        const f32x4 kkr = k1 * kkc; const float nrm = __builtin_amdgcn_rsqf(fmaxf(allreduce16((kkr[0] * kkr[0] + kkr[1] * kkr[1]) + (kkr[2] * kkr[2] + kkr[3] * kkr[3])), 1e-24f));     \
        const f32x4 kkn = kkr * nrm; \
        *(LAS f32x4*)(bp_ + row_ * 64 + 4 * cs) = rr; *(LAS f32x4*)(bp_ + 2048 + row_ * 64 + 4 * cs) = w4[p_]; *(LAS f32x4*)(bp_ + 4096 + row_ * 64 + 4 * cs) = k1 * (1.f + (a4[p_] - 1.f) * kac); \
        *(LAS f32x4*)(bp_ + 6144 + row_ * 64 + 4 * cs) = -kkn; *(LAS f32x4*)(bp_ + 8192 + row_ * 64 + 4 * cs) = kkn * a4[p_]; \
        if ((cs >> 3) == half) *(LAS f32x4*)(bp_ + 10240 + row_ * 32 + 4 * (cs & 7)) = vv; } } while (0)
#define RW_RD(dst, arr, tt_) do { dst[0] = *(const LAS f32x4*)(bp + (arr) * 2048 + (tt_) * 64 + 8 * s); dst[1] = *(const LAS f32x4*)(bp + (arr) * 2048 + (tt_) * 64 + 8 * s + 4); } while (0)
    f32x4 S[2]; S[0] = (f32x4){0.f, 0.f, 0.f, 0.f}; S[1] = S[0];
    RW_LOAD(0); RW_XFORM(base);
    rw_bar(bcnt, btarget, lane);
    for (int ch = 0; ch < SEQ / 32; ++ch) {
        const LAS float* bp = base + (ch & 1) * BUF; LAS float* sY = sYb + (ch & 1) * 1024;
        if (ch + 1 < SEQ / 32) RW_LOAD(ch + 1);
        f32x4 R4[2], W4[2], K4[2], N4[2], B4[2]; RW_RD(R4, 0, 0); RW_RD(W4, 1, 0); RW_RD(K4, 2, 0); RW_RD(N4, 3, 0); RW_RD(B4, 4, 0); float v = bp[10240 + r];
        float ykeep = 0.f;
#pragma unroll 8
        for (int tt = 0; tt < 32; ++tt) {
            const int tn = (tt + 1) & 31;
            f32x4 R4n[2], W4n[2], K4n[2], N4n[2], B4n[2]; RW_RD(R4n, 0, tn); RW_RD(W4n, 1, tn); RW_RD(K4n, 2, tn); RW_RD(N4n, 3, tn); RW_RD(B4n, 4, tn); const float vn = bp[10240 + tn * 32 + r];
            const f32x4 p0 = S[0] * N4[0], p1 = S[1] * N4[1];
            const float sa = allreduce8(((p0[0] + p0[1]) + (p0[2] + p0[3])) + ((p1[0] + p1[1]) + (p1[2] + p1[3])));
            S[0] = S[0] * W4[0] + (sa * B4[0] + v * K4[0]); S[1] = S[1] * W4[1] + (sa * B4[1] + v * K4[1]);
            const f32x4 y0 = S[0] * R4[0], y1 = S[1] * R4[1];
            const float y = allreduce8(((y0[0] + y0[1]) + (y0[2] + y0[3])) + ((y1[0] + y1[1]) + (y1[2] + y1[3])));
            ykeep = (s == (tt & 7)) ? y : ykeep;
            if ((tt & 7) == 7) sY[((tt & 24) + s) * 32 + r] = ykeep;
#pragma unroll
            for (int q_ = 0; q_ < 2; ++q_) { R4[q_] = R4n[q_]; W4[q_] = W4n[q_]; K4[q_] = K4n[q_]; N4[q_] = N4n[q_]; B4[q_] = B4n[q_]; } v = vn;
        }
        if (ch + 1 < SEQ / 32) RW_XFORM(base + ((ch + 1) & 1) * BUF);
        rw_bar(bcnt, btarget, lane);
        for (int i = tid; i < 1024; i += 256) { const int tt = i >> 5, rr2 = i & 31; YRAW[((size_t)b * SEQ + ch * 32 + tt) * RD + h * 64 + half * 32 + rr2] = sY[i]; }
    }
    rw_bar(bcnt, btarget, lane);
#undef RW_LOAD
#undef RW_XFORM
#undef RW_RD
}
constexpr int CV_BR = 8 * 32, CV_WO = 16 * 32, CV_GU = NE * 16 * 64, CV_DN = NE * 16 * 32, CV_ITEMS = 2 * CV_BR + CV_WO + CV_GU + CV_DN;
struct CvItem { const float* src; unsigned char* dst; int N; int f8; };
__device__ __forceinline__ CvItem cv_decode(Frame& F, int it) {
    CvItem c; int r = it; const int lane = F.lane;
    if (r < CV_BR) { const int kb = r >> 5, nb = r & 31; c.src = F.in[I_WBA] + (size_t)(kb * 128) * D + nb * 64 + lane; c.dst = F.ws + WS_WA + ((size_t)(nb * 64 + lane) * RD + kb * 128) * 2; c.N = D; c.f8 = 0; return c; } r -= CV_BR;
    if (r < CV_BR) { const int kb = r >> 5, nb = r & 31; c.src = F.in[I_WBB] + (size_t)(kb * 128) * D + nb * 64 + lane; c.dst = F.ws + WS_WB + ((size_t)(nb * 64 + lane) * RD + kb * 128) * 2; c.N = D; c.f8 = 0; return c; } r -= CV_BR;
    if (r < CV_WO) { const int kb = r >> 5, nb = r & 31; c.src = F.in[I_WOUT] + (size_t)(kb * 128) * D + nb * 64 + lane; c.dst = F.ws + WS_WO + ((size_t)(nb * 64 + lane) * D + kb * 128) * 2; c.N = D; c.f8 = 0; return c; } r -= CV_WO;
    if (r < CV_GU) { const int e = r >> 10, q = r & 1023, kb = q >> 6, nb = q & 63, n0 = nb * 64;
        const int dr = n0 < FF ? ((n0 >> 7) * 256 + (n0 & 127)) : (((n0 - FF) >> 7) * 256 + 128 + ((n0 - FF) & 127));
        c.src = F.in[I_WGU] + (size_t)e * D * 2 * FF + (size_t)(kb * 128) * (2 * FF) + n0 + lane; c.dst = F.ws + WS_WGU + (size_t)e * 2 * FF * D + (size_t)(dr + lane) * D + kb * 128; c.N = 2 * FF; c.f8 = 1; return c; } r -= CV_GU;
    { const int e = r >> 9, q = r & 511, kb = q >> 5, nb = q & 31;
        c.src = F.in[I_WDN] + (size_t)e * FF * D + (size_t)(kb * 128) * D + nb * 64 + lane; c.dst = F.ws + WS_WDN + (size_t)e * D * FF + (size_t)(nb * 64 + lane) * FF + kb * 128; c.N = D; c.f8 = 1; }
    return c;
}
__device__ __forceinline__ int cv_claim(Frame& F, LAS unsigned* next, int lo) { unsigned i = 0; if (F.lane == 0) i = __hip_atomic_fetch_add(next, 1u, __ATOMIC_RELAXED, __HIP_MEMORY_SCOPE_WORKGROUP);
    return lo + (int)(unsigned)__builtin_amdgcn_readfirstlane((int)i); }
__device__ __forceinline__ void convert_item(Frame& F, int it);
__device__ __forceinline__ void convert_loop(Frame& F, unsigned* next, unsigned* p1done, unsigned ngemm) {
    for (;;) { unsigned b = 0xffffffffu;
        if (F.lane == 0) { if (!(p1done && __hip_atomic_load(p1done, __ATOMIC_RELAXED, __HIP_MEMORY_SCOPE_AGENT) >= ngemm)) b = __hip_atomic_fetch_add(next, 2u, __ATOMIC_RELAXED, __HIP_MEMORY_SCOPE_AGENT); }
        const unsigned base = (unsigned)__builtin_amdgcn_readfirstlane((int)b); if (base >= (unsigned)CV_ITEMS) break;
        for (int k = 0; k < 2; ++k) { const int it = (int)base + k; if (it < CV_ITEMS) convert_item(F, it); } }
}
__device__ __forceinline__ void convert_item(Frame& F, int i0) {
    { const CvItem c = cv_decode(F, i0);
        float x[128];
#pragma unroll
        for (int i = 0; i < 128; ++i) x[i] = c.src[(size_t)i * c.N];
        if (c.f8) {
#pragma unroll
            for (int q = 0; q < 8; ++q) { v4u o; o.x = pk4f8(x[16 * q + 0] * F8_SW, x[16 * q + 1] * F8_SW, x[16 * q + 2] * F8_SW, x[16 * q + 3] * F8_SW); o.y = pk4f8(x[16 * q + 4] * F8_SW, x[16 * q + 5] * F8_SW, x[16 * q + 6] * F8_SW, x[16 * q + 7] * F8_SW);
                o.z = pk4f8(x[16 * q + 8] * F8_SW, x[16 * q + 9] * F8_SW, x[16 * q + 10] * F8_SW, x[16 * q + 11] * F8_SW); o.w = pk4f8(x[16 * q + 12] * F8_SW, x[16 * q + 13] * F8_SW, x[16 * q + 14] * F8_SW, x[16 * q + 15] * F8_SW);
                *(v4u*)(c.dst + 16 * q) = o; } }
        else {
#pragma unroll
            for (int q = 0; q < 16; ++q) { v4u o; o.x = pk2(x[8 * q + 0], x[8 * q + 1]); o.y = pk2(x[8 * q + 2], x[8 * q + 3]); o.z = pk2(x[8 * q + 4], x[8 * q + 5]); o.w = pk2(x[8 * q + 6], x[8 * q + 7]);
                *(v4u*)(c.dst + 16 * q) = o; } } }
}

__device__ __forceinline__ void mlstm_scan_unit(Frame& F, int unit, LAS unsigned* bcnt, unsigned& btarget) {
    const int b = unit >> 5, mh = (unit >> 3) & 3, sl = unit & 7;
    const bf16* P = (const bf16*)(F.ws + WS_P); const bf16* QKC = (const bf16*)(F.ws + WS_QKC); const float* GLF = (const float*)(F.ws + WS_GLF); float* HRAW = (float*)(F.ws + WS_HRAW);
    constexpr int VS = 56;
    LAS bf16* Lq = (LAS bf16*)F.lds;
    LAS bf16* Lk = Lq + 64 * 136;
    LAS bf16* Lv = Lk + 64 * 136;
    LAS bf16* Lvs = Lv + 64 * VS;
    LAS bf16* LcT = Lvs + 64 * VS;
    LAS bf16* Ls = LcT + 2 * 48 * 136;
    LAS float* sb = (LAS float*)(Ls + 64 * 72); LAS float* su = sb + 64; LAS float* smx = su + 64; LAS float* swk = smx + 64;
    const int tid = F.tid, lane = F.lane, w = F.wave, fr = lane & 15, fq = lane >> 4;
    for (int i = tid; i < 2 * 48 * 136; i += 256) LcT[i] = 0;
    for (int i = tid; i < 64 * 16; i += 256) { const int j = i >> 4, c = 32 + (i & 15); Lv[j * VS + c] = (c == 32) ? (bf16)0x3F80 : (bf16)0; Lvs[j * VS + c] = 0; }
    const int pr0 = tid >> 4, pc = 8 * (tid & 15);
    v4u rq[4], rk[4], rv; f32x4 g3;
#define ML_LOAD(ch) do { const size_t tk0_ = (size_t)b * SEQ + (ch) * 64; \
        _Pragma("unroll") for (int i_ = 0; i_ < 4; ++i_) { const bf16* s_ = QKC + (tk0_ + pr0 + 16 * i_) * 1024 + mh * 128 + pc; rq[i_] = *(const v4u*)s_; rk[i_] = *(const v4u*)(s_ + 512); } \
        rv = *(const v4u*)(P + (tk0_ + (tid >> 2)) * NINP + MLO + 1024 + mh * 256 + sl * 32 + 8 * (tid & 3)); \
        g3 = *(const f32x4*)(GLF + (tk0_ + lane) * 16 + 4 * mh); } while (0)
    f32x4 st[2][3];
#pragma unroll
    for (int a = 0; a < 2; ++a)
#pragma unroll
        for (int n = 0; n < 3; ++n) st[a][n] = (f32x4){0.f, 0.f, 0.f, 0.f};
    float mstate = 0.f;
    ML_LOAD(0);
    rw_bar(bcnt, btarget, lane);
    for (int ch = 0; ch < SEQ / 64; ++ch) {
        const size_t tk0 = (size_t)b * SEQ + ch * 64;
        LAS bf16* cTc = LcT + (ch & 1) * 48 * 136; LAS bf16* cTn = LcT + ((ch + 1) & 1) * 48 * 136;
        float mnew, dec;
        { const float bc = g3[0], u = g3[1], pm = g3[2];
          const float gtot = __shfl(bc, 63), pmall = __shfl(pm, 63);
          mnew = gtot + fmaxf(mstate, pmall); dec = __expf(gtot + mstate - mnew);
          const float wk = __expf(u + gtot - mnew);
          sb[lane] = bc; su[lane] = u; smx[lane] = fmaxf(mstate, pm); swk[lane] = wk;
          if (w == 0) Lvs[lane * VS + 32] = (bf16)f2bf(wk); }
#pragma unroll
        for (int i = 0; i < 4; ++i) { *(LAS v4u*)(Lq + (pr0 + 16 * i) * 136 + pc) = rq[i]; *(LAS v4u*)(Lk + (pr0 + 16 * i) * 136 + pc) = rk[i]; }
        LDS_WAIT();
        { const int j = tid >> 2, d0 = 8 * (tid & 3); const float wkj = swk[j]; *(LAS v4u*)(Lv + j * VS + d0) = rv;
          const unsigned uu[4] = {rv.x, rv.y, rv.z, rv.w}; v4u sv;
          sv.x = pk2(wkj * __uint_as_float(uu[0] << 16), wkj * __uint_as_float(uu[0] & 0xffff0000u)); sv.y = pk2(wkj * __uint_as_float(uu[1] << 16), wkj * __uint_as_float(uu[1] & 0xffff0000u));
          sv.z = pk2(wkj * __uint_as_float(uu[2] << 16), wkj * __uint_as_float(uu[2] & 0xffff0000u)); sv.w = pk2(wkj * __uint_as_float(uu[3] << 16), wkj * __uint_as_float(uu[3] & 0xffff0000u));
          *(LAS v4u*)(Lvs + j * VS + d0) = sv; }
        if (ch + 1 < SEQ / 64) ML_LOAD(ch + 1);
        rw_bar(bcnt, btarget, lane);
        { const int tt = w; const int t = 16 * tt + fr; const float mxt = smx[t];
#pragma unroll
          for (int jt = 0; jt < 4; ++jt) { f32x4 acc = (f32x4){0.f, 0.f, 0.f, 0.f};
              if (jt <= tt) {
#pragma unroll
                  for (int ks = 0; ks < 4; ++ks) { const s16x8 a = *(const LAS s16x8*)(Lk + (16 * jt + fr) * 136 + 32 * ks + 8 * fq), bq = *(const LAS s16x8*)(Lq + (16 * tt + fr) * 136 + 32 * ks + 8 * fq);
                      acc = __builtin_amdgcn_mfma_f32_16x16x32_bf16(a, bq, acc, 0, 0, 0); }
                  const f32x4 u4 = *(const LAS f32x4*)(su + 16 * jt + 4 * fq);
#pragma unroll
                  for (int rg_ = 0; rg_ < 4; ++rg_) { const int j = 16 * jt + 4 * fq + rg_; acc[rg_] = (j <= t) ? acc[rg_] * __expf(u4[rg_] - mxt) : 0.f; } }
              *(LAS unsigned long long*)(Ls + t * 72 + 16 * jt + 4 * fq) = pack4bf(acc); } }
        rw_bar(bcnt, btarget, lane);
        { const int mi = w; f32x4 a1[3], a2[3];
#pragma unroll
          for (int n = 0; n < 3; ++n) { a1[n] = (f32x4){0.f, 0.f, 0.f, 0.f}; a2[n] = a1[n]; }
#pragma unroll
          for (int ks = 0; ks < 2; ++ks) { const s16x8 A = *(const LAS s16x8*)(Ls + (16 * mi + fr) * 72 + 32 * ks + 8 * fq);
#pragma unroll
              for (int n = 0; n < 3; ++n) a1[n] = __builtin_amdgcn_mfma_f32_16x16x32_bf16(A, tr_frag(Lv, VS, 32 * ks + 8 * fq, 16 * n, fr), a1[n], 0, 0, 0); }
#pragma unroll
          for (int ks = 0; ks < 4; ++ks) { const s16x8 A = *(const LAS s16x8*)(Lq + (16 * mi + fr) * 136 + 32 * ks + 8 * fq);
#pragma unroll
              for (int n = 0; n < 3; ++n) a2[n] = __builtin_amdgcn_mfma_f32_16x16x32_bf16(A, *(const LAS s16x8*)(cTc + (16 * n + fr) * 136 + 32 * ks + 8 * fq), a2[n], 0, 0, 0); }
          const f32x4 mx4 = *(const LAS f32x4*)(smx + 16 * mi + 4 * fq), b4 = *(const LAS f32x4*)(sb + 16 * mi + 4 * fq);
#pragma unroll
          for (int rg_ = 0; rg_ < 4; ++rg_) { const float wi = __expf(mstate - mx4[rg_]); float den = a1[2][rg_] + wi * a2[2][rg_]; den = __shfl(den, lane & 48);
              const float mt = b4[rg_] + mx4[rg_]; const float inv = __builtin_amdgcn_rcpf(fmaxf(fabsf(den), __expf(-mt))); float* hp = HRAW + (tk0 + 16 * mi + 4 * fq + rg_) * RD + mh * 256 + sl * 32 + fr;
              hp[0] = (a1[0][rg_] + wi * a2[0][rg_]) * inv; hp[16] = (a1[1][rg_] + wi * a2[1][rg_]) * inv; } }
        {
#pragma unroll
          for (int a = 0; a < 2; ++a) {
#pragma unroll
              for (int n = 0; n < 3; ++n) st[a][n] = st[a][n] * dec;
#pragma unroll
              for (int ks = 0; ks < 2; ++ks) { const s16x8 A = tr_frag(Lk, 136, 32 * ks + 8 * fq, 16 * (2 * w + a), fr);
#pragma unroll
                  for (int n = 0; n < 3; ++n) st[a][n] = __builtin_amdgcn_mfma_f32_16x16x32_bf16(A, tr_frag(Lvs, VS, 32 * ks + 8 * fq, 16 * n, fr), st[a][n], 0, 0, 0); }
#pragma unroll
              for (int n = 0; n < 3; ++n) *(LAS unsigned long long*)(cTn + (16 * n + fr) * 136 + 16 * (2 * w + a) + 4 * fq) = pack4bf(st[a][n]); } }
        mstate = mnew;
        rw_bar(bcnt, btarget, lane);
    }
#undef ML_LOAD
}

__device__ __forceinline__ float rowsum4(f32x4 v) { return (v[0] + v[1]) + (v[2] + v[3]); }
__device__ __forceinline__ void p5_finalize(Frame& F) {
    const bf16* __restrict__ P = (const bf16*)(F.ws + WS_P); const float* __restrict__ WAG = (const float*)(F.ws + WS_WAG); const float* __restrict__ YRAW = (const float*)(F.ws + WS_YRAW); const float* __restrict__ HRAW = (const float*)(F.ws + WS_HRAW);
    bf16* __restrict__ OA = (bf16*)(F.ws + WS_OA); bf16* __restrict__ OB = (bf16*)(F.ws + WS_OB);
    const int gw = F.bid * NWAVES + F.wave, NGW = F.G * NWAVES, lane = F.lane;
    { const int hq = gw & 3, c0 = (hq * 4 + (lane >> 4)) * 64 + 4 * (lane & 15);
      const f32x4 mu_r = *(const f32x4*)(F.in[I_MU] + c0), mu_k = *(const f32x4*)(F.in[I_MU] + 1024 + c0), mu_v = *(const f32x4*)(F.in[I_MU] + 2048 + c0);
      const f32x4 kac = *(const f32x4*)(F.in[I_KA] + c0), rkc = *(const f32x4*)(F.in[I_RK] + c0), lnw = *(const f32x4*)(F.in[I_LNW] + c0), lnb = *(const f32x4*)(F.in[I_LNB] + c0);
      v2u cr, ck, cv, qr, qk, qv; f32x4 a4, g4, y4;
#define P5_LOAD(q_) do { const int tk_ = (q_) >> 2; const bf16* pr_ = P + (size_t)tk_ * NINP + c0; cr = *(const v2u*)(pr_); ck = *(const v2u*)(pr_ + 1024); cv = *(const v2u*)(pr_ + 2048); \
          if (tk_ & (SEQ - 1)) { qr = *(const v2u*)(pr_ - NINP); qk = *(const v2u*)(pr_ - NINP + 1024); qv = *(const v2u*)(pr_ - NINP + 2048); } else { qr = (v2u){0u, 0u}; qk = qr; qv = qr; } \
          a4 = *(const f32x4*)(WAG + (size_t)tk_ * 3072 + 1024 + c0); g4 = *(const f32x4*)(WAG + (size_t)tk_ * 3072 + 2048 + c0); y4 = *(const f32x4*)(YRAW + (size_t)tk_ * RD + c0); } while (0)
      if (gw < T * 4) P5_LOAD(gw);
      for (int q = gw; q < T * 4; q += NGW) { const int tk = q >> 2;
          const f32x4 pr4 = UNP4(cr), pk4 = UNP4(ck), pv4 = UNP4(cv), qr4 = UNP4(qr), qk4 = UNP4(qk), qv4 = UNP4(qv); const f32x4 a = a4, g = g4, y = y4;
          if (q + NGW < T * 4) P5_LOAD(q + NGW);
          const f32x4 rr = pr4 + (qr4 - pr4) * mu_r, k1 = pk4 + (qk4 - pk4) * mu_k, vv = pv4 + (qv4 - pv4) * mu_v;
          const f32x4 kmod = k1 * (1.f + (a - 1.f) * kac);
          const float dot = allreduce16(rowsum4(rr * kmod * rkc)); const float mean = allreduce16(rowsum4(y)) * (1.f / 64.f); const f32x4 dl = y - mean;
          const float var = allreduce16(rowsum4(dl * dl)) * (1.f / 64.f); const float rs = __builtin_amdgcn_rsqf(var + GN_EPS);
          const f32x4 o = (dl * rs * lnw + lnb + dot * vv) * g;
          v2u ov; ov.x = pk2(o[0], o[1]); ov.y = pk2(o[2], o[3]); *(v2u*)(OA + (size_t)tk * RD + c0) = ov; }
#undef P5_LOAD
    }
    { const int mh = gw & 3, d0 = mh * 256 + 4 * lane; const f32x4 nw = *(const f32x4*)(F.in[I_MNW] + d0);
      f32x4 hv; v2u po;
#define P5B_LOAD(q_) do { const int tk_ = (q_) >> 2; hv = *(const f32x4*)(HRAW + (size_t)tk_ * RD + d0); po = *(const v2u*)(P + (size_t)tk_ * NINP + MLO + 2056 + d0); } while (0)
      if (gw < T * 4) P5B_LOAD(gw);
      for (int q = gw; q < T * 4; q += NGW) { const int tk = q >> 2; const f32x4 h4 = hv; const v2u p2 = po;
          if (q + NGW < T * 4) P5B_LOAD(q + NGW);
          float ss = allreduce16(rowsum4(h4 * h4)); ss += __shfl_xor(ss, 16); ss += __shfl_xor(ss, 32);
          const float rs = __builtin_amdgcn_rsqf(ss * (1.f / 256.f) + NORM_EPS); const f32x4 og = UNP4(p2);
          const float o0 = h4[0] * rs * nw[0] * sigm(og[0]), o1 = h4[1] * rs * nw[1] * sigm(og[1]), o2 = h4[2] * rs * nw[2] * sigm(og[2]), o3 = h4[3] * rs * nw[3] * sigm(og[3]);
          v2u o; o.x = pk2(o0, o1); o.y = pk2(o2, o3); *(v2u*)(OB + (size_t)tk * RD + d0) = o; }
#undef P5B_LOAD
    }
}

typedef float f32x16 __attribute__((ext_vector_type(16)));
__device__ __forceinline__ void p8_route(Frame& F) {
    const float* X1 = (const float*)(F.ws + WS_X1); unsigned char* H2 = (unsigned char*)(F.ws + WS_HN); int* RLIST = (int*)(F.ws + WS_RLIST); float* RWT = (float*)(F.ws + WS_RW);
    const float* RWS = (const float*)(F.ws + WS_RWS); const float* nw = F.in[I_N2W]; const float* rtb = F.in[I_RTB];
    LAS float* part = (LAS float*)F.lds;
    LAS float* ssq = part + 8 * 32 * 33;
    LAS float* lgt = ssq + 256;
    LAS float* srs = lgt + 32 * 33;
    const int lane = F.lane, w = F.wave, i = lane & 31, h = lane >> 5, tid = F.tid;
    for (int tile = F.bid; tile < T / 32; tile += F.G) {
        const int m0 = tile * 32; const float* xrow = X1 + (size_t)(m0 + i) * D + 256 * w + 4 * h;
        f32x16 acc;
#pragma unroll
        for (int r_ = 0; r_ < 16; ++r_) acc[r_] = 0.f;
        float ss = 0.f; const float* bp = RWS + (size_t)(256 * w + 4 * h) * NE + i;
#pragma unroll 4
        for (int q = 0; q < 32; ++q) { const f32x4 xa = *(const f32x4*)(xrow + 8 * q);
#pragma unroll
            for (int j = 0; j < 4; ++j) acc = __builtin_amdgcn_mfma_f32_32x32x2f32(xa[j], bp[(8 * q + j) * NE], acc, 0, 0, 0);
            ss += (xa[0] * xa[0] + xa[1] * xa[1]) + (xa[2] * xa[2] + xa[3] * xa[3]); }
        ss += __shfl_xor(ss, 32);
        if (h == 0) ssq[w * 32 + i] = ss;
#pragma unroll
        for (int r_ = 0; r_ < 16; ++r_) part[(w * 32 + (r_ & 3) + 8 * (r_ >> 2) + 4 * h) * 33 + i] = acc[r_];
        __syncthreads();
#pragma unroll
        for (int k2 = 0; k2 < 2; ++k2) { const int idx = tid + NTHR * k2, ii = idx >> 5, e = idx & 31; float sm = 0.f, sq = 0.f;
#pragma unroll
            for (int ww = 0; ww < 8; ++ww) { sm += part[(ww * 32 + ii) * 33 + e]; sq += ssq[ww * 32 + ii]; }
            const float rs = 1.f / sqrtf(sq * (1.f / D) + NORM_EPS); lgt[ii * 33 + e] = sm * rs + rtb[e]; if (e == 0) srs[ii] = rs; }
        __syncthreads();
        { const float rs = srs[i] * F8_SX; unsigned char* orow = H2 + (size_t)(m0 + i) * D + 256 * w + 4 * h;
#pragma unroll 8
          for (int q = 0; q < 32; ++q) { const f32x4 n4 = *(const f32x4*)(nw + 256 * w + 4 * h + 8 * q); const f32x4 hv = *(const f32x4*)(xrow + 8 * q) * rs * n4; *(unsigned*)(orow + 8 * q) = pk4f8(hv[0], hv[1], hv[2], hv[3]); } }
        if (tid < 32) { const LAS float* lr = lgt + tid * 33; unsigned used = 0u; int idx[4]; float val[4];
#pragma unroll
            for (int s4 = 0; s4 < 4; ++s4) { float best = -INFINITY; int bi = 0;
                for (int e = 0; e < 32; ++e) { const float v = lr[e]; const bool ok = !((used >> e) & 1u) && (v > best); best = ok ? v : best; bi = ok ? e : bi; }
                used |= 1u << bi; idx[s4] = bi; val[s4] = best; }
            const float e1 = __expf(val[1] - val[0]), e2 = __expf(val[2] - val[0]), e3 = __expf(val[3] - val[0]); const float inv = 1.f / (1.f + e1 + e2 + e3);
            const float wv[4] = {inv, e1 * inv, e2 * inv, e3 * inv};
#pragma unroll
            for (int s4 = 0; s4 < 4; ++s4) { const unsigned pos = atomicAdd(F.ctl + CW_CNT + 64 * idx[s4], 1u); RLIST[idx[s4] * ECAP + pos] = (m0 + tid) * 4 + s4; RWT[idx[s4] * ECAP + pos] = wv[s4]; } }
        __syncthreads();
    }
}

__device__ __forceinline__ void build_moe_tables(Frame& F) {
    LAS int* MI = (LAS int*)F.MISC;
    __syncthreads();
    if (F.tid == 0) { int mt = 0, cs = 0;
        for (int e = 0; e < NE; ++e) { const int c = (int)__hip_atomic_load(F.ctl + CW_CNT + 64 * e, __ATOMIC_RELAXED, __HIP_MEMORY_SCOPE_AGENT); MI[MI_CNT + e] = c; MI[MI_POFF + e] = mt * 256; MI[MI_CST + e] = cs; cs += c;
            const int nt = (c + 255) >> 8; for (int i = 0; i < nt; ++i) { MI[MI_TILE_E + mt + i] = e; MI[MI_TILE_I0 + mt + i] = i * 256; } mt += nt; }
        MI[MI_CST + NE] = cs; MI[MI_MT] = mt; }
    __syncthreads();
}
__device__ __forceinline__ void p9_gather(Frame& F) {
    build_moe_tables(F);
    const LAS int* MI = (const LAS int*)F.MISC; const bf16* H2 = (const bf16*)(F.ws + WS_HN); bf16* XB = (bf16*)(F.ws + WS_XB); const int* RLIST = (const int*)(F.ws + WS_RLIST);
    const int gw = F.bid * NWAVES + F.wave, NGW = F.G * NWAVES, total = MI[MI_CST + NE];
    for (int q = gw; q < total; q += NGW) { int e = 0;
        for (int k = 1; k < NE; ++k) e = (MI[MI_CST + k] <= q) ? k : e;
        const int i = q - MI[MI_CST + e]; const int tok = RLIST[e * ECAP + i] >> 2;
        const v4u* src = (const v4u*)(H2 + (size_t)tok * D) + F.lane; v4u* dst = (v4u*)(XB + (size_t)(MI[MI_POFF + e] + i) * D) + F.lane;
#pragma unroll
        for (int j = 0; j < 4; ++j) dst[64 * j] = src[64 * j]; }
}
__device__ __forceinline__ void p12_final(Frame& F) {
    const float* X1 = (const float*)(F.ws + WS_X1); const bf16* YS = (const bf16*)(F.ws + WS_YS); const float* fw = F.in[I_FNW];
    const int gw = F.bid * NWAVES + F.wave, NGW = F.G * NWAVES;
    for (int m = gw; m < T; m += NGW) {
        const f32x4* xr = (const f32x4*)(X1 + (size_t)m * D) + F.lane; f32x4 v[8]; float s = 0.f;
#pragma unroll
        for (int j = 0; j < 8; ++j) { v[j] = xr[64 * j];
#pragma unroll
            for (int sl = 0; sl < 4; ++sl) { const v2u y = ((const v2u*)(YS + ((size_t)m * 4 + sl) * D))[F.lane + 64 * j];
                v[j][0] += __uint_as_float(y.x << 16); v[j][1] += __uint_as_float(y.x & 0xffff0000u); v[j][2] += __uint_as_float(y.y << 16); v[j][3] += __uint_as_float(y.y & 0xffff0000u); }
            s += (v[j][0] * v[j][0] + v[j][1] * v[j][1]) + (v[j][2] * v[j][2] + v[j][3] * v[j][3]); }
        const float rstd = __builtin_amdgcn_rsqf(wave_sum(s) * (1.f / D) + NORM_EPS);
        f32x4* orow = (f32x4*)(F.out + (size_t)m * D) + F.lane;
#pragma unroll
        for (int j = 0; j < 8; ++j) { const f32x4 w = ((const f32x4*)fw)[F.lane + 64 * j]; orow[64 * j] = v[j] * rstd * w; }
    }
}

__global__ void __launch_bounds__(NTHR, 2) mk_fwd(Args args) {
    extern __shared__ __attribute__((aligned(16))) unsigned char lds[];
    Frame F;
    F.lds = (LAS unsigned char*)lds; F.MISC = (volatile LAS unsigned*)(F.lds + MISC_OFF);
    F.tid = threadIdx.x; F.lane = F.tid & 63; F.wave = __builtin_amdgcn_readfirstlane(F.tid >> 6); F.G = gridDim.x; F.bid = blockIdx.x;
    F.in = args.in; F.out = args.out; F.ws = args.ws; F.ctl = (unsigned*)(args.ws + WS_CTL);
    for (int u = F.tid; u < (LDS_BYTES - MISC_OFF) / 4; u += NTHR) ((LAS unsigned*)(F.lds + MISC_OFF))[u] = 0u;
    __syncthreads();
    XcdBarrier bar; bar.bar = F.ctl + CW_BAR; bar.x = 0; bar.st = nullptr;
    if (MK_N_LAUNCHES == 1) bar = xcd_barrier_post(F.ctl + CW_BAR, F.MISC + 8);
    const int lo = args.ph_lo, hi = args.ph_hi;
#define IN(k) (lo <= (k) && (k) < hi)
#ifndef PROBE_PHASE
#define PROBE_PHASE -1
#endif
#define REP(k) ((PROBE_PHASE) == (k) ? 2 : 1)
#define SEAM(k) do { if (IN(k) && IN((k) + 1)) xcd_barrier(bar); } while (0)
    LAS unsigned char* ring = F.lds;
    const LAS int* MI = (const LAS int*)F.MISC;

    if (IN(0)) { for (int rep = 0; rep < REP(0); ++rep) p0_prologue(F); } SEAM(0);
    if (IN(1)) {
        const int ng = F.G > 2 * NCV ? F.G - NCV : F.G;
        if (F.bid < ng) {
            pg8::Gemm g{(const bf16*)(F.ws + WS_HN), (const bf16*)(F.ws + WS_WIN), T, NINP, D}; pg8::StaticOrder S; S.init(T, NINP, ng, F.bid);
            EpiBf16Plain E{(bf16*)(F.ws + WS_P), NINP};
            pg8::gemm_phase<EpiBf16Plain, pg8::StaticOrder, true, true>(ring, g, S, E);
            if (F.tid == 0) __hip_atomic_fetch_add(F.ctl + CW_P1DONE, 1u, __ATOMIC_RELAXED, __HIP_MEMORY_SCOPE_AGENT);
        } else convert_loop(F, F.ctl + CW_CVNEXT, F.ctl + CW_P1DONE, (unsigned)ng);
    } SEAM(1);
    if (IN(2)) { for (int rep = 0; rep < REP(2); ++rep) p2_lora_in(F); } SEAM(2);
    if (IN(3)) {
        pg8::Gemm g{(const bf16*)(F.ws + WS_LIN), (const bf16*)(F.ws + WS_WL), T, 3072, 512}; pg8::StaticOrder S; S.init(T, 3072, F.G, F.bid);
        EpiLora E{(float*)(F.ws + WS_WAG), F.in[I_W0], F.in[I_A0]};
        pg8::gemm_phase<EpiLora, pg8::StaticOrder, true, true>(ring, g, S, E);
    } SEAM(3);
    if (IN(4)) {
        { LAS unsigned* ctl2 = (LAS unsigned*)F.MISC + 16;
          if (F.wave < 4) { unsigned bt = 0u; for (int rep = 0; rep < REP(40); ++rep) for (int u = F.bid; u < 256; u += F.G) rwkv_chunk_unit(F, u, (LAS unsigned char*)F.MISC + 256, ctl2, bt); }
          else { Frame F2 = F; F2.tid = F.tid - 256; F2.wave = F.wave - 4; F2.lds = F.lds + 45056; unsigned bt = 0u;
                 for (int rep = 0; rep < REP(41); ++rep) for (int u = F.bid; u < 256; u += F.G) mlstm_scan_unit(F2, u, ctl2 + 2, bt); }
          convert_loop(F, F.ctl + CW_CVNEXT, nullptr, 0u);
          __syncthreads(); }
    } SEAM(4);
    if (IN(5)) { for (int rep = 0; rep < REP(5); ++rep) p5_finalize(F); } SEAM(5);
    if (IN(6)) {
        { pg8::Gemm g{(const bf16*)(F.ws + WS_OA), (const bf16*)(F.ws + WS_WA), T, D, RD}; pg8::StaticOrder S; S.init(T, D, F.G, F.bid);
          EpiGateA E{(float*)(F.ws + WS_TMP), (const bf16*)(F.ws + WS_P), F.in[I_BGATE]};
          pg8::gemm_phase<EpiGateA, pg8::StaticOrder, true, true>(ring, g, S, E); }
        VM_WAIT(); __syncthreads();
        { pg8::Gemm g{(const bf16*)(F.ws + WS_OB), (const bf16*)(F.ws + WS_WB), T, D, RD}; pg8::StaticOrder S; S.init(T, D, F.G, F.bid);
          EpiGateB E{(const float*)(F.ws + WS_TMP), (bf16*)(F.ws + WS_MRG), (const bf16*)(F.ws + WS_P), F.in[I_BGATE]};
          pg8::gemm_phase<EpiGateB, pg8::StaticOrder, true, true>(ring, g, S, E); }
    } SEAM(6);
    if (IN(7)) {
        pg8::Gemm g{(const bf16*)(F.ws + WS_MRG), (const bf16*)(F.ws + WS_WO), T, D, D}; pg8::StaticOrder S; S.init(T, D, F.G, F.bid);
        EpiResid E{F.in[I_X], (float*)(F.ws + WS_X1)};
        pg8::gemm_phase<EpiResid, pg8::StaticOrder, true, true>(ring, g, S, E);
    } SEAM(7);
    if (IN(8)) { p8_route(F); } SEAM(8);
    if (IN(10)) {
        build_moe_tables(F);
        const int mt = MI[MI_MT];
        pg8::Gemm g{(const bf16*)(F.ws + WS_HN), (const bf16*)(F.ws + WS_WGU), mt * 256, 2 * FF, D / 2};
        MoeGatherOrder S; S.init(mt * 256, 2 * FF, F.G, F.bid); S.tile_e = MI + MI_TILE_E; S.estride = (size_t)2 * FF * D;
        S.tile_i0 = MI + MI_TILE_I0; S.cnt = MI + MI_CNT; S.rlist = (const int*)(F.ws + WS_RLIST); S.rowoff = (LAS unsigned*)F.MISC + MI_ROWOFF; S.rowbytes = D;
        EpiSwiGLU E{(unsigned char*)(F.ws + WS_ACT), F.in[I_BGU], MI + MI_TILE_E};
        pg8::gemm_phase<EpiSwiGLU, MoeGatherOrder, true, true, true>(ring, g, S, E);
    } SEAM(10);
    if (IN(11)) {
        build_moe_tables(F);
        const int mt = MI[MI_MT];
        pg8::Gemm g{(const bf16*)(F.ws + WS_ACT), (const bf16*)(F.ws + WS_WDN), mt * 256, D, FF / 2};
        MoeOrder S; S.init(mt * 256, D, F.G, F.bid); S.tile_e = MI + MI_TILE_E; S.estride = (size_t)D * FF;
        LAS int* rowdst = (LAS int*)F.MISC + MI_ROWOFF; LAS float* rowwt = (LAS float*)F.MISC + MI_ROWOFF + 10 * 256;
        fill_down_tables(F, S, rowdst, rowwt);
        EpiDown E{(bf16*)(F.ws + WS_YS), F.in[I_BDN], MI + MI_TILE_E, rowdst, rowwt};
        pg8::gemm_phase<EpiDown, MoeOrder, true, true, true>(ring, g, S, E);
    } SEAM(11);
    if (IN(12)) { for (int rep = 0; rep < REP(12); ++rep) p12_final(F); }
#undef IN
#undef SEAM
}

extern "C" void kernel_launch(void* const* d_in, const int* in_sizes, int n_in, void* d_out, int out_size, void* d_ws, size_t ws_size, hipStream_t stream) {
    static int grid = 0;
    if (grid == 0) {
        if (n_in != 30 || out_size != T * D || ws_size < WS_END) { fprintf(stderr, "kernel_launch: unexpected problem (n_in %d, out %d, ws %zu)\n", n_in, out_size, ws_size); grid = -1; return; }
        int dev = 0, cus = 0, per_cu = 0;
        if (hipGetDevice(&dev) != hipSuccess || hipDeviceGetAttribute(&cus, hipDeviceAttributeMultiprocessorCount, dev) != hipSuccess) { grid = -1; return; }
        if (hipFuncSetAttribute((const void*)mk_fwd, hipFuncAttributeMaxDynamicSharedMemorySize, LDS_BYTES) != hipSuccess) { fprintf(stderr, "kernel_launch: hipFuncSetAttribute failed\n"); grid = -1; return; }
        if (hipOccupancyMaxActiveBlocksPerMultiprocessor(&per_cu, (const void*)mk_fwd, NTHR, LDS_BYTES) != hipSuccess || per_cu < 1) fprintf(stderr, "kernel_launch: occupancy query says %d\n", per_cu);
        (void)hipGetLastError();
        grid = cus;
    }
    if (grid < 0) return;
    if (hipMemsetAsync((char*)d_ws + WS_CTL, 0, CTL_ZERO_BYTES, stream) != hipSuccess) return;
    Args a{};
    for (int i = 0; i < 30; ++i) a.in[i] = (const float*)d_in[i];
    a.out = (float*)d_out; a.ws = (unsigned char*)d_ws;
    for (int li = 0; li < MK_N_LAUNCHES; ++li) {
        a.ph_lo = (MK_N_LAUNCHES == 1) ? 0 : li; a.ph_hi = (MK_N_LAUNCHES == 1) ? NPH : li + 1;
        hipLaunchKernelGGL(mk_fwd, dim3(grid), dim3(NTHR), LDS_BYTES, stream, a);
        const hipError_t le = hipPeekAtLastError();
        if (le != hipSuccess) { fprintf(stderr, "kernel_launch: launch %d failed: %s\n", li, hipGetErrorName(le)); break; }
    }
}
```

```cpp
#include <hip/hip_runtime.h>
#include <cstdio>
#include <cstdint>
#define MK_N_LAUNCHES 1
#define PROBE_PHASE -1
namespace pg8 {
#define PG8_LAS __attribute__((address_space(3)))
typedef unsigned short bf16_t;
typedef short bf16x8 __attribute__((ext_vector_type(8)));
typedef float f32x4 __attribute__((ext_vector_type(4)));
typedef unsigned u32x4 __attribute__((ext_vector_type(4)));
constexpr int BM = 256, BK = 64, HALF = 128, HTB = HALF * BK * 2  , STAGE_BYTES = 8 * HTB, NXCD = 8, WGM = 8;

__host__ __device__ __forceinline__ int lds_byte(int r, int c) { const int st = (r >> 4) * 2 + (c >> 5), rr = r & 15, cc = c & 31, ob = rr * 64 + cc * 2; return st * 1024 + (ob ^ (((ob >> 9) & 1) << 5)); }
__host__ __device__ __forceinline__ void stage_rc(int b, int& R, int& C) { const int st = b / 1024, sb = b % 1024, swz = sb ^ (((sb >> 9) & 1) << 5); R = (st >> 1) * 16 + swz / 64; C = (st & 1) * 32 + (swz % 64) / 2; }
__host__ __device__ __forceinline__ int perm32(int rho) { const int n = rho >> 4, i = rho & 15; return 8 * (i >> 2) + 4 * n + (i & 3); }

struct Unit { int pm, pn, ord; };
struct Gemm { const bf16_t* A; const bf16_t* Bt; int M, N, K; };

struct StaticOrder {
    int nM, nN, nwg, G, c;
    __host__ __device__ void init(int M, int N, int G_, int c_) { nM = M / BM; nN = N / BM; nwg = nM * nN; G = G_; c = c_; }
    __host__ __device__ bool next(int i, Unit& u) const {
        const long L = (long)i * G + c; if (L >= nwg) return false;
        int wgid = (int)L; { const int q = nwg / NXCD, r = nwg % NXCD, xcd = wgid % NXCD, off = wgid / NXCD; wgid = (xcd < r ? xcd * (q + 1) : r * (q + 1) + (xcd - r) * q) + off; }
        const int nig = WGM * nN, gid = wgid / nig, fm = gid * WGM, gsz = (nM - fm) < WGM ? (nM - fm) : WGM;
        u.pm = fm + ((wgid % nig) % gsz); u.pn = (wgid % nig) / gsz; u.ord = i; return true;
    }
    __device__ __forceinline__ void a_ready(const Unit&) const {}
    static constexpr bool GATHER = false;
    __device__ __forceinline__ void fill_all() const {}
    __device__ __forceinline__ unsigned row_off(int, int) const { return 0u; }
    __device__ __forceinline__ void done(const Unit&) const {}
    __device__ __forceinline__ size_t a_off(const Unit& u, size_t tstep) const { return (size_t)u.pm * tstep; }
    __device__ __forceinline__ size_t b_off(const Unit& u, size_t tstep) const { return (size_t)u.pn * tstep; }
};
__device__ __forceinline__ unsigned cvt_pk_bf16(float lo, float hi) { unsigned r; asm volatile("v_cvt_pk_bf16_f32 %0, %1, %2" : "=v"(r) : "v"(lo), "v"(hi)); return r; }
typedef int v8i32 __attribute__((ext_vector_type(8)));
typedef int v4i32 __attribute__((ext_vector_type(4)));
__device__ __forceinline__ v8i32 cat8(bf16x8 lo, bf16x8 hi) { const v4i32 a = __builtin_bit_cast(v4i32, lo), b = __builtin_bit_cast(v4i32, hi); return __builtin_shufflevector(a, b, 0, 1, 2, 3, 4, 5, 6, 7); }
template <class Epi, class Sched, bool ALIGN_EPI = false, bool SP2 = false, bool FP8 = false>
__device__ __forceinline__ void gemm_phase(PG8_LAS unsigned char* lds, const Gemm g, const Sched& S, const Epi& E) {
    const int tid = threadIdx.x, wid = __builtin_amdgcn_readfirstlane(tid >> 6), lane = tid & 63, wr = wid >> 2, wc = wid & 3, fr = lane & 15, fq = lane >> 4;
    const int K = g.K, nt = K / BK;
    unsigned voffA[2], voffB[2];
#pragma unroll
    for (int i = 0; i < 2; ++i) { int R, C; stage_rc(tid * 16 + i * 8192, R, C); const int Rb = Epi::PERM ? ((R & ~31) + perm32(R & 31)) : R;
        voffA[i] = (unsigned)(R * K + C) * 2u; voffB[i] = (unsigned)(Rb * K + C) * 2u; }
    unsigned voffA1[2]; int rselA[2]; unsigned cselA[2];
#pragma unroll
    for (int i = 0; i < 2; ++i) { int R, C; stage_rc(tid * 16 + i * 8192, R, C); rselA[i] = R; cselA[i] = (unsigned)C * 2u; voffA1[i] = voffA[i]; }
    const size_t kstep = (size_t)(BK * 2);
    const size_t hstep = (size_t)HALF * K * 2;
    const size_t tstep = 2 * hstep;
    const size_t hstepA = Sched::GATHER ? (size_t)0 : hstep;
#define PG8_ROWS(_u) do { _Pragma("unroll") for (int _i = 0; _i < 2; ++_i) { voffA[_i] = S.row_off((_u), rselA[_i]) + cselA[_i]; voffA1[_i] = S.row_off((_u), HALF + rselA[_i]) + cselA[_i]; } } while (0)
    const unsigned ldsw = (unsigned)wid * 1024u;
    const int aoff = lds_byte(wr * 64 + fr, fq * 8), boff = lds_byte(wc * 32 + fr, fq * 8);
#define PG8_SA(b, h) (((b) * 2 + (h)) * HTB)
#define PG8_SB(b, h) ((4 + (b) * 2 + (h)) * HTB)
#define PG8_STAGE(bufoff, gbase, voff) do { _Pragma("unroll") for (int _i = 0; _i < 2; ++_i) \
        __builtin_amdgcn_global_load_lds((const unsigned*)((const char*)(gbase) + (voff)[_i]), (PG8_LAS unsigned*)(lds + (bufoff) + ldsw + _i * 8192), 16, 0, 0); } while (0)
#define PG8_LDA(dst, b, h) do { if constexpr (FP8) { _Pragma("unroll") for (int m = 0; m < 4; ++m) dst##8[m] = cat8(*(const PG8_LAS bf16x8*)(lds + PG8_SA(b, h) + aoff + m * 2048), *(const PG8_LAS bf16x8*)(lds + PG8_SA(b, h) + aoff + m * 2048 + 1024)); } \
        else { _Pragma("unroll") for (int m = 0; m < 4; ++m) _Pragma("unroll") for (int k = 0; k < 2; ++k) dst[m][k] = *(const PG8_LAS bf16x8*)(lds + PG8_SA(b, h) + aoff + m * 2048 + k * 1024); } } while (0)
#define PG8_LDB(dst, b, h) do { if constexpr (FP8) { _Pragma("unroll") for (int n = 0; n < 2; ++n) dst##8[n] = cat8(*(const PG8_LAS bf16x8*)(lds + PG8_SB(b, h) + boff + n * 2048), *(const PG8_LAS bf16x8*)(lds + PG8_SB(b, h) + boff + n * 2048 + 1024)); } \
        else { _Pragma("unroll") for (int n = 0; n < 2; ++n) _Pragma("unroll") for (int k = 0; k < 2; ++k) dst[n][k] = *(const PG8_LAS bf16x8*)(lds + PG8_SB(b, h) + boff + n * 2048 + k * 1024); } } while (0)
#define PG8_MMA(ai, bj, At, Bt) do { __builtin_amdgcn_s_setprio(1); if constexpr (FP8) { _Pragma("unroll") for (int m = 0; m < 4; ++m) _Pragma("unroll") for (int n = 0; n < 2; ++n) \
        asm volatile("v_mfma_scale_f32_16x16x128_f8f6f4 %0, %1, %2, %0, %3, %3 op_sel_hi:[0,0,0]" : "+v"(acc[ai][bj][m][n]) : "v"(Bt##8[n]), "v"(At##8[m]), "v"(f8scale)); } else { \
        _Pragma("unroll") for (int m = 0; m < 4; ++m) _Pragma("unroll") for (int n = 0; n < 2; ++n) _Pragma("unroll") for (int k = 0; k < 2; ++k) \
        acc[ai][bj][m][n] = __builtin_amdgcn_mfma_f32_16x16x32_bf16(Bt[n][k], At[m][k], acc[ai][bj][m][n], 0, 0, 0); } __builtin_amdgcn_s_setprio(0); } while (0)
#define PG8_WAIT_V(n) asm volatile("s_waitcnt vmcnt(" #n ")" ::: "memory")
#define PG8_WAIT_L(n) asm volatile("s_waitcnt lgkmcnt(" #n ")" ::: "memory")
#define PG8_BAR __builtin_amdgcn_s_barrier()
#define PG8_SCHED __builtin_amdgcn_sched_barrier(0)
    Unit cur, nxt; int ui = 0;
    if (!S.next(0, cur)) return;
    f32x4 acc[2][2][4][2];
#pragma unroll
    for (int a = 0; a < 2; ++a)
#pragma unroll
        for (int b = 0; b < 2; ++b)
#pragma unroll
            for (int m = 0; m < 4; ++m)
#pragma unroll
                for (int n = 0; n < 2; ++n) acc[a][b][m][n] = (f32x4){0.f, 0.f, 0.f, 0.f};
    const int f8scale = 0x7f7f7f7f;
    bf16x8 At[4][2], B0[2][2], B1[2][2]; v8i32 At8[4], B08[2], B18[2];
    const char* cA = (const char*)g.A + S.a_off(cur, tstep); const char* cB = (const char*)g.Bt + S.b_off(cur, tstep);
    S.a_ready(cur);
    if constexpr (Sched::GATHER) { S.fill_all(); asm volatile("s_waitcnt vmcnt(0) lgkmcnt(0)" ::: "memory"); __builtin_amdgcn_s_barrier(); asm volatile("" ::: "memory"); PG8_ROWS(0); }
    if constexpr (SP2) {
        PG8_STAGE(PG8_SB(0, 0), cB, voffB); PG8_STAGE(PG8_SB(0, 1), cB + hstep, voffB); PG8_STAGE(PG8_SA(0, 0), cA, voffA); PG8_STAGE(PG8_SA(0, 1), cA + hstepA, voffA1);
        if (wr == 1) PG8_BAR;
        PG8_WAIT_V(2); PG8_BAR;
        PG8_STAGE(PG8_SB(1, 0), cB + kstep, voffB); PG8_STAGE(PG8_SA(1, 0), cA + kstep, voffA); PG8_STAGE(PG8_SB(1, 1), cB + hstep + kstep, voffB);
        PG8_WAIT_V(6); PG8_BAR;
    } else {
        PG8_STAGE(PG8_SB(0, 0), cB, voffB); PG8_STAGE(PG8_SA(0, 0), cA, voffA); PG8_STAGE(PG8_SB(0, 1), cB + hstep, voffB); PG8_STAGE(PG8_SA(0, 1), cA + hstepA, voffA1);
        if (wr == 1) PG8_BAR;
        PG8_WAIT_V(4); PG8_BAR;
        PG8_STAGE(PG8_SB(1, 0), cB + kstep, voffB); PG8_STAGE(PG8_SA(1, 0), cA + kstep, voffA); PG8_STAGE(PG8_SB(1, 1), cB + hstep + kstep, voffB);
        PG8_WAIT_V(6); PG8_BAR;
    }
    for (;;) {
        const bool has_next = S.next(ui + 1, nxt);
        const char* nA = has_next ? (const char*)g.A + S.a_off(nxt, tstep) : cA; const char* nB = has_next ? (const char*)g.Bt + S.b_off(nxt, tstep) : cB;
        for (int t = 0; t < nt; t += 2) {
            const bool last = (t == nt - 2);
            const char* a1 = cA + (size_t)(t + 1) * kstep;
            const char* a2 = last ? nA : cA + (size_t)(t + 2) * kstep; const char* b2 = last ? nB : cB + (size_t)(t + 2) * kstep;
            const char* a3 = a2 + kstep; const char* b3 = b2 + kstep;
            if (last && has_next) S.a_ready(nxt);
            if constexpr (SP2) {
            PG8_LDB(B0, 0, 0); PG8_LDB(B1, 0, 1); PG8_SCHED; PG8_LDA(At, 0, 0); PG8_STAGE(PG8_SA(1, 1), a1 + hstepA, voffA1);
            PG8_WAIT_V(8); PG8_WAIT_L(0); PG8_BAR; PG8_MMA(0, 0, At, B0); PG8_MMA(0, 1, At, B1); PG8_BAR; PG8_SCHED;
            if constexpr (Sched::GATHER) { if (last && has_next) PG8_ROWS(ui + 1); }
            PG8_LDA(At, 0, 1); PG8_STAGE(PG8_SB(0, 0), b2, voffB); PG8_STAGE(PG8_SB(0, 1), b2 + hstep, voffB); PG8_STAGE(PG8_SA(0, 0), a2, voffA);
            PG8_WAIT_V(8); PG8_WAIT_L(0); PG8_BAR; PG8_MMA(1, 0, At, B0); PG8_MMA(1, 1, At, B1); PG8_BAR; PG8_SCHED;
            PG8_LDB(B0, 1, 0); PG8_LDB(B1, 1, 1); PG8_SCHED; PG8_LDA(At, 1, 0); PG8_STAGE(PG8_SA(0, 1), a2 + hstepA, voffA1);
            PG8_WAIT_V(8); PG8_WAIT_L(0); PG8_BAR; PG8_MMA(0, 0, At, B0); PG8_MMA(0, 1, At, B1); PG8_BAR; PG8_SCHED;
            PG8_LDA(At, 1, 1); PG8_STAGE(PG8_SB(1, 0), b3, voffB); PG8_STAGE(PG8_SB(1, 1), b3 + hstep, voffB); PG8_STAGE(PG8_SA(1, 0), a3, voffA);
            PG8_WAIT_V(8); PG8_WAIT_L(0); PG8_BAR; PG8_MMA(1, 0, At, B0); PG8_MMA(1, 1, At, B1); PG8_BAR; PG8_SCHED;
            } else {
            PG8_LDB(B0, 0, 0); PG8_SCHED; PG8_LDA(At, 0, 0); PG8_STAGE(PG8_SA(1, 1), a1 + hstepA, voffA1);
            PG8_WAIT_L(8); PG8_BAR; PG8_WAIT_L(0); PG8_MMA(0, 0, At, B0); PG8_BAR; PG8_SCHED;
            PG8_LDB(B1, 0, 1); PG8_STAGE(PG8_SB(0, 0), b2, voffB);
            PG8_BAR; PG8_WAIT_L(0); PG8_MMA(0, 1, At, B1); PG8_BAR;
            PG8_LDA(At, 0, 1); PG8_STAGE(PG8_SA(0, 0), a2, voffA);
            PG8_BAR; PG8_WAIT_L(0); PG8_MMA(1, 0, At, B0); PG8_BAR; PG8_SCHED;
            PG8_STAGE(PG8_SB(0, 1), b2 + hstep, voffB);
            PG8_WAIT_V(6); PG8_BAR; PG8_MMA(1, 1, At, B1); PG8_BAR;
            PG8_LDB(B0, 1, 0); PG8_SCHED; PG8_LDA(At, 1, 0); PG8_STAGE(PG8_SA(0, 1), a2 + hstepA, voffA1);
            PG8_WAIT_L(8); PG8_BAR; PG8_WAIT_L(0); PG8_MMA(0, 0, At, B0); PG8_BAR; PG8_SCHED;
            PG8_LDB(B1, 1, 1); PG8_STAGE(PG8_SB(1, 0), b3, voffB);
            PG8_BAR; PG8_WAIT_L(0); PG8_MMA(0, 1, At, B1); PG8_BAR;
            PG8_LDA(At, 1, 1); PG8_STAGE(PG8_SA(1, 0), a3, voffA);
            PG8_BAR; PG8_WAIT_L(0); PG8_MMA(1, 0, At, B0); PG8_BAR; PG8_SCHED;
            PG8_STAGE(PG8_SB(1, 1), b3 + hstep, voffB);
            PG8_WAIT_V(6); PG8_BAR; PG8_MMA(1, 1, At, B1); PG8_BAR;
            }
        }
        if constexpr (ALIGN_EPI) { if (wr == 0) PG8_BAR; }
        if constexpr (FP8) { asm volatile("s_nop 15\n\ts_nop 15" ::: "memory"); }
        if constexpr (!Epi::AFTER_DRAIN) { E(acc, cur, wr, wc, fr, fq); S.done(cur); }
        if (!has_next) break;
#pragma unroll
        for (int a = 0; a < 2; ++a)
#pragma unroll
            for (int b = 0; b < 2; ++b)
#pragma unroll
                for (int m = 0; m < 4; ++m)
#pragma unroll
                    for (int n = 0; n < 2; ++n) acc[a][b][m][n] = (f32x4){0.f, 0.f, 0.f, 0.f};
        cur = nxt; cA = nA; cB = nB; ++ui;
        if constexpr (ALIGN_EPI) { if (wr == 1) PG8_BAR; }
    }
    PG8_WAIT_V(0);
    if constexpr (!ALIGN_EPI) { if (wr == 0) PG8_BAR; }
    PG8_BAR;
    if constexpr (Epi::AFTER_DRAIN) { E.fused(acc, cur, wr, wc, fr, fq, lds, wid, lane); S.done(cur); }
#undef PG8_ROWS
#undef PG8_SA
#undef PG8_SB
#undef PG8_STAGE
#undef PG8_LDA
#undef PG8_LDB
#undef PG8_MMA
#undef PG8_WAIT_V
#undef PG8_WAIT_L
#undef PG8_BAR
#undef PG8_SCHED
}
}

#ifndef MK_N_LAUNCHES
#define MK_N_LAUNCHES 1
#endif
#define GAS __attribute__((address_space(1)))
#define LAS __attribute__((address_space(3)))
typedef unsigned short bf16;
typedef unsigned v4u __attribute__((ext_vector_type(4)));
typedef unsigned v2u __attribute__((ext_vector_type(2)));
typedef float f32x4 __attribute__((ext_vector_type(4)));
typedef float f32x2 __attribute__((ext_vector_type(2)));

constexpr int NWAVES = 8, NTHR = 512;
constexpr int NPH = 13;
constexpr int D = 2048, BATCH = 8, SEQ = 2048, T = BATCH * SEQ;
constexpr int NIN = 10696, NINP = 10752;
constexpr int MLO = 3520, GTO = 6600;
constexpr int RH = 16, RD = 1024;
constexpr int MH = 4;
constexpr int NE = 32, FF = 2048, ECAP = 16384, PMAX = 65536 + NE * 256, MTMAX = PMAX / 256;
constexpr float NORM_EPS = 1e-6f, GN_EPS = 64e-5f;
constexpr size_t MiB = 1u << 20;
constexpr size_t WS_CTL = 0, CTL_ZERO_BYTES = 1 * MiB;
constexpr size_t WS_WIN = 1 * MiB, WS_WA = 43 * MiB, WS_WB = 47 * MiB, WS_WO = 51 * MiB, WS_WL = 59 * MiB;
constexpr size_t WS_RLIST = 62 * MiB, WS_RW = 64 * MiB, WS_RWS = 2787 * MiB;
constexpr size_t WS_WGU = 66 * MiB, WS_WDN = 578 * MiB, WS_HN = 834 * MiB, WS_P = 898 * MiB, WS_LIN = 1234 * MiB, WS_WAG = 1250 * MiB;
constexpr size_t WS_YRAW = 1442 * MiB, WS_HRAW = 1506 * MiB, WS_OA = 1570 * MiB, WS_OB = 1602 * MiB, WS_TMP = 1634 * MiB, WS_MRG = 1762 * MiB;
constexpr size_t WS_QKC = WS_TMP, WS_GLF = WS_TMP + 64 * MiB;
constexpr size_t WS_X1 = 1826 * MiB, WS_XB = 1954 * MiB, WS_ACT = 2242 * MiB, WS_YS = 2530 * MiB, WS_END = 2788 * MiB;
constexpr int CW_BAR = 4096;
constexpr int CW_CVNEXT = 8192, CW_P1DONE = 8192 + 64;
constexpr int NCV = 32;
constexpr int CW_CNT = 16384;
constexpr int RING_BYTES = 131072, MISC_OFF = RING_BYTES, LDS_BYTES = RING_BYTES + 8192 + 20 * 1024;
constexpr int MI_TILE_E = 64, MI_TILE_I0 = 64 + 320, MI_CNT = 64 + 640, MI_POFF = MI_CNT + 32, MI_CST = MI_POFF + 32, MI_MT = MI_CST + 40, MI_ROWOFF = 2048;

#define LDS_WAIT() asm volatile("s_waitcnt lgkmcnt(0)" ::: "memory")
#define VM_WAIT() asm volatile("s_waitcnt vmcnt(0)" ::: "memory")
__device__ __forceinline__ float bf2f(bf16 v) { return __uint_as_float(((unsigned)v) << 16); }
__device__ __forceinline__ unsigned f2bf(float f) { unsigned u = __float_as_uint(f); return (u + 0x7fffu + ((u >> 16) & 1u)) >> 16; }
typedef __bf16 bf16x2_t __attribute__((ext_vector_type(2)));
__device__ __forceinline__ unsigned pk2(float lo, float hi) { const f32x2 v = {lo, hi}; const bf16x2_t b = __builtin_convertvector(v, bf16x2_t); return __builtin_bit_cast(unsigned, b); }
__device__ __forceinline__ unsigned pk4f8(float a, float b, float c, float d) { int r = 0; r = __builtin_amdgcn_cvt_pk_fp8_f32(a, b, r, false); r = __builtin_amdgcn_cvt_pk_fp8_f32(c, d, r, true); return (unsigned)r; }
constexpr float F8_SX = 8.f, F8_SW = 256.f, F8_SA = 4.f;
__device__ __forceinline__ float wave_sum(float v) {
#pragma unroll
    for (int o = 1; o < 64; o <<= 1) v += __shfl_xor(v, o);
    return v;
}
#define UNP4(v) ((f32x4){__uint_as_float((v).x << 16), __uint_as_float((v).x & 0xffff0000u), __uint_as_float((v).y << 16), __uint_as_float((v).y & 0xffff0000u)})
__device__ __forceinline__ float sigm(float x) { return __builtin_amdgcn_rcpf(1.f + __expf(-x)); }
template <int CTRL> __device__ __forceinline__ float dppf(float x) { return __builtin_bit_cast(float, __builtin_amdgcn_mov_dpp(__builtin_bit_cast(int, x), CTRL, 0xf, 0xf, true)); }
__device__ __forceinline__ float allreduce16(float x) { x += dppf<0x128>(x); x += dppf<0x124>(x); x += dppf<0x4E>(x); x += dppf<0xB1>(x); return x; }

#define XB_TMO      128
#define XB_XCNT(j)  (256  + 64 * (j))
#define XB_XSUB(j)  (1280 + 64 * (j))
#define XB_XGEN(j)  (2304 + 64 * (j))
#define XB_TOP      3328
#define XB_TOPGEN   3392
#define XCD_BAR_WORDS 3456
#define XB_SPIN_CAP (1u << 18)
__device__ __forceinline__ unsigned xb_ld(unsigned* p)              { return __hip_atomic_load(p, __ATOMIC_RELAXED, __HIP_MEMORY_SCOPE_AGENT); }
__device__ __forceinline__ unsigned xb_add(unsigned* p, unsigned v) { return __hip_atomic_fetch_add(p, v, __ATOMIC_RELAXED, __HIP_MEMORY_SCOPE_AGENT); }
__device__ __forceinline__ unsigned xb_xcc_id() { return (unsigned)__builtin_amdgcn_s_getreg((3 << 11) | 20) & 0xFu; }
#define XB_SPIN(cond, bar) do { unsigned _sp = 0; while (cond) { __builtin_amdgcn_s_sleep(1); \
    if ((++_sp & 255u) == 0u) { if (xb_ld(&(bar)[XB_TMO])) break; if (_sp > XB_SPIN_CAP) { atomicAdd(&(bar)[XB_TMO], 1u); break; } } } } while (0)
struct XcdBarrier { unsigned* bar; unsigned x; volatile LAS unsigned* st; };
__device__ __forceinline__ XcdBarrier xcd_barrier_post(unsigned* bar, volatile LAS unsigned* st) {
    XcdBarrier b; b.bar = bar; b.x = xb_xcc_id(); b.st = st;
    if (threadIdx.x == 0) (void)xb_add(&bar[XB_XCNT(b.x)], 1u);
    return b;
}
__device__ __forceinline__ void xcd_barrier_complete(unsigned* bar, unsigned x, unsigned& nloc, unsigned& nx) {
    const unsigned G = gridDim.x * gridDim.y * gridDim.z;
    unsigned sum, cnt, mine, sp = 0u;
    for (;;) {
        sum = 0u; cnt = 0u; mine = 0u;
#pragma unroll
        for (unsigned j = 0; j < 16; ++j) { const unsigned c = xb_ld(&bar[XB_XCNT(j)]); sum += c; cnt += (c > 0u) ? 1u : 0u; mine = (j == x) ? c : mine; }
        if (sum == G) break;
        __builtin_amdgcn_s_sleep(1);
        if ((++sp & 255u) == 0u) { if (xb_ld(&bar[XB_TMO])) break; if (sp > XB_SPIN_CAP) { atomicAdd(&bar[XB_TMO], 1u); break; } }
    }
    nloc = mine > 0u ? mine : 1u; nx = cnt > 0u ? cnt : 1u;
}
__device__ __forceinline__ void xcd_barrier(const XcdBarrier& b) {
    asm volatile("s_waitcnt vmcnt(0)" ::: "memory");
    __syncthreads();
    if (threadIdx.x == 0) {
        unsigned* bar = b.bar;
        __builtin_amdgcn_s_waitcnt(0);
        unsigned nloc = b.st[0], nx = b.st[1];
        if (nloc == 0u) { xcd_barrier_complete(bar, b.x, nloc, nx); b.st[0] = nloc; b.st[1] = nx; }
        const unsigned old = xb_add(&bar[XB_XSUB(b.x)], 1u);
        const unsigned gen = old / nloc;
        if (old + 1u == (gen + 1u) * nloc) {
            __builtin_amdgcn_fence(__ATOMIC_RELEASE, "agent");
            asm volatile("s_waitcnt vmcnt(0)" ::: "memory");
            const unsigned og = xb_add(&bar[XB_TOP], 1u);
            const unsigned tg = og / nx;
            if (og + 1u == (tg + 1u) * nx) xb_add(&bar[XB_TOPGEN], 1u);
            else XB_SPIN(xb_ld(&bar[XB_TOPGEN]) == tg, bar);
            __builtin_amdgcn_fence(__ATOMIC_ACQUIRE, "agent");
            xb_add(&bar[XB_XGEN(b.x)], 1u);
            asm volatile("s_waitcnt vmcnt(0)" ::: "memory");
        } else {
            XB_SPIN(xb_ld(&bar[XB_XGEN(b.x)]) == gen, bar);
            __builtin_amdgcn_fence(__ATOMIC_ACQUIRE, "agent");
            asm volatile("s_waitcnt vmcnt(0)" ::: "memory");
        }
    }
    __syncthreads();
}

struct Args { const float* in[30]; float* out; unsigned char* ws; int ph_lo, ph_hi; };
enum { I_X = 0, I_N1W, I_WIN, I_BGATE, I_MU, I_W0, I_WUP, I_A0, I_AUP, I_GUP, I_KK, I_KA, I_RK, I_LNW, I_LNB, I_CONVW, I_IB, I_FB, I_MNW, I_WBA, I_WBB, I_WOUT, I_N2W, I_RTW, I_RTB, I_WGU, I_BGU, I_WDN, I_BDN, I_FNW };

struct Frame {
    LAS unsigned char* lds; volatile LAS unsigned* MISC; unsigned* ctl;
    int tid, lane, wave, G, bid;
    const float* const* in; float* out; unsigned char* ws;
};

using pg8::Unit; using pg8::HALF; using pg8::BM;
struct EpiBf16Plain {
    static constexpr bool PERM = true, AFTER_DRAIN = false;
    bf16* O; int ldc;
    __device__ __forceinline__ void operator()(const f32x4 (&acc)[2][2][4][2], const Unit& u, int wr, int wc, int fr, int fq) const {
        const int row0 = u.pm * BM + wr * 64 + fr, col0 = u.pn * BM + wc * 32 + 8 * fq;
#pragma unroll
        for (int ai = 0; ai < 2; ++ai)
#pragma unroll
            for (int m = 0; m < 4; ++m) { bf16* rowp = O + (size_t)(row0 + ai * HALF + m * 16) * ldc + col0;
#pragma unroll
                for (int bj = 0; bj < 2; ++bj) { const f32x4 v0 = acc[ai][bj][m][0], v1 = acc[ai][bj][m][1];
                    v4u w; w.x = pg8::cvt_pk_bf16(v0[0], v0[1]); w.y = pg8::cvt_pk_bf16(v0[2], v0[3]); w.z = pg8::cvt_pk_bf16(v1[0], v1[1]); w.w = pg8::cvt_pk_bf16(v1[2], v1[3]);
                    *(v4u*)(rowp + bj * HALF) = w; } }
    }
};
struct EpiLora {
    static constexpr bool PERM = false, AFTER_DRAIN = false;
    float* O; const float* w0; const float* a0;
    __device__ __forceinline__ void operator()(const f32x4 (&acc)[2][2][4][2], const Unit& u, int wr, int wc, int fr, int fq) const {
        const int row0 = u.pm * BM + wr * 64 + fr, col0 = u.pn * BM + wc * 32 + 4 * fq, seg = u.pn >> 2;
        f32x4 bv[2][2];
#pragma unroll
        for (int bj = 0; bj < 2; ++bj)
#pragma unroll
            for (int n = 0; n < 2; ++n) { const int c = col0 + bj * HALF + n * 16;
                bv[bj][n] = seg == 0 ? *(const f32x4*)(w0 + c) : (seg == 1 ? *(const f32x4*)(a0 + (c - 1024)) : (f32x4){0.f, 0.f, 0.f, 0.f}); }
#pragma unroll
        for (int ai = 0; ai < 2; ++ai)
#pragma unroll
            for (int m = 0; m < 4; ++m) { float* rowp = O + (size_t)(row0 + ai * HALF + m * 16) * 3072 + col0;
#pragma unroll
                for (int bj = 0; bj < 2; ++bj)
#pragma unroll
                    for (int n = 0; n < 2; ++n) { f32x4 v = acc[ai][bj][m][n] + bv[bj][n];
                        if (seg == 0) {
#pragma unroll
                            for (int j = 0; j < 4; ++j) v[j] = -0.6065306597126334f * sigm(v[j]); }
                        else if (seg == 1) {
#pragma unroll
                            for (int j = 0; j < 4; ++j) v[j] = sigm(v[j]); }
                        *(f32x4*)(rowp + bj * HALF + n * 16) = v; } }
    }
};
struct EpiGateA {
    static constexpr bool PERM = true, AFTER_DRAIN = false;
    float* TMP; const bf16* P; const float* bg;
    __device__ __forceinline__ void operator()(const f32x4 (&acc)[2][2][4][2], const Unit& u, int wr, int wc, int fr, int fq) const {
        const int row0 = u.pm * BM + wr * 64 + fr, col0 = u.pn * BM + wc * 32 + 8 * fq;
#pragma unroll
        for (int ai = 0; ai < 2; ++ai)
#pragma unroll
            for (int m = 0; m < 4; ++m) { const size_t r = (size_t)(row0 + ai * HALF + m * 16);
#pragma unroll
                for (int bj = 0; bj < 2; ++bj) { const int c = col0 + bj * HALF;
                    const v4u pg = *(const v4u*)(P + r * NINP + GTO + c); const f32x4 b0 = *(const f32x4*)(bg + c), b1 = *(const f32x4*)(bg + c + 4);
                    f32x4 g0, g1;
                    g0[0] = sigm(__uint_as_float(pg.x << 16) + b0[0]); g0[1] = sigm(__uint_as_float(pg.x & 0xffff0000u) + b0[1]);
                    g0[2] = sigm(__uint_as_float(pg.y << 16) + b0[2]); g0[3] = sigm(__uint_as_float(pg.y & 0xffff0000u) + b0[3]);
                    g1[0] = sigm(__uint_as_float(pg.z << 16) + b1[0]); g1[1] = sigm(__uint_as_float(pg.z & 0xffff0000u) + b1[1]);
                    g1[2] = sigm(__uint_as_float(pg.w << 16) + b1[2]); g1[3] = sigm(__uint_as_float(pg.w & 0xffff0000u) + b1[3]);
                    *(f32x4*)(TMP + r * D + c) = g0 * acc[ai][bj][m][0]; *(f32x4*)(TMP + r * D + c + 4) = g1 * acc[ai][bj][m][1]; } }
    }
};
struct EpiGateB {
    static constexpr bool PERM = true, AFTER_DRAIN = false;
    const float* TMP; bf16* MRG; const bf16* P; const float* bg;
    __device__ __forceinline__ void operator()(const f32x4 (&acc)[2][2][4][2], const Unit& u, int wr, int wc, int fr, int fq) const {
        const int row0 = u.pm * BM + wr * 64 + fr, col0 = u.pn * BM + wc * 32 + 8 * fq;
#pragma unroll
        for (int ai = 0; ai < 2; ++ai)
#pragma unroll
            for (int m = 0; m < 4; ++m) { const size_t r = (size_t)(row0 + ai * HALF + m * 16);
#pragma unroll
                for (int bj = 0; bj < 2; ++bj) { const int c = col0 + bj * HALF;
                    const v4u pg = *(const v4u*)(P + r * NINP + GTO + D + c); const f32x4 b0 = *(const f32x4*)(bg + D + c), b1 = *(const f32x4*)(bg + D + c + 4);
                    const f32x4 t0 = *(const f32x4*)(TMP + r * D + c), t1 = *(const f32x4*)(TMP + r * D + c + 4);
                    f32x4 g0, g1;
                    g0[0] = sigm(__uint_as_float(pg.x << 16) + b0[0]); g0[1] = sigm(__uint_as_float(pg.x & 0xffff0000u) + b0[1]);
                    g0[2] = sigm(__uint_as_float(pg.y << 16) + b0[2]); g0[3] = sigm(__uint_as_float(pg.y & 0xffff0000u) + b0[3]);
                    g1[0] = sigm(__uint_as_float(pg.z << 16) + b1[0]); g1[1] = sigm(__uint_as_float(pg.z & 0xffff0000u) + b1[1]);
                    g1[2] = sigm(__uint_as_float(pg.w << 16) + b1[2]); g1[3] = sigm(__uint_as_float(pg.w & 0xffff0000u) + b1[3]);
                    const f32x4 v0 = t0 + g0 * acc[ai][bj][m][0], v1 = t1 + g1 * acc[ai][bj][m][1];
                    v4u w; w.x = pg8::cvt_pk_bf16(v0[0], v0[1]); w.y = pg8::cvt_pk_bf16(v0[2], v0[3]); w.z = pg8::cvt_pk_bf16(v1[0], v1[1]); w.w = pg8::cvt_pk_bf16(v1[2], v1[3]);
                    *(v4u*)(MRG + r * D + c) = w; } }
    }
};
struct EpiResid {
    static constexpr bool PERM = false, AFTER_DRAIN = false;
    const float* X; float* O;
    __device__ __forceinline__ void operator()(const f32x4 (&acc)[2][2][4][2], const Unit& u, int wr, int wc, int fr, int fq) const {
        const int row0 = u.pm * BM + wr * 64 + fr, col0 = u.pn * BM + wc * 32 + 4 * fq;
#pragma unroll
        for (int ai = 0; ai < 2; ++ai)
#pragma unroll
            for (int m = 0; m < 4; ++m) { const size_t off = (size_t)(row0 + ai * HALF + m * 16) * D + col0;
#pragma unroll
                for (int bj = 0; bj < 2; ++bj)
#pragma unroll
                    for (int n = 0; n < 2; ++n) *(f32x4*)(O + off + bj * HALF + n * 16) = *(const f32x4*)(X + off + bj * HALF + n * 16) + acc[ai][bj][m][n]; }
    }
};
struct MoeOrder : pg8::StaticOrder {
    const LAS int* tile_e; size_t estride;
    __device__ __forceinline__ size_t b_off(const Unit& u, size_t tstep) const { return (size_t)tile_e[u.pm] * estride + (size_t)u.pn * tstep; }
};
struct MoeGatherOrder : MoeOrder {
    static constexpr bool GATHER = true;
    const LAS int* tile_i0; const LAS int* cnt; const int* rlist; LAS unsigned* rowoff; unsigned rowbytes;
    __device__ __forceinline__ size_t a_off(const Unit&, size_t) const { return 0; }
    __device__ __forceinline__ void fill_all() const { const int tid = threadIdx.x, r = tid & 255;
        for (int u0 = tid >> 8; ; u0 += 6) { Unit ua, ub, uc; const bool va = next(u0, ua), vb = next(u0 + 2, ub), vc = next(u0 + 4, uc); if (!va) break;
            int ta = 0, tb = 0, tc = 0;
            { const int e = tile_e[ua.pm], i = tile_i0[ua.pm] + r; if (i < cnt[e]) ta = rlist[e * ECAP + i]; }
            if (vb) { const int e = tile_e[ub.pm], i = tile_i0[ub.pm] + r; if (i < cnt[e]) tb = rlist[e * ECAP + i]; }
            if (vc) { const int e = tile_e[uc.pm], i = tile_i0[uc.pm] + r; if (i < cnt[e]) tc = rlist[e * ECAP + i]; }
            rowoff[u0 * 256 + r] = (unsigned)(ta >> 2) * rowbytes; if (vb) rowoff[(u0 + 2) * 256 + r] = (unsigned)(tb >> 2) * rowbytes; if (vc) rowoff[(u0 + 4) * 256 + r] = (unsigned)(tc >> 2) * rowbytes; } }
    __device__ __forceinline__ unsigned row_off(int ui, int r) const { return rowoff[ui * 256 + r]; }
};
struct EpiSwiGLU {
    static constexpr bool PERM = true, AFTER_DRAIN = false;
    unsigned char* ACT; const float* bgu; const LAS int* tile_e;
    __device__ __forceinline__ void operator()(const f32x4 (&acc)[2][2][4][2], const Unit& u, int wr, int wc, int fr, int fq) const {
        const int row0 = u.pm * BM + wr * 64 + fr, colg = u.pn * 128 + wc * 32 + 8 * fq; const int e = tile_e[u.pm];
        const float* bp = bgu + (size_t)e * 4096 + colg;
        const f32x4 bg0 = *(const f32x4*)(bp), bg1 = *(const f32x4*)(bp + 4), bu0 = *(const f32x4*)(bp + 2048), bu1 = *(const f32x4*)(bp + 2052);
#pragma unroll
        for (int ai = 0; ai < 2; ++ai)
#pragma unroll
            for (int m = 0; m < 4; ++m) { const size_t r = (size_t)(row0 + ai * HALF + m * 16);
                constexpr float DS = 1.f / (F8_SX * F8_SW);
                const f32x4 ga = acc[ai][0][m][0] * DS + bg0, gb = acc[ai][0][m][1] * DS + bg1, ua = acc[ai][1][m][0] * DS + bu0, ub = acc[ai][1][m][1] * DS + bu1;
                float o[8];
#pragma unroll
                for (int j = 0; j < 4; ++j) { const float g = fminf(ga[j], 7.f), up = fminf(fmaxf(ua[j], -7.f), 7.f); o[j] = F8_SA * (up + 1.f) * g * sigm(1.702f * g);
                                              const float g2 = fminf(gb[j], 7.f), up2 = fminf(fmaxf(ub[j], -7.f), 7.f); o[4 + j] = F8_SA * (up2 + 1.f) * g2 * sigm(1.702f * g2); }
                v2u w; w.x = pk4f8(o[0], o[1], o[2], o[3]); w.y = pk4f8(o[4], o[5], o[6], o[7]);
                *(v2u*)(ACT + r * FF + colg) = w; }
    }
};
struct EpiDown {
    static constexpr bool PERM = true, AFTER_DRAIN = false;
    bf16* YS; const float* bdn; const LAS int* tile_e; const LAS int* rowdst; const LAS float* rowwt;
    __device__ __forceinline__ void operator()(const f32x4 (&acc)[2][2][4][2], const Unit& u, int wr, int wc, int fr, int fq) const {
        const int e = tile_e[u.pm]; const int col0 = u.pn * BM + wc * 32 + 8 * fq;
        const float* bp = bdn + (size_t)e * D + col0; constexpr float DS = 1.f / (F8_SA * F8_SW);
#pragma unroll
        for (int bj = 0; bj < 2; ++bj) { const f32x4 b0 = *(const f32x4*)(bp + bj * HALF), b1 = *(const f32x4*)(bp + bj * HALF + 4);
#pragma unroll
            for (int ai = 0; ai < 2; ++ai)
#pragma unroll
                for (int m = 0; m < 4; ++m) { const int r = u.ord * 256 + ai * HALF + wr * 64 + m * 16 + fr;
                    const int dst = rowdst[r]; const float w = rowwt[r];
                    const f32x4 v0 = (acc[ai][bj][m][0] * DS + b0) * w, v1 = (acc[ai][bj][m][1] * DS + b1) * w;
                    v4u o; o.x = pg8::cvt_pk_bf16(v0[0], v0[1]); o.y = pg8::cvt_pk_bf16(v0[2], v0[3]); o.z = pg8::cvt_pk_bf16(v1[0], v1[1]); o.w = pg8::cvt_pk_bf16(v1[2], v1[3]);
                    *(v4u*)(YS + (size_t)dst * D + col0 + bj * HALF) = o; } }
    }
};
template <class Sched> __device__ __forceinline__ void fill_down_tables(Frame& F, const Sched& S, LAS int* rowdst, LAS float* rowwt) {
    const LAS int* MI = (const LAS int*)F.MISC; const int* rlist = (const int*)(F.ws + WS_RLIST); const float* rw = (const float*)(F.ws + WS_RW);
    const int r = F.tid & 255;
    for (int u0 = F.tid >> 8; ; u0 += 4) { Unit ua, ub; const bool va = S.next(u0, ua), vb = S.next(u0 + 2, ub); if (!va) break;
        int da = T * 4, db = T * 4; float wa = 0.f, wb = 0.f;
        { const int e = MI[MI_TILE_E + ua.pm], i = MI[MI_TILE_I0 + ua.pm] + r; if (i < MI[MI_CNT + e]) { da = rlist[e * ECAP + i]; wa = rw[e * ECAP + i]; } }
        if (vb) { const int e = MI[MI_TILE_E + ub.pm], i = MI[MI_TILE_I0 + ub.pm] + r; if (i < MI[MI_CNT + e]) { db = rlist[e * ECAP + i]; wb = rw[e * ECAP + i]; } }
        rowdst[u0 * 256 + r] = da; rowwt[u0 * 256 + r] = wa; if (vb) { rowdst[(u0 + 2) * 256 + r] = db; rowwt[(u0 + 2) * 256 + r] = wb; } }
    __syncthreads();
}

__device__ __forceinline__ void transpose_item(const float* __restrict__ W, int N, int k0, int n0, bf16* WT, int dst_row0, int ldk, LAS float* scr, int lane) {
    const int n = n0 + (lane & 31); const bool ok = n < N;
#pragma unroll 8
    for (int i = 0; i < 32; ++i) { const int kk = 2 * i + (lane >> 5); scr[kk * 33 + (lane & 31)] = ok ? W[(size_t)(k0 + kk) * N + n] : 0.f; }
    LDS_WAIT(); asm volatile("" ::: "memory");
    const int c = lane & 7;
#pragma unroll
    for (int j = 0; j < 4; ++j) { const int nn = (lane >> 3) + 8 * j; const LAS float* s = scr + (8 * c) * 33 + nn;
        v4u o; o.x = pk2(s[0 * 33], s[1 * 33]); o.y = pk2(s[2 * 33], s[3 * 33]); o.z = pk2(s[4 * 33], s[5 * 33]); o.w = pk2(s[6 * 33], s[7 * 33]);
        *(v4u*)(WT + (size_t)(dst_row0 + nn) * ldk + k0 + 8 * c) = o; }
    LDS_WAIT(); asm volatile("" ::: "memory");
}
__device__ __forceinline__ void p0_prologue(Frame& F) {
    LAS float* scr = (LAS float*)(F.lds + F.wave * 16384);
    const int gw = F.bid * NWAVES + F.wave, NGW = F.G * NWAVES;
    bf16* WIN_T = (bf16*)(F.ws + WS_WIN); bf16* WA_T = (bf16*)(F.ws + WS_WA); bf16* WB_T = (bf16*)(F.ws + WS_WB); bf16* WO_T = (bf16*)(F.ws + WS_WO);
    bf16* WGU_T = (bf16*)(F.ws + WS_WGU); bf16* WDN_T = (bf16*)(F.ws + WS_WDN); bf16* WL_T = (bf16*)(F.ws + WS_WL); bf16* HN = (bf16*)(F.ws + WS_HN);
    constexpr int NB_WIN = (NIN + 31) / 32;
    constexpr int I_WINc = 32 * NB_WIN, I_BR = 16 * 64, I_WO = 32 * 64, I_GU = NE * 32 * 128, I_DN = NE * 32 * 64;
    constexpr int NITEMS = I_WINc;
    for (int it = gw; it < NITEMS; it += NGW) {
        int r = it;
        { const int kb = r / NB_WIN, nb = r % NB_WIN; transpose_item(F.in[I_WIN], NIN, kb * 64, nb * 32, WIN_T, nb * 32, D, scr, F.lane); }
    }
    { const int gt = F.bid * NTHR + F.tid, NGT = F.G * NTHR; constexpr int Z0 = NB_WIN * 32 * D, Z1 = NINP * D;
      for (int i = Z0 + gt * 8; i < Z1; i += NGT * 8) *(v4u*)(WIN_T + i) = (v4u){0u, 0u, 0u, 0u}; }
    { const int gt = F.bid * NTHR + F.tid, NGT = F.G * NTHR;
      for (int i = gt; i < 3072 * 512; i += NGT) { const int n = i >> 9, k = i & 511; float v = 0.f;
          if (n < 1024) { if (k < 96) v = F.in[I_WUP][k * RD + n]; }
          else if (n < 2048) { if (k >= 128 && k < 224) v = F.in[I_AUP][(k - 128) * RD + (n - 1024)]; }
          else { if (k >= 256) v = F.in[I_GUP][(k - 256) * RD + (n - 2048)]; }
          WL_T[i] = (bf16)f2bf(v); } }
    { const int gt = F.bid * NTHR + F.tid, NGT = F.G * NTHR; float* RWS = (float*)(F.ws + WS_RWS);
      for (int i = gt; i < D * NE; i += NGT) RWS[i] = F.in[I_N2W][i >> 5] * F.in[I_RTW][i]; }
    const float* x = F.in[I_X]; const float* nw = F.in[I_N1W];
    for (int m = gw; m < T; m += NGW) {
        const f32x4* xr = (const f32x4*)(x + (size_t)m * D) + F.lane; f32x4 v[8]; float s = 0.f;
#pragma unroll
        for (int j = 0; j < 8; ++j) { v[j] = xr[64 * j]; s += (v[j][0] * v[j][0] + v[j][1] * v[j][1]) + (v[j][2] * v[j][2] + v[j][3] * v[j][3]); }
        const float rstd = __builtin_amdgcn_rsqf(wave_sum(s) * (1.f / D) + NORM_EPS);
        v2u* o8 = (v2u*)(HN + (size_t)m * D) + F.lane;
#pragma unroll
        for (int j = 0; j < 8; ++j) { const f32x4 w = ((const f32x4*)nw)[F.lane + 64 * j]; v2u o; o.x = pk2(v[j][0] * rstd * w[0], v[j][1] * rstd * w[1]); o.y = pk2(v[j][2] * rstd * w[2], v[j][3] * rstd * w[3]); o8[64 * j] = o; }
    }
}

__device__ __forceinline__ void p2_lora_in(Frame& F) {
    const bf16* __restrict__ P = (const bf16*)(F.ws + WS_P); bf16* __restrict__ LIN = (bf16*)(F.ws + WS_LIN); const float* __restrict__ mu = F.in[I_MU];
    const int gt = F.bid * NTHR + F.tid, NGT = F.G * NTHR;
#pragma unroll 2
    for (int i = gt; i < T * 64; i += NGT) { const int t = i >> 6, g = i & 63; int col = -1, kind = 0;
        if (g < 12) { col = 3072 + 8 * g; kind = 0; } else if (g >= 16 && g < 28) { col = 3168 + 8 * (g - 16); kind = 1; } else if (g >= 32) { col = 3264 + 8 * (g - 32); kind = 2; }
        v4u o = (v4u){0u, 0u, 0u, 0u};
        if (col >= 0) { const v4u pc = *(const v4u*)(P + (size_t)t * NINP + col); v4u pp = (v4u){0u, 0u, 0u, 0u}; if (t & (SEQ - 1)) pp = *(const v4u*)(P + (size_t)(t - 1) * NINP + col);
            const f32x4 m0 = *(const f32x4*)(mu + col), m1 = *(const f32x4*)(mu + col + 4);
            const unsigned pcs[4] = {pc.x, pc.y, pc.z, pc.w}, pps[4] = {pp.x, pp.y, pp.z, pp.w}; float x[8];
#pragma unroll
            for (int k = 0; k < 4; ++k) { const float c0 = __uint_as_float(pcs[k] << 16), c1 = __uint_as_float(pcs[k] & 0xffff0000u), q0 = __uint_as_float(pps[k] << 16), q1 = __uint_as_float(pps[k] & 0xffff0000u);
                const float ma = k < 2 ? m0[2 * k] : m1[2 * k - 4], mb = k < 2 ? m0[2 * k + 1] : m1[2 * k - 3];
                x[2 * k] = c0 + (q0 - c0) * ma; x[2 * k + 1] = c1 + (q1 - c1) * mb; }
#pragma unroll
            for (int k = 0; k < 8; ++k) x[k] = kind == 0 ? tanhf(x[k]) : (kind == 1 ? x[k] : sigm(x[k]));
            o.x = pk2(x[0], x[1]); o.y = pk2(x[2], x[3]); o.z = pk2(x[4], x[5]); o.w = pk2(x[6], x[7]); }
        *(v4u*)(LIN + (size_t)t * 512 + 8 * g) = o; }
    { bf16* __restrict__ QKC = (bf16*)(F.ws + WS_QKC); const float* __restrict__ cw = F.in[I_CONVW];
      for (int i = gt; i < T * 128; i += NGT) { const int t = i >> 7, c0 = 8 * (i & 127); const int sq = t & (SEQ - 1); float acc[8];
#pragma unroll
          for (int k = 0; k < 8; ++k) acc[k] = 0.f;
#pragma unroll
          for (int j = 0; j < 4; ++j) { if (sq - 3 + j >= 0) { const v4u pv = *(const v4u*)(P + (size_t)(t - 3 + j) * NINP + MLO + c0); const f32x4 w0 = *(const f32x4*)(cw + j * 1024 + c0), w1 = *(const f32x4*)(cw + j * 1024 + c0 + 4);
                  acc[0] += __uint_as_float(pv.x << 16) * w0[0]; acc[1] += __uint_as_float(pv.x & 0xffff0000u) * w0[1]; acc[2] += __uint_as_float(pv.y << 16) * w0[2]; acc[3] += __uint_as_float(pv.y & 0xffff0000u) * w0[3];
                  acc[4] += __uint_as_float(pv.z << 16) * w1[0]; acc[5] += __uint_as_float(pv.z & 0xffff0000u) * w1[1]; acc[6] += __uint_as_float(pv.w << 16) * w1[2]; acc[7] += __uint_as_float(pv.w & 0xffff0000u) * w1[3]; } }
          const float sc = c0 < 512 ? 0.08838834764831845f : 1.f;
#pragma unroll
          for (int k = 0; k < 8; ++k) acc[k] = acc[k] * sigm(acc[k]) * sc;
          v4u o; o.x = pk2(acc[0], acc[1]); o.y = pk2(acc[2], acc[3]); o.z = pk2(acc[4], acc[5]); o.w = pk2(acc[6], acc[7]); *(v4u*)(QKC + (size_t)t * 1024 + c0) = o; } }
    { float* __restrict__ GLF = (float*)(F.ws + WS_GLF); const int gw = F.bid * NWAVES + F.wave, NGW = F.G * NWAVES, lane = F.lane;
      for (int q = gw; q < (T / 64) * 4; q += NGW) { const int chk = q >> 2, mh = q & 3; const size_t t = (size_t)chk * 64 + lane; const bf16* pr = P + t * NINP + MLO + 2048;
          const float ip = 15.f * tanhf((bf2f(pr[mh]) + F.in[I_IB][mh]) * (1.f / 15.f)), fp = 15.f * tanhf((bf2f(pr[4 + mh]) + F.in[I_FB][mh]) * (1.f / 15.f));
          float bc = fminf(fp, 0.f) - log1pf(__expf(-fabsf(fp)));
#pragma unroll
          for (int o = 1; o < 64; o <<= 1) { const float t_ = __shfl_up(bc, o); if (lane >= o) bc += t_; }
          const float u = ip - bc; float pm = u;
#pragma unroll
          for (int o = 1; o < 64; o <<= 1) { const float t_ = __shfl_up(pm, o); if (lane >= o) pm = fmaxf(pm, t_); }
          *(f32x4*)(GLF + t * 16 + 4 * mh) = (f32x4){bc, u, pm, 0.f}; } }
}

typedef short s16x8 __attribute__((ext_vector_type(8)));
typedef short s16x4 __attribute__((ext_vector_type(4)));
__device__ __forceinline__ unsigned long long pack4bf(f32x4 v) { return (unsigned long long)pk2(v[0], v[1]) | ((unsigned long long)pk2(v[2], v[3]) << 32); }
__device__ __forceinline__ s16x8 tr_frag(const LAS bf16* img, int stride, int r0, int c0, int fr) {
    const LAS bf16* p0 = img + (r0 + (fr >> 2)) * stride + c0 + 4 * (fr & 3);
    const s16x4 lo = __builtin_bit_cast(s16x4, __builtin_amdgcn_ds_read_tr16_b64_v4i16((LAS s16x4*)p0));
    const s16x4 hi = __builtin_bit_cast(s16x4, __builtin_amdgcn_ds_read_tr16_b64_v4i16((LAS s16x4*)(p0 + 4 * stride)));
    return __builtin_shufflevector(lo, hi, 0, 1, 2, 3, 4, 5, 6, 7);
}

__device__ __forceinline__ void rw_bar(LAS unsigned* cnt, unsigned& target, int lane);
__device__ __forceinline__ void rwkv_chunk_unit(Frame& F, int unit, LAS unsigned char* regB, LAS unsigned* bcnt, unsigned& btarget) {
    const int b = unit >> 5, h = (unit >> 1) & 15, half = unit & 1;
    const bf16* P = (const bf16*)(F.ws + WS_P); const float* WAG = (const float*)(F.ws + WS_WAG); float* YRAW = (float*)(F.ws + WS_YRAW);
    constexpr int KS = 72, LS = 40;
    LAS bf16* At = (LAS bf16*)F.lds; LAS bf16* Bt = At + 32 * KS; LAS bf16* Kt = Bt + 32 * KS; LAS bf16* Rt = Kt + 32 * KS;
    LAS bf16* Vv = Rt + 32 * KS;
    LAS bf16* Sb = Vv + 32 * LS;
    LAS bf16* G2b = Sb + 32 * KS; LAS bf16* G3b = G2b + 32 * LS; LAS bf16* G4b = G3b + 32 * LS;
    LAS bf16* Pwb = G4b + 32 * LS;
    LAS bf16* Acb = Pwb + 2 * 32 * LS;
    LAS bf16* RHt = (LAS bf16*)regB;
    LAS bf16* Ubt = RHt + 32 * LS;
    LAS float* lwf = (LAS float*)(Ubt + 32 * LS);
    LAS float* csf = lwf + 2048;
    LAS float* gtf = csf + 2048;
    LAS float* glf = gtf + 256;
    const int tid = F.tid, lane = F.lane, w = F.wave, fr = lane & 15, fq = lane >> 4;
    const int ts = tid >> 4, cs = tid & 15, c0 = h * 64 + 4 * cs;
    const int sk = tid & 63, sq = tid >> 6;
    const f32x4 mu_r = *(const f32x4*)(F.in[I_MU] + c0), mu_k = *(const f32x4*)(F.in[I_MU] + 1024 + c0), mu_v = *(const f32x4*)(F.in[I_MU] + 2048 + c0);
    const f32x4 kkc = *(const f32x4*)(F.in[I_KK] + c0), kac = *(const f32x4*)(F.in[I_KA] + c0);
    for (int i = tid; i < 32 * KS; i += 256) Sb[i] = 0;
    v2u cr[2], ck[2], cv[2], qr[2], qk[2], qv[2]; f32x4 w4[2], a4[2];
#define RC_LOAD(ch) do { _Pragma("unroll") for (int p_ = 0; p_ < 2; ++p_) { const int t_ = (ch) * 32 + ts + 16 * p_; const size_t tk_ = (size_t)b * SEQ + t_; const bf16* pr_ = P + tk_ * NINP + c0; \
        cr[p_] = *(const v2u*)(pr_); ck[p_] = *(const v2u*)(pr_ + 1024); cv[p_] = *(const v2u*)(pr_ + 2048); \
        if (t_ > 0) { qr[p_] = *(const v2u*)(pr_ - NINP); qk[p_] = *(const v2u*)(pr_ - NINP + 1024); qv[p_] = *(const v2u*)(pr_ - NINP + 2048); } else { qr[p_] = (v2u){0u, 0u}; qk[p_] = qr[p_]; qv[p_] = qr[p_]; } \
        w4[p_] = *(const f32x4*)(WAG + tk_ * 3072 + c0); a4[p_] = *(const f32x4*)(WAG + tk_ * 3072 + 1024 + c0); } } while (0)
    const int mi = w >> 1, nj = w & 1;
    f32x4 st[2]; st[0] = (f32x4){0.f, 0.f, 0.f, 0.f}; st[1] = st[0];
    RC_LOAD(0);
    rw_bar(bcnt, btarget, lane);
    for (int ch = 0; ch < SEQ / 32; ++ch) {
        f32x4 rr[2], kmod[2], vv[2], kkn[2], lw[2], al[2];
#pragma unroll
        for (int p_ = 0; p_ < 2; ++p_) { const f32x4 pr4 = UNP4(cr[p_]), pk4 = UNP4(ck[p_]), pv4 = UNP4(cv[p_]), qr4 = UNP4(qr[p_]), qk4 = UNP4(qk[p_]), qv4 = UNP4(qv[p_]); lw[p_] = w4[p_]; al[p_] = a4[p_];
            rr[p_] = pr4 + (qr4 - pr4) * mu_r; const f32x4 k1 = pk4 + (qk4 - pk4) * mu_k; vv[p_] = pv4 + (qv4 - pv4) * mu_v;
            const f32x4 kkr = k1 * kkc; const float nrm = __builtin_amdgcn_rsqf(fmaxf(allreduce16((kkr[0] * kkr[0] + kkr[1] * kkr[1]) + (kkr[2] * kkr[2] + kkr[3] * kkr[3])), 1e-24f));
            kkn[p_] = kkr * nrm; kmod[p_] = k1 * (1.f + (al[p_] - 1.f) * kac);
            *(LAS f32x4*)(lwf + (ts + 16 * p_) * 64 + 4 * cs) = lw[p_]; }
        if (ch + 1 < SEQ / 32) RC_LOAD(ch + 1);
        rw_bar(bcnt, btarget, lane);
        float cc[8];
#pragma unroll
        for (int i = 0; i < 8; ++i) cc[i] = lwf[(8 * sq + i) * 64 + sk] + (i ? cc[i - 1] : 0.f);
        gtf[sq * 64 + sk] = cc[7];
        rw_bar(bcnt, btarget, lane);
        { float off = 0.f;
#pragma unroll
          for (int q = 0; q < 3; ++q) off += (q < sq) ? gtf[q * 64 + sk] : 0.f;
#pragma unroll
          for (int i = 0; i < 8; ++i) csf[(8 * sq + i) * 64 + sk] = off + cc[i]; }
        rw_bar(bcnt, btarget, lane);
#pragma unroll
        for (int p_ = 0; p_ < 2; ++p_) { const int t = ts + 16 * p_; const f32x4 cg = *(const LAS f32x4*)(csf + t * 64 + 4 * cs); f32x4 g, gp, gi;
#pragma unroll
          for (int j = 0; j < 4; ++j) { g[j] = __expf(cg[j]); gp[j] = __expf(cg[j] - lw[p_][j]); gi[j] = __expf(-cg[j]); }
          *(LAS unsigned long long*)(At + t * KS + 4 * cs) = pack4bf(-(kkn[p_] * gp)); *(LAS unsigned long long*)(Bt + t * KS + 4 * cs) = pack4bf(kkn[p_] * al[p_] * gi);
          *(LAS unsigned long long*)(Kt + t * KS + 4 * cs) = pack4bf(kmod[p_] * gi); *(LAS unsigned long long*)(Rt + t * KS + 4 * cs) = pack4bf(rr[p_] * g);
          if ((cs >> 3) == half) *(LAS unsigned long long*)(Vv + t * LS + 4 * (cs & 7)) = pack4bf(vv[p_]);
          if (t == 31) *(LAS f32x4*)(glf + 4 * cs) = g; }
        rw_bar(bcnt, btarget, lane);
        f32x4 accT, pwT;
        { const int t = 16 * mi + fr, jb = 16 * nj + 4 * fq;
          f32x4 g1 = (f32x4){0.f, 0.f, 0.f, 0.f}, g2 = g1, g3 = g1, g4 = g1;
#pragma unroll
          for (int ks = 0; ks < 2; ++ks) { const s16x8 bj = *(const LAS s16x8*)(Bt + (16 * nj + fr) * KS + 32 * ks + 8 * fq), kj = *(const LAS s16x8*)(Kt + (16 * nj + fr) * KS + 32 * ks + 8 * fq);
              const s16x8 at = *(const LAS s16x8*)(At + (16 * mi + fr) * KS + 32 * ks + 8 * fq), rt = *(const LAS s16x8*)(Rt + (16 * mi + fr) * KS + 32 * ks + 8 * fq);
              g1 = __builtin_amdgcn_mfma_f32_16x16x32_bf16(bj, at, g1, 0, 0, 0); g2 = __builtin_amdgcn_mfma_f32_16x16x32_bf16(kj, at, g2, 0, 0, 0);
              g3 = __builtin_amdgcn_mfma_f32_16x16x32_bf16(bj, rt, g3, 0, 0, 0); g4 = __builtin_amdgcn_mfma_f32_16x16x32_bf16(kj, rt, g4, 0, 0, 0); }
#pragma unroll
          for (int rg_ = 0; rg_ < 4; ++rg_) { const int j = jb + rg_; g1[rg_] = (j < t) ? g1[rg_] : 0.f; g2[rg_] = (j < t) ? g2[rg_] : 0.f; g3[rg_] = (j <= t) ? g3[rg_] : 0.f; g4[rg_] = (j <= t) ? g4[rg_] : 0.f; }
          pwT = g1; *(LAS unsigned long long*)(Pwb + t * LS + jb) = pack4bf(g1);
#pragma unroll
          for (int rg_ = 0; rg_ < 4; ++rg_) accT[rg_] = g1[rg_] + ((jb + rg_ == t) ? 1.f : 0.f);
          *(LAS unsigned long long*)(Acb + 32 * LS + t * LS + jb) = pack4bf(accT);
          *(LAS unsigned long long*)(G2b + t * LS + jb) = pack4bf(g2); *(LAS unsigned long long*)(G3b + t * LS + jb) = pack4bf(g3); *(LAS unsigned long long*)(G4b + t * LS + jb) = pack4bf(g4); }
        rw_bar(bcnt, btarget, lane);
        f32x4 yv = (f32x4){0.f, 0.f, 0.f, 0.f};
#pragma unroll
        for (int s = 0; s < 5; ++s) { const LAS bf16* Pr = Pwb + (s & 1) * 32 * LS; LAS bf16* Pn = Pwb + ((s + 1) & 1) * 32 * LS; const LAS bf16* Ar = Acb + (s & 1) * 32 * LS; LAS bf16* An = Acb + ((s + 1) & 1) * 32 * LS;
            const s16x8 xrow = *(const LAS s16x8*)(Pr + (16 * mi + fr) * LS + 8 * fq);
            if (s < 4) { f32x4 z = (f32x4){0.f, 0.f, 0.f, 0.f}; z = __builtin_amdgcn_mfma_f32_16x16x32_bf16(tr_frag(Pr, LS, 8 * fq, 16 * nj, fr), xrow, z, 0, 0, 0);
                         *(LAS unsigned long long*)(Pn + (16 * mi + fr) * LS + 16 * nj + 4 * fq) = pack4bf(z); }
            if (s >= 1) { accT = __builtin_amdgcn_mfma_f32_16x16x32_bf16(tr_frag(Ar, LS, 8 * fq, 16 * nj, fr), xrow, accT, 0, 0, 0);
                          *(LAS unsigned long long*)(An + (16 * mi + fr) * LS + 16 * nj + 4 * fq) = pack4bf(accT); }
            if (s == 0) {
                f32x4 z = (f32x4){0.f, 0.f, 0.f, 0.f};
#pragma unroll
                for (int ks = 0; ks < 2; ++ks) { const s16x8 sb = *(const LAS s16x8*)(Sb + (16 * nj + fr) * KS + 32 * ks + 8 * fq);
                    z = __builtin_amdgcn_mfma_f32_16x16x32_bf16(*(const LAS s16x8*)(At + (16 * mi + fr) * KS + 32 * ks + 8 * fq), sb, z, 0, 0, 0);
                    yv = __builtin_amdgcn_mfma_f32_16x16x32_bf16(*(const LAS s16x8*)(Rt + (16 * mi + fr) * KS + 32 * ks + 8 * fq), sb, yv, 0, 0, 0); }
                const s16x8 vt_ = tr_frag(Vv, LS, 8 * fq, 16 * nj, fr);
                z = __builtin_amdgcn_mfma_f32_16x16x32_bf16(*(const LAS s16x8*)(G2b + (16 * mi + fr) * LS + 8 * fq), vt_, z, 0, 0, 0);
                yv = __builtin_amdgcn_mfma_f32_16x16x32_bf16(*(const LAS s16x8*)(G4b + (16 * mi + fr) * LS + 8 * fq), vt_, yv, 0, 0, 0);
                *(LAS unsigned long long*)(RHt + (16 * nj + fr) * LS + 16 * mi + 4 * fq) = pack4bf(z); }
            rw_bar(bcnt, btarget, lane); }
        { f32x4 z = (f32x4){0.f, 0.f, 0.f, 0.f};
          z = __builtin_amdgcn_mfma_f32_16x16x32_bf16(*(const LAS s16x8*)(Acb + 32 * LS + (16 * mi + fr) * LS + 8 * fq), *(const LAS s16x8*)(RHt + (16 * nj + fr) * LS + 8 * fq), z, 0, 0, 0);
          *(LAS unsigned long long*)(Ubt + (16 * nj + fr) * LS + 16 * mi + 4 * fq) = pack4bf(z); }
        rw_bar(bcnt, btarget, lane);
        { yv = __builtin_amdgcn_mfma_f32_16x16x32_bf16(*(const LAS s16x8*)(G3b + (16 * mi + fr) * LS + 8 * fq), *(const LAS s16x8*)(Ubt + (16 * nj + fr) * LS + 8 * fq), yv, 0, 0, 0);
          float* yp = YRAW + ((size_t)b * SEQ + ch * 32 + 16 * mi + 4 * fq) * RD + h * 64 + half * 32 + 16 * nj + fr;
#pragma unroll
          for (int rg_ = 0; rg_ < 4; ++rg_) yp[(size_t)rg_ * RD] = yv[rg_]; }
        { const int kt = w; const s16x8 bt_ = tr_frag(Bt, KS, 8 * fq, 16 * kt, fr), kt_ = tr_frag(Kt, KS, 8 * fq, 16 * kt, fr); const f32x4 gl4 = *(const LAS f32x4*)(glf + 16 * kt + 4 * fq);
#pragma unroll
          for (int vt = 0; vt < 2; ++vt) {
              st[vt] = __builtin_amdgcn_mfma_f32_16x16x32_bf16(bt_, *(const LAS s16x8*)(Ubt + (16 * vt + fr) * LS + 8 * fq), st[vt], 0, 0, 0);
              st[vt] = __builtin_amdgcn_mfma_f32_16x16x32_bf16(kt_, tr_frag(Vv, LS, 8 * fq, 16 * vt, fr), st[vt], 0, 0, 0);
              st[vt] = st[vt] * gl4;
              *(LAS unsigned long long*)(Sb + (16 * vt + fr) * KS + 16 * kt + 4 * fq) = pack4bf(st[vt]); } }
        rw_bar(bcnt, btarget, lane);
    }
#undef RC_LOAD
}

__device__ __forceinline__ float allreduce8(float x) { x += dppf<0x141>(x); x += dppf<0xB1>(x); x += dppf<0x4E>(x); return x; }
__device__ __forceinline__ void rw_bar(LAS unsigned* cnt, unsigned& target, int lane) {
    asm volatile("s_waitcnt lgkmcnt(0)" ::: "memory");
    if (lane == 0) __hip_atomic_fetch_add(cnt, 1u, __ATOMIC_RELAXED, __HIP_MEMORY_SCOPE_WORKGROUP);
    target += 4u;
    while ((unsigned)__builtin_amdgcn_readfirstlane((int)__hip_atomic_load(cnt, __ATOMIC_RELAXED, __HIP_MEMORY_SCOPE_WORKGROUP)) < target) __builtin_amdgcn_s_sleep(1);
    asm volatile("" ::: "memory");
}
constexpr int CV_BR = 8 * 32, CV_WO = 16 * 32, CV_GU = NE * 16 * 64, CV_DN = NE * 16 * 32, CV_ITEMS = 2 * CV_BR + CV_WO + CV_GU + CV_DN;
struct CvItem { const float* src; unsigned char* dst; int N; int f8; };
__device__ __forceinline__ CvItem cv_decode(Frame& F, int it) {
    CvItem c; int r = it; const int lane = F.lane;
    if (r < CV_BR) { const int kb = r >> 5, nb = r & 31; c.src = F.in[I_WBA] + (size_t)(kb * 128) * D + nb * 64 + lane; c.dst = F.ws + WS_WA + ((size_t)(nb * 64 + lane) * RD + kb * 128) * 2; c.N = D; c.f8 = 0; return c; } r -= CV_BR;
    if (r < CV_BR) { const int kb = r >> 5, nb = r & 31; c.src = F.in[I_WBB] + (size_t)(kb * 128) * D + nb * 64 + lane; c.dst = F.ws + WS_WB + ((size_t)(nb * 64 + lane) * RD + kb * 128) * 2; c.N = D; c.f8 = 0; return c; } r -= CV_BR;
    if (r < CV_WO) { const int kb = r >> 5, nb = r & 31; c.src = F.in[I_WOUT] + (size_t)(kb * 128) * D + nb * 64 + lane; c.dst = F.ws + WS_WO + ((size_t)(nb * 64 + lane) * D + kb * 128) * 2; c.N = D; c.f8 = 0; return c; } r -= CV_WO;
    if (r < CV_GU) { const int e = r >> 10, q = r & 1023, kb = q >> 6, nb = q & 63, n0 = nb * 64;
        const int dr = n0 < FF ? ((n0 >> 7) * 256 + (n0 & 127)) : (((n0 - FF) >> 7) * 256 + 128 + ((n0 - FF) & 127));
        c.src = F.in[I_WGU] + (size_t)e * D * 2 * FF + (size_t)(kb * 128) * (2 * FF) + n0 + lane; c.dst = F.ws + WS_WGU + (size_t)e * 2 * FF * D + (size_t)(dr + lane) * D + kb * 128; c.N = 2 * FF; c.f8 = 1; return c; } r -= CV_GU;
    { const int e = r >> 9, q = r & 511, kb = q >> 5, nb = q & 31;
        c.src = F.in[I_WDN] + (size_t)e * FF * D + (size_t)(kb * 128) * D + nb * 64 + lane; c.dst = F.ws + WS_WDN + (size_t)e * D * FF + (size_t)(nb * 64 + lane) * FF + kb * 128; c.N = D; c.f8 = 1; }
    return c;
}
__device__ __forceinline__ void convert_item(Frame& F, int it);
__device__ __forceinline__ void convert_loop(Frame& F, unsigned* next, unsigned* p1done, unsigned ngemm) {
    for (;;) { unsigned b = 0xffffffffu;
        if (F.lane == 0) { if (!(p1done && __hip_atomic_load(p1done, __ATOMIC_RELAXED, __HIP_MEMORY_SCOPE_AGENT) >= ngemm)) b = __hip_atomic_fetch_add(next, 2u, __ATOMIC_RELAXED, __HIP_MEMORY_SCOPE_AGENT); }
        const unsigned base = (unsigned)__builtin_amdgcn_readfirstlane((int)b); if (base >= (unsigned)CV_ITEMS) break;
        for (int k = 0; k < 2; ++k) { const int it = (int)base + k; if (it < CV_ITEMS) convert_item(F, it); } }
}
__device__ __forceinline__ void convert_item(Frame& F, int i0) {
    { const CvItem c = cv_decode(F, i0);
        float x[128];
#pragma unroll
        for (int i = 0; i < 128; ++i) x[i] = c.src[(size_t)i * c.N];
        if (c.f8) {
#pragma unroll
            for (int q = 0; q < 8; ++q) { v4u o; o.x = pk4f8(x[16 * q + 0] * F8_SW, x[16 * q + 1] * F8_SW, x[16 * q + 2] * F8_SW, x[16 * q + 3] * F8_SW); o.y = pk4f8(x[16 * q + 4] * F8_SW, x[16 * q + 5] * F8_SW, x[16 * q + 6] * F8_SW, x[16 * q + 7] * F8_SW);
                o.z = pk4f8(x[16 * q + 8] * F8_SW, x[16 * q + 9] * F8_SW, x[16 * q + 10] * F8_SW, x[16 * q + 11] * F8_SW); o.w = pk4f8(x[16 * q + 12] * F8_SW, x[16 * q + 13] * F8_SW, x[16 * q + 14] * F8_SW, x[16 * q + 15] * F8_SW);
                *(v4u*)(c.dst + 16 * q) = o; } }
        else {
#pragma unroll
            for (int q = 0; q < 16; ++q) { v4u o; o.x = pk2(x[8 * q + 0], x[8 * q + 1]); o.y = pk2(x[8 * q + 2], x[8 * q + 3]); o.z = pk2(x[8 * q + 4], x[8 * q + 5]); o.w = pk2(x[8 * q + 6], x[8 * q + 7]);
                *(v4u*)(c.dst + 16 * q) = o; } } }
}

__device__ __forceinline__ void mlstm_scan_unit(Frame& F, int unit, LAS unsigned* bcnt, unsigned& btarget) {
    const int b = unit >> 5, mh = (unit >> 3) & 3, sl = unit & 7;
    const bf16* P = (const bf16*)(F.ws + WS_P); const bf16* QKC = (const bf16*)(F.ws + WS_QKC); const float* GLF = (const float*)(F.ws + WS_GLF); float* HRAW = (float*)(F.ws + WS_HRAW);
    constexpr int VS = 56;
    LAS bf16* Lq = (LAS bf16*)F.lds;
    LAS bf16* Lk = Lq + 64 * 136;
    LAS bf16* Lv = Lk + 64 * 136;
    LAS bf16* Lvs = Lv + 64 * VS;
    LAS bf16* LcT = Lvs + 64 * VS;
    LAS bf16* Ls = LcT + 2 * 48 * 136;
    LAS float* sb = (LAS float*)(Ls + 64 * 72); LAS float* su = sb + 64; LAS float* smx = su + 64; LAS float* swk = smx + 64;
    const int tid = F.tid, lane = F.lane, w = F.wave, fr = lane & 15, fq = lane >> 4;
    for (int i = tid; i < 2 * 48 * 136; i += 256) LcT[i] = 0;
    for (int i = tid; i < 64 * 16; i += 256) { const int j = i >> 4, c = 32 + (i & 15); Lv[j * VS + c] = (c == 32) ? (bf16)0x3F80 : (bf16)0; Lvs[j * VS + c] = 0; }
    const int pr0 = tid >> 4, pc = 8 * (tid & 15);
    v4u rq[4], rk[4], rv; f32x4 g3;
#define ML_LOAD(ch) do { const size_t tk0_ = (size_t)b * SEQ + (ch) * 64; \
        _Pragma("unroll") for (int i_ = 0; i_ < 4; ++i_) { const bf16* s_ = QKC + (tk0_ + pr0 + 16 * i_) * 1024 + mh * 128 + pc; rq[i_] = *(const v4u*)s_; rk[i_] = *(const v4u*)(s_ + 512); } \
        rv = *(const v4u*)(P + (tk0_ + (tid >> 2)) * NINP + MLO + 1024 + mh * 256 + sl * 32 + 8 * (tid & 3)); \
        g3 = *(const f32x4*)(GLF + (tk0_ + lane) * 16 + 4 * mh); } while (0)
    f32x4 st[2][3];
#pragma unroll
    for (int a = 0; a < 2; ++a)
#pragma unroll
        for (int n = 0; n < 3; ++n) st[a][n] = (f32x4){0.f, 0.f, 0.f, 0.f};
    float mstate = 0.f;
    ML_LOAD(0);
    rw_bar(bcnt, btarget, lane);
    for (int ch = 0; ch < SEQ / 64; ++ch) {
        const size_t tk0 = (size_t)b * SEQ + ch * 64;
        LAS bf16* cTc = LcT + (ch & 1) * 48 * 136; LAS bf16* cTn = LcT + ((ch + 1) & 1) * 48 * 136;
        float mnew, dec;
        { const float bc = g3[0], u = g3[1], pm = g3[2];
          const float gtot = __shfl(bc, 63), pmall = __shfl(pm, 63);
          mnew = gtot + fmaxf(mstate, pmall); dec = __expf(gtot + mstate - mnew);
          const float wk = __expf(u + gtot - mnew);
          sb[lane] = bc; su[lane] = u; smx[lane] = fmaxf(mstate, pm); swk[lane] = wk;
          if (w == 0) Lvs[lane * VS + 32] = (bf16)f2bf(wk); }
#pragma unroll
        for (int i = 0; i < 4; ++i) { *(LAS v4u*)(Lq + (pr0 + 16 * i) * 136 + pc) = rq[i]; *(LAS v4u*)(Lk + (pr0 + 16 * i) * 136 + pc) = rk[i]; }
        LDS_WAIT();
        { const int j = tid >> 2, d0 = 8 * (tid & 3); const float wkj = swk[j]; *(LAS v4u*)(Lv + j * VS + d0) = rv;
          const unsigned uu[4] = {rv.x, rv.y, rv.z, rv.w}; v4u sv;
          sv.x = pk2(wkj * __uint_as_float(uu[0] << 16), wkj * __uint_as_float(uu[0] & 0xffff0000u)); sv.y = pk2(wkj * __uint_as_float(uu[1] << 16), wkj * __uint_as_float(uu[1] & 0xffff0000u));
          sv.z = pk2(wkj * __uint_as_float(uu[2] << 16), wkj * __uint_as_float(uu[2] & 0xffff0000u)); sv.w = pk2(wkj * __uint_as_float(uu[3] << 16), wkj * __uint_as_float(uu[3] & 0xffff0000u));
          *(LAS v4u*)(Lvs + j * VS + d0) = sv; }
        if (ch + 1 < SEQ / 64) ML_LOAD(ch + 1);
        rw_bar(bcnt, btarget, lane);
        { const int tt = w; const int t = 16 * tt + fr; const float mxt = smx[t];
#pragma unroll
          for (int jt = 0; jt < 4; ++jt) { f32x4 acc = (f32x4){0.f, 0.f, 0.f, 0.f};
              if (jt <= tt) {
#pragma unroll
                  for (int ks = 0; ks < 4; ++ks) { const s16x8 a = *(const LAS s16x8*)(Lk + (16 * jt + fr) * 136 + 32 * ks + 8 * fq), bq = *(const LAS s16x8*)(Lq + (16 * tt + fr) * 136 + 32 * ks + 8 * fq);
                      acc = __builtin_amdgcn_mfma_f32_16x16x32_bf16(a, bq, acc, 0, 0, 0); }
                  const f32x4 u4 = *(const LAS f32x4*)(su + 16 * jt + 4 * fq);
#pragma unroll
                  for (int rg_ = 0; rg_ < 4; ++rg_) { const int j = 16 * jt + 4 * fq + rg_; acc[rg_] = (j <= t) ? acc[rg_] * __expf(u4[rg_] - mxt) : 0.f; } }
              *(LAS unsigned long long*)(Ls + t * 72 + 16 * jt + 4 * fq) = pack4bf(acc); } }
        rw_bar(bcnt, btarget, lane);
        { const int mi = w; f32x4 a1[3], a2[3];
#pragma unroll
          for (int n = 0; n < 3; ++n) { a1[n] = (f32x4){0.f, 0.f, 0.f, 0.f}; a2[n] = a1[n]; }
#pragma unroll
          for (int ks = 0; ks < 2; ++ks) { const s16x8 A = *(const LAS s16x8*)(Ls + (16 * mi + fr) * 72 + 32 * ks + 8 * fq);
#pragma unroll
              for (int n = 0; n < 3; ++n) a1[n] = __builtin_amdgcn_mfma_f32_16x16x32_bf16(A, tr_frag(Lv, VS, 32 * ks + 8 * fq, 16 * n, fr), a1[n], 0, 0, 0); }
#pragma unroll
          for (int ks = 0; ks < 4; ++ks) { const s16x8 A = *(const LAS s16x8*)(Lq + (16 * mi + fr) * 136 + 32 * ks + 8 * fq);
#pragma unroll
              for (int n = 0; n < 3; ++n) a2[n] = __builtin_amdgcn_mfma_f32_16x16x32_bf16(A, *(const LAS s16x8*)(cTc + (16 * n + fr) * 136 + 32 * ks + 8 * fq), a2[n], 0, 0, 0); }
          const f32x4 mx4 = *(const LAS f32x4*)(smx + 16 * mi + 4 * fq), b4 = *(const LAS f32x4*)(sb + 16 * mi + 4 * fq);
#pragma unroll
          for (int rg_ = 0; rg_ < 4; ++rg_) { const float wi = __expf(mstate - mx4[rg_]); float den = a1[2][rg_] + wi * a2[2][rg_]; den = __shfl(den, lane & 48);
              const float mt = b4[rg_] + mx4[rg_]; const float inv = __builtin_amdgcn_rcpf(fmaxf(fabsf(den), __expf(-mt))); float* hp = HRAW + (tk0 + 16 * mi + 4 * fq + rg_) * RD + mh * 256 + sl * 32 + fr;
              hp[0] = (a1[0][rg_] + wi * a2[0][rg_]) * inv; hp[16] = (a1[1][rg_] + wi * a2[1][rg_]) * inv; } }
        {
#pragma unroll
          for (int a = 0; a < 2; ++a) {
#pragma unroll
              for (int n = 0; n < 3; ++n) st[a][n] = st[a][n] * dec;
#pragma unroll
              for (int ks = 0; ks < 2; ++ks) { const s16x8 A = tr_frag(Lk, 136, 32 * ks + 8 * fq, 16 * (2 * w + a), fr);
#pragma unroll
                  for (int n = 0; n < 3; ++n) st[a][n] = __builtin_amdgcn_mfma_f32_16x16x32_bf16(A, tr_frag(Lvs, VS, 32 * ks + 8 * fq, 16 * n, fr), st[a][n], 0, 0, 0); }
#pragma unroll
              for (int n = 0; n < 3; ++n) *(LAS unsigned long long*)(cTn + (16 * n + fr) * 136 + 16 * (2 * w + a) + 4 * fq) = pack4bf(st[a][n]); } }
        mstate = mnew;
        rw_bar(bcnt, btarget, lane);
    }
#undef ML_LOAD
}

__device__ __forceinline__ float rowsum4(f32x4 v) { return (v[0] + v[1]) + (v[2] + v[3]); }
__device__ __forceinline__ void p5_finalize(Frame& F) {
    const bf16* __restrict__ P = (const bf16*)(F.ws + WS_P); const float* __restrict__ WAG = (const float*)(F.ws + WS_WAG); const float* __restrict__ YRAW = (const float*)(F.ws + WS_YRAW); const float* __restrict__ HRAW = (const float*)(F.ws + WS_HRAW);
    bf16* __restrict__ OA = (bf16*)(F.ws + WS_OA); bf16* __restrict__ OB = (bf16*)(F.ws + WS_OB);
    const int gw = F.bid * NWAVES + F.wave, NGW = F.G * NWAVES, lane = F.lane;
    { const int hq = gw & 3, c0 = (hq * 4 + (lane >> 4)) * 64 + 4 * (lane & 15);
      const f32x4 mu_r = *(const f32x4*)(F.in[I_MU] + c0), mu_k = *(const f32x4*)(F.in[I_MU] + 1024 + c0), mu_v = *(const f32x4*)(F.in[I_MU] + 2048 + c0);
      const f32x4 kac = *(const f32x4*)(F.in[I_KA] + c0), rkc = *(const f32x4*)(F.in[I_RK] + c0), lnw = *(const f32x4*)(F.in[I_LNW] + c0), lnb = *(const f32x4*)(F.in[I_LNB] + c0);
      v2u cr, ck, cv, qr, qk, qv; f32x4 a4, g4, y4;
#define P5_LOAD(q_) do { const int tk_ = (q_) >> 2; const bf16* pr_ = P + (size_t)tk_ * NINP + c0; cr = *(const v2u*)(pr_); ck = *(const v2u*)(pr_ + 1024); cv = *(const v2u*)(pr_ + 2048); \
          if (tk_ & (SEQ - 1)) { qr = *(const v2u*)(pr_ - NINP); qk = *(const v2u*)(pr_ - NINP + 1024); qv = *(const v2u*)(pr_ - NINP + 2048); } else { qr = (v2u){0u, 0u}; qk = qr; qv = qr; } \
          a4 = *(const f32x4*)(WAG + (size_t)tk_ * 3072 + 1024 + c0); g4 = *(const f32x4*)(WAG + (size_t)tk_ * 3072 + 2048 + c0); y4 = *(const f32x4*)(YRAW + (size_t)tk_ * RD + c0); } while (0)
      if (gw < T * 4) P5_LOAD(gw);
      for (int q = gw; q < T * 4; q += NGW) { const int tk = q >> 2;
          const f32x4 pr4 = UNP4(cr), pk4 = UNP4(ck), pv4 = UNP4(cv), qr4 = UNP4(qr), qk4 = UNP4(qk), qv4 = UNP4(qv); const f32x4 a = a4, g = g4, y = y4;
          if (q + NGW < T * 4) P5_LOAD(q + NGW);
          const f32x4 rr = pr4 + (qr4 - pr4) * mu_r, k1 = pk4 + (qk4 - pk4) * mu_k, vv = pv4 + (qv4 - pv4) * mu_v;
          const f32x4 kmod = k1 * (1.f + (a - 1.f) * kac);
          const float dot = allreduce16(rowsum4(rr * kmod * rkc)); const float mean = allreduce16(rowsum4(y)) * (1.f / 64.f); const f32x4 dl = y - mean;
          const float var = allreduce16(rowsum4(dl * dl)) * (1.f / 64.f); const float rs = __builtin_amdgcn_rsqf(var + GN_EPS);
          const f32x4 o = (dl * rs * lnw + lnb + dot * vv) * g;
          v2u ov; ov.x = pk2(o[0], o[1]); ov.y = pk2(o[2], o[3]); *(v2u*)(OA + (size_t)tk * RD + c0) = ov; }
#undef P5_LOAD
    }
    { const int mh = gw & 3, d0 = mh * 256 + 4 * lane; const f32x4 nw = *(const f32x4*)(F.in[I_MNW] + d0);
      f32x4 hv; v2u po;
#define P5B_LOAD(q_) do { const int tk_ = (q_) >> 2; hv = *(const f32x4*)(HRAW + (size_t)tk_ * RD + d0); po = *(const v2u*)(P + (size_t)tk_ * NINP + MLO + 2056 + d0); } while (0)
      if (gw < T * 4) P5B_LOAD(gw);
      for (int q = gw; q < T * 4; q += NGW) { const int tk = q >> 2; const f32x4 h4 = hv; const v2u p2 = po;
          if (q + NGW < T * 4) P5B_LOAD(q + NGW);
          float ss = allreduce16(rowsum4(h4 * h4)); ss += __shfl_xor(ss, 16); ss += __shfl_xor(ss, 32);
          const float rs = __builtin_amdgcn_rsqf(ss * (1.f / 256.f) + NORM_EPS); const f32x4 og = UNP4(p2);
          const float o0 = h4[0] * rs * nw[0] * sigm(og[0]), o1 = h4[1] * rs * nw[1] * sigm(og[1]), o2 = h4[2] * rs * nw[2] * sigm(og[2]), o3 = h4[3] * rs * nw[3] * sigm(og[3]);
          v2u o; o.x = pk2(o0, o1); o.y = pk2(o2, o3); *(v2u*)(OB + (size_t)tk * RD + d0) = o; }
#undef P5B_LOAD
    }
}

typedef float f32x16 __attribute__((ext_vector_type(16)));
__device__ __forceinline__ void p8_route(Frame& F) {
    const float* X1 = (const float*)(F.ws + WS_X1); unsigned char* H2 = (unsigned char*)(F.ws + WS_HN); int* RLIST = (int*)(F.ws + WS_RLIST); float* RWT = (float*)(F.ws + WS_RW);
    const float* RWS = (const float*)(F.ws + WS_RWS); const float* nw = F.in[I_N2W]; const float* rtb = F.in[I_RTB];
    LAS float* part = (LAS float*)F.lds;
    LAS float* ssq = part + 8 * 32 * 33;
    LAS float* lgt = ssq + 256;
    LAS float* srs = lgt + 32 * 33;
    const int lane = F.lane, w = F.wave, i = lane & 31, h = lane >> 5, tid = F.tid;
    for (int tile = F.bid; tile < T / 32; tile += F.G) {
        const int m0 = tile * 32; const float* xrow = X1 + (size_t)(m0 + i) * D + 256 * w + 4 * h;
        f32x16 acc;
#pragma unroll
        for (int r_ = 0; r_ < 16; ++r_) acc[r_] = 0.f;
        float ss = 0.f; const float* bp = RWS + (size_t)(256 * w + 4 * h) * NE + i;
#pragma unroll 4
        for (int q = 0; q < 32; ++q) { const f32x4 xa = *(const f32x4*)(xrow + 8 * q);
#pragma unroll
            for (int j = 0; j < 4; ++j) acc = __builtin_amdgcn_mfma_f32_32x32x2f32(xa[j], bp[(8 * q + j) * NE], acc, 0, 0, 0);
            ss += (xa[0] * xa[0] + xa[1] * xa[1]) + (xa[2] * xa[2] + xa[3] * xa[3]); }
        ss += __shfl_xor(ss, 32);
        if (h == 0) ssq[w * 32 + i] = ss;
#pragma unroll
        for (int r_ = 0; r_ < 16; ++r_) part[(w * 32 + (r_ & 3) + 8 * (r_ >> 2) + 4 * h) * 33 + i] = acc[r_];
        __syncthreads();
#pragma unroll
        for (int k2 = 0; k2 < 2; ++k2) { const int idx = tid + NTHR * k2, ii = idx >> 5, e = idx & 31; float sm = 0.f, sq = 0.f;
#pragma unroll
            for (int ww = 0; ww < 8; ++ww) { sm += part[(ww * 32 + ii) * 33 + e]; sq += ssq[ww * 32 + ii]; }
            const float rs = 1.f / sqrtf(sq * (1.f / D) + NORM_EPS); lgt[ii * 33 + e] = sm * rs + rtb[e]; if (e == 0) srs[ii] = rs; }
        __syncthreads();
        { const float rs = srs[i] * F8_SX; unsigned char* orow = H2 + (size_t)(m0 + i) * D + 256 * w + 4 * h;
#pragma unroll 8
          for (int q = 0; q < 32; ++q) { const f32x4 n4 = *(const f32x4*)(nw + 256 * w + 4 * h + 8 * q); const f32x4 hv = *(const f32x4*)(xrow + 8 * q) * rs * n4; *(unsigned*)(orow + 8 * q) = pk4f8(hv[0], hv[1], hv[2], hv[3]); } }
        if (tid < 32) { const LAS float* lr = lgt + tid * 33; unsigned used = 0u; int idx[4]; float val[4];
#pragma unroll
            for (int s4 = 0; s4 < 4; ++s4) { float best = -INFINITY; int bi = 0;
                for (int e = 0; e < 32; ++e) { const float v = lr[e]; const bool ok = !((used >> e) & 1u) && (v > best); best = ok ? v : best; bi = ok ? e : bi; }
                used |= 1u << bi; idx[s4] = bi; val[s4] = best; }
            const float e1 = __expf(val[1] - val[0]), e2 = __expf(val[2] - val[0]), e3 = __expf(val[3] - val[0]); const float inv = 1.f / (1.f + e1 + e2 + e3);
            const float wv[4] = {inv, e1 * inv, e2 * inv, e3 * inv};
#pragma unroll
            for (int s4 = 0; s4 < 4; ++s4) { const unsigned pos = atomicAdd(F.ctl + CW_CNT + 64 * idx[s4], 1u); RLIST[idx[s4] * ECAP + pos] = (m0 + tid) * 4 + s4; RWT[idx[s4] * ECAP + pos] = wv[s4]; } }
        __syncthreads();
    }
}

__device__ __forceinline__ void build_moe_tables(Frame& F) {
    LAS int* MI = (LAS int*)F.MISC;
    __syncthreads();
    if (F.tid == 0) { int mt = 0, cs = 0;
        for (int e = 0; e < NE; ++e) { const int c = (int)__hip_atomic_load(F.ctl + CW_CNT + 64 * e, __ATOMIC_RELAXED, __HIP_MEMORY_SCOPE_AGENT); MI[MI_CNT + e] = c; MI[MI_POFF + e] = mt * 256; MI[MI_CST + e] = cs; cs += c;
            const int nt = (c + 255) >> 8; for (int i = 0; i < nt; ++i) { MI[MI_TILE_E + mt + i] = e; MI[MI_TILE_I0 + mt + i] = i * 256; } mt += nt; }
        MI[MI_CST + NE] = cs; MI[MI_MT] = mt; }
    __syncthreads();
}
__device__ __forceinline__ void p9_gather(Frame& F) {
    build_moe_tables(F);
    const LAS int* MI = (const LAS int*)F.MISC; const bf16* H2 = (const bf16*)(F.ws + WS_HN); bf16* XB = (bf16*)(F.ws + WS_XB); const int* RLIST = (const int*)(F.ws + WS_RLIST);
    const int gw = F.bid * NWAVES + F.wave, NGW = F.G * NWAVES, total = MI[MI_CST + NE];
    for (int q = gw; q < total; q += NGW) { int e = 0;
        for (int k = 1; k < NE; ++k) e = (MI[MI_CST + k] <= q) ? k : e;
        const int i = q - MI[MI_CST + e]; const int tok = RLIST[e * ECAP + i] >> 2;
        const v4u* src = (const v4u*)(H2 + (size_t)tok * D) + F.lane; v4u* dst = (v4u*)(XB + (size_t)(MI[MI_POFF + e] + i) * D) + F.lane;
#pragma unroll
        for (int j = 0; j < 4; ++j) dst[64 * j] = src[64 * j]; }
}
__device__ __forceinline__ void p12_final(Frame& F) {
    const float* X1 = (const float*)(F.ws + WS_X1); const bf16* YS = (const bf16*)(F.ws + WS_YS); const float* fw = F.in[I_FNW];
    const int gw = F.bid * NWAVES + F.wave, NGW = F.G * NWAVES;
    for (int m = gw; m < T; m += NGW) {
        const f32x4* xr = (const f32x4*)(X1 + (size_t)m * D) + F.lane; f32x4 v[8]; float s = 0.f;
#pragma unroll
        for (int j = 0; j < 8; ++j) { v[j] = xr[64 * j];
#pragma unroll
            for (int sl = 0; sl < 4; ++sl) { const v2u y = ((const v2u*)(YS + ((size_t)m * 4 + sl) * D))[F.lane + 64 * j];
                v[j][0] += __uint_as_float(y.x << 16); v[j][1] += __uint_as_float(y.x & 0xffff0000u); v[j][2] += __uint_as_float(y.y << 16); v[j][3] += __uint_as_float(y.y & 0xffff0000u); }
            s += (v[j][0] * v[j][0] + v[j][1] * v[j][1]) + (v[j][2] * v[j][2] + v[j][3] * v[j][3]); }
        const float rstd = __builtin_amdgcn_rsqf(wave_sum(s) * (1.f / D) + NORM_EPS);
        f32x4* orow = (f32x4*)(F.out + (size_t)m * D) + F.lane;
#pragma unroll
        for (int j = 0; j < 8; ++j) { const f32x4 w = ((const f32x4*)fw)[F.lane + 64 * j]; orow[64 * j] = v[j] * rstd * w; }
    }
}

__global__ void __launch_bounds__(NTHR, 2) mk_fwd(Args args) {
    extern __shared__ __attribute__((aligned(16))) unsigned char lds[];
    Frame F;
    F.lds = (LAS unsigned char*)lds; F.MISC = (volatile LAS unsigned*)(F.lds + MISC_OFF);
    F.tid = threadIdx.x; F.lane = F.tid & 63; F.wave = __builtin_amdgcn_readfirstlane(F.tid >> 6); F.G = gridDim.x; F.bid = blockIdx.x;
    F.in = args.in; F.out = args.out; F.ws = args.ws; F.ctl = (unsigned*)(args.ws + WS_CTL);
    for (int u = F.tid; u < (LDS_BYTES - MISC_OFF) / 4; u += NTHR) ((LAS unsigned*)(F.lds + MISC_OFF))[u] = 0u;
    __syncthreads();
    XcdBarrier bar; bar.bar = F.ctl + CW_BAR; bar.x = 0; bar.st = nullptr;
    if (MK_N_LAUNCHES == 1) bar = xcd_barrier_post(F.ctl + CW_BAR, F.MISC + 8);
    const int lo = args.ph_lo, hi = args.ph_hi;
#define IN(k) (lo <= (k) && (k) < hi)
#ifndef PROBE_PHASE
#define PROBE_PHASE -1
#endif
#define REP(k) ((PROBE_PHASE) == (k) ? 2 : 1)
#define SEAM(k) do { if (IN(k) && IN((k) + 1)) xcd_barrier(bar); } while (0)
    LAS unsigned char* ring = F.lds;
    const LAS int* MI = (const LAS int*)F.MISC;

    if (IN(0)) { for (int rep = 0; rep < REP(0); ++rep) p0_prologue(F); } SEAM(0);
    if (IN(1)) {
        const int ng = F.G > 2 * NCV ? F.G - NCV : F.G;
        if (F.bid < ng) {
            pg8::Gemm g{(const bf16*)(F.ws + WS_HN), (const bf16*)(F.ws + WS_WIN), T, NINP, D}; pg8::StaticOrder S; S.init(T, NINP, ng, F.bid);
            EpiBf16Plain E{(bf16*)(F.ws + WS_P), NINP};
            pg8::gemm_phase<EpiBf16Plain, pg8::StaticOrder, true, true>(ring, g, S, E);
            if (F.tid == 0) __hip_atomic_fetch_add(F.ctl + CW_P1DONE, 1u, __ATOMIC_RELAXED, __HIP_MEMORY_SCOPE_AGENT);
        } else convert_loop(F, F.ctl + CW_CVNEXT, F.ctl + CW_P1DONE, (unsigned)ng);
    } SEAM(1);
    if (IN(2)) { for (int rep = 0; rep < REP(2); ++rep) p2_lora_in(F); } SEAM(2);
    if (IN(3)) {
        pg8::Gemm g{(const bf16*)(F.ws + WS_LIN), (const bf16*)(F.ws + WS_WL), T, 3072, 512}; pg8::StaticOrder S; S.init(T, 3072, F.G, F.bid);
        EpiLora E{(float*)(F.ws + WS_WAG), F.in[I_W0], F.in[I_A0]};
        pg8::gemm_phase<EpiLora, pg8::StaticOrder, true, true>(ring, g, S, E);
    } SEAM(3);
    if (IN(4)) {
        { LAS unsigned* ctl2 = (LAS unsigned*)F.MISC + 16;
          if (F.wave < 4) { unsigned bt = 0u; for (int rep = 0; rep < REP(40); ++rep) for (int u = F.bid; u < 256; u += F.G) rwkv_chunk_unit(F, u, (LAS unsigned char*)F.MISC + 256, ctl2, bt); }
          else { Frame F2 = F; F2.tid = F.tid - 256; F2.wave = F.wave - 4; F2.lds = F.lds + 45056; unsigned bt = 0u;
                 for (int rep = 0; rep < REP(41); ++rep) for (int u = F.bid; u < 256; u += F.G) mlstm_scan_unit(F2, u, ctl2 + 2, bt); }
          convert_loop(F, F.ctl + CW_CVNEXT, nullptr, 0u);
          __syncthreads(); }
    } SEAM(4);
    if (IN(5)) { for (int rep = 0; rep < REP(5); ++rep) p5_finalize(F); } SEAM(5);
    if (IN(6)) {
        { pg8::Gemm g{(const bf16*)(F.ws + WS_OA), (const bf16*)(F.ws + WS_WA), T, D, RD}; pg8::StaticOrder S; S.init(T, D, F.G, F.bid);
          EpiGateA E{(float*)(F.ws + WS_TMP), (const bf16*)(F.ws + WS_P), F.in[I_BGATE]};
          pg8::gemm_phase<EpiGateA, pg8::StaticOrder, true, true>(ring, g, S, E); }
        VM_WAIT(); __syncthreads();
        { pg8::Gemm g{(const bf16*)(F.ws + WS_OB), (const bf16*)(F.ws + WS_WB), T, D, RD}; pg8::StaticOrder S; S.init(T, D, F.G, F.bid);
          EpiGateB E{(const float*)(F.ws + WS_TMP), (bf16*)(F.ws + WS_MRG), (const bf16*)(F.ws + WS_P), F.in[I_BGATE]};
          pg8::gemm_phase<EpiGateB, pg8::StaticOrder, true, true>(ring, g, S, E); }
    } SEAM(6);
    if (IN(7)) {
        pg8::Gemm g{(const bf16*)(F.ws + WS_MRG), (const bf16*)(F.ws + WS_WO), T, D, D}; pg8::StaticOrder S; S.init(T, D, F.G, F.bid);
        EpiResid E{F.in[I_X], (float*)(F.ws + WS_X1)};
        pg8::gemm_phase<EpiResid, pg8::StaticOrder, true, true>(ring, g, S, E);
    } SEAM(7);
    if (IN(8)) { p8_route(F); } SEAM(8);
    if (IN(10)) {
        build_moe_tables(F);
        const int mt = MI[MI_MT];
        pg8::Gemm g{(const bf16*)(F.ws + WS_HN), (const bf16*)(F.ws + WS_WGU), mt * 256, 2 * FF, D / 2};
        MoeGatherOrder S; S.init(mt * 256, 2 * FF, F.G, F.bid); S.tile_e = MI + MI_TILE_E; S.estride = (size_t)2 * FF * D;
        S.tile_i0 = MI + MI_TILE_I0; S.cnt = MI + MI_CNT; S.rlist = (const int*)(F.ws + WS_RLIST); S.rowoff = (LAS unsigned*)F.MISC + MI_ROWOFF; S.rowbytes = D;
        EpiSwiGLU E{(unsigned char*)(F.ws + WS_ACT), F.in[I_BGU], MI + MI_TILE_E};
        pg8::gemm_phase<EpiSwiGLU, MoeGatherOrder, true, true, true>(ring, g, S, E);
    } SEAM(10);
    if (IN(11)) {
        build_moe_tables(F);
        const int mt = MI[MI_MT];
        pg8::Gemm g{(const bf16*)(F.ws + WS_ACT), (const bf16*)(F.ws + WS_WDN), mt * 256, D, FF / 2};
        MoeOrder S; S.init(mt * 256, D, F.G, F.bid); S.tile_e = MI + MI_TILE_E; S.estride = (size_t)D * FF;
        LAS int* rowdst = (LAS int*)F.MISC + MI_ROWOFF; LAS float* rowwt = (LAS float*)F.MISC + MI_ROWOFF + 10 * 256;
        fill_down_tables(F, S, rowdst, rowwt);
        EpiDown E{(bf16*)(F.ws + WS_YS), F.in[I_BDN], MI + MI_TILE_E, rowdst, rowwt};
        pg8::gemm_phase<EpiDown, MoeOrder, true, true, true>(ring, g, S, E);
    } SEAM(11);
    if (IN(12)) { for (int rep = 0; rep < REP(12); ++rep) p12_final(F); }
#undef IN
#undef SEAM
}

extern "C" void kernel_launch(void* const* d_in, const int* in_sizes, int n_in, void* d_out, int out_size, void* d_ws, size_t ws_size, hipStream_t stream) {
    static int grid = 0;
    if (grid == 0) {
        if (n_in != 30 || out_size != T * D || ws_size < WS_END) { fprintf(stderr, "kernel_launch: unexpected problem (n_in %d, out %d, ws %zu)\n", n_in, out_size, ws_size); grid = -1; return; }
        int dev = 0, cus = 0, per_cu = 0;
        if (hipGetDevice(&dev) != hipSuccess || hipDeviceGetAttribute(&cus, hipDeviceAttributeMultiprocessorCount, dev) != hipSuccess) { grid = -1; return; }
        if (hipFuncSetAttribute((const void*)mk_fwd, hipFuncAttributeMaxDynamicSharedMemorySize, LDS_BYTES) != hipSuccess) { fprintf(stderr, "kernel_launch: hipFuncSetAttribute failed\n"); grid = -1; return; }
        if (hipOccupancyMaxActiveBlocksPerMultiprocessor(&per_cu, (const void*)mk_fwd, NTHR, LDS_BYTES) != hipSuccess || per_cu < 1) fprintf(stderr, "kernel_launch: occupancy query says %d\n", per_cu);
        (void)hipGetLastError();
        grid = cus;
    }
    if (grid < 0) return;
    if (hipMemsetAsync((char*)d_ws + WS_CTL, 0, CTL_ZERO_BYTES, stream) != hipSuccess) return;
    Args a{};
    for (int i = 0; i < 30; ++i) a.in[i] = (const float*)d_in[i];
    a.out = (float*)d_out; a.ws = (unsigned char*)d_ws;
    for (int li = 0; li < MK_N_LAUNCHES; ++li) {
        a.ph_lo = (MK_N_LAUNCHES == 1) ? 0 : li; a.ph_hi = (MK_N_LAUNCHES == 1) ? NPH : li + 1;
        hipLaunchKernelGGL(mk_fwd, dim3(grid), dim3(NTHR), LDS_BYTES, stream, a);
        const hipError_t le = hipPeekAtLastError();
        if (le != hipSuccess) { fprintf(stderr, "kernel_launch: launch %d failed: %s\n", li, hipGetErrorName(le)); break; }
    }
}
```

```cpp
#include <hip/hip_runtime.h>
#include <cstdio>
#include <cstdint>
#define MK_N_LAUNCHES 1
#define PROBE_PHASE -1
namespace pg8 {
#define PG8_LAS __attribute__((address_space(3)))
typedef unsigned short bf16_t;
typedef short bf16x8 __attribute__((ext_vector_type(8)));
typedef float f32x4 __attribute__((ext_vector_type(4)));
typedef unsigned u32x4 __attribute__((ext_vector_type(4)));
constexpr int BM = 256, BK = 64, HALF = 128, HTB = HALF * BK * 2  , STAGE_BYTES = 8 * HTB, NXCD = 8, WGM = 8;

__host__ __device__ __forceinline__ int lds_byte(int r, int c) { const int st = (r >> 4) * 2 + (c >> 5), rr = r & 15, cc = c & 31, ob = rr * 64 + cc * 2; return st * 1024 + (ob ^ (((ob >> 9) & 1) << 5)); }
__host__ __device__ __forceinline__ void stage_rc(int b, int& R, int& C) { const int st = b / 1024, sb = b % 1024, swz = sb ^ (((sb >> 9) & 1) << 5); R = (st >> 1) * 16 + swz / 64; C = (st & 1) * 32 + (swz % 64) / 2; }
__host__ __device__ __forceinline__ int perm32(int rho) { const int n = rho >> 4, i = rho & 15; return 8 * (i >> 2) + 4 * n + (i & 3); }

struct Unit { int pm, pn, ord; };
struct Gemm { const bf16_t* A; const bf16_t* Bt; int M, N, K; };

struct StaticOrder {
    int nM, nN, nwg, G, c;
    __host__ __device__ void init(int M, int N, int G_, int c_) { nM = M / BM; nN = N / BM; nwg = nM * nN; G = G_; c = c_; }
    __host__ __device__ bool next(int i, Unit& u) const {
        const long L = (long)i * G + c; if (L >= nwg) return false;
        int wgid = (int)L; { const int q = nwg / NXCD, r = nwg % NXCD, xcd = wgid % NXCD, off = wgid / NXCD; wgid = (xcd < r ? xcd * (q + 1) : r * (q + 1) + (xcd - r) * q) + off; }
        const int nig = WGM * nN, gid = wgid / nig, fm = gid * WGM, gsz = (nM - fm) < WGM ? (nM - fm) : WGM;
        u.pm = fm + ((wgid % nig) % gsz); u.pn = (wgid % nig) / gsz; u.ord = i; return true;
    }
    __device__ __forceinline__ void a_ready(const Unit&) const {}
    static constexpr bool GATHER = false;
    __device__ __forceinline__ void fill_all() const {}
    __device__ __forceinline__ unsigned row_off(int, int) const { return 0u; }
    __device__ __forceinline__ void done(const Unit&) const {}
    __device__ __forceinline__ size_t a_off(const Unit& u, size_t tstep) const { return (size_t)u.pm * tstep; }
    __device__ __forceinline__ size_t b_off(const Unit& u, size_t tstep) const { return (size_t)u.pn * tstep; }
};
__device__ __forceinline__ unsigned cvt_pk_bf16(float lo, float hi) { unsigned r; asm volatile("v_cvt_pk_bf16_f32 %0, %1, %2" : "=v"(r) : "v"(lo), "v"(hi)); return r; }
typedef int v8i32 __attribute__((ext_vector_type(8)));
typedef int v4i32 __attribute__((ext_vector_type(4)));
__device__ __forceinline__ v8i32 cat8(bf16x8 lo, bf16x8 hi) { const v4i32 a = __builtin_bit_cast(v4i32, lo), b = __builtin_bit_cast(v4i32, hi); return __builtin_shufflevector(a, b, 0, 1, 2, 3, 4, 5, 6, 7); }
template <class Epi, class Sched, bool ALIGN_EPI = false, bool SP2 = false, bool FP8 = false, bool I8 = false>
__device__ __forceinline__ void gemm_phase(PG8_LAS unsigned char* lds, const Gemm g, const Sched& S, const Epi& E) {
    const int tid = threadIdx.x, wid = __builtin_amdgcn_readfirstlane(tid >> 6), lane = tid & 63, wr = wid >> 2, wc = wid & 3, fr = lane & 15, fq = lane >> 4;
    const int K = g.K, nt = K / BK;
    unsigned voffA[2], voffB[2];
#pragma unroll
    for (int i = 0; i < 2; ++i) { int R, C; stage_rc(tid * 16 + i * 8192, R, C); const int Rb = Epi::PERM ? ((R & ~31) + perm32(R & 31)) : R;
        voffA[i] = (unsigned)(R * K + C) * 2u; voffB[i] = (unsigned)(Rb * K + C) * 2u; }
    unsigned voffA1[2]; int rselA[2]; unsigned cselA[2];
#pragma unroll
    for (int i = 0; i < 2; ++i) { int R, C; stage_rc(tid * 16 + i * 8192, R, C); rselA[i] = R; cselA[i] = (unsigned)C * 2u; voffA1[i] = voffA[i]; }
    const size_t kstep = (size_t)(BK * 2);
    const size_t hstep = (size_t)HALF * K * 2;
    const size_t tstep = 2 * hstep;
    const size_t hstepA = Sched::GATHER ? (size_t)0 : hstep;
#define PG8_ROWS(_u) do { _Pragma("unroll") for (int _i = 0; _i < 2; ++_i) { voffA[_i] = S.row_off((_u), rselA[_i]) + cselA[_i]; voffA1[_i] = S.row_off((_u), HALF + rselA[_i]) + cselA[_i]; } } while (0)
    const unsigned ldsw = (unsigned)wid * 1024u;
    const int aoff = lds_byte(wr * 64 + fr, fq * 8), boff = lds_byte(wc * 32 + fr, fq * 8);
#define PG8_SA(b, h) (((b) * 2 + (h)) * HTB)
#define PG8_SB(b, h) ((4 + (b) * 2 + (h)) * HTB)
#define PG8_STAGE(bufoff, gbase, voff) do { _Pragma("unroll") for (int _i = 0; _i < 2; ++_i) \
        __builtin_amdgcn_global_load_lds((const unsigned*)((const char*)(gbase) + (voff)[_i]), (PG8_LAS unsigned*)(lds + (bufoff) + ldsw + _i * 8192), 16, 0, 0); } while (0)
#define PG8_LDA(dst, b, h) do { if constexpr (FP8) { _Pragma("unroll") for (int m = 0; m < 4; ++m) dst##8[m] = cat8(*(const PG8_LAS bf16x8*)(lds + PG8_SA(b, h) + aoff + m * 2048), *(const PG8_LAS bf16x8*)(lds + PG8_SA(b, h) + aoff + m * 2048 + 1024)); } \
        else { _Pragma("unroll") for (int m = 0; m < 4; ++m) _Pragma("unroll") for (int k = 0; k < 2; ++k) dst[m][k] = *(const PG8_LAS bf16x8*)(lds + PG8_SA(b, h) + aoff + m * 2048 + k * 1024); } } while (0)
#define PG8_LDB(dst, b, h) do { if constexpr (FP8) { _Pragma("unroll") for (int n = 0; n < 2; ++n) dst##8[n] = cat8(*(const PG8_LAS bf16x8*)(lds + PG8_SB(b, h) + boff + n * 2048), *(const PG8_LAS bf16x8*)(lds + PG8_SB(b, h) + boff + n * 2048 + 1024)); } \
        else { _Pragma("unroll") for (int n = 0; n < 2; ++n) _Pragma("unroll") for (int k = 0; k < 2; ++k) dst[n][k] = *(const PG8_LAS bf16x8*)(lds + PG8_SB(b, h) + boff + n * 2048 + k * 1024); } } while (0)
#define PG8_MMA(ai, bj, At, Bt) do { __builtin_amdgcn_s_setprio(1); if constexpr (FP8) { _Pragma("unroll") for (int m = 0; m < 4; ++m) _Pragma("unroll") for (int n = 0; n < 2; ++n) \
        asm volatile("v_mfma_scale_f32_16x16x128_f8f6f4 %0, %1, %2, %0, %3, %3 op_sel_hi:[0,0,0]" : "+v"(acc[ai][bj][m][n]) : "v"(Bt##8[n]), "v"(At##8[m]), "v"(f8scale)); } else { \
        _Pragma("unroll") for (int m = 0; m < 4; ++m) _Pragma("unroll") for (int n = 0; n < 2; ++n) _Pragma("unroll") for (int k = 0; k < 2; ++k) { \
        if constexpr (I8) acc[ai][bj][m][n] = __builtin_bit_cast(f32x4, __builtin_amdgcn_mfma_i32_16x16x64_i8(__builtin_bit_cast(v4i32, Bt[n][k]), __builtin_bit_cast(v4i32, At[m][k]), __builtin_bit_cast(v4i32, acc[ai][bj][m][n]), 0, 0, 0)); \
        else acc[ai][bj][m][n] = __builtin_amdgcn_mfma_f32_16x16x32_bf16(Bt[n][k], At[m][k], acc[ai][bj][m][n], 0, 0, 0); } } __builtin_amdgcn_s_setprio(0); } while (0)
#define PG8_WAIT_V(n) asm volatile("s_waitcnt vmcnt(" #n ")" ::: "memory")
#define PG8_WAIT_L(n) asm volatile("s_waitcnt lgkmcnt(" #n ")" ::: "memory")
#define PG8_BAR __builtin_amdgcn_s_barrier()
#define PG8_SCHED __builtin_amdgcn_sched_barrier(0)
    Unit cur, nxt; int ui = 0;
    if (!S.next(0, cur)) return;
    f32x4 acc[2][2][4][2];
#pragma unroll
    for (int a = 0; a < 2; ++a)
#pragma unroll
        for (int b = 0; b < 2; ++b)
#pragma unroll
            for (int m = 0; m < 4; ++m)
#pragma unroll
                for (int n = 0; n < 2; ++n) acc[a][b][m][n] = (f32x4){0.f, 0.f, 0.f, 0.f};
    const int f8scale = 0x7f7f7f7f;
    bf16x8 At[4][2], B0[2][2], B1[2][2]; v8i32 At8[4], B08[2], B18[2];
    const char* cA = (const char*)g.A + S.a_off(cur, tstep); const char* cB = (const char*)g.Bt + S.b_off(cur, tstep);
    S.a_ready(cur);
    if constexpr (Sched::GATHER) { S.fill_all(); asm volatile("s_waitcnt vmcnt(0) lgkmcnt(0)" ::: "memory"); __builtin_amdgcn_s_barrier(); asm volatile("" ::: "memory"); PG8_ROWS(0); }
    if constexpr (SP2) {
        PG8_STAGE(PG8_SB(0, 0), cB, voffB); PG8_STAGE(PG8_SB(0, 1), cB + hstep, voffB); PG8_STAGE(PG8_SA(0, 0), cA, voffA); PG8_STAGE(PG8_SA(0, 1), cA + hstepA, voffA1);
        if (wr == 1) PG8_BAR;
        PG8_WAIT_V(2); PG8_BAR;
        PG8_STAGE(PG8_SB(1, 0), cB + kstep, voffB); PG8_STAGE(PG8_SA(1, 0), cA + kstep, voffA); PG8_STAGE(PG8_SB(1, 1), cB + hstep + kstep, voffB);
        PG8_WAIT_V(6); PG8_BAR;
    } else {
        PG8_STAGE(PG8_SB(0, 0), cB, voffB); PG8_STAGE(PG8_SA(0, 0), cA, voffA); PG8_STAGE(PG8_SB(0, 1), cB + hstep, voffB); PG8_STAGE(PG8_SA(0, 1), cA + hstepA, voffA1);
        if (wr == 1) PG8_BAR;
        PG8_WAIT_V(4); PG8_BAR;
        PG8_STAGE(PG8_SB(1, 0), cB + kstep, voffB); PG8_STAGE(PG8_SA(1, 0), cA + kstep, voffA); PG8_STAGE(PG8_SB(1, 1), cB + hstep + kstep, voffB);
        PG8_WAIT_V(6); PG8_BAR;
    }
    for (;;) {
        const bool has_next = S.next(ui + 1, nxt);
        const char* nA = has_next ? (const char*)g.A + S.a_off(nxt, tstep) : cA; const char* nB = has_next ? (const char*)g.Bt + S.b_off(nxt, tstep) : cB;
        for (int t = 0; t < nt; t += 2) {
            const bool last = (t == nt - 2);
            const char* a1 = cA + (size_t)(t + 1) * kstep;
            const char* a2 = last ? nA : cA + (size_t)(t + 2) * kstep; const char* b2 = last ? nB : cB + (size_t)(t + 2) * kstep;
            const char* a3 = a2 + kstep; const char* b3 = b2 + kstep;
            if (last && has_next) S.a_ready(nxt);
            if constexpr (SP2) {
            PG8_LDB(B0, 0, 0); PG8_LDB(B1, 0, 1); PG8_SCHED; PG8_LDA(At, 0, 0); PG8_STAGE(PG8_SA(1, 1), a1 + hstepA, voffA1);
            PG8_WAIT_V(8); PG8_WAIT_L(0); PG8_BAR; PG8_MMA(0, 0, At, B0); PG8_MMA(0, 1, At, B1); PG8_BAR; PG8_SCHED;
            if constexpr (Sched::GATHER) { if (last && has_next) PG8_ROWS(ui + 1); }
            PG8_LDA(At, 0, 1); PG8_STAGE(PG8_SB(0, 0), b2, voffB); PG8_STAGE(PG8_SB(0, 1), b2 + hstep, voffB); PG8_STAGE(PG8_SA(0, 0), a2, voffA);
            PG8_WAIT_V(8); PG8_WAIT_L(0); PG8_BAR; PG8_MMA(1, 0, At, B0); PG8_MMA(1, 1, At, B1); PG8_BAR; PG8_SCHED;
            PG8_LDB(B0, 1, 0); PG8_LDB(B1, 1, 1); PG8_SCHED; PG8_LDA(At, 1, 0); PG8_STAGE(PG8_SA(0, 1), a2 + hstepA, voffA1);
            PG8_WAIT_V(8); PG8_WAIT_L(0); PG8_BAR; PG8_MMA(0, 0, At, B0); PG8_MMA(0, 1, At, B1); PG8_BAR; PG8_SCHED;
            PG8_LDA(At, 1, 1); PG8_STAGE(PG8_SB(1, 0), b3, voffB); PG8_STAGE(PG8_SB(1, 1), b3 + hstep, voffB); PG8_STAGE(PG8_SA(1, 0), a3, voffA);
            PG8_WAIT_V(8); PG8_WAIT_L(0); PG8_BAR; PG8_MMA(1, 0, At, B0); PG8_MMA(1, 1, At, B1); PG8_BAR; PG8_SCHED;
            } else {
            PG8_LDB(B0, 0, 0); PG8_SCHED; PG8_LDA(At, 0, 0); PG8_STAGE(PG8_SA(1, 1), a1 + hstepA, voffA1);
            PG8_WAIT_L(8); PG8_BAR; PG8_WAIT_L(0); PG8_MMA(0, 0, At, B0); PG8_BAR; PG8_SCHED;
            PG8_LDB(B1, 0, 1); PG8_STAGE(PG8_SB(0, 0), b2, voffB);
            PG8_BAR; PG8_WAIT_L(0); PG8_MMA(0, 1, At, B1); PG8_BAR;
            PG8_LDA(At, 0, 1); PG8_STAGE(PG8_SA(0, 0), a2, voffA);
            PG8_BAR; PG8_WAIT_L(0); PG8_MMA(1, 0, At, B0); PG8_BAR; PG8_SCHED;
            PG8_STAGE(PG8_SB(0, 1), b2 + hstep, voffB);
            PG8_WAIT_V(6); PG8_BAR; PG8_MMA(1, 1, At, B1); PG8_BAR;
            PG8_LDB(B0, 1, 0); PG8_SCHED; PG8_LDA(At, 1, 0); PG8_STAGE(PG8_SA(0, 1), a2 + hstepA, voffA1);
            PG8_WAIT_L(8); PG8_BAR; PG8_WAIT_L(0); PG8_MMA(0, 0, At, B0); PG8_BAR; PG8_SCHED;
            PG8_LDB(B1, 1, 1); PG8_STAGE(PG8_SB(1, 0), b3, voffB);
            PG8_BAR; PG8_WAIT_L(0); PG8_MMA(0, 1, At, B1); PG8_BAR;
            PG8_LDA(At, 1, 1); PG8_STAGE(PG8_SA(1, 0), a3, voffA);
            PG8_BAR; PG8_WAIT_L(0); PG8_MMA(1, 0, At, B0); PG8_BAR; PG8_SCHED;
            PG8_STAGE(PG8_SB(1, 1), b3 + hstep, voffB);
            PG8_WAIT_V(6); PG8_BAR; PG8_MMA(1, 1, At, B1); PG8_BAR;
            }
        }
        if constexpr (ALIGN_EPI) { if (wr == 0) PG8_BAR; }
        if constexpr (FP8) { asm volatile("s_nop 15\n\ts_nop 15" ::: "memory"); }
        if constexpr (!Epi::AFTER_DRAIN) { E(acc, cur, wr, wc, fr, fq); S.done(cur); }
        if (!has_next) break;
#pragma unroll
        for (int a = 0; a < 2; ++a)
#pragma unroll
            for (int b = 0; b < 2; ++b)
#pragma unroll
                for (int m = 0; m < 4; ++m)
#pragma unroll
                    for (int n = 0; n < 2; ++n) acc[a][b][m][n] = (f32x4){0.f, 0.f, 0.f, 0.f};
        cur = nxt; cA = nA; cB = nB; ++ui;
        if constexpr (ALIGN_EPI) { if (wr == 1) PG8_BAR; }
    }
    PG8_WAIT_V(0);
    if constexpr (!ALIGN_EPI) { if (wr == 0) PG8_BAR; }
    PG8_BAR;
    if constexpr (Epi::AFTER_DRAIN) { E.fused(acc, cur, wr, wc, fr, fq, lds, wid, lane); S.done(cur); }
#undef PG8_ROWS
#undef PG8_SA
#undef PG8_SB
#undef PG8_STAGE
#undef PG8_LDA
#undef PG8_LDB
#undef PG8_MMA
#undef PG8_WAIT_V
#undef PG8_WAIT_L
#undef PG8_BAR
#undef PG8_SCHED
}
}

#ifndef MK_N_LAUNCHES
#define MK_N_LAUNCHES 1
#endif
#define GAS __attribute__((address_space(1)))
#define LAS __attribute__((address_space(3)))
typedef unsigned short bf16;
typedef unsigned v4u __attribute__((ext_vector_type(4)));
typedef unsigned v2u __attribute__((ext_vector_type(2)));
typedef float f32x4 __attribute__((ext_vector_type(4)));
typedef float f32x2 __attribute__((ext_vector_type(2)));

constexpr int NWAVES = 8, NTHR = 512;
constexpr int NPH = 13;
constexpr int D = 2048, BATCH = 8, SEQ = 2048, T = BATCH * SEQ;
constexpr int NIN = 10696, NINP = 10752;
constexpr int MLO = 3520, GTO = 6600;
constexpr int RH = 16, RD = 1024;
constexpr int MH = 4;
constexpr int NE = 32, FF = 2048, ECAP = 16384, PMAX = 65536 + NE * 256, MTMAX = PMAX / 256;
constexpr float NORM_EPS = 1e-6f, GN_EPS = 64e-5f;
constexpr size_t MiB = 1u << 20;
constexpr size_t WS_CTL = 0, CTL_ZERO_BYTES = 1 * MiB;
constexpr size_t WS_WIN = 1 * MiB, WS_WA = 43 * MiB, WS_WB = 47 * MiB, WS_WO = 51 * MiB, WS_WL = 59 * MiB;
constexpr size_t WS_RLIST = 62 * MiB, WS_RW = 64 * MiB, WS_RWS = 2787 * MiB, WS_RA = 2787 * MiB + 512 * 1024;
constexpr size_t WS_WGU = 66 * MiB, WS_WDN = 578 * MiB, WS_HN = 834 * MiB, WS_P = 898 * MiB, WS_LIN = 1234 * MiB, WS_WAG = 1250 * MiB;
constexpr size_t WS_YRAW = 1442 * MiB, WS_HRAW = 1506 * MiB, WS_OA = 1570 * MiB, WS_OB = 1602 * MiB, WS_TMP = 1634 * MiB, WS_MRG = 1762 * MiB;
constexpr size_t WS_QKC = WS_TMP, WS_GLF = WS_TMP + 64 * MiB;
constexpr size_t WS_X1 = 1826 * MiB, WS_XB = 1954 * MiB, WS_ACT = 2242 * MiB, WS_YS = 2530 * MiB, WS_END = 2788 * MiB;
constexpr int CW_BAR = 4096;
constexpr int CW_CVNEXT = 8192, CW_P1DONE = 8192 + 64;
constexpr int NCV = 64;
constexpr int CW_COLMAX = 32768;
constexpr int CW_CNT = 16384;
constexpr int RING_BYTES = 131072, MISC_OFF = RING_BYTES, LDS_BYTES = RING_BYTES + 8192 + 20 * 1024;
constexpr int MI_TILE_E = 64, MI_TILE_I0 = 64 + 320, MI_CNT = 64 + 640, MI_POFF = MI_CNT + 32, MI_CST = MI_POFF + 32, MI_MT = MI_CST + 40, MI_ROWOFF = 2048;

#define LDS_WAIT() asm volatile("s_waitcnt lgkmcnt(0)" ::: "memory")
#define VM_WAIT() asm volatile("s_waitcnt vmcnt(0)" ::: "memory")
__device__ __forceinline__ float bf2f(bf16 v) { return __uint_as_float(((unsigned)v) << 16); }
__device__ __forceinline__ unsigned f2bf(float f) { unsigned u = __float_as_uint(f); return (u + 0x7fffu + ((u >> 16) & 1u)) >> 16; }
typedef __bf16 bf16x2_t __attribute__((ext_vector_type(2)));
__device__ __forceinline__ unsigned pk2(float lo, float hi) { const f32x2 v = {lo, hi}; const bf16x2_t b = __builtin_convertvector(v, bf16x2_t); return __builtin_bit_cast(unsigned, b); }
__device__ __forceinline__ unsigned pk4f8(float a, float b, float c, float d) { int r = 0; r = __builtin_amdgcn_cvt_pk_fp8_f32(a, b, r, false); r = __builtin_amdgcn_cvt_pk_fp8_f32(c, d, r, true); return (unsigned)r; }
constexpr float F8_SX = 8.f, F8_SW = 256.f, F8_SA = 4.f;
__device__ __forceinline__ unsigned pk4i8(float a, float b, float c, float d) {
    const int ia = (int)__builtin_rintf(a), ib = (int)__builtin_rintf(b), ic = (int)__builtin_rintf(c), id = (int)__builtin_rintf(d);
    return (unsigned)(ia & 255) | ((unsigned)(ib & 255) << 8) | ((unsigned)(ic & 255) << 16) | ((unsigned)id << 24); }
__device__ __forceinline__ float wave_max(float v) {
#pragma unroll
    for (int o = 1; o < 64; o <<= 1) v = fmaxf(v, __shfl_xor(v, o));
    return v;
}
__device__ __forceinline__ float wave_sum(float v) {
#pragma unroll
    for (int o = 1; o < 64; o <<= 1) v += __shfl_xor(v, o);
    return v;
}
#define UNP4(v) ((f32x4){__uint_as_float((v).x << 16), __uint_as_float((v).x & 0xffff0000u), __uint_as_float((v).y << 16), __uint_as_float((v).y & 0xffff0000u)})
__device__ __forceinline__ float sigm(float x) { return __builtin_amdgcn_rcpf(1.f + __expf(-x)); }
template <int CTRL> __device__ __forceinline__ float dppf(float x) { return __builtin_bit_cast(float, __builtin_amdgcn_mov_dpp(__builtin_bit_cast(int, x), CTRL, 0xf, 0xf, true)); }
__device__ __forceinline__ float allreduce16(float x) { x += dppf<0x128>(x); x += dppf<0x124>(x); x += dppf<0x4E>(x); x += dppf<0xB1>(x); return x; }

#define XB_TMO      128
#define XB_XCNT(j)  (256  + 64 * (j))
#define XB_XSUB(j)  (1280 + 64 * (j))
#define XB_XGEN(j)  (2304 + 64 * (j))
#define XB_TOP      3328
#define XB_TOPGEN   3392
#define XCD_BAR_WORDS 3456
#define XB_SPIN_CAP (1u << 18)
__device__ __forceinline__ unsigned xb_ld(unsigned* p)              { return __hip_atomic_load(p, __ATOMIC_RELAXED, __HIP_MEMORY_SCOPE_AGENT); }
__device__ __forceinline__ unsigned xb_add(unsigned* p, unsigned v) { return __hip_atomic_fetch_add(p, v, __ATOMIC_RELAXED, __HIP_MEMORY_SCOPE_AGENT); }
__device__ __forceinline__ unsigned xb_xcc_id() { return (unsigned)__builtin_amdgcn_s_getreg((3 << 11) | 20) & 0xFu; }
#define XB_SPIN(cond, bar) do { unsigned _sp = 0; while (cond) { __builtin_amdgcn_s_sleep(1); \
    if ((++_sp & 255u) == 0u) { if (xb_ld(&(bar)[XB_TMO])) break; if (_sp > XB_SPIN_CAP) { atomicAdd(&(bar)[XB_TMO], 1u); break; } } } } while (0)
struct XcdBarrier { unsigned* bar; unsigned x; volatile LAS unsigned* st; };
__device__ __forceinline__ XcdBarrier xcd_barrier_post(unsigned* bar, volatile LAS unsigned* st) {
    XcdBarrier b; b.bar = bar; b.x = xb_xcc_id(); b.st = st;
    if (threadIdx.x == 0) (void)xb_add(&bar[XB_XCNT(b.x)], 1u);
    return b;
}
__device__ __forceinline__ void xcd_barrier_complete(unsigned* bar, unsigned x, unsigned& nloc, unsigned& nx) {
    const unsigned G = gridDim.x * gridDim.y * gridDim.z;
    unsigned sum, cnt, mine, sp = 0u;
    for (;;) {
        sum = 0u; cnt = 0u; mine = 0u;
#pragma unroll
        for (unsigned j = 0; j < 16; ++j) { const unsigned c = xb_ld(&bar[XB_XCNT(j)]); sum += c; cnt += (c > 0u) ? 1u : 0u; mine = (j == x) ? c : mine; }
        if (sum == G) break;
        __builtin_amdgcn_s_sleep(1);
        if ((++sp & 255u) == 0u) { if (xb_ld(&bar[XB_TMO])) break; if (sp > XB_SPIN_CAP) { atomicAdd(&bar[XB_TMO], 1u); break; } }
    }
    nloc = mine > 0u ? mine : 1u; nx = cnt > 0u ? cnt : 1u;
}
__device__ __forceinline__ void xcd_barrier(const XcdBarrier& b) {
    asm volatile("s_waitcnt vmcnt(0)" ::: "memory");
    __syncthreads();
    if (threadIdx.x == 0) {
        unsigned* bar = b.bar;
        __builtin_amdgcn_s_waitcnt(0);
        unsigned nloc = b.st[0], nx = b.st[1];
        if (nloc == 0u) { xcd_barrier_complete(bar, b.x, nloc, nx); b.st[0] = nloc; b.st[1] = nx; }
        const unsigned old = xb_add(&bar[XB_XSUB(b.x)], 1u);
        const unsigned gen = old / nloc;
        if (old + 1u == (gen + 1u) * nloc) {
            __builtin_amdgcn_fence(__ATOMIC_RELEASE, "agent");
            asm volatile("s_waitcnt vmcnt(0)" ::: "memory");
            const unsigned og = xb_add(&bar[XB_TOP], 1u);
            const unsigned tg = og / nx;
            if (og + 1u == (tg + 1u) * nx) xb_add(&bar[XB_TOPGEN], 1u);
            else XB_SPIN(xb_ld(&bar[XB_TOPGEN]) == tg, bar);
            __builtin_amdgcn_fence(__ATOMIC_ACQUIRE, "agent");
            xb_add(&bar[XB_XGEN(b.x)], 1u);
            asm volatile("s_waitcnt vmcnt(0)" ::: "memory");
        } else {
            XB_SPIN(xb_ld(&bar[XB_XGEN(b.x)]) == gen, bar);
            __builtin_amdgcn_fence(__ATOMIC_ACQUIRE, "agent");
            asm volatile("s_waitcnt vmcnt(0)" ::: "memory");
        }
    }
    __syncthreads();
}

struct Args { const float* in[30]; float* out; unsigned char* ws; int ph_lo, ph_hi; };
enum { I_X = 0, I_N1W, I_WIN, I_BGATE, I_MU, I_W0, I_WUP, I_A0, I_AUP, I_GUP, I_KK, I_KA, I_RK, I_LNW, I_LNB, I_CONVW, I_IB, I_FB, I_MNW, I_WBA, I_WBB, I_WOUT, I_N2W, I_RTW, I_RTB, I_WGU, I_BGU, I_WDN, I_BDN, I_FNW };

struct Frame {
    LAS unsigned char* lds; volatile LAS unsigned* MISC; unsigned* ctl;
    int tid, lane, wave, G, bid;
    const float* const* in; float* out; unsigned char* ws;
};

using pg8::Unit; using pg8::HALF; using pg8::BM;
struct EpiBf16Plain {
    static constexpr bool PERM = true, AFTER_DRAIN = false;
    bf16* O; int ldc;
    __device__ __forceinline__ void operator()(const f32x4 (&acc)[2][2][4][2], const Unit& u, int wr, int wc, int fr, int fq) const {
        const int row0 = u.pm * BM + wr * 64 + fr, col0 = u.pn * BM + wc * 32 + 8 * fq;
#pragma unroll
        for (int ai = 0; ai < 2; ++ai)
#pragma unroll
            for (int m = 0; m < 4; ++m) { bf16* rowp = O + (size_t)(row0 + ai * HALF + m * 16) * ldc + col0;
#pragma unroll
                for (int bj = 0; bj < 2; ++bj) { const f32x4 v0 = acc[ai][bj][m][0], v1 = acc[ai][bj][m][1];
                    v4u w; w.x = pg8::cvt_pk_bf16(v0[0], v0[1]); w.y = pg8::cvt_pk_bf16(v0[2], v0[3]); w.z = pg8::cvt_pk_bf16(v1[0], v1[1]); w.w = pg8::cvt_pk_bf16(v1[2], v1[3]);
                    *(v4u*)(rowp + bj * HALF) = w; } }
    }
};
struct EpiP1I8 {
    static constexpr bool PERM = true, AFTER_DRAIN = false;
    bf16* O; int ldc; const float* ra; const unsigned* colmax;
    __device__ __forceinline__ void operator()(const f32x4 (&acc)[2][2][4][2], const Unit& u, int wr, int wc, int fr, int fq) const {
        const int row0 = u.pm * BM + wr * 64 + fr, col0 = u.pn * BM + wc * 32 + 8 * fq;
        f32x4 cb[2][2];
#pragma unroll
        for (int bj = 0; bj < 2; ++bj)
#pragma unroll
            for (int n = 0; n < 2; ++n) { const v4u cm = *(const v4u*)(colmax + col0 + bj * HALF + 4 * n);
                cb[bj][n] = (f32x4){__uint_as_float(cm.x), __uint_as_float(cm.y), __uint_as_float(cm.z), __uint_as_float(cm.w)} * (1.f / 127.f); }
#pragma unroll
        for (int ai = 0; ai < 2; ++ai)
#pragma unroll
            for (int m = 0; m < 4; ++m) { const int r = row0 + ai * HALF + m * 16; const float rs = ra[r]; bf16* rowp = O + (size_t)r * ldc + col0;
#pragma unroll
                for (int bj = 0; bj < 2; ++bj) { const v4u i0 = __builtin_bit_cast(v4u, acc[ai][bj][m][0]), i1 = __builtin_bit_cast(v4u, acc[ai][bj][m][1]);
                    const f32x4 v0 = (f32x4){(float)(int)i0.x, (float)(int)i0.y, (float)(int)i0.z, (float)(int)i0.w} * cb[bj][0] * rs, v1 = (f32x4){(float)(int)i1.x, (float)(int)i1.y, (float)(int)i1.z, (float)(int)i1.w} * cb[bj][1] * rs;
                    v4u w; w.x = pk2(v0[0], v0[1]); w.y = pk2(v0[2], v0[3]); w.z = pk2(v1[0], v1[1]); w.w = pk2(v1[2], v1[3]);
                    *(v4u*)(rowp + bj * HALF) = w; } }
    }
};
struct EpiLora {
    static constexpr bool PERM = false, AFTER_DRAIN = false;
    float* O; const float* w0; const float* a0;
    __device__ __forceinline__ void operator()(const f32x4 (&acc)[2][2][4][2], const Unit& u, int wr, int wc, int fr, int fq) const {
        const int row0 = u.pm * BM + wr * 64 + fr, col0 = u.pn * BM + wc * 32 + 4 * fq, seg = u.pn >> 2;
        f32x4 bv[2][2];
#pragma unroll
        for (int bj = 0; bj < 2; ++bj)
#pragma unroll
            for (int n = 0; n < 2; ++n) { const int c = col0 + bj * HALF + n * 16;
                bv[bj][n] = seg == 0 ? *(const f32x4*)(w0 + c) : (seg == 1 ? *(const f32x4*)(a0 + (c - 1024)) : (f32x4){0.f, 0.f, 0.f, 0.f}); }
#pragma unroll
        for (int ai = 0; ai < 2; ++ai)
#pragma unroll
            for (int m = 0; m < 4; ++m) { float* rowp = O + (size_t)(row0 + ai * HALF + m * 16) * 3072 + col0;
#pragma unroll
                for (int bj = 0; bj < 2; ++bj)
#pragma unroll
                    for (int n = 0; n < 2; ++n) { f32x4 v = acc[ai][bj][m][n] + bv[bj][n];
                        if (seg == 0) {
#pragma unroll
                            for (int j = 0; j < 4; ++j) v[j] = -0.6065306597126334f * sigm(v[j]); }
                        else if (seg == 1) {
#pragma unroll
                            for (int j = 0; j < 4; ++j) v[j] = sigm(v[j]); }
                        *(f32x4*)(rowp + bj * HALF + n * 16) = v; } }
    }
};
struct EpiGateA {
    static constexpr bool PERM = true, AFTER_DRAIN = false;
    float* TMP; const bf16* P; const float* bg;
    __device__ __forceinline__ void operator()(const f32x4 (&acc)[2][2][4][2], const Unit& u, int wr, int wc, int fr, int fq) const {
        const int row0 = u.pm * BM + wr * 64 + fr, col0 = u.pn * BM + wc * 32 + 8 * fq;
#pragma unroll
        for (int ai = 0; ai < 2; ++ai)
#pragma unroll
            for (int m = 0; m < 4; ++m) { const size_t r = (size_t)(row0 + ai * HALF + m * 16);
#pragma unroll
                for (int bj = 0; bj < 2; ++bj) { const int c = col0 + bj * HALF;
                    const v4u pg = *(const v4u*)(P + r * NINP + GTO + c); const f32x4 b0 = *(const f32x4*)(bg + c), b1 = *(const f32x4*)(bg + c + 4);
                    f32x4 g0, g1;
                    g0[0] = sigm(__uint_as_float(pg.x << 16) + b0[0]); g0[1] = sigm(__uint_as_float(pg.x & 0xffff0000u) + b0[1]);
                    g0[2] = sigm(__uint_as_float(pg.y << 16) + b0[2]); g0[3] = sigm(__uint_as_float(pg.y & 0xffff0000u) + b0[3]);
                    g1[0] = sigm(__uint_as_float(pg.z << 16) + b1[0]); g1[1] = sigm(__uint_as_float(pg.z & 0xffff0000u) + b1[1]);
                    g1[2] = sigm(__uint_as_float(pg.w << 16) + b1[2]); g1[3] = sigm(__uint_as_float(pg.w & 0xffff0000u) + b1[3]);
                    *(f32x4*)(TMP + r * D + c) = g0 * acc[ai][bj][m][0]; *(f32x4*)(TMP + r * D + c + 4) = g1 * acc[ai][bj][m][1]; } }
    }
};
struct EpiGateB {
    static constexpr bool PERM = true, AFTER_DRAIN = false;
    const float* TMP; bf16* MRG; const bf16* P; const float* bg;
    __device__ __forceinline__ void operator()(const f32x4 (&acc)[2][2][4][2], const Unit& u, int wr, int wc, int fr, int fq) const {
        const int row0 = u.pm * BM + wr * 64 + fr, col0 = u.pn * BM + wc * 32 + 8 * fq;
#pragma unroll
        for (int ai = 0; ai < 2; ++ai)
#pragma unroll
            for (int m = 0; m < 4; ++m) { const size_t r = (size_t)(row0 + ai * HALF + m * 16);
#pragma unroll
                for (int bj = 0; bj < 2; ++bj) { const int c = col0 + bj * HALF;
                    const v4u pg = *(const v4u*)(P + r * NINP + GTO + D + c); const f32x4 b0 = *(const f32x4*)(bg + D + c), b1 = *(const f32x4*)(bg + D + c + 4);
                    const f32x4 t0 = *(const f32x4*)(TMP + r * D + c), t1 = *(const f32x4*)(TMP + r * D + c + 4);
                    f32x4 g0, g1;
                    g0[0] = sigm(__uint_as_float(pg.x << 16) + b0[0]); g0[1] = sigm(__uint_as_float(pg.x & 0xffff0000u) + b0[1]);
                    g0[2] = sigm(__uint_as_float(pg.y << 16) + b0[2]); g0[3] = sigm(__uint_as_float(pg.y & 0xffff0000u) + b0[3]);
                    g1[0] = sigm(__uint_as_float(pg.z << 16) + b1[0]); g1[1] = sigm(__uint_as_float(pg.z & 0xffff0000u) + b1[1]);
                    g1[2] = sigm(__uint_as_float(pg.w << 16) + b1[2]); g1[3] = sigm(__uint_as_float(pg.w & 0xffff0000u) + b1[3]);
                    const f32x4 v0 = t0 + g0 * acc[ai][bj][m][0], v1 = t1 + g1 * acc[ai][bj][m][1];
                    v4u w; w.x = pg8::cvt_pk_bf16(v0[0], v0[1]); w.y = pg8::cvt_pk_bf16(v0[2], v0[3]); w.z = pg8::cvt_pk_bf16(v1[0], v1[1]); w.w = pg8::cvt_pk_bf16(v1[2], v1[3]);
                    *(v4u*)(MRG + r * D + c) = w; } }
    }
};
struct EpiResid {
    static constexpr bool PERM = false, AFTER_DRAIN = false;
    const float* X; float* O;
    __device__ __forceinline__ void operator()(const f32x4 (&acc)[2][2][4][2], const Unit& u, int wr, int wc, int fr, int fq) const {
        const int row0 = u.pm * BM + wr * 64 + fr, col0 = u.pn * BM + wc * 32 + 4 * fq;
#pragma unroll
        for (int ai = 0; ai < 2; ++ai)
#pragma unroll
            for (int m = 0; m < 4; ++m) { const size_t off = (size_t)(row0 + ai * HALF + m * 16) * D + col0;
#pragma unroll
                for (int bj = 0; bj < 2; ++bj)
#pragma unroll
                    for (int n = 0; n < 2; ++n) *(f32x4*)(O + off + bj * HALF + n * 16) = *(const f32x4*)(X + off + bj * HALF + n * 16) + acc[ai][bj][m][n]; }
    }
};
struct MoeOrder : pg8::StaticOrder {
    const LAS int* tile_e; size_t estride;
    __device__ __forceinline__ size_t b_off(const Unit& u, size_t tstep) const { return (size_t)tile_e[u.pm] * estride + (size_t)u.pn * tstep; }
};
struct MoeGatherOrder : MoeOrder {
    static constexpr bool GATHER = true;
    const LAS int* tile_i0; const LAS int* cnt; const int* rlist; LAS unsigned* rowoff; unsigned rowbytes;
    __device__ __forceinline__ size_t a_off(const Unit&, size_t) const { return 0; }
    __device__ __forceinline__ void fill_all() const { const int tid = threadIdx.x, r = tid & 255;
        for (int u0 = tid >> 8; ; u0 += 6) { Unit ua, ub, uc; const bool va = next(u0, ua), vb = next(u0 + 2, ub), vc = next(u0 + 4, uc); if (!va) break;
            int ta = 0, tb = 0, tc = 0;
            { const int e = tile_e[ua.pm], i = tile_i0[ua.pm] + r; if (i < cnt[e]) ta = rlist[e * ECAP + i]; }
            if (vb) { const int e = tile_e[ub.pm], i = tile_i0[ub.pm] + r; if (i < cnt[e]) tb = rlist[e * ECAP + i]; }
            if (vc) { const int e = tile_e[uc.pm], i = tile_i0[uc.pm] + r; if (i < cnt[e]) tc = rlist[e * ECAP + i]; }
            rowoff[u0 * 256 + r] = (unsigned)(ta >> 2) * rowbytes; if (vb) rowoff[(u0 + 2) * 256 + r] = (unsigned)(tb >> 2) * rowbytes; if (vc) rowoff[(u0 + 4) * 256 + r] = (unsigned)(tc >> 2) * rowbytes; } }
    __device__ __forceinline__ unsigned row_off(int ui, int r) const { return rowoff[ui * 256 + r]; }
};
struct EpiSwiGLU {
    static constexpr bool PERM = true, AFTER_DRAIN = false;
    unsigned char* ACT; const float* bgu; const LAS int* tile_e;
    __device__ __forceinline__ void operator()(const f32x4 (&acc)[2][2][4][2], const Unit& u, int wr, int wc, int fr, int fq) const {
        const int row0 = u.pm * BM + wr * 64 + fr, colg = u.pn * 128 + wc * 32 + 8 * fq; const int e = tile_e[u.pm];
        const float* bp = bgu + (size_t)e * 4096 + colg;
        const f32x4 bg0 = *(const f32x4*)(bp), bg1 = *(const f32x4*)(bp + 4), bu0 = *(const f32x4*)(bp + 2048), bu1 = *(const f32x4*)(bp + 2052);
#pragma unroll
        for (int ai = 0; ai < 2; ++ai)
#pragma unroll
            for (int m = 0; m < 4; ++m) { const size_t r = (size_t)(row0 + ai * HALF + m * 16);
                constexpr float DS = 1.f / (F8_SX * F8_SW);
                const f32x4 ga = acc[ai][0][m][0] * DS + bg0, gb = acc[ai][0][m][1] * DS + bg1, ua = acc[ai][1][m][0] * DS + bu0, ub = acc[ai][1][m][1] * DS + bu1;
                float o[8];
#pragma unroll
                for (int j = 0; j < 4; ++j) { const float g = fminf(ga[j], 7.f), up = fminf(fmaxf(ua[j], -7.f), 7.f); o[j] = F8_SA * (up + 1.f) * g * sigm(1.702f * g);
                                              const float g2 = fminf(gb[j], 7.f), up2 = fminf(fmaxf(ub[j], -7.f), 7.f); o[4 + j] = F8_SA * (up2 + 1.f) * g2 * sigm(1.702f * g2); }
                v2u w; w.x = pk4f8(o[0], o[1], o[2], o[3]); w.y = pk4f8(o[4], o[5], o[6], o[7]);
                *(v2u*)(ACT + r * FF + colg) = w; }
    }
};
struct EpiDown {
    static constexpr bool PERM = true, AFTER_DRAIN = false;
    bf16* YS; const float* bdn; const LAS int* tile_e; const LAS int* rowdst; const LAS float* rowwt;
    __device__ __forceinline__ void operator()(const f32x4 (&acc)[2][2][4][2], const Unit& u, int wr, int wc, int fr, int fq) const {
        const int e = tile_e[u.pm]; const int col0 = u.pn * BM + wc * 32 + 8 * fq;
        const float* bp = bdn + (size_t)e * D + col0; constexpr float DS = 1.f / (F8_SA * F8_SW);
#pragma unroll
        for (int bj = 0; bj < 2; ++bj) { const f32x4 b0 = *(const f32x4*)(bp + bj * HALF), b1 = *(const f32x4*)(bp + bj * HALF + 4);
#pragma unroll
            for (int ai = 0; ai < 2; ++ai)
#pragma unroll
                for (int m = 0; m < 4; ++m) { const int r = u.ord * 256 + ai * HALF + wr * 64 + m * 16 + fr;
                    const int dst = rowdst[r]; const float w = rowwt[r];
                    const f32x4 v0 = (acc[ai][bj][m][0] * DS + b0) * w, v1 = (acc[ai][bj][m][1] * DS + b1) * w;
                    v4u o; o.x = pg8::cvt_pk_bf16(v0[0], v0[1]); o.y = pg8::cvt_pk_bf16(v0[2], v0[3]); o.z = pg8::cvt_pk_bf16(v1[0], v1[1]); o.w = pg8::cvt_pk_bf16(v1[2], v1[3]);
                    *(v4u*)(YS + (size_t)dst * D + col0 + bj * HALF) = o; } }
    }
};
template <class Sched> __device__ __forceinline__ void fill_down_tables(Frame& F, const Sched& S, LAS int* rowdst, LAS float* rowwt) {
    const LAS int* MI = (const LAS int*)F.MISC; const int* rlist = (const int*)(F.ws + WS_RLIST); const float* rw = (const float*)(F.ws + WS_RW);
    const int r = F.tid & 255;
    for (int u0 = F.tid >> 8; ; u0 += 4) { Unit ua, ub; const bool va = S.next(u0, ua), vb = S.next(u0 + 2, ub); if (!va) break;
        int da = T * 4, db = T * 4; float wa = 0.f, wb = 0.f;
        { const int e = MI[MI_TILE_E + ua.pm], i = MI[MI_TILE_I0 + ua.pm] + r; if (i < MI[MI_CNT + e]) { da = rlist[e * ECAP + i]; wa = rw[e * ECAP + i]; } }
        if (vb) { const int e = MI[MI_TILE_E + ub.pm], i = MI[MI_TILE_I0 + ub.pm] + r; if (i < MI[MI_CNT + e]) { db = rlist[e * ECAP + i]; wb = rw[e * ECAP + i]; } }
        rowdst[u0 * 256 + r] = da; rowwt[u0 * 256 + r] = wa; if (vb) { rowdst[(u0 + 2) * 256 + r] = db; rowwt[(u0 + 2) * 256 + r] = wb; } }
    __syncthreads();
}

__device__ __forceinline__ void transpose_item(const float* __restrict__ W, int N, int k0, int n0, bf16* WT, int dst_row0, int ldk, LAS float* scr, int lane) {
    const int n = n0 + (lane & 31); const bool ok = n < N;
#pragma unroll 8
    for (int i = 0; i < 32; ++i) { const int kk = 2 * i + (lane >> 5); scr[kk * 33 + (lane & 31)] = ok ? W[(size_t)(k0 + kk) * N + n] : 0.f; }
    LDS_WAIT(); asm volatile("" ::: "memory");
    const int c = lane & 7;
#pragma unroll
    for (int j = 0; j < 4; ++j) { const int nn = (lane >> 3) + 8 * j; const LAS float* s = scr + (8 * c) * 33 + nn;
        v4u o; o.x = pk2(s[0 * 33], s[1 * 33]); o.y = pk2(s[2 * 33], s[3 * 33]); o.z = pk2(s[4 * 33], s[5 * 33]); o.w = pk2(s[6 * 33], s[7 * 33]);
        *(v4u*)(WT + (size_t)(dst_row0 + nn) * ldk + k0 + 8 * c) = o; }
    LDS_WAIT(); asm volatile("" ::: "memory");
}
__device__ __forceinline__ void transpose_item_i8(const float* __restrict__ W, int N, int k0, int n0, unsigned char* WT, int dst_row0, int ldk, const unsigned* colmax, LAS float* scr, int lane) {
    const int n = n0 + (lane & 31); const bool ok = n < N;
#pragma unroll 8
    for (int i = 0; i < 32; ++i) { const int kk = 2 * i + (lane >> 5); scr[kk * 33 + (lane & 31)] = ok ? W[(size_t)(k0 + kk) * N + n] : 0.f; }
    LDS_WAIT(); asm volatile("" ::: "memory");
#pragma unroll
    for (int j = 0; j < 2; ++j) { const int ch = lane + 64 * j, nn = ch >> 2, c = ch & 3; const LAS float* s = scr + (16 * c) * 33 + nn;
        const float cm = __uint_as_float(colmax[n0 + nn]); const float sc = cm > 0.f ? 127.f / cm : 0.f;
        v4u o; o.x = pk4i8(s[0 * 33] * sc, s[1 * 33] * sc, s[2 * 33] * sc, s[3 * 33] * sc); o.y = pk4i8(s[4 * 33] * sc, s[5 * 33] * sc, s[6 * 33] * sc, s[7 * 33] * sc);
        o.z = pk4i8(s[8 * 33] * sc, s[9 * 33] * sc, s[10 * 33] * sc, s[11 * 33] * sc); o.w = pk4i8(s[12 * 33] * sc, s[13 * 33] * sc, s[14 * 33] * sc, s[15 * 33] * sc);
        *(v4u*)(WT + (size_t)(dst_row0 + nn) * ldk + k0 + 16 * c) = o; }
    LDS_WAIT(); asm volatile("" ::: "memory");
}
__device__ __forceinline__ void p0b_win(Frame& F) {
    LAS float* scr = (LAS float*)(F.lds + F.wave * 16384);
    const int gw = F.bid * NWAVES + F.wave, NGW = F.G * NWAVES; unsigned char* WIN8 = F.ws + WS_WIN; const unsigned* colmax = F.ctl + CW_COLMAX;
    constexpr int NB_WIN = (NIN + 31) / 32;
    for (int it = gw; it < 32 * NB_WIN; it += NGW) { const int kb = it / NB_WIN, nb = it % NB_WIN; transpose_item_i8(F.in[I_WIN], NIN, kb * 64, nb * 32, WIN8, nb * 32, D, colmax, scr, F.lane); }
    { const int gt = F.bid * NTHR + F.tid, NGT = F.G * NTHR; constexpr int Z0 = NB_WIN * 32 * D, Z1 = NINP * D;
      for (int i = Z0 + gt * 16; i < Z1; i += NGT * 16) *(v4u*)(WIN8 + i) = (v4u){0u, 0u, 0u, 0u}; }
}
__device__ __forceinline__ void p0_prologue(Frame& F) {
    LAS float* scr = (LAS float*)(F.lds + F.wave * 16384);
    const int gw = F.bid * NWAVES + F.wave, NGW = F.G * NWAVES;
    bf16* WIN_T = (bf16*)(F.ws + WS_WIN); bf16* WA_T = (bf16*)(F.ws + WS_WA); bf16* WB_T = (bf16*)(F.ws + WS_WB); bf16* WO_T = (bf16*)(F.ws + WS_WO);
    bf16* WGU_T = (bf16*)(F.ws + WS_WGU); bf16* WDN_T = (bf16*)(F.ws + WS_WDN); bf16* WL_T = (bf16*)(F.ws + WS_WL); bf16* HN = (bf16*)(F.ws + WS_HN);
    { const float* W = F.in[I_WIN]; unsigned* colmax = F.ctl + CW_COLMAX;
      for (int task = gw; task < 168 * 12; task += NGW) { const int cb = task % 168, kc = task / 168, n = cb * 64 + F.lane, k_lo = kc * 171, k_hi = (k_lo + 171 < D) ? k_lo + 171 : D; float m = 0.f;
          if (n < NIN) {
#pragma unroll 8
              for (int k = k_lo; k < k_hi; ++k) m = fmaxf(m, fabsf(W[(size_t)k * NIN + n]));
              atomicMax(colmax + n, __float_as_uint(m)); } } }
    { const int gt = F.bid * NTHR + F.tid, NGT = F.G * NTHR;
      for (int i = gt; i < 3072 * 512; i += NGT) { const int n = i >> 9, k = i & 511; float v = 0.f;
          if (n < 1024) { if (k < 96) v = F.in[I_WUP][k * RD + n]; }
          else if (n < 2048) { if (k >= 128 && k < 224) v = F.in[I_AUP][(k - 128) * RD + (n - 1024)]; }
          else { if (k >= 256) v = F.in[I_GUP][(k - 256) * RD + (n - 2048)]; }
          WL_T[i] = (bf16)f2bf(v); } }
    { const int gt = F.bid * NTHR + F.tid, NGT = F.G * NTHR; float* RWS = (float*)(F.ws + WS_RWS);
      for (int i = gt; i < D * NE; i += NGT) RWS[i] = F.in[I_N2W][i >> 5] * F.in[I_RTW][i]; }
    const float* x = F.in[I_X]; const float* nw = F.in[I_N1W];
    for (int m = gw; m < T; m += NGW) {
        const f32x4* xr = (const f32x4*)(x + (size_t)m * D) + F.lane; f32x4 v[8]; float s = 0.f;
#pragma unroll
        for (int j = 0; j < 8; ++j) { v[j] = xr[64 * j]; s += (v[j][0] * v[j][0] + v[j][1] * v[j][1]) + (v[j][2] * v[j][2] + v[j][3] * v[j][3]); }
        const float rstd = __builtin_amdgcn_rsqf(wave_sum(s) * (1.f / D) + NORM_EPS);
        float am = 0.f;
#pragma unroll
        for (int j = 0; j < 8; ++j) { const f32x4 w = ((const f32x4*)nw)[F.lane + 64 * j]; v[j] = v[j] * rstd * w; am = fmaxf(fmaxf(am, fmaxf(fabsf(v[j][0]), fabsf(v[j][1]))), fmaxf(fabsf(v[j][2]), fabsf(v[j][3]))); }
        am = wave_max(am); const float sc = am > 0.f ? 127.f / am : 0.f;
        if (F.lane == 0) ((float*)(F.ws + WS_RA))[m] = am * (1.f / 127.f);
        unsigned* o4 = (unsigned*)((unsigned char*)HN + (size_t)m * D) + F.lane;
#pragma unroll
        for (int j = 0; j < 8; ++j) o4[64 * j] = pk4i8(v[j][0] * sc, v[j][1] * sc, v[j][2] * sc, v[j][3] * sc);
    }
}

__device__ __forceinline__ void p2_lora_in(Frame& F) {
    const bf16* __restrict__ P = (const bf16*)(F.ws + WS_P); bf16* __restrict__ LIN = (bf16*)(F.ws + WS_LIN); const float* __restrict__ mu = F.in[I_MU];
    const int gt = F.bid * NTHR + F.tid, NGT = F.G * NTHR;
#pragma unroll 2
    for (int i = gt; i < T * 64; i += NGT) { const int t = i >> 6, g = i & 63; int col = -1, kind = 0;
        if (g < 12) { col = 3072 + 8 * g; kind = 0; } else if (g >= 16 && g < 28) { col = 3168 + 8 * (g - 16); kind = 1; } else if (g >= 32) { col = 3264 + 8 * (g - 32); kind = 2; }
        v4u o = (v4u){0u, 0u, 0u, 0u};
        if (col >= 0) { const v4u pc = *(const v4u*)(P + (size_t)t * NINP + col); v4u pp = (v4u){0u, 0u, 0u, 0u}; if (t & (SEQ - 1)) pp = *(const v4u*)(P + (size_t)(t - 1) * NINP + col);
            const f32x4 m0 = *(const f32x4*)(mu + col), m1 = *(const f32x4*)(mu + col + 4);
            const unsigned pcs[4] = {pc.x, pc.y, pc.z, pc.w}, pps[4] = {pp.x, pp.y, pp.z, pp.w}; float x[8];
#pragma unroll
            for (int k = 0; k < 4; ++k) { const float c0 = __uint_as_float(pcs[k] << 16), c1 = __uint_as_float(pcs[k] & 0xffff0000u), q0 = __uint_as_float(pps[k] << 16), q1 = __uint_as_float(pps[k] & 0xffff0000u);
                const float ma = k < 2 ? m0[2 * k] : m1[2 * k - 4], mb = k < 2 ? m0[2 * k + 1] : m1[2 * k - 3];
                x[2 * k] = c0 + (q0 - c0) * ma; x[2 * k + 1] = c1 + (q1 - c1) * mb; }
#pragma unroll
            for (int k = 0; k < 8; ++k) x[k] = kind == 0 ? tanhf(x[k]) : (kind == 1 ? x[k] : sigm(x[k]));
            o.x = pk2(x[0], x[1]); o.y = pk2(x[2], x[3]); o.z = pk2(x[4], x[5]); o.w = pk2(x[6], x[7]); }
        *(v4u*)(LIN + (size_t)t * 512 + 8 * g) = o; }
    { bf16* __restrict__ QKC = (bf16*)(F.ws + WS_QKC); const float* __restrict__ cw = F.in[I_CONVW];
      for (int i = gt; i < T * 128; i += NGT) { const int t = i >> 7, c0 = 8 * (i & 127); const int sq = t & (SEQ - 1); float acc[8];
#pragma unroll
          for (int k = 0; k < 8; ++k) acc[k] = 0.f;
#pragma unroll
          for (int j = 0; j < 4; ++j) { if (sq - 3 + j >= 0) { const v4u pv = *(const v4u*)(P + (size_t)(t - 3 + j) * NINP + MLO + c0); const f32x4 w0 = *(const f32x4*)(cw + j * 1024 + c0), w1 = *(const f32x4*)(cw + j * 1024 + c0 + 4);
                  acc[0] += __uint_as_float(pv.x << 16) * w0[0]; acc[1] += __uint_as_float(pv.x & 0xffff0000u) * w0[1]; acc[2] += __uint_as_float(pv.y << 16) * w0[2]; acc[3] += __uint_as_float(pv.y & 0xffff0000u) * w0[3];
                  acc[4] += __uint_as_float(pv.z << 16) * w1[0]; acc[5] += __uint_as_float(pv.z & 0xffff0000u) * w1[1]; acc[6] += __uint_as_float(pv.w << 16) * w1[2]; acc[7] += __uint_as_float(pv.w & 0xffff0000u) * w1[3]; } }
          const float sc = c0 < 512 ? 0.08838834764831845f : 1.f;
#pragma unroll
          for (int k = 0; k < 8; ++k) acc[k] = acc[k] * sigm(acc[k]) * sc;
          v4u o; o.x = pk2(acc[0], acc[1]); o.y = pk2(acc[2], acc[3]); o.z = pk2(acc[4], acc[5]); o.w = pk2(acc[6], acc[7]); *(v4u*)(QKC + (size_t)t * 1024 + c0) = o; } }
    { float* __restrict__ GLF = (float*)(F.ws + WS_GLF); const int gw = F.bid * NWAVES + F.wave, NGW = F.G * NWAVES, lane = F.lane;
      for (int q = gw; q < (T / 64) * 4; q += NGW) { const int chk = q >> 2, mh = q & 3; const size_t t = (size_t)chk * 64 + lane; const bf16* pr = P + t * NINP + MLO + 2048;
          const float ip = 15.f * tanhf((bf2f(pr[mh]) + F.in[I_IB][mh]) * (1.f / 15.f)), fp = 15.f * tanhf((bf2f(pr[4 + mh]) + F.in[I_FB][mh]) * (1.f / 15.f));
          float bc = fminf(fp, 0.f) - log1pf(__expf(-fabsf(fp)));
#pragma unroll
          for (int o = 1; o < 64; o <<= 1) { const float t_ = __shfl_up(bc, o); if (lane >= o) bc += t_; }
          const float u = ip - bc; float pm = u;
#pragma unroll
          for (int o = 1; o < 64; o <<= 1) { const float t_ = __shfl_up(pm, o); if (lane >= o) pm = fmaxf(pm, t_); }
          *(f32x4*)(GLF + t * 16 + 4 * mh) = (f32x4){bc, u, pm, 0.f}; } }
}

typedef short s16x8 __attribute__((ext_vector_type(8)));
typedef short s16x4 __attribute__((ext_vector_type(4)));
__device__ __forceinline__ unsigned long long pack4bf(f32x4 v) { return (unsigned long long)pk2(v[0], v[1]) | ((unsigned long long)pk2(v[2], v[3]) << 32); }
__device__ __forceinline__ s16x8 tr_frag(const LAS bf16* img, int stride, int r0, int c0, int fr) {
    const LAS bf16* p0 = img + (r0 + (fr >> 2)) * stride + c0 + 4 * (fr & 3);
    const s16x4 lo = __builtin_bit_cast(s16x4, __builtin_amdgcn_ds_read_tr16_b64_v4i16((LAS s16x4*)p0));
    const s16x4 hi = __builtin_bit_cast(s16x4, __builtin_amdgcn_ds_read_tr16_b64_v4i16((LAS s16x4*)(p0 + 4 * stride)));
    return __builtin_shufflevector(lo, hi, 0, 1, 2, 3, 4, 5, 6, 7);
}

__device__ __forceinline__ void rw_bar(LAS unsigned* cnt, unsigned& target, int lane);
__device__ __forceinline__ void rwkv_chunk_unit(Frame& F, int unit, LAS unsigned char* regB, LAS unsigned* bcnt, unsigned& btarget) {
    const int b = unit >> 5, h = (unit >> 1) & 15, half = unit & 1;
    const bf16* P = (const bf16*)(F.ws + WS_P); const float* WAG = (const float*)(F.ws + WS_WAG); float* YRAW = (float*)(F.ws + WS_YRAW);
    constexpr int KS = 72, LS = 40;
    LAS bf16* At = (LAS bf16*)F.lds; LAS bf16* Bt = At + 32 * KS; LAS bf16* Kt = Bt + 32 * KS; LAS bf16* Rt = Kt + 32 * KS;
    LAS bf16* Vv = Rt + 32 * KS;
    LAS bf16* Sb = Vv + 32 * LS;
    LAS bf16* G2b = Sb + 32 * KS; LAS bf16* G3b = G2b + 32 * LS; LAS bf16* G4b = G3b + 32 * LS;
    LAS bf16* Pwb = G4b + 32 * LS;
    LAS bf16* Acb = Pwb + 2 * 32 * LS;
    LAS bf16* RHt = (LAS bf16*)regB;
    LAS bf16* Ubt = RHt + 32 * LS;
    LAS float* lwf = (LAS float*)(Ubt + 32 * LS);
    LAS float* csf = lwf + 2048;
    LAS float* gtf = csf + 2048;
    LAS float* glf = gtf + 256;
    const int tid = F.tid, lane = F.lane, w = F.wave, fr = lane & 15, fq = lane >> 4;
    const int ts = tid >> 4, cs = tid & 15, c0 = h * 64 + 4 * cs;
    const int sk = tid & 63, sq = tid >> 6;
    const f32x4 mu_r = *(const f32x4*)(F.in[I_MU] + c0), mu_k = *(const f32x4*)(F.in[I_MU] + 1024 + c0), mu_v = *(const f32x4*)(F.in[I_MU] + 2048 + c0);
    const f32x4 kkc = *(const f32x4*)(F.in[I_KK] + c0), kac = *(const f32x4*)(F.in[I_KA] + c0);
    for (int i = tid; i < 32 * KS; i += 256) Sb[i] = 0;
    v2u cr[2], ck[2], cv[2], qr[2], qk[2], qv[2]; f32x4 w4[2], a4[2];
#define RC_LOAD(ch) do { _Pragma("unroll") for (int p_ = 0; p_ < 2; ++p_) { const int t_ = (ch) * 32 + ts + 16 * p_; const size_t tk_ = (size_t)b * SEQ + t_; const bf16* pr_ = P + tk_ * NINP + c0; \
        cr[p_] = *(const v2u*)(pr_); ck[p_] = *(const v2u*)(pr_ + 1024); cv[p_] = *(const v2u*)(pr_ + 2048); \
        if (t_ > 0) { qr[p_] = *(const v2u*)(pr_ - NINP); qk[p_] = *(const v2u*)(pr_ - NINP + 1024); qv[p_] = *(const v2u*)(pr_ - NINP + 2048); } else { qr[p_] = (v2u){0u, 0u}; qk[p_] = qr[p_]; qv[p_] = qr[p_]; } \
        w4[p_] = *(const f32x4*)(WAG + tk_ * 3072 + c0); a4[p_] = *(const f32x4*)(WAG + tk_ * 3072 + 1024 + c0); } } while (0)
    const int mi = w >> 1, nj = w & 1;
    f32x4 st[2]; st[0] = (f32x4){0.f, 0.f, 0.f, 0.f}; st[1] = st[0];
    RC_LOAD(0);
    rw_bar(bcnt, btarget, lane);
    for (int ch = 0; ch < SEQ / 32; ++ch) {
        f32x4 rr[2], kmod[2], vv[2], kkn[2], lw[2], al[2];
#pragma unroll
        for (int p_ = 0; p_ < 2; ++p_) { const f32x4 pr4 = UNP4(cr[p_]), pk4 = UNP4(ck[p_]), pv4 = UNP4(cv[p_]), qr4 = UNP4(qr[p_]), qk4 = UNP4(qk[p_]), qv4 = UNP4(qv[p_]); lw[p_] = w4[p_]; al[p_] = a4[p_];
            rr[p_] = pr4 + (qr4 - pr4) * mu_r; const f32x4 k1 = pk4 + (qk4 - pk4) * mu_k; vv[p_] = pv4 + (qv4 - pv4) * mu_v;
            const f32x4 kkr = k1 * kkc; const float nrm = __builtin_amdgcn_rsqf(fmaxf(allreduce16((kkr[0] * kkr[0] + kkr[1] * kkr[1]) + (kkr[2] * kkr[2] + kkr[3] * kkr[3])), 1e-24f));
            kkn[p_] = kkr * nrm; kmod[p_] = k1 * (1.f + (al[p_] - 1.f) * kac);
            *(LAS f32x4*)(lwf + (ts + 16 * p_) * 64 + 4 * cs) = lw[p_]; }
        if (ch + 1 < SEQ / 32) RC_LOAD(ch + 1);
        rw_bar(bcnt, btarget, lane);
        float cc[8];
#pragma unroll
        for (int i = 0; i < 8; ++i) cc[i] = lwf[(8 * sq + i) * 64 + sk] + (i ? cc[i - 1] : 0.f);
        gtf[sq * 64 + sk] = cc[7];
        rw_bar(bcnt, btarget, lane);
        { float off = 0.f;
#pragma unroll
          for (int q = 0; q < 3; ++q) off += (q < sq) ? gtf[q * 64 + sk] : 0.f;
#pragma unroll
          for (int i = 0; i < 8; ++i) csf[(8 * sq + i) * 64 + sk] = off + cc[i]; }
        rw_bar(bcnt, btarget, lane);
#pragma unroll
        for (int p_ = 0; p_ < 2; ++p_) { const int t = ts + 16 * p_; const f32x4 cg = *(const LAS f32x4*)(csf + t * 64 + 4 * cs); f32x4 g, gp, gi;
#pragma unroll
          for (int j = 0; j < 4; ++j) { g[j] = __expf(cg[j]); gp[j] = __expf(cg[j] - lw[p_][j]); gi[j] = __expf(-cg[j]); }
          *(LAS unsigned long long*)(At + t * KS + 4 * cs) = pack4bf(-(kkn[p_] * gp)); *(LAS unsigned long long*)(Bt + t * KS + 4 * cs) = pack4bf(kkn[p_] * al[p_] * gi);
          *(LAS unsigned long long*)(Kt + t * KS + 4 * cs) = pack4bf(kmod[p_] * gi); *(LAS unsigned long long*)(Rt + t * KS + 4 * cs) = pack4bf(rr[p_] * g);
          if ((cs >> 3) == half) *(LAS unsigned long long*)(Vv + t * LS + 4 * (cs & 7)) = pack4bf(vv[p_]);
          if (t == 31) *(LAS f32x4*)(glf + 4 * cs) = g; }
        rw_bar(bcnt, btarget, lane);
        f32x4 accT, pwT;
        { const int t = 16 * mi + fr, jb = 16 * nj + 4 * fq;
          f32x4 g1 = (f32x4){0.f, 0.f, 0.f, 0.f}, g2 = g1, g3 = g1, g4 = g1;
#pragma unroll
          for (int ks = 0; ks < 2; ++ks) { const s16x8 bj = *(const LAS s16x8*)(Bt + (16 * nj + fr) * KS + 32 * ks + 8 * fq), kj = *(const LAS s16x8*)(Kt + (16 * nj + fr) * KS + 32 * ks + 8 * fq);
              const s16x8 at = *(const LAS s16x8*)(At + (16 * mi + fr) * KS + 32 * ks + 8 * fq), rt = *(const LAS s16x8*)(Rt + (16 * mi + fr) * KS + 32 * ks + 8 * fq);
              g1 = __builtin_amdgcn_mfma_f32_16x16x32_bf16(bj, at, g1, 0, 0, 0); g2 = __builtin_amdgcn_mfma_f32_16x16x32_bf16(kj, at, g2, 0, 0, 0);
              g3 = __builtin_amdgcn_mfma_f32_16x16x32_bf16(bj, rt, g3, 0, 0, 0); g4 = __builtin_amdgcn_mfma_f32_16x16x32_bf16(kj, rt, g4, 0, 0, 0); }
#pragma unroll
          for (int rg_ = 0; rg_ < 4; ++rg_) { const int j = jb + rg_; g1[rg_] = (j < t) ? g1[rg_] : 0.f; g2[rg_] = (j < t) ? g2[rg_] : 0.f; g3[rg_] = (j <= t) ? g3[rg_] : 0.f; g4[rg_] = (j <= t) ? g4[rg_] : 0.f; }
          pwT = g1; *(LAS unsigned long long*)(Pwb + t * LS + jb) = pack4bf(g1);
#pragma unroll
          for (int rg_ = 0; rg_ < 4; ++rg_) accT[rg_] = g1[rg_] + ((jb + rg_ == t) ? 1.f : 0.f);
          *(LAS unsigned long long*)(Acb + 32 * LS + t * LS + jb) = pack4bf(accT);
          *(LAS unsigned long long*)(G2b + t * LS + jb) = pack4bf(g2); *(LAS unsigned long long*)(G3b + t * LS + jb) = pack4bf(g3); *(LAS unsigned long long*)(G4b + t * LS + jb) = pack4bf(g4); }
        rw_bar(bcnt, btarget, lane);
        f32x4 yv = (f32x4){0.f, 0.f, 0.f, 0.f};
#pragma unroll
        for (int s = 0; s < 5; ++s) { const LAS bf16* Pr = Pwb + (s & 1) * 32 * LS; LAS bf16* Pn = Pwb + ((s + 1) & 1) * 32 * LS; const LAS bf16* Ar = Acb + (s & 1) * 32 * LS; LAS bf16* An = Acb + ((s + 1) & 1) * 32 * LS;
            const s16x8 xrow = *(const LAS s16x8*)(Pr + (16 * mi + fr) * LS + 8 * fq);
            if (s < 4) { f32x4 z = (f32x4){0.f, 0.f, 0.f, 0.f}; z = __builtin_amdgcn_mfma_f32_16x16x32_bf16(tr_frag(Pr, LS, 8 * fq, 16 * nj, fr), xrow, z, 0, 0, 0);
                         *(LAS unsigned long long*)(Pn + (16 * mi + fr) * LS + 16 * nj + 4 * fq) = pack4bf(z); }
            if (s >= 1) { accT = __builtin_amdgcn_mfma_f32_16x16x32_bf16(tr_frag(Ar, LS, 8 * fq, 16 * nj, fr), xrow, accT, 0, 0, 0);
                          *(LAS unsigned long long*)(An + (16 * mi + fr) * LS + 16 * nj + 4 * fq) = pack4bf(accT); }
            if (s == 0) {
                f32x4 z = (f32x4){0.f, 0.f, 0.f, 0.f};
#pragma unroll
                for (int ks = 0; ks < 2; ++ks) { const s16x8 sb = *(const LAS s16x8*)(Sb + (16 * nj + fr) * KS + 32 * ks + 8 * fq);
                    z = __builtin_amdgcn_mfma_f32_16x16x32_bf16(*(const LAS s16x8*)(At + (16 * mi + fr) * KS + 32 * ks + 8 * fq), sb, z, 0, 0, 0);
                    yv = __builtin_amdgcn_mfma_f32_16x16x32_bf16(*(const LAS s16x8*)(Rt + (16 * mi + fr) * KS + 32 * ks + 8 * fq), sb, yv, 0, 0, 0); }
                const s16x8 vt_ = tr_frag(Vv, LS, 8 * fq, 16 * nj, fr);
                z = __builtin_amdgcn_mfma_f32_16x16x32_bf16(*(const LAS s16x8*)(G2b + (16 * mi + fr) * LS + 8 * fq), vt_, z, 0, 0, 0);
                yv = __builtin_amdgcn_mfma_f32_16x16x32_bf16(*(const LAS s16x8*)(G4b + (16 * mi + fr) * LS + 8 * fq), vt_, yv, 0, 0, 0);
                *(LAS unsigned long long*)(RHt + (16 * nj + fr) * LS + 16 * mi + 4 * fq) = pack4bf(z); }
            rw_bar(bcnt, btarget, lane); }
        { f32x4 z = (f32x4){0.f, 0.f, 0.f, 0.f};
          z = __builtin_amdgcn_mfma_f32_16x16x32_bf16(*(const LAS s16x8*)(Acb + 32 * LS + (16 * mi + fr) * LS + 8 * fq), *(const LAS s16x8*)(RHt + (16 * nj + fr) * LS + 8 * fq), z, 0, 0, 0);
          *(LAS unsigned long long*)(Ubt + (16 * nj + fr) * LS + 16 * mi + 4 * fq) = pack4bf(z); }
        rw_bar(bcnt, btarget, lane);
        { yv = __builtin_amdgcn_mfma_f32_16x16x32_bf16(*(const LAS s16x8*)(G3b + (16 * mi + fr) * LS + 8 * fq), *(const LAS s16x8*)(Ubt + (16 * nj + fr) * LS + 8 * fq), yv, 0, 0, 0);
          float* yp = YRAW + ((size_t)b * SEQ + ch * 32 + 16 * mi + 4 * fq) * RD + h * 64 + half * 32 + 16 * nj + fr;
#pragma unroll
          for (int rg_ = 0; rg_ < 4; ++rg_) yp[(size_t)rg_ * RD] = yv[rg_]; }
        { const int kt = w; const s16x8 bt_ = tr_frag(Bt, KS, 8 * fq, 16 * kt, fr), kt_ = tr_frag(Kt, KS, 8 * fq, 16 * kt, fr); const f32x4 gl4 = *(const LAS f32x4*)(glf + 16 * kt + 4 * fq);
#pragma unroll
          for (int vt = 0; vt < 2; ++vt) {
              st[vt] = __builtin_amdgcn_mfma_f32_16x16x32_bf16(bt_, *(const LAS s16x8*)(Ubt + (16 * vt + fr) * LS + 8 * fq), st[vt], 0, 0, 0);
              st[vt] = __builtin_amdgcn_mfma_f32_16x16x32_bf16(kt_, tr_frag(Vv, LS, 8 * fq, 16 * vt, fr), st[vt], 0, 0, 0);
              st[vt] = st[vt] * gl4;
              *(LAS unsigned long long*)(Sb + (16 * vt + fr) * KS + 16 * kt + 4 * fq) = pack4bf(st[vt]); } }
        rw_bar(bcnt, btarget, lane);
    }
#undef RC_LOAD
}

__device__ __forceinline__ float allreduce8(float x) { x += dppf<0x141>(x); x += dppf<0xB1>(x); x += dppf<0x4E>(x); return x; }
__device__ __forceinline__ void rw_bar(LAS unsigned* cnt, unsigned& target, int lane) {
    asm volatile("s_waitcnt lgkmcnt(0)" ::: "memory");
    if (lane == 0) __hip_atomic_fetch_add(cnt, 1u, __ATOMIC_RELAXED, __HIP_MEMORY_SCOPE_WORKGROUP);
    target += 4u;
    while ((unsigned)__builtin_amdgcn_readfirstlane((int)__hip_atomic_load(cnt, __ATOMIC_RELAXED, __HIP_MEMORY_SCOPE_WORKGROUP)) < target) __builtin_amdgcn_s_sleep(1);
    asm volatile("" ::: "memory");
}
constexpr int CV_BR = 8 * 32, CV_WO = 16 * 32, CV_GU = NE * 16 * 64, CV_DN = NE * 16 * 32, CV_ITEMS = 2 * CV_BR + CV_WO + CV_GU + CV_DN;
struct CvItem { const float* src; unsigned char* dst; int N; int f8; };
__device__ __forceinline__ CvItem cv_decode(Frame& F, int it) {
    CvItem c; int r = it; const int lane = F.lane;
    if (r < CV_BR) { const int kb = r >> 5, nb = r & 31; c.src = F.in[I_WBA] + (size_t)(kb * 128) * D + nb * 64 + lane; c.dst = F.ws + WS_WA + ((size_t)(nb * 64 + lane) * RD + kb * 128) * 2; c.N = D; c.f8 = 0; return c; } r -= CV_BR;
    if (r < CV_BR) { const int kb = r >> 5, nb = r & 31; c.src = F.in[I_WBB] + (size_t)(kb * 128) * D + nb * 64 + lane; c.dst = F.ws + WS_WB + ((size_t)(nb * 64 + lane) * RD + kb * 128) * 2; c.N = D; c.f8 = 0; return c; } r -= CV_BR;
    if (r < CV_WO) { const int kb = r >> 5, nb = r & 31; c.src = F.in[I_WOUT] + (size_t)(kb * 128) * D + nb * 64 + lane; c.dst = F.ws + WS_WO + ((size_t)(nb * 64 + lane) * D + kb * 128) * 2; c.N = D; c.f8 = 0; return c; } r -= CV_WO;
    if (r < CV_GU) { const int e = r >> 10, q = r & 1023, kb = q >> 6, nb = q & 63, n0 = nb * 64;
        const int dr = n0 < FF ? ((n0 >> 7) * 256 + (n0 & 127)) : (((n0 - FF) >> 7) * 256 + 128 + ((n0 - FF) & 127));
        c.src = F.in[I_WGU] + (size_t)e * D * 2 * FF + (size_t)(kb * 128) * (2 * FF) + n0 + lane; c.dst = F.ws + WS_WGU + (size_t)e * 2 * FF * D + (size_t)(dr + lane) * D + kb * 128; c.N = 2 * FF; c.f8 = 1; return c; } r -= CV_GU;
    { const int e = r >> 9, q = r & 511, kb = q >> 5, nb = q & 31;
        c.src = F.in[I_WDN] + (size_t)e * FF * D + (size_t)(kb * 128) * D + nb * 64 + lane; c.dst = F.ws + WS_WDN + (size_t)e * D * FF + (size_t)(nb * 64 + lane) * FF + kb * 128; c.N = D; c.f8 = 1; }
    return c;
}
__device__ __forceinline__ void convert_item(Frame& F, int it);
__device__ __forceinline__ void convert_loop(Frame& F, unsigned* next, unsigned* p1done, unsigned ngemm) {
    for (;;) { unsigned b = 0xffffffffu;
        if (F.lane == 0) { if (!(p1done && __hip_atomic_load(p1done, __ATOMIC_RELAXED, __HIP_MEMORY_SCOPE_AGENT) >= ngemm)) b = __hip_atomic_fetch_add(next, 2u, __ATOMIC_RELAXED, __HIP_MEMORY_SCOPE_AGENT); }
        const unsigned base = (unsigned)__builtin_amdgcn_readfirstlane((int)b); if (base >= (unsigned)CV_ITEMS) break;
        for (int k = 0; k < 2; ++k) { const int it = (int)base + k; if (it < CV_ITEMS) convert_item(F, it); } }
}
__device__ __forceinline__ void convert_item(Frame& F, int i0) {
    { const CvItem c = cv_decode(F, i0);
        float x[128];
#pragma unroll
        for (int i = 0; i < 128; ++i) x[i] = c.src[(size_t)i * c.N];
        if (c.f8) {
#pragma unroll
            for (int q = 0; q < 8; ++q) { v4u o; o.x = pk4f8(x[16 * q + 0] * F8_SW, x[16 * q + 1] * F8_SW, x[16 * q + 2] * F8_SW, x[16 * q + 3] * F8_SW); o.y = pk4f8(x[16 * q + 4] * F8_SW, x[16 * q + 5] * F8_SW, x[16 * q + 6] * F8_SW, x[16 * q + 7] * F8_SW);
                o.z = pk4f8(x[16 * q + 8] * F8_SW, x[16 * q + 9] * F8_SW, x[16 * q + 10] * F8_SW, x[16 * q + 11] * F8_SW); o.w = pk4f8(x[16 * q + 12] * F8_SW, x[16 * q + 13] * F8_SW, x[16 * q + 14] * F8_SW, x[16 * q + 15] * F8_SW);
                *(v4u*)(c.dst + 16 * q) = o; } }
        else {
#pragma unroll
            for (int q = 0; q < 16; ++q) { v4u o; o.x = pk2(x[8 * q + 0], x[8 * q + 1]); o.y = pk2(x[8 * q + 2], x[8 * q + 3]); o.z = pk2(x[8 * q + 4], x[8 * q + 5]); o.w = pk2(x[8 * q + 6], x[8 * q + 7]);
                *(v4u*)(c.dst + 16 * q) = o; } } }
}

__device__ __forceinline__ void mlstm_scan_unit(Frame& F, int unit, LAS unsigned* bcnt, unsigned& btarget) {
    const int b = unit >> 5, mh = (unit >> 3) & 3, sl = unit & 7;
    const bf16* P = (const bf16*)(F.ws + WS_P); const bf16* QKC = (const bf16*)(F.ws + WS_QKC); const float* GLF = (const float*)(F.ws + WS_GLF); float* HRAW = (float*)(F.ws + WS_HRAW);
    constexpr int VS = 56;
    LAS bf16* Lq = (LAS bf16*)F.lds;
    LAS bf16* Lk = Lq + 64 * 136;
    LAS bf16* Lv = Lk + 64 * 136;
    LAS bf16* Lvs = Lv + 64 * VS;
    LAS bf16* LcT = Lvs + 64 * VS;
    LAS bf16* Ls = LcT + 2 * 48 * 136;
    LAS float* sb = (LAS float*)(Ls + 64 * 72); LAS float* su = sb + 64; LAS float* smx = su + 64; LAS float* swk = smx + 64;
    const int tid = F.tid, lane = F.lane, w = F.wave, fr = lane & 15, fq = lane >> 4;
    for (int i = tid; i < 2 * 48 * 136; i += 256) LcT[i] = 0;
    for (int i = tid; i < 64 * 16; i += 256) { const int j = i >> 4, c = 32 + (i & 15); Lv[j * VS + c] = (c == 32) ? (bf16)0x3F80 : (bf16)0; Lvs[j * VS + c] = 0; }
    const int pr0 = tid >> 4, pc = 8 * (tid & 15);
    v4u rq[4], rk[4], rv; f32x4 g3;
#define ML_LOAD(ch) do { const size_t tk0_ = (size_t)b * SEQ + (ch) * 64; \
        _Pragma("unroll") for (int i_ = 0; i_ < 4; ++i_) { const bf16* s_ = QKC + (tk0_ + pr0 + 16 * i_) * 1024 + mh * 128 + pc; rq[i_] = *(const v4u*)s_; rk[i_] = *(const v4u*)(s_ + 512); } \
        rv = *(const v4u*)(P + (tk0_ + (tid >> 2)) * NINP + MLO + 1024 + mh * 256 + sl * 32 + 8 * (tid & 3)); \
        g3 = *(const f32x4*)(GLF + (tk0_ + lane) * 16 + 4 * mh); } while (0)
    f32x4 st[2][3];
#pragma unroll
    for (int a = 0; a < 2; ++a)
#pragma unroll
        for (int n = 0; n < 3; ++n) st[a][n] = (f32x4){0.f, 0.f, 0.f, 0.f};
    float mstate = 0.f;
    ML_LOAD(0);
    rw_bar(bcnt, btarget, lane);
    for (int ch = 0; ch < SEQ / 64; ++ch) {
        const size_t tk0 = (size_t)b * SEQ + ch * 64;
        LAS bf16* cTc = LcT + (ch & 1) * 48 * 136; LAS bf16* cTn = LcT + ((ch + 1) & 1) * 48 * 136;
        float mnew, dec;
        { const float bc = g3[0], u = g3[1], pm = g3[2];
          const float gtot = __shfl(bc, 63), pmall = __shfl(pm, 63);
          mnew = gtot + fmaxf(mstate, pmall); dec = __expf(gtot + mstate - mnew);
          const float wk = __expf(u + gtot - mnew);
          sb[lane] = bc; su[lane] = u; smx[lane] = fmaxf(mstate, pm); swk[lane] = wk;
          if (w == 0) Lvs[lane * VS + 32] = (bf16)f2bf(wk); }
#pragma unroll
        for (int i = 0; i < 4; ++i) { *(LAS v4u*)(Lq + (pr0 + 16 * i) * 136 + pc) = rq[i]; *(LAS v4u*)(Lk + (pr0 + 16 * i) * 136 + pc) = rk[i]; }
        LDS_WAIT();
        { const int j = tid >> 2, d0 = 8 * (tid & 3); const float wkj = swk[j]; *(LAS v4u*)(Lv + j * VS + d0) = rv;
          const unsigned uu[4] = {rv.x, rv.y, rv.z, rv.w}; v4u sv;
          sv.x = pk2(wkj * __uint_as_float(uu[0] << 16), wkj * __uint_as_float(uu[0] & 0xffff0000u)); sv.y = pk2(wkj * __uint_as_float(uu[1] << 16), wkj * __uint_as_float(uu[1] & 0xffff0000u));
          sv.z = pk2(wkj * __uint_as_float(uu[2] << 16), wkj * __uint_as_float(uu[2] & 0xffff0000u)); sv.w = pk2(wkj * __uint_as_float(uu[3] << 16), wkj * __uint_as_float(uu[3] & 0xffff0000u));
          *(LAS v4u*)(Lvs + j * VS + d0) = sv; }
        if (ch + 1 < SEQ / 64) ML_LOAD(ch + 1);
        rw_bar(bcnt, btarget, lane);
        { const int tt = w; const int t = 16 * tt + fr; const float mxt = smx[t];
#pragma unroll
          for (int jt = 0; jt < 4; ++jt) { f32x4 acc = (f32x4){0.f, 0.f, 0.f, 0.f};
              if (jt <= tt) {
#pragma unroll
                  for (int ks = 0; ks < 4; ++ks) { const s16x8 a = *(const LAS s16x8*)(Lk + (16 * jt + fr) * 136 + 32 * ks + 8 * fq), bq = *(const LAS s16x8*)(Lq + (16 * tt + fr) * 136 + 32 * ks + 8 * fq);
                      acc = __builtin_amdgcn_mfma_f32_16x16x32_bf16(a, bq, acc, 0, 0, 0); }
                  const f32x4 u4 = *(const LAS f32x4*)(su + 16 * jt + 4 * fq);
#pragma unroll
                  for (int rg_ = 0; rg_ < 4; ++rg_) { const int j = 16 * jt + 4 * fq + rg_; acc[rg_] = (j <= t) ? acc[rg_] * __expf(u4[rg_] - mxt) : 0.f; } }
              *(LAS unsigned long long*)(Ls + t * 72 + 16 * jt + 4 * fq) = pack4bf(acc); } }
        rw_bar(bcnt, btarget, lane);
        { const int mi = w; f32x4 a1[3], a2[3];
#pragma unroll
          for (int n = 0; n < 3; ++n) { a1[n] = (f32x4){0.f, 0.f, 0.f, 0.f}; a2[n] = a1[n]; }
#pragma unroll
          for (int ks = 0; ks < 2; ++ks) { const s16x8 A = *(const LAS s16x8*)(Ls + (16 * mi + fr) * 72 + 32 * ks + 8 * fq);
#pragma unroll
              for (int n = 0; n < 3; ++n) a1[n] = __builtin_amdgcn_mfma_f32_16x16x32_bf16(A, tr_frag(Lv, VS, 32 * ks + 8 * fq, 16 * n, fr), a1[n], 0, 0, 0); }
#pragma unroll
          for (int ks = 0; ks < 4; ++ks) { const s16x8 A = *(const LAS s16x8*)(Lq + (16 * mi + fr) * 136 + 32 * ks + 8 * fq);
#pragma unroll
              for (int n = 0; n < 3; ++n) a2[n] = __builtin_amdgcn_mfma_f32_16x16x32_bf16(A, *(const LAS s16x8*)(cTc + (16 * n + fr) * 136 + 32 * ks + 8 * fq), a2[n], 0, 0, 0); }
          const f32x4 mx4 = *(const LAS f32x4*)(smx + 16 * mi + 4 * fq), b4 = *(const LAS f32x4*)(sb + 16 * mi + 4 * fq);
#pragma unroll
          for (int rg_ = 0; rg_ < 4; ++rg_) { const float wi = __expf(mstate - mx4[rg_]); float den = a1[2][rg_] + wi * a2[2][rg_]; den = __shfl(den, lane & 48);
              const float mt = b4[rg_] + mx4[rg_]; const float inv = __builtin_amdgcn_rcpf(fmaxf(fabsf(den), __expf(-mt))); float* hp = HRAW + (tk0 + 16 * mi + 4 * fq + rg_) * RD + mh * 256 + sl * 32 + fr;
              hp[0] = (a1[0][rg_] + wi * a2[0][rg_]) * inv; hp[16] = (a1[1][rg_] + wi * a2[1][rg_]) * inv; } }
        {
#pragma unroll
          for (int a = 0; a < 2; ++a) {
#pragma unroll
              for (int n = 0; n < 3; ++n) st[a][n] = st[a][n] * dec;
#pragma unroll
              for (int ks = 0; ks < 2; ++ks) { const s16x8 A = tr_frag(Lk, 136, 32 * ks + 8 * fq, 16 * (2 * w + a), fr);
#pragma unroll
                  for (int n = 0; n < 3; ++n) st[a][n] = __builtin_amdgcn_mfma_f32_16x16x32_bf16(A, tr_frag(Lvs, VS, 32 * ks + 8 * fq, 16 * n, fr), st[a][n], 0, 0, 0); }
#pragma unroll
              for (int n = 0; n < 3; ++n) *(LAS unsigned long long*)(cTn + (16 * n + fr) * 136 + 16 * (2 * w + a) + 4 * fq) = pack4bf(st[a][n]); } }
        mstate = mnew;
        rw_bar(bcnt, btarget, lane);
    }
#undef ML_LOAD
}

__device__ __forceinline__ float rowsum4(f32x4 v) { return (v[0] + v[1]) + (v[2] + v[3]); }
__device__ __forceinline__ void p5_finalize(Frame& F) {
    const bf16* __restrict__ P = (const bf16*)(F.ws + WS_P); const float* __restrict__ WAG = (const float*)(F.ws + WS_WAG); const float* __restrict__ YRAW = (const float*)(F.ws + WS_YRAW); const float* __restrict__ HRAW = (const float*)(F.ws + WS_HRAW);
    bf16* __restrict__ OA = (bf16*)(F.ws + WS_OA); bf16* __restrict__ OB = (bf16*)(F.ws + WS_OB);
    const int gw = F.bid * NWAVES + F.wave, NGW = F.G * NWAVES, lane = F.lane;
    { const int hq = gw & 3, c0 = (hq * 4 + (lane >> 4)) * 64 + 4 * (lane & 15);
      const f32x4 mu_r = *(const f32x4*)(F.in[I_MU] + c0), mu_k = *(const f32x4*)(F.in[I_MU] + 1024 + c0), mu_v = *(const f32x4*)(F.in[I_MU] + 2048 + c0);
      const f32x4 kac = *(const f32x4*)(F.in[I_KA] + c0), rkc = *(const f32x4*)(F.in[I_RK] + c0), lnw = *(const f32x4*)(F.in[I_LNW] + c0), lnb = *(const f32x4*)(F.in[I_LNB] + c0);
      v2u cr, ck, cv, qr, qk, qv; f32x4 a4, g4, y4;
#define P5_LOAD(q_) do { const int tk_ = (q_) >> 2; const bf16* pr_ = P + (size_t)tk_ * NINP + c0; cr = *(const v2u*)(pr_); ck = *(const v2u*)(pr_ + 1024); cv = *(const v2u*)(pr_ + 2048); \
          if (tk_ & (SEQ - 1)) { qr = *(const v2u*)(pr_ - NINP); qk = *(const v2u*)(pr_ - NINP + 1024); qv = *(const v2u*)(pr_ - NINP + 2048); } else { qr = (v2u){0u, 0u}; qk = qr; qv = qr; } \
          a4 = *(const f32x4*)(WAG + (size_t)tk_ * 3072 + 1024 + c0); g4 = *(const f32x4*)(WAG + (size_t)tk_ * 3072 + 2048 + c0); y4 = *(const f32x4*)(YRAW + (size_t)tk_ * RD + c0); } while (0)
      if (gw < T * 4) P5_LOAD(gw);
      for (int q = gw; q < T * 4; q += NGW) { const int tk = q >> 2;
          const f32x4 pr4 = UNP4(cr), pk4 = UNP4(ck), pv4 = UNP4(cv), qr4 = UNP4(qr), qk4 = UNP4(qk), qv4 = UNP4(qv); const f32x4 a = a4, g = g4, y = y4;
          if (q + NGW < T * 4) P5_LOAD(q + NGW);
          const f32x4 rr = pr4 + (qr4 - pr4) * mu_r, k1 = pk4 + (qk4 - pk4) * mu_k, vv = pv4 + (qv4 - pv4) * mu_v;
          const f32x4 kmod = k1 * (1.f + (a - 1.f) * kac);
          const float dot = allreduce16(rowsum4(rr * kmod * rkc)); const float mean = allreduce16(rowsum4(y)) * (1.f / 64.f); const f32x4 dl = y - mean;
          const float var = allreduce16(rowsum4(dl * dl)) * (1.f / 64.f); const float rs = __builtin_amdgcn_rsqf(var + GN_EPS);
          const f32x4 o = (dl * rs * lnw + lnb + dot * vv) * g;
          v2u ov; ov.x = pk2(o[0], o[1]); ov.y = pk2(o[2], o[3]); *(v2u*)(OA + (size_t)tk * RD + c0) = ov; }
#undef P5_LOAD
    }
    { const int mh = gw & 3, d0 = mh * 256 + 4 * lane; const f32x4 nw = *(const f32x4*)(F.in[I_MNW] + d0);
      f32x4 hv; v2u po;
#define P5B_LOAD(q_) do { const int tk_ = (q_) >> 2; hv = *(const f32x4*)(HRAW + (size_t)tk_ * RD + d0); po = *(const v2u*)(P + (size_t)tk_ * NINP + MLO + 2056 + d0); } while (0)
      if (gw < T * 4) P5B_LOAD(gw);
      for (int q = gw; q < T * 4; q += NGW) { const int tk = q >> 2; const f32x4 h4 = hv; const v2u p2 = po;
          if (q + NGW < T * 4) P5B_LOAD(q + NGW);
          float ss = allreduce16(rowsum4(h4 * h4)); ss += __shfl_xor(ss, 16); ss += __shfl_xor(ss, 32);
          const float rs = __builtin_amdgcn_rsqf(ss * (1.f / 256.f) + NORM_EPS); const f32x4 og = UNP4(p2);
          const float o0 = h4[0] * rs * nw[0] * sigm(og[0]), o1 = h4[1] * rs * nw[1] * sigm(og[1]), o2 = h4[2] * rs * nw[2] * sigm(og[2]), o3 = h4[3] * rs * nw[3] * sigm(og[3]);
          v2u o; o.x = pk2(o0, o1); o.y = pk2(o2, o3); *(v2u*)(OB + (size_t)tk * RD + d0) = o; }
#undef P5B_LOAD
    }
}

typedef float f32x16 __attribute__((ext_vector_type(16)));
__device__ __forceinline__ void p8_route(Frame& F) {
    const float* X1 = (const float*)(F.ws + WS_X1); unsigned char* H2 = (unsigned char*)(F.ws + WS_HN); int* RLIST = (int*)(F.ws + WS_RLIST); float* RWT = (float*)(F.ws + WS_RW);
    const float* RWS = (const float*)(F.ws + WS_RWS); const float* nw = F.in[I_N2W]; const float* rtb = F.in[I_RTB];
    LAS float* part = (LAS float*)F.lds;
    LAS float* ssq = part + 8 * 32 * 33;
    LAS float* lgt = ssq + 256;
    LAS float* srs = lgt + 32 * 33;
    const int lane = F.lane, w = F.wave, i = lane & 31, h = lane >> 5, tid = F.tid;
    for (int tile = F.bid; tile < T / 32; tile += F.G) {
        const int m0 = tile * 32; const float* xrow = X1 + (size_t)(m0 + i) * D + 256 * w + 4 * h;
        f32x16 acc;
#pragma unroll
        for (int r_ = 0; r_ < 16; ++r_) acc[r_] = 0.f;
        float ss = 0.f; const float* bp = RWS + (size_t)(256 * w + 4 * h) * NE + i;
#pragma unroll 4
        for (int q = 0; q < 32; ++q) { const f32x4 xa = *(const f32x4*)(xrow + 8 * q);
#pragma unroll
            for (int j = 0; j < 4; ++j) acc = __builtin_amdgcn_mfma_f32_32x32x2f32(xa[j], bp[(8 * q + j) * NE], acc, 0, 0, 0);
            ss += (xa[0] * xa[0] + xa[1] * xa[1]) + (xa[2] * xa[2] + xa[3] * xa[3]); }
        ss += __shfl_xor(ss, 32);
        if (h == 0) ssq[w * 32 + i] = ss;
#pragma unroll
        for (int r_ = 0; r_ < 16; ++r_) part[(w * 32 + (r_ & 3) + 8 * (r_ >> 2) + 4 * h) * 33 + i] = acc[r_];
        __syncthreads();
#pragma unroll
        for (int k2 = 0; k2 < 2; ++k2) { const int idx = tid + NTHR * k2, ii = idx >> 5, e = idx & 31; float sm = 0.f, sq = 0.f;
#pragma unroll
            for (int ww = 0; ww < 8; ++ww) { sm += part[(ww * 32 + ii) * 33 + e]; sq += ssq[ww * 32 + ii]; }
            const float rs = 1.f / sqrtf(sq * (1.f / D) + NORM_EPS); lgt[ii * 33 + e] = sm * rs + rtb[e]; if (e == 0) srs[ii] = rs; }
        __syncthreads();
        { const float rs = srs[i] * F8_SX; unsigned char* orow = H2 + (size_t)(m0 + i) * D + 256 * w + 4 * h;
#pragma unroll 8
          for (int q = 0; q < 32; ++q) { const f32x4 n4 = *(const f32x4*)(nw + 256 * w + 4 * h + 8 * q); const f32x4 hv = *(const f32x4*)(xrow + 8 * q) * rs * n4; *(unsigned*)(orow + 8 * q) = pk4f8(hv[0], hv[1], hv[2], hv[3]); } }
        if (tid < 32) { const LAS float* lr = lgt + tid * 33; unsigned used = 0u; int idx[4]; float val[4];
#pragma unroll
            for (int s4 = 0; s4 < 4; ++s4) { float best = -INFINITY; int bi = 0;
                for (int e = 0; e < 32; ++e) { const float v = lr[e]; const bool ok = !((used >> e) & 1u) && (v > best); best = ok ? v : best; bi = ok ? e : bi; }
                used |= 1u << bi; idx[s4] = bi; val[s4] = best; }
            const float e1 = __expf(val[1] - val[0]), e2 = __expf(val[2] - val[0]), e3 = __expf(val[3] - val[0]); const float inv = 1.f / (1.f + e1 + e2 + e3);
            const float wv[4] = {inv, e1 * inv, e2 * inv, e3 * inv};
#pragma unroll
            for (int s4 = 0; s4 < 4; ++s4) { const unsigned pos = atomicAdd(F.ctl + CW_CNT + 64 * idx[s4], 1u); RLIST[idx[s4] * ECAP + pos] = (m0 + tid) * 4 + s4; RWT[idx[s4] * ECAP + pos] = wv[s4]; } }
        __syncthreads();
    }
}

__device__ __forceinline__ void build_moe_tables(Frame& F) {
    LAS int* MI = (LAS int*)F.MISC;
    __syncthreads();
    if (F.tid == 0) { int mt = 0, cs = 0;
        for (int e = 0; e < NE; ++e) { const int c = (int)__hip_atomic_load(F.ctl + CW_CNT + 64 * e, __ATOMIC_RELAXED, __HIP_MEMORY_SCOPE_AGENT); MI[MI_CNT + e] = c; MI[MI_POFF + e] = mt * 256; MI[MI_CST + e] = cs; cs += c;
            const int nt = (c + 255) >> 8; for (int i = 0; i < nt; ++i) { MI[MI_TILE_E + mt + i] = e; MI[MI_TILE_I0 + mt + i] = i * 256; } mt += nt; }
        MI[MI_CST + NE] = cs; MI[MI_MT] = mt; }
    __syncthreads();
}
__device__ __forceinline__ void p9_gather(Frame& F) {
    build_moe_tables(F);
    const LAS int* MI = (const LAS int*)F.MISC; const bf16* H2 = (const bf16*)(F.ws + WS_HN); bf16* XB = (bf16*)(F.ws + WS_XB); const int* RLIST = (const int*)(F.ws + WS_RLIST);
    const int gw = F.bid * NWAVES + F.wave, NGW = F.G * NWAVES, total = MI[MI_CST + NE];
    for (int q = gw; q < total; q += NGW) { int e = 0;
        for (int k = 1; k < NE; ++k) e = (MI[MI_CST + k] <= q) ? k : e;
        const int i = q - MI[MI_CST + e]; const int tok = RLIST[e * ECAP + i] >> 2;
        const v4u* src = (const v4u*)(H2 + (size_t)tok * D) + F.lane; v4u* dst = (v4u*)(XB + (size_t)(MI[MI_POFF + e] + i) * D) + F.lane;
#pragma unroll
        for (int j = 0; j < 4; ++j) dst[64 * j] = src[64 * j]; }
}
__device__ __forceinline__ void p12_final(Frame& F) {
    const float* X1 = (const float*)(F.ws + WS_X1); const bf16* YS = (const bf16*)(F.ws + WS_YS); const float* fw = F.in[I_FNW];
    const int gw = F.bid * NWAVES + F.wave, NGW = F.G * NWAVES;
    for (int m = gw; m < T; m += NGW) {
        const f32x4* xr = (const f32x4*)(X1 + (size_t)m * D) + F.lane; f32x4 v[8]; float s = 0.f;
#pragma unroll
        for (int j = 0; j < 8; ++j) { v[j] = xr[64 * j];
#pragma unroll
            for (int sl = 0; sl < 4; ++sl) { const v2u y = ((const v2u*)(YS + ((size_t)m * 4 + sl) * D))[F.lane + 64 * j];
                v[j][0] += __uint_as_float(y.x << 16); v[j][1] += __uint_as_float(y.x & 0xffff0000u); v[j][2] += __uint_as_float(y.y << 16); v[j][3] += __uint_as_float(y.y & 0xffff0000u); }
            s += (v[j][0] * v[j][0] + v[j][1] * v[j][1]) + (v[j][2] * v[j][2] + v[j][3] * v[j][3]); }
        const float rstd = __builtin_amdgcn_rsqf(wave_sum(s) * (1.f / D) + NORM_EPS);
        f32x4* orow = (f32x4*)(F.out + (size_t)m * D) + F.lane;
#pragma unroll
        for (int j = 0; j < 8; ++j) { const f32x4 w = ((const f32x4*)fw)[F.lane + 64 * j]; orow[64 * j] = v[j] * rstd * w; }
    }
}

__global__ void __launch_bounds__(NTHR, 2) mk_fwd(Args args) {
    extern __shared__ __attribute__((aligned(16))) unsigned char lds[];
    Frame F;
    F.lds = (LAS unsigned char*)lds; F.MISC = (volatile LAS unsigned*)(F.lds + MISC_OFF);
    F.tid = threadIdx.x; F.lane = F.tid & 63; F.wave = __builtin_amdgcn_readfirstlane(F.tid >> 6); F.G = gridDim.x; F.bid = blockIdx.x;
    F.in = args.in; F.out = args.out; F.ws = args.ws; F.ctl = (unsigned*)(args.ws + WS_CTL);
    for (int u = F.tid; u < (LDS_BYTES - MISC_OFF) / 4; u += NTHR) ((LAS unsigned*)(F.lds + MISC_OFF))[u] = 0u;
    __syncthreads();
    XcdBarrier bar; bar.bar = F.ctl + CW_BAR; bar.x = 0; bar.st = nullptr;
    if (MK_N_LAUNCHES == 1) bar = xcd_barrier_post(F.ctl + CW_BAR, F.MISC + 8);
    const int lo = args.ph_lo, hi = args.ph_hi;
#define IN(k) (lo <= (k) && (k) < hi)
#ifndef PROBE_PHASE
#define PROBE_PHASE -1
#endif
#define REP(k) ((PROBE_PHASE) == (k) ? 2 : 1)
#define SEAM(k) do { if (IN(k) && IN((k) + 1)) xcd_barrier(bar); } while (0)
    LAS unsigned char* ring = F.lds;
    const LAS int* MI = (const LAS int*)F.MISC;

    static_assert(MK_N_LAUNCHES == 1, "the W_in quantisation needs an in-launch barrier inside phase 0");
    if (IN(0)) { p0_prologue(F); xcd_barrier(bar); p0b_win(F); } SEAM(0);
    if (IN(1)) {
        const int ng = F.G > 2 * NCV ? F.G - NCV : F.G;
        if (F.bid < ng) {
            pg8::Gemm g{(const bf16*)(F.ws + WS_HN), (const bf16*)(F.ws + WS_WIN), T, NINP, D / 2}; pg8::StaticOrder S; S.init(T, NINP, ng, F.bid);
            EpiP1I8 E{(bf16*)(F.ws + WS_P), NINP, (const float*)(F.ws + WS_RA), F.ctl + CW_COLMAX};
            pg8::gemm_phase<EpiP1I8, pg8::StaticOrder, true, true, false, true>(ring, g, S, E);
            if (F.tid == 0) __hip_atomic_fetch_add(F.ctl + CW_P1DONE, 1u, __ATOMIC_RELAXED, __HIP_MEMORY_SCOPE_AGENT);
        } else convert_loop(F, F.ctl + CW_CVNEXT, F.ctl + CW_P1DONE, (unsigned)ng);
    } SEAM(1);
    if (IN(2)) { for (int rep = 0; rep < REP(2); ++rep) p2_lora_in(F); } SEAM(2);
    if (IN(3)) {
        pg8::Gemm g{(const bf16*)(F.ws + WS_LIN), (const bf16*)(F.ws + WS_WL), T, 3072, 512}; pg8::StaticOrder S; S.init(T, 3072, F.G, F.bid);
        EpiLora E{(float*)(F.ws + WS_WAG), F.in[I_W0], F.in[I_A0]};
        pg8::gemm_phase<EpiLora, pg8::StaticOrder, true, true>(ring, g, S, E);
    } SEAM(3);
    if (IN(4)) {
        { LAS unsigned* ctl2 = (LAS unsigned*)F.MISC + 16;
          if (F.wave < 4) { unsigned bt = 0u; for (int rep = 0; rep < REP(40); ++rep) for (int u = F.bid; u < 256; u += F.G) rwkv_chunk_unit(F, u, (LAS unsigned char*)F.MISC + 256, ctl2, bt); }
          else { Frame F2 = F; F2.tid = F.tid - 256; F2.wave = F.wave - 4; F2.lds = F.lds + 45056; unsigned bt = 0u;
                 for (int rep = 0; rep < REP(41); ++rep) for (int u = F.bid; u < 256; u += F.G) mlstm_scan_unit(F2, u, ctl2 + 2, bt); }
          convert_loop(F, F.ctl + CW_CVNEXT, nullptr, 0u);
          __syncthreads(); }
    } SEAM(4);
    if (IN(5)) { for (int rep = 0; rep < REP(5); ++rep) p5_finalize(F); } SEAM(5);
    if (IN(6)) {
        { pg8::Gemm g{(const bf16*)(F.ws + WS_OA), (const bf16*)(F.ws + WS_WA), T, D, RD}; pg8::StaticOrder S; S.init(T, D, F.G, F.bid);
          EpiGateA E{(float*)(F.ws + WS_TMP), (const bf16*)(F.ws + WS_P), F.in[I_BGATE]};
          pg8::gemm_phase<EpiGateA, pg8::StaticOrder, true, true>(ring, g, S, E); }
        VM_WAIT(); __syncthreads();
        { pg8::Gemm g{(const bf16*)(F.ws + WS_OB), (const bf16*)(F.ws + WS_WB), T, D, RD}; pg8::StaticOrder S; S.init(T, D, F.G, F.bid);
          EpiGateB E{(const float*)(F.ws + WS_TMP), (bf16*)(F.ws + WS_MRG), (const bf16*)(F.ws + WS_P), F.in[I_BGATE]};
          pg8::gemm_phase<EpiGateB, pg8::StaticOrder, true, true>(ring, g, S, E); }
    } SEAM(6);
    if (IN(7)) {
        pg8::Gemm g{(const bf16*)(F.ws + WS_MRG), (const bf16*)(F.ws + WS_WO), T, D, D}; pg8::StaticOrder S; S.init(T, D, F.G, F.bid);
        EpiResid E{F.in[I_X], (float*)(F.ws + WS_X1)};
        pg8::gemm_phase<EpiResid, pg8::StaticOrder, true, true>(ring, g, S, E);
    } SEAM(7);
    if (IN(8)) { p8_route(F); } SEAM(8);
    if (IN(10)) {
        build_moe_tables(F);
        const int mt = MI[MI_MT];
        pg8::Gemm g{(const bf16*)(F.ws + WS_HN), (const bf16*)(F.ws + WS_WGU), mt * 256, 2 * FF, D / 2};
        MoeGatherOrder S; S.init(mt * 256, 2 * FF, F.G, F.bid); S.tile_e = MI + MI_TILE_E; S.estride = (size_t)2 * FF * D;
        S.tile_i0 = MI + MI_TILE_I0; S.cnt = MI + MI_CNT; S.rlist = (const int*)(F.ws + WS_RLIST); S.rowoff = (LAS unsigned*)F.MISC + MI_ROWOFF; S.rowbytes = D;
        EpiSwiGLU E{(unsigned char*)(F.ws + WS_ACT), F.in[I_BGU], MI + MI_TILE_E};
        pg8::gemm_phase<EpiSwiGLU, MoeGatherOrder, true, true, true>(ring, g, S, E);
    } SEAM(10);
    if (IN(11)) {
        build_moe_tables(F);
        const int mt = MI[MI_MT];
        pg8::Gemm g{(const bf16*)(F.ws + WS_ACT), (const bf16*)(F.ws + WS_WDN), mt * 256, D, FF / 2};
        MoeOrder S; S.init(mt * 256, D, F.G, F.bid); S.tile_e = MI + MI_TILE_E; S.estride = (size_t)D * FF;
        LAS int* rowdst = (LAS int*)F.MISC + MI_ROWOFF; LAS float* rowwt = (LAS float*)F.MISC + MI_ROWOFF + 10 * 256;
        fill_down_tables(F, S, rowdst, rowwt);
        EpiDown E{(bf16*)(F.ws + WS_YS), F.in[I_BDN], MI + MI_TILE_E, rowdst, rowwt};
        pg8::gemm_phase<EpiDown, MoeOrder, true, true, true>(ring, g, S, E);
    } SEAM(11);
    if (IN(12)) { for (int rep = 0; rep < REP(12); ++rep) p12_final(F); }
#undef IN
#undef SEAM
}

extern "C" void kernel_launch(void* const* d_in, const int* in_sizes, int n_in, void* d_out, int out_size, void* d_ws, size_t ws_size, hipStream_t stream) {
    static int grid = 0;
    if (grid == 0) {
        if (n_in != 30 || out_size != T * D || ws_size < WS_END) { fprintf(stderr, "kernel_launch: unexpected problem (n_in %d, out %d, ws %zu)\n", n_in, out_size, ws_size); grid = -1; return; }
        int dev = 0, cus = 0, per_cu = 0;
        if (hipGetDevice(&dev) != hipSuccess || hipDeviceGetAttribute(&cus, hipDeviceAttributeMultiprocessorCount, dev) != hipSuccess) { grid = -1; return; }
        if (hipFuncSetAttribute((const void*)mk_fwd, hipFuncAttributeMaxDynamicSharedMemorySize, LDS_BYTES) != hipSuccess) { fprintf(stderr, "kernel_launch: hipFuncSetAttribute failed\n"); grid = -1; return; }
        if (hipOccupancyMaxActiveBlocksPerMultiprocessor(&per_cu, (const void*)mk_fwd, NTHR, LDS_BYTES) != hipSuccess || per_cu < 1) fprintf(stderr, "kernel_launch: occupancy query says %d\n", per_cu);
        (void)hipGetLastError();
        grid = cus;
    }
    if (grid < 0) return;
    if (hipMemsetAsync((char*)d_ws + WS_CTL, 0, CTL_ZERO_BYTES, stream) != hipSuccess) return;
    Args a{};
    for (int i = 0; i < 30; ++i) a.in[i] = (const float*)d_in[i];
    a.out = (float*)d_out; a.ws = (unsigned char*)d_ws;
    for (int li = 0; li < MK_N_LAUNCHES; ++li) {
        a.ph_lo = (MK_N_LAUNCHES == 1) ? 0 : li; a.ph_hi = (MK_N_LAUNCHES == 1) ? NPH : li + 1;
        hipLaunchKernelGGL(mk_fwd, dim3(grid), dim3(NTHR), LDS_BYTES, stream, a);
        const hipError_t le = hipPeekAtLastError();
        if (le != hipSuccess) { fprintf(stderr, "kernel_launch: launch %d failed: %s\n", li, hipGetErrorName(le)); break; }
    }
}
```

```cpp
#include <hip/hip_runtime.h>
#include <cstdio>
#include <cstdint>
#define MK_N_LAUNCHES 1
#define PROBE_PHASE -1
namespace pg8 {
#define PG8_LAS __attribute__((address_space(3)))
typedef unsigned short bf16_t;
typedef short bf16x8 __attribute__((ext_vector_type(8)));
typedef float f32x4 __attribute__((ext_vector_type(4)));
typedef unsigned u32x4 __attribute__((ext_vector_type(4)));
constexpr int BM = 256, BK = 64, HALF = 128, HTB = HALF * BK * 2  , STAGE_BYTES = 8 * HTB, NXCD = 8, WGM = 8;

__host__ __device__ __forceinline__ int lds_byte(int r, int c) { const int st = (r >> 4) * 2 + (c >> 5), rr = r & 15, cc = c & 31, ob = rr * 64 + cc * 2; return st * 1024 + (ob ^ (((ob >> 9) & 1) << 5)); }
__host__ __device__ __forceinline__ void stage_rc(int b, int& R, int& C) { const int st = b / 1024, sb = b % 1024, swz = sb ^ (((sb >> 9) & 1) << 5); R = (st >> 1) * 16 + swz / 64; C = (st & 1) * 32 + (swz % 64) / 2; }
__host__ __device__ __forceinline__ int perm32(int rho) { const int n = rho >> 4, i = rho & 15; return 8 * (i >> 2) + 4 * n + (i & 3); }

struct Unit { int pm, pn, ord; };
struct Gemm { const bf16_t* A; const bf16_t* Bt; int M, N, K; };

struct StaticOrder {
    int nM, nN, nwg, G, c;
    __host__ __device__ void init(int M, int N, int G_, int c_) { nM = M / BM; nN = N / BM; nwg = nM * nN; G = G_; c = c_; }
    __host__ __device__ bool next(int i, Unit& u) const {
        const long L = (long)i * G + c; if (L >= nwg) return false;
        int wgid = (int)L; { const int q = nwg / NXCD, r = nwg % NXCD, xcd = wgid % NXCD, off = wgid / NXCD; wgid = (xcd < r ? xcd * (q + 1) : r * (q + 1) + (xcd - r) * q) + off; }
        const int nig = WGM * nN, gid = wgid / nig, fm = gid * WGM, gsz = (nM - fm) < WGM ? (nM - fm) : WGM;
        u.pm = fm + ((wgid % nig) % gsz); u.pn = (wgid % nig) / gsz; u.ord = i; return true;
    }
    __device__ __forceinline__ void a_ready(const Unit&) const {}
    static constexpr bool GATHER = false;
    __device__ __forceinline__ void fill_all() const {}
    __device__ __forceinline__ unsigned row_off(int, int) const { return 0u; }
    __device__ __forceinline__ void done(const Unit&) const {}
    __device__ __forceinline__ size_t a_off(const Unit& u, size_t tstep) const { return (size_t)u.pm * tstep; }
    __device__ __forceinline__ size_t b_off(const Unit& u, size_t tstep) const { return (size_t)u.pn * tstep; }
};
__device__ __forceinline__ unsigned cvt_pk_bf16(float lo, float hi) { unsigned r; asm volatile("v_cvt_pk_bf16_f32 %0, %1, %2" : "=v"(r) : "v"(lo), "v"(hi)); return r; }
typedef int v8i32 __attribute__((ext_vector_type(8)));
typedef int v4i32 __attribute__((ext_vector_type(4)));
__device__ __forceinline__ v8i32 cat8(bf16x8 lo, bf16x8 hi) { const v4i32 a = __builtin_bit_cast(v4i32, lo), b = __builtin_bit_cast(v4i32, hi); return __builtin_shufflevector(a, b, 0, 1, 2, 3, 4, 5, 6, 7); }
template <class Epi, class Sched, bool ALIGN_EPI = false, bool SP2 = false, bool FP8 = false, bool I8 = false>
__device__ __forceinline__ void gemm_phase(PG8_LAS unsigned char* lds, const Gemm g, const Sched& S, const Epi& E) {
    const int tid = threadIdx.x, wid = __builtin_amdgcn_readfirstlane(tid >> 6), lane = tid & 63, wr = wid >> 2, wc = wid & 3, fr = lane & 15, fq = lane >> 4;
    const int K = g.K, nt = K / BK;
    unsigned voffA[2], voffB[2];
#pragma unroll
    for (int i = 0; i < 2; ++i) { int R, C; stage_rc(tid * 16 + i * 8192, R, C); const int Rb = Epi::PERM ? ((R & ~31) + perm32(R & 31)) : R;
        voffA[i] = (unsigned)(R * K + C) * 2u; voffB[i] = (unsigned)(Rb * K + C) * 2u; }
    unsigned voffA1[2]; int rselA[2]; unsigned cselA[2];
#pragma unroll
    for (int i = 0; i < 2; ++i) { int R, C; stage_rc(tid * 16 + i * 8192, R, C); rselA[i] = R; cselA[i] = (unsigned)C * 2u; voffA1[i] = voffA[i]; }
    const size_t kstep = (size_t)(BK * 2);
    const size_t hstep = (size_t)HALF * K * 2;
    const size_t tstep = 2 * hstep;
    const size_t hstepA = Sched::GATHER ? (size_t)0 : hstep;
#define PG8_ROWS(_u) do { _Pragma("unroll") for (int _i = 0; _i < 2; ++_i) { voffA[_i] = S.row_off((_u), rselA[_i]) + cselA[_i]; voffA1[_i] = S.row_off((_u), HALF + rselA[_i]) + cselA[_i]; } } while (0)
    const unsigned ldsw = (unsigned)wid * 1024u;
    const int aoff = lds_byte(wr * 64 + fr, fq * 8), boff = lds_byte(wc * 32 + fr, fq * 8);
#define PG8_SA(b, h) (((b) * 2 + (h)) * HTB)
#define PG8_SB(b, h) ((4 + (b) * 2 + (h)) * HTB)
#define PG8_STAGE(bufoff, gbase, voff) do { _Pragma("unroll") for (int _i = 0; _i < 2; ++_i) \
        __builtin_amdgcn_global_load_lds((const unsigned*)((const char*)(gbase) + (voff)[_i]), (PG8_LAS unsigned*)(lds + (bufoff) + ldsw + _i * 8192), 16, 0, 0); } while (0)
#define PG8_LDA(dst, b, h) do { if constexpr (FP8) { _Pragma("unroll") for (int m = 0; m < 4; ++m) dst##8[m] = cat8(*(const PG8_LAS bf16x8*)(lds + PG8_SA(b, h) + aoff + m * 2048), *(const PG8_LAS bf16x8*)(lds + PG8_SA(b, h) + aoff + m * 2048 + 1024)); } \
        else { _Pragma("unroll") for (int m = 0; m < 4; ++m) _Pragma("unroll") for (int k = 0; k < 2; ++k) dst[m][k] = *(const PG8_LAS bf16x8*)(lds + PG8_SA(b, h) + aoff + m * 2048 + k * 1024); } } while (0)
#define PG8_LDB(dst, b, h) do { if constexpr (FP8) { _Pragma("unroll") for (int n = 0; n < 2; ++n) dst##8[n] = cat8(*(const PG8_LAS bf16x8*)(lds + PG8_SB(b, h) + boff + n * 2048), *(const PG8_LAS bf16x8*)(lds + PG8_SB(b, h) + boff + n * 2048 + 1024)); } \
        else { _Pragma("unroll") for (int n = 0; n < 2; ++n) _Pragma("unroll") for (int k = 0; k < 2; ++k) dst[n][k] = *(const PG8_LAS bf16x8*)(lds + PG8_SB(b, h) + boff + n * 2048 + k * 1024); } } while (0)
#define PG8_MMA(ai, bj, At, Bt) do { __builtin_amdgcn_s_setprio(1); if constexpr (FP8) { _Pragma("unroll") for (int m = 0; m < 4; ++m) _Pragma("unroll") for (int n = 0; n < 2; ++n) \
        asm volatile("v_mfma_scale_f32_16x16x128_f8f6f4 %0, %1, %2, %0, %3, %3 op_sel_hi:[0,0,0]" : "+v"(acc[ai][bj][m][n]) : "v"(Bt##8[n]), "v"(At##8[m]), "v"(f8scale)); } else { \
        _Pragma("unroll") for (int m = 0; m < 4; ++m) _Pragma("unroll") for (int n = 0; n < 2; ++n) _Pragma("unroll") for (int k = 0; k < 2; ++k) { \
        if constexpr (I8) acc[ai][bj][m][n] = __builtin_bit_cast(f32x4, __builtin_amdgcn_mfma_i32_16x16x64_i8(__builtin_bit_cast(v4i32, Bt[n][k]), __builtin_bit_cast(v4i32, At[m][k]), __builtin_bit_cast(v4i32, acc[ai][bj][m][n]), 0, 0, 0)); \
        else acc[ai][bj][m][n] = __builtin_amdgcn_mfma_f32_16x16x32_bf16(Bt[n][k], At[m][k], acc[ai][bj][m][n], 0, 0, 0); } } __builtin_amdgcn_s_setprio(0); } while (0)
#define PG8_WAIT_V(n) asm volatile("s_waitcnt vmcnt(" #n ")" ::: "memory")
#define PG8_WAIT_L(n) asm volatile("s_waitcnt lgkmcnt(" #n ")" ::: "memory")
#define PG8_BAR __builtin_amdgcn_s_barrier()
#define PG8_SCHED __builtin_amdgcn_sched_barrier(0)
    Unit cur, nxt; int ui = 0;
    if (!S.next(0, cur)) return;
    f32x4 acc[2][2][4][2];
#pragma unroll
    for (int a = 0; a < 2; ++a)
#pragma unroll
        for (int b = 0; b < 2; ++b)
#pragma unroll
            for (int m = 0; m < 4; ++m)
#pragma unroll
                for (int n = 0; n < 2; ++n) acc[a][b][m][n] = (f32x4){0.f, 0.f, 0.f, 0.f};
    const int f8scale = 0x7f7f7f7f;
    bf16x8 At[4][2], B0[2][2], B1[2][2]; v8i32 At8[4], B08[2], B18[2];
    const char* cA = (const char*)g.A + S.a_off(cur, tstep); const char* cB = (const char*)g.Bt + S.b_off(cur, tstep);
    S.a_ready(cur);
    if constexpr (Sched::GATHER) { S.fill_all(); asm volatile("s_waitcnt vmcnt(0) lgkmcnt(0)" ::: "memory"); __builtin_amdgcn_s_barrier(); asm volatile("" ::: "memory"); PG8_ROWS(0); }
    if constexpr (SP2) {
        PG8_STAGE(PG8_SB(0, 0), cB, voffB); PG8_STAGE(PG8_SB(0, 1), cB + hstep, voffB); PG8_STAGE(PG8_SA(0, 0), cA, voffA); PG8_STAGE(PG8_SA(0, 1), cA + hstepA, voffA1);
        if (wr == 1) PG8_BAR;
        PG8_WAIT_V(2); PG8_BAR;
        PG8_STAGE(PG8_SB(1, 0), cB + kstep, voffB); PG8_STAGE(PG8_SA(1, 0), cA + kstep, voffA); PG8_STAGE(PG8_SB(1, 1), cB + hstep + kstep, voffB);
        PG8_WAIT_V(6); PG8_BAR;
    } else {
        PG8_STAGE(PG8_SB(0, 0), cB, voffB); PG8_STAGE(PG8_SA(0, 0), cA, voffA); PG8_STAGE(PG8_SB(0, 1), cB + hstep, voffB); PG8_STAGE(PG8_SA(0, 1), cA + hstepA, voffA1);
        if (wr == 1) PG8_BAR;
        PG8_WAIT_V(4); PG8_BAR;
        PG8_STAGE(PG8_SB(1, 0), cB + kstep, voffB); PG8_STAGE(PG8_SA(1, 0), cA + kstep, voffA); PG8_STAGE(PG8_SB(1, 1), cB + hstep + kstep, voffB);
        PG8_WAIT_V(6); PG8_BAR;
    }
    for (;;) {
        const bool has_next = S.next(ui + 1, nxt);
        const char* nA = has_next ? (const char*)g.A + S.a_off(nxt, tstep) : cA; const char* nB = has_next ? (const char*)g.Bt + S.b_off(nxt, tstep) : cB;
        for (int t = 0; t < nt; t += 2) {
            const bool last = (t == nt - 2);
            const char* a1 = cA + (size_t)(t + 1) * kstep;
            const char* a2 = last ? nA : cA + (size_t)(t + 2) * kstep; const char* b2 = last ? nB : cB + (size_t)(t + 2) * kstep;
            const char* a3 = a2 + kstep; const char* b3 = b2 + kstep;
            if (last && has_next) S.a_ready(nxt);
            if constexpr (SP2) {
            PG8_LDB(B0, 0, 0); PG8_LDB(B1, 0, 1); PG8_SCHED; PG8_LDA(At, 0, 0); PG8_STAGE(PG8_SA(1, 1), a1 + hstepA, voffA1);
            PG8_WAIT_V(8); PG8_WAIT_L(0); PG8_BAR; PG8_MMA(0, 0, At, B0); PG8_MMA(0, 1, At, B1); PG8_BAR; PG8_SCHED;
            if constexpr (Sched::GATHER) { if (last && has_next) PG8_ROWS(ui + 1); }
            PG8_LDA(At, 0, 1); PG8_STAGE(PG8_SB(0, 0), b2, voffB); PG8_STAGE(PG8_SB(0, 1), b2 + hstep, voffB); PG8_STAGE(PG8_SA(0, 0), a2, voffA);
            PG8_WAIT_V(8); PG8_WAIT_L(0); PG8_BAR; PG8_MMA(1, 0, At, B0); PG8_MMA(1, 1, At, B1); PG8_BAR; PG8_SCHED;
            PG8_LDB(B0, 1, 0); PG8_LDB(B1, 1, 1); PG8_SCHED; PG8_LDA(At, 1, 0); PG8_STAGE(PG8_SA(0, 1), a2 + hstepA, voffA1);
            PG8_WAIT_V(8); PG8_WAIT_L(0); PG8_BAR; PG8_MMA(0, 0, At, B0); PG8_MMA(0, 1, At, B1); PG8_BAR; PG8_SCHED;
            PG8_LDA(At, 1, 1); PG8_STAGE(PG8_SB(1, 0), b3, voffB); PG8_STAGE(PG8_SB(1, 1), b3 + hstep, voffB); PG8_STAGE(PG8_SA(1, 0), a3, voffA);
            PG8_WAIT_V(8); PG8_WAIT_L(0); PG8_BAR; PG8_MMA(1, 0, At, B0); PG8_MMA(1, 1, At, B1); PG8_BAR; PG8_SCHED;
            } else {
            PG8_LDB(B0, 0, 0); PG8_SCHED; PG8_LDA(At, 0, 0); PG8_STAGE(PG8_SA(1, 1), a1 + hstepA, voffA1);
            PG8_WAIT_L(8); PG8_BAR; PG8_WAIT_L(0); PG8_MMA(0, 0, At, B0); PG8_BAR; PG8_SCHED;
            PG8_LDB(B1, 0, 1); PG8_STAGE(PG8_SB(0, 0), b2, voffB);
            PG8_BAR; PG8_WAIT_L(0); PG8_MMA(0, 1, At, B1); PG8_BAR;
            PG8_LDA(At, 0, 1); PG8_STAGE(PG8_SA(0, 0), a2, voffA);
            PG8_BAR; PG8_WAIT_L(0); PG8_MMA(1, 0, At, B0); PG8_BAR; PG8_SCHED;
            PG8_STAGE(PG8_SB(0, 1), b2 + hstep, voffB);
            PG8_WAIT_V(6); PG8_BAR; PG8_MMA(1, 1, At, B1); PG8_BAR;
            PG8_LDB(B0, 1, 0); PG8_SCHED; PG8_LDA(At, 1, 0); PG8_STAGE(PG8_SA(0, 1), a2 + hstepA, voffA1);
            PG8_WAIT_L(8); PG8_BAR; PG8_WAIT_L(0); PG8_MMA(0, 0, At, B0); PG8_BAR; PG8_SCHED;
            PG8_LDB(B1, 1, 1); PG8_STAGE(PG8_SB(1, 0), b3, voffB);
            PG8_BAR; PG8_WAIT_L(0); PG8_MMA(0, 1, At, B1); PG8_BAR;
            PG8_LDA(At, 1, 1); PG8_STAGE(PG8_SA(1, 0), a3, voffA);
            PG8_BAR; PG8_WAIT_L(0); PG8_MMA(1, 0, At, B0); PG8_BAR; PG8_SCHED;
            PG8_STAGE(PG8_SB(1, 1), b3 + hstep, voffB);
            PG8_WAIT_V(6); PG8_BAR; PG8_MMA(1, 1, At, B1); PG8_BAR;
            }
        }
        if constexpr (ALIGN_EPI) { if (wr == 0) PG8_BAR; }
        if constexpr (FP8) { asm volatile("s_nop 15\n\ts_nop 15" ::: "memory"); }
        if constexpr (!Epi::AFTER_DRAIN) { E(acc, cur, wr, wc, fr, fq); S.done(cur); }
        if (!has_next) break;
#pragma unroll
        for (int a = 0; a < 2; ++a)
#pragma unroll
            for (int b = 0; b < 2; ++b)
#pragma unroll
                for (int m = 0; m < 4; ++m)
#pragma unroll
                    for (int n = 0; n < 2; ++n) acc[a][b][m][n] = (f32x4){0.f, 0.f, 0.f, 0.f};
        cur = nxt; cA = nA; cB = nB; ++ui;
        if constexpr (ALIGN_EPI) { if (wr == 1) PG8_BAR; }
    }
    PG8_WAIT_V(0);
    if constexpr (!ALIGN_EPI) { if (wr == 0) PG8_BAR; }
    PG8_BAR;
    if constexpr (Epi::AFTER_DRAIN) { E.fused(acc, cur, wr, wc, fr, fq, lds, wid, lane); S.done(cur); }
#undef PG8_ROWS
#undef PG8_SA
#undef PG8_SB
#undef PG8_STAGE
#undef PG8_LDA
#undef PG8_LDB
#undef PG8_MMA
#undef PG8_WAIT_V
#undef PG8_WAIT_L
#undef PG8_BAR
#undef PG8_SCHED
}
}

#ifndef MK_N_LAUNCHES
#define MK_N_LAUNCHES 1
#endif
#define GAS __attribute__((address_space(1)))
#define LAS __attribute__((address_space(3)))
typedef unsigned short bf16;
typedef unsigned v4u __attribute__((ext_vector_type(4)));
typedef unsigned v2u __attribute__((ext_vector_type(2)));
typedef float f32x4 __attribute__((ext_vector_type(4)));
typedef float f32x2 __attribute__((ext_vector_type(2)));

constexpr int NWAVES = 8, NTHR = 512;
constexpr int NPH = 13;
constexpr int D = 2048, BATCH = 8, SEQ = 2048, T = BATCH * SEQ;
constexpr int NIN = 10696, NINP = 10752;
constexpr int MLO = 3520, GTO = 6600;
constexpr int RH = 16, RD = 1024;
constexpr int MH = 4;
constexpr int NE = 32, FF = 2048, ECAP = 16384, PMAX = 65536 + NE * 256, MTMAX = PMAX / 256;
constexpr float NORM_EPS = 1e-6f, GN_EPS = 64e-5f;
constexpr size_t MiB = 1u << 20;
constexpr size_t WS_CTL = 0, CTL_ZERO_BYTES = 1 * MiB;
constexpr size_t WS_WIN = 1 * MiB, WS_WA = 43 * MiB, WS_WB = 47 * MiB, WS_WO = 51 * MiB, WS_WL = 59 * MiB;
constexpr size_t WS_RLIST = 62 * MiB, WS_RW = 64 * MiB, WS_RWS = 2787 * MiB, WS_RA = 2787 * MiB + 512 * 1024;
constexpr size_t WS_WGU = 66 * MiB, WS_WDN = 578 * MiB, WS_HN = 834 * MiB, WS_P = 898 * MiB, WS_LIN = 1234 * MiB, WS_WAG = 1250 * MiB;
constexpr size_t WS_YRAW = 1442 * MiB, WS_HRAW = 1506 * MiB, WS_OA = 1570 * MiB, WS_OB = 1602 * MiB, WS_TMP = 1634 * MiB, WS_MRG = 1762 * MiB;
constexpr size_t WS_QKC = WS_TMP, WS_GLF = WS_TMP + 64 * MiB;
constexpr size_t WS_X1 = 1826 * MiB, WS_XB = 1954 * MiB, WS_ACT = 2242 * MiB, WS_YS = 2530 * MiB, WS_END = 2788 * MiB;
constexpr int CW_BAR = 4096;
constexpr int CW_CVNEXT = 8192, CW_P1DONE = 8192 + 64;
constexpr int NCV = 64;
constexpr int CW_COLMAX = 32768;
constexpr int CW_CNT = 16384;
constexpr int RING_BYTES = 131072, MISC_OFF = RING_BYTES, LDS_BYTES = RING_BYTES + 8192 + 20 * 1024;
constexpr int MI_TILE_E = 64, MI_TILE_I0 = 64 + 320, MI_CNT = 64 + 640, MI_POFF = MI_CNT + 32, MI_CST = MI_POFF + 32, MI_MT = MI_CST + 40, MI_ROWOFF = 2048;

#define LDS_WAIT() asm volatile("s_waitcnt lgkmcnt(0)" ::: "memory")
#define VM_WAIT() asm volatile("s_waitcnt vmcnt(0)" ::: "memory")
__device__ __forceinline__ float bf2f(bf16 v) { return __uint_as_float(((unsigned)v) << 16); }
__device__ __forceinline__ unsigned f2bf(float f) { unsigned u = __float_as_uint(f); return (u + 0x7fffu + ((u >> 16) & 1u)) >> 16; }
typedef __bf16 bf16x2_t __attribute__((ext_vector_type(2)));
__device__ __forceinline__ unsigned pk2(float lo, float hi) { const f32x2 v = {lo, hi}; const bf16x2_t b = __builtin_convertvector(v, bf16x2_t); return __builtin_bit_cast(unsigned, b); }
__device__ __forceinline__ unsigned pk4f8(float a, float b, float c, float d) { int r = 0; r = __builtin_amdgcn_cvt_pk_fp8_f32(a, b, r, false); r = __builtin_amdgcn_cvt_pk_fp8_f32(c, d, r, true); return (unsigned)r; }
constexpr float F8_SX = 8.f, F8_SW = 256.f, F8_SA = 4.f;
__device__ __forceinline__ unsigned pk4i8(float a, float b, float c, float d) {
    const int ia = (int)__builtin_rintf(a), ib = (int)__builtin_rintf(b), ic = (int)__builtin_rintf(c), id = (int)__builtin_rintf(d);
    return (unsigned)(ia & 255) | ((unsigned)(ib & 255) << 8) | ((unsigned)(ic & 255) << 16) | ((unsigned)id << 24); }
__device__ __forceinline__ float wave_max(float v) {
#pragma unroll
    for (int o = 1; o < 64; o <<= 1) v = fmaxf(v, __shfl_xor(v, o));
    return v;
}
__device__ __forceinline__ float wave_sum(float v) {
#pragma unroll
    for (int o = 1; o < 64; o <<= 1) v += __shfl_xor(v, o);
    return v;
}
#define UNP4(v) ((f32x4){__uint_as_float((v).x << 16), __uint_as_float((v).x & 0xffff0000u), __uint_as_float((v).y << 16), __uint_as_float((v).y & 0xffff0000u)})
__device__ __forceinline__ float sigm(float x) { return __builtin_amdgcn_rcpf(1.f + __expf(-x)); }
template <int CTRL> __device__ __forceinline__ float dppf(float x) { return __builtin_bit_cast(float, __builtin_amdgcn_mov_dpp(__builtin_bit_cast(int, x), CTRL, 0xf, 0xf, true)); }
__device__ __forceinline__ float allreduce16(float x) { x += dppf<0x128>(x); x += dppf<0x124>(x); x += dppf<0x4E>(x); x += dppf<0xB1>(x); return x; }

#define XB_TMO      128
#define XB_XCNT(j)  (256  + 64 * (j))
#define XB_XSUB(j)  (1280 + 64 * (j))
#define XB_XGEN(j)  (2304 + 64 * (j))
#define XB_TOP      3328
#define XB_TOPGEN   3392
#define XCD_BAR_WORDS 3456
#define XB_SPIN_CAP (1u << 18)
__device__ __forceinline__ unsigned xb_ld(unsigned* p)              { return __hip_atomic_load(p, __ATOMIC_RELAXED, __HIP_MEMORY_SCOPE_AGENT); }
__device__ __forceinline__ unsigned xb_add(unsigned* p, unsigned v) { return __hip_atomic_fetch_add(p, v, __ATOMIC_RELAXED, __HIP_MEMORY_SCOPE_AGENT); }
__device__ __forceinline__ unsigned xb_xcc_id() { return (unsigned)__builtin_amdgcn_s_getreg((3 << 11) | 20) & 0xFu; }
#define XB_SPIN(cond, bar) do { unsigned _sp = 0; while (cond) { __builtin_amdgcn_s_sleep(1); \
    if ((++_sp & 255u) == 0u) { if (xb_ld(&(bar)[XB_TMO])) break; if (_sp > XB_SPIN_CAP) { atomicAdd(&(bar)[XB_TMO], 1u); break; } } } } while (0)
struct XcdBarrier { unsigned* bar; unsigned x; volatile LAS unsigned* st; };
__device__ __forceinline__ XcdBarrier xcd_barrier_post(unsigned* bar, volatile LAS unsigned* st) {
    XcdBarrier b; b.bar = bar; b.x = xb_xcc_id(); b.st = st;
    if (threadIdx.x == 0) (void)xb_add(&bar[XB_XCNT(b.x)], 1u);
    return b;
}
__device__ __forceinline__ void xcd_barrier_complete(unsigned* bar, unsigned x, unsigned& nloc, unsigned& nx) {
    const unsigned G = gridDim.x * gridDim.y * gridDim.z;
    unsigned sum, cnt, mine, sp = 0u;
    for (;;) {
        sum = 0u; cnt = 0u; mine = 0u;
#pragma unroll
        for (unsigned j = 0; j < 16; ++j) { const unsigned c = xb_ld(&bar[XB_XCNT(j)]); sum += c; cnt += (c > 0u) ? 1u : 0u; mine = (j == x) ? c : mine; }
        if (sum == G) break;
        __builtin_amdgcn_s_sleep(1);
        if ((++sp & 255u) == 0u) { if (xb_ld(&bar[XB_TMO])) break; if (sp > XB_SPIN_CAP) { atomicAdd(&bar[XB_TMO], 1u); break; } }
    }
    nloc = mine > 0u ? mine : 1u; nx = cnt > 0u ? cnt : 1u;
}
__device__ __forceinline__ void xcd_barrier(const XcdBarrier& b) {
    asm volatile("s_waitcnt vmcnt(0)" ::: "memory");
    __syncthreads();
    if (threadIdx.x == 0) {
        unsigned* bar = b.bar;
        __builtin_amdgcn_s_waitcnt(0);
        unsigned nloc = b.st[0], nx = b.st[1];
        if (nloc == 0u) { xcd_barrier_complete(bar, b.x, nloc, nx); b.st[0] = nloc; b.st[1] = nx; }
        const unsigned old = xb_add(&bar[XB_XSUB(b.x)], 1u);
        const unsigned gen = old / nloc;
        if (old + 1u == (gen + 1u) * nloc) {
            __builtin_amdgcn_fence(__ATOMIC_RELEASE, "agent");
            asm volatile("s_waitcnt vmcnt(0)" ::: "memory");
            const unsigned og = xb_add(&bar[XB_TOP], 1u);
            const unsigned tg = og / nx;
            if (og + 1u == (tg + 1u) * nx) xb_add(&bar[XB_TOPGEN], 1u);
            else XB_SPIN(xb_ld(&bar[XB_TOPGEN]) == tg, bar);
            __builtin_amdgcn_fence(__ATOMIC_ACQUIRE, "agent");
            xb_add(&bar[XB_XGEN(b.x)], 1u);
            asm volatile("s_waitcnt vmcnt(0)" ::: "memory");
        } else {
            XB_SPIN(xb_ld(&bar[XB_XGEN(b.x)]) == gen, bar);
            __builtin_amdgcn_fence(__ATOMIC_ACQUIRE, "agent");
            asm volatile("s_waitcnt vmcnt(0)" ::: "memory");
        }
    }
    __syncthreads();
}

struct Args { const float* in[30]; float* out; unsigned char* ws; int ph_lo, ph_hi; };
enum { I_X = 0, I_N1W, I_WIN, I_BGATE, I_MU, I_W0, I_WUP, I_A0, I_AUP, I_GUP, I_KK, I_KA, I_RK, I_LNW, I_LNB, I_CONVW, I_IB, I_FB, I_MNW, I_WBA, I_WBB, I_WOUT, I_N2W, I_RTW, I_RTB, I_WGU, I_BGU, I_WDN, I_BDN, I_FNW };

struct Frame {
    LAS unsigned char* lds; volatile LAS unsigned* MISC; unsigned* ctl;
    int tid, lane, wave, G, bid;
    const float* const* in; float* out; unsigned char* ws;
};

using pg8::Unit; using pg8::HALF; using pg8::BM;
struct EpiBf16Plain {
    static constexpr bool PERM = true, AFTER_DRAIN = false;
    bf16* O; int ldc;
    __device__ __forceinline__ void operator()(const f32x4 (&acc)[2][2][4][2], const Unit& u, int wr, int wc, int fr, int fq) const {
        const int row0 = u.pm * BM + wr * 64 + fr, col0 = u.pn * BM + wc * 32 + 8 * fq;
#pragma unroll
        for (int ai = 0; ai < 2; ++ai)
#pragma unroll
            for (int m = 0; m < 4; ++m) { bf16* rowp = O + (size_t)(row0 + ai * HALF + m * 16) * ldc + col0;
#pragma unroll
                for (int bj = 0; bj < 2; ++bj) { const f32x4 v0 = acc[ai][bj][m][0], v1 = acc[ai][bj][m][1];
                    v4u w; w.x = pg8::cvt_pk_bf16(v0[0], v0[1]); w.y = pg8::cvt_pk_bf16(v0[2], v0[3]); w.z = pg8::cvt_pk_bf16(v1[0], v1[1]); w.w = pg8::cvt_pk_bf16(v1[2], v1[3]);
                    *(v4u*)(rowp + bj * HALF) = w; } }
    }
};
struct EpiP1I8 {
    static constexpr bool PERM = true, AFTER_DRAIN = false;
    bf16* O; int ldc; const float* ra; const unsigned* colmax;
    __device__ __forceinline__ void operator()(const f32x4 (&acc)[2][2][4][2], const Unit& u, int wr, int wc, int fr, int fq) const {
        const int row0 = u.pm * BM + wr * 64 + fr, col0 = u.pn * BM + wc * 32 + 8 * fq;
        f32x4 cb[2][2];
#pragma unroll
        for (int bj = 0; bj < 2; ++bj)
#pragma unroll
            for (int n = 0; n < 2; ++n) { const v4u cm = *(const v4u*)(colmax + col0 + bj * HALF + 4 * n);
                cb[bj][n] = (f32x4){__uint_as_float(cm.x), __uint_as_float(cm.y), __uint_as_float(cm.z), __uint_as_float(cm.w)} * (1.f / 127.f); }
#pragma unroll
        for (int ai = 0; ai < 2; ++ai)
#pragma unroll
            for (int m = 0; m < 4; ++m) { const int r = row0 + ai * HALF + m * 16; const float rs = ra[r]; bf16* rowp = O + (size_t)r * ldc + col0;
#pragma unroll
                for (int bj = 0; bj < 2; ++bj) { const v4u i0 = __builtin_bit_cast(v4u, acc[ai][bj][m][0]), i1 = __builtin_bit_cast(v4u, acc[ai][bj][m][1]);
                    const f32x4 v0 = (f32x4){(float)(int)i0.x, (float)(int)i0.y, (float)(int)i0.z, (float)(int)i0.w} * cb[bj][0] * rs, v1 = (f32x4){(float)(int)i1.x, (float)(int)i1.y, (float)(int)i1.z, (float)(int)i1.w} * cb[bj][1] * rs;
                    v4u w; w.x = pk2(v0[0], v0[1]); w.y = pk2(v0[2], v0[3]); w.z = pk2(v1[0], v1[1]); w.w = pk2(v1[2], v1[3]);
                    *(v4u*)(rowp + bj * HALF) = w; } }
    }
};
struct EpiLora {
    static constexpr bool PERM = false, AFTER_DRAIN = false;
    float* O; const float* w0; const float* a0;
    __device__ __forceinline__ void operator()(const f32x4 (&acc)[2][2][4][2], const Unit& u, int wr, int wc, int fr, int fq) const {
        const int row0 = u.pm * BM + wr * 64 + fr, col0 = u.pn * BM + wc * 32 + 4 * fq, seg = u.pn >> 2;
        f32x4 bv[2][2];
#pragma unroll
        for (int bj = 0; bj < 2; ++bj)
#pragma unroll
            for (int n = 0; n < 2; ++n) { const int c = col0 + bj * HALF + n * 16;
                bv[bj][n] = seg == 0 ? *(const f32x4*)(w0 + c) : (seg == 1 ? *(const f32x4*)(a0 + (c - 1024)) : (f32x4){0.f, 0.f, 0.f, 0.f}); }
#pragma unroll
        for (int ai = 0; ai < 2; ++ai)
#pragma unroll
            for (int m = 0; m < 4; ++m) { float* rowp = O + (size_t)(row0 + ai * HALF + m * 16) * 3072 + col0;
#pragma unroll
                for (int bj = 0; bj < 2; ++bj)
#pragma unroll
                    for (int n = 0; n < 2; ++n) { f32x4 v = acc[ai][bj][m][n] + bv[bj][n];
                        if (seg == 0) {
#pragma unroll
                            for (int j = 0; j < 4; ++j) v[j] = -0.6065306597126334f * sigm(v[j]); }
                        else if (seg == 1) {
#pragma unroll
                            for (int j = 0; j < 4; ++j) v[j] = sigm(v[j]); }
                        *(f32x4*)(rowp + bj * HALF + n * 16) = v; } }
    }
};
struct EpiGateA {
    static constexpr bool PERM = true, AFTER_DRAIN = false;
    float* TMP; const bf16* P; const float* bg;
    __device__ __forceinline__ void operator()(const f32x4 (&acc)[2][2][4][2], const Unit& u, int wr, int wc, int fr, int fq) const {
        const int row0 = u.pm * BM + wr * 64 + fr, col0 = u.pn * BM + wc * 32 + 8 * fq;
#pragma unroll
        for (int ai = 0; ai < 2; ++ai)
#pragma unroll
            for (int m = 0; m < 4; ++m) { const size_t r = (size_t)(row0 + ai * HALF + m * 16);
#pragma unroll
                for (int bj = 0; bj < 2; ++bj) { const int c = col0 + bj * HALF;
                    const v4u pg = *(const v4u*)(P + r * NINP + GTO + c); const f32x4 b0 = *(const f32x4*)(bg + c), b1 = *(const f32x4*)(bg + c + 4);
                    f32x4 g0, g1;
                    g0[0] = sigm(__uint_as_float(pg.x << 16) + b0[0]); g0[1] = sigm(__uint_as_float(pg.x & 0xffff0000u) + b0[1]);
                    g0[2] = sigm(__uint_as_float(pg.y << 16) + b0[2]); g0[3] = sigm(__uint_as_float(pg.y & 0xffff0000u) + b0[3]);
                    g1[0] = sigm(__uint_as_float(pg.z << 16) + b1[0]); g1[1] = sigm(__uint_as_float(pg.z & 0xffff0000u) + b1[1]);
                    g1[2] = sigm(__uint_as_float(pg.w << 16) + b1[2]); g1[3] = sigm(__uint_as_float(pg.w & 0xffff0000u) + b1[3]);
                    *(f32x4*)(TMP + r * D + c) = g0 * acc[ai][bj][m][0]; *(f32x4*)(TMP + r * D + c + 4) = g1 * acc[ai][bj][m][1]; } }
    }
};
struct EpiGateB {
    static constexpr bool PERM = true, AFTER_DRAIN = false;
    const float* TMP; bf16* MRG; const bf16* P; const float* bg;
    __device__ __forceinline__ void operator()(const f32x4 (&acc)[2][2][4][2], const Unit& u, int wr, int wc, int fr, int fq) const {
        const int row0 = u.pm * BM + wr * 64 + fr, col0 = u.pn * BM + wc * 32 + 8 * fq;
#pragma unroll
        for (int ai = 0; ai < 2; ++ai)
#pragma unroll
            for (int m = 0; m < 4; ++m) { const size_t r = (size_t)(row0 + ai * HALF + m * 16);
#pragma unroll
                for (int bj = 0; bj < 2; ++bj) { const int c = col0 + bj * HALF;
                    const v4u pg = *(const v4u*)(P + r * NINP + GTO + D + c); const f32x4 b0 = *(const f32x4*)(bg + D + c), b1 = *(const f32x4*)(bg + D + c + 4);
                    const f32x4 t0 = *(const f32x4*)(TMP + r * D + c), t1 = *(const f32x4*)(TMP + r * D + c + 4);
                    f32x4 g0, g1;
                    g0[0] = sigm(__uint_as_float(pg.x << 16) + b0[0]); g0[1] = sigm(__uint_as_float(pg.x & 0xffff0000u) + b0[1]);
                    g0[2] = sigm(__uint_as_float(pg.y << 16) + b0[2]); g0[3] = sigm(__uint_as_float(pg.y & 0xffff0000u) + b0[3]);
                    g1[0] = sigm(__uint_as_float(pg.z << 16) + b1[0]); g1[1] = sigm(__uint_as_float(pg.z & 0xffff0000u) + b1[1]);
                    g1[2] = sigm(__uint_as_float(pg.w << 16) + b1[2]); g1[3] = sigm(__uint_as_float(pg.w & 0xffff0000u) + b1[3]);
                    const f32x4 v0 = t0 + g0 * acc[ai][bj][m][0], v1 = t1 + g1 * acc[ai][bj][m][1];
                    v4u w; w.x = pg8::cvt_pk_bf16(v0[0], v0[1]); w.y = pg8::cvt_pk_bf16(v0[2], v0[3]); w.z = pg8::cvt_pk_bf16(v1[0], v1[1]); w.w = pg8::cvt_pk_bf16(v1[2], v1[3]);
                    *(v4u*)(MRG + r * D + c) = w; } }
    }
};
struct EpiResid {
    static constexpr bool PERM = false, AFTER_DRAIN = false;
    const float* X; float* O;
    __device__ __forceinline__ void operator()(const f32x4 (&acc)[2][2][4][2], const Unit& u, int wr, int wc, int fr, int fq) const {
        const int row0 = u.pm * BM + wr * 64 + fr, col0 = u.pn * BM + wc * 32 + 4 * fq;
#pragma unroll
        for (int ai = 0; ai < 2; ++ai)
#pragma unroll
            for (int m = 0; m < 4; ++m) { const size_t off = (size_t)(row0 + ai * HALF + m * 16) * D + col0;
#pragma unroll
                for (int bj = 0; bj < 2; ++bj)
#pragma unroll
                    for (int n = 0; n < 2; ++n) *(f32x4*)(O + off + bj * HALF + n * 16) = *(const f32x4*)(X + off + bj * HALF + n * 16) + acc[ai][bj][m][n]; }
    }
};
struct MoeOrder : pg8::StaticOrder {
    const LAS int* tile_e; size_t estride;
    __device__ __forceinline__ size_t b_off(const Unit& u, size_t tstep) const { return (size_t)tile_e[u.pm] * estride + (size_t)u.pn * tstep; }
};
struct MoeGatherOrder : MoeOrder {
    static constexpr bool GATHER = true;
    const LAS int* tile_i0; const LAS int* cnt; const int* rlist; LAS unsigned* rowoff; unsigned rowbytes;
    __device__ __forceinline__ size_t a_off(const Unit&, size_t) const { return 0; }
    __device__ __forceinline__ void fill_all() const { const int tid = threadIdx.x, r = tid & 255;
        for (int u0 = tid >> 8; ; u0 += 6) { Unit ua, ub, uc; const bool va = next(u0, ua), vb = next(u0 + 2, ub), vc = next(u0 + 4, uc); if (!va) break;
            int ta = 0, tb = 0, tc = 0;
            { const int e = tile_e[ua.pm], i = tile_i0[ua.pm] + r; if (i < cnt[e]) ta = rlist[e * ECAP + i]; }
            if (vb) { const int e = tile_e[ub.pm], i = tile_i0[ub.pm] + r; if (i < cnt[e]) tb = rlist[e * ECAP + i]; }
            if (vc) { const int e = tile_e[uc.pm], i = tile_i0[uc.pm] + r; if (i < cnt[e]) tc = rlist[e * ECAP + i]; }
            rowoff[u0 * 256 + r] = (unsigned)(ta >> 2) * rowbytes; if (vb) rowoff[(u0 + 2) * 256 + r] = (unsigned)(tb >> 2) * rowbytes; if (vc) rowoff[(u0 + 4) * 256 + r] = (unsigned)(tc >> 2) * rowbytes; } }
    __device__ __forceinline__ unsigned row_off(int ui, int r) const { return rowoff[ui * 256 + r]; }
};
struct EpiSwiGLU {
    static constexpr bool PERM = true, AFTER_DRAIN = false;
    unsigned char* ACT; const float* bgu; const LAS int* tile_e;
    __device__ __forceinline__ void operator()(const f32x4 (&acc)[2][2][4][2], const Unit& u, int wr, int wc, int fr, int fq) const {
        const int row0 = u.pm * BM + wr * 64 + fr, colg = u.pn * 128 + wc * 32 + 8 * fq; const int e = tile_e[u.pm];
        const float* bp = bgu + (size_t)e * 4096 + colg;
        const f32x4 bg0 = *(const f32x4*)(bp), bg1 = *(const f32x4*)(bp + 4), bu0 = *(const f32x4*)(bp + 2048), bu1 = *(const f32x4*)(bp + 2052);
#pragma unroll
        for (int ai = 0; ai < 2; ++ai)
#pragma unroll
            for (int m = 0; m < 4; ++m) { const size_t r = (size_t)(row0 + ai * HALF + m * 16);
                constexpr float DS = 1.f / (F8_SX * F8_SW);
                const f32x4 ga = acc[ai][0][m][0] * DS + bg0, gb = acc[ai][0][m][1] * DS + bg1, ua = acc[ai][1][m][0] * DS + bu0, ub = acc[ai][1][m][1] * DS + bu1;
                float o[8];
#pragma unroll
                for (int j = 0; j < 4; ++j) { const float g = fminf(ga[j], 7.f), up = fminf(fmaxf(ua[j], -7.f), 7.f); o[j] = F8_SA * (up + 1.f) * g * sigm(1.702f * g);
                                              const float g2 = fminf(gb[j], 7.f), up2 = fminf(fmaxf(ub[j], -7.f), 7.f); o[4 + j] = F8_SA * (up2 + 1.f) * g2 * sigm(1.702f * g2); }
                v2u w; w.x = pk4f8(o[0], o[1], o[2], o[3]); w.y = pk4f8(o[4], o[5], o[6], o[7]);
                *(v2u*)(ACT + r * FF + colg) = w; }
    }
};
struct EpiDown {
    static constexpr bool PERM = true, AFTER_DRAIN = false;
    bf16* YS; const float* bdn; const LAS int* tile_e; const LAS int* rowdst; const LAS float* rowwt;
    __device__ __forceinline__ void operator()(const f32x4 (&acc)[2][2][4][2], const Unit& u, int wr, int wc, int fr, int fq) const {
        const int e = tile_e[u.pm]; const int col0 = u.pn * BM + wc * 32 + 8 * fq;
        const float* bp = bdn + (size_t)e * D + col0; constexpr float DS = 1.f / (F8_SA * F8_SW);
#pragma unroll
        for (int bj = 0; bj < 2; ++bj) { const f32x4 b0 = *(const f32x4*)(bp + bj * HALF), b1 = *(const f32x4*)(bp + bj * HALF + 4);
#pragma unroll
            for (int ai = 0; ai < 2; ++ai)
#pragma unroll
                for (int m = 0; m < 4; ++m) { const int r = u.ord * 256 + ai * HALF + wr * 64 + m * 16 + fr;
                    const int dst = rowdst[r]; const float w = rowwt[r];
                    const f32x4 v0 = (acc[ai][bj][m][0] * DS + b0) * w, v1 = (acc[ai][bj][m][1] * DS + b1) * w;
                    v4u o; o.x = pg8::cvt_pk_bf16(v0[0], v0[1]); o.y = pg8::cvt_pk_bf16(v0[2], v0[3]); o.z = pg8::cvt_pk_bf16(v1[0], v1[1]); o.w = pg8::cvt_pk_bf16(v1[2], v1[3]);
                    *(v4u*)(YS + (size_t)dst * D + col0 + bj * HALF) = o; } }
    }
};
template <class Sched> __device__ __forceinline__ void fill_down_tables(Frame& F, const Sched& S, LAS int* rowdst, LAS float* rowwt) {
    const LAS int* MI = (const LAS int*)F.MISC; const int* rlist = (const int*)(F.ws + WS_RLIST); const float* rw = (const float*)(F.ws + WS_RW);
    const int r = F.tid & 255;
    for (int u0 = F.tid >> 8; ; u0 += 4) { Unit ua, ub; const bool va = S.next(u0, ua), vb = S.next(u0 + 2, ub); if (!va) break;
        int da = T * 4, db = T * 4; float wa = 0.f, wb = 0.f;
        { const int e = MI[MI_TILE_E + ua.pm], i = MI[MI_TILE_I0 + ua.pm] + r; if (i < MI[MI_CNT + e]) { da = rlist[e * ECAP + i]; wa = rw[e * ECAP + i]; } }
        if (vb) { const int e = MI[MI_TILE_E + ub.pm], i = MI[MI_TILE_I0 + ub.pm] + r; if (i < MI[MI_CNT + e]) { db = rlist[e * ECAP + i]; wb = rw[e * ECAP + i]; } }
        rowdst[u0 * 256 + r] = da; rowwt[u0 * 256 + r] = wa; if (vb) { rowdst[(u0 + 2) * 256 + r] = db; rowwt[(u0 + 2) * 256 + r] = wb; } }
    __syncthreads();
}

__device__ __forceinline__ void transpose_item(const float* __restrict__ W, int N, int k0, int n0, bf16* WT, int dst_row0, int ldk, LAS float* scr, int lane) {
    const int n = n0 + (lane & 31); const bool ok = n < N;
#pragma unroll 8
    for (int i = 0; i < 32; ++i) { const int kk = 2 * i + (lane >> 5); scr[kk * 33 + (lane & 31)] = ok ? W[(size_t)(k0 + kk) * N + n] : 0.f; }
    LDS_WAIT(); asm volatile("" ::: "memory");
    const int c = lane & 7;
#pragma unroll
    for (int j = 0; j < 4; ++j) { const int nn = (lane >> 3) + 8 * j; const LAS float* s = scr + (8 * c) * 33 + nn;
        v4u o; o.x = pk2(s[0 * 33], s[1 * 33]); o.y = pk2(s[2 * 33], s[3 * 33]); o.z = pk2(s[4 * 33], s[5 * 33]); o.w = pk2(s[6 * 33], s[7 * 33]);
        *(v4u*)(WT + (size_t)(dst_row0 + nn) * ldk + k0 + 8 * c) = o; }
    LDS_WAIT(); asm volatile("" ::: "memory");
}
__device__ __forceinline__ void transpose_item_i8(const float* __restrict__ W, int N, int k0, int n0, unsigned char* WT, int dst_row0, int ldk, const unsigned* colmax, LAS float* scr, int lane) {
    const int n = n0 + (lane & 31); const bool ok = n < N;
#pragma unroll 8
    for (int i = 0; i < 32; ++i) { const int kk = 2 * i + (lane >> 5); scr[kk * 33 + (lane & 31)] = ok ? W[(size_t)(k0 + kk) * N + n] : 0.f; }
    LDS_WAIT(); asm volatile("" ::: "memory");
#pragma unroll
    for (int j = 0; j < 2; ++j) { const int ch = lane + 64 * j, nn = ch >> 2, c = ch & 3; const LAS float* s = scr + (16 * c) * 33 + nn;
        const float cm = __uint_as_float(colmax[n0 + nn]); const float sc = cm > 0.f ? 127.f / cm : 0.f;
        v4u o; o.x = pk4i8(s[0 * 33] * sc, s[1 * 33] * sc, s[2 * 33] * sc, s[3 * 33] * sc); o.y = pk4i8(s[4 * 33] * sc, s[5 * 33] * sc, s[6 * 33] * sc, s[7 * 33] * sc);
        o.z = pk4i8(s[8 * 33] * sc, s[9 * 33] * sc, s[10 * 33] * sc, s[11 * 33] * sc); o.w = pk4i8(s[12 * 33] * sc, s[13 * 33] * sc, s[14 * 33] * sc, s[15 * 33] * sc);
        *(v4u*)(WT + (size_t)(dst_row0 + nn) * ldk + k0 + 16 * c) = o; }
    LDS_WAIT(); asm volatile("" ::: "memory");
}
__device__ __forceinline__ void p0b_win(Frame& F) {
    LAS float* scr = (LAS float*)(F.lds + F.wave * 16384);
    const int gw = F.bid * NWAVES + F.wave, NGW = F.G * NWAVES; unsigned char* WIN8 = F.ws + WS_WIN; const unsigned* colmax = F.ctl + CW_COLMAX;
    constexpr int NB_WIN = (NIN + 31) / 32;
    for (int it = gw; it < 32 * NB_WIN; it += NGW) { const int kb = it / NB_WIN, nb = it % NB_WIN; transpose_item_i8(F.in[I_WIN], NIN, kb * 64, nb * 32, WIN8, nb * 32, D, colmax, scr, F.lane); }
    { const int gt = F.bid * NTHR + F.tid, NGT = F.G * NTHR; constexpr int Z0 = NB_WIN * 32 * D, Z1 = NINP * D;
      for (int i = Z0 + gt * 16; i < Z1; i += NGT * 16) *(v4u*)(WIN8 + i) = (v4u){0u, 0u, 0u, 0u}; }
}
__device__ __forceinline__ void p0_prologue(Frame& F) {
    LAS float* scr = (LAS float*)(F.lds + F.wave * 16384);
    const int gw = F.bid * NWAVES + F.wave, NGW = F.G * NWAVES;
    bf16* WIN_T = (bf16*)(F.ws + WS_WIN); bf16* WA_T = (bf16*)(F.ws + WS_WA); bf16* WB_T = (bf16*)(F.ws + WS_WB); bf16* WO_T = (bf16*)(F.ws + WS_WO);
    bf16* WGU_T = (bf16*)(F.ws + WS_WGU); bf16* WDN_T = (bf16*)(F.ws + WS_WDN); bf16* WL_T = (bf16*)(F.ws + WS_WL); bf16* HN = (bf16*)(F.ws + WS_HN);
    { const float* W = F.in[I_WIN]; unsigned* colmax = F.ctl + CW_COLMAX;
      for (int task = gw; task < 168 * 16; task += NGW) { const int cb = task % 168, kc = task / 168, n = cb * 64 + F.lane; float m = 0.f;
          if (n < NIN) { const float* wp = W + (size_t)(kc * 128) * NIN + n;
#pragma unroll 1
              for (int k0 = 0; k0 < 128; k0 += 32) { float v[32];
#pragma unroll
                  for (int i = 0; i < 32; ++i) v[i] = wp[(size_t)(k0 + i) * NIN];
#pragma unroll
                  for (int i = 0; i < 32; ++i) m = fmaxf(m, fabsf(v[i])); }
              atomicMax(colmax + n, __float_as_uint(m)); } } }
    { const int gt = F.bid * NTHR + F.tid, NGT = F.G * NTHR;
      for (int i = gt; i < 3072 * 512; i += NGT) { const int n = i >> 9, k = i & 511; float v = 0.f;
          if (n < 1024) { if (k < 96) v = F.in[I_WUP][k * RD + n]; }
          else if (n < 2048) { if (k >= 128 && k < 224) v = F.in[I_AUP][(k - 128) * RD + (n - 1024)]; }
          else { if (k >= 256) v = F.in[I_GUP][(k - 256) * RD + (n - 2048)]; }
          WL_T[i] = (bf16)f2bf(v); } }
    { const int gt = F.bid * NTHR + F.tid, NGT = F.G * NTHR; float* RWS = (float*)(F.ws + WS_RWS);
      for (int i = gt; i < D * NE; i += NGT) RWS[i] = F.in[I_N2W][i >> 5] * F.in[I_RTW][i]; }
    const float* x = F.in[I_X]; const float* nw = F.in[I_N1W];
    for (int m = gw; m < T; m += NGW) {
        const f32x4* xr = (const f32x4*)(x + (size_t)m * D) + F.lane; f32x4 v[8]; float s = 0.f;
#pragma unroll
        for (int j = 0; j < 8; ++j) { v[j] = xr[64 * j]; s += (v[j][0] * v[j][0] + v[j][1] * v[j][1]) + (v[j][2] * v[j][2] + v[j][3] * v[j][3]); }
        const float rstd = __builtin_amdgcn_rsqf(wave_sum(s) * (1.f / D) + NORM_EPS);
        float am = 0.f;
#pragma unroll
        for (int j = 0; j < 8; ++j) { const f32x4 w = ((const f32x4*)nw)[F.lane + 64 * j]; v[j] = v[j] * rstd * w; am = fmaxf(fmaxf(am, fmaxf(fabsf(v[j][0]), fabsf(v[j][1]))), fmaxf(fabsf(v[j][2]), fabsf(v[j][3]))); }
        am = wave_max(am); const float sc = am > 0.f ? 127.f / am : 0.f;
        if (F.lane == 0) ((float*)(F.ws + WS_RA))[m] = am * (1.f / 127.f);
        unsigned* o4 = (unsigned*)((unsigned char*)HN + (size_t)m * D) + F.lane;
#pragma unroll
        for (int j = 0; j < 8; ++j) o4[64 * j] = pk4i8(v[j][0] * sc, v[j][1] * sc, v[j][2] * sc, v[j][3] * sc);
    }
}

__device__ __forceinline__ void p2_lora_in(Frame& F) {
    const bf16* __restrict__ P = (const bf16*)(F.ws + WS_P); bf16* __restrict__ LIN = (bf16*)(F.ws + WS_LIN); const float* __restrict__ mu = F.in[I_MU];
    const int gt = F.bid * NTHR + F.tid, NGT = F.G * NTHR;
#pragma unroll 2
    for (int i = gt; i < T * 64; i += NGT) { const int t = i >> 6, g = i & 63; int col = -1, kind = 0;
        if (g < 12) { col = 3072 + 8 * g; kind = 0; } else if (g >= 16 && g < 28) { col = 3168 + 8 * (g - 16); kind = 1; } else if (g >= 32) { col = 3264 + 8 * (g - 32); kind = 2; }
        v4u o = (v4u){0u, 0u, 0u, 0u};
        if (col >= 0) { const v4u pc = *(const v4u*)(P + (size_t)t * NINP + col); v4u pp = (v4u){0u, 0u, 0u, 0u}; if (t & (SEQ - 1)) pp = *(const v4u*)(P + (size_t)(t - 1) * NINP + col);
            const f32x4 m0 = *(const f32x4*)(mu + col), m1 = *(const f32x4*)(mu + col + 4);
            const unsigned pcs[4] = {pc.x, pc.y, pc.z, pc.w}, pps[4] = {pp.x, pp.y, pp.z, pp.w}; float x[8];
#pragma unroll
            for (int k = 0; k < 4; ++k) { const float c0 = __uint_as_float(pcs[k] << 16), c1 = __uint_as_float(pcs[k] & 0xffff0000u), q0 = __uint_as_float(pps[k] << 16), q1 = __uint_as_float(pps[k] & 0xffff0000u);
                const float ma = k < 2 ? m0[2 * k] : m1[2 * k - 4], mb = k < 2 ? m0[2 * k + 1] : m1[2 * k - 3];
                x[2 * k] = c0 + (q0 - c0) * ma; x[2 * k + 1] = c1 + (q1 - c1) * mb; }
#pragma unroll
            for (int k = 0; k < 8; ++k) x[k] = kind == 0 ? tanhf(x[k]) : (kind == 1 ? x[k] : sigm(x[k]));
            o.x = pk2(x[0], x[1]); o.y = pk2(x[2], x[3]); o.z = pk2(x[4], x[5]); o.w = pk2(x[6], x[7]); }
        *(v4u*)(LIN + (size_t)t * 512 + 8 * g) = o; }
    { bf16* __restrict__ QKC = (bf16*)(F.ws + WS_QKC); const float* __restrict__ cw = F.in[I_CONVW];
      for (int i = gt; i < T * 128; i += NGT) { const int t = i >> 7, c0 = 8 * (i & 127); const int sq = t & (SEQ - 1); float acc[8];
#pragma unroll
          for (int k = 0; k < 8; ++k) acc[k] = 0.f;
#pragma unroll
          for (int j = 0; j < 4; ++j) { if (sq - 3 + j >= 0) { const v4u pv = *(const v4u*)(P + (size_t)(t - 3 + j) * NINP + MLO + c0); const f32x4 w0 = *(const f32x4*)(cw + j * 1024 + c0), w1 = *(const f32x4*)(cw + j * 1024 + c0 + 4);
                  acc[0] += __uint_as_float(pv.x << 16) * w0[0]; acc[1] += __uint_as_float(pv.x & 0xffff0000u) * w0[1]; acc[2] += __uint_as_float(pv.y << 16) * w0[2]; acc[3] += __uint_as_float(pv.y & 0xffff0000u) * w0[3];
                  acc[4] += __uint_as_float(pv.z << 16) * w1[0]; acc[5] += __uint_as_float(pv.z & 0xffff0000u) * w1[1]; acc[6] += __uint_as_float(pv.w << 16) * w1[2]; acc[7] += __uint_as_float(pv.w & 0xffff0000u) * w1[3]; } }
          const float sc = c0 < 512 ? 0.08838834764831845f : 1.f;
#pragma unroll
          for (int k = 0; k < 8; ++k) acc[k] = acc[k] * sigm(acc[k]) * sc;
          v4u o; o.x = pk2(acc[0], acc[1]); o.y = pk2(acc[2], acc[3]); o.z = pk2(acc[4], acc[5]); o.w = pk2(acc[6], acc[7]); *(v4u*)(QKC + (size_t)t * 1024 + c0) = o; } }
    { float* __restrict__ GLF = (float*)(F.ws + WS_GLF); const int gw = F.bid * NWAVES + F.wave, NGW = F.G * NWAVES, lane = F.lane;
      for (int q = gw; q < (T / 64) * 4; q += NGW) { const int chk = q >> 2, mh = q & 3; const size_t t = (size_t)chk * 64 + lane; const bf16* pr = P + t * NINP + MLO + 2048;
          const float ip = 15.f * tanhf((bf2f(pr[mh]) + F.in[I_IB][mh]) * (1.f / 15.f)), fp = 15.f * tanhf((bf2f(pr[4 + mh]) + F.in[I_FB][mh]) * (1.f / 15.f));
          float bc = fminf(fp, 0.f) - log1pf(__expf(-fabsf(fp)));
#pragma unroll
          for (int o = 1; o < 64; o <<= 1) { const float t_ = __shfl_up(bc, o); if (lane >= o) bc += t_; }
          const float u = ip - bc; float pm = u;
#pragma unroll
          for (int o = 1; o < 64; o <<= 1) { const float t_ = __shfl_up(pm, o); if (lane >= o) pm = fmaxf(pm, t_); }
          *(f32x4*)(GLF + t * 16 + 4 * mh) = (f32x4){bc, u, pm, 0.f}; } }
}

typedef short s16x8 __attribute__((ext_vector_type(8)));
typedef short s16x4 __attribute__((ext_vector_type(4)));
__device__ __forceinline__ unsigned long long pack4bf(f32x4 v) { return (unsigned long long)pk2(v[0], v[1]) | ((unsigned long long)pk2(v[2], v[3]) << 32); }
__device__ __forceinline__ s16x8 tr_frag(const LAS bf16* img, int stride, int r0, int c0, int fr) {
    const LAS bf16* p0 = img + (r0 + (fr >> 2)) * stride + c0 + 4 * (fr & 3);
    const s16x4 lo = __builtin_bit_cast(s16x4, __builtin_amdgcn_ds_read_tr16_b64_v4i16((LAS s16x4*)p0));
    const s16x4 hi = __builtin_bit_cast(s16x4, __builtin_amdgcn_ds_read_tr16_b64_v4i16((LAS s16x4*)(p0 + 4 * stride)));
    return __builtin_shufflevector(lo, hi, 0, 1, 2, 3, 4, 5, 6, 7);
}

__device__ __forceinline__ void rw_bar(LAS unsigned* cnt, unsigned& target, int lane);
__device__ __forceinline__ void rwkv_chunk_unit(Frame& F, int unit, LAS unsigned char* regB, LAS unsigned* bcnt, unsigned& btarget) {
    const int b = unit >> 5, h = (unit >> 1) & 15, half = unit & 1;
    const bf16* P = (const bf16*)(F.ws + WS_P); const float* WAG = (const float*)(F.ws + WS_WAG); float* YRAW = (float*)(F.ws + WS_YRAW);
    constexpr int KS = 72, LS = 40;
    LAS bf16* At = (LAS bf16*)F.lds; LAS bf16* Bt = At + 32 * KS; LAS bf16* Kt = Bt + 32 * KS; LAS bf16* Rt = Kt + 32 * KS;
    LAS bf16* Vv = Rt + 32 * KS;
    LAS bf16* Sb = Vv + 32 * LS;
    LAS bf16* G2b = Sb + 32 * KS; LAS bf16* G3b = G2b + 32 * LS; LAS bf16* G4b = G3b + 32 * LS;
    LAS bf16* Pwb = G4b + 32 * LS;
    LAS bf16* Acb = Pwb + 2 * 32 * LS;
    LAS bf16* RHt = (LAS bf16*)regB;
    LAS bf16* Ubt = RHt + 32 * LS;
    LAS float* lwf = (LAS float*)(Ubt + 32 * LS);
    LAS float* csf = lwf + 2048;
    LAS float* gtf = csf + 2048;
    LAS float* glf = gtf + 256;
    const int tid = F.tid, lane = F.lane, w = F.wave, fr = lane & 15, fq = lane >> 4;
    const int ts = tid >> 4, cs = tid & 15, c0 = h * 64 + 4 * cs;
    const int sk = tid & 63, sq = tid >> 6;
    const f32x4 mu_r = *(const f32x4*)(F.in[I_MU] + c0), mu_k = *(const f32x4*)(F.in[I_MU] + 1024 + c0), mu_v = *(const f32x4*)(F.in[I_MU] + 2048 + c0);
    const f32x4 kkc = *(const f32x4*)(F.in[I_KK] + c0), kac = *(const f32x4*)(F.in[I_KA] + c0);
    for (int i = tid; i < 32 * KS; i += 256) Sb[i] = 0;
    v2u cr[2], ck[2], cv[2], qr[2], qk[2], qv[2]; f32x4 w4[2], a4[2];
#define RC_LOAD(ch) do { _Pragma("unroll") for (int p_ = 0; p_ < 2; ++p_) { const int t_ = (ch) * 32 + ts + 16 * p_; const size_t tk_ = (size_t)b * SEQ + t_; const bf16* pr_ = P + tk_ * NINP + c0; \
        cr[p_] = *(const v2u*)(pr_); ck[p_] = *(const v2u*)(pr_ + 1024); cv[p_] = *(const v2u*)(pr_ + 2048); \
        if (t_ > 0) { qr[p_] = *(const v2u*)(pr_ - NINP); qk[p_] = *(const v2u*)(pr_ - NINP + 1024); qv[p_] = *(const v2u*)(pr_ - NINP + 2048); } else { qr[p_] = (v2u){0u, 0u}; qk[p_] = qr[p_]; qv[p_] = qr[p_]; } \
        w4[p_] = *(const f32x4*)(WAG + tk_ * 3072 + c0); a4[p_] = *(const f32x4*)(WAG + tk_ * 3072 + 1024 + c0); } } while (0)
    const int mi = w >> 1, nj = w & 1;
    f32x4 st[2]; st[0] = (f32x4){0.f, 0.f, 0.f, 0.f}; st[1] = st[0];
    RC_LOAD(0);
    rw_bar(bcnt, btarget, lane);
    for (int ch = 0; ch < SEQ / 32; ++ch) {
        f32x4 rr[2], kmod[2], vv[2], kkn[2], lw[2], al[2];
#pragma unroll
        for (int p_ = 0; p_ < 2; ++p_) { const f32x4 pr4 = UNP4(cr[p_]), pk4 = UNP4(ck[p_]), pv4 = UNP4(cv[p_]), qr4 = UNP4(qr[p_]), qk4 = UNP4(qk[p_]), qv4 = UNP4(qv[p_]); lw[p_] = w4[p_]; al[p_] = a4[p_];
            rr[p_] = pr4 + (qr4 - pr4) * mu_r; const f32x4 k1 = pk4 + (qk4 - pk4) * mu_k; vv[p_] = pv4 + (qv4 - pv4) * mu_v;
            const f32x4 kkr = k1 * kkc; const float nrm = __builtin_amdgcn_rsqf(fmaxf(allreduce16((kkr[0] * kkr[0] + kkr[1] * kkr[1]) + (kkr[2] * kkr[2] + kkr[3] * kkr[3])), 1e-24f));
            kkn[p_] = kkr * nrm; kmod[p_] = k1 * (1.f + (al[p_] - 1.f) * kac);
            *(LAS f32x4*)(lwf + (ts + 16 * p_) * 64 + 4 * cs) = lw[p_]; }
        if (ch + 1 < SEQ / 32) RC_LOAD(ch + 1);
        rw_bar(bcnt, btarget, lane);
        float cc[8];
#pragma unroll
        for (int i = 0; i < 8; ++i) cc[i] = lwf[(8 * sq + i) * 64 + sk] + (i ? cc[i - 1] : 0.f);
        gtf[sq * 64 + sk] = cc[7];
        rw_bar(bcnt, btarget, lane);
        { float off = 0.f;
#pragma unroll
          for (int q = 0; q < 3; ++q) off += (q < sq) ? gtf[q * 64 + sk] : 0.f;
#pragma unroll
          for (int i = 0; i < 8; ++i) csf[(8 * sq + i) * 64 + sk] = off + cc[i]; }
        rw_bar(bcnt, btarget, lane);
#pragma unroll
        for (int p_ = 0; p_ < 2; ++p_) { const int t = ts + 16 * p_; const f32x4 cg = *(const LAS f32x4*)(csf + t * 64 + 4 * cs); f32x4 g, gp, gi;
#pragma unroll
          for (int j = 0; j < 4; ++j) { g[j] = __expf(cg[j]); gp[j] = __expf(cg[j] - lw[p_][j]); gi[j] = __expf(-cg[j]); }
          *(LAS unsigned long long*)(At + t * KS + 4 * cs) = pack4bf(-(kkn[p_] * gp)); *(LAS unsigned long long*)(Bt + t * KS + 4 * cs) = pack4bf(kkn[p_] * al[p_] * gi);
          *(LAS unsigned long long*)(Kt + t * KS + 4 * cs) = pack4bf(kmod[p_] * gi); *(LAS unsigned long long*)(Rt + t * KS + 4 * cs) = pack4bf(rr[p_] * g);
          if ((cs >> 3) == half) *(LAS unsigned long long*)(Vv + t * LS + 4 * (cs & 7)) = pack4bf(vv[p_]);
          if (t == 31) *(LAS f32x4*)(glf + 4 * cs) = g; }
        rw_bar(bcnt, btarget, lane);
        f32x4 accT, pwT;
        { const int t = 16 * mi + fr, jb = 16 * nj + 4 * fq;
          f32x4 g1 = (f32x4){0.f, 0.f, 0.f, 0.f}, g2 = g1, g3 = g1, g4 = g1;
#pragma unroll
          for (int ks = 0; ks < 2; ++ks) { const s16x8 bj = *(const LAS s16x8*)(Bt + (16 * nj + fr) * KS + 32 * ks + 8 * fq), kj = *(const LAS s16x8*)(Kt + (16 * nj + fr) * KS + 32 * ks + 8 * fq);
              const s16x8 at = *(const LAS s16x8*)(At + (16 * mi + fr) * KS + 32 * ks + 8 * fq), rt = *(const LAS s16x8*)(Rt + (16 * mi + fr) * KS + 32 * ks + 8 * fq);
              g1 = __builtin_amdgcn_mfma_f32_16x16x32_bf16(bj, at, g1, 0, 0, 0); g2 = __builtin_amdgcn_mfma_f32_16x16x32_bf16(kj, at, g2, 0, 0, 0);
              g3 = __builtin_amdgcn_mfma_f32_16x16x32_bf16(bj, rt, g3, 0, 0, 0); g4 = __builtin_amdgcn_mfma_f32_16x16x32_bf16(kj, rt, g4, 0, 0, 0); }
#pragma unroll
          for (int rg_ = 0; rg_ < 4; ++rg_) { const int j = jb + rg_; g1[rg_] = (j < t) ? g1[rg_] : 0.f; g2[rg_] = (j < t) ? g2[rg_] : 0.f; g3[rg_] = (j <= t) ? g3[rg_] : 0.f; g4[rg_] = (j <= t) ? g4[rg_] : 0.f; }
          pwT = g1; *(LAS unsigned long long*)(Pwb + t * LS + jb) = pack4bf(g1);
#pragma unroll
          for (int rg_ = 0; rg_ < 4; ++rg_) accT[rg_] = g1[rg_] + ((jb + rg_ == t) ? 1.f : 0.f);
          *(LAS unsigned long long*)(Acb + 32 * LS + t * LS + jb) = pack4bf(accT);
          *(LAS unsigned long long*)(G2b + t * LS + jb) = pack4bf(g2); *(LAS unsigned long long*)(G3b + t * LS + jb) = pack4bf(g3); *(LAS unsigned long long*)(G4b + t * LS + jb) = pack4bf(g4); }
        rw_bar(bcnt, btarget, lane);
        f32x4 yv = (f32x4){0.f, 0.f, 0.f, 0.f};
#pragma unroll
        for (int s = 0; s < 5; ++s) { const LAS bf16* Pr = Pwb + (s & 1) * 32 * LS; LAS bf16* Pn = Pwb + ((s + 1) & 1) * 32 * LS; const LAS bf16* Ar = Acb + (s & 1) * 32 * LS; LAS bf16* An = Acb + ((s + 1) & 1) * 32 * LS;
            const s16x8 xrow = *(const LAS s16x8*)(Pr + (16 * mi + fr) * LS + 8 * fq);
            if (s < 4) { f32x4 z = (f32x4){0.f, 0.f, 0.f, 0.f}; z = __builtin_amdgcn_mfma_f32_16x16x32_bf16(tr_frag(Pr, LS, 8 * fq, 16 * nj, fr), xrow, z, 0, 0, 0);
                         *(LAS unsigned long long*)(Pn + (16 * mi + fr) * LS + 16 * nj + 4 * fq) = pack4bf(z); }
            if (s >= 1) { accT = __builtin_amdgcn_mfma_f32_16x16x32_bf16(tr_frag(Ar, LS, 8 * fq, 16 * nj, fr), xrow, accT, 0, 0, 0);
                          *(LAS unsigned long long*)(An + (16 * mi + fr) * LS + 16 * nj + 4 * fq) = pack4bf(accT); }
            if (s == 0) {
                f32x4 z = (f32x4){0.f, 0.f, 0.f, 0.f};
#pragma unroll
                for (int ks = 0; ks < 2; ++ks) { const s16x8 sb = *(const LAS s16x8*)(Sb + (16 * nj + fr) * KS + 32 * ks + 8 * fq);
                    z = __builtin_amdgcn_mfma_f32_16x16x32_bf16(*(const LAS s16x8*)(At + (16 * mi + fr) * KS + 32 * ks + 8 * fq), sb, z, 0, 0, 0);
                    yv = __builtin_amdgcn_mfma_f32_16x16x32_bf16(*(const LAS s16x8*)(Rt + (16 * mi + fr) * KS + 32 * ks + 8 * fq), sb, yv, 0, 0, 0); }
                const s16x8 vt_ = tr_frag(Vv, LS, 8 * fq, 16 * nj, fr);
                z = __builtin_amdgcn_mfma_f32_16x16x32_bf16(*(const LAS s16x8*)(G2b + (16 * mi + fr) * LS + 8 * fq), vt_, z, 0, 0, 0);
                yv = __builtin_amdgcn_mfma_f32_16x16x32_bf16(*(const LAS s16x8*)(G4b + (16 * mi + fr) * LS + 8 * fq), vt_, yv, 0, 0, 0);
                *(LAS unsigned long long*)(RHt + (16 * nj + fr) * LS + 16 * mi + 4 * fq) = pack4bf(z); }
            rw_bar(bcnt, btarget, lane); }
        { f32x4 z = (f32x4){0.f, 0.f, 0.f, 0.f};
          z = __builtin_amdgcn_mfma_f32_16x16x32_bf16(*(const LAS s16x8*)(Acb + 32 * LS + (16 * mi + fr) * LS + 8 * fq), *(const LAS s16x8*)(RHt + (16 * nj + fr) * LS + 8 * fq), z, 0, 0, 0);
          *(LAS unsigned long long*)(Ubt + (16 * nj + fr) * LS + 16 * mi + 4 * fq) = pack4bf(z); }
        rw_bar(bcnt, btarget, lane);
        { yv = __builtin_amdgcn_mfma_f32_16x16x32_bf16(*(const LAS s16x8*)(G3b + (16 * mi + fr) * LS + 8 * fq), *(const LAS s16x8*)(Ubt + (16 * nj + fr) * LS + 8 * fq), yv, 0, 0, 0);
          float* yp = YRAW + ((size_t)b * SEQ + ch * 32 + 16 * mi + 4 * fq) * RD + h * 64 + half * 32 + 16 * nj + fr;
#pragma unroll
          for (int rg_ = 0; rg_ < 4; ++rg_) yp[(size_t)rg_ * RD] = yv[rg_]; }
        { const int kt = w; const s16x8 bt_ = tr_frag(Bt, KS, 8 * fq, 16 * kt, fr), kt_ = tr_frag(Kt, KS, 8 * fq, 16 * kt, fr); const f32x4 gl4 = *(const LAS f32x4*)(glf + 16 * kt + 4 * fq);
#pragma unroll
          for (int vt = 0; vt < 2; ++vt) {
              st[vt] = __builtin_amdgcn_mfma_f32_16x16x32_bf16(bt_, *(const LAS s16x8*)(Ubt + (16 * vt + fr) * LS + 8 * fq), st[vt], 0, 0, 0);
              st[vt] = __builtin_amdgcn_mfma_f32_16x16x32_bf16(kt_, tr_frag(Vv, LS, 8 * fq, 16 * vt, fr), st[vt], 0, 0, 0);
              st[vt] = st[vt] * gl4;
              *(LAS unsigned long long*)(Sb + (16 * vt + fr) * KS + 16 * kt + 4 * fq) = pack4bf(st[vt]); } }
        rw_bar(bcnt, btarget, lane);
    }
#undef RC_LOAD
}

__device__ __forceinline__ float allreduce8(float x) { x += dppf<0x141>(x); x += dppf<0xB1>(x); x += dppf<0x4E>(x); return x; }
__device__ __forceinline__ void rw_bar(LAS unsigned* cnt, unsigned& target, int lane) {
    asm volatile("s_waitcnt lgkmcnt(0)" ::: "memory");
    if (lane == 0) __hip_atomic_fetch_add(cnt, 1u, __ATOMIC_RELAXED, __HIP_MEMORY_SCOPE_WORKGROUP);
    target += 4u;
    while ((unsigned)__builtin_amdgcn_readfirstlane((int)__hip_atomic_load(cnt, __ATOMIC_RELAXED, __HIP_MEMORY_SCOPE_WORKGROUP)) < target) __builtin_amdgcn_s_sleep(1);
    asm volatile("" ::: "memory");
}
constexpr int CV_BR = 8 * 32, CV_WO = 16 * 32, CV_GU = NE * 16 * 64, CV_DN = NE * 16 * 32, CV_ITEMS = 2 * CV_BR + CV_WO + CV_GU + CV_DN;
struct CvItem { const float* src; unsigned char* dst; int N; int f8; };
__device__ __forceinline__ CvItem cv_decode(Frame& F, int it) {
    CvItem c; int r = it; const int lane = F.lane;
    if (r < CV_BR) { const int kb = r >> 5, nb = r & 31; c.src = F.in[I_WBA] + (size_t)(kb * 128) * D + nb * 64 + lane; c.dst = F.ws + WS_WA + ((size_t)(nb * 64 + lane) * RD + kb * 128) * 2; c.N = D; c.f8 = 0; return c; } r -= CV_BR;
    if (r < CV_BR) { const int kb = r >> 5, nb = r & 31; c.src = F.in[I_WBB] + (size_t)(kb * 128) * D + nb * 64 + lane; c.dst = F.ws + WS_WB + ((size_t)(nb * 64 + lane) * RD + kb * 128) * 2; c.N = D; c.f8 = 0; return c; } r -= CV_BR;
    if (r < CV_WO) { const int kb = r >> 5, nb = r & 31; c.src = F.in[I_WOUT] + (size_t)(kb * 128) * D + nb * 64 + lane; c.dst = F.ws + WS_WO + ((size_t)(nb * 64 + lane) * D + kb * 128) * 2; c.N = D; c.f8 = 0; return c; } r -= CV_WO;
    if (r < CV_GU) { const int e = r >> 10, q = r & 1023, kb = q >> 6, nb = q & 63, n0 = nb * 64;
        const int dr = n0 < FF ? ((n0 >> 7) * 256 + (n0 & 127)) : (((n0 - FF) >> 7) * 256 + 128 + ((n0 - FF) & 127));
        c.src = F.in[I_WGU] + (size_t)e * D * 2 * FF + (size_t)(kb * 128) * (2 * FF) + n0 + lane; c.dst = F.ws + WS_WGU + (size_t)e * 2 * FF * D + (size_t)(dr + lane) * D + kb * 128; c.N = 2 * FF; c.f8 = 1; return c; } r -= CV_GU;
    { const int e = r >> 9, q = r & 511, kb = q >> 5, nb = q & 31;
        c.src = F.in[I_WDN] + (size_t)e * FF * D + (size_t)(kb * 128) * D + nb * 64 + lane; c.dst = F.ws + WS_WDN + (size_t)e * D * FF + (size_t)(nb * 64 + lane) * FF + kb * 128; c.N = D; c.f8 = 1; }
    return c;
}
__device__ __forceinline__ void convert_item(Frame& F, int it);
__device__ __forceinline__ void convert_loop(Frame& F, unsigned* next, unsigned* p1done, unsigned ngemm) {
    for (;;) { unsigned b = 0xffffffffu;
        if (F.lane == 0) { if (!(p1done && __hip_atomic_load(p1done, __ATOMIC_RELAXED, __HIP_MEMORY_SCOPE_AGENT) >= ngemm)) b = __hip_atomic_fetch_add(next, 2u, __ATOMIC_RELAXED, __HIP_MEMORY_SCOPE_AGENT); }
        const unsigned base = (unsigned)__builtin_amdgcn_readfirstlane((int)b); if (base >= (unsigned)CV_ITEMS) break;
        for (int k = 0; k < 2; ++k) { const int it = (int)base + k; if (it < CV_ITEMS) convert_item(F, it); } }
}
__device__ __forceinline__ void convert_item(Frame& F, int i0) {
    { const CvItem c = cv_decode(F, i0);
        float x[128];
#pragma unroll
        for (int i = 0; i < 128; ++i) x[i] = c.src[(size_t)i * c.N];
        if (c.f8) {
#pragma unroll
            for (int q = 0; q < 8; ++q) { v4u o; o.x = pk4f8(x[16 * q + 0] * F8_SW, x[16 * q + 1] * F8_SW, x[16 * q + 2] * F8_SW, x[16 * q + 3] * F8_SW); o.y = pk4f8(x[16 * q + 4] * F8_SW, x[16 * q + 5] * F8_SW, x[16 * q + 6] * F8_SW, x[16 * q + 7] * F8_SW);
                o.z = pk4f8(x[16 * q + 8] * F8_SW, x[16 * q + 9] * F8_SW, x[16 * q + 10] * F8_SW, x[16 * q + 11] * F8_SW); o.w = pk4f8(x[16 * q + 12] * F8_SW, x[16 * q + 13] * F8_SW, x[16 * q + 14] * F8_SW, x[16 * q + 15] * F8_SW);
                *(v4u*)(c.dst + 16 * q) = o; } }
        else {
#pragma unroll
            for (int q = 0; q < 16; ++q) { v4u o; o.x = pk2(x[8 * q + 0], x[8 * q + 1]); o.y = pk2(x[8 * q + 2], x[8 * q + 3]); o.z = pk2(x[8 * q + 4], x[8 * q + 5]); o.w = pk2(x[8 * q + 6], x[8 * q + 7]);
                *(v4u*)(c.dst + 16 * q) = o; } } }
}

__device__ __forceinline__ void mlstm_scan_unit(Frame& F, int unit, LAS unsigned* bcnt, unsigned& btarget) {
    const int b = unit >> 5, mh = (unit >> 3) & 3, sl = unit & 7;
    const bf16* P = (const bf16*)(F.ws + WS_P); const bf16* QKC = (const bf16*)(F.ws + WS_QKC); const float* GLF = (const float*)(F.ws + WS_GLF); float* HRAW = (float*)(F.ws + WS_HRAW);
    constexpr int VS = 56;
    LAS bf16* Lq = (LAS bf16*)F.lds;
    LAS bf16* Lk = Lq + 64 * 136;
    LAS bf16* Lv = Lk + 64 * 136;
    LAS bf16* Lvs = Lv + 64 * VS;
    LAS bf16* LcT = Lvs + 64 * VS;
    LAS bf16* Ls = LcT + 2 * 48 * 136;
    LAS float* sb = (LAS float*)(Ls + 64 * 72); LAS float* su = sb + 64; LAS float* smx = su + 64; LAS float* swk = smx + 64;
    const int tid = F.tid, lane = F.lane, w = F.wave, fr = lane & 15, fq = lane >> 4;
    for (int i = tid; i < 2 * 48 * 136; i += 256) LcT[i] = 0;
    for (int i = tid; i < 64 * 16; i += 256) { const int j = i >> 4, c = 32 + (i & 15); Lv[j * VS + c] = (c == 32) ? (bf16)0x3F80 : (bf16)0; Lvs[j * VS + c] = 0; }
    const int pr0 = tid >> 4, pc = 8 * (tid & 15);
    v4u rq[4], rk[4], rv; f32x4 g3;
#define ML_LOAD(ch) do { const size_t tk0_ = (size_t)b * SEQ + (ch) * 64; \
        _Pragma("unroll") for (int i_ = 0; i_ < 4; ++i_) { const bf16* s_ = QKC + (tk0_ + pr0 + 16 * i_) * 1024 + mh * 128 + pc; rq[i_] = *(const v4u*)s_; rk[i_] = *(const v4u*)(s_ + 512); } \
        rv = *(const v4u*)(P + (tk0_ + (tid >> 2)) * NINP + MLO + 1024 + mh * 256 + sl * 32 + 8 * (tid & 3)); \
        g3 = *(const f32x4*)(GLF + (tk0_ + lane) * 16 + 4 * mh); } while (0)
    f32x4 st[2][3];
#pragma unroll
    for (int a = 0; a < 2; ++a)
#pragma unroll
        for (int n = 0; n < 3; ++n) st[a][n] = (f32x4){0.f, 0.f, 0.f, 0.f};
    float mstate = 0.f;
    ML_LOAD(0);
    rw_bar(bcnt, btarget, lane);
    for (int ch = 0; ch < SEQ / 64; ++ch) {
        const size_t tk0 = (size_t)b * SEQ + ch * 64;
        LAS bf16* cTc = LcT + (ch & 1) * 48 * 136; LAS bf16* cTn = LcT + ((ch + 1) & 1) * 48 * 136;
        float mnew, dec;
        { const float bc = g3[0], u = g3[1], pm = g3[2];
          const float gtot = __shfl(bc, 63), pmall = __shfl(pm, 63);
          mnew = gtot + fmaxf(mstate, pmall); dec = __expf(gtot + mstate - mnew);
          const float wk = __expf(u + gtot - mnew);
          sb[lane] = bc; su[lane] = u; smx[lane] = fmaxf(mstate, pm); swk[lane] = wk;
          if (w == 0) Lvs[lane * VS + 32] = (bf16)f2bf(wk); }
#pragma unroll
        for (int i = 0; i < 4; ++i) { *(LAS v4u*)(Lq + (pr0 + 16 * i) * 136 + pc) = rq[i]; *(LAS v4u*)(Lk + (pr0 + 16 * i) * 136 + pc) = rk[i]; }
        LDS_WAIT();
        { const int j = tid >> 2, d0 = 8 * (tid & 3); const float wkj = swk[j]; *(LAS v4u*)(Lv + j * VS + d0) = rv;
          const unsigned uu[4] = {rv.x, rv.y, rv.z, rv.w}; v4u sv;
          sv.x = pk2(wkj * __uint_as_float(uu[0] << 16), wkj * __uint_as_float(uu[0] & 0xffff0000u)); sv.y = pk2(wkj * __uint_as_float(uu[1] << 16), wkj * __uint_as_float(uu[1] & 0xffff0000u));
          sv.z = pk2(wkj * __uint_as_float(uu[2] << 16), wkj * __uint_as_float(uu[2] & 0xffff0000u)); sv.w = pk2(wkj * __uint_as_float(uu[3] << 16), wkj * __uint_as_float(uu[3] & 0xffff0000u));
          *(LAS v4u*)(Lvs + j * VS + d0) = sv; }
        if (ch + 1 < SEQ / 64) ML_LOAD(ch + 1);
        rw_bar(bcnt, btarget, lane);
        { const int tt = w; const int t = 16 * tt + fr; const float mxt = smx[t];
#pragma unroll
          for (int jt = 0; jt < 4; ++jt) { f32x4 acc = (f32x4){0.f, 0.f, 0.f, 0.f};
              if (jt <= tt) {
#pragma unroll
                  for (int ks = 0; ks < 4; ++ks) { const s16x8 a = *(const LAS s16x8*)(Lk + (16 * jt + fr) * 136 + 32 * ks + 8 * fq), bq = *(const LAS s16x8*)(Lq + (16 * tt + fr) * 136 + 32 * ks + 8 * fq);
                      acc = __builtin_amdgcn_mfma_f32_16x16x32_bf16(a, bq, acc, 0, 0, 0); }
                  const f32x4 u4 = *(const LAS f32x4*)(su + 16 * jt + 4 * fq);
#pragma unroll
                  for (int rg_ = 0; rg_ < 4; ++rg_) { const int j = 16 * jt + 4 * fq + rg_; acc[rg_] = (j <= t) ? acc[rg_] * __expf(u4[rg_] - mxt) : 0.f; } }
              *(LAS unsigned long long*)(Ls + t * 72 + 16 * jt + 4 * fq) = pack4bf(acc); } }
        rw_bar(bcnt, btarget, lane);
        { const int mi = w; f32x4 a1[3], a2[3];
#pragma unroll
          for (int n = 0; n < 3; ++n) { a1[n] = (f32x4){0.f, 0.f, 0.f, 0.f}; a2[n] = a1[n]; }
#pragma unroll
          for (int ks = 0; ks < 2; ++ks) { const s16x8 A = *(const LAS s16x8*)(Ls + (16 * mi + fr) * 72 + 32 * ks + 8 * fq);
#pragma unroll
              for (int n = 0; n < 3; ++n) a1[n] = __builtin_amdgcn_mfma_f32_16x16x32_bf16(A, tr_frag(Lv, VS, 32 * ks + 8 * fq, 16 * n, fr), a1[n], 0, 0, 0); }
#pragma unroll
          for (int ks = 0; ks < 4; ++ks) { const s16x8 A = *(const LAS s16x8*)(Lq + (16 * mi + fr) * 136 + 32 * ks + 8 * fq);
#pragma unroll
              for (int n = 0; n < 3; ++n) a2[n] = __builtin_amdgcn_mfma_f32_16x16x32_bf16(A, *(const LAS s16x8*)(cTc + (16 * n + fr) * 136 + 32 * ks + 8 * fq), a2[n], 0, 0, 0); }
          const f32x4 mx4 = *(const LAS f32x4*)(smx + 16 * mi + 4 * fq), b4 = *(const LAS f32x4*)(sb + 16 * mi + 4 * fq);
#pragma unroll
          for (int rg_ = 0; rg_ < 4; ++rg_) { const float wi = __expf(mstate - mx4[rg_]); float den = a1[2][rg_] + wi * a2[2][rg_]; den = __shfl(den, lane & 48);
              const float mt = b4[rg_] + mx4[rg_]; const float inv = __builtin_amdgcn_rcpf(fmaxf(fabsf(den), __expf(-mt))); float* hp = HRAW + (tk0 + 16 * mi + 4 * fq + rg_) * RD + mh * 256 + sl * 32 + fr;
              hp[0] = (a1[0][rg_] + wi * a2[0][rg_]) * inv; hp[16] = (a1[1][rg_] + wi * a2[1][rg_]) * inv; } }
        {
#pragma unroll
          for (int a = 0; a < 2; ++a) {
#pragma unroll
              for (int n = 0; n < 3; ++n) st[a][n] = st[a][n] * dec;
#pragma unroll
              for (int ks = 0; ks < 2; ++ks) { const s16x8 A = tr_frag(Lk, 136, 32 * ks + 8 * fq, 16 * (2 * w + a), fr);
#pragma unroll
                  for (int n = 0; n < 3; ++n) st[a][n] = __builtin_amdgcn_mfma_f32_16x16x32_bf16(A, tr_frag(Lvs, VS, 32 * ks + 8 * fq, 16 * n, fr), st[a][n], 0, 0, 0); }
#pragma unroll
              for (int n = 0; n < 3; ++n) *(LAS unsigned long long*)(cTn + (16 * n + fr) * 136 + 16 * (2 * w + a) + 4 * fq) = pack4bf(st[a][n]); } }
        mstate = mnew;
        rw_bar(bcnt, btarget, lane);
    }
#undef ML_LOAD
}

__device__ __forceinline__ float rowsum4(f32x4 v) { return (v[0] + v[1]) + (v[2] + v[3]); }
__device__ __forceinline__ void p5_finalize(Frame& F) {
    const bf16* __restrict__ P = (const bf16*)(F.ws + WS_P); const float* __restrict__ WAG = (const float*)(F.ws + WS_WAG); const float* __restrict__ YRAW = (const float*)(F.ws + WS_YRAW); const float* __restrict__ HRAW = (const float*)(F.ws + WS_HRAW);
    bf16* __restrict__ OA = (bf16*)(F.ws + WS_OA); bf16* __restrict__ OB = (bf16*)(F.ws + WS_OB);
    const int gw = F.bid * NWAVES + F.wave, NGW = F.G * NWAVES, lane = F.lane;
    { const int hq = gw & 3, c0 = (hq * 4 + (lane >> 4)) * 64 + 4 * (lane & 15);
      const f32x4 mu_r = *(const f32x4*)(F.in[I_MU] + c0), mu_k = *(const f32x4*)(F.in[I_MU] + 1024 + c0), mu_v = *(const f32x4*)(F.in[I_MU] + 2048 + c0);
      const f32x4 kac = *(const f32x4*)(F.in[I_KA] + c0), rkc = *(const f32x4*)(F.in[I_RK] + c0), lnw = *(const f32x4*)(F.in[I_LNW] + c0), lnb = *(const f32x4*)(F.in[I_LNB] + c0);
      v2u cr, ck, cv, qr, qk, qv; f32x4 a4, g4, y4;
#define P5_LOAD(q_) do { const int tk_ = (q_) >> 2; const bf16* pr_ = P + (size_t)tk_ * NINP + c0; cr = *(const v2u*)(pr_); ck = *(const v2u*)(pr_ + 1024); cv = *(const v2u*)(pr_ + 2048); \
          if (tk_ & (SEQ - 1)) { qr = *(const v2u*)(pr_ - NINP); qk = *(const v2u*)(pr_ - NINP + 1024); qv = *(const v2u*)(pr_ - NINP + 2048); } else { qr = (v2u){0u, 0u}; qk = qr; qv = qr; } \
          a4 = *(const f32x4*)(WAG + (size_t)tk_ * 3072 + 1024 + c0); g4 = *(const f32x4*)(WAG + (size_t)tk_ * 3072 + 2048 + c0); y4 = *(const f32x4*)(YRAW + (size_t)tk_ * RD + c0); } while (0)
      if (gw < T * 4) P5_LOAD(gw);
      for (int q = gw; q < T * 4; q += NGW) { const int tk = q >> 2;
          const f32x4 pr4 = UNP4(cr), pk4 = UNP4(ck), pv4 = UNP4(cv), qr4 = UNP4(qr), qk4 = UNP4(qk), qv4 = UNP4(qv); const f32x4 a = a4, g = g4, y = y4;
          if (q + NGW < T * 4) P5_LOAD(q + NGW);
          const f32x4 rr = pr4 + (qr4 - pr4) * mu_r, k1 = pk4 + (qk4 - pk4) * mu_k, vv = pv4 + (qv4 - pv4) * mu_v;
          const f32x4 kmod = k1 * (1.f + (a - 1.f) * kac);
          const float dot = allreduce16(rowsum4(rr * kmod * rkc)); const float mean = allreduce16(rowsum4(y)) * (1.f / 64.f); const f32x4 dl = y - mean;
          const float var = allreduce16(rowsum4(dl * dl)) * (1.f / 64.f); const float rs = __builtin_amdgcn_rsqf(var + GN_EPS);
          const f32x4 o = (dl * rs * lnw + lnb + dot * vv) * g;
          v2u ov; ov.x = pk2(o[0], o[1]); ov.y = pk2(o[2], o[3]); *(v2u*)(OA + (size_t)tk * RD + c0) = ov; }
#undef P5_LOAD
    }
    { const int mh = gw & 3, d0 = mh * 256 + 4 * lane; const f32x4 nw = *(const f32x4*)(F.in[I_MNW] + d0);
      f32x4 hv; v2u po;
#define P5B_LOAD(q_) do { const int tk_ = (q_) >> 2; hv = *(const f32x4*)(HRAW + (size_t)tk_ * RD + d0); po = *(const v2u*)(P + (size_t)tk_ * NINP + MLO + 2056 + d0); } while (0)
      if (gw < T * 4) P5B_LOAD(gw);
      for (int q = gw; q < T * 4; q += NGW) { const int tk = q >> 2; const f32x4 h4 = hv; const v2u p2 = po;
          if (q + NGW < T * 4) P5B_LOAD(q + NGW);
          float ss = allreduce16(rowsum4(h4 * h4)); ss += __shfl_xor(ss, 16); ss += __shfl_xor(ss, 32);
          const float rs = __builtin_amdgcn_rsqf(ss * (1.f / 256.f) + NORM_EPS); const f32x4 og = UNP4(p2);
          const float o0 = h4[0] * rs * nw[0] * sigm(og[0]), o1 = h4[1] * rs * nw[1] * sigm(og[1]), o2 = h4[2] * rs * nw[2] * sigm(og[2]), o3 = h4[3] * rs * nw[3] * sigm(og[3]);
          v2u o; o.x = pk2(o0, o1); o.y = pk2(o2, o3); *(v2u*)(OB + (size_t)tk * RD + d0) = o; }
#undef P5B_LOAD
    }
}

typedef float f32x16 __attribute__((ext_vector_type(16)));
__device__ __forceinline__ void p8_route(Frame& F) {
    const float* X1 = (const float*)(F.ws + WS_X1); unsigned char* H2 = (unsigned char*)(F.ws + WS_HN); int* RLIST = (int*)(F.ws + WS_RLIST); float* RWT = (float*)(F.ws + WS_RW);
    const float* RWS = (const float*)(F.ws + WS_RWS); const float* nw = F.in[I_N2W]; const float* rtb = F.in[I_RTB];
    LAS float* part = (LAS float*)F.lds;
    LAS float* ssq = part + 8 * 32 * 33;
    LAS float* lgt = ssq + 256;
    LAS float* srs = lgt + 32 * 33;
    const int lane = F.lane, w = F.wave, i = lane & 31, h = lane >> 5, tid = F.tid;
    for (int tile = F.bid; tile < T / 32; tile += F.G) {
        const int m0 = tile * 32; const float* xrow = X1 + (size_t)(m0 + i) * D + 256 * w + 4 * h;
        f32x16 acc;
#pragma unroll
        for (int r_ = 0; r_ < 16; ++r_) acc[r_] = 0.f;
        float ss = 0.f; const float* bp = RWS + (size_t)(256 * w + 4 * h) * NE + i;
#pragma unroll 4
        for (int q = 0; q < 32; ++q) { const f32x4 xa = *(const f32x4*)(xrow + 8 * q);
#pragma unroll
            for (int j = 0; j < 4; ++j) acc = __builtin_amdgcn_mfma_f32_32x32x2f32(xa[j], bp[(8 * q + j) * NE], acc, 0, 0, 0);
            ss += (xa[0] * xa[0] + xa[1] * xa[1]) + (xa[2] * xa[2] + xa[3] * xa[3]); }
        ss += __shfl_xor(ss, 32);
        if (h == 0) ssq[w * 32 + i] = ss;
#pragma unroll
        for (int r_ = 0; r_ < 16; ++r_) part[(w * 32 + (r_ & 3) + 8 * (r_ >> 2) + 4 * h) * 33 + i] = acc[r_];
        __syncthreads();
#pragma unroll
        for (int k2 = 0; k2 < 2; ++k2) { const int idx = tid + NTHR * k2, ii = idx >> 5, e = idx & 31; float sm = 0.f, sq = 0.f;
#pragma unroll
            for (int ww = 0; ww < 8; ++ww) { sm += part[(ww * 32 + ii) * 33 + e]; sq += ssq[ww * 32 + ii]; }
            const float rs = 1.f / sqrtf(sq * (1.f / D) + NORM_EPS); lgt[ii * 33 + e] = sm * rs + rtb[e]; if (e == 0) srs[ii] = rs; }
        __syncthreads();
        { const float rs = srs[i] * F8_SX; unsigned char* orow = H2 + (size_t)(m0 + i) * D + 256 * w + 4 * h;
#pragma unroll 8
          for (int q = 0; q < 32; ++q) { const f32x4 n4 = *(const f32x4*)(nw + 256 * w + 4 * h + 8 * q); const f32x4 hv = *(const f32x4*)(xrow + 8 * q) * rs * n4; *(unsigned*)(orow + 8 * q) = pk4f8(hv[0], hv[1], hv[2], hv[3]); } }
        if (tid < 32) { const LAS float* lr = lgt + tid * 33; unsigned used = 0u; int idx[4]; float val[4];
#pragma unroll
            for (int s4 = 0; s4 < 4; ++s4) { float best = -INFINITY; int bi = 0;
                for (int e = 0; e < 32; ++e) { const float v = lr[e]; const bool ok = !((used >> e) & 1u) && (v > best); best = ok ? v : best; bi = ok ? e : bi; }
                used |= 1u << bi; idx[s4] = bi; val[s4] = best; }
            const float e1 = __expf(val[1] - val[0]), e2 = __expf(val[2] - val[0]), e3 = __expf(val[3] - val[0]); const float inv = 1.f / (1.f + e1 + e2 + e3);
            const float wv[4] = {inv, e1 * inv, e2 * inv, e3 * inv};
            unsigned pos[4];
#pragma unroll
            for (int s4 = 0; s4 < 4; ++s4) pos[s4] = atomicAdd(F.ctl + CW_CNT + 64 * idx[s4], 1u);
#pragma unroll
            for (int s4 = 0; s4 < 4; ++s4) { RLIST[idx[s4] * ECAP + pos[s4]] = (m0 + tid) * 4 + s4; RWT[idx[s4] * ECAP + pos[s4]] = wv[s4]; } }
        __syncthreads();
    }
}

__device__ __forceinline__ void build_moe_tables(Frame& F) {
    LAS int* MI = (LAS int*)F.MISC;
    __syncthreads();
    if (F.tid < NE) MI[MI_CNT + F.tid] = (int)__hip_atomic_load(F.ctl + CW_CNT + 64 * F.tid, __ATOMIC_RELAXED, __HIP_MEMORY_SCOPE_AGENT);
    __syncthreads();
    if (F.tid == 0) { int mt = 0, cs = 0;
        for (int e = 0; e < NE; ++e) { const int c = MI[MI_CNT + e]; MI[MI_POFF + e] = mt * 256; MI[MI_CST + e] = cs; cs += c;
            const int nt = (c + 255) >> 8; for (int i = 0; i < nt; ++i) { MI[MI_TILE_E + mt + i] = e; MI[MI_TILE_I0 + mt + i] = i * 256; } mt += nt; }
        MI[MI_CST + NE] = cs; MI[MI_MT] = mt; }
    __syncthreads();
}
__device__ __forceinline__ void p9_gather(Frame& F) {
    build_moe_tables(F);
    const LAS int* MI = (const LAS int*)F.MISC; const bf16* H2 = (const bf16*)(F.ws + WS_HN); bf16* XB = (bf16*)(F.ws + WS_XB); const int* RLIST = (const int*)(F.ws + WS_RLIST);
    const int gw = F.bid * NWAVES + F.wave, NGW = F.G * NWAVES, total = MI[MI_CST + NE];
    for (int q = gw; q < total; q += NGW) { int e = 0;
        for (int k = 1; k < NE; ++k) e = (MI[MI_CST + k] <= q) ? k : e;
        const int i = q - MI[MI_CST + e]; const int tok = RLIST[e * ECAP + i] >> 2;
        const v4u* src = (const v4u*)(H2 + (size_t)tok * D) + F.lane; v4u* dst = (v4u*)(XB + (size_t)(MI[MI_POFF + e] + i) * D) + F.lane;
#pragma unroll
        for (int j = 0; j < 4; ++j) dst[64 * j] = src[64 * j]; }
}
__device__ __forceinline__ void p12_final(Frame& F) {
    const float* X1 = (const float*)(F.ws + WS_X1); const bf16* YS = (const bf16*)(F.ws + WS_YS); const float* fw = F.in[I_FNW];
    const int gw = F.bid * NWAVES + F.wave, NGW = F.G * NWAVES;
    for (int m = gw; m < T; m += NGW) {
        const f32x4* xr = (const f32x4*)(X1 + (size_t)m * D) + F.lane; f32x4 v[8]; float s = 0.f;
#pragma unroll
        for (int j = 0; j < 8; ++j) { v[j] = xr[64 * j];
#pragma unroll
            for (int sl = 0; sl < 4; ++sl) { const v2u y = ((const v2u*)(YS + ((size_t)m * 4 + sl) * D))[F.lane + 64 * j];
                v[j][0] += __uint_as_float(y.x << 16); v[j][1] += __uint_as_float(y.x & 0xffff0000u); v[j][2] += __uint_as_float(y.y << 16); v[j][3] += __uint_as_float(y.y & 0xffff0000u); }
            s += (v[j][0] * v[j][0] + v[j][1] * v[j][1]) + (v[j][2] * v[j][2] + v[j][3] * v[j][3]); }
        const float rstd = __builtin_amdgcn_rsqf(wave_sum(s) * (1.f / D) + NORM_EPS);
        f32x4* orow = (f32x4*)(F.out + (size_t)m * D) + F.lane;
#pragma unroll
        for (int j = 0; j < 8; ++j) { const f32x4 w = ((const f32x4*)fw)[F.lane + 64 * j]; orow[64 * j] = v[j] * rstd * w; }
    }
}

__global__ void __launch_bounds__(NTHR, 2) mk_fwd(Args args) {
    extern __shared__ __attribute__((aligned(16))) unsigned char lds[];
    Frame F;
    F.lds = (LAS unsigned char*)lds; F.MISC = (volatile LAS unsigned*)(F.lds + MISC_OFF);
    F.tid = threadIdx.x; F.lane = F.tid & 63; F.wave = __builtin_amdgcn_readfirstlane(F.tid >> 6); F.G = gridDim.x; F.bid = blockIdx.x;
    F.in = args.in; F.out = args.out; F.ws = args.ws; F.ctl = (unsigned*)(args.ws + WS_CTL);
    for (int u = F.tid; u < (LDS_BYTES - MISC_OFF) / 4; u += NTHR) ((LAS unsigned*)(F.lds + MISC_OFF))[u] = 0u;
    __syncthreads();
    XcdBarrier bar; bar.bar = F.ctl + CW_BAR; bar.x = 0; bar.st = nullptr;
    if (MK_N_LAUNCHES == 1) bar = xcd_barrier_post(F.ctl + CW_BAR, F.MISC + 8);
    const int lo = args.ph_lo, hi = args.ph_hi;
#define IN(k) (lo <= (k) && (k) < hi)
#ifndef PROBE_PHASE
#define PROBE_PHASE -1
#endif
#define REP(k) ((PROBE_PHASE) == (k) ? 2 : 1)
#define SEAM(k) do { if (IN(k) && IN((k) + 1)) xcd_barrier(bar); } while (0)
    LAS unsigned char* ring = F.lds;
    const LAS int* MI = (const LAS int*)F.MISC;

    static_assert(MK_N_LAUNCHES == 1, "the W_in quantisation needs an in-launch barrier inside phase 0");
    if (IN(0)) { p0_prologue(F); xcd_barrier(bar); p0b_win(F); } SEAM(0);
    if (IN(1)) {
        const int ng = F.G > 2 * NCV ? F.G - NCV : F.G;
        if (F.bid < ng) {
            pg8::Gemm g{(const bf16*)(F.ws + WS_HN), (const bf16*)(F.ws + WS_WIN), T, NINP, D / 2}; pg8::StaticOrder S; S.init(T, NINP, ng, F.bid);
            EpiP1I8 E{(bf16*)(F.ws + WS_P), NINP, (const float*)(F.ws + WS_RA), F.ctl + CW_COLMAX};
            pg8::gemm_phase<EpiP1I8, pg8::StaticOrder, true, true, false, true>(ring, g, S, E);
            if (F.tid == 0) __hip_atomic_fetch_add(F.ctl + CW_P1DONE, 1u, __ATOMIC_RELAXED, __HIP_MEMORY_SCOPE_AGENT);
        } else convert_loop(F, F.ctl + CW_CVNEXT, F.ctl + CW_P1DONE, (unsigned)ng);
    } SEAM(1);
    if (IN(2)) { for (int rep = 0; rep < REP(2); ++rep) p2_lora_in(F); } SEAM(2);
    if (IN(3)) {
        pg8::Gemm g{(const bf16*)(F.ws + WS_LIN), (const bf16*)(F.ws + WS_WL), T, 3072, 512}; pg8::StaticOrder S; S.init(T, 3072, F.G, F.bid);
        EpiLora E{(float*)(F.ws + WS_WAG), F.in[I_W0], F.in[I_A0]};
        pg8::gemm_phase<EpiLora, pg8::StaticOrder, true, true>(ring, g, S, E);
    } SEAM(3);
    if (IN(4)) {
        { LAS unsigned* ctl2 = (LAS unsigned*)F.MISC + 16;
          if (F.wave < 4) { unsigned bt = 0u; for (int rep = 0; rep < REP(40); ++rep) for (int u = F.bid; u < 256; u += F.G) rwkv_chunk_unit(F, u, (LAS unsigned char*)F.MISC + 256, ctl2, bt); }
          else { Frame F2 = F; F2.tid = F.tid - 256; F2.wave = F.wave - 4; F2.lds = F.lds + 45056; unsigned bt = 0u;
                 for (int rep = 0; rep < REP(41); ++rep) for (int u = F.bid; u < 256; u += F.G) mlstm_scan_unit(F2, u, ctl2 + 2, bt); }
          convert_loop(F, F.ctl + CW_CVNEXT, nullptr, 0u);
          __syncthreads(); }
    } SEAM(4);
    if (IN(5)) { for (int rep = 0; rep < REP(5); ++rep) p5_finalize(F); } SEAM(5);
    if (IN(6)) {
        { pg8::Gemm g{(const bf16*)(F.ws + WS_OA), (const bf16*)(F.ws + WS_WA), T, D, RD}; pg8::StaticOrder S; S.init(T, D, F.G, F.bid);
          EpiGateA E{(float*)(F.ws + WS_TMP), (const bf16*)(F.ws + WS_P), F.in[I_BGATE]};
          pg8::gemm_phase<EpiGateA, pg8::StaticOrder, true, true>(ring, g, S, E); }
        VM_WAIT(); __syncthreads();
        { pg8::Gemm g{(const bf16*)(F.ws + WS_OB), (const bf16*)(F.ws + WS_WB), T, D, RD}; pg8::StaticOrder S; S.init(T, D, F.G, F.bid);
          EpiGateB E{(const float*)(F.ws + WS_TMP), (bf16*)(F.ws + WS_MRG), (const bf16*)(F.ws + WS_P), F.in[I_BGATE]};
          pg8::gemm_phase<EpiGateB, pg8::StaticOrder, true, true>(ring, g, S, E); }
    } SEAM(6);
    if (IN(7)) {
        pg8::Gemm g{(const bf16*)(F.ws + WS_MRG), (const bf16*)(F.ws + WS_WO), T, D, D}; pg8::StaticOrder S; S.init(T, D, F.G, F.bid);
        EpiResid E{F.in[I_X], (float*)(F.ws + WS_X1)};
        pg8::gemm_phase<EpiResid, pg8::StaticOrder, true, true>(ring, g, S, E);
    } SEAM(7);
    if (IN(8)) { p8_route(F); } SEAM(8);
    if (IN(10)) {
        build_moe_tables(F);
        const int mt = MI[MI_MT];
        pg8::Gemm g{(const bf16*)(F.ws + WS_HN), (const bf16*)(F.ws + WS_WGU), mt * 256, 2 * FF, D / 2};
        MoeGatherOrder S; S.init(mt * 256, 2 * FF, F.G, F.bid); S.tile_e = MI + MI_TILE_E; S.estride = (size_t)2 * FF * D;
        S.tile_i0 = MI + MI_TILE_I0; S.cnt = MI + MI_CNT; S.rlist = (const int*)(F.ws + WS_RLIST); S.rowoff = (LAS unsigned*)F.MISC + MI_ROWOFF; S.rowbytes = D;
        EpiSwiGLU E{(unsigned char*)(F.ws + WS_ACT), F.in[I_BGU], MI + MI_TILE_E};
        pg8::gemm_phase<EpiSwiGLU, MoeGatherOrder, true, true, true>(ring, g, S, E);
    } SEAM(10);
    if (IN(11)) {
        build_moe_tables(F);
        const int mt = MI[MI_MT];
        pg8::Gemm g{(const bf16*)(F.ws + WS_ACT), (const bf16*)(F.ws + WS_WDN), mt * 256, D, FF / 2};
        MoeOrder S; S.init(mt * 256, D, F.G, F.bid); S.tile_e = MI + MI_TILE_E; S.estride = (size_t)D * FF;
        LAS int* rowdst = (LAS int*)F.MISC + MI_ROWOFF; LAS float* rowwt = (LAS float*)F.MISC + MI_ROWOFF + 10 * 256;
        fill_down_tables(F, S, rowdst, rowwt);
        EpiDown E{(bf16*)(F.ws + WS_YS), F.in[I_BDN], MI + MI_TILE_E, rowdst, rowwt};
        pg8::gemm_phase<EpiDown, MoeOrder, true, true, true>(ring, g, S, E);
    } SEAM(11);
    if (IN(12)) { for (int rep = 0; rep < REP(12); ++rep) p12_final(F); }
#undef IN
#undef SEAM
}

extern "C" void kernel_launch(void* const* d_in, const int* in_sizes, int n_in, void* d_out, int out_size, void* d_ws, size_t ws_size, hipStream_t stream) {
    static int grid = 0;
    if (grid == 0) {
        if (n_in != 30 || out_size != T * D || ws_size < WS_END) { fprintf(stderr, "kernel_launch: unexpected problem (n_in %d, out %d, ws %zu)\n", n_in, out_size, ws_size); grid = -1; return; }
        int dev = 0, cus = 0, per_cu = 0;
        if (hipGetDevice(&dev) != hipSuccess || hipDeviceGetAttribute(&cus, hipDeviceAttributeMultiprocessorCount, dev) != hipSuccess) { grid = -1; return; }
        if (hipFuncSetAttribute((const void*)mk_fwd, hipFuncAttributeMaxDynamicSharedMemorySize, LDS_BYTES) != hipSuccess) { fprintf(stderr, "kernel_launch: hipFuncSetAttribute failed\n"); grid = -1; return; }
        if (hipOccupancyMaxActiveBlocksPerMultiprocessor(&per_cu, (const void*)mk_fwd, NTHR, LDS_BYTES) != hipSuccess || per_cu < 1) fprintf(stderr, "kernel_launch: occupancy query says %d\n", per_cu);
        (void)hipGetLastError();
        grid = cus;
    }
    if (grid < 0) return;
    if (hipMemsetAsync((char*)d_ws + WS_CTL, 0, CTL_ZERO_BYTES, stream) != hipSuccess) return;
    Args a{};
    for (int i = 0; i < 30; ++i) a.in[i] = (const float*)d_in[i];
    a.out = (float*)d_out; a.ws = (unsigned char*)d_ws;
    for (int li = 0; li < MK_N_LAUNCHES; ++li) {
        a.ph_lo = (MK_N_LAUNCHES == 1) ? 0 : li; a.ph_hi = (MK_N_LAUNCHES == 1) ? NPH : li + 1;
        hipLaunchKernelGGL(mk_fwd, dim3(grid), dim3(NTHR), LDS_BYTES, stream, a);
        const hipError_t le = hipPeekAtLastError();
        if (le != hipSuccess) { fprintf(stderr, "kernel_launch: launch %d failed: %s\n", li, hipGetErrorName(le)); break; }
    }
}
```

```cpp
#include <hip/hip_runtime.h>
#include <cstdio>
#include <cstdint>
#define MK_N_LAUNCHES 1
#define PROBE_PHASE -1
namespace pg8 {
#define PG8_LAS __attribute__((address_space(3)))
typedef unsigned short bf16_t;
typedef short bf16x8 __attribute__((ext_vector_type(8)));
typedef float f32x4 __attribute__((ext_vector_type(4)));
typedef unsigned u32x4 __attribute__((ext_vector_type(4)));
constexpr int BM = 256, BK = 64, HALF = 128, HTB = HALF * BK * 2  , STAGE_BYTES = 8 * HTB, NXCD = 8, WGM = 8;

__host__ __device__ __forceinline__ int lds_byte(int r, int c) { const int st = (r >> 4) * 2 + (c >> 5), rr = r & 15, cc = c & 31, ob = rr * 64 + cc * 2; return st * 1024 + (ob ^ (((ob >> 9) & 1) << 5)); }
__host__ __device__ __forceinline__ void stage_rc(int b, int& R, int& C) { const int st = b / 1024, sb = b % 1024, swz = sb ^ (((sb >> 9) & 1) << 5); R = (st >> 1) * 16 + swz / 64; C = (st & 1) * 32 + (swz % 64) / 2; }
__host__ __device__ __forceinline__ int perm32(int rho) { const int n = rho >> 4, i = rho & 15; return 8 * (i >> 2) + 4 * n + (i & 3); }

struct Unit { int pm, pn, ord; };
struct Gemm { const bf16_t* A; const bf16_t* Bt; int M, N, K; };

struct StaticOrder {
    int nM, nN, nwg, G, c;
    __host__ __device__ void init(int M, int N, int G_, int c_) { nM = M / BM; nN = N / BM; nwg = nM * nN; G = G_; c = c_; }
    __host__ __device__ bool next(int i, Unit& u) const {
        const long L = (long)i * G + c; if (L >= nwg) return false;
        int wgid = (int)L; { const int q = nwg / NXCD, r = nwg % NXCD, xcd = wgid % NXCD, off = wgid / NXCD; wgid = (xcd < r ? xcd * (q + 1) : r * (q + 1) + (xcd - r) * q) + off; }
        const int nig = WGM * nN, gid = wgid / nig, fm = gid * WGM, gsz = (nM - fm) < WGM ? (nM - fm) : WGM;
        u.pm = fm + ((wgid % nig) % gsz); u.pn = (wgid % nig) / gsz; u.ord = i; return true;
    }
    __device__ __forceinline__ void a_ready(const Unit&) const {}
    static constexpr bool GATHER = false;
    __device__ __forceinline__ void fill_all() const {}
    __device__ __forceinline__ unsigned row_off(int, int) const { return 0u; }
    __device__ __forceinline__ void done(const Unit&) const {}
    __device__ __forceinline__ size_t a_off(const Unit& u, size_t tstep) const { return (size_t)u.pm * tstep; }
    __device__ __forceinline__ size_t b_off(const Unit& u, size_t tstep) const { return (size_t)u.pn * tstep; }
};
__device__ __forceinline__ unsigned cvt_pk_bf16(float lo, float hi) { unsigned r; asm volatile("v_cvt_pk_bf16_f32 %0, %1, %2" : "=v"(r) : "v"(lo), "v"(hi)); return r; }
typedef int v8i32 __attribute__((ext_vector_type(8)));
typedef int v4i32 __attribute__((ext_vector_type(4)));
__device__ __forceinline__ v8i32 cat8(bf16x8 lo, bf16x8 hi) { const v4i32 a = __builtin_bit_cast(v4i32, lo), b = __builtin_bit_cast(v4i32, hi); return __builtin_shufflevector(a, b, 0, 1, 2, 3, 4, 5, 6, 7); }
template <class Epi, class Sched, bool ALIGN_EPI = false, bool SP2 = false, bool FP8 = false, bool I8 = false>
__device__ __forceinline__ void gemm_phase(PG8_LAS unsigned char* lds, const Gemm g, const Sched& S, const Epi& E) {
    const int tid = threadIdx.x, wid = __builtin_amdgcn_readfirstlane(tid >> 6), lane = tid & 63, wr = wid >> 2, wc = wid & 3, fr = lane & 15, fq = lane >> 4;
    const int K = g.K, nt = K / BK;
    unsigned voffA[2], voffB[2];
#pragma unroll
    for (int i = 0; i < 2; ++i) { int R, C; stage_rc(tid * 16 + i * 8192, R, C); const int Rb = Epi::PERM ? ((R & ~31) + perm32(R & 31)) : R;
        voffA[i] = (unsigned)(R * K + C) * 2u; voffB[i] = (unsigned)(Rb * K + C) * 2u; }
    unsigned voffA1[2]; int rselA[2]; unsigned cselA[2];
#pragma unroll
    for (int i = 0; i < 2; ++i) { int R, C; stage_rc(tid * 16 + i * 8192, R, C); rselA[i] = R; cselA[i] = (unsigned)C * 2u; voffA1[i] = voffA[i]; }
    const size_t kstep = (size_t)(BK * 2);
    const size_t hstep = (size_t)HALF * K * 2;
    const size_t tstep = 2 * hstep;
    const size_t hstepA = Sched::GATHER ? (size_t)0 : hstep;
#define PG8_ROWS(_u) do { _Pragma("unroll") for (int _i = 0; _i < 2; ++_i) { voffA[_i] = S.row_off((_u), rselA[_i]) + cselA[_i]; voffA1[_i] = S.row_off((_u), HALF + rselA[_i]) + cselA[_i]; } } while (0)
    const unsigned ldsw = (unsigned)wid * 1024u;
    const int aoff = lds_byte(wr * 64 + fr, fq * 8), boff = lds_byte(wc * 32 + fr, fq * 8);
#define PG8_SA(b, h) (((b) * 2 + (h)) * HTB)
#define PG8_SB(b, h) ((4 + (b) * 2 + (h)) * HTB)
#define PG8_STAGE(bufoff, gbase, voff) do { _Pragma("unroll") for (int _i = 0; _i < 2; ++_i) \
        __builtin_amdgcn_global_load_lds((const unsigned*)((const char*)(gbase) + (voff)[_i]), (PG8_LAS unsigned*)(lds + (bufoff) + ldsw + _i * 8192), 16, 0, 0); } while (0)
#define PG8_LDA(dst, b, h) do { if constexpr (FP8) { _Pragma("unroll") for (int m = 0; m < 4; ++m) dst##8[m] = cat8(*(const PG8_LAS bf16x8*)(lds + PG8_SA(b, h) + aoff + m * 2048), *(const PG8_LAS bf16x8*)(lds + PG8_SA(b, h) + aoff + m * 2048 + 1024)); } \
        else { _Pragma("unroll") for (int m = 0; m < 4; ++m) _Pragma("unroll") for (int k = 0; k < 2; ++k) dst[m][k] = *(const PG8_LAS bf16x8*)(lds + PG8_SA(b, h) + aoff + m * 2048 + k * 1024); } } while (0)
#define PG8_LDB(dst, b, h) do { if constexpr (FP8) { _Pragma("unroll") for (int n = 0; n < 2; ++n) dst##8[n] = cat8(*(const PG8_LAS bf16x8*)(lds + PG8_SB(b, h) + boff + n * 2048), *(const PG8_LAS bf16x8*)(lds + PG8_SB(b, h) + boff + n * 2048 + 1024)); } \
        else { _Pragma("unroll") for (int n = 0; n < 2; ++n) _Pragma("unroll") for (int k = 0; k < 2; ++k) dst[n][k] = *(const PG8_LAS bf16x8*)(lds + PG8_SB(b, h) + boff + n * 2048 + k * 1024); } } while (0)
#define PG8_MMA(ai, bj, At, Bt) do { __builtin_amdgcn_s_setprio(1); if constexpr (FP8) { _Pragma("unroll") for (int m = 0; m < 4; ++m) _Pragma("unroll") for (int n = 0; n < 2; ++n) \
        asm volatile("v_mfma_scale_f32_16x16x128_f8f6f4 %0, %1, %2, %0, %3, %3 op_sel_hi:[0,0,0]" : "+v"(acc[ai][bj][m][n]) : "v"(Bt##8[n]), "v"(At##8[m]), "v"(f8scale)); } else { \
        _Pragma("unroll") for (int m = 0; m < 4; ++m) _Pragma("unroll") for (int n = 0; n < 2; ++n) _Pragma("unroll") for (int k = 0; k < 2; ++k) { \
        if constexpr (I8) acc[ai][bj][m][n] = __builtin_bit_cast(f32x4, __builtin_amdgcn_mfma_i32_16x16x64_i8(__builtin_bit_cast(v4i32, Bt[n][k]), __builtin_bit_cast(v4i32, At[m][k]), __builtin_bit_cast(v4i32, acc[ai][bj][m][n]), 0, 0, 0)); \
        else acc[ai][bj][m][n] = __builtin_amdgcn_mfma_f32_16x16x32_bf16(Bt[n][k], At[m][k], acc[ai][bj][m][n], 0, 0, 0); } } __builtin_amdgcn_s_setprio(0); } while (0)
#define PG8_WAIT_V(n) asm volatile("s_waitcnt vmcnt(" #n ")" ::: "memory")
#define PG8_WAIT_L(n) asm volatile("s_waitcnt lgkmcnt(" #n ")" ::: "memory")
#define PG8_BAR __builtin_amdgcn_s_barrier()
#define PG8_SCHED __builtin_amdgcn_sched_barrier(0)
    Unit cur, nxt; int ui = 0;
    if (!S.next(0, cur)) return;
    f32x4 acc[2][2][4][2];
#pragma unroll
    for (int a = 0; a < 2; ++a)
#pragma unroll
        for (int b = 0; b < 2; ++b)
#pragma unroll
            for (int m = 0; m < 4; ++m)
#pragma unroll
                for (int n = 0; n < 2; ++n) acc[a][b][m][n] = (f32x4){0.f, 0.f, 0.f, 0.f};
    const int f8scale = 0x7f7f7f7f;
    bf16x8 At[4][2], B0[2][2], B1[2][2]; v8i32 At8[4], B08[2], B18[2];
    const char* cA = (const char*)g.A + S.a_off(cur, tstep); const char* cB = (const char*)g.Bt + S.b_off(cur, tstep);
    S.a_ready(cur);
    if constexpr (Sched::GATHER) { S.fill_all(); asm volatile("s_waitcnt vmcnt(0) lgkmcnt(0)" ::: "memory"); __builtin_amdgcn_s_barrier(); asm volatile("" ::: "memory"); PG8_ROWS(0); }
    if constexpr (SP2) {
        PG8_STAGE(PG8_SB(0, 0), cB, voffB); PG8_STAGE(PG8_SB(0, 1), cB + hstep, voffB); PG8_STAGE(PG8_SA(0, 0), cA, voffA); PG8_STAGE(PG8_SA(0, 1), cA + hstepA, voffA1);
        if (wr == 1) PG8_BAR;
        PG8_WAIT_V(2); PG8_BAR;
        PG8_STAGE(PG8_SB(1, 0), cB + kstep, voffB); PG8_STAGE(PG8_SA(1, 0), cA + kstep, voffA); PG8_STAGE(PG8_SB(1, 1), cB + hstep + kstep, voffB);
        PG8_WAIT_V(6); PG8_BAR;
    } else {
        PG8_STAGE(PG8_SB(0, 0), cB, voffB); PG8_STAGE(PG8_SA(0, 0), cA, voffA); PG8_STAGE(PG8_SB(0, 1), cB + hstep, voffB); PG8_STAGE(PG8_SA(0, 1), cA + hstepA, voffA1);
        if (wr == 1) PG8_BAR;
        PG8_WAIT_V(4); PG8_BAR;
        PG8_STAGE(PG8_SB(1, 0), cB + kstep, voffB); PG8_STAGE(PG8_SA(1, 0), cA + kstep, voffA); PG8_STAGE(PG8_SB(1, 1), cB + hstep + kstep, voffB);
        PG8_WAIT_V(6); PG8_BAR;
    }
    for (;;) {
        const bool has_next = S.next(ui + 1, nxt);
        const char* nA = has_next ? (const char*)g.A + S.a_off(nxt, tstep) : cA; const char* nB = has_next ? (const char*)g.Bt + S.b_off(nxt, tstep) : cB;
        for (int t = 0; t < nt; t += 2) {
            const bool last = (t == nt - 2);
            const char* a1 = cA + (size_t)(t + 1) * kstep;
            const char* a2 = last ? nA : cA + (size_t)(t + 2) * kstep; const char* b2 = last ? nB : cB + (size_t)(t + 2) * kstep;
            const char* a3 = a2 + kstep; const char* b3 = b2 + kstep;
            if (last && has_next) S.a_ready(nxt);
            if constexpr (SP2) {
            PG8_LDB(B0, 0, 0); PG8_LDB(B1, 0, 1); PG8_SCHED; PG8_LDA(At, 0, 0); PG8_STAGE(PG8_SA(1, 1), a1 + hstepA, voffA1);
            PG8_WAIT_V(8); PG8_WAIT_L(0); PG8_BAR; PG8_MMA(0, 0, At, B0); PG8_MMA(0, 1, At, B1); PG8_BAR; PG8_SCHED;
            if constexpr (Sched::GATHER) { if (last && has_next) PG8_ROWS(ui + 1); }
            PG8_LDA(At, 0, 1); PG8_STAGE(PG8_SB(0, 0), b2, voffB); PG8_STAGE(PG8_SB(0, 1), b2 + hstep, voffB); PG8_STAGE(PG8_SA(0, 0), a2, voffA);
            PG8_WAIT_V(8); PG8_WAIT_L(0); PG8_BAR; PG8_MMA(1, 0, At, B0); PG8_MMA(1, 1, At, B1); PG8_BAR; PG8_SCHED;
            PG8_LDB(B0, 1, 0); PG8_LDB(B1, 1, 1); PG8_SCHED; PG8_LDA(At, 1, 0); PG8_STAGE(PG8_SA(0, 1), a2 + hstepA, voffA1);
            PG8_WAIT_V(8); PG8_WAIT_L(0); PG8_BAR; PG8_MMA(0, 0, At, B0); PG8_MMA(0, 1, At, B1); PG8_BAR; PG8_SCHED;
            PG8_LDA(At, 1, 1); PG8_STAGE(PG8_SB(1, 0), b3, voffB); PG8_STAGE(PG8_SB(1, 1), b3 + hstep, voffB); PG8_STAGE(PG8_SA(1, 0), a3, voffA);
            PG8_WAIT_V(8); PG8_WAIT_L(0); PG8_BAR; PG8_MMA(1, 0, At, B0); PG8_MMA(1, 1, At, B1); PG8_BAR; PG8_SCHED;
            } else {
            PG8_LDB(B0, 0, 0); PG8_SCHED; PG8_LDA(At, 0, 0); PG8_STAGE(PG8_SA(1, 1), a1 + hstepA, voffA1);
            PG8_WAIT_L(8); PG8_BAR; PG8_WAIT_L(0); PG8_MMA(0, 0, At, B0); PG8_BAR; PG8_SCHED;
            PG8_LDB(B1, 0, 1); PG8_STAGE(PG8_SB(0, 0), b2, voffB);
            PG8_BAR; PG8_WAIT_L(0); PG8_MMA(0, 1, At, B1); PG8_BAR;
            PG8_LDA(At, 0, 1); PG8_STAGE(PG8_SA(0, 0), a2, voffA);
            PG8_BAR; PG8_WAIT_L(0); PG8_MMA(1, 0, At, B0); PG8_BAR; PG8_SCHED;
            PG8_STAGE(PG8_SB(0, 1), b2 + hstep, voffB);
            PG8_WAIT_V(6); PG8_BAR; PG8_MMA(1, 1, At, B1); PG8_BAR;
            PG8_LDB(B0, 1, 0); PG8_SCHED; PG8_LDA(At, 1, 0); PG8_STAGE(PG8_SA(0, 1), a2 + hstepA, voffA1);
            PG8_WAIT_L(8); PG8_BAR; PG8_WAIT_L(0); PG8_MMA(0, 0, At, B0); PG8_BAR; PG8_SCHED;
            PG8_LDB(B1, 1, 1); PG8_STAGE(PG8_SB(1, 0), b3, voffB);
            PG8_BAR; PG8_WAIT_L(0); PG8_MMA(0, 1, At, B1); PG8_BAR;
            PG8_LDA(At, 1, 1); PG8_STAGE(PG8_SA(1, 0), a3, voffA);
            PG8_BAR; PG8_WAIT_L(0); PG8_MMA(1, 0, At, B0); PG8_BAR; PG8_SCHED;
            PG8_STAGE(PG8_SB(1, 1), b3 + hstep, voffB);
            PG8_WAIT_V(6); PG8_BAR; PG8_MMA(1, 1, At, B1); PG8_BAR;
            }
        }
        if constexpr (ALIGN_EPI) { if (wr == 0) PG8_BAR; }
        if constexpr (FP8) { asm volatile("s_nop 15\n\ts_nop 15" ::: "memory"); }
        if constexpr (!Epi::AFTER_DRAIN) { E(acc, cur, wr, wc, fr, fq); S.done(cur); }
        if (!has_next) break;
#pragma unroll
        for (int a = 0; a < 2; ++a)
#pragma unroll
            for (int b = 0; b < 2; ++b)
#pragma unroll
                for (int m = 0; m < 4; ++m)
#pragma unroll
                    for (int n = 0; n < 2; ++n) acc[a][b][m][n] = (f32x4){0.f, 0.f, 0.f, 0.f};
        cur = nxt; cA = nA; cB = nB; ++ui;
        if constexpr (ALIGN_EPI) { if (wr == 1) PG8_BAR; }
    }
    PG8_WAIT_V(0);
    if constexpr (!ALIGN_EPI) { if (wr == 0) PG8_BAR; }
    PG8_BAR;
    if constexpr (Epi::AFTER_DRAIN) { E.fused(acc, cur, wr, wc, fr, fq, lds, wid, lane); S.done(cur); }
#undef PG8_ROWS
#undef PG8_SA
#undef PG8_SB
#undef PG8_STAGE
#undef PG8_LDA
#undef PG8_LDB
#undef PG8_MMA
#undef PG8_WAIT_V
#undef PG8_WAIT_L
#undef PG8_BAR
#undef PG8_SCHED
}
}

#ifndef MK_N_LAUNCHES
#define MK_N_LAUNCHES 1
#endif
#define GAS __attribute__((address_space(1)))
#define LAS __attribute__((address_space(3)))
typedef unsigned short bf16;
typedef unsigned v4u __attribute__((ext_vector_type(4)));
typedef unsigned v2u __attribute__((ext_vector_type(2)));
typedef float f32x4 __attribute__((ext_vector_type(4)));
typedef float f32x2 __attribute__((ext_vector_type(2)));

constexpr int NWAVES = 8, NTHR = 512;
constexpr int NPH = 13;
constexpr int D = 2048, BATCH = 8, SEQ = 2048, T = BATCH * SEQ;
constexpr int NIN = 10696, NINP = 10752;
constexpr int MLO = 3520, GTO = 6600;
constexpr int RH = 16, RD = 1024;
constexpr int MH = 4;
constexpr int NE = 32, FF = 2048, ECAP = 16384, PMAX = 65536 + NE * 256, MTMAX = PMAX / 256;
constexpr float NORM_EPS = 1e-6f, GN_EPS = 64e-5f;
constexpr size_t MiB = 1u << 20;
constexpr size_t WS_CTL = 0, CTL_ZERO_BYTES = 1 * MiB;
constexpr size_t WS_WIN = 1 * MiB, WS_WA = 43 * MiB, WS_WB = 47 * MiB, WS_WO = 51 * MiB, WS_WL = 59 * MiB;
constexpr size_t WS_RLIST = 62 * MiB, WS_RW = 64 * MiB, WS_RWS = 2787 * MiB, WS_RA = 2787 * MiB + 512 * 1024;
constexpr size_t WS_WGU = 66 * MiB, WS_WDN = 578 * MiB, WS_HN = 834 * MiB, WS_P = 898 * MiB, WS_LIN = 1234 * MiB, WS_WAG = 1250 * MiB;
constexpr size_t WS_YRAW = 1442 * MiB, WS_HRAW = 1506 * MiB, WS_OA = 1570 * MiB, WS_OB = 1602 * MiB, WS_TMP = 1634 * MiB, WS_MRG = 1762 * MiB;
constexpr size_t WS_QKC = WS_TMP, WS_GLF = WS_TMP + 64 * MiB;
constexpr size_t WS_X1 = 1826 * MiB, WS_XB = 1954 * MiB, WS_ACT = 2242 * MiB, WS_YS = 2530 * MiB, WS_END = 2788 * MiB;
constexpr int CW_BAR = 4096;
constexpr int CW_CVNEXT = 8192, CW_P1DONE = 8192 + 64;
constexpr int NCV = 64;
constexpr int CW_COLMAX = 32768;
constexpr int CW_CNT = 16384;
constexpr int RING_BYTES = 131072, MISC_OFF = RING_BYTES, LDS_BYTES = RING_BYTES + 8192 + 20 * 1024;
constexpr int MI_TILE_E = 64, MI_TILE_I0 = 64 + 320, MI_CNT = 64 + 640, MI_POFF = MI_CNT + 32, MI_CST = MI_POFF + 32, MI_MT = MI_CST + 40, MI_ROWOFF = 2048;

#define LDS_WAIT() asm volatile("s_waitcnt lgkmcnt(0)" ::: "memory")
#define VM_WAIT() asm volatile("s_waitcnt vmcnt(0)" ::: "memory")
__device__ __forceinline__ float bf2f(bf16 v) { return __uint_as_float(((unsigned)v) << 16); }
__device__ __forceinline__ unsigned f2bf(float f) { unsigned u = __float_as_uint(f); return (u + 0x7fffu + ((u >> 16) & 1u)) >> 16; }
typedef __bf16 bf16x2_t __attribute__((ext_vector_type(2)));
__device__ __forceinline__ unsigned pk2(float lo, float hi) { const f32x2 v = {lo, hi}; const bf16x2_t b = __builtin_convertvector(v, bf16x2_t); return __builtin_bit_cast(unsigned, b); }
__device__ __forceinline__ unsigned pk4f8(float a, float b, float c, float d) { int r = 0; r = __builtin_amdgcn_cvt_pk_fp8_f32(a, b, r, false); r = __builtin_amdgcn_cvt_pk_fp8_f32(c, d, r, true); return (unsigned)r; }
constexpr float F8_SX = 8.f, F8_SW = 256.f, F8_SA = 4.f, F8_SY = 16.f;
__device__ __forceinline__ unsigned pk4i8(float a, float b, float c, float d) {
    const int ia = (int)__builtin_rintf(a), ib = (int)__builtin_rintf(b), ic = (int)__builtin_rintf(c), id = (int)__builtin_rintf(d);
    return (unsigned)(ia & 255) | ((unsigned)(ib & 255) << 8) | ((unsigned)(ic & 255) << 16) | ((unsigned)id << 24); }
__device__ __forceinline__ float wave_max(float v) {
#pragma unroll
    for (int o = 1; o < 64; o <<= 1) v = fmaxf(v, __shfl_xor(v, o));
    return v;
}
__device__ __forceinline__ float wave_sum(float v) {
#pragma unroll
    for (int o = 1; o < 64; o <<= 1) v += __shfl_xor(v, o);
    return v;
}
#define UNP4(v) ((f32x4){__uint_as_float((v).x << 16), __uint_as_float((v).x & 0xffff0000u), __uint_as_float((v).y << 16), __uint_as_float((v).y & 0xffff0000u)})
__device__ __forceinline__ float sigm(float x) { return __builtin_amdgcn_rcpf(1.f + __expf(-x)); }
template <int CTRL> __device__ __forceinline__ float dppf(float x) { return __builtin_bit_cast(float, __builtin_amdgcn_mov_dpp(__builtin_bit_cast(int, x), CTRL, 0xf, 0xf, true)); }
__device__ __forceinline__ float allreduce16(float x) { x += dppf<0x128>(x); x += dppf<0x124>(x); x += dppf<0x4E>(x); x += dppf<0xB1>(x); return x; }

#define XB_TMO      128
#define XB_XCNT(j)  (256  + 64 * (j))
#define XB_XSUB(j)  (1280 + 64 * (j))
#define XB_XGEN(j)  (2304 + 64 * (j))
#define XB_TOP      3328
#define XB_TOPGEN   3392
#define XCD_BAR_WORDS 3456
#define XB_SPIN_CAP (1u << 18)
__device__ __forceinline__ unsigned xb_ld(unsigned* p)              { return __hip_atomic_load(p, __ATOMIC_RELAXED, __HIP_MEMORY_SCOPE_AGENT); }
__device__ __forceinline__ unsigned xb_add(unsigned* p, unsigned v) { return __hip_atomic_fetch_add(p, v, __ATOMIC_RELAXED, __HIP_MEMORY_SCOPE_AGENT); }
__device__ __forceinline__ unsigned xb_xcc_id() { return (unsigned)__builtin_amdgcn_s_getreg((3 << 11) | 20) & 0xFu; }
#define XB_SPIN(cond, bar) do { unsigned _sp = 0; while (cond) { __builtin_amdgcn_s_sleep(1); \
    if ((++_sp & 255u) == 0u) { if (xb_ld(&(bar)[XB_TMO])) break; if (_sp > XB_SPIN_CAP) { atomicAdd(&(bar)[XB_TMO], 1u); break; } } } } while (0)
struct XcdBarrier { unsigned* bar; unsigned x; volatile LAS unsigned* st; };
__device__ __forceinline__ XcdBarrier xcd_barrier_post(unsigned* bar, volatile LAS unsigned* st) {
    XcdBarrier b; b.bar = bar; b.x = xb_xcc_id(); b.st = st;
    if (threadIdx.x == 0) (void)xb_add(&bar[XB_XCNT(b.x)], 1u);
    return b;
}
__device__ __forceinline__ void xcd_barrier_complete(unsigned* bar, unsigned x, unsigned& nloc, unsigned& nx) {
    const unsigned G = gridDim.x * gridDim.y * gridDim.z;
    unsigned sum, cnt, mine, sp = 0u;
    for (;;) {
        sum = 0u; cnt = 0u; mine = 0u;
#pragma unroll
        for (unsigned j = 0; j < 16; ++j) { const unsigned c = xb_ld(&bar[XB_XCNT(j)]); sum += c; cnt += (c > 0u) ? 1u : 0u; mine = (j == x) ? c : mine; }
        if (sum == G) break;
        __builtin_amdgcn_s_sleep(1);
        if ((++sp & 255u) == 0u) { if (xb_ld(&bar[XB_TMO])) break; if (sp > XB_SPIN_CAP) { atomicAdd(&bar[XB_TMO], 1u); break; } }
    }
    nloc = mine > 0u ? mine : 1u; nx = cnt > 0u ? cnt : 1u;
}
__device__ __forceinline__ void xcd_barrier(const XcdBarrier& b) {
    asm volatile("s_waitcnt vmcnt(0)" ::: "memory");
    __syncthreads();
    if (threadIdx.x == 0) {
        unsigned* bar = b.bar;
        __builtin_amdgcn_s_waitcnt(0);
        unsigned nloc = b.st[0], nx = b.st[1];
        if (nloc == 0u) { xcd_barrier_complete(bar, b.x, nloc, nx); b.st[0] = nloc; b.st[1] = nx; }
        const unsigned old = xb_add(&bar[XB_XSUB(b.x)], 1u);
        const unsigned gen = old / nloc;
        if (old + 1u == (gen + 1u) * nloc) {
            __builtin_amdgcn_fence(__ATOMIC_RELEASE, "agent");
            asm volatile("s_waitcnt vmcnt(0)" ::: "memory");
            const unsigned og = xb_add(&bar[XB_TOP], 1u);
            const unsigned tg = og / nx;
            if (og + 1u == (tg + 1u) * nx) xb_add(&bar[XB_TOPGEN], 1u);
            else XB_SPIN(xb_ld(&bar[XB_TOPGEN]) == tg, bar);
            __builtin_amdgcn_fence(__ATOMIC_ACQUIRE, "agent");
            xb_add(&bar[XB_XGEN(b.x)], 1u);
            asm volatile("s_waitcnt vmcnt(0)" ::: "memory");
        } else {
            XB_SPIN(xb_ld(&bar[XB_XGEN(b.x)]) == gen, bar);
            __builtin_amdgcn_fence(__ATOMIC_ACQUIRE, "agent");
            asm volatile("s_waitcnt vmcnt(0)" ::: "memory");
        }
    }
    __syncthreads();
}

struct Args { const float* in[30]; float* out; unsigned char* ws; int ph_lo, ph_hi; };
enum { I_X = 0, I_N1W, I_WIN, I_BGATE, I_MU, I_W0, I_WUP, I_A0, I_AUP, I_GUP, I_KK, I_KA, I_RK, I_LNW, I_LNB, I_CONVW, I_IB, I_FB, I_MNW, I_WBA, I_WBB, I_WOUT, I_N2W, I_RTW, I_RTB, I_WGU, I_BGU, I_WDN, I_BDN, I_FNW };

struct Frame {
    LAS unsigned char* lds; volatile LAS unsigned* MISC; unsigned* ctl;
    int tid, lane, wave, G, bid;
    const float* const* in; float* out; unsigned char* ws;
};

using pg8::Unit; using pg8::HALF; using pg8::BM;
struct EpiBf16Plain {
    static constexpr bool PERM = true, AFTER_DRAIN = false;
    bf16* O; int ldc;
    __device__ __forceinline__ void operator()(const f32x4 (&acc)[2][2][4][2], const Unit& u, int wr, int wc, int fr, int fq) const {
        const int row0 = u.pm * BM + wr * 64 + fr, col0 = u.pn * BM + wc * 32 + 8 * fq;
#pragma unroll
        for (int ai = 0; ai < 2; ++ai)
#pragma unroll
            for (int m = 0; m < 4; ++m) { bf16* rowp = O + (size_t)(row0 + ai * HALF + m * 16) * ldc + col0;
#pragma unroll
                for (int bj = 0; bj < 2; ++bj) { const f32x4 v0 = acc[ai][bj][m][0], v1 = acc[ai][bj][m][1];
                    v4u w; w.x = pg8::cvt_pk_bf16(v0[0], v0[1]); w.y = pg8::cvt_pk_bf16(v0[2], v0[3]); w.z = pg8::cvt_pk_bf16(v1[0], v1[1]); w.w = pg8::cvt_pk_bf16(v1[2], v1[3]);
                    *(v4u*)(rowp + bj * HALF) = w; } }
    }
};
struct EpiP1I8 {
    static constexpr bool PERM = true, AFTER_DRAIN = false;
    bf16* O; int ldc; const float* ra; const unsigned* colmax;
    __device__ __forceinline__ void operator()(const f32x4 (&acc)[2][2][4][2], const Unit& u, int wr, int wc, int fr, int fq) const {
        const int row0 = u.pm * BM + wr * 64 + fr, col0 = u.pn * BM + wc * 32 + 8 * fq;
        f32x4 cb[2][2];
#pragma unroll
        for (int bj = 0; bj < 2; ++bj)
#pragma unroll
            for (int n = 0; n < 2; ++n) { const v4u cm = *(const v4u*)(colmax + col0 + bj * HALF + 4 * n);
                cb[bj][n] = (f32x4){__uint_as_float(cm.x), __uint_as_float(cm.y), __uint_as_float(cm.z), __uint_as_float(cm.w)} * (1.f / 127.f); }
#pragma unroll
        for (int ai = 0; ai < 2; ++ai)
#pragma unroll
            for (int m = 0; m < 4; ++m) { const int r = row0 + ai * HALF + m * 16; const float rs = ra[r]; bf16* rowp = O + (size_t)r * ldc + col0;
#pragma unroll
                for (int bj = 0; bj < 2; ++bj) { const v4u i0 = __builtin_bit_cast(v4u, acc[ai][bj][m][0]), i1 = __builtin_bit_cast(v4u, acc[ai][bj][m][1]);
                    const f32x4 v0 = (f32x4){(float)(int)i0.x, (float)(int)i0.y, (float)(int)i0.z, (float)(int)i0.w} * cb[bj][0] * rs, v1 = (f32x4){(float)(int)i1.x, (float)(int)i1.y, (float)(int)i1.z, (float)(int)i1.w} * cb[bj][1] * rs;
                    v4u w; w.x = pk2(v0[0], v0[1]); w.y = pk2(v0[2], v0[3]); w.z = pk2(v1[0], v1[1]); w.w = pk2(v1[2], v1[3]);
                    *(v4u*)(rowp + bj * HALF) = w; } }
    }
};
struct EpiLora {
    static constexpr bool PERM = false, AFTER_DRAIN = false;
    float* O; const float* w0; const float* a0;
    __device__ __forceinline__ void operator()(const f32x4 (&acc)[2][2][4][2], const Unit& u, int wr, int wc, int fr, int fq) const {
        const int row0 = u.pm * BM + wr * 64 + fr, col0 = u.pn * BM + wc * 32 + 4 * fq, seg = u.pn >> 2;
        f32x4 bv[2][2];
#pragma unroll
        for (int bj = 0; bj < 2; ++bj)
#pragma unroll
            for (int n = 0; n < 2; ++n) { const int c = col0 + bj * HALF + n * 16;
                bv[bj][n] = seg == 0 ? *(const f32x4*)(w0 + c) : (seg == 1 ? *(const f32x4*)(a0 + (c - 1024)) : (f32x4){0.f, 0.f, 0.f, 0.f}); }
#pragma unroll
        for (int ai = 0; ai < 2; ++ai)
#pragma unroll
            for (int m = 0; m < 4; ++m) { float* rowp = O + (size_t)(row0 + ai * HALF + m * 16) * 3072 + col0;
#pragma unroll
                for (int bj = 0; bj < 2; ++bj)
#pragma unroll
                    for (int n = 0; n < 2; ++n) { f32x4 v = acc[ai][bj][m][n] + bv[bj][n];
                        if (seg == 0) {
#pragma unroll
                            for (int j = 0; j < 4; ++j) v[j] = -0.6065306597126334f * sigm(v[j]); }
                        else if (seg == 1) {
#pragma unroll
                            for (int j = 0; j < 4; ++j) v[j] = sigm(v[j]); }
                        *(f32x4*)(rowp + bj * HALF + n * 16) = v; } }
    }
};
struct EpiGateA {
    static constexpr bool PERM = true, AFTER_DRAIN = false;
    float* TMP; const bf16* P; const float* bg;
    __device__ __forceinline__ void operator()(const f32x4 (&acc)[2][2][4][2], const Unit& u, int wr, int wc, int fr, int fq) const {
        const int row0 = u.pm * BM + wr * 64 + fr, col0 = u.pn * BM + wc * 32 + 8 * fq;
#pragma unroll
        for (int ai = 0; ai < 2; ++ai)
#pragma unroll
            for (int m = 0; m < 4; ++m) { const size_t r = (size_t)(row0 + ai * HALF + m * 16);
#pragma unroll
                for (int bj = 0; bj < 2; ++bj) { const int c = col0 + bj * HALF;
                    const v4u pg = *(const v4u*)(P + r * NINP + GTO + c); const f32x4 b0 = *(const f32x4*)(bg + c), b1 = *(const f32x4*)(bg + c + 4);
                    f32x4 g0, g1;
                    g0[0] = sigm(__uint_as_float(pg.x << 16) + b0[0]); g0[1] = sigm(__uint_as_float(pg.x & 0xffff0000u) + b0[1]);
                    g0[2] = sigm(__uint_as_float(pg.y << 16) + b0[2]); g0[3] = sigm(__uint_as_float(pg.y & 0xffff0000u) + b0[3]);
                    g1[0] = sigm(__uint_as_float(pg.z << 16) + b1[0]); g1[1] = sigm(__uint_as_float(pg.z & 0xffff0000u) + b1[1]);
                    g1[2] = sigm(__uint_as_float(pg.w << 16) + b1[2]); g1[3] = sigm(__uint_as_float(pg.w & 0xffff0000u) + b1[3]);
                    *(f32x4*)(TMP + r * D + c) = g0 * acc[ai][bj][m][0]; *(f32x4*)(TMP + r * D + c + 4) = g1 * acc[ai][bj][m][1]; } }
    }
};
struct EpiGateB {
    static constexpr bool PERM = true, AFTER_DRAIN = false;
    const float* TMP; bf16* MRG; const bf16* P; const float* bg;
    __device__ __forceinline__ void operator()(const f32x4 (&acc)[2][2][4][2], const Unit& u, int wr, int wc, int fr, int fq) const {
        const int row0 = u.pm * BM + wr * 64 + fr, col0 = u.pn * BM + wc * 32 + 8 * fq;
#pragma unroll
        for (int ai = 0; ai < 2; ++ai)
#pragma unroll
            for (int m = 0; m < 4; ++m) { const size_t r = (size_t)(row0 + ai * HALF + m * 16);
#pragma unroll
                for (int bj = 0; bj < 2; ++bj) { const int c = col0 + bj * HALF;
                    const v4u pg = *(const v4u*)(P + r * NINP + GTO + D + c); const f32x4 b0 = *(const f32x4*)(bg + D + c), b1 = *(const f32x4*)(bg + D + c + 4);
                    const f32x4 t0 = *(const f32x4*)(TMP + r * D + c), t1 = *(const f32x4*)(TMP + r * D + c + 4);
                    f32x4 g0, g1;
                    g0[0] = sigm(__uint_as_float(pg.x << 16) + b0[0]); g0[1] = sigm(__uint_as_float(pg.x & 0xffff0000u) + b0[1]);
                    g0[2] = sigm(__uint_as_float(pg.y << 16) + b0[2]); g0[3] = sigm(__uint_as_float(pg.y & 0xffff0000u) + b0[3]);
                    g1[0] = sigm(__uint_as_float(pg.z << 16) + b1[0]); g1[1] = sigm(__uint_as_float(pg.z & 0xffff0000u) + b1[1]);
                    g1[2] = sigm(__uint_as_float(pg.w << 16) + b1[2]); g1[3] = sigm(__uint_as_float(pg.w & 0xffff0000u) + b1[3]);
                    const f32x4 v0 = t0 + g0 * acc[ai][bj][m][0], v1 = t1 + g1 * acc[ai][bj][m][1];
                    v4u w; w.x = pg8::cvt_pk_bf16(v0[0], v0[1]); w.y = pg8::cvt_pk_bf16(v0[2], v0[3]); w.z = pg8::cvt_pk_bf16(v1[0], v1[1]); w.w = pg8::cvt_pk_bf16(v1[2], v1[3]);
                    *(v4u*)(MRG + r * D + c) = w; } }
    }
};
struct EpiResid {
    static constexpr bool PERM = false, AFTER_DRAIN = false;
    const float* X; float* O;
    __device__ __forceinline__ void operator()(const f32x4 (&acc)[2][2][4][2], const Unit& u, int wr, int wc, int fr, int fq) const {
        const int row0 = u.pm * BM + wr * 64 + fr, col0 = u.pn * BM + wc * 32 + 4 * fq;
#pragma unroll
        for (int ai = 0; ai < 2; ++ai)
#pragma unroll
            for (int m = 0; m < 4; ++m) { const size_t off = (size_t)(row0 + ai * HALF + m * 16) * D + col0;
#pragma unroll
                for (int bj = 0; bj < 2; ++bj)
#pragma unroll
                    for (int n = 0; n < 2; ++n) *(f32x4*)(O + off + bj * HALF + n * 16) = *(const f32x4*)(X + off + bj * HALF + n * 16) + acc[ai][bj][m][n]; }
    }
};
struct MoeOrder : pg8::StaticOrder {
    const LAS int* tile_e; size_t estride;
    __device__ __forceinline__ size_t b_off(const Unit& u, size_t tstep) const { return (size_t)tile_e[u.pm] * estride + (size_t)u.pn * tstep; }
};
struct MoeGatherOrder : MoeOrder {
    static constexpr bool GATHER = true;
    const LAS int* tile_i0; const LAS int* cnt; const int* rlist; LAS unsigned* rowoff; unsigned rowbytes;
    __device__ __forceinline__ size_t a_off(const Unit&, size_t) const { return 0; }
    __device__ __forceinline__ void fill_all() const { const int tid = threadIdx.x, r = tid & 255;
        for (int u0 = tid >> 8; ; u0 += 6) { Unit ua, ub, uc; const bool va = next(u0, ua), vb = next(u0 + 2, ub), vc = next(u0 + 4, uc); if (!va) break;
            int ta = 0, tb = 0, tc = 0;
            { const int e = tile_e[ua.pm], i = tile_i0[ua.pm] + r; if (i < cnt[e]) ta = rlist[e * ECAP + i]; }
            if (vb) { const int e = tile_e[ub.pm], i = tile_i0[ub.pm] + r; if (i < cnt[e]) tb = rlist[e * ECAP + i]; }
            if (vc) { const int e = tile_e[uc.pm], i = tile_i0[uc.pm] + r; if (i < cnt[e]) tc = rlist[e * ECAP + i]; }
            rowoff[u0 * 256 + r] = (unsigned)(ta >> 2) * rowbytes; if (vb) rowoff[(u0 + 2) * 256 + r] = (unsigned)(tb >> 2) * rowbytes; if (vc) rowoff[(u0 + 4) * 256 + r] = (unsigned)(tc >> 2) * rowbytes; } }
    __device__ __forceinline__ unsigned row_off(int ui, int r) const { return rowoff[ui * 256 + r]; }
};
struct EpiSwiGLU {
    static constexpr bool PERM = true, AFTER_DRAIN = false;
    unsigned char* ACT; const float* bgu; const LAS int* tile_e;
    __device__ __forceinline__ void operator()(const f32x4 (&acc)[2][2][4][2], const Unit& u, int wr, int wc, int fr, int fq) const {
        const int row0 = u.pm * BM + wr * 64 + fr, colg = u.pn * 128 + wc * 32 + 8 * fq; const int e = tile_e[u.pm];
        const float* bp = bgu + (size_t)e * 4096 + colg;
        const f32x4 bg0 = *(const f32x4*)(bp), bg1 = *(const f32x4*)(bp + 4), bu0 = *(const f32x4*)(bp + 2048), bu1 = *(const f32x4*)(bp + 2052);
#pragma unroll
        for (int ai = 0; ai < 2; ++ai)
#pragma unroll
            for (int m = 0; m < 4; ++m) { const size_t r = (size_t)(row0 + ai * HALF + m * 16);
                constexpr float DS = 1.f / (F8_SX * F8_SW);
                const f32x4 ga = acc[ai][0][m][0] * DS + bg0, gb = acc[ai][0][m][1] * DS + bg1, ua = acc[ai][1][m][0] * DS + bu0, ub = acc[ai][1][m][1] * DS + bu1;
                float o[8];
#pragma unroll
                for (int j = 0; j < 4; ++j) { const float g = fminf(ga[j], 7.f), up = fminf(fmaxf(ua[j], -7.f), 7.f); o[j] = F8_SA * (up + 1.f) * g * sigm(1.702f * g);
                                              const float g2 = fminf(gb[j], 7.f), up2 = fminf(fmaxf(ub[j], -7.f), 7.f); o[4 + j] = F8_SA * (up2 + 1.f) * g2 * sigm(1.702f * g2); }
                v2u w; w.x = pk4f8(o[0], o[1], o[2], o[3]); w.y = pk4f8(o[4], o[5], o[6], o[7]);
                *(v2u*)(ACT + r * FF + colg) = w; }
    }
};
struct EpiDown {
    static constexpr bool PERM = true, AFTER_DRAIN = false;
    unsigned char* YS; const float* bdn; const LAS int* tile_e; const LAS int* rowdst; const LAS float* rowwt;
    __device__ __forceinline__ void operator()(const f32x4 (&acc)[2][2][4][2], const Unit& u, int wr, int wc, int fr, int fq) const {
        const int e = tile_e[u.pm]; const int col0 = u.pn * BM + wc * 32 + 8 * fq;
        const float* bp = bdn + (size_t)e * D + col0; constexpr float DS = 1.f / (F8_SA * F8_SW);
#pragma unroll
        for (int bj = 0; bj < 2; ++bj) { const f32x4 b0 = *(const f32x4*)(bp + bj * HALF), b1 = *(const f32x4*)(bp + bj * HALF + 4);
#pragma unroll
            for (int ai = 0; ai < 2; ++ai)
#pragma unroll
                for (int m = 0; m < 4; ++m) { const int r = u.ord * 256 + ai * HALF + wr * 64 + m * 16 + fr;
                    const int dst = rowdst[r]; const float w = rowwt[r];
                    const f32x4 v0 = (acc[ai][bj][m][0] * DS + b0) * (w * F8_SY), v1 = (acc[ai][bj][m][1] * DS + b1) * (w * F8_SY);
                    v2u o; o.x = pk4f8(v0[0], v0[1], v0[2], v0[3]); o.y = pk4f8(v1[0], v1[1], v1[2], v1[3]);
                    *(v2u*)(YS + (size_t)dst * D + col0 + bj * HALF) = o; } }
    }
};
template <class Sched> __device__ __forceinline__ void fill_down_tables(Frame& F, const Sched& S, LAS int* rowdst, LAS float* rowwt) {
    const LAS int* MI = (const LAS int*)F.MISC; const int* rlist = (const int*)(F.ws + WS_RLIST); const float* rw = (const float*)(F.ws + WS_RW);
    const int r = F.tid & 255;
    for (int u0 = F.tid >> 8; ; u0 += 4) { Unit ua, ub; const bool va = S.next(u0, ua), vb = S.next(u0 + 2, ub); if (!va) break;
        int da = T * 4, db = T * 4; float wa = 0.f, wb = 0.f;
        { const int e = MI[MI_TILE_E + ua.pm], i = MI[MI_TILE_I0 + ua.pm] + r; if (i < MI[MI_CNT + e]) { da = rlist[e * ECAP + i]; wa = rw[e * ECAP + i]; } }
        if (vb) { const int e = MI[MI_TILE_E + ub.pm], i = MI[MI_TILE_I0 + ub.pm] + r; if (i < MI[MI_CNT + e]) { db = rlist[e * ECAP + i]; wb = rw[e * ECAP + i]; } }
        rowdst[u0 * 256 + r] = da; rowwt[u0 * 256 + r] = wa; if (vb) { rowdst[(u0 + 2) * 256 + r] = db; rowwt[(u0 + 2) * 256 + r] = wb; } }
    __syncthreads();
}

__device__ __forceinline__ void transpose_item(const float* __restrict__ W, int N, int k0, int n0, bf16* WT, int dst_row0, int ldk, LAS float* scr, int lane) {
    const int n = n0 + (lane & 31); const bool ok = n < N;
#pragma unroll 8
    for (int i = 0; i < 32; ++i) { const int kk = 2 * i + (lane >> 5); scr[kk * 33 + (lane & 31)] = ok ? W[(size_t)(k0 + kk) * N + n] : 0.f; }
    LDS_WAIT(); asm volatile("" ::: "memory");
    const int c = lane & 7;
#pragma unroll
    for (int j = 0; j < 4; ++j) { const int nn = (lane >> 3) + 8 * j; const LAS float* s = scr + (8 * c) * 33 + nn;
        v4u o; o.x = pk2(s[0 * 33], s[1 * 33]); o.y = pk2(s[2 * 33], s[3 * 33]); o.z = pk2(s[4 * 33], s[5 * 33]); o.w = pk2(s[6 * 33], s[7 * 33]);
        *(v4u*)(WT + (size_t)(dst_row0 + nn) * ldk + k0 + 8 * c) = o; }
    LDS_WAIT(); asm volatile("" ::: "memory");
}
__device__ __forceinline__ void transpose_item_i8(const float* __restrict__ W, int N, int k0, int n0, unsigned char* WT, int dst_row0, int ldk, const unsigned* colmax, LAS float* scr, int lane) {
    const int n = n0 + (lane & 31); const bool ok = n < N;
#pragma unroll 8
    for (int i = 0; i < 32; ++i) { const int kk = 2 * i + (lane >> 5); scr[kk * 33 + (lane & 31)] = ok ? W[(size_t)(k0 + kk) * N + n] : 0.f; }
    LDS_WAIT(); asm volatile("" ::: "memory");
#pragma unroll
    for (int j = 0; j < 2; ++j) { const int ch = lane + 64 * j, nn = ch >> 2, c = ch & 3; const LAS float* s = scr + (16 * c) * 33 + nn;
        const float cm = __uint_as_float(colmax[n0 + nn]); const float sc = cm > 0.f ? 127.f / cm : 0.f;
        v4u o; o.x = pk4i8(s[0 * 33] * sc, s[1 * 33] * sc, s[2 * 33] * sc, s[3 * 33] * sc); o.y = pk4i8(s[4 * 33] * sc, s[5 * 33] * sc, s[6 * 33] * sc, s[7 * 33] * sc);
        o.z = pk4i8(s[8 * 33] * sc, s[9 * 33] * sc, s[10 * 33] * sc, s[11 * 33] * sc); o.w = pk4i8(s[12 * 33] * sc, s[13 * 33] * sc, s[14 * 33] * sc, s[15 * 33] * sc);
        *(v4u*)(WT + (size_t)(dst_row0 + nn) * ldk + k0 + 16 * c) = o; }
    LDS_WAIT(); asm volatile("" ::: "memory");
}
__device__ __forceinline__ void p0b_win(Frame& F) {
    LAS float* scr = (LAS float*)(F.lds + F.wave * 16384);
    const int gw = F.bid * NWAVES + F.wave, NGW = F.G * NWAVES; unsigned char* WIN8 = F.ws + WS_WIN; const unsigned* colmax = F.ctl + CW_COLMAX;
    constexpr int NB_WIN = (NIN + 31) / 32;
    for (int it = gw; it < 32 * NB_WIN; it += NGW) { const int kb = it / NB_WIN, nb = it % NB_WIN; transpose_item_i8(F.in[I_WIN], NIN, kb * 64, nb * 32, WIN8, nb * 32, D, colmax, scr, F.lane); }
    { const int gt = F.bid * NTHR + F.tid, NGT = F.G * NTHR; constexpr int Z0 = NB_WIN * 32 * D, Z1 = NINP * D;
      for (int i = Z0 + gt * 16; i < Z1; i += NGT * 16) *(v4u*)(WIN8 + i) = (v4u){0u, 0u, 0u, 0u}; }
}
__device__ __forceinline__ void p0_prologue(Frame& F) {
    LAS float* scr = (LAS float*)(F.lds + F.wave * 16384);
    const int gw = F.bid * NWAVES + F.wave, NGW = F.G * NWAVES;
    bf16* WIN_T = (bf16*)(F.ws + WS_WIN); bf16* WA_T = (bf16*)(F.ws + WS_WA); bf16* WB_T = (bf16*)(F.ws + WS_WB); bf16* WO_T = (bf16*)(F.ws + WS_WO);
    bf16* WGU_T = (bf16*)(F.ws + WS_WGU); bf16* WDN_T = (bf16*)(F.ws + WS_WDN); bf16* WL_T = (bf16*)(F.ws + WS_WL); bf16* HN = (bf16*)(F.ws + WS_HN);
    { const float* W = F.in[I_WIN]; unsigned* colmax = F.ctl + CW_COLMAX;
      for (int task = gw; task < 168 * 16; task += NGW) { const int cb = task % 168, kc = task / 168, n = cb * 64 + F.lane; float m = 0.f;
          if (n < NIN) { const float* wp = W + (size_t)(kc * 128) * NIN + n;
#pragma unroll 1
              for (int k0 = 0; k0 < 128; k0 += 32) { float v[32];
#pragma unroll
                  for (int i = 0; i < 32; ++i) v[i] = wp[(size_t)(k0 + i) * NIN];
#pragma unroll
                  for (int i = 0; i < 32; ++i) m = fmaxf(m, fabsf(v[i])); }
              atomicMax(colmax + n, __float_as_uint(m)); } } }
    { const int gt = F.bid * NTHR + F.tid, NGT = F.G * NTHR;
      for (int i = gt; i < 3072 * 512; i += NGT) { const int n = i >> 9, k = i & 511; float v = 0.f;
          if (n < 1024) { if (k < 96) v = F.in[I_WUP][k * RD + n]; }
          else if (n < 2048) { if (k >= 128 && k < 224) v = F.in[I_AUP][(k - 128) * RD + (n - 1024)]; }
          else { if (k >= 256) v = F.in[I_GUP][(k - 256) * RD + (n - 2048)]; }
          WL_T[i] = (bf16)f2bf(v); } }
    { const int gt = F.bid * NTHR + F.tid, NGT = F.G * NTHR; float* RWS = (float*)(F.ws + WS_RWS);
      for (int i = gt; i < D * NE; i += NGT) RWS[i] = F.in[I_N2W][i >> 5] * F.in[I_RTW][i]; }
    const float* x = F.in[I_X]; const float* nw = F.in[I_N1W];
    for (int m = gw; m < T; m += NGW) {
        const f32x4* xr = (const f32x4*)(x + (size_t)m * D) + F.lane; f32x4 v[8]; float s = 0.f;
#pragma unroll
        for (int j = 0; j < 8; ++j) { v[j] = xr[64 * j]; s += (v[j][0] * v[j][0] + v[j][1] * v[j][1]) + (v[j][2] * v[j][2] + v[j][3] * v[j][3]); }
        const float rstd = __builtin_amdgcn_rsqf(wave_sum(s) * (1.f / D) + NORM_EPS);
        float am = 0.f;
#pragma unroll
        for (int j = 0; j < 8; ++j) { const f32x4 w = ((const f32x4*)nw)[F.lane + 64 * j]; v[j] = v[j] * rstd * w; am = fmaxf(fmaxf(am, fmaxf(fabsf(v[j][0]), fabsf(v[j][1]))), fmaxf(fabsf(v[j][2]), fabsf(v[j][3]))); }
        am = wave_max(am); const float sc = am > 0.f ? 127.f / am : 0.f;
        if (F.lane == 0) ((float*)(F.ws + WS_RA))[m] = am * (1.f / 127.f);
        unsigned* o4 = (unsigned*)((unsigned char*)HN + (size_t)m * D) + F.lane;
#pragma unroll
        for (int j = 0; j < 8; ++j) o4[64 * j] = pk4i8(v[j][0] * sc, v[j][1] * sc, v[j][2] * sc, v[j][3] * sc);
    }
}

__device__ __forceinline__ void p2_lora_in(Frame& F) {
    const bf16* __restrict__ P = (const bf16*)(F.ws + WS_P); bf16* __restrict__ LIN = (bf16*)(F.ws + WS_LIN); const float* __restrict__ mu = F.in[I_MU];
    const int gt = F.bid * NTHR + F.tid, NGT = F.G * NTHR;
#pragma unroll 2
    for (int i = gt; i < T * 64; i += NGT) { const int t = i >> 6, g = i & 63; int col = -1, kind = 0;
        if (g < 12) { col = 3072 + 8 * g; kind = 0; } else if (g >= 16 && g < 28) { col = 3168 + 8 * (g - 16); kind = 1; } else if (g >= 32) { col = 3264 + 8 * (g - 32); kind = 2; }
        v4u o = (v4u){0u, 0u, 0u, 0u};
        if (col >= 0) { const v4u pc = *(const v4u*)(P + (size_t)t * NINP + col); v4u pp = (v4u){0u, 0u, 0u, 0u}; if (t & (SEQ - 1)) pp = *(const v4u*)(P + (size_t)(t - 1) * NINP + col);
            const f32x4 m0 = *(const f32x4*)(mu + col), m1 = *(const f32x4*)(mu + col + 4);
            const unsigned pcs[4] = {pc.x, pc.y, pc.z, pc.w}, pps[4] = {pp.x, pp.y, pp.z, pp.w}; float x[8];
#pragma unroll
            for (int k = 0; k < 4; ++k) { const float c0 = __uint_as_float(pcs[k] << 16), c1 = __uint_as_float(pcs[k] & 0xffff0000u), q0 = __uint_as_float(pps[k] << 16), q1 = __uint_as_float(pps[k] & 0xffff0000u);
                const float ma = k < 2 ? m0[2 * k] : m1[2 * k - 4], mb = k < 2 ? m0[2 * k + 1] : m1[2 * k - 3];
                x[2 * k] = c0 + (q0 - c0) * ma; x[2 * k + 1] = c1 + (q1 - c1) * mb; }
#pragma unroll
            for (int k = 0; k < 8; ++k) x[k] = kind == 0 ? tanhf(x[k]) : (kind == 1 ? x[k] : sigm(x[k]));
            o.x = pk2(x[0], x[1]); o.y = pk2(x[2], x[3]); o.z = pk2(x[4], x[5]); o.w = pk2(x[6], x[7]); }
        *(v4u*)(LIN + (size_t)t * 512 + 8 * g) = o; }
    { bf16* __restrict__ QKC = (bf16*)(F.ws + WS_QKC); const float* __restrict__ cw = F.in[I_CONVW];
      for (int i = gt; i < T * 128; i += NGT) { const int t = i >> 7, c0 = 8 * (i & 127); const int sq = t & (SEQ - 1); float acc[8];
#pragma unroll
          for (int k = 0; k < 8; ++k) acc[k] = 0.f;
#pragma unroll
          for (int j = 0; j < 4; ++j) { if (sq - 3 + j >= 0) { const v4u pv = *(const v4u*)(P + (size_t)(t - 3 + j) * NINP + MLO + c0); const f32x4 w0 = *(const f32x4*)(cw + j * 1024 + c0), w1 = *(const f32x4*)(cw + j * 1024 + c0 + 4);
                  acc[0] += __uint_as_float(pv.x << 16) * w0[0]; acc[1] += __uint_as_float(pv.x & 0xffff0000u) * w0[1]; acc[2] += __uint_as_float(pv.y << 16) * w0[2]; acc[3] += __uint_as_float(pv.y & 0xffff0000u) * w0[3];
                  acc[4] += __uint_as_float(pv.z << 16) * w1[0]; acc[5] += __uint_as_float(pv.z & 0xffff0000u) * w1[1]; acc[6] += __uint_as_float(pv.w << 16) * w1[2]; acc[7] += __uint_as_float(pv.w & 0xffff0000u) * w1[3]; } }
          const float sc = c0 < 512 ? 0.08838834764831845f : 1.f;
#pragma unroll
          for (int k = 0; k < 8; ++k) acc[k] = acc[k] * sigm(acc[k]) * sc;
          v4u o; o.x = pk2(acc[0], acc[1]); o.y = pk2(acc[2], acc[3]); o.z = pk2(acc[4], acc[5]); o.w = pk2(acc[6], acc[7]); *(v4u*)(QKC + (size_t)t * 1024 + c0) = o; } }
    { float* __restrict__ GLF = (float*)(F.ws + WS_GLF); const int gw = F.bid * NWAVES + F.wave, NGW = F.G * NWAVES, lane = F.lane;
      for (int q = gw; q < (T / 64) * 4; q += NGW) { const int chk = q >> 2, mh = q & 3; const size_t t = (size_t)chk * 64 + lane; const bf16* pr = P + t * NINP + MLO + 2048;
          const float ip = 15.f * tanhf((bf2f(pr[mh]) + F.in[I_IB][mh]) * (1.f / 15.f)), fp = 15.f * tanhf((bf2f(pr[4 + mh]) + F.in[I_FB][mh]) * (1.f / 15.f));
          float bc = fminf(fp, 0.f) - log1pf(__expf(-fabsf(fp)));
#pragma unroll
          for (int o = 1; o < 64; o <<= 1) { const float t_ = __shfl_up(bc, o); if (lane >= o) bc += t_; }
          const float u = ip - bc; float pm = u;
#pragma unroll
          for (int o = 1; o < 64; o <<= 1) { const float t_ = __shfl_up(pm, o); if (lane >= o) pm = fmaxf(pm, t_); }
          *(f32x4*)(GLF + t * 16 + 4 * mh) = (f32x4){bc, u, pm, 0.f}; } }
}

typedef short s16x8 __attribute__((ext_vector_type(8)));
typedef short s16x4 __attribute__((ext_vector_type(4)));
__device__ __forceinline__ unsigned long long pack4bf(f32x4 v) { return (unsigned long long)pk2(v[0], v[1]) | ((unsigned long long)pk2(v[2], v[3]) << 32); }
__device__ __forceinline__ s16x8 tr_frag(const LAS bf16* img, int stride, int r0, int c0, int fr) {
    const LAS bf16* p0 = img + (r0 + (fr >> 2)) * stride + c0 + 4 * (fr & 3);
    const s16x4 lo = __builtin_bit_cast(s16x4, __builtin_amdgcn_ds_read_tr16_b64_v4i16((LAS s16x4*)p0));
    const s16x4 hi = __builtin_bit_cast(s16x4, __builtin_amdgcn_ds_read_tr16_b64_v4i16((LAS s16x4*)(p0 + 4 * stride)));
    return __builtin_shufflevector(lo, hi, 0, 1, 2, 3, 4, 5, 6, 7);
}

__device__ __forceinline__ void rw_bar(LAS unsigned* cnt, unsigned& target, int lane);
__device__ __forceinline__ void rwkv_chunk_unit(Frame& F, int unit, LAS unsigned char* regB, LAS unsigned* bcnt, unsigned& btarget) {
    const int b = unit >> 5, h = (unit >> 1) & 15, half = unit & 1;
    const bf16* P = (const bf16*)(F.ws + WS_P); const float* WAG = (const float*)(F.ws + WS_WAG); float* YRAW = (float*)(F.ws + WS_YRAW);
    constexpr int KS = 72, LS = 40;
    LAS bf16* At = (LAS bf16*)F.lds; LAS bf16* Bt = At + 32 * KS; LAS bf16* Kt = Bt + 32 * KS; LAS bf16* Rt = Kt + 32 * KS;
    LAS bf16* Vv = Rt + 32 * KS;
    LAS bf16* Sb = Vv + 32 * LS;
    LAS bf16* G2b = Sb + 32 * KS; LAS bf16* G3b = G2b + 32 * LS; LAS bf16* G4b = G3b + 32 * LS;
    LAS bf16* Pwb = G4b + 32 * LS;
    LAS bf16* Acb = Pwb + 2 * 32 * LS;
    LAS bf16* RHt = (LAS bf16*)regB;
    LAS bf16* Ubt = RHt + 32 * LS;
    LAS float* lwf = (LAS float*)(Ubt + 32 * LS);
    LAS float* csf = lwf + 2048;
    LAS float* gtf = csf + 2048;
    LAS float* glf = gtf + 256;
    const int tid = F.tid, lane = F.lane, w = F.wave, fr = lane & 15, fq = lane >> 4;
    const int ts = tid >> 4, cs = tid & 15, c0 = h * 64 + 4 * cs;
    const int sk = tid & 63, sq = tid >> 6;
    const f32x4 mu_r = *(const f32x4*)(F.in[I_MU] + c0), mu_k = *(const f32x4*)(F.in[I_MU] + 1024 + c0), mu_v = *(const f32x4*)(F.in[I_MU] + 2048 + c0);
    const f32x4 kkc = *(const f32x4*)(F.in[I_KK] + c0), kac = *(const f32x4*)(F.in[I_KA] + c0);
    for (int i = tid; i < 32 * KS; i += 256) Sb[i] = 0;
    v2u cr[2], ck[2], cv[2], qr[2], qk[2], qv[2]; f32x4 w4[2], a4[2];
#define RC_LOAD(ch) do { _Pragma("unroll") for (int p_ = 0; p_ < 2; ++p_) { const int t_ = (ch) * 32 + ts + 16 * p_; const size_t tk_ = (size_t)b * SEQ + t_; const bf16* pr_ = P + tk_ * NINP + c0; \
        cr[p_] = *(const v2u*)(pr_); ck[p_] = *(const v2u*)(pr_ + 1024); cv[p_] = *(const v2u*)(pr_ + 2048); \
        if (t_ > 0) { qr[p_] = *(const v2u*)(pr_ - NINP); qk[p_] = *(const v2u*)(pr_ - NINP + 1024); qv[p_] = *(const v2u*)(pr_ - NINP + 2048); } else { qr[p_] = (v2u){0u, 0u}; qk[p_] = qr[p_]; qv[p_] = qr[p_]; } \
        w4[p_] = *(const f32x4*)(WAG + tk_ * 3072 + c0); a4[p_] = *(const f32x4*)(WAG + tk_ * 3072 + 1024 + c0); } } while (0)
    const int mi = w >> 1, nj = w & 1;
    f32x4 st[2]; st[0] = (f32x4){0.f, 0.f, 0.f, 0.f}; st[1] = st[0];
    RC_LOAD(0);
    rw_bar(bcnt, btarget, lane);
    for (int ch = 0; ch < SEQ / 32; ++ch) {
        f32x4 rr[2], kmod[2], vv[2], kkn[2], lw[2], al[2];
#pragma unroll
        for (int p_ = 0; p_ < 2; ++p_) { const f32x4 pr4 = UNP4(cr[p_]), pk4 = UNP4(ck[p_]), pv4 = UNP4(cv[p_]), qr4 = UNP4(qr[p_]), qk4 = UNP4(qk[p_]), qv4 = UNP4(qv[p_]); lw[p_] = w4[p_]; al[p_] = a4[p_];
            rr[p_] = pr4 + (qr4 - pr4) * mu_r; const f32x4 k1 = pk4 + (qk4 - pk4) * mu_k; vv[p_] = pv4 + (qv4 - pv4) * mu_v;
            const f32x4 kkr = k1 * kkc; const float nrm = __builtin_amdgcn_rsqf(fmaxf(allreduce16((kkr[0] * kkr[0] + kkr[1] * kkr[1]) + (kkr[2] * kkr[2] + kkr[3] * kkr[3])), 1e-24f));
            kkn[p_] = kkr * nrm; kmod[p_] = k1 * (1.f + (al[p_] - 1.f) * kac);
            *(LAS f32x4*)(lwf + (ts + 16 * p_) * 64 + 4 * cs) = lw[p_]; }
        if (ch + 1 < SEQ / 32) RC_LOAD(ch + 1);
        rw_bar(bcnt, btarget, lane);
        float cc[8];
#pragma unroll
        for (int i = 0; i < 8; ++i) cc[i] = lwf[(8 * sq + i) * 64 + sk] + (i ? cc[i - 1] : 0.f);
        gtf[sq * 64 + sk] = cc[7];
        rw_bar(bcnt, btarget, lane);
        { float off = 0.f;
#pragma unroll
          for (int q = 0; q < 3; ++q) off += (q < sq) ? gtf[q * 64 + sk] : 0.f;
#pragma unroll
          for (int i = 0; i < 8; ++i) csf[(8 * sq + i) * 64 + sk] = off + cc[i]; }
        rw_bar(bcnt, btarget, lane);
#pragma unroll
        for (int p_ = 0; p_ < 2; ++p_) { const int t = ts + 16 * p_; const f32x4 cg = *(const LAS f32x4*)(csf + t * 64 + 4 * cs); f32x4 g, gp, gi;
#pragma unroll
          for (int j = 0; j < 4; ++j) { g[j] = __expf(cg[j]); gp[j] = __expf(cg[j] - lw[p_][j]); gi[j] = __expf(-cg[j]); }
          *(LAS unsigned long long*)(At + t * KS + 4 * cs) = pack4bf(-(kkn[p_] * gp)); *(LAS unsigned long long*)(Bt + t * KS + 4 * cs) = pack4bf(kkn[p_] * al[p_] * gi);
          *(LAS unsigned long long*)(Kt + t * KS + 4 * cs) = pack4bf(kmod[p_] * gi); *(LAS unsigned long long*)(Rt + t * KS + 4 * cs) = pack4bf(rr[p_] * g);
          if ((cs >> 3) == half) *(LAS unsigned long long*)(Vv + t * LS + 4 * (cs & 7)) = pack4bf(vv[p_]);
          if (t == 31) *(LAS f32x4*)(glf + 4 * cs) = g; }
        rw_bar(bcnt, btarget, lane);
        f32x4 accT, pwT;
        { const int t = 16 * mi + fr, jb = 16 * nj + 4 * fq;
          f32x4 g1 = (f32x4){0.f, 0.f, 0.f, 0.f}, g2 = g1, g3 = g1, g4 = g1;
#pragma unroll
          for (int ks = 0; ks < 2; ++ks) { const s16x8 bj = *(const LAS s16x8*)(Bt + (16 * nj + fr) * KS + 32 * ks + 8 * fq), kj = *(const LAS s16x8*)(Kt + (16 * nj + fr) * KS + 32 * ks + 8 * fq);
              const s16x8 at = *(const LAS s16x8*)(At + (16 * mi + fr) * KS + 32 * ks + 8 * fq), rt = *(const LAS s16x8*)(Rt + (16 * mi + fr) * KS + 32 * ks + 8 * fq);
              g1 = __builtin_amdgcn_mfma_f32_16x16x32_bf16(bj, at, g1, 0, 0, 0); g2 = __builtin_amdgcn_mfma_f32_16x16x32_bf16(kj, at, g2, 0, 0, 0);
              g3 = __builtin_amdgcn_mfma_f32_16x16x32_bf16(bj, rt, g3, 0, 0, 0); g4 = __builtin_amdgcn_mfma_f32_16x16x32_bf16(kj, rt, g4, 0, 0, 0); }
#pragma unroll
          for (int rg_ = 0; rg_ < 4; ++rg_) { const int j = jb + rg_; g1[rg_] = (j < t) ? g1[rg_] : 0.f; g2[rg_] = (j < t) ? g2[rg_] : 0.f; g3[rg_] = (j <= t) ? g3[rg_] : 0.f; g4[rg_] = (j <= t) ? g4[rg_] : 0.f; }
          pwT = g1; *(LAS unsigned long long*)(Pwb + t * LS + jb) = pack4bf(g1);
#pragma unroll
          for (int rg_ = 0; rg_ < 4; ++rg_) accT[rg_] = g1[rg_] + ((jb + rg_ == t) ? 1.f : 0.f);
          *(LAS unsigned long long*)(Acb + 32 * LS + t * LS + jb) = pack4bf(accT);
          *(LAS unsigned long long*)(G2b + t * LS + jb) = pack4bf(g2); *(LAS unsigned long long*)(G3b + t * LS + jb) = pack4bf(g3); *(LAS unsigned long long*)(G4b + t * LS + jb) = pack4bf(g4); }
        rw_bar(bcnt, btarget, lane);
        f32x4 yv = (f32x4){0.f, 0.f, 0.f, 0.f};
#pragma unroll
        for (int s = 0; s < 5; ++s) { const LAS bf16* Pr = Pwb + (s & 1) * 32 * LS; LAS bf16* Pn = Pwb + ((s + 1) & 1) * 32 * LS; const LAS bf16* Ar = Acb + (s & 1) * 32 * LS; LAS bf16* An = Acb + ((s + 1) & 1) * 32 * LS;
            const s16x8 xrow = *(const LAS s16x8*)(Pr + (16 * mi + fr) * LS + 8 * fq);
            if (s < 4) { f32x4 z = (f32x4){0.f, 0.f, 0.f, 0.f}; z = __builtin_amdgcn_mfma_f32_16x16x32_bf16(tr_frag(Pr, LS, 8 * fq, 16 * nj, fr), xrow, z, 0, 0, 0);
                         *(LAS unsigned long long*)(Pn + (16 * mi + fr) * LS + 16 * nj + 4 * fq) = pack4bf(z); }
            if (s >= 1) { accT = __builtin_amdgcn_mfma_f32_16x16x32_bf16(tr_frag(Ar, LS, 8 * fq, 16 * nj, fr), xrow, accT, 0, 0, 0);
                          *(LAS unsigned long long*)(An + (16 * mi + fr) * LS + 16 * nj + 4 * fq) = pack4bf(accT); }
            if (s == 0) {
                f32x4 z = (f32x4){0.f, 0.f, 0.f, 0.f};
#pragma unroll
                for (int ks = 0; ks < 2; ++ks) { const s16x8 sb = *(const LAS s16x8*)(Sb + (16 * nj + fr) * KS + 32 * ks + 8 * fq);
                    z = __builtin_amdgcn_mfma_f32_16x16x32_bf16(*(const LAS s16x8*)(At + (16 * mi + fr) * KS + 32 * ks + 8 * fq), sb, z, 0, 0, 0);
                    yv = __builtin_amdgcn_mfma_f32_16x16x32_bf16(*(const LAS s16x8*)(Rt + (16 * mi + fr) * KS + 32 * ks + 8 * fq), sb, yv, 0, 0, 0); }
                const s16x8 vt_ = tr_frag(Vv, LS, 8 * fq, 16 * nj, fr);
                z = __builtin_amdgcn_mfma_f32_16x16x32_bf16(*(const LAS s16x8*)(G2b + (16 * mi + fr) * LS + 8 * fq), vt_, z, 0, 0, 0);
                yv = __builtin_amdgcn_mfma_f32_16x16x32_bf16(*(const LAS s16x8*)(G4b + (16 * mi + fr) * LS + 8 * fq), vt_, yv, 0, 0, 0);
                *(LAS unsigned long long*)(RHt + (16 * nj + fr) * LS + 16 * mi + 4 * fq) = pack4bf(z); }
            rw_bar(bcnt, btarget, lane); }
        { f32x4 z = (f32x4){0.f, 0.f, 0.f, 0.f};
          z = __builtin_amdgcn_mfma_f32_16x16x32_bf16(*(const LAS s16x8*)(Acb + 32 * LS + (16 * mi + fr) * LS + 8 * fq), *(const LAS s16x8*)(RHt + (16 * nj + fr) * LS + 8 * fq), z, 0, 0, 0);
          *(LAS unsigned long long*)(Ubt + (16 * nj + fr) * LS + 16 * mi + 4 * fq) = pack4bf(z); }
        rw_bar(bcnt, btarget, lane);
        { yv = __builtin_amdgcn_mfma_f32_16x16x32_bf16(*(const LAS s16x8*)(G3b + (16 * mi + fr) * LS + 8 * fq), *(const LAS s16x8*)(Ubt + (16 * nj + fr) * LS + 8 * fq), yv, 0, 0, 0);
          float* yp = YRAW + ((size_t)b * SEQ + ch * 32 + 16 * mi + 4 * fq) * RD + h * 64 + half * 32 + 16 * nj + fr;
#pragma unroll
          for (int rg_ = 0; rg_ < 4; ++rg_) yp[(size_t)rg_ * RD] = yv[rg_]; }
        { const int kt = w; const s16x8 bt_ = tr_frag(Bt, KS, 8 * fq, 16 * kt, fr), kt_ = tr_frag(Kt, KS, 8 * fq, 16 * kt, fr); const f32x4 gl4 = *(const LAS f32x4*)(glf + 16 * kt + 4 * fq);
#pragma unroll
          for (int vt = 0; vt < 2; ++vt) {
              st[vt] = __builtin_amdgcn_mfma_f32_16x16x32_bf16(bt_, *(const LAS s16x8*)(Ubt + (16 * vt + fr) * LS + 8 * fq), st[vt], 0, 0, 0);
              st[vt] = __builtin_amdgcn_mfma_f32_16x16x32_bf16(kt_, tr_frag(Vv, LS, 8 * fq, 16 * vt, fr), st[vt], 0, 0, 0);
              st[vt] = st[vt] * gl4;
              *(LAS unsigned long long*)(Sb + (16 * vt + fr) * KS + 16 * kt + 4 * fq) = pack4bf(st[vt]); } }
        rw_bar(bcnt, btarget, lane);
    }
#undef RC_LOAD
}

__device__ __forceinline__ float allreduce8(float x) { x += dppf<0x141>(x); x += dppf<0xB1>(x); x += dppf<0x4E>(x); return x; }
__device__ __forceinline__ void rw_bar(LAS unsigned* cnt, unsigned& target, int lane) {
    asm volatile("s_waitcnt lgkmcnt(0)" ::: "memory");
    if (lane == 0) __hip_atomic_fetch_add(cnt, 1u, __ATOMIC_RELAXED, __HIP_MEMORY_SCOPE_WORKGROUP);
    target += 4u;
    while ((unsigned)__builtin_amdgcn_readfirstlane((int)__hip_atomic_load(cnt, __ATOMIC_RELAXED, __HIP_MEMORY_SCOPE_WORKGROUP)) < target) __builtin_amdgcn_s_sleep(1);
    asm volatile("" ::: "memory");
}
constexpr int CV_BR = 8 * 32, CV_WO = 16 * 32, CV_GU = NE * 16 * 64, CV_DN = NE * 16 * 32, CV_ITEMS = 2 * CV_BR + CV_WO + CV_GU + CV_DN;
struct CvItem { const float* src; unsigned char* dst; int N; int f8; };
__device__ __forceinline__ CvItem cv_decode(Frame& F, int it) {
    CvItem c; int r = it; const int lane = F.lane;
    if (r < CV_BR) { const int kb = r >> 5, nb = r & 31; c.src = F.in[I_WBA] + (size_t)(kb * 128) * D + nb * 64 + lane; c.dst = F.ws + WS_WA + ((size_t)(nb * 64 + lane) * RD + kb * 128) * 2; c.N = D; c.f8 = 0; return c; } r -= CV_BR;
    if (r < CV_BR) { const int kb = r >> 5, nb = r & 31; c.src = F.in[I_WBB] + (size_t)(kb * 128) * D + nb * 64 + lane; c.dst = F.ws + WS_WB + ((size_t)(nb * 64 + lane) * RD + kb * 128) * 2; c.N = D; c.f8 = 0; return c; } r -= CV_BR;
    if (r < CV_WO) { const int kb = r >> 5, nb = r & 31; c.src = F.in[I_WOUT] + (size_t)(kb * 128) * D + nb * 64 + lane; c.dst = F.ws + WS_WO + ((size_t)(nb * 64 + lane) * D + kb * 128) * 2; c.N = D; c.f8 = 0; return c; } r -= CV_WO;
    if (r < CV_GU) { const int e = r >> 10, q = r & 1023, kb = q >> 6, nb = q & 63, n0 = nb * 64;
        const int dr = n0 < FF ? ((n0 >> 7) * 256 + (n0 & 127)) : (((n0 - FF) >> 7) * 256 + 128 + ((n0 - FF) & 127));
        c.src = F.in[I_WGU] + (size_t)e * D * 2 * FF + (size_t)(kb * 128) * (2 * FF) + n0 + lane; c.dst = F.ws + WS_WGU + (size_t)e * 2 * FF * D + (size_t)(dr + lane) * D + kb * 128; c.N = 2 * FF; c.f8 = 1; return c; } r -= CV_GU;
    { const int e = r >> 9, q = r & 511, kb = q >> 5, nb = q & 31;
        c.src = F.in[I_WDN] + (size_t)e * FF * D + (size_t)(kb * 128) * D + nb * 64 + lane; c.dst = F.ws + WS_WDN + (size_t)e * D * FF + (size_t)(nb * 64 + lane) * FF + kb * 128; c.N = D; c.f8 = 1; }
    return c;
}
__device__ __forceinline__ void convert_item(Frame& F, int it);
__device__ __forceinline__ void convert_loop(Frame& F, unsigned* next, unsigned* p1done, unsigned ngemm) {
    for (;;) { unsigned b = 0xffffffffu;
        if (F.lane == 0) { if (!(p1done && __hip_atomic_load(p1done, __ATOMIC_RELAXED, __HIP_MEMORY_SCOPE_AGENT) >= ngemm)) b = __hip_atomic_fetch_add(next, 2u, __ATOMIC_RELAXED, __HIP_MEMORY_SCOPE_AGENT); }
        const unsigned base = (unsigned)__builtin_amdgcn_readfirstlane((int)b); if (base >= (unsigned)CV_ITEMS) break;
        for (int k = 0; k < 2; ++k) { const int it = (int)base + k; if (it < CV_ITEMS) convert_item(F, it); } }
}
__device__ __forceinline__ void convert_item(Frame& F, int i0) {
    { const CvItem c = cv_decode(F, i0);
        float x[128];
#pragma unroll
        for (int i = 0; i < 128; ++i) x[i] = c.src[(size_t)i * c.N];
        if (c.f8) {
#pragma unroll
            for (int q = 0; q < 8; ++q) { v4u o; o.x = pk4f8(x[16 * q + 0] * F8_SW, x[16 * q + 1] * F8_SW, x[16 * q + 2] * F8_SW, x[16 * q + 3] * F8_SW); o.y = pk4f8(x[16 * q + 4] * F8_SW, x[16 * q + 5] * F8_SW, x[16 * q + 6] * F8_SW, x[16 * q + 7] * F8_SW);
                o.z = pk4f8(x[16 * q + 8] * F8_SW, x[16 * q + 9] * F8_SW, x[16 * q + 10] * F8_SW, x[16 * q + 11] * F8_SW); o.w = pk4f8(x[16 * q + 12] * F8_SW, x[16 * q + 13] * F8_SW, x[16 * q + 14] * F8_SW, x[16 * q + 15] * F8_SW);
                *(v4u*)(c.dst + 16 * q) = o; } }
        else {
#pragma unroll
            for (int q = 0; q < 16; ++q) { v4u o; o.x = pk2(x[8 * q + 0], x[8 * q + 1]); o.y = pk2(x[8 * q + 2], x[8 * q + 3]); o.z = pk2(x[8 * q + 4], x[8 * q + 5]); o.w = pk2(x[8 * q + 6], x[8 * q + 7]);
                *(v4u*)(c.dst + 16 * q) = o; } } }
}

__device__ __forceinline__ void mlstm_scan_unit(Frame& F, int unit, LAS unsigned* bcnt, unsigned& btarget) {
    const int b = unit >> 5, mh = (unit >> 3) & 3, sl = unit & 7;
    const bf16* P = (const bf16*)(F.ws + WS_P); const bf16* QKC = (const bf16*)(F.ws + WS_QKC); const float* GLF = (const float*)(F.ws + WS_GLF); float* HRAW = (float*)(F.ws + WS_HRAW);
    constexpr int VS = 56;
    LAS bf16* Lq = (LAS bf16*)F.lds;
    LAS bf16* Lk = Lq + 64 * 136;
    LAS bf16* Lv = Lk + 64 * 136;
    LAS bf16* Lvs = Lv + 64 * VS;
    LAS bf16* LcT = Lvs + 64 * VS;
    LAS bf16* Ls = LcT + 2 * 48 * 136;
    LAS float* sb = (LAS float*)(Ls + 64 * 72); LAS float* su = sb + 64; LAS float* smx = su + 64; LAS float* swk = smx + 64;
    const int tid = F.tid, lane = F.lane, w = F.wave, fr = lane & 15, fq = lane >> 4;
    for (int i = tid; i < 2 * 48 * 136; i += 256) LcT[i] = 0;
    for (int i = tid; i < 64 * 16; i += 256) { const int j = i >> 4, c = 32 + (i & 15); Lv[j * VS + c] = (c == 32) ? (bf16)0x3F80 : (bf16)0; Lvs[j * VS + c] = 0; }
    const int pr0 = tid >> 4, pc = 8 * (tid & 15);
    v4u rq[4], rk[4], rv; f32x4 g3;
#define ML_LOAD(ch) do { const size_t tk0_ = (size_t)b * SEQ + (ch) * 64; \
        _Pragma("unroll") for (int i_ = 0; i_ < 4; ++i_) { const bf16* s_ = QKC + (tk0_ + pr0 + 16 * i_) * 1024 + mh * 128 + pc; rq[i_] = *(const v4u*)s_; rk[i_] = *(const v4u*)(s_ + 512); } \
        rv = *(const v4u*)(P + (tk0_ + (tid >> 2)) * NINP + MLO + 1024 + mh * 256 + sl * 32 + 8 * (tid & 3)); \
        g3 = *(const f32x4*)(GLF + (tk0_ + lane) * 16 + 4 * mh); } while (0)
    f32x4 st[2][3];
#pragma unroll
    for (int a = 0; a < 2; ++a)
#pragma unroll
        for (int n = 0; n < 3; ++n) st[a][n] = (f32x4){0.f, 0.f, 0.f, 0.f};
    float mstate = 0.f;
    ML_LOAD(0);
    rw_bar(bcnt, btarget, lane);
    for (int ch = 0; ch < SEQ / 64; ++ch) {
        const size_t tk0 = (size_t)b * SEQ + ch * 64;
        LAS bf16* cTc = LcT + (ch & 1) * 48 * 136; LAS bf16* cTn = LcT + ((ch + 1) & 1) * 48 * 136;
        float mnew, dec;
        { const float bc = g3[0], u = g3[1], pm = g3[2];
          const float gtot = __shfl(bc, 63), pmall = __shfl(pm, 63);
          mnew = gtot + fmaxf(mstate, pmall); dec = __expf(gtot + mstate - mnew);
          const float wk = __expf(u + gtot - mnew);
          sb[lane] = bc; su[lane] = u; smx[lane] = fmaxf(mstate, pm); swk[lane] = wk;
          if (w == 0) Lvs[lane * VS + 32] = (bf16)f2bf(wk); }
#pragma unroll
        for (int i = 0; i < 4; ++i) { *(LAS v4u*)(Lq + (pr0 + 16 * i) * 136 + pc) = rq[i]; *(LAS v4u*)(Lk + (pr0 + 16 * i) * 136 + pc) = rk[i]; }
        LDS_WAIT();
        { const int j = tid >> 2, d0 = 8 * (tid & 3); const float wkj = swk[j]; *(LAS v4u*)(Lv + j * VS + d0) = rv;
          const unsigned uu[4] = {rv.x, rv.y, rv.z, rv.w}; v4u sv;
          sv.x = pk2(wkj * __uint_as_float(uu[0] << 16), wkj * __uint_as_float(uu[0] & 0xffff0000u)); sv.y = pk2(wkj * __uint_as_float(uu[1] << 16), wkj * __uint_as_float(uu[1] & 0xffff0000u));
          sv.z = pk2(wkj * __uint_as_float(uu[2] << 16), wkj * __uint_as_float(uu[2] & 0xffff0000u)); sv.w = pk2(wkj * __uint_as_float(uu[3] << 16), wkj * __uint_as_float(uu[3] & 0xffff0000u));
          *(LAS v4u*)(Lvs + j * VS + d0) = sv; }
        if (ch + 1 < SEQ / 64) ML_LOAD(ch + 1);
        rw_bar(bcnt, btarget, lane);
        { const int tt = w; const int t = 16 * tt + fr; const float mxt = smx[t];
#pragma unroll
          for (int jt = 0; jt < 4; ++jt) { f32x4 acc = (f32x4){0.f, 0.f, 0.f, 0.f};
              if (jt <= tt) {
#pragma unroll
                  for (int ks = 0; ks < 4; ++ks) { const s16x8 a = *(const LAS s16x8*)(Lk + (16 * jt + fr) * 136 + 32 * ks + 8 * fq), bq = *(const LAS s16x8*)(Lq + (16 * tt + fr) * 136 + 32 * ks + 8 * fq);
                      acc = __builtin_amdgcn_mfma_f32_16x16x32_bf16(a, bq, acc, 0, 0, 0); }
                  const f32x4 u4 = *(const LAS f32x4*)(su + 16 * jt + 4 * fq);
#pragma unroll
                  for (int rg_ = 0; rg_ < 4; ++rg_) { const int j = 16 * jt + 4 * fq + rg_; acc[rg_] = (j <= t) ? acc[rg_] * __expf(u4[rg_] - mxt) : 0.f; } }
              *(LAS unsigned long long*)(Ls + t * 72 + 16 * jt + 4 * fq) = pack4bf(acc); } }
        rw_bar(bcnt, btarget, lane);
        { const int mi = w; f32x4 a1[3], a2[3];
#pragma unroll
          for (int n = 0; n < 3; ++n) { a1[n] = (f32x4){0.f, 0.f, 0.f, 0.f}; a2[n] = a1[n]; }
#pragma unroll
          for (int ks = 0; ks < 2; ++ks) { const s16x8 A = *(const LAS s16x8*)(Ls + (16 * mi + fr) * 72 + 32 * ks + 8 * fq);
#pragma unroll
              for (int n = 0; n < 3; ++n) a1[n] = __builtin_amdgcn_mfma_f32_16x16x32_bf16(A, tr_frag(Lv, VS, 32 * ks + 8 * fq, 16 * n, fr), a1[n], 0, 0, 0); }
#pragma unroll
          for (int ks = 0; ks < 4; ++ks) { const s16x8 A = *(const LAS s16x8*)(Lq + (16 * mi + fr) * 136 + 32 * ks + 8 * fq);
#pragma unroll
              for (int n = 0; n < 3; ++n) a2[n] = __builtin_amdgcn_mfma_f32_16x16x32_bf16(A, *(const LAS s16x8*)(cTc + (16 * n + fr) * 136 + 32 * ks + 8 * fq), a2[n], 0, 0, 0); }
          const f32x4 mx4 = *(const LAS f32x4*)(smx + 16 * mi + 4 * fq), b4 = *(const LAS f32x4*)(sb + 16 * mi + 4 * fq);
#pragma unroll
          for (int rg_ = 0; rg_ < 4; ++rg_) { const float wi = __expf(mstate - mx4[rg_]); float den = a1[2][rg_] + wi * a2[2][rg_]; den = __shfl(den, lane & 48);
              const float mt = b4[rg_] + mx4[rg_]; const float inv = __builtin_amdgcn_rcpf(fmaxf(fabsf(den), __expf(-mt))); float* hp = HRAW + (tk0 + 16 * mi + 4 * fq + rg_) * RD + mh * 256 + sl * 32 + fr;
              hp[0] = (a1[0][rg_] + wi * a2[0][rg_]) * inv; hp[16] = (a1[1][rg_] + wi * a2[1][rg_]) * inv; } }
        {
#pragma unroll
          for (int a = 0; a < 2; ++a) {
#pragma unroll
              for (int n = 0; n < 3; ++n) st[a][n] = st[a][n] * dec;
#pragma unroll
              for (int ks = 0; ks < 2; ++ks) { const s16x8 A = tr_frag(Lk, 136, 32 * ks + 8 * fq, 16 * (2 * w + a), fr);
#pragma unroll
                  for (int n = 0; n < 3; ++n) st[a][n] = __builtin_amdgcn_mfma_f32_16x16x32_bf16(A, tr_frag(Lvs, VS, 32 * ks + 8 * fq, 16 * n, fr), st[a][n], 0, 0, 0); }
#pragma unroll
              for (int n = 0; n < 3; ++n) *(LAS unsigned long long*)(cTn + (16 * n + fr) * 136 + 16 * (2 * w + a) + 4 * fq) = pack4bf(st[a][n]); } }
        mstate = mnew;
        rw_bar(bcnt, btarget, lane);
    }
#undef ML_LOAD
}

__device__ __forceinline__ float rowsum4(f32x4 v) { return (v[0] + v[1]) + (v[2] + v[3]); }
__device__ __forceinline__ void p5_finalize(Frame& F) {
    const bf16* __restrict__ P = (const bf16*)(F.ws + WS_P); const float* __restrict__ WAG = (const float*)(F.ws + WS_WAG); const float* __restrict__ YRAW = (const float*)(F.ws + WS_YRAW); const float* __restrict__ HRAW = (const float*)(F.ws + WS_HRAW);
    bf16* __restrict__ OA = (bf16*)(F.ws + WS_OA); bf16* __restrict__ OB = (bf16*)(F.ws + WS_OB);
    const int gw = F.bid * NWAVES + F.wave, NGW = F.G * NWAVES, lane = F.lane;
    { const int hq = gw & 3, c0 = (hq * 4 + (lane >> 4)) * 64 + 4 * (lane & 15);
      const f32x4 mu_r = *(const f32x4*)(F.in[I_MU] + c0), mu_k = *(const f32x4*)(F.in[I_MU] + 1024 + c0), mu_v = *(const f32x4*)(F.in[I_MU] + 2048 + c0);
      const f32x4 kac = *(const f32x4*)(F.in[I_KA] + c0), rkc = *(const f32x4*)(F.in[I_RK] + c0), lnw = *(const f32x4*)(F.in[I_LNW] + c0), lnb = *(const f32x4*)(F.in[I_LNB] + c0);
      v2u cr, ck, cv, qr, qk, qv; f32x4 a4, g4, y4;
#define P5_LOAD(q_) do { const int tk_ = (q_) >> 2; const bf16* pr_ = P + (size_t)tk_ * NINP + c0; cr = *(const v2u*)(pr_); ck = *(const v2u*)(pr_ + 1024); cv = *(const v2u*)(pr_ + 2048); \
          if (tk_ & (SEQ - 1)) { qr = *(const v2u*)(pr_ - NINP); qk = *(const v2u*)(pr_ - NINP + 1024); qv = *(const v2u*)(pr_ - NINP + 2048); } else { qr = (v2u){0u, 0u}; qk = qr; qv = qr; } \
          a4 = *(const f32x4*)(WAG + (size_t)tk_ * 3072 + 1024 + c0); g4 = *(const f32x4*)(WAG + (size_t)tk_ * 3072 + 2048 + c0); y4 = *(const f32x4*)(YRAW + (size_t)tk_ * RD + c0); } while (0)
      if (gw < T * 4) P5_LOAD(gw);
      for (int q = gw; q < T * 4; q += NGW) { const int tk = q >> 2;
          const f32x4 pr4 = UNP4(cr), pk4 = UNP4(ck), pv4 = UNP4(cv), qr4 = UNP4(qr), qk4 = UNP4(qk), qv4 = UNP4(qv); const f32x4 a = a4, g = g4, y = y4;
          if (q + NGW < T * 4) P5_LOAD(q + NGW);
          const f32x4 rr = pr4 + (qr4 - pr4) * mu_r, k1 = pk4 + (qk4 - pk4) * mu_k, vv = pv4 + (qv4 - pv4) * mu_v;
          const f32x4 kmod = k1 * (1.f + (a - 1.f) * kac);
          const float dot = allreduce16(rowsum4(rr * kmod * rkc)); const float mean = allreduce16(rowsum4(y)) * (1.f / 64.f); const f32x4 dl = y - mean;
          const float var = allreduce16(rowsum4(dl * dl)) * (1.f / 64.f); const float rs = __builtin_amdgcn_rsqf(var + GN_EPS);
          const f32x4 o = (dl * rs * lnw + lnb + dot * vv) * g;
          v2u ov; ov.x = pk2(o[0], o[1]); ov.y = pk2(o[2], o[3]); *(v2u*)(OA + (size_t)tk * RD + c0) = ov; }
#undef P5_LOAD
    }
    { const int mh = gw & 3, d0 = mh * 256 + 4 * lane; const f32x4 nw = *(const f32x4*)(F.in[I_MNW] + d0);
      f32x4 hv; v2u po;
#define P5B_LOAD(q_) do { const int tk_ = (q_) >> 2; hv = *(const f32x4*)(HRAW + (size_t)tk_ * RD + d0); po = *(const v2u*)(P + (size_t)tk_ * NINP + MLO + 2056 + d0); } while (0)
      if (gw < T * 4) P5B_LOAD(gw);
      for (int q = gw; q < T * 4; q += NGW) { const int tk = q >> 2; const f32x4 h4 = hv; const v2u p2 = po;
          if (q + NGW < T * 4) P5B_LOAD(q + NGW);
          float ss = allreduce16(rowsum4(h4 * h4)); ss += __shfl_xor(ss, 16); ss += __shfl_xor(ss, 32);
          const float rs = __builtin_amdgcn_rsqf(ss * (1.f / 256.f) + NORM_EPS); const f32x4 og = UNP4(p2);
          const float o0 = h4[0] * rs * nw[0] * sigm(og[0]), o1 = h4[1] * rs * nw[1] * sigm(og[1]), o2 = h4[2] * rs * nw[2] * sigm(og[2]), o3 = h4[3] * rs * nw[3] * sigm(og[3]);
          v2u o; o.x = pk2(o0, o1); o.y = pk2(o2, o3); *(v2u*)(OB + (size_t)tk * RD + d0) = o; }
#undef P5B_LOAD
    }
}

typedef float f32x16 __attribute__((ext_vector_type(16)));
__device__ __forceinline__ void p8_route(Frame& F) {
    const float* X1 = (const float*)(F.ws + WS_X1); unsigned char* H2 = (unsigned char*)(F.ws + WS_HN); int* RLIST = (int*)(F.ws + WS_RLIST); float* RWT = (float*)(F.ws + WS_RW);
    const float* RWS = (const float*)(F.ws + WS_RWS); const float* nw = F.in[I_N2W]; const float* rtb = F.in[I_RTB];
    LAS float* part = (LAS float*)F.lds;
    LAS float* ssq = part + 8 * 32 * 33;
    LAS float* lgt = ssq + 256;
    LAS float* srs = lgt + 32 * 33;
    const int lane = F.lane, w = F.wave, i = lane & 31, h = lane >> 5, tid = F.tid;
    for (int tile = F.bid; tile < T / 32; tile += F.G) {
        const int m0 = tile * 32; const float* xrow = X1 + (size_t)(m0 + i) * D + 256 * w + 4 * h;
        f32x16 acc;
#pragma unroll
        for (int r_ = 0; r_ < 16; ++r_) acc[r_] = 0.f;
        float ss = 0.f; const float* bp = RWS + (size_t)(256 * w + 4 * h) * NE + i;
#pragma unroll 4
        for (int q = 0; q < 32; ++q) { const f32x4 xa = *(const f32x4*)(xrow + 8 * q);
#pragma unroll
            for (int j = 0; j < 4; ++j) acc = __builtin_amdgcn_mfma_f32_32x32x2f32(xa[j], bp[(8 * q + j) * NE], acc, 0, 0, 0);
            ss += (xa[0] * xa[0] + xa[1] * xa[1]) + (xa[2] * xa[2] + xa[3] * xa[3]); }
        ss += __shfl_xor(ss, 32);
        if (h == 0) ssq[w * 32 + i] = ss;
#pragma unroll
        for (int r_ = 0; r_ < 16; ++r_) part[(w * 32 + (r_ & 3) + 8 * (r_ >> 2) + 4 * h) * 33 + i] = acc[r_];
        __syncthreads();
#pragma unroll
        for (int k2 = 0; k2 < 2; ++k2) { const int idx = tid + NTHR * k2, ii = idx >> 5, e = idx & 31; float sm = 0.f, sq = 0.f;
#pragma unroll
            for (int ww = 0; ww < 8; ++ww) { sm += part[(ww * 32 + ii) * 33 + e]; sq += ssq[ww * 32 + ii]; }
            const float rs = 1.f / sqrtf(sq * (1.f / D) + NORM_EPS); lgt[ii * 33 + e] = sm * rs + rtb[e]; if (e == 0) srs[ii] = rs; }
        __syncthreads();
        { const float rs = srs[i] * F8_SX; unsigned char* orow = H2 + (size_t)(m0 + i) * D + 256 * w + 4 * h;
#pragma unroll 8
          for (int q = 0; q < 32; ++q) { const f32x4 n4 = *(const f32x4*)(nw + 256 * w + 4 * h + 8 * q); const f32x4 hv = *(const f32x4*)(xrow + 8 * q) * rs * n4; *(unsigned*)(orow + 8 * q) = pk4f8(hv[0], hv[1], hv[2], hv[3]); } }
        if (tid < 32) { const LAS float* lr = lgt + tid * 33; unsigned used = 0u; int idx[4]; float val[4];
#pragma unroll
            for (int s4 = 0; s4 < 4; ++s4) { float best = -INFINITY; int bi = 0;
                for (int e = 0; e < 32; ++e) { const float v = lr[e]; const bool ok = !((used >> e) & 1u) && (v > best); best = ok ? v : best; bi = ok ? e : bi; }
                used |= 1u << bi; idx[s4] = bi; val[s4] = best; }
            const float e1 = __expf(val[1] - val[0]), e2 = __expf(val[2] - val[0]), e3 = __expf(val[3] - val[0]); const float inv = 1.f / (1.f + e1 + e2 + e3);
            const float wv[4] = {inv, e1 * inv, e2 * inv, e3 * inv};
            unsigned pos[4];
#pragma unroll
            for (int s4 = 0; s4 < 4; ++s4) pos[s4] = atomicAdd(F.ctl + CW_CNT + 64 * idx[s4], 1u);
#pragma unroll
            for (int s4 = 0; s4 < 4; ++s4) { RLIST[idx[s4] * ECAP + pos[s4]] = (m0 + tid) * 4 + s4; RWT[idx[s4] * ECAP + pos[s4]] = wv[s4]; } }
        __syncthreads();
    }
}

__device__ __forceinline__ void build_moe_tables(Frame& F) {
    LAS int* MI = (LAS int*)F.MISC;
    __syncthreads();
    if (F.tid < NE) MI[MI_CNT + F.tid] = (int)__hip_atomic_load(F.ctl + CW_CNT + 64 * F.tid, __ATOMIC_RELAXED, __HIP_MEMORY_SCOPE_AGENT);
    __syncthreads();
    if (F.tid == 0) { int mt = 0, cs = 0;
        for (int e = 0; e < NE; ++e) { const int c = MI[MI_CNT + e]; MI[MI_POFF + e] = mt * 256; MI[MI_CST + e] = cs; cs += c;
            const int nt = (c + 255) >> 8; for (int i = 0; i < nt; ++i) { MI[MI_TILE_E + mt + i] = e; MI[MI_TILE_I0 + mt + i] = i * 256; } mt += nt; }
        MI[MI_CST + NE] = cs; MI[MI_MT] = mt; }
    __syncthreads();
}
__device__ __forceinline__ void p9_gather(Frame& F) {
    build_moe_tables(F);
    const LAS int* MI = (const LAS int*)F.MISC; const bf16* H2 = (const bf16*)(F.ws + WS_HN); bf16* XB = (bf16*)(F.ws + WS_XB); const int* RLIST = (const int*)(F.ws + WS_RLIST);
    const int gw = F.bid * NWAVES + F.wave, NGW = F.G * NWAVES, total = MI[MI_CST + NE];
    for (int q = gw; q < total; q += NGW) { int e = 0;
        for (int k = 1; k < NE; ++k) e = (MI[MI_CST + k] <= q) ? k : e;
        const int i = q - MI[MI_CST + e]; const int tok = RLIST[e * ECAP + i] >> 2;
        const v4u* src = (const v4u*)(H2 + (size_t)tok * D) + F.lane; v4u* dst = (v4u*)(XB + (size_t)(MI[MI_POFF + e] + i) * D) + F.lane;
#pragma unroll
        for (int j = 0; j < 4; ++j) dst[64 * j] = src[64 * j]; }
}
__device__ __forceinline__ void p12_final(Frame& F) {
    const float* X1 = (const float*)(F.ws + WS_X1); const unsigned char* YS = (const unsigned char*)(F.ws + WS_YS); const float* fw = F.in[I_FNW];
    const int gw = F.bid * NWAVES + F.wave, NGW = F.G * NWAVES;
    for (int m = gw; m < T; m += NGW) {
        const f32x4* xr = (const f32x4*)(X1 + (size_t)m * D) + F.lane; f32x4 v[8]; float s = 0.f;
#pragma unroll
        for (int j = 0; j < 8; ++j) { v[j] = xr[64 * j];
#pragma unroll
            for (int sl = 0; sl < 4; ++sl) { const int y = ((const int*)(YS + ((size_t)m * 4 + sl) * D))[F.lane + 64 * j];
                const f32x2 ylo = __builtin_amdgcn_cvt_pk_f32_fp8(y, false), yhi = __builtin_amdgcn_cvt_pk_f32_fp8(y, true);
                v[j][0] += ylo[0] * (1.f / F8_SY); v[j][1] += ylo[1] * (1.f / F8_SY); v[j][2] += yhi[0] * (1.f / F8_SY); v[j][3] += yhi[1] * (1.f / F8_SY); }
            s += (v[j][0] * v[j][0] + v[j][1] * v[j][1]) + (v[j][2] * v[j][2] + v[j][3] * v[j][3]); }
        const float rstd = __builtin_amdgcn_rsqf(wave_sum(s) * (1.f / D) + NORM_EPS);
        f32x4* orow = (f32x4*)(F.out + (size_t)m * D) + F.lane;
#pragma unroll
        for (int j = 0; j < 8; ++j) { const f32x4 w = ((const f32x4*)fw)[F.lane + 64 * j]; orow[64 * j] = v[j] * rstd * w; }
    }
}

__global__ void __launch_bounds__(NTHR, 2) mk_fwd(Args args) {
    extern __shared__ __attribute__((aligned(16))) unsigned char lds[];
    Frame F;
    F.lds = (LAS unsigned char*)lds; F.MISC = (volatile LAS unsigned*)(F.lds + MISC_OFF);
    F.tid = threadIdx.x; F.lane = F.tid & 63; F.wave = __builtin_amdgcn_readfirstlane(F.tid >> 6); F.G = gridDim.x; F.bid = blockIdx.x;
    F.in = args.in; F.out = args.out; F.ws = args.ws; F.ctl = (unsigned*)(args.ws + WS_CTL);
    for (int u = F.tid; u < (LDS_BYTES - MISC_OFF) / 4; u += NTHR) ((LAS unsigned*)(F.lds + MISC_OFF))[u] = 0u;
    __syncthreads();
    XcdBarrier bar; bar.bar = F.ctl + CW_BAR; bar.x = 0; bar.st = nullptr;
    if (MK_N_LAUNCHES == 1) bar = xcd_barrier_post(F.ctl + CW_BAR, F.MISC + 8);
    const int lo = args.ph_lo, hi = args.ph_hi;
#define IN(k) (lo <= (k) && (k) < hi)
#ifndef PROBE_PHASE
#define PROBE_PHASE -1
#endif
#define REP(k) ((PROBE_PHASE) == (k) ? 2 : 1)
#define SEAM(k) do { if (IN(k) && IN((k) + 1)) xcd_barrier(bar); } while (0)
    LAS unsigned char* ring = F.lds;
    const LAS int* MI = (const LAS int*)F.MISC;

    static_assert(MK_N_LAUNCHES == 1, "the W_in quantisation needs an in-launch barrier inside phase 0");
    if (IN(0)) { p0_prologue(F); xcd_barrier(bar); p0b_win(F); } SEAM(0);
    if (IN(1)) {
        const int ng = F.G > 2 * NCV ? F.G - NCV : F.G;
        if (F.bid < ng) {
            pg8::Gemm g{(const bf16*)(F.ws + WS_HN), (const bf16*)(F.ws + WS_WIN), T, NINP, D / 2}; pg8::StaticOrder S; S.init(T, NINP, ng, F.bid);
            EpiP1I8 E{(bf16*)(F.ws + WS_P), NINP, (const float*)(F.ws + WS_RA), F.ctl + CW_COLMAX};
            pg8::gemm_phase<EpiP1I8, pg8::StaticOrder, true, true, false, true>(ring, g, S, E);
            if (F.tid == 0) __hip_atomic_fetch_add(F.ctl + CW_P1DONE, 1u, __ATOMIC_RELAXED, __HIP_MEMORY_SCOPE_AGENT);
        } else convert_loop(F, F.ctl + CW_CVNEXT, F.ctl + CW_P1DONE, (unsigned)ng);
    } SEAM(1);
    if (IN(2)) { for (int rep = 0; rep < REP(2); ++rep) p2_lora_in(F); } SEAM(2);
    if (IN(3)) {
        pg8::Gemm g{(const bf16*)(F.ws + WS_LIN), (const bf16*)(F.ws + WS_WL), T, 3072, 512}; pg8::StaticOrder S; S.init(T, 3072, F.G, F.bid);
        EpiLora E{(float*)(F.ws + WS_WAG), F.in[I_W0], F.in[I_A0]};
        pg8::gemm_phase<EpiLora, pg8::StaticOrder, true, true>(ring, g, S, E);
    } SEAM(3);
    if (IN(4)) {
        { LAS unsigned* ctl2 = (LAS unsigned*)F.MISC + 16;
          if (F.wave < 4) { unsigned bt = 0u; for (int rep = 0; rep < REP(40); ++rep) for (int u = F.bid; u < 256; u += F.G) rwkv_chunk_unit(F, u, (LAS unsigned char*)F.MISC + 256, ctl2, bt); }
          else { Frame F2 = F; F2.tid = F.tid - 256; F2.wave = F.wave - 4; F2.lds = F.lds + 45056; unsigned bt = 0u;
                 for (int rep = 0; rep < REP(41); ++rep) for (int u = F.bid; u < 256; u += F.G) mlstm_scan_unit(F2, u, ctl2 + 2, bt); }
          convert_loop(F, F.ctl + CW_CVNEXT, nullptr, 0u);
          __syncthreads(); }
    } SEAM(4);
    if (IN(5)) { for (int rep = 0; rep < REP(5); ++rep) p5_finalize(F); } SEAM(5);
    if (IN(6)) {
        { pg8::Gemm g{(const bf16*)(F.ws + WS_OA), (const bf16*)(F.ws + WS_WA), T, D, RD}; pg8::StaticOrder S; S.init(T, D, F.G, F.bid);
          EpiGateA E{(float*)(F.ws + WS_TMP), (const bf16*)(F.ws + WS_P), F.in[I_BGATE]};
          pg8::gemm_phase<EpiGateA, pg8::StaticOrder, true, true>(ring, g, S, E); }
        VM_WAIT(); __syncthreads();
        { pg8::Gemm g{(const bf16*)(F.ws + WS_OB), (const bf16*)(F.ws + WS_WB), T, D, RD}; pg8::StaticOrder S; S.init(T, D, F.G, F.bid);
          EpiGateB E{(const float*)(F.ws + WS_TMP), (bf16*)(F.ws + WS_MRG), (const bf16*)(F.ws + WS_P), F.in[I_BGATE]};
          pg8::gemm_phase<EpiGateB, pg8::StaticOrder, true, true>(ring, g, S, E); }
    } SEAM(6);
    if (IN(7)) {
        pg8::Gemm g{(const bf16*)(F.ws + WS_MRG), (const bf16*)(F.ws + WS_WO), T, D, D}; pg8::StaticOrder S; S.init(T, D, F.G, F.bid);
        EpiResid E{F.in[I_X], (float*)(F.ws + WS_X1)};
        pg8::gemm_phase<EpiResid, pg8::StaticOrder, true, true>(ring, g, S, E);
    } SEAM(7);
    if (IN(8)) { p8_route(F); } SEAM(8);
    if (IN(10)) {
        build_moe_tables(F);
        const int mt = MI[MI_MT];
        pg8::Gemm g{(const bf16*)(F.ws + WS_HN), (const bf16*)(F.ws + WS_WGU), mt * 256, 2 * FF, D / 2};
        MoeGatherOrder S; S.init(mt * 256, 2 * FF, F.G, F.bid); S.tile_e = MI + MI_TILE_E; S.estride = (size_t)2 * FF * D;
        S.tile_i0 = MI + MI_TILE_I0; S.cnt = MI + MI_CNT; S.rlist = (const int*)(F.ws + WS_RLIST); S.rowoff = (LAS unsigned*)F.MISC + MI_ROWOFF; S.rowbytes = D;
        EpiSwiGLU E{(unsigned char*)(F.ws + WS_ACT), F.in[I_BGU], MI + MI_TILE_E};
        pg8::gemm_phase<EpiSwiGLU, MoeGatherOrder, true, true, true>(ring, g, S, E);
    } SEAM(10);
    if (IN(11)) {
        build_moe_tables(F);
        const int mt = MI[MI_MT];
        pg8::Gemm g{(const bf16*)(F.ws + WS_ACT), (const bf16*)(F.ws + WS_WDN), mt * 256, D, FF / 2};
        MoeOrder S; S.init(mt * 256, D, F.G, F.bid); S.tile_e = MI + MI_TILE_E; S.estride = (size_t)D * FF;
        LAS int* rowdst = (LAS int*)F.MISC + MI_ROWOFF; LAS float* rowwt = (LAS float*)F.MISC + MI_ROWOFF + 10 * 256;
        fill_down_tables(F, S, rowdst, rowwt);
        EpiDown E{(unsigned char*)(F.ws + WS_YS), F.in[I_BDN], MI + MI_TILE_E, rowdst, rowwt};
        pg8::gemm_phase<EpiDown, MoeOrder, true, true, true>(ring, g, S, E);
    } SEAM(11);
    if (IN(12)) { for (int rep = 0; rep < REP(12); ++rep) p12_final(F); }
#undef IN
#undef SEAM
}

extern "C" void kernel_launch(void* const* d_in, const int* in_sizes, int n_in, void* d_out, int out_size, void* d_ws, size_t ws_size, hipStream_t stream) {
    static int grid = 0;
    if (grid == 0) {
        if (n_in != 30 || out_size != T * D || ws_size < WS_END) { fprintf(stderr, "kernel_launch: unexpected problem (n_in %d, out %d, ws %zu)\n", n_in, out_size, ws_size); grid = -1; return; }
        int dev = 0, cus = 0, per_cu = 0;
        if (hipGetDevice(&dev) != hipSuccess || hipDeviceGetAttribute(&cus, hipDeviceAttributeMultiprocessorCount, dev) != hipSuccess) { grid = -1; return; }
        if (hipFuncSetAttribute((const void*)mk_fwd, hipFuncAttributeMaxDynamicSharedMemorySize, LDS_BYTES) != hipSuccess) { fprintf(stderr, "kernel_launch: hipFuncSetAttribute failed\n"); grid = -1; return; }
        if (hipOccupancyMaxActiveBlocksPerMultiprocessor(&per_cu, (const void*)mk_fwd, NTHR, LDS_BYTES) != hipSuccess || per_cu < 1) fprintf(stderr, "kernel_launch: occupancy query says %d\n", per_cu);
        (void)hipGetLastError();
        grid = cus;
    }
    if (grid < 0) return;
    if (hipMemsetAsync((char*)d_ws + WS_CTL, 0, CTL_ZERO_BYTES, stream) != hipSuccess) return;
    Args a{};
    for (int i = 0; i < 30; ++i) a.in[i] = (const float*)d_in[i];
    a.out = (float*)d_out; a.ws = (unsigned char*)d_ws;
    for (int li = 0; li < MK_N_LAUNCHES; ++li) {
        a.ph_lo = (MK_N_LAUNCHES == 1) ? 0 : li; a.ph_hi = (MK_N_LAUNCHES == 1) ? NPH : li + 1;
        hipLaunchKernelGGL(mk_fwd, dim3(grid), dim3(NTHR), LDS_BYTES, stream, a);
        const hipError_t le = hipPeekAtLastError();
        if (le != hipSuccess) { fprintf(stderr, "kernel_launch: launch %d failed: %s\n", li, hipGetErrorName(le)); break; }
    }
}
```

```cpp
#include <hip/hip_runtime.h>
#include <cstdio>
#include <cstdint>
#define MK_N_LAUNCHES 1
#define PROBE_PHASE -1
namespace pg8 {
#define PG8_LAS __attribute__((address_space(3)))
typedef unsigned short bf16_t;
typedef short bf16x8 __attribute__((ext_vector_type(8)));
typedef float f32x4 __attribute__((ext_vector_type(4)));
typedef unsigned u32x4 __attribute__((ext_vector_type(4)));
constexpr int BM = 256, BK = 64, HALF = 128, HTB = HALF * BK * 2  , STAGE_BYTES = 8 * HTB, NXCD = 8, WGM = 8;

__host__ __device__ __forceinline__ int lds_byte(int r, int c) { const int st = (r >> 4) * 2 + (c >> 5), rr = r & 15, cc = c & 31, ob = rr * 64 + cc * 2; return st * 1024 + (ob ^ (((ob >> 9) & 1) << 5)); }
__host__ __device__ __forceinline__ void stage_rc(int b, int& R, int& C) { const int st = b / 1024, sb = b % 1024, swz = sb ^ (((sb >> 9) & 1) << 5); R = (st >> 1) * 16 + swz / 64; C = (st & 1) * 32 + (swz % 64) / 2; }
__host__ __device__ __forceinline__ int perm32(int rho) { const int n = rho >> 4, i = rho & 15; return 8 * (i >> 2) + 4 * n + (i & 3); }

struct Unit { int pm, pn, ord; };
struct Gemm { const bf16_t* A; const bf16_t* Bt; int M, N, K; };

struct StaticOrder {
    int nM, nN, nwg, G, c;
    __host__ __device__ void init(int M, int N, int G_, int c_) { nM = M / BM; nN = N / BM; nwg = nM * nN; G = G_; c = c_; }
    __host__ __device__ bool next(int i, Unit& u) const {
        const long L = (long)i * G + c; if (L >= nwg) return false;
        int wgid = (int)L; { const int q = nwg / NXCD, r = nwg % NXCD, xcd = wgid % NXCD, off = wgid / NXCD; wgid = (xcd < r ? xcd * (q + 1) : r * (q + 1) + (xcd - r) * q) + off; }
        const int nig = WGM * nN, gid = wgid / nig, fm = gid * WGM, gsz = (nM - fm) < WGM ? (nM - fm) : WGM;
        u.pm = fm + ((wgid % nig) % gsz); u.pn = (wgid % nig) / gsz; u.ord = i; return true;
    }
    __device__ __forceinline__ void a_ready(const Unit&) const {}
    static constexpr bool GATHER = false;
    __device__ __forceinline__ void fill_all() const {}
    __device__ __forceinline__ unsigned row_off(int, int) const { return 0u; }
    __device__ __forceinline__ void done(const Unit&) const {}
    __device__ __forceinline__ size_t a_off(const Unit& u, size_t tstep) const { return (size_t)u.pm * tstep; }
    __device__ __forceinline__ size_t b_off(const Unit& u, size_t tstep) const { return (size_t)u.pn * tstep; }
};
__device__ __forceinline__ unsigned cvt_pk_bf16(float lo, float hi) { unsigned r; asm volatile("v_cvt_pk_bf16_f32 %0, %1, %2" : "=v"(r) : "v"(lo), "v"(hi)); return r; }
typedef int v8i32 __attribute__((ext_vector_type(8)));
typedef int v4i32 __attribute__((ext_vector_type(4)));
__device__ __forceinline__ v8i32 cat8(bf16x8 lo, bf16x8 hi) { const v4i32 a = __builtin_bit_cast(v4i32, lo), b = __builtin_bit_cast(v4i32, hi); return __builtin_shufflevector(a, b, 0, 1, 2, 3, 4, 5, 6, 7); }
template <class Epi, class Sched, bool ALIGN_EPI = false, bool SP2 = false, bool FP8 = false, bool I8 = false>
__device__ __forceinline__ void gemm_phase(PG8_LAS unsigned char* lds, const Gemm g, const Sched& S, const Epi& E) {
    const int tid = threadIdx.x, wid = __builtin_amdgcn_readfirstlane(tid >> 6), lane = tid & 63, wr = wid >> 2, wc = wid & 3, fr = lane & 15, fq = lane >> 4;
    const int K = g.K, nt = K / BK;
    unsigned voffA[2], voffB[2];
#pragma unroll
    for (int i = 0; i < 2; ++i) { int R, C; stage_rc(tid * 16 + i * 8192, R, C); const int Rb = Epi::PERM ? ((R & ~31) + perm32(R & 31)) : R;
        voffA[i] = (unsigned)(R * K + C) * 2u; voffB[i] = (unsigned)(Rb * K + C) * 2u; }
    unsigned voffA1[2]; int rselA[2]; unsigned cselA[2];
#pragma unroll
    for (int i = 0; i < 2; ++i) { int R, C; stage_rc(tid * 16 + i * 8192, R, C); rselA[i] = R; cselA[i] = (unsigned)C * 2u; voffA1[i] = voffA[i]; }
    const size_t kstep = (size_t)(BK * 2);
    const size_t hstep = (size_t)HALF * K * 2;
    const size_t tstep = 2 * hstep;
    const size_t hstepA = Sched::GATHER ? (size_t)0 : hstep;
#define PG8_ROWS(_u) do { _Pragma("unroll") for (int _i = 0; _i < 2; ++_i) { voffA[_i] = S.row_off((_u), rselA[_i]) + cselA[_i]; voffA1[_i] = S.row_off((_u), HALF + rselA[_i]) + cselA[_i]; } } while (0)
    const unsigned ldsw = (unsigned)wid * 1024u;
    const int aoff = lds_byte(wr * 64 + fr, fq * 8), boff = lds_byte(wc * 32 + fr, fq * 8);
#define PG8_SA(b, h) (((b) * 2 + (h)) * HTB)
#define PG8_SB(b, h) ((4 + (b) * 2 + (h)) * HTB)
#define PG8_STAGE(bufoff, gbase, voff) do { _Pragma("unroll") for (int _i = 0; _i < 2; ++_i) \
        __builtin_amdgcn_global_load_lds((const unsigned*)((const char*)(gbase) + (voff)[_i]), (PG8_LAS unsigned*)(lds + (bufoff) + ldsw + _i * 8192), 16, 0, 0); } while (0)
#define PG8_LDA(dst, b, h) do { if constexpr (FP8) { _Pragma("unroll") for (int m = 0; m < 4; ++m) dst##8[m] = cat8(*(const PG8_LAS bf16x8*)(lds + PG8_SA(b, h) + aoff + m * 2048), *(const PG8_LAS bf16x8*)(lds + PG8_SA(b, h) + aoff + m * 2048 + 1024)); } \
        else { _Pragma("unroll") for (int m = 0; m < 4; ++m) _Pragma("unroll") for (int k = 0; k < 2; ++k) dst[m][k] = *(const PG8_LAS bf16x8*)(lds + PG8_SA(b, h) + aoff + m * 2048 + k * 1024); } } while (0)
#define PG8_LDB(dst, b, h) do { if constexpr (FP8) { _Pragma("unroll") for (int n = 0; n < 2; ++n) dst##8[n] = cat8(*(const PG8_LAS bf16x8*)(lds + PG8_SB(b, h) + boff + n * 2048), *(const PG8_LAS bf16x8*)(lds + PG8_SB(b, h) + boff + n * 2048 + 1024)); } \
        else { _Pragma("unroll") for (int n = 0; n < 2; ++n) _Pragma("unroll") for (int k = 0; k < 2; ++k) dst[n][k] = *(const PG8_LAS bf16x8*)(lds + PG8_SB(b, h) + boff + n * 2048 + k * 1024); } } while (0)
#define PG8_MMA(ai, bj, At, Bt) do { __builtin_amdgcn_s_setprio(1); if constexpr (FP8) { _Pragma("unroll") for (int m = 0; m < 4; ++m) _Pragma("unroll") for (int n = 0; n < 2; ++n) \
        asm volatile("v_mfma_scale_f32_16x16x128_f8f6f4 %0, %1, %2, %0, %3, %3 op_sel_hi:[0,0,0]" : "+v"(acc[ai][bj][m][n]) : "v"(Bt##8[n]), "v"(At##8[m]), "v"(f8scale)); } else { \
        _Pragma("unroll") for (int m = 0; m < 4; ++m) _Pragma("unroll") for (int n = 0; n < 2; ++n) _Pragma("unroll") for (int k = 0; k < 2; ++k) { \
        if constexpr (I8) acc[ai][bj][m][n] = __builtin_bit_cast(f32x4, __builtin_amdgcn_mfma_i32_16x16x64_i8(__builtin_bit_cast(v4i32, Bt[n][k]), __builtin_bit_cast(v4i32, At[m][k]), __builtin_bit_cast(v4i32, acc[ai][bj][m][n]), 0, 0, 0)); \
        else acc[ai][bj][m][n] = __builtin_amdgcn_mfma_f32_16x16x32_bf16(Bt[n][k], At[m][k], acc[ai][bj][m][n], 0, 0, 0); } } __builtin_amdgcn_s_setprio(0); } while (0)
#define PG8_WAIT_V(n) asm volatile("s_waitcnt vmcnt(" #n ")" ::: "memory")
#define PG8_WAIT_L(n) asm volatile("s_waitcnt lgkmcnt(" #n ")" ::: "memory")
#define PG8_BAR __builtin_amdgcn_s_barrier()
#define PG8_SCHED __builtin_amdgcn_sched_barrier(0)
    Unit cur, nxt; int ui = 0;
    if (!S.next(0, cur)) return;
    f32x4 acc[2][2][4][2];
#pragma unroll
    for (int a = 0; a < 2; ++a)
#pragma unroll
        for (int b = 0; b < 2; ++b)
#pragma unroll
            for (int m = 0; m < 4; ++m)
#pragma unroll
                for (int n = 0; n < 2; ++n) acc[a][b][m][n] = (f32x4){0.f, 0.f, 0.f, 0.f};
    const int f8scale = 0x7f7f7f7f;
    bf16x8 At[4][2], B0[2][2], B1[2][2]; v8i32 At8[4], B08[2], B18[2];
    const char* cA = (const char*)g.A + S.a_off(cur, tstep); const char* cB = (const char*)g.Bt + S.b_off(cur, tstep);
    S.a_ready(cur);
    if constexpr (Sched::GATHER) { S.fill_all(); asm volatile("s_waitcnt vmcnt(0) lgkmcnt(0)" ::: "memory"); __builtin_amdgcn_s_barrier(); asm volatile("" ::: "memory"); PG8_ROWS(0); }
    if constexpr (SP2) {
        PG8_STAGE(PG8_SB(0, 0), cB, voffB); PG8_STAGE(PG8_SB(0, 1), cB + hstep, voffB); PG8_STAGE(PG8_SA(0, 0), cA, voffA); PG8_STAGE(PG8_SA(0, 1), cA + hstepA, voffA1);
        if (wr == 1) PG8_BAR;
        PG8_WAIT_V(2); PG8_BAR;
        PG8_STAGE(PG8_SB(1, 0), cB + kstep, voffB); PG8_STAGE(PG8_SA(1, 0), cA + kstep, voffA); PG8_STAGE(PG8_SB(1, 1), cB + hstep + kstep, voffB);
        PG8_WAIT_V(6); PG8_BAR;
    } else {
        PG8_STAGE(PG8_SB(0, 0), cB, voffB); PG8_STAGE(PG8_SA(0, 0), cA, voffA); PG8_STAGE(PG8_SB(0, 1), cB + hstep, voffB); PG8_STAGE(PG8_SA(0, 1), cA + hstepA, voffA1);
        if (wr == 1) PG8_BAR;
        PG8_WAIT_V(4); PG8_BAR;
        PG8_STAGE(PG8_SB(1, 0), cB + kstep, voffB); PG8_STAGE(PG8_SA(1, 0), cA + kstep, voffA); PG8_STAGE(PG8_SB(1, 1), cB + hstep + kstep, voffB);
        PG8_WAIT_V(6); PG8_BAR;
    }
    for (;;) {
        const bool has_next = S.next(ui + 1, nxt);
        const char* nA = has_next ? (const char*)g.A + S.a_off(nxt, tstep) : cA; const char* nB = has_next ? (const char*)g.Bt + S.b_off(nxt, tstep) : cB;
        for (int t = 0; t < nt; t += 2) {
            const bool last = (t == nt - 2);
            const char* a1 = cA + (size_t)(t + 1) * kstep;
            const char* a2 = last ? nA : cA + (size_t)(t + 2) * kstep; const char* b2 = last ? nB : cB + (size_t)(t + 2) * kstep;
            const char* a3 = a2 + kstep; const char* b3 = b2 + kstep;
            if (last && has_next) S.a_ready(nxt);
            if constexpr (SP2) {
            PG8_LDB(B0, 0, 0); PG8_LDB(B1, 0, 1); PG8_SCHED; PG8_LDA(At, 0, 0); PG8_STAGE(PG8_SA(1, 1), a1 + hstepA, voffA1);
            PG8_WAIT_V(8); PG8_WAIT_L(0); PG8_BAR; PG8_MMA(0, 0, At, B0); PG8_MMA(0, 1, At, B1); PG8_BAR; PG8_SCHED;
            if constexpr (Sched::GATHER) { if (last && has_next) PG8_ROWS(ui + 1); }
            PG8_LDA(At, 0, 1); PG8_STAGE(PG8_SB(0, 0), b2, voffB); PG8_STAGE(PG8_SB(0, 1), b2 + hstep, voffB); PG8_STAGE(PG8_SA(0, 0), a2, voffA);
            PG8_WAIT_V(8); PG8_WAIT_L(0); PG8_BAR; PG8_MMA(1, 0, At, B0); PG8_MMA(1, 1, At, B1); PG8_BAR; PG8_SCHED;
            PG8_LDB(B0, 1, 0); PG8_LDB(B1, 1, 1); PG8_SCHED; PG8_LDA(At, 1, 0); PG8_STAGE(PG8_SA(0, 1), a2 + hstepA, voffA1);
            PG8_WAIT_V(8); PG8_WAIT_L(0); PG8_BAR; PG8_MMA(0, 0, At, B0); PG8_MMA(0, 1, At, B1); PG8_BAR; PG8_SCHED;
            PG8_LDA(At, 1, 1); PG8_STAGE(PG8_SB(1, 0), b3, voffB); PG8_STAGE(PG8_SB(1, 1), b3 + hstep, voffB); PG8_STAGE(PG8_SA(1, 0), a3, voffA);
            PG8_WAIT_V(8); PG8_WAIT_L(0); PG8_BAR; PG8_MMA(1, 0, At, B0); PG8_MMA(1, 1, At, B1); PG8_BAR; PG8_SCHED;
            } else {
            PG8_LDB(B0, 0, 0); PG8_SCHED; PG8_LDA(At, 0, 0); PG8_STAGE(PG8_SA(1, 1), a1 + hstepA, voffA1);
            PG8_WAIT_L(8); PG8_BAR; PG8_WAIT_L(0); PG8_MMA(0, 0, At, B0); PG8_BAR; PG8_SCHED;
            PG8_LDB(B1, 0, 1); PG8_STAGE(PG8_SB(0, 0), b2, voffB);
            PG8_BAR; PG8_WAIT_L(0); PG8_MMA(0, 1, At, B1); PG8_BAR;
            PG8_LDA(At, 0, 1); PG8_STAGE(PG8_SA(0, 0), a2, voffA);
            PG8_BAR; PG8_WAIT_L(0); PG8_MMA(1, 0, At, B0); PG8_BAR; PG8_SCHED;
            PG8_STAGE(PG8_SB(0, 1), b2 + hstep, voffB);
            PG8_WAIT_V(6); PG8_BAR; PG8_MMA(1, 1, At, B1); PG8_BAR;
            PG8_LDB(B0, 1, 0); PG8_SCHED; PG8_LDA(At, 1, 0); PG8_STAGE(PG8_SA(0, 1), a2 + hstepA, voffA1);
            PG8_WAIT_L(8); PG8_BAR; PG8_WAIT_L(0); PG8_MMA(0, 0, At, B0); PG8_BAR; PG8_SCHED;
            PG8_LDB(B1, 1, 1); PG8_STAGE(PG8_SB(1, 0), b3, voffB);
            PG8_BAR; PG8_WAIT_L(0); PG8_MMA(0, 1, At, B1); PG8_BAR;
            PG8_LDA(At, 1, 1); PG8_STAGE(PG8_SA(1, 0), a3, voffA);
            PG8_BAR; PG8_WAIT_L(0); PG8_MMA(1, 0, At, B0); PG8_BAR; PG8_SCHED;
            PG8_STAGE(PG8_SB(1, 1), b3 + hstep, voffB);
            PG8_WAIT_V(6); PG8_BAR; PG8_MMA(1, 1, At, B1); PG8_BAR;
            }
        }
        if constexpr (ALIGN_EPI) { if (wr == 0) PG8_BAR; }
        if constexpr (FP8) { asm volatile("s_nop 15\n\ts_nop 15" ::: "memory"); }
        if constexpr (!Epi::AFTER_DRAIN) { E(acc, cur, wr, wc, fr, fq); S.done(cur); }
        if (!has_next) break;
#pragma unroll
        for (int a = 0; a < 2; ++a)
#pragma unroll
            for (int b = 0; b < 2; ++b)
#pragma unroll
                for (int m = 0; m < 4; ++m)
#pragma unroll
                    for (int n = 0; n < 2; ++n) acc[a][b][m][n] = (f32x4){0.f, 0.f, 0.f, 0.f};
        cur = nxt; cA = nA; cB = nB; ++ui;
        if constexpr (ALIGN_EPI) { if (wr == 1) PG8_BAR; }
    }
    PG8_WAIT_V(0);
    if constexpr (!ALIGN_EPI) { if (wr == 0) PG8_BAR; }
    PG8_BAR;
    if constexpr (Epi::AFTER_DRAIN) { E.fused(acc, cur, wr, wc, fr, fq, lds, wid, lane); S.done(cur); }
#undef PG8_ROWS
#undef PG8_SA
#undef PG8_SB
#undef PG8_STAGE
#undef PG8_LDA
#undef PG8_LDB
#undef PG8_MMA
#undef PG8_WAIT_V
#undef PG8_WAIT_L
#undef PG8_BAR
#undef PG8_SCHED
}
}

#ifndef MK_N_LAUNCHES
#define MK_N_LAUNCHES 1
#endif
#define GAS __attribute__((address_space(1)))
#define LAS __attribute__((address_space(3)))
typedef unsigned short bf16;
typedef unsigned v4u __attribute__((ext_vector_type(4)));
typedef unsigned v2u __attribute__((ext_vector_type(2)));
typedef float f32x4 __attribute__((ext_vector_type(4)));
typedef float f32x2 __attribute__((ext_vector_type(2)));

constexpr int NWAVES = 8, NTHR = 512;
constexpr int NPH = 13;
constexpr int D = 2048, BATCH = 8, SEQ = 2048, T = BATCH * SEQ;
constexpr int NIN = 10696, NINP = 10752;
constexpr int MLO = 3520, GTO = 6600;
constexpr int RH = 16, RD = 1024;
constexpr int MH = 4;
constexpr int NE = 32, FF = 2048, ECAP = 16384, PMAX = 65536 + NE * 256, MTMAX = PMAX / 256;
constexpr float NORM_EPS = 1e-6f, GN_EPS = 64e-5f;
constexpr size_t MiB = 1u << 20;
constexpr size_t WS_CTL = 0, CTL_ZERO_BYTES = 1 * MiB;
constexpr size_t WS_WIN = 1 * MiB, WS_WA = 43 * MiB, WS_WB = 47 * MiB, WS_WO = 51 * MiB, WS_WL = 59 * MiB;
constexpr size_t WS_RLIST = 62 * MiB, WS_RW = 64 * MiB, WS_RWS = 2787 * MiB, WS_RA = 2787 * MiB + 512 * 1024;
constexpr size_t WS_WGU = 66 * MiB, WS_WDN = 578 * MiB, WS_HN = 834 * MiB, WS_P = 898 * MiB, WS_LIN = 1234 * MiB, WS_WAG = 1250 * MiB;
constexpr size_t WS_YRAW = 1442 * MiB, WS_HRAW = 1506 * MiB, WS_OA = 1570 * MiB, WS_OB = 1602 * MiB, WS_TMP = 1634 * MiB, WS_MRG = 1762 * MiB;
constexpr size_t WS_QKC = WS_TMP, WS_GLF = WS_TMP + 64 * MiB;
constexpr size_t WS_X1 = 1826 * MiB, WS_XB = 1954 * MiB, WS_ACT = 2242 * MiB, WS_YS = 2530 * MiB, WS_END = 2788 * MiB;
constexpr int CW_BAR = 4096;
constexpr int CW_CVNEXT = 8192, CW_P1DONE = 8192 + 64;
constexpr int NCV = 64;
constexpr int CW_COLMAX = 32768;
constexpr int CW_CNT = 16384;
constexpr int RING_BYTES = 131072, MISC_OFF = RING_BYTES, LDS_BYTES = RING_BYTES + 8192 + 20 * 1024;
constexpr int MI_TILE_E = 64, MI_TILE_I0 = 64 + 320, MI_CNT = 64 + 640, MI_POFF = MI_CNT + 32, MI_CST = MI_POFF + 32, MI_MT = MI_CST + 40, MI_ROWOFF = 2048;

#define LDS_WAIT() asm volatile("s_waitcnt lgkmcnt(0)" ::: "memory")
#define VM_WAIT() asm volatile("s_waitcnt vmcnt(0)" ::: "memory")
__device__ __forceinline__ float bf2f(bf16 v) { return __uint_as_float(((unsigned)v) << 16); }
__device__ __forceinline__ unsigned f2bf(float f) { unsigned u = __float_as_uint(f); return (u + 0x7fffu + ((u >> 16) & 1u)) >> 16; }
typedef __bf16 bf16x2_t __attribute__((ext_vector_type(2)));
__device__ __forceinline__ unsigned pk2(float lo, float hi) { const f32x2 v = {lo, hi}; const bf16x2_t b = __builtin_convertvector(v, bf16x2_t); return __builtin_bit_cast(unsigned, b); }
__device__ __forceinline__ unsigned pk4f8(float a, float b, float c, float d) { int r = 0; r = __builtin_amdgcn_cvt_pk_fp8_f32(a, b, r, false); r = __builtin_amdgcn_cvt_pk_fp8_f32(c, d, r, true); return (unsigned)r; }
constexpr float F8_SX = 8.f, F8_SW = 256.f, F8_SA = 4.f, F8_SY = 16.f;
__device__ __forceinline__ unsigned pk4i8(float a, float b, float c, float d) {
    const int ia = (int)__builtin_rintf(a), ib = (int)__builtin_rintf(b), ic = (int)__builtin_rintf(c), id = (int)__builtin_rintf(d);
    return (unsigned)(ia & 255) | ((unsigned)(ib & 255) << 8) | ((unsigned)(ic & 255) << 16) | ((unsigned)id << 24); }
__device__ __forceinline__ float wave_max(float v) {
#pragma unroll
    for (int o = 1; o < 64; o <<= 1) v = fmaxf(v, __shfl_xor(v, o));
    return v;
}
__device__ __forceinline__ float wave_sum(float v) {
#pragma unroll
    for (int o = 1; o < 64; o <<= 1) v += __shfl_xor(v, o);
    return v;
}
#define UNP4(v) ((f32x4){__uint_as_float((v).x << 16), __uint_as_float((v).x & 0xffff0000u), __uint_as_float((v).y << 16), __uint_as_float((v).y & 0xffff0000u)})
__device__ __forceinline__ float sigm(float x) { return __builtin_amdgcn_rcpf(1.f + __expf(-x)); }
template <int CTRL> __device__ __forceinline__ float dppf(float x) { return __builtin_bit_cast(float, __builtin_amdgcn_mov_dpp(__builtin_bit_cast(int, x), CTRL, 0xf, 0xf, true)); }
__device__ __forceinline__ float allreduce16(float x) { x += dppf<0x128>(x); x += dppf<0x124>(x); x += dppf<0x4E>(x); x += dppf<0xB1>(x); return x; }

#define XB_TMO      128
#define XB_XCNT(j)  (256  + 64 * (j))
#define XB_XSUB(j)  (1280 + 64 * (j))
#define XB_XGEN(j)  (2304 + 64 * (j))
#define XB_TOP      3328
#define XB_TOPGEN   3392
#define XCD_BAR_WORDS 3456
#define XB_SPIN_CAP (1u << 18)
__device__ __forceinline__ unsigned xb_ld(unsigned* p)              { return __hip_atomic_load(p, __ATOMIC_RELAXED, __HIP_MEMORY_SCOPE_AGENT); }
__device__ __forceinline__ unsigned xb_add(unsigned* p, unsigned v) { return __hip_atomic_fetch_add(p, v, __ATOMIC_RELAXED, __HIP_MEMORY_SCOPE_AGENT); }
__device__ __forceinline__ unsigned xb_xcc_id() { return (unsigned)__builtin_amdgcn_s_getreg((3 << 11) | 20) & 0xFu; }
#define XB_SPIN(cond, bar) do { unsigned _sp = 0; while (cond) { __builtin_amdgcn_s_sleep(1); \
    if ((++_sp & 255u) == 0u) { if (xb_ld(&(bar)[XB_TMO])) break; if (_sp > XB_SPIN_CAP) { atomicAdd(&(bar)[XB_TMO], 1u); break; } } } } while (0)
struct XcdBarrier { unsigned* bar; unsigned x; volatile LAS unsigned* st; };
__device__ __forceinline__ XcdBarrier xcd_barrier_post(unsigned* bar, volatile LAS unsigned* st) {
    XcdBarrier b; b.bar = bar; b.x = xb_xcc_id(); b.st = st;
    if (threadIdx.x == 0) (void)xb_add(&bar[XB_XCNT(b.x)], 1u);
    return b;
}
__device__ __forceinline__ void xcd_barrier_complete(unsigned* bar, unsigned x, unsigned& nloc, unsigned& nx) {
    const unsigned G = gridDim.x * gridDim.y * gridDim.z;
    unsigned sum, cnt, mine, sp = 0u;
    for (;;) {
        sum = 0u; cnt = 0u; mine = 0u;
#pragma unroll
        for (unsigned j = 0; j < 16; ++j) { const unsigned c = xb_ld(&bar[XB_XCNT(j)]); sum += c; cnt += (c > 0u) ? 1u : 0u; mine = (j == x) ? c : mine; }
        if (sum == G) break;
        __builtin_amdgcn_s_sleep(1);
        if ((++sp & 255u) == 0u) { if (xb_ld(&bar[XB_TMO])) break; if (sp > XB_SPIN_CAP) { atomicAdd(&bar[XB_TMO], 1u); break; } }
    }
    nloc = mine > 0u ? mine : 1u; nx = cnt > 0u ? cnt : 1u;
}
__device__ __forceinline__ void xcd_barrier(const XcdBarrier& b) {
    asm volatile("s_waitcnt vmcnt(0)" ::: "memory");
    __syncthreads();
    if (threadIdx.x == 0) {
        unsigned* bar = b.bar;
        __builtin_amdgcn_s_waitcnt(0);
        unsigned nloc = b.st[0], nx = b.st[1];
        if (nloc == 0u) { xcd_barrier_complete(bar, b.x, nloc, nx); b.st[0] = nloc; b.st[1] = nx; }
        const unsigned old = xb_add(&bar[XB_XSUB(b.x)], 1u);
        const unsigned gen = old / nloc;
        if (old + 1u == (gen + 1u) * nloc) {
            __builtin_amdgcn_fence(__ATOMIC_RELEASE, "agent");
            asm volatile("s_waitcnt vmcnt(0)" ::: "memory");
            const unsigned og = xb_add(&bar[XB_TOP], 1u);
            const unsigned tg = og / nx;
            if (og + 1u == (tg + 1u) * nx) xb_add(&bar[XB_TOPGEN], 1u);
            else XB_SPIN(xb_ld(&bar[XB_TOPGEN]) == tg, bar);
            __builtin_amdgcn_fence(__ATOMIC_ACQUIRE, "agent");
            xb_add(&bar[XB_XGEN(b.x)], 1u);
            asm volatile("s_waitcnt vmcnt(0)" ::: "memory");
        } else {
            XB_SPIN(xb_ld(&bar[XB_XGEN(b.x)]) == gen, bar);
            __builtin_amdgcn_fence(__ATOMIC_ACQUIRE, "agent");
            asm volatile("s_waitcnt vmcnt(0)" ::: "memory");
        }
    }
    __syncthreads();
}

struct Args { const float* in[30]; float* out; unsigned char* ws; int ph_lo, ph_hi; };
enum { I_X = 0, I_N1W, I_WIN, I_BGATE, I_MU, I_W0, I_WUP, I_A0, I_AUP, I_GUP, I_KK, I_KA, I_RK, I_LNW, I_LNB, I_CONVW, I_IB, I_FB, I_MNW, I_WBA, I_WBB, I_WOUT, I_N2W, I_RTW, I_RTB, I_WGU, I_BGU, I_WDN, I_BDN, I_FNW };

struct Frame {
    LAS unsigned char* lds; volatile LAS unsigned* MISC; unsigned* ctl;
    int tid, lane, wave, G, bid;
    const float* const* in; float* out; unsigned char* ws;
};

using pg8::Unit; using pg8::HALF; using pg8::BM;
struct EpiBf16Plain {
    static constexpr bool PERM = true, AFTER_DRAIN = false;
    bf16* O; int ldc;
    __device__ __forceinline__ void operator()(const f32x4 (&acc)[2][2][4][2], const Unit& u, int wr, int wc, int fr, int fq) const {
        const int row0 = u.pm * BM + wr * 64 + fr, col0 = u.pn * BM + wc * 32 + 8 * fq;
#pragma unroll
        for (int ai = 0; ai < 2; ++ai)
#pragma unroll
            for (int m = 0; m < 4; ++m) { bf16* rowp = O + (size_t)(row0 + ai * HALF + m * 16) * ldc + col0;
#pragma unroll
                for (int bj = 0; bj < 2; ++bj) { const f32x4 v0 = acc[ai][bj][m][0], v1 = acc[ai][bj][m][1];
                    v4u w; w.x = pg8::cvt_pk_bf16(v0[0], v0[1]); w.y = pg8::cvt_pk_bf16(v0[2], v0[3]); w.z = pg8::cvt_pk_bf16(v1[0], v1[1]); w.w = pg8::cvt_pk_bf16(v1[2], v1[3]);
                    *(v4u*)(rowp + bj * HALF) = w; } }
    }
};
struct EpiP1I8 {
    static constexpr bool PERM = true, AFTER_DRAIN = false;
    bf16* O; int ldc; const float* ra; const unsigned* colmax;
    __device__ __forceinline__ void operator()(const f32x4 (&acc)[2][2][4][2], const Unit& u, int wr, int wc, int fr, int fq) const {
        const int row0 = u.pm * BM + wr * 64 + fr, col0 = u.pn * BM + wc * 32 + 8 * fq;
        f32x4 cb[2][2];
#pragma unroll
        for (int bj = 0; bj < 2; ++bj)
#pragma unroll
            for (int n = 0; n < 2; ++n) { const v4u cm = *(const v4u*)(colmax + col0 + bj * HALF + 4 * n);
                cb[bj][n] = (f32x4){__uint_as_float(cm.x), __uint_as_float(cm.y), __uint_as_float(cm.z), __uint_as_float(cm.w)} * (1.f / 127.f); }
#pragma unroll
        for (int ai = 0; ai < 2; ++ai)
#pragma unroll
            for (int m = 0; m < 4; ++m) { const int r = row0 + ai * HALF + m * 16; const float rs = ra[r]; bf16* rowp = O + (size_t)r * ldc + col0;
#pragma unroll
                for (int bj = 0; bj < 2; ++bj) { const v4u i0 = __builtin_bit_cast(v4u, acc[ai][bj][m][0]), i1 = __builtin_bit_cast(v4u, acc[ai][bj][m][1]);
                    const f32x4 v0 = (f32x4){(float)(int)i0.x, (float)(int)i0.y, (float)(int)i0.z, (float)(int)i0.w} * cb[bj][0] * rs, v1 = (f32x4){(float)(int)i1.x, (float)(int)i1.y, (float)(int)i1.z, (float)(int)i1.w} * cb[bj][1] * rs;
                    v4u w; w.x = pk2(v0[0], v0[1]); w.y = pk2(v0[2], v0[3]); w.z = pk2(v1[0], v1[1]); w.w = pk2(v1[2], v1[3]);
                    *(v4u*)(rowp + bj * HALF) = w; } }
    }
};
struct EpiLora {
    static constexpr bool PERM = false, AFTER_DRAIN = false;
    float* WLD; bf16* AG; const float* w0; const float* a0;
    __device__ __forceinline__ void operator()(const f32x4 (&acc)[2][2][4][2], const Unit& u, int wr, int wc, int fr, int fq) const {
        const int row0 = u.pm * BM + wr * 64 + fr, col0 = u.pn * BM + wc * 32 + 4 * fq, seg = u.pn >> 2;
        f32x4 bv[2][2];
#pragma unroll
        for (int bj = 0; bj < 2; ++bj)
#pragma unroll
            for (int n = 0; n < 2; ++n) { const int c = col0 + bj * HALF + n * 16;
                bv[bj][n] = seg == 0 ? *(const f32x4*)(w0 + c) : (seg == 1 ? *(const f32x4*)(a0 + (c - 1024)) : (f32x4){0.f, 0.f, 0.f, 0.f}); }
#pragma unroll
        for (int ai = 0; ai < 2; ++ai)
#pragma unroll
            for (int m = 0; m < 4; ++m) { const size_t r = (size_t)(row0 + ai * HALF + m * 16);
#pragma unroll
                for (int bj = 0; bj < 2; ++bj)
#pragma unroll
                    for (int n = 0; n < 2; ++n) { f32x4 v = acc[ai][bj][m][n] + bv[bj][n]; const int c = col0 + bj * HALF + n * 16;
                        if (seg == 0) {
#pragma unroll
                            for (int j = 0; j < 4; ++j) v[j] = -0.6065306597126334f * sigm(v[j]);
                            *(f32x4*)(WLD + r * RD + c) = v; }
                        else { if (seg == 1) {
#pragma unroll
                                for (int j = 0; j < 4; ++j) v[j] = sigm(v[j]); }
                            v2u o; o.x = pk2(v[0], v[1]); o.y = pk2(v[2], v[3]); *(v2u*)(AG + r * D + (c - 1024)) = o; } } }
    }
};
struct EpiGateA {
    static constexpr bool PERM = true, AFTER_DRAIN = false;
    bf16* TMP; const bf16* P; const float* bg;
    __device__ __forceinline__ void operator()(const f32x4 (&acc)[2][2][4][2], const Unit& u, int wr, int wc, int fr, int fq) const {
        const int row0 = u.pm * BM + wr * 64 + fr, col0 = u.pn * BM + wc * 32 + 8 * fq;
#pragma unroll
        for (int ai = 0; ai < 2; ++ai)
#pragma unroll
            for (int m = 0; m < 4; ++m) { const size_t r = (size_t)(row0 + ai * HALF + m * 16);
#pragma unroll
                for (int bj = 0; bj < 2; ++bj) { const int c = col0 + bj * HALF;
                    const v4u pg = *(const v4u*)(P + r * NINP + GTO + c); const f32x4 b0 = *(const f32x4*)(bg + c), b1 = *(const f32x4*)(bg + c + 4);
                    f32x4 g0, g1;
                    g0[0] = sigm(__uint_as_float(pg.x << 16) + b0[0]); g0[1] = sigm(__uint_as_float(pg.x & 0xffff0000u) + b0[1]);
                    g0[2] = sigm(__uint_as_float(pg.y << 16) + b0[2]); g0[3] = sigm(__uint_as_float(pg.y & 0xffff0000u) + b0[3]);
                    g1[0] = sigm(__uint_as_float(pg.z << 16) + b1[0]); g1[1] = sigm(__uint_as_float(pg.z & 0xffff0000u) + b1[1]);
                    g1[2] = sigm(__uint_as_float(pg.w << 16) + b1[2]); g1[3] = sigm(__uint_as_float(pg.w & 0xffff0000u) + b1[3]);
                    const f32x4 t0 = g0 * acc[ai][bj][m][0], t1 = g1 * acc[ai][bj][m][1]; v4u tw; tw.x = pk2(t0[0], t0[1]); tw.y = pk2(t0[2], t0[3]); tw.z = pk2(t1[0], t1[1]); tw.w = pk2(t1[2], t1[3]);
                    *(v4u*)(TMP + r * D + c) = tw; } }
    }
};
struct EpiGateB {
    static constexpr bool PERM = true, AFTER_DRAIN = false;
    const bf16* TMP; bf16* MRG; const bf16* P; const float* bg;
    __device__ __forceinline__ void operator()(const f32x4 (&acc)[2][2][4][2], const Unit& u, int wr, int wc, int fr, int fq) const {
        const int row0 = u.pm * BM + wr * 64 + fr, col0 = u.pn * BM + wc * 32 + 8 * fq;
#pragma unroll
        for (int ai = 0; ai < 2; ++ai)
#pragma unroll
            for (int m = 0; m < 4; ++m) { const size_t r = (size_t)(row0 + ai * HALF + m * 16);
#pragma unroll
                for (int bj = 0; bj < 2; ++bj) { const int c = col0 + bj * HALF;
                    const v4u pg = *(const v4u*)(P + r * NINP + GTO + D + c); const f32x4 b0 = *(const f32x4*)(bg + D + c), b1 = *(const f32x4*)(bg + D + c + 4);
                    const v4u tw = *(const v4u*)(TMP + r * D + c); const f32x4 t0 = (f32x4){__uint_as_float(tw.x << 16), __uint_as_float(tw.x & 0xffff0000u), __uint_as_float(tw.y << 16), __uint_as_float(tw.y & 0xffff0000u)}, t1 = (f32x4){__uint_as_float(tw.z << 16), __uint_as_float(tw.z & 0xffff0000u), __uint_as_float(tw.w << 16), __uint_as_float(tw.w & 0xffff0000u)};
                    f32x4 g0, g1;
                    g0[0] = sigm(__uint_as_float(pg.x << 16) + b0[0]); g0[1] = sigm(__uint_as_float(pg.x & 0xffff0000u) + b0[1]);
                    g0[2] = sigm(__uint_as_float(pg.y << 16) + b0[2]); g0[3] = sigm(__uint_as_float(pg.y & 0xffff0000u) + b0[3]);
                    g1[0] = sigm(__uint_as_float(pg.z << 16) + b1[0]); g1[1] = sigm(__uint_as_float(pg.z & 0xffff0000u) + b1[1]);
                    g1[2] = sigm(__uint_as_float(pg.w << 16) + b1[2]); g1[3] = sigm(__uint_as_float(pg.w & 0xffff0000u) + b1[3]);
                    const f32x4 v0 = t0 + g0 * acc[ai][bj][m][0], v1 = t1 + g1 * acc[ai][bj][m][1];
                    v4u w; w.x = pg8::cvt_pk_bf16(v0[0], v0[1]); w.y = pg8::cvt_pk_bf16(v0[2], v0[3]); w.z = pg8::cvt_pk_bf16(v1[0], v1[1]); w.w = pg8::cvt_pk_bf16(v1[2], v1[3]);
                    *(v4u*)(MRG + r * D + c) = w; } }
    }
};
struct EpiResid {
    static constexpr bool PERM = true, AFTER_DRAIN = false;
    const float* X; bf16* O;
    __device__ __forceinline__ void operator()(const f32x4 (&acc)[2][2][4][2], const Unit& u, int wr, int wc, int fr, int fq) const {
        const int row0 = u.pm * BM + wr * 64 + fr, col0 = u.pn * BM + wc * 32 + 8 * fq;
#pragma unroll
        for (int ai = 0; ai < 2; ++ai)
#pragma unroll
            for (int m = 0; m < 4; ++m) { const size_t off = (size_t)(row0 + ai * HALF + m * 16) * D + col0;
#pragma unroll
                for (int bj = 0; bj < 2; ++bj) { const f32x4 v0 = *(const f32x4*)(X + off + bj * HALF) + acc[ai][bj][m][0], v1 = *(const f32x4*)(X + off + bj * HALF + 4) + acc[ai][bj][m][1];
                    v4u w; w.x = pk2(v0[0], v0[1]); w.y = pk2(v0[2], v0[3]); w.z = pk2(v1[0], v1[1]); w.w = pk2(v1[2], v1[3]);
                    *(v4u*)(O + off + bj * HALF) = w; } }
    }
};
struct MoeOrder : pg8::StaticOrder {
    const LAS int* tile_e; size_t estride;
    __device__ __forceinline__ size_t b_off(const Unit& u, size_t tstep) const { return (size_t)tile_e[u.pm] * estride + (size_t)u.pn * tstep; }
};
struct MoeGatherOrder : MoeOrder {
    static constexpr bool GATHER = true;
    const LAS int* tile_i0; const LAS int* cnt; const int* rlist; LAS unsigned* rowoff; unsigned rowbytes;
    __device__ __forceinline__ size_t a_off(const Unit&, size_t) const { return 0; }
    __device__ __forceinline__ void fill_all() const { const int tid = threadIdx.x, r = tid & 255;
        for (int u0 = tid >> 8; ; u0 += 6) { Unit ua, ub, uc; const bool va = next(u0, ua), vb = next(u0 + 2, ub), vc = next(u0 + 4, uc); if (!va) break;
            int ta = 0, tb = 0, tc = 0;
            { const int e = tile_e[ua.pm], i = tile_i0[ua.pm] + r; if (i < cnt[e]) ta = rlist[e * ECAP + i]; }
            if (vb) { const int e = tile_e[ub.pm], i = tile_i0[ub.pm] + r; if (i < cnt[e]) tb = rlist[e * ECAP + i]; }
            if (vc) { const int e = tile_e[uc.pm], i = tile_i0[uc.pm] + r; if (i < cnt[e]) tc = rlist[e * ECAP + i]; }
            rowoff[u0 * 256 + r] = (unsigned)(ta >> 2) * rowbytes; if (vb) rowoff[(u0 + 2) * 256 + r] = (unsigned)(tb >> 2) * rowbytes; if (vc) rowoff[(u0 + 4) * 256 + r] = (unsigned)(tc >> 2) * rowbytes; } }
    __device__ __forceinline__ unsigned row_off(int ui, int r) const { return rowoff[ui * 256 + r]; }
};
struct EpiSwiGLU {
    static constexpr bool PERM = true, AFTER_DRAIN = false;
    unsigned char* ACT; const float* bgu; const LAS int* tile_e;
    __device__ __forceinline__ void operator()(const f32x4 (&acc)[2][2][4][2], const Unit& u, int wr, int wc, int fr, int fq) const {
        const int row0 = u.pm * BM + wr * 64 + fr, colg = u.pn * 128 + wc * 32 + 8 * fq; const int e = tile_e[u.pm];
        const float* bp = bgu + (size_t)e * 4096 + colg;
        const f32x4 bg0 = *(const f32x4*)(bp), bg1 = *(const f32x4*)(bp + 4), bu0 = *(const f32x4*)(bp + 2048), bu1 = *(const f32x4*)(bp + 2052);
#pragma unroll
        for (int ai = 0; ai < 2; ++ai)
#pragma unroll
            for (int m = 0; m < 4; ++m) { const size_t r = (size_t)(row0 + ai * HALF + m * 16);
                constexpr float DS = 1.f / (F8_SX * F8_SW);
                const f32x4 ga = acc[ai][0][m][0] * DS + bg0, gb = acc[ai][0][m][1] * DS + bg1, ua = acc[ai][1][m][0] * DS + bu0, ub = acc[ai][1][m][1] * DS + bu1;
                float o[8];
#pragma unroll
                for (int j = 0; j < 4; ++j) { const float g = fminf(ga[j], 7.f), up = fminf(fmaxf(ua[j], -7.f), 7.f); o[j] = F8_SA * (up + 1.f) * g * sigm(1.702f * g);
                                              const float g2 = fminf(gb[j], 7.f), up2 = fminf(fmaxf(ub[j], -7.f), 7.f); o[4 + j] = F8_SA * (up2 + 1.f) * g2 * sigm(1.702f * g2); }
                v2u w; w.x = pk4f8(o[0], o[1], o[2], o[3]); w.y = pk4f8(o[4], o[5], o[6], o[7]);
                *(v2u*)(ACT + r * FF + colg) = w; }
    }
};
struct EpiDown {
    static constexpr bool PERM = true, AFTER_DRAIN = false;
    unsigned char* YS; const float* bdn; const LAS int* tile_e; const LAS int* rowdst; const LAS float* rowwt;
    __device__ __forceinline__ void operator()(const f32x4 (&acc)[2][2][4][2], const Unit& u, int wr, int wc, int fr, int fq) const {
        const int e = tile_e[u.pm]; const int col0 = u.pn * BM + wc * 32 + 8 * fq;
        const float* bp = bdn + (size_t)e * D + col0; constexpr float DS = 1.f / (F8_SA * F8_SW);
#pragma unroll
        for (int bj = 0; bj < 2; ++bj) { const f32x4 b0 = *(const f32x4*)(bp + bj * HALF), b1 = *(const f32x4*)(bp + bj * HALF + 4);
#pragma unroll
            for (int ai = 0; ai < 2; ++ai)
#pragma unroll
                for (int m = 0; m < 4; ++m) { const int r = u.ord * 256 + ai * HALF + wr * 64 + m * 16 + fr;
                    const int dst = rowdst[r]; const float w = rowwt[r];
                    const f32x4 v0 = (acc[ai][bj][m][0] * DS + b0) * (w * F8_SY), v1 = (acc[ai][bj][m][1] * DS + b1) * (w * F8_SY);
                    v2u o; o.x = pk4f8(v0[0], v0[1], v0[2], v0[3]); o.y = pk4f8(v1[0], v1[1], v1[2], v1[3]);
                    *(v2u*)(YS + (size_t)dst * D + col0 + bj * HALF) = o; } }
    }
};
template <class Sched> __device__ __forceinline__ void fill_down_tables(Frame& F, const Sched& S, LAS int* rowdst, LAS float* rowwt) {
    const LAS int* MI = (const LAS int*)F.MISC; const int* rlist = (const int*)(F.ws + WS_RLIST); const float* rw = (const float*)(F.ws + WS_RW);
    const int r = F.tid & 255;
    for (int u0 = F.tid >> 8; ; u0 += 4) { Unit ua, ub; const bool va = S.next(u0, ua), vb = S.next(u0 + 2, ub); if (!va) break;
        int da = T * 4, db = T * 4; float wa = 0.f, wb = 0.f;
        { const int e = MI[MI_TILE_E + ua.pm], i = MI[MI_TILE_I0 + ua.pm] + r; if (i < MI[MI_CNT + e]) { da = rlist[e * ECAP + i]; wa = rw[e * ECAP + i]; } }
        if (vb) { const int e = MI[MI_TILE_E + ub.pm], i = MI[MI_TILE_I0 + ub.pm] + r; if (i < MI[MI_CNT + e]) { db = rlist[e * ECAP + i]; wb = rw[e * ECAP + i]; } }
        rowdst[u0 * 256 + r] = da; rowwt[u0 * 256 + r] = wa; if (vb) { rowdst[(u0 + 2) * 256 + r] = db; rowwt[(u0 + 2) * 256 + r] = wb; } }
    __syncthreads();
}

__device__ __forceinline__ void transpose_item(const float* __restrict__ W, int N, int k0, int n0, bf16* WT, int dst_row0, int ldk, LAS float* scr, int lane) {
    const int n = n0 + (lane & 31); const bool ok = n < N;
#pragma unroll 8
    for (int i = 0; i < 32; ++i) { const int kk = 2 * i + (lane >> 5); scr[kk * 33 + (lane & 31)] = ok ? W[(size_t)(k0 + kk) * N + n] : 0.f; }
    LDS_WAIT(); asm volatile("" ::: "memory");
    const int c = lane & 7;
#pragma unroll
    for (int j = 0; j < 4; ++j) { const int nn = (lane >> 3) + 8 * j; const LAS float* s = scr + (8 * c) * 33 + nn;
        v4u o; o.x = pk2(s[0 * 33], s[1 * 33]); o.y = pk2(s[2 * 33], s[3 * 33]); o.z = pk2(s[4 * 33], s[5 * 33]); o.w = pk2(s[6 * 33], s[7 * 33]);
        *(v4u*)(WT + (size_t)(dst_row0 + nn) * ldk + k0 + 8 * c) = o; }
    LDS_WAIT(); asm volatile("" ::: "memory");
}
__device__ __forceinline__ void transpose_item_i8(const float* __restrict__ W, int N, int k0, int n0, unsigned char* WT, int dst_row0, int ldk, const unsigned* colmax, LAS float* scr, int lane) {
    const int n = n0 + (lane & 31); const bool ok = n < N;
#pragma unroll 8
    for (int i = 0; i < 32; ++i) { const int kk = 2 * i + (lane >> 5); scr[kk * 33 + (lane & 31)] = ok ? W[(size_t)(k0 + kk) * N + n] : 0.f; }
    LDS_WAIT(); asm volatile("" ::: "memory");
#pragma unroll
    for (int j = 0; j < 2; ++j) { const int ch = lane + 64 * j, nn = ch >> 2, c = ch & 3; const LAS float* s = scr + (16 * c) * 33 + nn;
        const float cm = __uint_as_float(colmax[n0 + nn]); const float sc = cm > 0.f ? 127.f / cm : 0.f;
        v4u o; o.x = pk4i8(s[0 * 33] * sc, s[1 * 33] * sc, s[2 * 33] * sc, s[3 * 33] * sc); o.y = pk4i8(s[4 * 33] * sc, s[5 * 33] * sc, s[6 * 33] * sc, s[7 * 33] * sc);
        o.z = pk4i8(s[8 * 33] * sc, s[9 * 33] * sc, s[10 * 33] * sc, s[11 * 33] * sc); o.w = pk4i8(s[12 * 33] * sc, s[13 * 33] * sc, s[14 * 33] * sc, s[15 * 33] * sc);
        *(v4u*)(WT + (size_t)(dst_row0 + nn) * ldk + k0 + 16 * c) = o; }
    LDS_WAIT(); asm volatile("" ::: "memory");
}
__device__ __forceinline__ void p0b_win(Frame& F) {
    LAS float* scr = (LAS float*)(F.lds + F.wave * 16384);
    const int gw = F.bid * NWAVES + F.wave, NGW = F.G * NWAVES; unsigned char* WIN8 = F.ws + WS_WIN; const unsigned* colmax = F.ctl + CW_COLMAX;
    constexpr int NB_WIN = (NIN + 31) / 32;
    for (int it = gw; it < 32 * NB_WIN; it += NGW) { const int kb = it / NB_WIN, nb = it % NB_WIN; transpose_item_i8(F.in[I_WIN], NIN, kb * 64, nb * 32, WIN8, nb * 32, D, colmax, scr, F.lane); }
    { const int gt = F.bid * NTHR + F.tid, NGT = F.G * NTHR; constexpr int Z0 = NB_WIN * 32 * D, Z1 = NINP * D;
      for (int i = Z0 + gt * 16; i < Z1; i += NGT * 16) *(v4u*)(WIN8 + i) = (v4u){0u, 0u, 0u, 0u}; }
}
__device__ __forceinline__ void p0_prologue(Frame& F) {
    LAS float* scr = (LAS float*)(F.lds + F.wave * 16384);
    const int gw = F.bid * NWAVES + F.wave, NGW = F.G * NWAVES;
    bf16* WIN_T = (bf16*)(F.ws + WS_WIN); bf16* WA_T = (bf16*)(F.ws + WS_WA); bf16* WB_T = (bf16*)(F.ws + WS_WB); bf16* WO_T = (bf16*)(F.ws + WS_WO);
    bf16* WGU_T = (bf16*)(F.ws + WS_WGU); bf16* WDN_T = (bf16*)(F.ws + WS_WDN); bf16* WL_T = (bf16*)(F.ws + WS_WL); bf16* HN = (bf16*)(F.ws + WS_HN);
    { const float* W = F.in[I_WIN]; unsigned* colmax = F.ctl + CW_COLMAX;
      for (int task = gw; task < 168 * 16; task += NGW) { const int cb = task % 168, kc = task / 168, n = cb * 64 + F.lane; float m = 0.f;
          if (n < NIN) { const float* wp = W + (size_t)(kc * 128) * NIN + n;
#pragma unroll 1
              for (int k0 = 0; k0 < 128; k0 += 32) { float v[32];
#pragma unroll
                  for (int i = 0; i < 32; ++i) v[i] = wp[(size_t)(k0 + i) * NIN];
#pragma unroll
                  for (int i = 0; i < 32; ++i) m = fmaxf(m, fabsf(v[i])); }
              atomicMax(colmax + n, __float_as_uint(m)); } } }
    { const int gt = F.bid * NTHR + F.tid, NGT = F.G * NTHR;
      for (int i = gt; i < 3072 * 512; i += NGT) { const int n = i >> 9, k = i & 511; float v = 0.f;
          if (n < 1024) { if (k < 96) v = F.in[I_WUP][k * RD + n]; }
          else if (n < 2048) { if (k >= 128 && k < 224) v = F.in[I_AUP][(k - 128) * RD + (n - 1024)]; }
          else { if (k >= 256) v = F.in[I_GUP][(k - 256) * RD + (n - 2048)]; }
          WL_T[i] = (bf16)f2bf(v); } }
    { const int gt = F.bid * NTHR + F.tid, NGT = F.G * NTHR; float* RWS = (float*)(F.ws + WS_RWS);
      for (int i = gt; i < D * NE; i += NGT) RWS[i] = F.in[I_N2W][i >> 5] * F.in[I_RTW][i]; }
    const float* x = F.in[I_X]; const float* nw = F.in[I_N1W];
    for (int m = gw; m < T; m += NGW) {
        const f32x4* xr = (const f32x4*)(x + (size_t)m * D) + F.lane; f32x4 v[8]; float s = 0.f;
#pragma unroll
        for (int j = 0; j < 8; ++j) { v[j] = xr[64 * j]; s += (v[j][0] * v[j][0] + v[j][1] * v[j][1]) + (v[j][2] * v[j][2] + v[j][3] * v[j][3]); }
        const float rstd = __builtin_amdgcn_rsqf(wave_sum(s) * (1.f / D) + NORM_EPS);
        float am = 0.f;
#pragma unroll
        for (int j = 0; j < 8; ++j) { const f32x4 w = ((const f32x4*)nw)[F.lane + 64 * j]; v[j] = v[j] * rstd * w; am = fmaxf(fmaxf(am, fmaxf(fabsf(v[j][0]), fabsf(v[j][1]))), fmaxf(fabsf(v[j][2]), fabsf(v[j][3]))); }
        am = wave_max(am); const float sc = am > 0.f ? 127.f / am : 0.f;
        if (F.lane == 0) ((float*)(F.ws + WS_RA))[m] = am * (1.f / 127.f);
        unsigned* o4 = (unsigned*)((unsigned char*)HN + (size_t)m * D) + F.lane;
#pragma unroll
        for (int j = 0; j < 8; ++j) o4[64 * j] = pk4i8(v[j][0] * sc, v[j][1] * sc, v[j][2] * sc, v[j][3] * sc);
    }
}

__device__ __forceinline__ void p2_lora_in(Frame& F) {
    const bf16* __restrict__ P = (const bf16*)(F.ws + WS_P); bf16* __restrict__ LIN = (bf16*)(F.ws + WS_LIN); const float* __restrict__ mu = F.in[I_MU];
    const int gt = F.bid * NTHR + F.tid, NGT = F.G * NTHR;
#pragma unroll 2
    for (int i = gt; i < T * 64; i += NGT) { const int t = i >> 6, g = i & 63; int col = -1, kind = 0;
        if (g < 12) { col = 3072 + 8 * g; kind = 0; } else if (g >= 16 && g < 28) { col = 3168 + 8 * (g - 16); kind = 1; } else if (g >= 32) { col = 3264 + 8 * (g - 32); kind = 2; }
        v4u o = (v4u){0u, 0u, 0u, 0u};
        if (col >= 0) { const v4u pc = *(const v4u*)(P + (size_t)t * NINP + col); v4u pp = (v4u){0u, 0u, 0u, 0u}; if (t & (SEQ - 1)) pp = *(const v4u*)(P + (size_t)(t - 1) * NINP + col);
            const f32x4 m0 = *(const f32x4*)(mu + col), m1 = *(const f32x4*)(mu + col + 4);
            const unsigned pcs[4] = {pc.x, pc.y, pc.z, pc.w}, pps[4] = {pp.x, pp.y, pp.z, pp.w}; float x[8];
#pragma unroll
            for (int k = 0; k < 4; ++k) { const float c0 = __uint_as_float(pcs[k] << 16), c1 = __uint_as_float(pcs[k] & 0xffff0000u), q0 = __uint_as_float(pps[k] << 16), q1 = __uint_as_float(pps[k] & 0xffff0000u);
                const float ma = k < 2 ? m0[2 * k] : m1[2 * k - 4], mb = k < 2 ? m0[2 * k + 1] : m1[2 * k - 3];
                x[2 * k] = c0 + (q0 - c0) * ma; x[2 * k + 1] = c1 + (q1 - c1) * mb; }
#pragma unroll
            for (int k = 0; k < 8; ++k) x[k] = kind == 0 ? tanhf(x[k]) : (kind == 1 ? x[k] : sigm(x[k]));
            o.x = pk2(x[0], x[1]); o.y = pk2(x[2], x[3]); o.z = pk2(x[4], x[5]); o.w = pk2(x[6], x[7]); }
        *(v4u*)(LIN + (size_t)t * 512 + 8 * g) = o; }
    { bf16* __restrict__ QKC = (bf16*)(F.ws + WS_QKC); const float* __restrict__ cw = F.in[I_CONVW];
      for (int i = gt; i < T * 128; i += NGT) { const int t = i >> 7, c0 = 8 * (i & 127); const int sq = t & (SEQ - 1); float acc[8];
#pragma unroll
          for (int k = 0; k < 8; ++k) acc[k] = 0.f;
#pragma unroll
          for (int j = 0; j < 4; ++j) { if (sq - 3 + j >= 0) { const v4u pv = *(const v4u*)(P + (size_t)(t - 3 + j) * NINP + MLO + c0); const f32x4 w0 = *(const f32x4*)(cw + j * 1024 + c0), w1 = *(const f32x4*)(cw + j * 1024 + c0 + 4);
                  acc[0] += __uint_as_float(pv.x << 16) * w0[0]; acc[1] += __uint_as_float(pv.x & 0xffff0000u) * w0[1]; acc[2] += __uint_as_float(pv.y << 16) * w0[2]; acc[3] += __uint_as_float(pv.y & 0xffff0000u) * w0[3];
                  acc[4] += __uint_as_float(pv.z << 16) * w1[0]; acc[5] += __uint_as_float(pv.z & 0xffff0000u) * w1[1]; acc[6] += __uint_as_float(pv.w << 16) * w1[2]; acc[7] += __uint_as_float(pv.w & 0xffff0000u) * w1[3]; } }
          const float sc = c0 < 512 ? 0.08838834764831845f : 1.f;
#pragma unroll
          for (int k = 0; k < 8; ++k) acc[k] = acc[k] * sigm(acc[k]) * sc;
          v4u o; o.x = pk2(acc[0], acc[1]); o.y = pk2(acc[2], acc[3]); o.z = pk2(acc[4], acc[5]); o.w = pk2(acc[6], acc[7]); *(v4u*)(QKC + (size_t)t * 1024 + c0) = o; } }
    { float* __restrict__ GLF = (float*)(F.ws + WS_GLF); const int gw = F.bid * NWAVES + F.wave, NGW = F.G * NWAVES, lane = F.lane;
      for (int q = gw; q < (T / 64) * 4; q += NGW) { const int chk = q >> 2, mh = q & 3; const size_t t = (size_t)chk * 64 + lane; const bf16* pr = P + t * NINP + MLO + 2048;
          const float ip = 15.f * tanhf((bf2f(pr[mh]) + F.in[I_IB][mh]) * (1.f / 15.f)), fp = 15.f * tanhf((bf2f(pr[4 + mh]) + F.in[I_FB][mh]) * (1.f / 15.f));
          float bc = fminf(fp, 0.f) - log1pf(__expf(-fabsf(fp)));
#pragma unroll
          for (int o = 1; o < 64; o <<= 1) { const float t_ = __shfl_up(bc, o); if (lane >= o) bc += t_; }
          const float u = ip - bc; float pm = u;
#pragma unroll
          for (int o = 1; o < 64; o <<= 1) { const float t_ = __shfl_up(pm, o); if (lane >= o) pm = fmaxf(pm, t_); }
          *(f32x4*)(GLF + t * 16 + 4 * mh) = (f32x4){bc, u, pm, 0.f}; } }
}

typedef short s16x8 __attribute__((ext_vector_type(8)));
typedef short s16x4 __attribute__((ext_vector_type(4)));
__device__ __forceinline__ unsigned long long pack4bf(f32x4 v) { return (unsigned long long)pk2(v[0], v[1]) | ((unsigned long long)pk2(v[2], v[3]) << 32); }
__device__ __forceinline__ s16x8 tr_frag(const LAS bf16* img, int stride, int r0, int c0, int fr) {
    const LAS bf16* p0 = img + (r0 + (fr >> 2)) * stride + c0 + 4 * (fr & 3);
    const s16x4 lo = __builtin_bit_cast(s16x4, __builtin_amdgcn_ds_read_tr16_b64_v4i16((LAS s16x4*)p0));
    const s16x4 hi = __builtin_bit_cast(s16x4, __builtin_amdgcn_ds_read_tr16_b64_v4i16((LAS s16x4*)(p0 + 4 * stride)));
    return __builtin_shufflevector(lo, hi, 0, 1, 2, 3, 4, 5, 6, 7);
}

__device__ __forceinline__ void rw_bar(LAS unsigned* cnt, unsigned& target, int lane);
__device__ __forceinline__ void rwkv_chunk_unit(Frame& F, int unit, LAS unsigned char* regB, LAS unsigned* bcnt, unsigned& btarget) {
    const int b = unit >> 5, h = (unit >> 1) & 15, half = unit & 1;
    const bf16* P = (const bf16*)(F.ws + WS_P); const float* WAG = (const float*)(F.ws + WS_WAG); const bf16* AGp = (const bf16*)(F.ws + WS_WAG + 64 * MiB); float* YRAW = (float*)(F.ws + WS_YRAW);
    constexpr int KS = 72, LS = 40;
    LAS bf16* At = (LAS bf16*)F.lds; LAS bf16* Bt = At + 32 * KS; LAS bf16* Kt = Bt + 32 * KS; LAS bf16* Rt = Kt + 32 * KS;
    LAS bf16* Vv = Rt + 32 * KS;
    LAS bf16* Sb = Vv + 32 * LS;
    LAS bf16* G2b = Sb + 32 * KS; LAS bf16* G3b = G2b + 32 * LS; LAS bf16* G4b = G3b + 32 * LS;
    LAS bf16* Pwb = G4b + 32 * LS;
    LAS bf16* Acb = Pwb + 2 * 32 * LS;
    LAS bf16* RHt = (LAS bf16*)regB;
    LAS bf16* Ubt = RHt + 32 * LS;
    LAS float* lwf = (LAS float*)(Ubt + 32 * LS);
    LAS float* csf = lwf + 2048;
    LAS float* gtf = csf + 2048;
    LAS float* glf = gtf + 256;
    const int tid = F.tid, lane = F.lane, w = F.wave, fr = lane & 15, fq = lane >> 4;
    const int ts = tid >> 4, cs = tid & 15, c0 = h * 64 + 4 * cs;
    const int sk = tid & 63, sq = tid >> 6;
    const f32x4 mu_r = *(const f32x4*)(F.in[I_MU] + c0), mu_k = *(const f32x4*)(F.in[I_MU] + 1024 + c0), mu_v = *(const f32x4*)(F.in[I_MU] + 2048 + c0);
    const f32x4 kkc = *(const f32x4*)(F.in[I_KK] + c0), kac = *(const f32x4*)(F.in[I_KA] + c0), rkc = *(const f32x4*)(F.in[I_RK] + c0);
    bf16* BON = (bf16*)(F.ws + WS_WAG + 128 * MiB);
    for (int i = tid; i < 32 * KS; i += 256) Sb[i] = 0;
    v2u cr[2], ck[2], cv[2], qr[2], qk[2], qv[2]; f32x4 w4[2], a4[2];
#define RC_LOAD(ch) do { _Pragma("unroll") for (int p_ = 0; p_ < 2; ++p_) { const int t_ = (ch) * 32 + ts + 16 * p_; const size_t tk_ = (size_t)b * SEQ + t_; const bf16* pr_ = P + tk_ * NINP + c0; \
        cr[p_] = *(const v2u*)(pr_); ck[p_] = *(const v2u*)(pr_ + 1024); cv[p_] = *(const v2u*)(pr_ + 2048); \
        if (t_ > 0) { qr[p_] = *(const v2u*)(pr_ - NINP); qk[p_] = *(const v2u*)(pr_ - NINP + 1024); qv[p_] = *(const v2u*)(pr_ - NINP + 2048); } else { qr[p_] = (v2u){0u, 0u}; qk[p_] = qr[p_]; qv[p_] = qr[p_]; } \
        w4[p_] = *(const f32x4*)(WAG + tk_ * RD + c0); { const v2u ab_ = *(const v2u*)(AGp + tk_ * D + c0); a4[p_] = UNP4(ab_); } } } while (0)
    const int mi = w >> 1, nj = w & 1;
    f32x4 st[2]; st[0] = (f32x4){0.f, 0.f, 0.f, 0.f}; st[1] = st[0];
    RC_LOAD(0);
    rw_bar(bcnt, btarget, lane);
    for (int ch = 0; ch < SEQ / 32; ++ch) {
        f32x4 rr[2], kmod[2], vv[2], kkn[2], lw[2], al[2];
#pragma unroll
        for (int p_ = 0; p_ < 2; ++p_) { const f32x4 pr4 = UNP4(cr[p_]), pk4 = UNP4(ck[p_]), pv4 = UNP4(cv[p_]), qr4 = UNP4(qr[p_]), qk4 = UNP4(qk[p_]), qv4 = UNP4(qv[p_]); lw[p_] = w4[p_]; al[p_] = a4[p_];
            rr[p_] = pr4 + (qr4 - pr4) * mu_r; const f32x4 k1 = pk4 + (qk4 - pk4) * mu_k; vv[p_] = pv4 + (qv4 - pv4) * mu_v;
            const f32x4 kkr = k1 * kkc; const float nrm = __builtin_amdgcn_rsqf(fmaxf(allreduce16((kkr[0] * kkr[0] + kkr[1] * kkr[1]) + (kkr[2] * kkr[2] + kkr[3] * kkr[3])), 1e-24f));
            kkn[p_] = kkr * nrm; kmod[p_] = k1 * (1.f + (al[p_] - 1.f) * kac);
            { const f32x4 rk_ = rr[p_] * kmod[p_] * rkc; const float dot = allreduce16((rk_[0] + rk_[1]) + (rk_[2] + rk_[3]));
              if ((cs >> 3) == half) *(unsigned long long*)(BON + ((size_t)b * SEQ + ch * 32 + ts + 16 * p_) * RD + c0) = pack4bf(vv[p_] * dot); }
            *(LAS f32x4*)(lwf + (ts + 16 * p_) * 64 + 4 * cs) = lw[p_]; }
        if (ch + 1 < SEQ / 32) RC_LOAD(ch + 1);
        rw_bar(bcnt, btarget, lane);
        float cc[8];
#pragma unroll
        for (int i = 0; i < 8; ++i) cc[i] = lwf[(8 * sq + i) * 64 + sk] + (i ? cc[i - 1] : 0.f);
        gtf[sq * 64 + sk] = cc[7];
        rw_bar(bcnt, btarget, lane);
        { float off = 0.f;
#pragma unroll
          for (int q = 0; q < 3; ++q) off += (q < sq) ? gtf[q * 64 + sk] : 0.f;
#pragma unroll
          for (int i = 0; i < 8; ++i) csf[(8 * sq + i) * 64 + sk] = off + cc[i]; }
        rw_bar(bcnt, btarget, lane);
#pragma unroll
        for (int p_ = 0; p_ < 2; ++p_) { const int t = ts + 16 * p_; const f32x4 cg = *(const LAS f32x4*)(csf + t * 64 + 4 * cs); f32x4 g, gp, gi;
#pragma unroll
          for (int j = 0; j < 4; ++j) { g[j] = __expf(cg[j]); gp[j] = __expf(cg[j] - lw[p_][j]); gi[j] = __expf(-cg[j]); }
          *(LAS unsigned long long*)(At + t * KS + 4 * cs) = pack4bf(-(kkn[p_] * gp)); *(LAS unsigned long long*)(Bt + t * KS + 4 * cs) = pack4bf(kkn[p_] * al[p_] * gi);
          *(LAS unsigned long long*)(Kt + t * KS + 4 * cs) = pack4bf(kmod[p_] * gi); *(LAS unsigned long long*)(Rt + t * KS + 4 * cs) = pack4bf(rr[p_] * g);
          if ((cs >> 3) == half) *(LAS unsigned long long*)(Vv + t * LS + 4 * (cs & 7)) = pack4bf(vv[p_]);
          if (t == 31) *(LAS f32x4*)(glf + 4 * cs) = g; }
        rw_bar(bcnt, btarget, lane);
        f32x4 accT, pwT;
        { const int t = 16 * mi + fr, jb = 16 * nj + 4 * fq;
          f32x4 g1 = (f32x4){0.f, 0.f, 0.f, 0.f}, g2 = g1, g3 = g1, g4 = g1;
#pragma unroll
          for (int ks = 0; ks < 2; ++ks) { const s16x8 bj = *(const LAS s16x8*)(Bt + (16 * nj + fr) * KS + 32 * ks + 8 * fq), kj = *(const LAS s16x8*)(Kt + (16 * nj + fr) * KS + 32 * ks + 8 * fq);
              const s16x8 at = *(const LAS s16x8*)(At + (16 * mi + fr) * KS + 32 * ks + 8 * fq), rt = *(const LAS s16x8*)(Rt + (16 * mi + fr) * KS + 32 * ks + 8 * fq);
              g1 = __builtin_amdgcn_mfma_f32_16x16x32_bf16(bj, at, g1, 0, 0, 0); g2 = __builtin_amdgcn_mfma_f32_16x16x32_bf16(kj, at, g2, 0, 0, 0);
              g3 = __builtin_amdgcn_mfma_f32_16x16x32_bf16(bj, rt, g3, 0, 0, 0); g4 = __builtin_amdgcn_mfma_f32_16x16x32_bf16(kj, rt, g4, 0, 0, 0); }
#pragma unroll
          for (int rg_ = 0; rg_ < 4; ++rg_) { const int j = jb + rg_; g1[rg_] = (j < t) ? g1[rg_] : 0.f; g2[rg_] = (j < t) ? g2[rg_] : 0.f; g3[rg_] = (j <= t) ? g3[rg_] : 0.f; g4[rg_] = (j <= t) ? g4[rg_] : 0.f; }
          pwT = g1; *(LAS unsigned long long*)(Pwb + t * LS + jb) = pack4bf(g1);
#pragma unroll
          for (int rg_ = 0; rg_ < 4; ++rg_) accT[rg_] = g1[rg_] + ((jb + rg_ == t) ? 1.f : 0.f);
          *(LAS unsigned long long*)(Acb + 32 * LS + t * LS + jb) = pack4bf(accT);
          *(LAS unsigned long long*)(G2b + t * LS + jb) = pack4bf(g2); *(LAS unsigned long long*)(G3b + t * LS + jb) = pack4bf(g3); *(LAS unsigned long long*)(G4b + t * LS + jb) = pack4bf(g4); }
        rw_bar(bcnt, btarget, lane);
        f32x4 yv = (f32x4){0.f, 0.f, 0.f, 0.f};
#pragma unroll
        for (int s = 0; s < 5; ++s) { const LAS bf16* Pr = Pwb + (s & 1) * 32 * LS; LAS bf16* Pn = Pwb + ((s + 1) & 1) * 32 * LS; const LAS bf16* Ar = Acb + (s & 1) * 32 * LS; LAS bf16* An = Acb + ((s + 1) & 1) * 32 * LS;
            const s16x8 xrow = *(const LAS s16x8*)(Pr + (16 * mi + fr) * LS + 8 * fq);
            if (s < 4) { f32x4 z = (f32x4){0.f, 0.f, 0.f, 0.f}; z = __builtin_amdgcn_mfma_f32_16x16x32_bf16(tr_frag(Pr, LS, 8 * fq, 16 * nj, fr), xrow, z, 0, 0, 0);
                         *(LAS unsigned long long*)(Pn + (16 * mi + fr) * LS + 16 * nj + 4 * fq) = pack4bf(z); }
            if (s >= 1) { accT = __builtin_amdgcn_mfma_f32_16x16x32_bf16(tr_frag(Ar, LS, 8 * fq, 16 * nj, fr), xrow, accT, 0, 0, 0);
                          *(LAS unsigned long long*)(An + (16 * mi + fr) * LS + 16 * nj + 4 * fq) = pack4bf(accT); }
            if (s == 0) {
                f32x4 z = (f32x4){0.f, 0.f, 0.f, 0.f};
#pragma unroll
                for (int ks = 0; ks < 2; ++ks) { const s16x8 sb = *(const LAS s16x8*)(Sb + (16 * nj + fr) * KS + 32 * ks + 8 * fq);
                    z = __builtin_amdgcn_mfma_f32_16x16x32_bf16(*(const LAS s16x8*)(At + (16 * mi + fr) * KS + 32 * ks + 8 * fq), sb, z, 0, 0, 0);
                    yv = __builtin_amdgcn_mfma_f32_16x16x32_bf16(*(const LAS s16x8*)(Rt + (16 * mi + fr) * KS + 32 * ks + 8 * fq), sb, yv, 0, 0, 0); }
                const s16x8 vt_ = tr_frag(Vv, LS, 8 * fq, 16 * nj, fr);
                z = __builtin_amdgcn_mfma_f32_16x16x32_bf16(*(const LAS s16x8*)(G2b + (16 * mi + fr) * LS + 8 * fq), vt_, z, 0, 0, 0);
                yv = __builtin_amdgcn_mfma_f32_16x16x32_bf16(*(const LAS s16x8*)(G4b + (16 * mi + fr) * LS + 8 * fq), vt_, yv, 0, 0, 0);
                *(LAS unsigned long long*)(RHt + (16 * nj + fr) * LS + 16 * mi + 4 * fq) = pack4bf(z); }
            rw_bar(bcnt, btarget, lane); }
        { f32x4 z = (f32x4){0.f, 0.f, 0.f, 0.f};
          z = __builtin_amdgcn_mfma_f32_16x16x32_bf16(*(const LAS s16x8*)(Acb + 32 * LS + (16 * mi + fr) * LS + 8 * fq), *(const LAS s16x8*)(RHt + (16 * nj + fr) * LS + 8 * fq), z, 0, 0, 0);
          *(LAS unsigned long long*)(Ubt + (16 * nj + fr) * LS + 16 * mi + 4 * fq) = pack4bf(z); }
        rw_bar(bcnt, btarget, lane);
        { yv = __builtin_amdgcn_mfma_f32_16x16x32_bf16(*(const LAS s16x8*)(G3b + (16 * mi + fr) * LS + 8 * fq), *(const LAS s16x8*)(Ubt + (16 * nj + fr) * LS + 8 * fq), yv, 0, 0, 0);
          float* yp = YRAW + ((size_t)b * SEQ + ch * 32 + 16 * mi + 4 * fq) * RD + h * 64 + half * 32 + 16 * nj + fr;
#pragma unroll
          for (int rg_ = 0; rg_ < 4; ++rg_) yp[(size_t)rg_ * RD] = yv[rg_]; }
        { const int kt = w; const s16x8 bt_ = tr_frag(Bt, KS, 8 * fq, 16 * kt, fr), kt_ = tr_frag(Kt, KS, 8 * fq, 16 * kt, fr); const f32x4 gl4 = *(const LAS f32x4*)(glf + 16 * kt + 4 * fq);
#pragma unroll
          for (int vt = 0; vt < 2; ++vt) {
              st[vt] = __builtin_amdgcn_mfma_f32_16x16x32_bf16(bt_, *(const LAS s16x8*)(Ubt + (16 * vt + fr) * LS + 8 * fq), st[vt], 0, 0, 0);
              st[vt] = __builtin_amdgcn_mfma_f32_16x16x32_bf16(kt_, tr_frag(Vv, LS, 8 * fq, 16 * vt, fr), st[vt], 0, 0, 0);
              st[vt] = st[vt] * gl4;
              *(LAS unsigned long long*)(Sb + (16 * vt + fr) * KS + 16 * kt + 4 * fq) = pack4bf(st[vt]); } }
        rw_bar(bcnt, btarget, lane);
    }
#undef RC_LOAD
}

__device__ __forceinline__ float allreduce8(float x) { x += dppf<0x141>(x); x += dppf<0xB1>(x); x += dppf<0x4E>(x); return x; }
__device__ __forceinline__ void rw_bar(LAS unsigned* cnt, unsigned& target, int lane) {
    asm volatile("s_waitcnt lgkmcnt(0)" ::: "memory");
    if (lane == 0) __hip_atomic_fetch_add(cnt, 1u, __ATOMIC_RELAXED, __HIP_MEMORY_SCOPE_WORKGROUP);
    target += 4u;
    while ((unsigned)__builtin_amdgcn_readfirstlane((int)__hip_atomic_load(cnt, __ATOMIC_RELAXED, __HIP_MEMORY_SCOPE_WORKGROUP)) < target) __builtin_amdgcn_s_sleep(1);
    asm volatile("" ::: "memory");
}
constexpr int CV_BR = 8 * 32, CV_WO = 16 * 32, CV_GU = NE * 16 * 64, CV_DN = NE * 16 * 32, CV_ITEMS = 2 * CV_BR + CV_WO + CV_GU + CV_DN;
struct CvItem { const float* src; unsigned char* dst; int N; int f8; };
__device__ __forceinline__ CvItem cv_decode(Frame& F, int it) {
    CvItem c; int r = it; const int lane = F.lane;
    if (r < CV_BR) { const int kb = r >> 5, nb = r & 31; c.src = F.in[I_WBA] + (size_t)(kb * 128) * D + nb * 64 + lane; c.dst = F.ws + WS_WA + ((size_t)(nb * 64 + lane) * RD + kb * 128) * 2; c.N = D; c.f8 = 0; return c; } r -= CV_BR;
    if (r < CV_BR) { const int kb = r >> 5, nb = r & 31; c.src = F.in[I_WBB] + (size_t)(kb * 128) * D + nb * 64 + lane; c.dst = F.ws + WS_WB + ((size_t)(nb * 64 + lane) * RD + kb * 128) * 2; c.N = D; c.f8 = 0; return c; } r -= CV_BR;
    if (r < CV_WO) { const int kb = r >> 5, nb = r & 31; c.src = F.in[I_WOUT] + (size_t)(kb * 128) * D + nb * 64 + lane; c.dst = F.ws + WS_WO + ((size_t)(nb * 64 + lane) * D + kb * 128) * 2; c.N = D; c.f8 = 0; return c; } r -= CV_WO;
    if (r < CV_GU) { const int e = r >> 10, q = r & 1023, kb = q >> 6, nb = q & 63, n0 = nb * 64;
        const int dr = n0 < FF ? ((n0 >> 7) * 256 + (n0 & 127)) : (((n0 - FF) >> 7) * 256 + 128 + ((n0 - FF) & 127));
        c.src = F.in[I_WGU] + (size_t)e * D * 2 * FF + (size_t)(kb * 128) * (2 * FF) + n0 + lane; c.dst = F.ws + WS_WGU + (size_t)e * 2 * FF * D + (size_t)(dr + lane) * D + kb * 128; c.N = 2 * FF; c.f8 = 1; return c; } r -= CV_GU;
    { const int e = r >> 9, q = r & 511, kb = q >> 5, nb = q & 31;
        c.src = F.in[I_WDN] + (size_t)e * FF * D + (size_t)(kb * 128) * D + nb * 64 + lane; c.dst = F.ws + WS_WDN + (size_t)e * D * FF + (size_t)(nb * 64 + lane) * FF + kb * 128; c.N = D; c.f8 = 1; }
    return c;
}
__device__ __forceinline__ void convert_item(Frame& F, int it);
__device__ __forceinline__ void convert_loop(Frame& F, unsigned* next, unsigned* p1done, unsigned ngemm) {
    for (;;) { unsigned b = 0xffffffffu;
        if (F.lane == 0) { if (!(p1done && __hip_atomic_load(p1done, __ATOMIC_RELAXED, __HIP_MEMORY_SCOPE_AGENT) >= ngemm)) b = __hip_atomic_fetch_add(next, 2u, __ATOMIC_RELAXED, __HIP_MEMORY_SCOPE_AGENT); }
        const unsigned base = (unsigned)__builtin_amdgcn_readfirstlane((int)b); if (base >= (unsigned)CV_ITEMS) break;
        for (int k = 0; k < 2; ++k) { const int it = (int)base + k; if (it < CV_ITEMS) convert_item(F, it); } }
}
__device__ __forceinline__ void convert_item(Frame& F, int i0) {
    { const CvItem c = cv_decode(F, i0);
        float x[128];
#pragma unroll
        for (int i = 0; i < 128; ++i) x[i] = c.src[(size_t)i * c.N];
        if (c.f8) {
#pragma unroll
            for (int q = 0; q < 8; ++q) { v4u o; o.x = pk4f8(x[16 * q + 0] * F8_SW, x[16 * q + 1] * F8_SW, x[16 * q + 2] * F8_SW, x[16 * q + 3] * F8_SW); o.y = pk4f8(x[16 * q + 4] * F8_SW, x[16 * q + 5] * F8_SW, x[16 * q + 6] * F8_SW, x[16 * q + 7] * F8_SW);
                o.z = pk4f8(x[16 * q + 8] * F8_SW, x[16 * q + 9] * F8_SW, x[16 * q + 10] * F8_SW, x[16 * q + 11] * F8_SW); o.w = pk4f8(x[16 * q + 12] * F8_SW, x[16 * q + 13] * F8_SW, x[16 * q + 14] * F8_SW, x[16 * q + 15] * F8_SW);
                *(v4u*)(c.dst + 16 * q) = o; } }
        else {
#pragma unroll
            for (int q = 0; q < 16; ++q) { v4u o; o.x = pk2(x[8 * q + 0], x[8 * q + 1]); o.y = pk2(x[8 * q + 2], x[8 * q + 3]); o.z = pk2(x[8 * q + 4], x[8 * q + 5]); o.w = pk2(x[8 * q + 6], x[8 * q + 7]);
                *(v4u*)(c.dst + 16 * q) = o; } } }
}

__device__ __forceinline__ void mlstm_scan_unit(Frame& F, int unit, LAS unsigned* bcnt, unsigned& btarget) {
    const int b = unit >> 5, mh = (unit >> 3) & 3, sl = unit & 7;
    const bf16* P = (const bf16*)(F.ws + WS_P); const bf16* QKC = (const bf16*)(F.ws + WS_QKC); const float* GLF = (const float*)(F.ws + WS_GLF); float* HRAW = (float*)(F.ws + WS_HRAW);
    constexpr int VS = 56;
    LAS bf16* Lq = (LAS bf16*)F.lds;
    LAS bf16* Lk = Lq + 64 * 136;
    LAS bf16* Lv = Lk + 64 * 136;
    LAS bf16* Lvs = Lv + 64 * VS;
    LAS bf16* LcT = Lvs + 64 * VS;
    LAS bf16* Ls = LcT + 2 * 48 * 136;
    LAS float* sb = (LAS float*)(Ls + 64 * 72); LAS float* su = sb + 64; LAS float* smx = su + 64; LAS float* swk = smx + 64;
    const int tid = F.tid, lane = F.lane, w = F.wave, fr = lane & 15, fq = lane >> 4;
    for (int i = tid; i < 2 * 48 * 136; i += 256) LcT[i] = 0;
    for (int i = tid; i < 64 * 16; i += 256) { const int j = i >> 4, c = 32 + (i & 15); Lv[j * VS + c] = (c == 32) ? (bf16)0x3F80 : (bf16)0; Lvs[j * VS + c] = 0; }
    const int pr0 = tid >> 4, pc = 8 * (tid & 15);
    v4u rq[4], rk[4], rv; f32x4 g3;
#define ML_LOAD(ch) do { const size_t tk0_ = (size_t)b * SEQ + (ch) * 64; \
        _Pragma("unroll") for (int i_ = 0; i_ < 4; ++i_) { const bf16* s_ = QKC + (tk0_ + pr0 + 16 * i_) * 1024 + mh * 128 + pc; rq[i_] = *(const v4u*)s_; rk[i_] = *(const v4u*)(s_ + 512); } \
        rv = *(const v4u*)(P + (tk0_ + (tid >> 2)) * NINP + MLO + 1024 + mh * 256 + sl * 32 + 8 * (tid & 3)); \
        g3 = *(const f32x4*)(GLF + (tk0_ + lane) * 16 + 4 * mh); } while (0)
    f32x4 st[2][3];
#pragma unroll
    for (int a = 0; a < 2; ++a)
#pragma unroll
        for (int n = 0; n < 3; ++n) st[a][n] = (f32x4){0.f, 0.f, 0.f, 0.f};
    float mstate = 0.f;
    ML_LOAD(0);
    rw_bar(bcnt, btarget, lane);
    for (int ch = 0; ch < SEQ / 64; ++ch) {
        const size_t tk0 = (size_t)b * SEQ + ch * 64;
        LAS bf16* cTc = LcT + (ch & 1) * 48 * 136; LAS bf16* cTn = LcT + ((ch + 1) & 1) * 48 * 136;
        float mnew, dec;
        { const float bc = g3[0], u = g3[1], pm = g3[2];
          const float gtot = __shfl(bc, 63), pmall = __shfl(pm, 63);
          mnew = gtot + fmaxf(mstate, pmall); dec = __expf(gtot + mstate - mnew);
          const float wk = __expf(u + gtot - mnew);
          sb[lane] = bc; su[lane] = u; smx[lane] = fmaxf(mstate, pm); swk[lane] = wk;
          if (w == 0) Lvs[lane * VS + 32] = (bf16)f2bf(wk); }
#pragma unroll
        for (int i = 0; i < 4; ++i) { *(LAS v4u*)(Lq + (pr0 + 16 * i) * 136 + pc) = rq[i]; *(LAS v4u*)(Lk + (pr0 + 16 * i) * 136 + pc) = rk[i]; }
        LDS_WAIT();
        { const int j = tid >> 2, d0 = 8 * (tid & 3); const float wkj = swk[j]; *(LAS v4u*)(Lv + j * VS + d0) = rv;
          const unsigned uu[4] = {rv.x, rv.y, rv.z, rv.w}; v4u sv;
          sv.x = pk2(wkj * __uint_as_float(uu[0] << 16), wkj * __uint_as_float(uu[0] & 0xffff0000u)); sv.y = pk2(wkj * __uint_as_float(uu[1] << 16), wkj * __uint_as_float(uu[1] & 0xffff0000u));
          sv.z = pk2(wkj * __uint_as_float(uu[2] << 16), wkj * __uint_as_float(uu[2] & 0xffff0000u)); sv.w = pk2(wkj * __uint_as_float(uu[3] << 16), wkj * __uint_as_float(uu[3] & 0xffff0000u));
          *(LAS v4u*)(Lvs + j * VS + d0) = sv; }
        if (ch + 1 < SEQ / 64) ML_LOAD(ch + 1);
        rw_bar(bcnt, btarget, lane);
        { const int tt = w; const int t = 16 * tt + fr; const float mxt = smx[t];
#pragma unroll
          for (int jt = 0; jt < 4; ++jt) { f32x4 acc = (f32x4){0.f, 0.f, 0.f, 0.f};
              if (jt <= tt) {
#pragma unroll
                  for (int ks = 0; ks < 4; ++ks) { const s16x8 a = *(const LAS s16x8*)(Lk + (16 * jt + fr) * 136 + 32 * ks + 8 * fq), bq = *(const LAS s16x8*)(Lq + (16 * tt + fr) * 136 + 32 * ks + 8 * fq);
                      acc = __builtin_amdgcn_mfma_f32_16x16x32_bf16(a, bq, acc, 0, 0, 0); }
                  const f32x4 u4 = *(const LAS f32x4*)(su + 16 * jt + 4 * fq);
#pragma unroll
                  for (int rg_ = 0; rg_ < 4; ++rg_) { const int j = 16 * jt + 4 * fq + rg_; acc[rg_] = (j <= t) ? acc[rg_] * __expf(u4[rg_] - mxt) : 0.f; } }
              *(LAS unsigned long long*)(Ls + t * 72 + 16 * jt + 4 * fq) = pack4bf(acc); } }
        rw_bar(bcnt, btarget, lane);
        { const int mi = w; f32x4 a1[3], a2[3];
#pragma unroll
          for (int n = 0; n < 3; ++n) { a1[n] = (f32x4){0.f, 0.f, 0.f, 0.f}; a2[n] = a1[n]; }
#pragma unroll
          for (int ks = 0; ks < 2; ++ks) { const s16x8 A = *(const LAS s16x8*)(Ls + (16 * mi + fr) * 72 + 32 * ks + 8 * fq);
#pragma unroll
              for (int n = 0; n < 3; ++n) a1[n] = __builtin_amdgcn_mfma_f32_16x16x32_bf16(A, tr_frag(Lv, VS, 32 * ks + 8 * fq, 16 * n, fr), a1[n], 0, 0, 0); }
#pragma unroll
          for (int ks = 0; ks < 4; ++ks) { const s16x8 A = *(const LAS s16x8*)(Lq + (16 * mi + fr) * 136 + 32 * ks + 8 * fq);
#pragma unroll
              for (int n = 0; n < 3; ++n) a2[n] = __builtin_amdgcn_mfma_f32_16x16x32_bf16(A, *(const LAS s16x8*)(cTc + (16 * n + fr) * 136 + 32 * ks + 8 * fq), a2[n], 0, 0, 0); }
          const f32x4 mx4 = *(const LAS f32x4*)(smx + 16 * mi + 4 * fq), b4 = *(const LAS f32x4*)(sb + 16 * mi + 4 * fq);
#pragma unroll
          for (int rg_ = 0; rg_ < 4; ++rg_) { const float wi = __expf(mstate - mx4[rg_]); float den = a1[2][rg_] + wi * a2[2][rg_]; den = __shfl(den, lane & 48);
              const float mt = b4[rg_] + mx4[rg_]; const float inv = __builtin_amdgcn_rcpf(fmaxf(fabsf(den), __expf(-mt))); float* hp = HRAW + (tk0 + 16 * mi + 4 * fq + rg_) * RD + mh * 256 + sl * 32 + fr;
              hp[0] = (a1[0][rg_] + wi * a2[0][rg_]) * inv; hp[16] = (a1[1][rg_] + wi * a2[1][rg_]) * inv; } }
        {
#pragma unroll
          for (int a = 0; a < 2; ++a) {
#pragma unroll
              for (int n = 0; n < 3; ++n) st[a][n] = st[a][n] * dec;
#pragma unroll
              for (int ks = 0; ks < 2; ++ks) { const s16x8 A = tr_frag(Lk, 136, 32 * ks + 8 * fq, 16 * (2 * w + a), fr);
#pragma unroll
                  for (int n = 0; n < 3; ++n) st[a][n] = __builtin_amdgcn_mfma_f32_16x16x32_bf16(A, tr_frag(Lvs, VS, 32 * ks + 8 * fq, 16 * n, fr), st[a][n], 0, 0, 0); }
#pragma unroll
              for (int n = 0; n < 3; ++n) *(LAS unsigned long long*)(cTn + (16 * n + fr) * 136 + 16 * (2 * w + a) + 4 * fq) = pack4bf(st[a][n]); } }
        mstate = mnew;
        rw_bar(bcnt, btarget, lane);
    }
#undef ML_LOAD
}

__device__ __forceinline__ float rowsum4(f32x4 v) { return (v[0] + v[1]) + (v[2] + v[3]); }
__device__ __forceinline__ void p5_finalize(Frame& F) {
    const bf16* __restrict__ P = (const bf16*)(F.ws + WS_P); const bf16* __restrict__ AGp = (const bf16*)(F.ws + WS_WAG + 64 * MiB); const float* __restrict__ YRAW = (const float*)(F.ws + WS_YRAW); const float* __restrict__ HRAW = (const float*)(F.ws + WS_HRAW);
    bf16* __restrict__ OA = (bf16*)(F.ws + WS_OA); bf16* __restrict__ OB = (bf16*)(F.ws + WS_OB);
    const int gw = F.bid * NWAVES + F.wave, NGW = F.G * NWAVES, lane = F.lane;
    { const int hq = gw & 3, c0 = (hq * 4 + (lane >> 4)) * 64 + 4 * (lane & 15);
      const f32x4 lnw = *(const f32x4*)(F.in[I_LNW] + c0), lnb = *(const f32x4*)(F.in[I_LNB] + c0); const bf16* __restrict__ BON = (const bf16*)(F.ws + WS_WAG + 128 * MiB);
      v2u bo, gb; f32x4 y4;
#define P5_LOAD(q_) do { const int tk_ = (q_) >> 2; bo = *(const v2u*)(BON + (size_t)tk_ * RD + c0); gb = *(const v2u*)(AGp + (size_t)tk_ * D + RD + c0); y4 = *(const f32x4*)(YRAW + (size_t)tk_ * RD + c0); } while (0)
      if (gw < T * 4) P5_LOAD(gw);
      for (int q = gw; q < T * 4; q += NGW) { const int tk = q >> 2; const f32x4 bon = UNP4(bo), g = UNP4(gb), y = y4;
          if (q + NGW < T * 4) P5_LOAD(q + NGW);
          const float mean = allreduce16(rowsum4(y)) * (1.f / 64.f); const f32x4 dl = y - mean;
          const float var = allreduce16(rowsum4(dl * dl)) * (1.f / 64.f); const float rs = __builtin_amdgcn_rsqf(var + GN_EPS);
          const f32x4 o = (dl * rs * lnw + lnb + bon) * g;
          v2u ov; ov.x = pk2(o[0], o[1]); ov.y = pk2(o[2], o[3]); *(v2u*)(OA + (size_t)tk * RD + c0) = ov; }
#undef P5_LOAD
    }
    { const int mh = gw & 3, d0 = mh * 256 + 4 * lane; const f32x4 nw = *(const f32x4*)(F.in[I_MNW] + d0);
      f32x4 hv; v2u po;
#define P5B_LOAD(q_) do { const int tk_ = (q_) >> 2; hv = *(const f32x4*)(HRAW + (size_t)tk_ * RD + d0); po = *(const v2u*)(P + (size_t)tk_ * NINP + MLO + 2056 + d0); } while (0)
      if (gw < T * 4) P5B_LOAD(gw);
      for (int q = gw; q < T * 4; q += NGW) { const int tk = q >> 2; const f32x4 h4 = hv; const v2u p2 = po;
          if (q + NGW < T * 4) P5B_LOAD(q + NGW);
          float ss = allreduce16(rowsum4(h4 * h4)); ss += __shfl_xor(ss, 16); ss += __shfl_xor(ss, 32);
          const float rs = __builtin_amdgcn_rsqf(ss * (1.f / 256.f) + NORM_EPS); const f32x4 og = UNP4(p2);
          const float o0 = h4[0] * rs * nw[0] * sigm(og[0]), o1 = h4[1] * rs * nw[1] * sigm(og[1]), o2 = h4[2] * rs * nw[2] * sigm(og[2]), o3 = h4[3] * rs * nw[3] * sigm(og[3]);
          v2u o; o.x = pk2(o0, o1); o.y = pk2(o2, o3); *(v2u*)(OB + (size_t)tk * RD + d0) = o; }
#undef P5B_LOAD
    }
}

typedef float f32x16 __attribute__((ext_vector_type(16)));
__device__ __forceinline__ void p8_route(Frame& F) {
    const bf16* X1 = (const bf16*)(F.ws + WS_X1); unsigned char* H2 = (unsigned char*)(F.ws + WS_HN); int* RLIST = (int*)(F.ws + WS_RLIST); float* RWT = (float*)(F.ws + WS_RW);
    const float* RWS = (const float*)(F.ws + WS_RWS); const float* nw = F.in[I_N2W]; const float* rtb = F.in[I_RTB];
    LAS float* part = (LAS float*)F.lds;
    LAS float* ssq = part + 8 * 32 * 33;
    LAS float* lgt = ssq + 256;
    LAS float* srs = lgt + 32 * 33;
    const int lane = F.lane, w = F.wave, i = lane & 31, h = lane >> 5, tid = F.tid;
    for (int tile = F.bid; tile < T / 32; tile += F.G) {
        const int m0 = tile * 32; const bf16* xrow = X1 + (size_t)(m0 + i) * D + 256 * w + 4 * h;
        f32x16 acc;
#pragma unroll
        for (int r_ = 0; r_ < 16; ++r_) acc[r_] = 0.f;
        float ss = 0.f; const float* bp = RWS + (size_t)(256 * w + 4 * h) * NE + i;
#pragma unroll 4
        for (int q = 0; q < 32; ++q) { const v2u xb_ = *(const v2u*)(xrow + 8 * q); const f32x4 xa = UNP4(xb_);
#pragma unroll
            for (int j = 0; j < 4; ++j) acc = __builtin_amdgcn_mfma_f32_32x32x2f32(xa[j], bp[(8 * q + j) * NE], acc, 0, 0, 0);
            ss += (xa[0] * xa[0] + xa[1] * xa[1]) + (xa[2] * xa[2] + xa[3] * xa[3]); }
        ss += __shfl_xor(ss, 32);
        if (h == 0) ssq[w * 32 + i] = ss;
#pragma unroll
        for (int r_ = 0; r_ < 16; ++r_) part[(w * 32 + (r_ & 3) + 8 * (r_ >> 2) + 4 * h) * 33 + i] = acc[r_];
        __syncthreads();
#pragma unroll
        for (int k2 = 0; k2 < 2; ++k2) { const int idx = tid + NTHR * k2, ii = idx >> 5, e = idx & 31; float sm = 0.f, sq = 0.f;
#pragma unroll
            for (int ww = 0; ww < 8; ++ww) { sm += part[(ww * 32 + ii) * 33 + e]; sq += ssq[ww * 32 + ii]; }
            const float rs = 1.f / sqrtf(sq * (1.f / D) + NORM_EPS); lgt[ii * 33 + e] = sm * rs + rtb[e]; if (e == 0) srs[ii] = rs; }
        __syncthreads();
        { const float rs = srs[i] * F8_SX; unsigned char* orow = H2 + (size_t)(m0 + i) * D + 256 * w + 4 * h;
#pragma unroll 8
          for (int q = 0; q < 32; ++q) { const f32x4 n4 = *(const f32x4*)(nw + 256 * w + 4 * h + 8 * q); const v2u xb_ = *(const v2u*)(xrow + 8 * q); const f32x4 hv = UNP4(xb_) * rs * n4; *(unsigned*)(orow + 8 * q) = pk4f8(hv[0], hv[1], hv[2], hv[3]); } }
        if (tid < 32) { const LAS float* lr = lgt + tid * 33; unsigned used = 0u; int idx[4]; float val[4];
#pragma unroll
            for (int s4 = 0; s4 < 4; ++s4) { float best = -INFINITY; int bi = 0;
                for (int e = 0; e < 32; ++e) { const float v = lr[e]; const bool ok = !((used >> e) & 1u) && (v > best); best = ok ? v : best; bi = ok ? e : bi; }
                used |= 1u << bi; idx[s4] = bi; val[s4] = best; }
            const float e1 = __expf(val[1] - val[0]), e2 = __expf(val[2] - val[0]), e3 = __expf(val[3] - val[0]); const float inv = 1.f / (1.f + e1 + e2 + e3);
            const float wv[4] = {inv, e1 * inv, e2 * inv, e3 * inv};
            unsigned pos[4];
#pragma unroll
            for (int s4 = 0; s4 < 4; ++s4) pos[s4] = atomicAdd(F.ctl + CW_CNT + 64 * idx[s4], 1u);
#pragma unroll
            for (int s4 = 0; s4 < 4; ++s4) { RLIST[idx[s4] * ECAP + pos[s4]] = (m0 + tid) * 4 + s4; RWT[idx[s4] * ECAP + pos[s4]] = wv[s4]; } }
        __syncthreads();
    }
}

__device__ __forceinline__ void build_moe_tables(Frame& F) {
    LAS int* MI = (LAS int*)F.MISC;
    __syncthreads();
    if (F.tid < NE) MI[MI_CNT + F.tid] = (int)__hip_atomic_load(F.ctl + CW_CNT + 64 * F.tid, __ATOMIC_RELAXED, __HIP_MEMORY_SCOPE_AGENT);
    __syncthreads();
    if (F.tid == 0) { int mt = 0, cs = 0;
        for (int e = 0; e < NE; ++e) { const int c = MI[MI_CNT + e]; MI[MI_POFF + e] = mt * 256; MI[MI_CST + e] = cs; cs += c;
            const int nt = (c + 255) >> 8; for (int i = 0; i < nt; ++i) { MI[MI_TILE_E + mt + i] = e; MI[MI_TILE_I0 + mt + i] = i * 256; } mt += nt; }
        MI[MI_CST + NE] = cs; MI[MI_MT] = mt; }
    __syncthreads();
}
__device__ __forceinline__ void p9_gather(Frame& F) {
    build_moe_tables(F);
    const LAS int* MI = (const LAS int*)F.MISC; const bf16* H2 = (const bf16*)(F.ws + WS_HN); bf16* XB = (bf16*)(F.ws + WS_XB); const int* RLIST = (const int*)(F.ws + WS_RLIST);
    const int gw = F.bid * NWAVES + F.wave, NGW = F.G * NWAVES, total = MI[MI_CST + NE];
    for (int q = gw; q < total; q += NGW) { int e = 0;
        for (int k = 1; k < NE; ++k) e = (MI[MI_CST + k] <= q) ? k : e;
        const int i = q - MI[MI_CST + e]; const int tok = RLIST[e * ECAP + i] >> 2;
        const v4u* src = (const v4u*)(H2 + (size_t)tok * D) + F.lane; v4u* dst = (v4u*)(XB + (size_t)(MI[MI_POFF + e] + i) * D) + F.lane;
#pragma unroll
        for (int j = 0; j < 4; ++j) dst[64 * j] = src[64 * j]; }
}
__device__ __forceinline__ void p12_final(Frame& F) {
    const bf16* X1 = (const bf16*)(F.ws + WS_X1); const unsigned char* YS = (const unsigned char*)(F.ws + WS_YS); const float* fw = F.in[I_FNW];
    const int gw = F.bid * NWAVES + F.wave, NGW = F.G * NWAVES;
    for (int m = gw; m < T; m += NGW) {
        const v2u* xr = (const v2u*)(X1 + (size_t)m * D) + F.lane; f32x4 v[8]; float s = 0.f;
#pragma unroll
        for (int j = 0; j < 8; ++j) { const v2u xb_ = xr[64 * j]; v[j] = UNP4(xb_);
#pragma unroll
            for (int sl = 0; sl < 4; ++sl) { const int y = ((const int*)(YS + ((size_t)m * 4 + sl) * D))[F.lane + 64 * j];
                const f32x2 ylo = __builtin_amdgcn_cvt_pk_f32_fp8(y, false), yhi = __builtin_amdgcn_cvt_pk_f32_fp8(y, true);
                v[j][0] += ylo[0] * (1.f / F8_SY); v[j][1] += ylo[1] * (1.f / F8_SY); v[j][2] += yhi[0] * (1.f / F8_SY); v[j][3] += yhi[1] * (1.f / F8_SY); }
            s += (v[j][0] * v[j][0] + v[j][1] * v[j][1]) + (v[j][2] * v[j][2] + v[j][3] * v[j][3]); }
        const float rstd = __builtin_amdgcn_rsqf(wave_sum(s) * (1.f / D) + NORM_EPS);
        f32x4* orow = (f32x4*)(F.out + (size_t)m * D) + F.lane;
#pragma unroll
        for (int j = 0; j < 8; ++j) { const f32x4 w = ((const f32x4*)fw)[F.lane + 64 * j]; orow[64 * j] = v[j] * rstd * w; }
    }
}

__global__ void __launch_bounds__(NTHR, 2) mk_fwd(Args args) {
    extern __shared__ __attribute__((aligned(16))) unsigned char lds[];
    Frame F;
    F.lds = (LAS unsigned char*)lds; F.MISC = (volatile LAS unsigned*)(F.lds + MISC_OFF);
    F.tid = threadIdx.x; F.lane = F.tid & 63; F.wave = __builtin_amdgcn_readfirstlane(F.tid >> 6); F.G = gridDim.x; F.bid = blockIdx.x;
    F.in = args.in; F.out = args.out; F.ws = args.ws; F.ctl = (unsigned*)(args.ws + WS_CTL);
    for (int u = F.tid; u < (LDS_BYTES - MISC_OFF) / 4; u += NTHR) ((LAS unsigned*)(F.lds + MISC_OFF))[u] = 0u;
    __syncthreads();
    XcdBarrier bar; bar.bar = F.ctl + CW_BAR; bar.x = 0; bar.st = nullptr;
    if (MK_N_LAUNCHES == 1) bar = xcd_barrier_post(F.ctl + CW_BAR, F.MISC + 8);
    const int lo = args.ph_lo, hi = args.ph_hi;
#define IN(k) (lo <= (k) && (k) < hi)
#ifndef PROBE_PHASE
#define PROBE_PHASE -1
#endif
#define REP(k) ((PROBE_PHASE) == (k) ? 2 : 1)
#define SEAM(k) do { if (IN(k) && IN((k) + 1)) xcd_barrier(bar); } while (0)
    LAS unsigned char* ring = F.lds;
    const LAS int* MI = (const LAS int*)F.MISC;

    static_assert(MK_N_LAUNCHES == 1, "the W_in quantisation needs an in-launch barrier inside phase 0");
    if (IN(0)) { p0_prologue(F); xcd_barrier(bar); p0b_win(F); } SEAM(0);
    if (IN(1)) {
        const int ng = F.G > 2 * NCV ? F.G - NCV : F.G;
        if (F.bid < ng) {
            pg8::Gemm g{(const bf16*)(F.ws + WS_HN), (const bf16*)(F.ws + WS_WIN), T, NINP, D / 2}; pg8::StaticOrder S; S.init(T, NINP, ng, F.bid);
            EpiP1I8 E{(bf16*)(F.ws + WS_P), NINP, (const float*)(F.ws + WS_RA), F.ctl + CW_COLMAX};
            pg8::gemm_phase<EpiP1I8, pg8::StaticOrder, true, true, false, true>(ring, g, S, E);
            if (F.tid == 0) __hip_atomic_fetch_add(F.ctl + CW_P1DONE, 1u, __ATOMIC_RELAXED, __HIP_MEMORY_SCOPE_AGENT);
        } else convert_loop(F, F.ctl + CW_CVNEXT, F.ctl + CW_P1DONE, (unsigned)ng);
    } SEAM(1);
    if (IN(2)) { for (int rep = 0; rep < REP(2); ++rep) p2_lora_in(F); } SEAM(2);
    if (IN(3)) {
        pg8::Gemm g{(const bf16*)(F.ws + WS_LIN), (const bf16*)(F.ws + WS_WL), T, 3072, 512}; pg8::StaticOrder S; S.init(T, 3072, F.G, F.bid);
        EpiLora E{(float*)(F.ws + WS_WAG), (bf16*)(F.ws + WS_WAG + 64 * MiB), F.in[I_W0], F.in[I_A0]};
        pg8::gemm_phase<EpiLora, pg8::StaticOrder, true, true>(ring, g, S, E);
    } SEAM(3);
    if (IN(4)) {
        { LAS unsigned* ctl2 = (LAS unsigned*)F.MISC + 16;
          if (F.wave < 4) { unsigned bt = 0u; for (int rep = 0; rep < REP(40); ++rep) for (int u = F.bid; u < 256; u += F.G) rwkv_chunk_unit(F, u, (LAS unsigned char*)F.MISC + 256, ctl2, bt); }
          else { Frame F2 = F; F2.tid = F.tid - 256; F2.wave = F.wave - 4; F2.lds = F.lds + 45056; unsigned bt = 0u;
                 for (int rep = 0; rep < REP(41); ++rep) for (int u = F.bid; u < 256; u += F.G) mlstm_scan_unit(F2, u, ctl2 + 2, bt); }
          convert_loop(F, F.ctl + CW_CVNEXT, nullptr, 0u);
          __syncthreads(); }
    } SEAM(4);
    if (IN(5)) { for (int rep = 0; rep < REP(5); ++rep) p5_finalize(F); } SEAM(5);
    if (IN(6)) {
        { pg8::Gemm g{(const bf16*)(F.ws + WS_OA), (const bf16*)(F.ws + WS_WA), T, D, RD}; pg8::StaticOrder S; S.init(T, D, F.G, F.bid);
          EpiGateA E{(bf16*)(F.ws + WS_TMP), (const bf16*)(F.ws + WS_P), F.in[I_BGATE]};
          pg8::gemm_phase<EpiGateA, pg8::StaticOrder, true, true>(ring, g, S, E); }
        VM_WAIT(); __syncthreads();
        { pg8::Gemm g{(const bf16*)(F.ws + WS_OB), (const bf16*)(F.ws + WS_WB), T, D, RD}; pg8::StaticOrder S; S.init(T, D, F.G, F.bid);
          EpiGateB E{(const bf16*)(F.ws + WS_TMP), (bf16*)(F.ws + WS_MRG), (const bf16*)(F.ws + WS_P), F.in[I_BGATE]};
          pg8::gemm_phase<EpiGateB, pg8::StaticOrder, true, true>(ring, g, S, E); }
    } SEAM(6);
    if (IN(7)) {
        pg8::Gemm g{(const bf16*)(F.ws + WS_MRG), (const bf16*)(F.ws + WS_WO), T, D, D}; pg8::StaticOrder S; S.init(T, D, F.G, F.bid);
        EpiResid E{F.in[I_X], (bf16*)(F.ws + WS_X1)};
        pg8::gemm_phase<EpiResid, pg8::StaticOrder, true, true>(ring, g, S, E);
    } SEAM(7);
    if (IN(8)) { p8_route(F); } SEAM(8);
    if (IN(10)) {
        build_moe_tables(F);
        const int mt = MI[MI_MT];
        pg8::Gemm g{(const bf16*)(F.ws + WS_HN), (const bf16*)(F.ws + WS_WGU), mt * 256, 2 * FF, D / 2};
        MoeGatherOrder S; S.init(mt * 256, 2 * FF, F.G, F.bid); S.tile_e = MI + MI_TILE_E; S.estride = (size_t)2 * FF * D;
        S.tile_i0 = MI + MI_TILE_I0; S.cnt = MI + MI_CNT; S.rlist = (const int*)(F.ws + WS_RLIST); S.rowoff = (LAS unsigned*)F.MISC + MI_ROWOFF; S.rowbytes = D;
        EpiSwiGLU E{(unsigned char*)(F.ws + WS_ACT), F.in[I_BGU], MI + MI_TILE_E};
        pg8::gemm_phase<EpiSwiGLU, MoeGatherOrder, true, true, true>(ring, g, S, E);
    } SEAM(10);
    if (IN(11)) {
        build_moe_tables(F);
        const int mt = MI[MI_MT];
        pg8::Gemm g{(const bf16*)(F.ws + WS_ACT), (const bf16*)(F.ws + WS_WDN), mt * 256, D, FF / 2};
        MoeOrder S; S.init(mt * 256, D, F.G, F.bid); S.tile_e = MI + MI_TILE_E; S.estride = (size_t)D * FF;
        LAS int* rowdst = (LAS int*)F.MISC + MI_ROWOFF; LAS float* rowwt = (LAS float*)F.MISC + MI_ROWOFF + 10 * 256;
        fill_down_tables(F, S, rowdst, rowwt);
        EpiDown E{(unsigned char*)(F.ws + WS_YS), F.in[I_BDN], MI + MI_TILE_E, rowdst, rowwt};
        pg8::gemm_phase<EpiDown, MoeOrder, true, true, true>(ring, g, S, E);
    } SEAM(11);
    if (IN(12)) { for (int rep = 0; rep < REP(12); ++rep) p12_final(F); }
#undef IN
#undef SEAM
}

extern "C" void kernel_launch(void* const* d_in, const int* in_sizes, int n_in, void* d_out, int out_size, void* d_ws, size_t ws_size, hipStream_t stream) {
    static int grid = 0;
    if (grid == 0) {
        if (n_in != 30 || out_size != T * D || ws_size < WS_END) { fprintf(stderr, "kernel_launch: unexpected problem (n_in %d, out %d, ws %zu)\n", n_in, out_size, ws_size); grid = -1; return; }
        int dev = 0, cus = 0, per_cu = 0;
        if (hipGetDevice(&dev) != hipSuccess || hipDeviceGetAttribute(&cus, hipDeviceAttributeMultiprocessorCount, dev) != hipSuccess) { grid = -1; return; }
        if (hipFuncSetAttribute((const void*)mk_fwd, hipFuncAttributeMaxDynamicSharedMemorySize, LDS_BYTES) != hipSuccess) { fprintf(stderr, "kernel_launch: hipFuncSetAttribute failed\n"); grid = -1; return; }
        if (hipOccupancyMaxActiveBlocksPerMultiprocessor(&per_cu, (const void*)mk_fwd, NTHR, LDS_BYTES) != hipSuccess || per_cu < 1) fprintf(stderr, "kernel_launch: occupancy query says %d\n", per_cu);
        (void)hipGetLastError();
        grid = cus;
    }
    if (grid < 0) return;
    if (hipMemsetAsync((char*)d_ws + WS_CTL, 0, CTL_ZERO_BYTES, stream) != hipSuccess) return;
    Args a{};
    for (int i = 0; i < 30; ++i) a.in[i] = (const float*)d_in[i];
    a.out = (float*)d_out; a.ws = (unsigned char*)d_ws;
    for (int li = 0; li < MK_N_LAUNCHES; ++li) {
        a.ph_lo = (MK_N_LAUNCHES == 1) ? 0 : li; a.ph_hi = (MK_N_LAUNCHES == 1) ? NPH : li + 1;
        hipLaunchKernelGGL(mk_fwd, dim3(grid), dim3(NTHR), LDS_BYTES, stream, a);
        const hipError_t le = hipPeekAtLastError();
        if (le != hipSuccess) { fprintf(stderr, "kernel_launch: launch %d failed: %s\n", li, hipGetErrorName(le)); break; }
    }
}
```

```cpp
#include <hip/hip_runtime.h>
#include <cstdio>
#include <cstdint>
#define MK_N_LAUNCHES 1
#define PROBE_PHASE -1
namespace pg8 {
#define PG8_LAS __attribute__((address_space(3)))
typedef unsigned short bf16_t;
typedef short bf16x8 __attribute__((ext_vector_type(8)));
typedef float f32x4 __attribute__((ext_vector_type(4)));
typedef unsigned u32x4 __attribute__((ext_vector_type(4)));
constexpr int BM = 256, BK = 64, HALF = 128, HTB = HALF * BK * 2  , STAGE_BYTES = 8 * HTB, NXCD = 8, WGM = 8;

__host__ __device__ __forceinline__ int lds_byte(int r, int c) { const int st = (r >> 4) * 2 + (c >> 5), rr = r & 15, cc = c & 31, ob = rr * 64 + cc * 2; return st * 1024 + (ob ^ (((ob >> 9) & 1) << 5)); }
__host__ __device__ __forceinline__ void stage_rc(int b, int& R, int& C) { const int st = b / 1024, sb = b % 1024, swz = sb ^ (((sb >> 9) & 1) << 5); R = (st >> 1) * 16 + swz / 64; C = (st & 1) * 32 + (swz % 64) / 2; }
__host__ __device__ __forceinline__ int perm32(int rho) { const int n = rho >> 4, i = rho & 15; return 8 * (i >> 2) + 4 * n + (i & 3); }

struct Unit { int pm, pn, ord; };
struct Gemm { const bf16_t* A; const bf16_t* Bt; int M, N, K; };

struct StaticOrder {
    int nM, nN, nwg, G, c;
    __host__ __device__ void init(int M, int N, int G_, int c_) { nM = M / BM; nN = N / BM; nwg = nM * nN; G = G_; c = c_; }
    __host__ __device__ bool next(int i, Unit& u) const {
        const long L = (long)i * G + c; if (L >= nwg) return false;
        int wgid = (int)L; { const int q = nwg / NXCD, r = nwg % NXCD, xcd = wgid % NXCD, off = wgid / NXCD; wgid = (xcd < r ? xcd * (q + 1) : r * (q + 1) + (xcd - r) * q) + off; }
        const int nig = WGM * nN, gid = wgid / nig, fm = gid * WGM, gsz = (nM - fm) < WGM ? (nM - fm) : WGM;
        u.pm = fm + ((wgid % nig) % gsz); u.pn = (wgid % nig) / gsz; u.ord = i; return true;
    }
    __device__ __forceinline__ void a_ready(const Unit&) const {}
    static constexpr bool GATHER = false;
    __device__ __forceinline__ void fill_all() const {}
    __device__ __forceinline__ unsigned row_off(int, int) const { return 0u; }
    __device__ __forceinline__ void done(const Unit&) const {}
    __device__ __forceinline__ size_t a_off(const Unit& u, size_t tstep) const { return (size_t)u.pm * tstep; }
    __device__ __forceinline__ size_t b_off(const Unit& u, size_t tstep) const { return (size_t)u.pn * tstep; }
};
__device__ __forceinline__ unsigned cvt_pk_bf16(float lo, float hi) { unsigned r; asm volatile("v_cvt_pk_bf16_f32 %0, %1, %2" : "=v"(r) : "v"(lo), "v"(hi)); return r; }
typedef int v8i32 __attribute__((ext_vector_type(8)));
typedef int v4i32 __attribute__((ext_vector_type(4)));
__device__ __forceinline__ v8i32 cat8(bf16x8 lo, bf16x8 hi) { const v4i32 a = __builtin_bit_cast(v4i32, lo), b = __builtin_bit_cast(v4i32, hi); return __builtin_shufflevector(a, b, 0, 1, 2, 3, 4, 5, 6, 7); }
template <class Epi, class Sched, bool ALIGN_EPI = false, bool SP2 = false, bool FP8 = false, bool I8 = false>
__device__ __forceinline__ void gemm_phase(PG8_LAS unsigned char* lds, const Gemm g, const Sched& S, const Epi& E) {
    const int tid = threadIdx.x, wid = __builtin_amdgcn_readfirstlane(tid >> 6), lane = tid & 63, wr = wid >> 2, wc = wid & 3, fr = lane & 15, fq = lane >> 4;
    const int K = g.K, nt = K / BK;
    unsigned voffA[2], voffB[2];
#pragma unroll
    for (int i = 0; i < 2; ++i) { int R, C; stage_rc(tid * 16 + i * 8192, R, C); const int Rb = Epi::PERM ? ((R & ~31) + perm32(R & 31)) : R;
        voffA[i] = (unsigned)(R * K + C) * 2u; voffB[i] = (unsigned)(Rb * K + C) * 2u; }
    unsigned voffA1[2]; int rselA[2]; unsigned cselA[2];
#pragma unroll
    for (int i = 0; i < 2; ++i) { int R, C; stage_rc(tid * 16 + i * 8192, R, C); rselA[i] = R; cselA[i] = (unsigned)C * 2u; voffA1[i] = voffA[i]; }
    const size_t kstep = (size_t)(BK * 2);
    const size_t hstep = (size_t)HALF * K * 2;
    const size_t tstep = 2 * hstep;
    const size_t hstepA = Sched::GATHER ? (size_t)0 : hstep;
#define PG8_ROWS(_u) do { _Pragma("unroll") for (int _i = 0; _i < 2; ++_i) { voffA[_i] = S.row_off((_u), rselA[_i]) + cselA[_i]; voffA1[_i] = S.row_off((_u), HALF + rselA[_i]) + cselA[_i]; } } while (0)
    const unsigned ldsw = (unsigned)wid * 1024u;
    const int aoff = lds_byte(wr * 64 + fr, fq * 8), boff = lds_byte(wc * 32 + fr, fq * 8);
#define PG8_SA(b, h) (((b) * 2 + (h)) * HTB)
#define PG8_SB(b, h) ((4 + (b) * 2 + (h)) * HTB)
#define PG8_STAGE(bufoff, gbase, voff) do { _Pragma("unroll") for (int _i = 0; _i < 2; ++_i) \
        __builtin_amdgcn_global_load_lds((const unsigned*)((const char*)(gbase) + (voff)[_i]), (PG8_LAS unsigned*)(lds + (bufoff) + ldsw + _i * 8192), 16, 0, 0); } while (0)
#define PG8_LDA(dst, b, h) do { if constexpr (FP8) { _Pragma("unroll") for (int m = 0; m < 4; ++m) dst##8[m] = cat8(*(const PG8_LAS bf16x8*)(lds + PG8_SA(b, h) + aoff + m * 2048), *(const PG8_LAS bf16x8*)(lds + PG8_SA(b, h) + aoff + m * 2048 + 1024)); } \
        else { _Pragma("unroll") for (int m = 0; m < 4; ++m) _Pragma("unroll") for (int k = 0; k < 2; ++k) dst[m][k] = *(const PG8_LAS bf16x8*)(lds + PG8_SA(b, h) + aoff + m * 2048 + k * 1024); } } while (0)
#define PG8_LDB(dst, b, h) do { if constexpr (FP8) { _Pragma("unroll") for (int n = 0; n < 2; ++n) dst##8[n] = cat8(*(const PG8_LAS bf16x8*)(lds + PG8_SB(b, h) + boff + n * 2048), *(const PG8_LAS bf16x8*)(lds + PG8_SB(b, h) + boff + n * 2048 + 1024)); } \
        else { _Pragma("unroll") for (int n = 0; n < 2; ++n) _Pragma("unroll") for (int k = 0; k < 2; ++k) dst[n][k] = *(const PG8_LAS bf16x8*)(lds + PG8_SB(b, h) + boff + n * 2048 + k * 1024); } } while (0)
#define PG8_MMA(ai, bj, At, Bt) do { __builtin_amdgcn_s_setprio(1); if constexpr (FP8) { _Pragma("unroll") for (int m = 0; m < 4; ++m) _Pragma("unroll") for (int n = 0; n < 2; ++n) \
        asm volatile("v_mfma_scale_f32_16x16x128_f8f6f4 %0, %1, %2, %0, %3, %3 op_sel_hi:[0,0,0]" : "+v"(acc[ai][bj][m][n]) : "v"(Bt##8[n]), "v"(At##8[m]), "v"(f8scale)); } else { \
        _Pragma("unroll") for (int m = 0; m < 4; ++m) _Pragma("unroll") for (int n = 0; n < 2; ++n) _Pragma("unroll") for (int k = 0; k < 2; ++k) { \
        if constexpr (I8) acc[ai][bj][m][n] = __builtin_bit_cast(f32x4, __builtin_amdgcn_mfma_i32_16x16x64_i8(__builtin_bit_cast(v4i32, Bt[n][k]), __builtin_bit_cast(v4i32, At[m][k]), __builtin_bit_cast(v4i32, acc[ai][bj][m][n]), 0, 0, 0)); \
        else acc[ai][bj][m][n] = __builtin_amdgcn_mfma_f32_16x16x32_bf16(Bt[n][k], At[m][k], acc[ai][bj][m][n], 0, 0, 0); } } __builtin_amdgcn_s_setprio(0); } while (0)
#define PG8_WAIT_V(n) asm volatile("s_waitcnt vmcnt(" #n ")" ::: "memory")
#define PG8_WAIT_L(n) asm volatile("s_waitcnt lgkmcnt(" #n ")" ::: "memory")
#define PG8_BAR __builtin_amdgcn_s_barrier()
#define PG8_SCHED __builtin_amdgcn_sched_barrier(0)
    Unit cur, nxt; int ui = 0;
    if (!S.next(0, cur)) return;
    f32x4 acc[2][2][4][2];
#pragma unroll
    for (int a = 0; a < 2; ++a)
#pragma unroll
        for (int b = 0; b < 2; ++b)
#pragma unroll
            for (int m = 0; m < 4; ++m)
#pragma unroll
                for (int n = 0; n < 2; ++n) acc[a][b][m][n] = (f32x4){0.f, 0.f, 0.f, 0.f};
    const int f8scale = 0x7f7f7f7f;
    bf16x8 At[4][2], B0[2][2], B1[2][2]; v8i32 At8[4], B08[2], B18[2];
    const char* cA = (const char*)g.A + S.a_off(cur, tstep); const char* cB = (const char*)g.Bt + S.b_off(cur, tstep);
    S.a_ready(cur);
    if constexpr (Sched::GATHER) { S.fill_all(); asm volatile("s_waitcnt vmcnt(0) lgkmcnt(0)" ::: "memory"); __builtin_amdgcn_s_barrier(); asm volatile("" ::: "memory"); PG8_ROWS(0); }
    if constexpr (SP2) {
        PG8_STAGE(PG8_SB(0, 0), cB, voffB); PG8_STAGE(PG8_SB(0, 1), cB + hstep, voffB); PG8_STAGE(PG8_SA(0, 0), cA, voffA); PG8_STAGE(PG8_SA(0, 1), cA + hstepA, voffA1);
        if (wr == 1) PG8_BAR;
        PG8_WAIT_V(2); PG8_BAR;
        PG8_STAGE(PG8_SB(1, 0), cB + kstep, voffB); PG8_STAGE(PG8_SA(1, 0), cA + kstep, voffA); PG8_STAGE(PG8_SB(1, 1), cB + hstep + kstep, voffB);
        PG8_WAIT_V(6); PG8_BAR;
    } else {
        PG8_STAGE(PG8_SB(0, 0), cB, voffB); PG8_STAGE(PG8_SA(0, 0), cA, voffA); PG8_STAGE(PG8_SB(0, 1), cB + hstep, voffB); PG8_STAGE(PG8_SA(0, 1), cA + hstepA, voffA1);
        if (wr == 1) PG8_BAR;
        PG8_WAIT_V(4); PG8_BAR;
        PG8_STAGE(PG8_SB(1, 0), cB + kstep, voffB); PG8_STAGE(PG8_SA(1, 0), cA + kstep, voffA); PG8_STAGE(PG8_SB(1, 1), cB + hstep + kstep, voffB);
        PG8_WAIT_V(6); PG8_BAR;
    }
    for (;;) {
        const bool has_next = S.next(ui + 1, nxt);
        const char* nA = has_next ? (const char*)g.A + S.a_off(nxt, tstep) : cA; const char* nB = has_next ? (const char*)g.Bt + S.b_off(nxt, tstep) : cB;
        for (int t = 0; t < nt; t += 2) {
            const bool last = (t == nt - 2);
            const char* a1 = cA + (size_t)(t + 1) * kstep;
            const char* a2 = last ? nA : cA + (size_t)(t + 2) * kstep; const char* b2 = last ? nB : cB + (size_t)(t + 2) * kstep;
            const char* a3 = a2 + kstep; const char* b3 = b2 + kstep;
            if (last && has_next) S.a_ready(nxt);
            if constexpr (SP2) {
            PG8_LDB(B0, 0, 0); PG8_LDB(B1, 0, 1); PG8_SCHED; PG8_LDA(At, 0, 0); PG8_STAGE(PG8_SA(1, 1), a1 + hstepA, voffA1);
            PG8_WAIT_V(8); PG8_WAIT_L(0); PG8_BAR; PG8_MMA(0, 0, At, B0); PG8_MMA(0, 1, At, B1); PG8_BAR; PG8_SCHED;
            if constexpr (Sched::GATHER) { if (last && has_next) PG8_ROWS(ui + 1); }
            PG8_LDA(At, 0, 1); PG8_STAGE(PG8_SB(0, 0), b2, voffB); PG8_STAGE(PG8_SB(0, 1), b2 + hstep, voffB); PG8_STAGE(PG8_SA(0, 0), a2, voffA);
            PG8_WAIT_V(8); PG8_WAIT_L(0); PG8_BAR; PG8_MMA(1, 0, At, B0); PG8_MMA(1, 1, At, B1); PG8_BAR; PG8_SCHED;
            PG8_LDB(B0, 1, 0); PG8_LDB(B1, 1, 1); PG8_SCHED; PG8_LDA(At, 1, 0); PG8_STAGE(PG8_SA(0, 1), a2 + hstepA, voffA1);
            PG8_WAIT_V(8); PG8_WAIT_L(0); PG8_BAR; PG8_MMA(0, 0, At, B0); PG8_MMA(0, 1, At, B1); PG8_BAR; PG8_SCHED;
            PG8_LDA(At, 1, 1); PG8_STAGE(PG8_SB(1, 0), b3, voffB); PG8_STAGE(PG8_SB(1, 1), b3 + hstep, voffB); PG8_STAGE(PG8_SA(1, 0), a3, voffA);
            PG8_WAIT_V(8); PG8_WAIT_L(0); PG8_BAR; PG8_MMA(1, 0, At, B0); PG8_MMA(1, 1, At, B1); PG8_BAR; PG8_SCHED;
            } else {
            PG8_LDB(B0, 0, 0); PG8_SCHED; PG8_LDA(At, 0, 0); PG8_STAGE(PG8_SA(1, 1), a1 + hstepA, voffA1);
            PG8_WAIT_L(8); PG8_BAR; PG8_WAIT_L(0); PG8_MMA(0, 0, At, B0); PG8_BAR; PG8_SCHED;
            PG8_LDB(B1, 0, 1); PG8_STAGE(PG8_SB(0, 0), b2, voffB);
            PG8_BAR; PG8_WAIT_L(0); PG8_MMA(0, 1, At, B1); PG8_BAR;
            PG8_LDA(At, 0, 1); PG8_STAGE(PG8_SA(0, 0), a2, voffA);
            PG8_BAR; PG8_WAIT_L(0); PG8_MMA(1, 0, At, B0); PG8_BAR; PG8_SCHED;
            PG8_STAGE(PG8_SB(0, 1), b2 + hstep, voffB);
            PG8_WAIT_V(6); PG8_BAR; PG8_MMA(1, 1, At, B1); PG8_BAR;
            PG8_LDB(B0, 1, 0); PG8_SCHED; PG8_LDA(At, 1, 0); PG8_STAGE(PG8_SA(0, 1), a2 + hstepA, voffA1);
            PG8_WAIT_L(8); PG8_BAR; PG8_WAIT_L(0); PG8_MMA(0, 0, At, B0); PG8_BAR; PG8_SCHED;
            PG8_LDB(B1, 1, 1); PG8_STAGE(PG8_SB(1, 0), b3, voffB);
            PG8_BAR; PG8_WAIT_L(0); PG8_MMA(0, 1, At, B1); PG8_BAR;
            PG8_LDA(At, 1, 1); PG8_STAGE(PG8_SA(1, 0), a3, voffA);
            PG8_BAR; PG8_WAIT_L(0); PG8_MMA(1, 0, At, B0); PG8_BAR; PG8_SCHED;
            PG8_STAGE(PG8_SB(1, 1), b3 + hstep, voffB);
            PG8_WAIT_V(6); PG8_BAR; PG8_MMA(1, 1, At, B1); PG8_BAR;
            }
        }
        if constexpr (ALIGN_EPI) { if (wr == 0) PG8_BAR; }
        if constexpr (FP8) { asm volatile("s_nop 15\n\ts_nop 15" ::: "memory"); }
        if constexpr (!Epi::AFTER_DRAIN) { E(acc, cur, wr, wc, fr, fq); S.done(cur); }
        if (!has_next) break;
#pragma unroll
        for (int a = 0; a < 2; ++a)
#pragma unroll
            for (int b = 0; b < 2; ++b)
#pragma unroll
                for (int m = 0; m < 4; ++m)
#pragma unroll
                    for (int n = 0; n < 2; ++n) acc[a][b][m][n] = (f32x4){0.f, 0.f, 0.f, 0.f};
        cur = nxt; cA = nA; cB = nB; ++ui;
        if constexpr (ALIGN_EPI) { if (wr == 1) PG8_BAR; }
    }
    PG8_WAIT_V(0);
    if constexpr (!ALIGN_EPI) { if (wr == 0) PG8_BAR; }
    PG8_BAR;
    if constexpr (Epi::AFTER_DRAIN) { E.fused(acc, cur, wr, wc, fr, fq, lds, wid, lane); S.done(cur); }
#undef PG8_ROWS
#undef PG8_SA
#undef PG8_SB
#undef PG8_STAGE
#undef PG8_LDA
#undef PG8_LDB
#undef PG8_MMA
#undef PG8_WAIT_V
#undef PG8_WAIT_L
#undef PG8_BAR
#undef PG8_SCHED
}
}

#ifndef MK_N_LAUNCHES
#define MK_N_LAUNCHES 1
#endif
#define GAS __attribute__((address_space(1)))
#define LAS __attribute__((address_space(3)))
typedef unsigned short bf16;
typedef unsigned v4u __attribute__((ext_vector_type(4)));
typedef unsigned v2u __attribute__((ext_vector_type(2)));
typedef float f32x4 __attribute__((ext_vector_type(4)));
typedef float f32x2 __attribute__((ext_vector_type(2)));

constexpr int NWAVES = 8, NTHR = 512;
constexpr int NPH = 13;
constexpr int D = 2048, BATCH = 8, SEQ = 2048, T = BATCH * SEQ;
constexpr int NIN = 10696, NINP = 10752;
constexpr int MLO = 3520, GTO = 6600;
constexpr int RH = 16, RD = 1024;
constexpr int MH = 4;
constexpr int NE = 32, FF = 2048, ECAP = 16384, PMAX = 65536 + NE * 256, MTMAX = PMAX / 256;
constexpr float NORM_EPS = 1e-6f, GN_EPS = 64e-5f;
constexpr size_t MiB = 1u << 20;
constexpr size_t WS_CTL = 0, CTL_ZERO_BYTES = 1 * MiB;
constexpr size_t WS_WIN = 1 * MiB, WS_WA = 43 * MiB, WS_WB = 47 * MiB, WS_WO = 51 * MiB, WS_WL = 59 * MiB;
constexpr size_t WS_RLIST = 62 * MiB, WS_RW = 64 * MiB, WS_RWS = 2787 * MiB, WS_RA = 2787 * MiB + 512 * 1024;
constexpr size_t WS_WGU = 66 * MiB, WS_WDN = 578 * MiB, WS_HN = 834 * MiB, WS_P = 898 * MiB, WS_LIN = 1234 * MiB, WS_WAG = 1250 * MiB;
constexpr size_t WS_YRAW = 1442 * MiB, WS_HRAW = 1506 * MiB, WS_OA = 1570 * MiB, WS_OB = 1602 * MiB, WS_TMP = 1634 * MiB, WS_MRG = 1762 * MiB;
constexpr size_t WS_QKC = WS_TMP, WS_GLF = WS_TMP + 64 * MiB;
constexpr size_t WS_X1 = 1826 * MiB, WS_XB = 1954 * MiB, WS_ACT = 2242 * MiB, WS_YS = 2530 * MiB, WS_END = 2788 * MiB;
constexpr int CW_BAR = 4096;
constexpr int CW_CVNEXT = 8192, CW_P1DONE = 8192 + 64;
constexpr int CV_W0 = 6, CV1_W0 = 4;
constexpr int NCV = 64;
constexpr int CW_COLMAX = 32768;
constexpr int CW_CNT = 16384;
constexpr int RING_BYTES = 131072, MISC_OFF = RING_BYTES, LDS_BYTES = RING_BYTES + 8192 + 20 * 1024;
constexpr int MI_TILE_E = 64, MI_TILE_I0 = 64 + 320, MI_CNT = 64 + 640, MI_POFF = MI_CNT + 32, MI_CST = MI_POFF + 32, MI_MT = MI_CST + 40, MI_ROWOFF = 2048;

#define LDS_WAIT() asm volatile("s_waitcnt lgkmcnt(0)" ::: "memory")
#define VM_WAIT() asm volatile("s_waitcnt vmcnt(0)" ::: "memory")
__device__ __forceinline__ float bf2f(bf16 v) { return __uint_as_float(((unsigned)v) << 16); }
__device__ __forceinline__ unsigned f2bf(float f) { unsigned u = __float_as_uint(f); return (u + 0x7fffu + ((u >> 16) & 1u)) >> 16; }
typedef __bf16 bf16x2_t __attribute__((ext_vector_type(2)));
__device__ __forceinline__ unsigned pk2(float lo, float hi) { const f32x2 v = {lo, hi}; const bf16x2_t b = __builtin_convertvector(v, bf16x2_t); return __builtin_bit_cast(unsigned, b); }
__device__ __forceinline__ unsigned pk4f8(float a, float b, float c, float d) { int r = 0; r = __builtin_amdgcn_cvt_pk_fp8_f32(a, b, r, false); r = __builtin_amdgcn_cvt_pk_fp8_f32(c, d, r, true); return (unsigned)r; }
constexpr float F8_SX = 8.f, F8_SW = 256.f, F8_SA = 4.f, F8_SY = 16.f;
__device__ __forceinline__ unsigned pk4i8(float a, float b, float c, float d) {
    const int ia = (int)__builtin_rintf(a), ib = (int)__builtin_rintf(b), ic = (int)__builtin_rintf(c), id = (int)__builtin_rintf(d);
    return (unsigned)(ia & 255) | ((unsigned)(ib & 255) << 8) | ((unsigned)(ic & 255) << 16) | ((unsigned)id << 24); }
__device__ __forceinline__ float wave_max(float v) {
#pragma unroll
    for (int o = 1; o < 64; o <<= 1) v = fmaxf(v, __shfl_xor(v, o));
    return v;
}
__device__ __forceinline__ float wave_sum(float v) {
#pragma unroll
    for (int o = 1; o < 64; o <<= 1) v += __shfl_xor(v, o);
    return v;
}
#define UNP4(v) ((f32x4){__uint_as_float((v).x << 16), __uint_as_float((v).x & 0xffff0000u), __uint_as_float((v).y << 16), __uint_as_float((v).y & 0xffff0000u)})
__device__ __forceinline__ float sigm(float x) { return __builtin_amdgcn_rcpf(1.f + __expf(-x)); }
template <int CTRL> __device__ __forceinline__ float dppf(float x) { return __builtin_bit_cast(float, __builtin_amdgcn_mov_dpp(__builtin_bit_cast(int, x), CTRL, 0xf, 0xf, true)); }
__device__ __forceinline__ float allreduce16(float x) { x += dppf<0x128>(x); x += dppf<0x124>(x); x += dppf<0x4E>(x); x += dppf<0xB1>(x); return x; }

#define XB_TMO      128
#define XB_XCNT(j)  (256  + 64 * (j))
#define XB_XSUB(j)  (1280 + 64 * (j))
#define XB_XGEN(j)  (2304 + 64 * (j))
#define XB_TOP      3328
#define XB_TOPGEN   3392
#define XCD_BAR_WORDS 3456
#define XB_SPIN_CAP (1u << 18)
__device__ __forceinline__ unsigned xb_ld(unsigned* p)              { return __hip_atomic_load(p, __ATOMIC_RELAXED, __HIP_MEMORY_SCOPE_AGENT); }
__device__ __forceinline__ unsigned xb_add(unsigned* p, unsigned v) { return __hip_atomic_fetch_add(p, v, __ATOMIC_RELAXED, __HIP_MEMORY_SCOPE_AGENT); }
__device__ __forceinline__ unsigned xb_xcc_id() { return (unsigned)__builtin_amdgcn_s_getreg((3 << 11) | 20) & 0xFu; }
#define XB_SPIN(cond, bar) do { unsigned _sp = 0; while (cond) { __builtin_amdgcn_s_sleep(1); \
    if ((++_sp & 255u) == 0u) { if (xb_ld(&(bar)[XB_TMO])) break; if (_sp > XB_SPIN_CAP) { atomicAdd(&(bar)[XB_TMO], 1u); break; } } } } while (0)
struct XcdBarrier { unsigned* bar; unsigned x; volatile LAS unsigned* st; };
__device__ __forceinline__ XcdBarrier xcd_barrier_post(unsigned* bar, volatile LAS unsigned* st) {
    XcdBarrier b; b.bar = bar; b.x = xb_xcc_id(); b.st = st;
    if (threadIdx.x == 0) (void)xb_add(&bar[XB_XCNT(b.x)], 1u);
    return b;
}
__device__ __forceinline__ void xcd_barrier_complete(unsigned* bar, unsigned x, unsigned& nloc, unsigned& nx) {
    const unsigned G = gridDim.x * gridDim.y * gridDim.z;
    unsigned sum, cnt, mine, sp = 0u;
    for (;;) {
        sum = 0u; cnt = 0u; mine = 0u;
#pragma unroll
        for (unsigned j = 0; j < 16; ++j) { const unsigned c = xb_ld(&bar[XB_XCNT(j)]); sum += c; cnt += (c > 0u) ? 1u : 0u; mine = (j == x) ? c : mine; }
        if (sum == G) break;
        __builtin_amdgcn_s_sleep(1);
        if ((++sp & 255u) == 0u) { if (xb_ld(&bar[XB_TMO])) break; if (sp > XB_SPIN_CAP) { atomicAdd(&bar[XB_TMO], 1u); break; } }
    }
    nloc = mine > 0u ? mine : 1u; nx = cnt > 0u ? cnt : 1u;
}
__device__ __forceinline__ void xcd_barrier(const XcdBarrier& b) {
    asm volatile("s_waitcnt vmcnt(0)" ::: "memory");
    __syncthreads();
    if (threadIdx.x == 0) {
        unsigned* bar = b.bar;
        __builtin_amdgcn_s_waitcnt(0);
        unsigned nloc = b.st[0], nx = b.st[1];
        if (nloc == 0u) { xcd_barrier_complete(bar, b.x, nloc, nx); b.st[0] = nloc; b.st[1] = nx; }
        const unsigned old = xb_add(&bar[XB_XSUB(b.x)], 1u);
        const unsigned gen = old / nloc;
        if (old + 1u == (gen + 1u) * nloc) {
            __builtin_amdgcn_fence(__ATOMIC_RELEASE, "agent");
            asm volatile("s_waitcnt vmcnt(0)" ::: "memory");
            const unsigned og = xb_add(&bar[XB_TOP], 1u);
            const unsigned tg = og / nx;
            if (og + 1u == (tg + 1u) * nx) xb_add(&bar[XB_TOPGEN], 1u);
            else XB_SPIN(xb_ld(&bar[XB_TOPGEN]) == tg, bar);
            __builtin_amdgcn_fence(__ATOMIC_ACQUIRE, "agent");
            xb_add(&bar[XB_XGEN(b.x)], 1u);
            asm volatile("s_waitcnt vmcnt(0)" ::: "memory");
        } else {
            XB_SPIN(xb_ld(&bar[XB_XGEN(b.x)]) == gen, bar);
            __builtin_amdgcn_fence(__ATOMIC_ACQUIRE, "agent");
            asm volatile("s_waitcnt vmcnt(0)" ::: "memory");
        }
    }
    __syncthreads();
}

struct Args { const float* in[30]; float* out; unsigned char* ws; int ph_lo, ph_hi; };
enum { I_X = 0, I_N1W, I_WIN, I_BGATE, I_MU, I_W0, I_WUP, I_A0, I_AUP, I_GUP, I_KK, I_KA, I_RK, I_LNW, I_LNB, I_CONVW, I_IB, I_FB, I_MNW, I_WBA, I_WBB, I_WOUT, I_N2W, I_RTW, I_RTB, I_WGU, I_BGU, I_WDN, I_BDN, I_FNW };

struct Frame {
    LAS unsigned char* lds; volatile LAS unsigned* MISC; unsigned* ctl;
    int tid, lane, wave, G, bid;
    const float* const* in; float* out; unsigned char* ws;
};

using pg8::Unit; using pg8::HALF; using pg8::BM;
struct EpiBf16Plain {
    static constexpr bool PERM = true, AFTER_DRAIN = false;
    bf16* O; int ldc;
    __device__ __forceinline__ void operator()(const f32x4 (&acc)[2][2][4][2], const Unit& u, int wr, int wc, int fr, int fq) const {
        const int row0 = u.pm * BM + wr * 64 + fr, col0 = u.pn * BM + wc * 32 + 8 * fq;
#pragma unroll
        for (int ai = 0; ai < 2; ++ai)
#pragma unroll
            for (int m = 0; m < 4; ++m) { bf16* rowp = O + (size_t)(row0 + ai * HALF + m * 16) * ldc + col0;
#pragma unroll
                for (int bj = 0; bj < 2; ++bj) { const f32x4 v0 = acc[ai][bj][m][0], v1 = acc[ai][bj][m][1];
                    v4u w; w.x = pg8::cvt_pk_bf16(v0[0], v0[1]); w.y = pg8::cvt_pk_bf16(v0[2], v0[3]); w.z = pg8::cvt_pk_bf16(v1[0], v1[1]); w.w = pg8::cvt_pk_bf16(v1[2], v1[3]);
                    *(v4u*)(rowp + bj * HALF) = w; } }
    }
};
struct EpiP1I8 {
    static constexpr bool PERM = true, AFTER_DRAIN = false;
    bf16* O; int ldc; const float* ra; const unsigned* colmax;
    __device__ __forceinline__ void operator()(const f32x4 (&acc)[2][2][4][2], const Unit& u, int wr, int wc, int fr, int fq) const {
        const int row0 = u.pm * BM + wr * 64 + fr, col0 = u.pn * BM + wc * 32 + 8 * fq;
        f32x4 cb[2][2];
#pragma unroll
        for (int bj = 0; bj < 2; ++bj)
#pragma unroll
            for (int n = 0; n < 2; ++n) { const v4u cm = *(const v4u*)(colmax + col0 + bj * HALF + 4 * n);
                cb[bj][n] = (f32x4){__uint_as_float(cm.x), __uint_as_float(cm.y), __uint_as_float(cm.z), __uint_as_float(cm.w)} * (1.f / 127.f); }
#pragma unroll
        for (int ai = 0; ai < 2; ++ai)
#pragma unroll
            for (int m = 0; m < 4; ++m) { const int r = row0 + ai * HALF + m * 16; const float rs = ra[r]; bf16* rowp = O + (size_t)r * ldc + col0;
#pragma unroll
                for (int bj = 0; bj < 2; ++bj) { const v4u i0 = __builtin_bit_cast(v4u, acc[ai][bj][m][0]), i1 = __builtin_bit_cast(v4u, acc[ai][bj][m][1]);
                    const f32x4 v0 = (f32x4){(float)(int)i0.x, (float)(int)i0.y, (float)(int)i0.z, (float)(int)i0.w} * cb[bj][0] * rs, v1 = (f32x4){(float)(int)i1.x, (float)(int)i1.y, (float)(int)i1.z, (float)(int)i1.w} * cb[bj][1] * rs;
                    v4u w; w.x = pk2(v0[0], v0[1]); w.y = pk2(v0[2], v0[3]); w.z = pk2(v1[0], v1[1]); w.w = pk2(v1[2], v1[3]);
                    *(v4u*)(rowp + bj * HALF) = w; } }
    }
};
struct EpiLora {
    static constexpr bool PERM = false, AFTER_DRAIN = false;
    float* WLD; bf16* AG; const float* w0; const float* a0;
    __device__ __forceinline__ void operator()(const f32x4 (&acc)[2][2][4][2], const Unit& u, int wr, int wc, int fr, int fq) const {
        const int row0 = u.pm * BM + wr * 64 + fr, col0 = u.pn * BM + wc * 32 + 4 * fq, seg = u.pn >> 2;
        f32x4 bv[2][2];
#pragma unroll
        for (int bj = 0; bj < 2; ++bj)
#pragma unroll
            for (int n = 0; n < 2; ++n) { const int c = col0 + bj * HALF + n * 16;
                bv[bj][n] = seg == 0 ? *(const f32x4*)(w0 + c) : (seg == 1 ? *(const f32x4*)(a0 + (c - 1024)) : (f32x4){0.f, 0.f, 0.f, 0.f}); }
#pragma unroll
        for (int ai = 0; ai < 2; ++ai)
#pragma unroll
            for (int m = 0; m < 4; ++m) { const size_t r = (size_t)(row0 + ai * HALF + m * 16);
#pragma unroll
                for (int bj = 0; bj < 2; ++bj)
#pragma unroll
                    for (int n = 0; n < 2; ++n) { f32x4 v = acc[ai][bj][m][n] + bv[bj][n]; const int c = col0 + bj * HALF + n * 16;
                        if (seg == 0) {
#pragma unroll
                            for (int j = 0; j < 4; ++j) v[j] = -0.6065306597126334f * sigm(v[j]);
                            *(f32x4*)(WLD + r * RD + c) = v; }
                        else { if (seg == 1) {
#pragma unroll
                                for (int j = 0; j < 4; ++j) v[j] = sigm(v[j]); }
                            v2u o; o.x = pk2(v[0], v[1]); o.y = pk2(v[2], v[3]); *(v2u*)(AG + r * D + (c - 1024)) = o; } } }
    }
};
struct EpiGateA {
    static constexpr bool PERM = true, AFTER_DRAIN = false;
    bf16* TMP; const bf16* P; const float* bg;
    __device__ __forceinline__ void operator()(const f32x4 (&acc)[2][2][4][2], const Unit& u, int wr, int wc, int fr, int fq) const {
        const int row0 = u.pm * BM + wr * 64 + fr, col0 = u.pn * BM + wc * 32 + 8 * fq;
#pragma unroll
        for (int ai = 0; ai < 2; ++ai)
#pragma unroll
            for (int m = 0; m < 4; ++m) { const size_t r = (size_t)(row0 + ai * HALF + m * 16);
#pragma unroll
                for (int bj = 0; bj < 2; ++bj) { const int c = col0 + bj * HALF;
                    const v4u pg = *(const v4u*)(P + r * NINP + GTO + c); const f32x4 b0 = *(const f32x4*)(bg + c), b1 = *(const f32x4*)(bg + c + 4);
                    f32x4 g0, g1;
                    g0[0] = sigm(__uint_as_float(pg.x << 16) + b0[0]); g0[1] = sigm(__uint_as_float(pg.x & 0xffff0000u) + b0[1]);
                    g0[2] = sigm(__uint_as_float(pg.y << 16) + b0[2]); g0[3] = sigm(__uint_as_float(pg.y & 0xffff0000u) + b0[3]);
                    g1[0] = sigm(__uint_as_float(pg.z << 16) + b1[0]); g1[1] = sigm(__uint_as_float(pg.z & 0xffff0000u) + b1[1]);
                    g1[2] = sigm(__uint_as_float(pg.w << 16) + b1[2]); g1[3] = sigm(__uint_as_float(pg.w & 0xffff0000u) + b1[3]);
                    const f32x4 t0 = g0 * acc[ai][bj][m][0], t1 = g1 * acc[ai][bj][m][1]; v4u tw; tw.x = pk2(t0[0], t0[1]); tw.y = pk2(t0[2], t0[3]); tw.z = pk2(t1[0], t1[1]); tw.w = pk2(t1[2], t1[3]);
                    *(v4u*)(TMP + r * D + c) = tw; } }
    }
};
struct EpiGateB {
    static constexpr bool PERM = true, AFTER_DRAIN = false;
    const bf16* TMP; bf16* MRG; const bf16* P; const float* bg;
    __device__ __forceinline__ void operator()(const f32x4 (&acc)[2][2][4][2], const Unit& u, int wr, int wc, int fr, int fq) const {
        const int row0 = u.pm * BM + wr * 64 + fr, col0 = u.pn * BM + wc * 32 + 8 * fq;
#pragma unroll
        for (int ai = 0; ai < 2; ++ai)
#pragma unroll
            for (int m = 0; m < 4; ++m) { const size_t r = (size_t)(row0 + ai * HALF + m * 16);
#pragma unroll
                for (int bj = 0; bj < 2; ++bj) { const int c = col0 + bj * HALF;
                    const v4u pg = *(const v4u*)(P + r * NINP + GTO + D + c); const f32x4 b0 = *(const f32x4*)(bg + D + c), b1 = *(const f32x4*)(bg + D + c + 4);
                    const v4u tw = *(const v4u*)(TMP + r * D + c); const f32x4 t0 = (f32x4){__uint_as_float(tw.x << 16), __uint_as_float(tw.x & 0xffff0000u), __uint_as_float(tw.y << 16), __uint_as_float(tw.y & 0xffff0000u)}, t1 = (f32x4){__uint_as_float(tw.z << 16), __uint_as_float(tw.z & 0xffff0000u), __uint_as_float(tw.w << 16), __uint_as_float(tw.w & 0xffff0000u)};
                    f32x4 g0, g1;
                    g0[0] = sigm(__uint_as_float(pg.x << 16) + b0[0]); g0[1] = sigm(__uint_as_float(pg.x & 0xffff0000u) + b0[1]);
                    g0[2] = sigm(__uint_as_float(pg.y << 16) + b0[2]); g0[3] = sigm(__uint_as_float(pg.y & 0xffff0000u) + b0[3]);
                    g1[0] = sigm(__uint_as_float(pg.z << 16) + b1[0]); g1[1] = sigm(__uint_as_float(pg.z & 0xffff0000u) + b1[1]);
                    g1[2] = sigm(__uint_as_float(pg.w << 16) + b1[2]); g1[3] = sigm(__uint_as_float(pg.w & 0xffff0000u) + b1[3]);
                    const f32x4 v0 = t0 + g0 * acc[ai][bj][m][0], v1 = t1 + g1 * acc[ai][bj][m][1];
                    v4u w; w.x = pg8::cvt_pk_bf16(v0[0], v0[1]); w.y = pg8::cvt_pk_bf16(v0[2], v0[3]); w.z = pg8::cvt_pk_bf16(v1[0], v1[1]); w.w = pg8::cvt_pk_bf16(v1[2], v1[3]);
                    *(v4u*)(MRG + r * D + c) = w; } }
    }
};
struct EpiResid {
    static constexpr bool PERM = true, AFTER_DRAIN = false;
    const float* X; bf16* O;
    __device__ __forceinline__ void operator()(const f32x4 (&acc)[2][2][4][2], const Unit& u, int wr, int wc, int fr, int fq) const {
        const int row0 = u.pm * BM + wr * 64 + fr, col0 = u.pn * BM + wc * 32 + 8 * fq;
#pragma unroll
        for (int ai = 0; ai < 2; ++ai)
#pragma unroll
            for (int m = 0; m < 4; ++m) { const size_t off = (size_t)(row0 + ai * HALF + m * 16) * D + col0;
#pragma unroll
                for (int bj = 0; bj < 2; ++bj) { const f32x4 v0 = *(const f32x4*)(X + off + bj * HALF) + acc[ai][bj][m][0], v1 = *(const f32x4*)(X + off + bj * HALF + 4) + acc[ai][bj][m][1];
                    v4u w; w.x = pk2(v0[0], v0[1]); w.y = pk2(v0[2], v0[3]); w.z = pk2(v1[0], v1[1]); w.w = pk2(v1[2], v1[3]);
                    *(v4u*)(O + off + bj * HALF) = w; } }
    }
};
struct MoeOrder : pg8::StaticOrder {
    const LAS int* tile_e; size_t estride;
    __device__ __forceinline__ size_t b_off(const Unit& u, size_t tstep) const { return (size_t)tile_e[u.pm] * estride + (size_t)u.pn * tstep; }
};
struct MoeGatherOrder : MoeOrder {
    static constexpr bool GATHER = true;
    const LAS int* tile_i0; const LAS int* cnt; const int* rlist; LAS unsigned* rowoff; unsigned rowbytes;
    __device__ __forceinline__ size_t a_off(const Unit&, size_t) const { return 0; }
    __device__ __forceinline__ void fill_all() const { const int tid = threadIdx.x, r = tid & 255;
        for (int u0 = tid >> 8; ; u0 += 6) { Unit ua, ub, uc; const bool va = next(u0, ua), vb = next(u0 + 2, ub), vc = next(u0 + 4, uc); if (!va) break;
            int ta = 0, tb = 0, tc = 0;
            { const int e = tile_e[ua.pm], i = tile_i0[ua.pm] + r; if (i < cnt[e]) ta = rlist[e * ECAP + i]; }
            if (vb) { const int e = tile_e[ub.pm], i = tile_i0[ub.pm] + r; if (i < cnt[e]) tb = rlist[e * ECAP + i]; }
            if (vc) { const int e = tile_e[uc.pm], i = tile_i0[uc.pm] + r; if (i < cnt[e]) tc = rlist[e * ECAP + i]; }
            rowoff[u0 * 256 + r] = (unsigned)(ta >> 2) * rowbytes; if (vb) rowoff[(u0 + 2) * 256 + r] = (unsigned)(tb >> 2) * rowbytes; if (vc) rowoff[(u0 + 4) * 256 + r] = (unsigned)(tc >> 2) * rowbytes; } }
    __device__ __forceinline__ unsigned row_off(int ui, int r) const { return rowoff[ui * 256 + r]; }
};
struct EpiSwiGLU {
    static constexpr bool PERM = true, AFTER_DRAIN = false;
    unsigned char* ACT; const float* bgu; const LAS int* tile_e;
    __device__ __forceinline__ void operator()(const f32x4 (&acc)[2][2][4][2], const Unit& u, int wr, int wc, int fr, int fq) const {
        const int row0 = u.pm * BM + wr * 64 + fr, colg = u.pn * 128 + wc * 32 + 8 * fq; const int e = tile_e[u.pm];
        const float* bp = bgu + (size_t)e * 4096 + colg;
        const f32x4 bg0 = *(const f32x4*)(bp), bg1 = *(const f32x4*)(bp + 4), bu0 = *(const f32x4*)(bp + 2048), bu1 = *(const f32x4*)(bp + 2052);
#pragma unroll
        for (int ai = 0; ai < 2; ++ai)
#pragma unroll
            for (int m = 0; m < 4; ++m) { const size_t r = (size_t)(row0 + ai * HALF + m * 16);
                constexpr float DS = 1.f / (F8_SX * F8_SW);
                const f32x4 ga = acc[ai][0][m][0] * DS + bg0, gb = acc[ai][0][m][1] * DS + bg1, ua = acc[ai][1][m][0] * DS + bu0, ub = acc[ai][1][m][1] * DS + bu1;
                float o[8];
#pragma unroll
                for (int j = 0; j < 4; ++j) { const float g = fminf(ga[j], 7.f), up = fminf(fmaxf(ua[j], -7.f), 7.f); o[j] = F8_SA * (up + 1.f) * g * sigm(1.702f * g);
                                              const float g2 = fminf(gb[j], 7.f), up2 = fminf(fmaxf(ub[j], -7.f), 7.f); o[4 + j] = F8_SA * (up2 + 1.f) * g2 * sigm(1.702f * g2); }
                v2u w; w.x = pk4f8(o[0], o[1], o[2], o[3]); w.y = pk4f8(o[4], o[5], o[6], o[7]);
                *(v2u*)(ACT + r * FF + colg) = w; }
    }
};
struct EpiDown {
    static constexpr bool PERM = true, AFTER_DRAIN = false;
    unsigned char* YS; const float* bdn; const LAS int* tile_e; const LAS int* rowdst; const LAS float* rowwt;
    __device__ __forceinline__ void operator()(const f32x4 (&acc)[2][2][4][2], const Unit& u, int wr, int wc, int fr, int fq) const {
        const int e = tile_e[u.pm]; const int col0 = u.pn * BM + wc * 32 + 8 * fq;
        const float* bp = bdn + (size_t)e * D + col0; constexpr float DS = 1.f / (F8_SA * F8_SW);
#pragma unroll
        for (int bj = 0; bj < 2; ++bj) { const f32x4 b0 = *(const f32x4*)(bp + bj * HALF), b1 = *(const f32x4*)(bp + bj * HALF + 4);
#pragma unroll
            for (int ai = 0; ai < 2; ++ai)
#pragma unroll
                for (int m = 0; m < 4; ++m) { const int r = u.ord * 256 + ai * HALF + wr * 64 + m * 16 + fr;
                    const int dst = rowdst[r]; const float w = rowwt[r];
                    const f32x4 v0 = (acc[ai][bj][m][0] * DS + b0) * (w * F8_SY), v1 = (acc[ai][bj][m][1] * DS + b1) * (w * F8_SY);
                    v2u o; o.x = pk4f8(v0[0], v0[1], v0[2], v0[3]); o.y = pk4f8(v1[0], v1[1], v1[2], v1[3]);
                    *(v2u*)(YS + (size_t)dst * D + col0 + bj * HALF) = o; } }
    }
};
template <class Sched> __device__ __forceinline__ void fill_down_tables(Frame& F, const Sched& S, LAS int* rowdst, LAS float* rowwt) {
    const LAS int* MI = (const LAS int*)F.MISC; const int* rlist = (const int*)(F.ws + WS_RLIST); const float* rw = (const float*)(F.ws + WS_RW);
    const int r = F.tid & 255;
    for (int u0 = F.tid >> 8; ; u0 += 4) { Unit ua, ub; const bool va = S.next(u0, ua), vb = S.next(u0 + 2, ub); if (!va) break;
        int da = T * 4, db = T * 4; float wa = 0.f, wb = 0.f;
        { const int e = MI[MI_TILE_E + ua.pm], i = MI[MI_TILE_I0 + ua.pm] + r; if (i < MI[MI_CNT + e]) { da = rlist[e * ECAP + i]; wa = rw[e * ECAP + i]; } }
        if (vb) { const int e = MI[MI_TILE_E + ub.pm], i = MI[MI_TILE_I0 + ub.pm] + r; if (i < MI[MI_CNT + e]) { db = rlist[e * ECAP + i]; wb = rw[e * ECAP + i]; } }
        rowdst[u0 * 256 + r] = da; rowwt[u0 * 256 + r] = wa; if (vb) { rowdst[(u0 + 2) * 256 + r] = db; rowwt[(u0 + 2) * 256 + r] = wb; } }
    __syncthreads();
}

__device__ __forceinline__ void transpose_item(const float* __restrict__ W, int N, int k0, int n0, bf16* WT, int dst_row0, int ldk, LAS float* scr, int lane) {
    const int n = n0 + (lane & 31); const bool ok = n < N;
#pragma unroll 8
    for (int i = 0; i < 32; ++i) { const int kk = 2 * i + (lane >> 5); scr[kk * 33 + (lane & 31)] = ok ? W[(size_t)(k0 + kk) * N + n] : 0.f; }
    LDS_WAIT(); asm volatile("" ::: "memory");
    const int c = lane & 7;
#pragma unroll
    for (int j = 0; j < 4; ++j) { const int nn = (lane >> 3) + 8 * j; const LAS float* s = scr + (8 * c) * 33 + nn;
        v4u o; o.x = pk2(s[0 * 33], s[1 * 33]); o.y = pk2(s[2 * 33], s[3 * 33]); o.z = pk2(s[4 * 33], s[5 * 33]); o.w = pk2(s[6 * 33], s[7 * 33]);
        *(v4u*)(WT + (size_t)(dst_row0 + nn) * ldk + k0 + 8 * c) = o; }
    LDS_WAIT(); asm volatile("" ::: "memory");
}
__device__ __forceinline__ void transpose_item_i8(const float* __restrict__ W, int N, int k0, int n0, unsigned char* WT, int dst_row0, int ldk, const unsigned* colmax, LAS float* scr, int lane) {
    const int n = n0 + (lane & 31); const bool ok = n < N;
#pragma unroll 8
    for (int i = 0; i < 32; ++i) { const int kk = 2 * i + (lane >> 5); scr[kk * 33 + (lane & 31)] = ok ? W[(size_t)(k0 + kk) * N + n] : 0.f; }
    LDS_WAIT(); asm volatile("" ::: "memory");
#pragma unroll
    for (int j = 0; j < 2; ++j) { const int ch = lane + 64 * j, nn = ch >> 2, c = ch & 3; const LAS float* s = scr + (16 * c) * 33 + nn;
        const float cm = __uint_as_float(colmax[n0 + nn]); const float sc = cm > 0.f ? 127.f / cm : 0.f;
        v4u o; o.x = pk4i8(s[0 * 33] * sc, s[1 * 33] * sc, s[2 * 33] * sc, s[3 * 33] * sc); o.y = pk4i8(s[4 * 33] * sc, s[5 * 33] * sc, s[6 * 33] * sc, s[7 * 33] * sc);
        o.z = pk4i8(s[8 * 33] * sc, s[9 * 33] * sc, s[10 * 33] * sc, s[11 * 33] * sc); o.w = pk4i8(s[12 * 33] * sc, s[13 * 33] * sc, s[14 * 33] * sc, s[15 * 33] * sc);
        *(v4u*)(WT + (size_t)(dst_row0 + nn) * ldk + k0 + 16 * c) = o; }
    LDS_WAIT(); asm volatile("" ::: "memory");
}
__device__ __forceinline__ void p0b_win(Frame& F) {
    LAS float* scr = (LAS float*)(F.lds + F.wave * 16384);
    const int gw = F.bid * NWAVES + F.wave, NGW = F.G * NWAVES; unsigned char* WIN8 = F.ws + WS_WIN; const unsigned* colmax = F.ctl + CW_COLMAX;
    constexpr int NB_WIN = (NIN + 31) / 32;
    for (int it = gw; it < 32 * NB_WIN; it += NGW) { const int kb = it / NB_WIN, nb = it % NB_WIN; transpose_item_i8(F.in[I_WIN], NIN, kb * 64, nb * 32, WIN8, nb * 32, D, colmax, scr, F.lane); }
    { const int gt = F.bid * NTHR + F.tid, NGT = F.G * NTHR; constexpr int Z0 = NB_WIN * 32 * D, Z1 = NINP * D;
      for (int i = Z0 + gt * 16; i < Z1; i += NGT * 16) *(v4u*)(WIN8 + i) = (v4u){0u, 0u, 0u, 0u}; }
}
__device__ __forceinline__ void p0_prologue(Frame& F) {
    LAS float* scr = (LAS float*)(F.lds + F.wave * 16384);
    const int gw = F.bid * NWAVES + F.wave, NGW = F.G * NWAVES;
    bf16* WIN_T = (bf16*)(F.ws + WS_WIN); bf16* WA_T = (bf16*)(F.ws + WS_WA); bf16* WB_T = (bf16*)(F.ws + WS_WB); bf16* WO_T = (bf16*)(F.ws + WS_WO);
    bf16* WGU_T = (bf16*)(F.ws + WS_WGU); bf16* WDN_T = (bf16*)(F.ws + WS_WDN); bf16* WL_T = (bf16*)(F.ws + WS_WL); bf16* HN = (bf16*)(F.ws + WS_HN);
    { const float* W = F.in[I_WIN]; unsigned* colmax = F.ctl + CW_COLMAX;
      for (int task = gw; task < 168 * 16; task += NGW) { const int cb = task % 168, kc = task / 168, n = cb * 64 + F.lane; float m = 0.f;
          if (n < NIN) { const float* wp = W + (size_t)(kc * 128) * NIN + n;
#pragma unroll 1
              for (int k0 = 0; k0 < 128; k0 += 32) { float v[32];
#pragma unroll
                  for (int i = 0; i < 32; ++i) v[i] = wp[(size_t)(k0 + i) * NIN];
#pragma unroll
                  for (int i = 0; i < 32; ++i) m = fmaxf(m, fabsf(v[i])); }
              atomicMax(colmax + n, __float_as_uint(m)); } } }
    { const int gt = F.bid * NTHR + F.tid, NGT = F.G * NTHR;
      for (int i = gt; i < 3072 * 512; i += NGT) { const int n = i >> 9, k = i & 511; float v = 0.f;
          if (n < 1024) { if (k < 96) v = F.in[I_WUP][k * RD + n]; }
          else if (n < 2048) { if (k >= 128 && k < 224) v = F.in[I_AUP][(k - 128) * RD + (n - 1024)]; }
          else { if (k >= 256) v = F.in[I_GUP][(k - 256) * RD + (n - 2048)]; }
          WL_T[i] = (bf16)f2bf(v); } }
    { const int gt = F.bid * NTHR + F.tid, NGT = F.G * NTHR; float* RWS = (float*)(F.ws + WS_RWS);
      for (int i = gt; i < D * NE; i += NGT) RWS[i] = F.in[I_N2W][i >> 5] * F.in[I_RTW][i]; }
    const float* x = F.in[I_X]; const float* nw = F.in[I_N1W];
    for (int m = gw; m < T; m += NGW) {
        const f32x4* xr = (const f32x4*)(x + (size_t)m * D) + F.lane; f32x4 v[8]; float s = 0.f;
#pragma unroll
        for (int j = 0; j < 8; ++j) { v[j] = xr[64 * j]; s += (v[j][0] * v[j][0] + v[j][1] * v[j][1]) + (v[j][2] * v[j][2] + v[j][3] * v[j][3]); }
        const float rstd = __builtin_amdgcn_rsqf(wave_sum(s) * (1.f / D) + NORM_EPS);
        float am = 0.f;
#pragma unroll
        for (int j = 0; j < 8; ++j) { const f32x4 w = ((const f32x4*)nw)[F.lane + 64 * j]; v[j] = v[j] * rstd * w; am = fmaxf(fmaxf(am, fmaxf(fabsf(v[j][0]), fabsf(v[j][1]))), fmaxf(fabsf(v[j][2]), fabsf(v[j][3]))); }
        am = wave_max(am); const float sc = am > 0.f ? 127.f / am : 0.f;
        if (F.lane == 0) ((float*)(F.ws + WS_RA))[m] = am * (1.f / 127.f);
        unsigned* o4 = (unsigned*)((unsigned char*)HN + (size_t)m * D) + F.lane;
#pragma unroll
        for (int j = 0; j < 8; ++j) o4[64 * j] = pk4i8(v[j][0] * sc, v[j][1] * sc, v[j][2] * sc, v[j][3] * sc);
    }
}

__device__ __forceinline__ void p2_lora_in(Frame& F) {
    const bf16* __restrict__ P = (const bf16*)(F.ws + WS_P); bf16* __restrict__ LIN = (bf16*)(F.ws + WS_LIN); const float* __restrict__ mu = F.in[I_MU];
    const int gt = F.bid * NTHR + F.tid, NGT = F.G * NTHR;
#pragma unroll 2
    for (int i = gt; i < T * 64; i += NGT) { const int t = i >> 6, g = i & 63; int col = -1, kind = 0;
        if (g < 12) { col = 3072 + 8 * g; kind = 0; } else if (g >= 16 && g < 28) { col = 3168 + 8 * (g - 16); kind = 1; } else if (g >= 32) { col = 3264 + 8 * (g - 32); kind = 2; }
        v4u o = (v4u){0u, 0u, 0u, 0u};
        if (col >= 0) { const v4u pc = *(const v4u*)(P + (size_t)t * NINP + col); v4u pp = (v4u){0u, 0u, 0u, 0u}; if (t & (SEQ - 1)) pp = *(const v4u*)(P + (size_t)(t - 1) * NINP + col);
            const f32x4 m0 = *(const f32x4*)(mu + col), m1 = *(const f32x4*)(mu + col + 4);
            const unsigned pcs[4] = {pc.x, pc.y, pc.z, pc.w}, pps[4] = {pp.x, pp.y, pp.z, pp.w}; float x[8];
#pragma unroll
            for (int k = 0; k < 4; ++k) { const float c0 = __uint_as_float(pcs[k] << 16), c1 = __uint_as_float(pcs[k] & 0xffff0000u), q0 = __uint_as_float(pps[k] << 16), q1 = __uint_as_float(pps[k] & 0xffff0000u);
                const float ma = k < 2 ? m0[2 * k] : m1[2 * k - 4], mb = k < 2 ? m0[2 * k + 1] : m1[2 * k - 3];
                x[2 * k] = c0 + (q0 - c0) * ma; x[2 * k + 1] = c1 + (q1 - c1) * mb; }
#pragma unroll
            for (int k = 0; k < 8; ++k) x[k] = kind == 0 ? tanhf(x[k]) : (kind == 1 ? x[k] : sigm(x[k]));
            o.x = pk2(x[0], x[1]); o.y = pk2(x[2], x[3]); o.z = pk2(x[4], x[5]); o.w = pk2(x[6], x[7]); }
        *(v4u*)(LIN + (size_t)t * 512 + 8 * g) = o; }
    { bf16* __restrict__ QKC = (bf16*)(F.ws + WS_QKC); const float* __restrict__ cw = F.in[I_CONVW];
      for (int i = gt; i < T * 128; i += NGT) { const int t = i >> 7, c0 = 8 * (i & 127); const int sq = t & (SEQ - 1); float acc[8];
#pragma unroll
          for (int k = 0; k < 8; ++k) acc[k] = 0.f;
#pragma unroll
          for (int j = 0; j < 4; ++j) { if (sq - 3 + j >= 0) { const v4u pv = *(const v4u*)(P + (size_t)(t - 3 + j) * NINP + MLO + c0); const f32x4 w0 = *(const f32x4*)(cw + j * 1024 + c0), w1 = *(const f32x4*)(cw + j * 1024 + c0 + 4);
                  acc[0] += __uint_as_float(pv.x << 16) * w0[0]; acc[1] += __uint_as_float(pv.x & 0xffff0000u) * w0[1]; acc[2] += __uint_as_float(pv.y << 16) * w0[2]; acc[3] += __uint_as_float(pv.y & 0xffff0000u) * w0[3];
                  acc[4] += __uint_as_float(pv.z << 16) * w1[0]; acc[5] += __uint_as_float(pv.z & 0xffff0000u) * w1[1]; acc[6] += __uint_as_float(pv.w << 16) * w1[2]; acc[7] += __uint_as_float(pv.w & 0xffff0000u) * w1[3]; } }
          const float sc = c0 < 512 ? 0.08838834764831845f : 1.f;
#pragma unroll
          for (int k = 0; k < 8; ++k) acc[k] = acc[k] * sigm(acc[k]) * sc;
          v4u o; o.x = pk2(acc[0], acc[1]); o.y = pk2(acc[2], acc[3]); o.z = pk2(acc[4], acc[5]); o.w = pk2(acc[6], acc[7]); *(v4u*)(QKC + (size_t)t * 1024 + c0) = o; } }
    { float* __restrict__ GLF = (float*)(F.ws + WS_GLF); const int gw = F.bid * NWAVES + F.wave, NGW = F.G * NWAVES, lane = F.lane;
      for (int q = gw; q < (T / 64) * 4; q += NGW) { const int chk = q >> 2, mh = q & 3; const size_t t = (size_t)chk * 64 + lane; const bf16* pr = P + t * NINP + MLO + 2048;
          const float ip = 15.f * tanhf((bf2f(pr[mh]) + F.in[I_IB][mh]) * (1.f / 15.f)), fp = 15.f * tanhf((bf2f(pr[4 + mh]) + F.in[I_FB][mh]) * (1.f / 15.f));
          float bc = fminf(fp, 0.f) - log1pf(__expf(-fabsf(fp)));
#pragma unroll
          for (int o = 1; o < 64; o <<= 1) { const float t_ = __shfl_up(bc, o); if (lane >= o) bc += t_; }
          const float u = ip - bc; float pm = u;
#pragma unroll
          for (int o = 1; o < 64; o <<= 1) { const float t_ = __shfl_up(pm, o); if (lane >= o) pm = fmaxf(pm, t_); }
          *(f32x4*)(GLF + t * 16 + 4 * mh) = (f32x4){bc, u, pm, 0.f}; } }
}

typedef short s16x8 __attribute__((ext_vector_type(8)));
typedef short s16x4 __attribute__((ext_vector_type(4)));
__device__ __forceinline__ unsigned long long pack4bf(f32x4 v) { return (unsigned long long)pk2(v[0], v[1]) | ((unsigned long long)pk2(v[2], v[3]) << 32); }
__device__ __forceinline__ s16x8 tr_frag(const LAS bf16* img, int stride, int r0, int c0, int fr) {
    const LAS bf16* p0 = img + (r0 + (fr >> 2)) * stride + c0 + 4 * (fr & 3);
    const s16x4 lo = __builtin_bit_cast(s16x4, __builtin_amdgcn_ds_read_tr16_b64_v4i16((LAS s16x4*)p0));
    const s16x4 hi = __builtin_bit_cast(s16x4, __builtin_amdgcn_ds_read_tr16_b64_v4i16((LAS s16x4*)(p0 + 4 * stride)));
    return __builtin_shufflevector(lo, hi, 0, 1, 2, 3, 4, 5, 6, 7);
}

__device__ __forceinline__ void rw_bar(LAS unsigned* cnt, unsigned& target, int lane);
__device__ __forceinline__ void rwkv_chunk_unit(Frame& F, int unit, LAS unsigned char* regB, LAS unsigned* bcnt, unsigned& btarget) {
    const int b = unit >> 5, h = (unit >> 1) & 15, half = unit & 1;
    const bf16* P = (const bf16*)(F.ws + WS_P); const float* WAG = (const float*)(F.ws + WS_WAG); const bf16* AGp = (const bf16*)(F.ws + WS_WAG + 64 * MiB); float* YRAW = (float*)(F.ws + WS_YRAW);
    constexpr int KS = 72, LS = 40;
    LAS bf16* At = (LAS bf16*)F.lds; LAS bf16* Bt = At + 32 * KS; LAS bf16* Kt = Bt + 32 * KS; LAS bf16* Rt = Kt + 32 * KS;
    LAS bf16* Vv = Rt + 32 * KS;
    LAS bf16* Sb = Vv + 32 * LS;
    LAS bf16* G2b = Sb + 32 * KS; LAS bf16* G3b = G2b + 32 * LS; LAS bf16* G4b = G3b + 32 * LS;
    LAS bf16* Pwb = G4b + 32 * LS;
    LAS bf16* Acb = Pwb + 2 * 32 * LS;
    LAS bf16* RHt = (LAS bf16*)regB;
    LAS bf16* Ubt = RHt + 32 * LS;
    LAS float* lwf = (LAS float*)(Ubt + 32 * LS);
    LAS float* csf = lwf + 2048;
    LAS float* gtf = csf + 2048;
    LAS float* glf = gtf + 256;
    const int tid = F.tid, lane = F.lane, w = F.wave, fr = lane & 15, fq = lane >> 4;
    const int ts = tid >> 4, cs = tid & 15, c0 = h * 64 + 4 * cs;
    const int sk = tid & 63, sq = tid >> 6;
    const f32x4 mu_r = *(const f32x4*)(F.in[I_MU] + c0), mu_k = *(const f32x4*)(F.in[I_MU] + 1024 + c0), mu_v = *(const f32x4*)(F.in[I_MU] + 2048 + c0);
    const f32x4 kkc = *(const f32x4*)(F.in[I_KK] + c0), kac = *(const f32x4*)(F.in[I_KA] + c0), rkc = *(const f32x4*)(F.in[I_RK] + c0);
    bf16* BON = (bf16*)(F.ws + WS_WAG + 128 * MiB);
    for (int i = tid; i < 32 * KS; i += 256) Sb[i] = 0;
    v2u cr[2], ck[2], cv[2], qr[2], qk[2], qv[2]; f32x4 w4[2], a4[2];
#define RC_LOAD(ch) do { _Pragma("unroll") for (int p_ = 0; p_ < 2; ++p_) { const int t_ = (ch) * 32 + ts + 16 * p_; const size_t tk_ = (size_t)b * SEQ + t_; const bf16* pr_ = P + tk_ * NINP + c0; \
        cr[p_] = *(const v2u*)(pr_); ck[p_] = *(const v2u*)(pr_ + 1024); cv[p_] = *(const v2u*)(pr_ + 2048); \
        if (t_ > 0) { qr[p_] = *(const v2u*)(pr_ - NINP); qk[p_] = *(const v2u*)(pr_ - NINP + 1024); qv[p_] = *(const v2u*)(pr_ - NINP + 2048); } else { qr[p_] = (v2u){0u, 0u}; qk[p_] = qr[p_]; qv[p_] = qr[p_]; } \
        w4[p_] = *(const f32x4*)(WAG + tk_ * RD + c0); { const v2u ab_ = *(const v2u*)(AGp + tk_ * D + c0); a4[p_] = UNP4(ab_); } } } while (0)
    const int mi = w >> 1, nj = w & 1;
    f32x4 st[2]; st[0] = (f32x4){0.f, 0.f, 0.f, 0.f}; st[1] = st[0];
    RC_LOAD(0);
    rw_bar(bcnt, btarget, lane);
    for (int ch = 0; ch < SEQ / 32; ++ch) {
        f32x4 rr[2], kmod[2], vv[2], kkn[2], lw[2], al[2];
#pragma unroll
        for (int p_ = 0; p_ < 2; ++p_) { const f32x4 pr4 = UNP4(cr[p_]), pk4 = UNP4(ck[p_]), pv4 = UNP4(cv[p_]), qr4 = UNP4(qr[p_]), qk4 = UNP4(qk[p_]), qv4 = UNP4(qv[p_]); lw[p_] = w4[p_]; al[p_] = a4[p_];
            rr[p_] = pr4 + (qr4 - pr4) * mu_r; const f32x4 k1 = pk4 + (qk4 - pk4) * mu_k; vv[p_] = pv4 + (qv4 - pv4) * mu_v;
            const f32x4 kkr = k1 * kkc; const float nrm = __builtin_amdgcn_rsqf(fmaxf(allreduce16((kkr[0] * kkr[0] + kkr[1] * kkr[1]) + (kkr[2] * kkr[2] + kkr[3] * kkr[3])), 1e-24f));
            kkn[p_] = kkr * nrm; kmod[p_] = k1 * (1.f + (al[p_] - 1.f) * kac);
            { const f32x4 rk_ = rr[p_] * kmod[p_] * rkc; const float dot = allreduce16((rk_[0] + rk_[1]) + (rk_[2] + rk_[3]));
              if ((cs >> 3) == half) *(unsigned long long*)(BON + ((size_t)b * SEQ + ch * 32 + ts + 16 * p_) * RD + c0) = pack4bf(vv[p_] * dot); }
            *(LAS f32x4*)(lwf + (ts + 16 * p_) * 64 + 4 * cs) = lw[p_]; }
        if (ch + 1 < SEQ / 32) RC_LOAD(ch + 1);
        rw_bar(bcnt, btarget, lane);
        float cc[8];
#pragma unroll
        for (int i = 0; i < 8; ++i) cc[i] = lwf[(8 * sq + i) * 64 + sk] + (i ? cc[i - 1] : 0.f);
        gtf[sq * 64 + sk] = cc[7];
        rw_bar(bcnt, btarget, lane);
        { float off = 0.f;
#pragma unroll
          for (int q = 0; q < 3; ++q) off += (q < sq) ? gtf[q * 64 + sk] : 0.f;
#pragma unroll
          for (int i = 0; i < 8; ++i) csf[(8 * sq + i) * 64 + sk] = off + cc[i]; }
        rw_bar(bcnt, btarget, lane);
#pragma unroll
        for (int p_ = 0; p_ < 2; ++p_) { const int t = ts + 16 * p_; const f32x4 cg = *(const LAS f32x4*)(csf + t * 64 + 4 * cs); f32x4 g, gp, gi;
#pragma unroll
          for (int j = 0; j < 4; ++j) { g[j] = __expf(cg[j]); gp[j] = __expf(cg[j] - lw[p_][j]); gi[j] = __expf(-cg[j]); }
          *(LAS unsigned long long*)(At + t * KS + 4 * cs) = pack4bf(-(kkn[p_] * gp)); *(LAS unsigned long long*)(Bt + t * KS + 4 * cs) = pack4bf(kkn[p_] * al[p_] * gi);
          *(LAS unsigned long long*)(Kt + t * KS + 4 * cs) = pack4bf(kmod[p_] * gi); *(LAS unsigned long long*)(Rt + t * KS + 4 * cs) = pack4bf(rr[p_] * g);
          if ((cs >> 3) == half) *(LAS unsigned long long*)(Vv + t * LS + 4 * (cs & 7)) = pack4bf(vv[p_]);
          if (t == 31) *(LAS f32x4*)(glf + 4 * cs) = g; }
        rw_bar(bcnt, btarget, lane);
        f32x4 accT, pwT;
        { const int t = 16 * mi + fr, jb = 16 * nj + 4 * fq;
          f32x4 g1 = (f32x4){0.f, 0.f, 0.f, 0.f}, g2 = g1, g3 = g1, g4 = g1;
#pragma unroll
          for (int ks = 0; ks < 2; ++ks) { const s16x8 bj = *(const LAS s16x8*)(Bt + (16 * nj + fr) * KS + 32 * ks + 8 * fq), kj = *(const LAS s16x8*)(Kt + (16 * nj + fr) * KS + 32 * ks + 8 * fq);
              const s16x8 at = *(const LAS s16x8*)(At + (16 * mi + fr) * KS + 32 * ks + 8 * fq), rt = *(const LAS s16x8*)(Rt + (16 * mi + fr) * KS + 32 * ks + 8 * fq);
              g1 = __builtin_amdgcn_mfma_f32_16x16x32_bf16(bj, at, g1, 0, 0, 0); g2 = __builtin_amdgcn_mfma_f32_16x16x32_bf16(kj, at, g2, 0, 0, 0);
              g3 = __builtin_amdgcn_mfma_f32_16x16x32_bf16(bj, rt, g3, 0, 0, 0); g4 = __builtin_amdgcn_mfma_f32_16x16x32_bf16(kj, rt, g4, 0, 0, 0); }
#pragma unroll
          for (int rg_ = 0; rg_ < 4; ++rg_) { const int j = jb + rg_; g1[rg_] = (j < t) ? g1[rg_] : 0.f; g2[rg_] = (j < t) ? g2[rg_] : 0.f; g3[rg_] = (j <= t) ? g3[rg_] : 0.f; g4[rg_] = (j <= t) ? g4[rg_] : 0.f; }
          pwT = g1; *(LAS unsigned long long*)(Pwb + t * LS + jb) = pack4bf(g1);
#pragma unroll
          for (int rg_ = 0; rg_ < 4; ++rg_) accT[rg_] = g1[rg_] + ((jb + rg_ == t) ? 1.f : 0.f);
          *(LAS unsigned long long*)(Acb + 32 * LS + t * LS + jb) = pack4bf(accT);
          *(LAS unsigned long long*)(G2b + t * LS + jb) = pack4bf(g2); *(LAS unsigned long long*)(G3b + t * LS + jb) = pack4bf(g3); *(LAS unsigned long long*)(G4b + t * LS + jb) = pack4bf(g4); }
        rw_bar(bcnt, btarget, lane);
        f32x4 yv = (f32x4){0.f, 0.f, 0.f, 0.f};
#pragma unroll
        for (int s = 0; s < 5; ++s) { const LAS bf16* Pr = Pwb + (s & 1) * 32 * LS; LAS bf16* Pn = Pwb + ((s + 1) & 1) * 32 * LS; const LAS bf16* Ar = Acb + (s & 1) * 32 * LS; LAS bf16* An = Acb + ((s + 1) & 1) * 32 * LS;
            const s16x8 xrow = *(const LAS s16x8*)(Pr + (16 * mi + fr) * LS + 8 * fq);
            if (s < 4) { f32x4 z = (f32x4){0.f, 0.f, 0.f, 0.f}; z = __builtin_amdgcn_mfma_f32_16x16x32_bf16(tr_frag(Pr, LS, 8 * fq, 16 * nj, fr), xrow, z, 0, 0, 0);
                         *(LAS unsigned long long*)(Pn + (16 * mi + fr) * LS + 16 * nj + 4 * fq) = pack4bf(z); }
            if (s >= 1) { accT = __builtin_amdgcn_mfma_f32_16x16x32_bf16(tr_frag(Ar, LS, 8 * fq, 16 * nj, fr), xrow, accT, 0, 0, 0);
                          *(LAS unsigned long long*)(An + (16 * mi + fr) * LS + 16 * nj + 4 * fq) = pack4bf(accT); }
            if (s == 0) {
                f32x4 z = (f32x4){0.f, 0.f, 0.f, 0.f};
#pragma unroll
                for (int ks = 0; ks < 2; ++ks) { const s16x8 sb = *(const LAS s16x8*)(Sb + (16 * nj + fr) * KS + 32 * ks + 8 * fq);
                    z = __builtin_amdgcn_mfma_f32_16x16x32_bf16(*(const LAS s16x8*)(At + (16 * mi + fr) * KS + 32 * ks + 8 * fq), sb, z, 0, 0, 0);
                    yv = __builtin_amdgcn_mfma_f32_16x16x32_bf16(*(const LAS s16x8*)(Rt + (16 * mi + fr) * KS + 32 * ks + 8 * fq), sb, yv, 0, 0, 0); }
                const s16x8 vt_ = tr_frag(Vv, LS, 8 * fq, 16 * nj, fr);
                z = __builtin_amdgcn_mfma_f32_16x16x32_bf16(*(const LAS s16x8*)(G2b + (16 * mi + fr) * LS + 8 * fq), vt_, z, 0, 0, 0);
                yv = __builtin_amdgcn_mfma_f32_16x16x32_bf16(*(const LAS s16x8*)(G4b + (16 * mi + fr) * LS + 8 * fq), vt_, yv, 0, 0, 0);
                *(LAS unsigned long long*)(RHt + (16 * nj + fr) * LS + 16 * mi + 4 * fq) = pack4bf(z); }
            rw_bar(bcnt, btarget, lane); }
        { f32x4 z = (f32x4){0.f, 0.f, 0.f, 0.f};
          z = __builtin_amdgcn_mfma_f32_16x16x32_bf16(*(const LAS s16x8*)(Acb + 32 * LS + (16 * mi + fr) * LS + 8 * fq), *(const LAS s16x8*)(RHt + (16 * nj + fr) * LS + 8 * fq), z, 0, 0, 0);
          *(LAS unsigned long long*)(Ubt + (16 * nj + fr) * LS + 16 * mi + 4 * fq) = pack4bf(z); }
        rw_bar(bcnt, btarget, lane);
        { yv = __builtin_amdgcn_mfma_f32_16x16x32_bf16(*(const LAS s16x8*)(G3b + (16 * mi + fr) * LS + 8 * fq), *(const LAS s16x8*)(Ubt + (16 * nj + fr) * LS + 8 * fq), yv, 0, 0, 0);
          float* yp = YRAW + ((size_t)b * SEQ + ch * 32 + 16 * mi + 4 * fq) * RD + h * 64 + half * 32 + 16 * nj + fr;
#pragma unroll
          for (int rg_ = 0; rg_ < 4; ++rg_) yp[(size_t)rg_ * RD] = yv[rg_]; }
        { const int kt = w; const s16x8 bt_ = tr_frag(Bt, KS, 8 * fq, 16 * kt, fr), kt_ = tr_frag(Kt, KS, 8 * fq, 16 * kt, fr); const f32x4 gl4 = *(const LAS f32x4*)(glf + 16 * kt + 4 * fq);
#pragma unroll
          for (int vt = 0; vt < 2; ++vt) {
              st[vt] = __builtin_amdgcn_mfma_f32_16x16x32_bf16(bt_, *(const LAS s16x8*)(Ubt + (16 * vt + fr) * LS + 8 * fq), st[vt], 0, 0, 0);
              st[vt] = __builtin_amdgcn_mfma_f32_16x16x32_bf16(kt_, tr_frag(Vv, LS, 8 * fq, 16 * vt, fr), st[vt], 0, 0, 0);
              st[vt] = st[vt] * gl4;
              *(LAS unsigned long long*)(Sb + (16 * vt + fr) * KS + 16 * kt + 4 * fq) = pack4bf(st[vt]); } }
        rw_bar(bcnt, btarget, lane);
    }
#undef RC_LOAD
}

__device__ __forceinline__ float allreduce8(float x) { x += dppf<0x141>(x); x += dppf<0xB1>(x); x += dppf<0x4E>(x); return x; }
__device__ __forceinline__ void rw_bar(LAS unsigned* cnt, unsigned& target, int lane) {
    asm volatile("s_waitcnt lgkmcnt(0)" ::: "memory");
    if (lane == 0) __hip_atomic_fetch_add(cnt, 1u, __ATOMIC_RELAXED, __HIP_MEMORY_SCOPE_WORKGROUP);
    target += 4u;
    while ((unsigned)__builtin_amdgcn_readfirstlane((int)__hip_atomic_load(cnt, __ATOMIC_RELAXED, __HIP_MEMORY_SCOPE_WORKGROUP)) < target) __builtin_amdgcn_s_sleep(1);
    asm volatile("" ::: "memory");
}
constexpr int CV_BR = 8 * 32, CV_WO = 16 * 32, CV_GU = NE * 16 * 64, CV_DN = NE * 16 * 32, CV_ITEMS = 2 * CV_BR + CV_WO + CV_GU + CV_DN;
struct CvItem { const float* src; unsigned char* dst; int N; int f8; };
__device__ __forceinline__ CvItem cv_decode(Frame& F, int it) {
    CvItem c; int r = it; const int lane = F.lane;
    if (r < CV_BR) { const int kb = r >> 5, nb = r & 31; c.src = F.in[I_WBA] + (size_t)(kb * 128) * D + nb * 64 + lane; c.dst = F.ws + WS_WA + ((size_t)(nb * 64 + lane) * RD + kb * 128) * 2; c.N = D; c.f8 = 0; return c; } r -= CV_BR;
    if (r < CV_BR) { const int kb = r >> 5, nb = r & 31; c.src = F.in[I_WBB] + (size_t)(kb * 128) * D + nb * 64 + lane; c.dst = F.ws + WS_WB + ((size_t)(nb * 64 + lane) * RD + kb * 128) * 2; c.N = D; c.f8 = 0; return c; } r -= CV_BR;
    if (r < CV_WO) { const int kb = r >> 5, nb = r & 31; c.src = F.in[I_WOUT] + (size_t)(kb * 128) * D + nb * 64 + lane; c.dst = F.ws + WS_WO + ((size_t)(nb * 64 + lane) * D + kb * 128) * 2; c.N = D; c.f8 = 0; return c; } r -= CV_WO;
    if (r < CV_GU) { const int e = r >> 10, q = r & 1023, kb = q >> 6, nb = q & 63, n0 = nb * 64;
        const int dr = n0 < FF ? ((n0 >> 7) * 256 + (n0 & 127)) : (((n0 - FF) >> 7) * 256 + 128 + ((n0 - FF) & 127));
        c.src = F.in[I_WGU] + (size_t)e * D * 2 * FF + (size_t)(kb * 128) * (2 * FF) + n0 + lane; c.dst = F.ws + WS_WGU + (size_t)e * 2 * FF * D + (size_t)(dr + lane) * D + kb * 128; c.N = 2 * FF; c.f8 = 1; return c; } r -= CV_GU;
    { const int e = r >> 9, q = r & 511, kb = q >> 5, nb = q & 31;
        c.src = F.in[I_WDN] + (size_t)e * FF * D + (size_t)(kb * 128) * D + nb * 64 + lane; c.dst = F.ws + WS_WDN + (size_t)e * D * FF + (size_t)(nb * 64 + lane) * FF + kb * 128; c.N = D; c.f8 = 1; }
    return c;
}
__device__ __forceinline__ void convert_item(Frame& F, int it);
__device__ __forceinline__ void convert_loop(Frame& F, unsigned* next, unsigned* p1done, unsigned ngemm) {
    for (;;) { unsigned b = 0xffffffffu;
        if (F.lane == 0) { if (!(p1done && __hip_atomic_load(p1done, __ATOMIC_RELAXED, __HIP_MEMORY_SCOPE_AGENT) >= ngemm)) b = __hip_atomic_fetch_add(next, 2u, __ATOMIC_RELAXED, __HIP_MEMORY_SCOPE_AGENT); }
        const unsigned base = (unsigned)__builtin_amdgcn_readfirstlane((int)b); if (base >= (unsigned)CV_ITEMS) break;
        for (int k = 0; k < 2; ++k) { const int it = (int)base + k; if (it < CV_ITEMS) convert_item(F, it); } }
}
__device__ __forceinline__ void convert_item(Frame& F, int i0) {
    { const CvItem c = cv_decode(F, i0);
        float x[128];
#pragma unroll
        for (int i = 0; i < 128; ++i) x[i] = c.src[(size_t)i * c.N];
        if (c.f8) {
#pragma unroll
            for (int q = 0; q < 8; ++q) { v4u o; o.x = pk4f8(x[16 * q + 0] * F8_SW, x[16 * q + 1] * F8_SW, x[16 * q + 2] * F8_SW, x[16 * q + 3] * F8_SW); o.y = pk4f8(x[16 * q + 4] * F8_SW, x[16 * q + 5] * F8_SW, x[16 * q + 6] * F8_SW, x[16 * q + 7] * F8_SW);
                o.z = pk4f8(x[16 * q + 8] * F8_SW, x[16 * q + 9] * F8_SW, x[16 * q + 10] * F8_SW, x[16 * q + 11] * F8_SW); o.w = pk4f8(x[16 * q + 12] * F8_SW, x[16 * q + 13] * F8_SW, x[16 * q + 14] * F8_SW, x[16 * q + 15] * F8_SW);
                *(v4u*)(c.dst + 16 * q) = o; } }
        else {
#pragma unroll
            for (int q = 0; q < 16; ++q) { v4u o; o.x = pk2(x[8 * q + 0], x[8 * q + 1]); o.y = pk2(x[8 * q + 2], x[8 * q + 3]); o.z = pk2(x[8 * q + 4], x[8 * q + 5]); o.w = pk2(x[8 * q + 6], x[8 * q + 7]);
                *(v4u*)(c.dst + 16 * q) = o; } } }
}

__device__ __forceinline__ void mlstm_scan_unit(Frame& F, int unit, LAS unsigned* bcnt, unsigned& btarget) {
    const int b = unit >> 5, mh = (unit >> 3) & 3, sl = unit & 7;
    const bf16* P = (const bf16*)(F.ws + WS_P); const bf16* QKC = (const bf16*)(F.ws + WS_QKC); const float* GLF = (const float*)(F.ws + WS_GLF); float* HRAW = (float*)(F.ws + WS_HRAW);
    constexpr int VS = 56;
    LAS bf16* Lq = (LAS bf16*)F.lds;
    LAS bf16* Lk = Lq + 64 * 136;
    LAS bf16* Lv = Lk + 64 * 136;
    LAS bf16* Lvs = Lv + 64 * VS;
    LAS bf16* LcT = Lvs + 64 * VS;
    LAS bf16* Ls = LcT + 2 * 48 * 136;
    LAS float* sb = (LAS float*)(Ls + 64 * 72); LAS float* su = sb + 64; LAS float* smx = su + 64; LAS float* swk = smx + 64;
    const int tid = F.tid, lane = F.lane, w = F.wave, fr = lane & 15, fq = lane >> 4;
    for (int i = tid; i < 2 * 48 * 136; i += 256) LcT[i] = 0;
    for (int i = tid; i < 64 * 16; i += 256) { const int j = i >> 4, c = 32 + (i & 15); Lv[j * VS + c] = (c == 32) ? (bf16)0x3F80 : (bf16)0; Lvs[j * VS + c] = 0; }
    const int pr0 = tid >> 4, pc = 8 * (tid & 15);
    v4u rq[4], rk[4], rv; f32x4 g3;
#define ML_LOAD(ch) do { const size_t tk0_ = (size_t)b * SEQ + (ch) * 64; \
        _Pragma("unroll") for (int i_ = 0; i_ < 4; ++i_) { const bf16* s_ = QKC + (tk0_ + pr0 + 16 * i_) * 1024 + mh * 128 + pc; rq[i_] = *(const v4u*)s_; rk[i_] = *(const v4u*)(s_ + 512); } \
        rv = *(const v4u*)(P + (tk0_ + (tid >> 2)) * NINP + MLO + 1024 + mh * 256 + sl * 32 + 8 * (tid & 3)); \
        g3 = *(const f32x4*)(GLF + (tk0_ + lane) * 16 + 4 * mh); } while (0)
    f32x4 st[2][3];
#pragma unroll
    for (int a = 0; a < 2; ++a)
#pragma unroll
        for (int n = 0; n < 3; ++n) st[a][n] = (f32x4){0.f, 0.f, 0.f, 0.f};
    float mstate = 0.f;
    ML_LOAD(0);
    rw_bar(bcnt, btarget, lane);
    for (int ch = 0; ch < SEQ / 64; ++ch) {
        const size_t tk0 = (size_t)b * SEQ + ch * 64;
        LAS bf16* cTc = LcT + (ch & 1) * 48 * 136; LAS bf16* cTn = LcT + ((ch + 1) & 1) * 48 * 136;
        float mnew, dec;
        { const float bc = g3[0], u = g3[1], pm = g3[2];
          const float gtot = __shfl(bc, 63), pmall = __shfl(pm, 63);
          mnew = gtot + fmaxf(mstate, pmall); dec = __expf(gtot + mstate - mnew);
          const float wk = __expf(u + gtot - mnew);
          sb[lane] = bc; su[lane] = u; smx[lane] = fmaxf(mstate, pm); swk[lane] = wk;
          if (w == 0) Lvs[lane * VS + 32] = (bf16)f2bf(wk); }
#pragma unroll
        for (int i = 0; i < 4; ++i) { *(LAS v4u*)(Lq + (pr0 + 16 * i) * 136 + pc) = rq[i]; *(LAS v4u*)(Lk + (pr0 + 16 * i) * 136 + pc) = rk[i]; }
        LDS_WAIT();
        { const int j = tid >> 2, d0 = 8 * (tid & 3); const float wkj = swk[j]; *(LAS v4u*)(Lv + j * VS + d0) = rv;
          const unsigned uu[4] = {rv.x, rv.y, rv.z, rv.w}; v4u sv;
          sv.x = pk2(wkj * __uint_as_float(uu[0] << 16), wkj * __uint_as_float(uu[0] & 0xffff0000u)); sv.y = pk2(wkj * __uint_as_float(uu[1] << 16), wkj * __uint_as_float(uu[1] & 0xffff0000u));
          sv.z = pk2(wkj * __uint_as_float(uu[2] << 16), wkj * __uint_as_float(uu[2] & 0xffff0000u)); sv.w = pk2(wkj * __uint_as_float(uu[3] << 16), wkj * __uint_as_float(uu[3] & 0xffff0000u));
          *(LAS v4u*)(Lvs + j * VS + d0) = sv; }
        if (ch + 1 < SEQ / 64) ML_LOAD(ch + 1);
        rw_bar(bcnt, btarget, lane);
        { const int tt = w; const int t = 16 * tt + fr; const float mxt = smx[t];
#pragma unroll
          for (int jt = 0; jt < 4; ++jt) { f32x4 acc = (f32x4){0.f, 0.f, 0.f, 0.f};
              if (jt <= tt) {
#pragma unroll
                  for (int ks = 0; ks < 4; ++ks) { const s16x8 a = *(const LAS s16x8*)(Lk + (16 * jt + fr) * 136 + 32 * ks + 8 * fq), bq = *(const LAS s16x8*)(Lq + (16 * tt + fr) * 136 + 32 * ks + 8 * fq);
                      acc = __builtin_amdgcn_mfma_f32_16x16x32_bf16(a, bq, acc, 0, 0, 0); }
                  const f32x4 u4 = *(const LAS f32x4*)(su + 16 * jt + 4 * fq);
#pragma unroll
                  for (int rg_ = 0; rg_ < 4; ++rg_) { const int j = 16 * jt + 4 * fq + rg_; acc[rg_] = (j <= t) ? acc[rg_] * __expf(u4[rg_] - mxt) : 0.f; } }
              *(LAS unsigned long long*)(Ls + t * 72 + 16 * jt + 4 * fq) = pack4bf(acc); } }
        rw_bar(bcnt, btarget, lane);
        { const int mi = w; f32x4 a1[3], a2[3];
#pragma unroll
          for (int n = 0; n < 3; ++n) { a1[n] = (f32x4){0.f, 0.f, 0.f, 0.f}; a2[n] = a1[n]; }
#pragma unroll
          for (int ks = 0; ks < 2; ++ks) { const s16x8 A = *(const LAS s16x8*)(Ls + (16 * mi + fr) * 72 + 32 * ks + 8 * fq);
#pragma unroll
              for (int n = 0; n < 3; ++n) a1[n] = __builtin_amdgcn_mfma_f32_16x16x32_bf16(A, tr_frag(Lv, VS, 32 * ks + 8 * fq, 16 * n, fr), a1[n], 0, 0, 0); }
#pragma unroll
          for (int ks = 0; ks < 4; ++ks) { const s16x8 A = *(const LAS s16x8*)(Lq + (16 * mi + fr) * 136 + 32 * ks + 8 * fq);
#pragma unroll
              for (int n = 0; n < 3; ++n) a2[n] = __builtin_amdgcn_mfma_f32_16x16x32_bf16(A, *(const LAS s16x8*)(cTc + (16 * n + fr) * 136 + 32 * ks + 8 * fq), a2[n], 0, 0, 0); }
          const f32x4 mx4 = *(const LAS f32x4*)(smx + 16 * mi + 4 * fq), b4 = *(const LAS f32x4*)(sb + 16 * mi + 4 * fq);
#pragma unroll
          for (int rg_ = 0; rg_ < 4; ++rg_) { const float wi = __expf(mstate - mx4[rg_]); float den = a1[2][rg_] + wi * a2[2][rg_]; den = __shfl(den, lane & 48);
              const float mt = b4[rg_] + mx4[rg_]; const float inv = __builtin_amdgcn_rcpf(fmaxf(fabsf(den), __expf(-mt))); float* hp = HRAW + (tk0 + 16 * mi + 4 * fq + rg_) * RD + mh * 256 + sl * 32 + fr;
              hp[0] = (a1[0][rg_] + wi * a2[0][rg_]) * inv; hp[16] = (a1[1][rg_] + wi * a2[1][rg_]) * inv; } }
        {
#pragma unroll
          for (int a = 0; a < 2; ++a) {
#pragma unroll
              for (int n = 0; n < 3; ++n) st[a][n] = st[a][n] * dec;
#pragma unroll
              for (int ks = 0; ks < 2; ++ks) { const s16x8 A = tr_frag(Lk, 136, 32 * ks + 8 * fq, 16 * (2 * w + a), fr);
#pragma unroll
                  for (int n = 0; n < 3; ++n) st[a][n] = __builtin_amdgcn_mfma_f32_16x16x32_bf16(A, tr_frag(Lvs, VS, 32 * ks + 8 * fq, 16 * n, fr), st[a][n], 0, 0, 0); }
#pragma unroll
              for (int n = 0; n < 3; ++n) *(LAS unsigned long long*)(cTn + (16 * n + fr) * 136 + 16 * (2 * w + a) + 4 * fq) = pack4bf(st[a][n]); } }
        mstate = mnew;
        rw_bar(bcnt, btarget, lane);
    }
#undef ML_LOAD
}

__device__ __forceinline__ float rowsum4(f32x4 v) { return (v[0] + v[1]) + (v[2] + v[3]); }
__device__ __forceinline__ void p5_finalize(Frame& F) {
    const bf16* __restrict__ P = (const bf16*)(F.ws + WS_P); const bf16* __restrict__ AGp = (const bf16*)(F.ws + WS_WAG + 64 * MiB); const float* __restrict__ YRAW = (const float*)(F.ws + WS_YRAW); const float* __restrict__ HRAW = (const float*)(F.ws + WS_HRAW);
    bf16* __restrict__ OA = (bf16*)(F.ws + WS_OA); bf16* __restrict__ OB = (bf16*)(F.ws + WS_OB);
    const int gw = F.bid * NWAVES + F.wave, NGW = F.G * NWAVES, lane = F.lane;
    { const int hq = gw & 3, c0 = (hq * 4 + (lane >> 4)) * 64 + 4 * (lane & 15);
      const f32x4 lnw = *(const f32x4*)(F.in[I_LNW] + c0), lnb = *(const f32x4*)(F.in[I_LNB] + c0); const bf16* __restrict__ BON = (const bf16*)(F.ws + WS_WAG + 128 * MiB);
      v2u bo, gb; f32x4 y4;
#define P5_LOAD(q_) do { const int tk_ = (q_) >> 2; bo = *(const v2u*)(BON + (size_t)tk_ * RD + c0); gb = *(const v2u*)(AGp + (size_t)tk_ * D + RD + c0); y4 = *(const f32x4*)(YRAW + (size_t)tk_ * RD + c0); } while (0)
      if (gw < T * 4) P5_LOAD(gw);
      for (int q = gw; q < T * 4; q += NGW) { const int tk = q >> 2; const f32x4 bon = UNP4(bo), g = UNP4(gb), y = y4;
          if (q + NGW < T * 4) P5_LOAD(q + NGW);
          const float mean = allreduce16(rowsum4(y)) * (1.f / 64.f); const f32x4 dl = y - mean;
          const float var = allreduce16(rowsum4(dl * dl)) * (1.f / 64.f); const float rs = __builtin_amdgcn_rsqf(var + GN_EPS);
          const f32x4 o = (dl * rs * lnw + lnb + bon) * g;
          v2u ov; ov.x = pk2(o[0], o[1]); ov.y = pk2(o[2], o[3]); *(v2u*)(OA + (size_t)tk * RD + c0) = ov; }
#undef P5_LOAD
    }
    { const int mh = gw & 3, d0 = mh * 256 + 4 * lane; const f32x4 nw = *(const f32x4*)(F.in[I_MNW] + d0);
      f32x4 hv; v2u po;
#define P5B_LOAD(q_) do { const int tk_ = (q_) >> 2; hv = *(const f32x4*)(HRAW + (size_t)tk_ * RD + d0); po = *(const v2u*)(P + (size_t)tk_ * NINP + MLO + 2056 + d0); } while (0)
      if (gw < T * 4) P5B_LOAD(gw);
      for (int q = gw; q < T * 4; q += NGW) { const int tk = q >> 2; const f32x4 h4 = hv; const v2u p2 = po;
          if (q + NGW < T * 4) P5B_LOAD(q + NGW);
          float ss = allreduce16(rowsum4(h4 * h4)); ss += __shfl_xor(ss, 16); ss += __shfl_xor(ss, 32);
          const float rs = __builtin_amdgcn_rsqf(ss * (1.f / 256.f) + NORM_EPS); const f32x4 og = UNP4(p2);
          const float o0 = h4[0] * rs * nw[0] * sigm(og[0]), o1 = h4[1] * rs * nw[1] * sigm(og[1]), o2 = h4[2] * rs * nw[2] * sigm(og[2]), o3 = h4[3] * rs * nw[3] * sigm(og[3]);
          v2u o; o.x = pk2(o0, o1); o.y = pk2(o2, o3); *(v2u*)(OB + (size_t)tk * RD + d0) = o; }
#undef P5B_LOAD
    }
}

typedef float f32x16 __attribute__((ext_vector_type(16)));
__device__ __forceinline__ void p8_route(Frame& F) {
    const bf16* X1 = (const bf16*)(F.ws + WS_X1); unsigned char* H2 = (unsigned char*)(F.ws + WS_HN); int* RLIST = (int*)(F.ws + WS_RLIST); float* RWT = (float*)(F.ws + WS_RW);
    const float* RWS = (const float*)(F.ws + WS_RWS); const float* nw = F.in[I_N2W]; const float* rtb = F.in[I_RTB];
    LAS float* part = (LAS float*)F.lds;
    LAS float* ssq = part + 8 * 32 * 33;
    LAS float* lgt = ssq + 256;
    LAS float* srs = lgt + 32 * 33;
    const int lane = F.lane, w = F.wave, i = lane & 31, h = lane >> 5, tid = F.tid;
    for (int tile = F.bid; tile < T / 32; tile += F.G) {
        const int m0 = tile * 32; const bf16* xrow = X1 + (size_t)(m0 + i) * D + 256 * w + 4 * h;
        f32x16 acc;
#pragma unroll
        for (int r_ = 0; r_ < 16; ++r_) acc[r_] = 0.f;
        float ss = 0.f; const float* bp = RWS + (size_t)(256 * w + 4 * h) * NE + i;
#pragma unroll 4
        for (int q = 0; q < 32; ++q) { const v2u xb_ = *(const v2u*)(xrow + 8 * q); const f32x4 xa = UNP4(xb_);
#pragma unroll
            for (int j = 0; j < 4; ++j) acc = __builtin_amdgcn_mfma_f32_32x32x2f32(xa[j], bp[(8 * q + j) * NE], acc, 0, 0, 0);
            ss += (xa[0] * xa[0] + xa[1] * xa[1]) + (xa[2] * xa[2] + xa[3] * xa[3]); }
        ss += __shfl_xor(ss, 32);
        if (h == 0) ssq[w * 32 + i] = ss;
#pragma unroll
        for (int r_ = 0; r_ < 16; ++r_) part[(w * 32 + (r_ & 3) + 8 * (r_ >> 2) + 4 * h) * 33 + i] = acc[r_];
        __syncthreads();
#pragma unroll
        for (int k2 = 0; k2 < 2; ++k2) { const int idx = tid + NTHR * k2, ii = idx >> 5, e = idx & 31; float sm = 0.f, sq = 0.f;
#pragma unroll
            for (int ww = 0; ww < 8; ++ww) { sm += part[(ww * 32 + ii) * 33 + e]; sq += ssq[ww * 32 + ii]; }
            const float rs = 1.f / sqrtf(sq * (1.f / D) + NORM_EPS); lgt[ii * 33 + e] = sm * rs + rtb[e]; if (e == 0) srs[ii] = rs; }
        __syncthreads();
        { const float rs = srs[i] * F8_SX; unsigned char* orow = H2 + (size_t)(m0 + i) * D + 256 * w + 4 * h;
#pragma unroll 8
          for (int q = 0; q < 32; ++q) { const f32x4 n4 = *(const f32x4*)(nw + 256 * w + 4 * h + 8 * q); const v2u xb_ = *(const v2u*)(xrow + 8 * q); const f32x4 hv = UNP4(xb_) * rs * n4; *(unsigned*)(orow + 8 * q) = pk4f8(hv[0], hv[1], hv[2], hv[3]); } }
        if (tid < 32) { const LAS float* lr = lgt + tid * 33; unsigned used = 0u; int idx[4]; float val[4];
#pragma unroll
            for (int s4 = 0; s4 < 4; ++s4) { float best = -INFINITY; int bi = 0;
                for (int e = 0; e < 32; ++e) { const float v = lr[e]; const bool ok = !((used >> e) & 1u) && (v > best); best = ok ? v : best; bi = ok ? e : bi; }
                used |= 1u << bi; idx[s4] = bi; val[s4] = best; }
            const float e1 = __expf(val[1] - val[0]), e2 = __expf(val[2] - val[0]), e3 = __expf(val[3] - val[0]); const float inv = 1.f / (1.f + e1 + e2 + e3);
            const float wv[4] = {inv, e1 * inv, e2 * inv, e3 * inv};
            unsigned pos[4];
#pragma unroll
            for (int s4 = 0; s4 < 4; ++s4) pos[s4] = atomicAdd(F.ctl + CW_CNT + 64 * idx[s4], 1u);
#pragma unroll
            for (int s4 = 0; s4 < 4; ++s4) { RLIST[idx[s4] * ECAP + pos[s4]] = (m0 + tid) * 4 + s4; RWT[idx[s4] * ECAP + pos[s4]] = wv[s4]; } }
        __syncthreads();
    }
}

__device__ __forceinline__ void build_moe_tables(Frame& F) {
    LAS int* MI = (LAS int*)F.MISC;
    __syncthreads();
    if (F.tid < NE) MI[MI_CNT + F.tid] = (int)__hip_atomic_load(F.ctl + CW_CNT + 64 * F.tid, __ATOMIC_RELAXED, __HIP_MEMORY_SCOPE_AGENT);
    __syncthreads();
    if (F.tid == 0) { int mt = 0, cs = 0;
        for (int e = 0; e < NE; ++e) { const int c = MI[MI_CNT + e]; MI[MI_POFF + e] = mt * 256; MI[MI_CST + e] = cs; cs += c;
            const int nt = (c + 255) >> 8; for (int i = 0; i < nt; ++i) { MI[MI_TILE_E + mt + i] = e; MI[MI_TILE_I0 + mt + i] = i * 256; } mt += nt; }
        MI[MI_CST + NE] = cs; MI[MI_MT] = mt; }
    __syncthreads();
}
__device__ __forceinline__ void p9_gather(Frame& F) {
    build_moe_tables(F);
    const LAS int* MI = (const LAS int*)F.MISC; const bf16* H2 = (const bf16*)(F.ws + WS_HN); bf16* XB = (bf16*)(F.ws + WS_XB); const int* RLIST = (const int*)(F.ws + WS_RLIST);
    const int gw = F.bid * NWAVES + F.wave, NGW = F.G * NWAVES, total = MI[MI_CST + NE];
    for (int q = gw; q < total; q += NGW) { int e = 0;
        for (int k = 1; k < NE; ++k) e = (MI[MI_CST + k] <= q) ? k : e;
        const int i = q - MI[MI_CST + e]; const int tok = RLIST[e * ECAP + i] >> 2;
        const v4u* src = (const v4u*)(H2 + (size_t)tok * D) + F.lane; v4u* dst = (v4u*)(XB + (size_t)(MI[MI_POFF + e] + i) * D) + F.lane;
#pragma unroll
        for (int j = 0; j < 4; ++j) dst[64 * j] = src[64 * j]; }
}
__device__ __forceinline__ void p12_final(Frame& F) {
    const bf16* X1 = (const bf16*)(F.ws + WS_X1); const unsigned char* YS = (const unsigned char*)(F.ws + WS_YS); const float* fw = F.in[I_FNW];
    const int gw = F.bid * NWAVES + F.wave, NGW = F.G * NWAVES;
    for (int m = gw; m < T; m += NGW) {
        const v2u* xr = (const v2u*)(X1 + (size_t)m * D) + F.lane; f32x4 v[8]; float s = 0.f;
#pragma unroll
        for (int j = 0; j < 8; ++j) { const v2u xb_ = xr[64 * j]; v[j] = UNP4(xb_);
#pragma unroll
            for (int sl = 0; sl < 4; ++sl) { const int y = ((const int*)(YS + ((size_t)m * 4 + sl) * D))[F.lane + 64 * j];
                const f32x2 ylo = __builtin_amdgcn_cvt_pk_f32_fp8(y, false), yhi = __builtin_amdgcn_cvt_pk_f32_fp8(y, true);
                v[j][0] += ylo[0] * (1.f / F8_SY); v[j][1] += ylo[1] * (1.f / F8_SY); v[j][2] += yhi[0] * (1.f / F8_SY); v[j][3] += yhi[1] * (1.f / F8_SY); }
            s += (v[j][0] * v[j][0] + v[j][1] * v[j][1]) + (v[j][2] * v[j][2] + v[j][3] * v[j][3]); }
        const float rstd = __builtin_amdgcn_rsqf(wave_sum(s) * (1.f / D) + NORM_EPS);
        f32x4* orow = (f32x4*)(F.out + (size_t)m * D) + F.lane;
#pragma unroll
        for (int j = 0; j < 8; ++j) { const f32x4 w = ((const f32x4*)fw)[F.lane + 64 * j]; orow[64 * j] = v[j] * rstd * w; }
    }
}

__global__ void __launch_bounds__(NTHR, 2) mk_fwd(Args args) {
    extern __shared__ __attribute__((aligned(16))) unsigned char lds[];
    Frame F;
    F.lds = (LAS unsigned char*)lds; F.MISC = (volatile LAS unsigned*)(F.lds + MISC_OFF);
    F.tid = threadIdx.x; F.lane = F.tid & 63; F.wave = __builtin_amdgcn_readfirstlane(F.tid >> 6); F.G = gridDim.x; F.bid = blockIdx.x;
    F.in = args.in; F.out = args.out; F.ws = args.ws; F.ctl = (unsigned*)(args.ws + WS_CTL);
    for (int u = F.tid; u < (LDS_BYTES - MISC_OFF) / 4; u += NTHR) ((LAS unsigned*)(F.lds + MISC_OFF))[u] = 0u;
    __syncthreads();
    XcdBarrier bar; bar.bar = F.ctl + CW_BAR; bar.x = 0; bar.st = nullptr;
    if (MK_N_LAUNCHES == 1) bar = xcd_barrier_post(F.ctl + CW_BAR, F.MISC + 8);
    const int lo = args.ph_lo, hi = args.ph_hi;
#define IN(k) (lo <= (k) && (k) < hi)
#ifndef PROBE_PHASE
#define PROBE_PHASE -1
#endif
#define REP(k) ((PROBE_PHASE) == (k) ? 2 : 1)
#define SEAM(k) do { if (IN(k) && IN((k) + 1)) xcd_barrier(bar); } while (0)
    LAS unsigned char* ring = F.lds;
    const LAS int* MI = (const LAS int*)F.MISC;

    static_assert(MK_N_LAUNCHES == 1, "the W_in quantisation needs an in-launch barrier inside phase 0");
    if (IN(0)) { p0_prologue(F); xcd_barrier(bar); p0b_win(F); } SEAM(0);
    if (IN(1)) {
        const int ng = F.G > 2 * NCV ? F.G - NCV : F.G;
        if (F.bid < ng) {
            pg8::Gemm g{(const bf16*)(F.ws + WS_HN), (const bf16*)(F.ws + WS_WIN), T, NINP, D / 2}; pg8::StaticOrder S; S.init(T, NINP, ng, F.bid);
            EpiP1I8 E{(bf16*)(F.ws + WS_P), NINP, (const float*)(F.ws + WS_RA), F.ctl + CW_COLMAX};
            pg8::gemm_phase<EpiP1I8, pg8::StaticOrder, true, true, false, true>(ring, g, S, E);
            if (F.tid == 0) __hip_atomic_fetch_add(F.ctl + CW_P1DONE, 1u, __ATOMIC_RELAXED, __HIP_MEMORY_SCOPE_AGENT);
        } else if (F.wave >= CV1_W0) convert_loop(F, F.ctl + CW_CVNEXT, F.ctl + CW_P1DONE, (unsigned)ng);
    } SEAM(1);
    if (IN(2)) { for (int rep = 0; rep < REP(2); ++rep) p2_lora_in(F); } SEAM(2);
    if (IN(3)) {
        pg8::Gemm g{(const bf16*)(F.ws + WS_LIN), (const bf16*)(F.ws + WS_WL), T, 3072, 512}; pg8::StaticOrder S; S.init(T, 3072, F.G, F.bid);
        EpiLora E{(float*)(F.ws + WS_WAG), (bf16*)(F.ws + WS_WAG + 64 * MiB), F.in[I_W0], F.in[I_A0]};
        pg8::gemm_phase<EpiLora, pg8::StaticOrder, true, true>(ring, g, S, E);
    } SEAM(3);
    if (IN(4)) {
        { LAS unsigned* ctl2 = (LAS unsigned*)F.MISC + 16;
          if (F.wave < 4) { unsigned bt = 0u; for (int rep = 0; rep < REP(40); ++rep) for (int u = F.bid; u < 256; u += F.G) rwkv_chunk_unit(F, u, (LAS unsigned char*)F.MISC + 256, ctl2, bt); }
          else { Frame F2 = F; F2.tid = F.tid - 256; F2.wave = F.wave - 4; F2.lds = F.lds + 45056; unsigned bt = 0u;
                 for (int rep = 0; rep < REP(41); ++rep) for (int u = F.bid; u < 256; u += F.G) mlstm_scan_unit(F2, u, ctl2 + 2, bt); }
          if (F.wave >= CV_W0) convert_loop(F, F.ctl + CW_CVNEXT, nullptr, 0u);
          __syncthreads(); }
    } SEAM(4);
    if (IN(5)) { for (int rep = 0; rep < REP(5); ++rep) p5_finalize(F); } SEAM(5);
    if (IN(6)) {
        { pg8::Gemm g{(const bf16*)(F.ws + WS_OA), (const bf16*)(F.ws + WS_WA), T, D, RD}; pg8::StaticOrder S; S.init(T, D, F.G, F.bid);
          EpiGateA E{(bf16*)(F.ws + WS_TMP), (const bf16*)(F.ws + WS_P), F.in[I_BGATE]};
          pg8::gemm_phase<EpiGateA, pg8::StaticOrder, true, true>(ring, g, S, E); }
        VM_WAIT(); __syncthreads();
        { pg8::Gemm g{(const bf16*)(F.ws + WS_OB), (const bf16*)(F.ws + WS_WB), T, D, RD}; pg8::StaticOrder S; S.init(T, D, F.G, F.bid);
          EpiGateB E{(const bf16*)(F.ws + WS_TMP), (bf16*)(F.ws + WS_MRG), (const bf16*)(F.ws + WS_P), F.in[I_BGATE]};
          pg8::gemm_phase<EpiGateB, pg8::StaticOrder, true, true>(ring, g, S, E); }
    } SEAM(6);
    if (IN(7)) {
        pg8::Gemm g{(const bf16*)(F.ws + WS_MRG), (const bf16*)(F.ws + WS_WO), T, D, D}; pg8::StaticOrder S; S.init(T, D, F.G, F.bid);
        EpiResid E{F.in[I_X], (bf16*)(F.ws + WS_X1)};
        pg8::gemm_phase<EpiResid, pg8::StaticOrder, true, true>(ring, g, S, E);
    } SEAM(7);
    if (IN(8)) { p8_route(F); } SEAM(8);
    if (IN(10)) {
        build_moe_tables(F);
        const int mt = MI[MI_MT];
        pg8::Gemm g{(const bf16*)(F.ws + WS_HN), (const bf16*)(F.ws + WS_WGU), mt * 256, 2 * FF, D / 2};
        MoeGatherOrder S; S.init(mt * 256, 2 * FF, F.G, F.bid); S.tile_e = MI + MI_TILE_E; S.estride = (size_t)2 * FF * D;
        S.tile_i0 = MI + MI_TILE_I0; S.cnt = MI + MI_CNT; S.rlist = (const int*)(F.ws + WS_RLIST); S.rowoff = (LAS unsigned*)F.MISC + MI_ROWOFF; S.rowbytes = D;
        EpiSwiGLU E{(unsigned char*)(F.ws + WS_ACT), F.in[I_BGU], MI + MI_TILE_E};
        pg8::gemm_phase<EpiSwiGLU, MoeGatherOrder, true, true, true>(ring, g, S, E);
    } SEAM(10);
    if (IN(11)) {
        build_moe_tables(F);
        const int mt = MI[MI_MT];
        pg8::Gemm g{(const bf16*)(F.ws + WS_ACT), (const bf16*)(F.ws + WS_WDN), mt * 256, D, FF / 2};
        MoeOrder S; S.init(mt * 256, D, F.G, F.bid); S.tile_e = MI + MI_TILE_E; S.estride = (size_t)D * FF;
        LAS int* rowdst = (LAS int*)F.MISC + MI_ROWOFF; LAS float* rowwt = (LAS float*)F.MISC + MI_ROWOFF + 10 * 256;
        fill_down_tables(F, S, rowdst, rowwt);
        EpiDown E{(unsigned char*)(F.ws + WS_YS), F.in[I_BDN], MI + MI_TILE_E, rowdst, rowwt};
        pg8::gemm_phase<EpiDown, MoeOrder, true, true, true>(ring, g, S, E);
    } SEAM(11);
    if (IN(12)) { for (int rep = 0; rep < REP(12); ++rep) p12_final(F); }
#undef IN
#undef SEAM
}

extern "C" void kernel_launch(void* const* d_in, const int* in_sizes, int n_in, void* d_out, int out_size, void* d_ws, size_t ws_size, hipStream_t stream) {
    static int grid = 0;
    if (grid == 0) {
        if (n_in != 30 || out_size != T * D || ws_size < WS_END) { fprintf(stderr, "kernel_launch: unexpected problem (n_in %d, out %d, ws %zu)\n", n_in, out_size, ws_size); grid = -1; return; }
        int dev = 0, cus = 0, per_cu = 0;
        if (hipGetDevice(&dev) != hipSuccess || hipDeviceGetAttribute(&cus, hipDeviceAttributeMultiprocessorCount, dev) != hipSuccess) { grid = -1; return; }
        if (hipFuncSetAttribute((const void*)mk_fwd, hipFuncAttributeMaxDynamicSharedMemorySize, LDS_BYTES) != hipSuccess) { fprintf(stderr, "kernel_launch: hipFuncSetAttribute failed\n"); grid = -1; return; }
        if (hipOccupancyMaxActiveBlocksPerMultiprocessor(&per_cu, (const void*)mk_fwd, NTHR, LDS_BYTES) != hipSuccess || per_cu < 1) fprintf(stderr, "kernel_launch: occupancy query says %d\n", per_cu);
        (void)hipGetLastError();
        grid = cus;
    }
    if (grid < 0) return;
    if (hipMemsetAsync((char*)d_ws + WS_CTL, 0, CTL_ZERO_BYTES, stream) != hipSuccess) return;
    Args a{};
    for (int i = 0; i < 30; ++i) a.in[i] = (const float*)d_in[i];
    a.out = (float*)d_out; a.ws = (unsigned char*)d_ws;
    for (int li = 0; li < MK_N_LAUNCHES; ++li) {
        a.ph_lo = (MK_N_LAUNCHES == 1) ? 0 : li; a.ph_hi = (MK_N_LAUNCHES == 1) ? NPH : li + 1;
        hipLaunchKernelGGL(mk_fwd, dim3(grid), dim3(NTHR), LDS_BYTES, stream, a);
        const hipError_t le = hipPeekAtLastError();
        if (le != hipSuccess) { fprintf(stderr, "kernel_launch: launch %d failed: %s\n", li, hipGetErrorName(le)); break; }
    }
}
```

```cpp
#include <hip/hip_runtime.h>
#include <cstdio>
#include <cstdint>
#define MK_N_LAUNCHES 1
#define PROBE_PHASE -1
namespace pg8 {
#define PG8_LAS __attribute__((address_space(3)))
typedef unsigned short bf16_t;
typedef short bf16x8 __attribute__((ext_vector_type(8)));
typedef float f32x4 __attribute__((ext_vector_type(4)));
typedef unsigned u32x4 __attribute__((ext_vector_type(4)));
constexpr int BM = 256, BK = 64, HALF = 128, HTB = HALF * BK * 2  , STAGE_BYTES = 8 * HTB, NXCD = 8, WGM = 8;

__host__ __device__ __forceinline__ int lds_byte(int r, int c) { const int st = (r >> 4) * 2 + (c >> 5), rr = r & 15, cc = c & 31, ob = rr * 64 + cc * 2; return st * 1024 + (ob ^ (((ob >> 9) & 1) << 5)); }
__host__ __device__ __forceinline__ void stage_rc(int b, int& R, int& C) { const int st = b / 1024, sb = b % 1024, swz = sb ^ (((sb >> 9) & 1) << 5); R = (st >> 1) * 16 + swz / 64; C = (st & 1) * 32 + (swz % 64) / 2; }
__host__ __device__ __forceinline__ int perm32(int rho) { const int n = rho >> 4, i = rho & 15; return 8 * (i >> 2) + 4 * n + (i & 3); }

struct Unit { int pm, pn, ord; };
struct Gemm { const bf16_t* A; const bf16_t* Bt; int M, N, K; };

struct StaticOrder {
    int nM, nN, nwg, G, c;
    __host__ __device__ void init(int M, int N, int G_, int c_) { nM = M / BM; nN = N / BM; nwg = nM * nN; G = G_; c = c_; }
    __host__ __device__ bool next(int i, Unit& u) const {
        const long L = (long)i * G + c; if (L >= nwg) return false;
        int wgid = (int)L; { const int q = nwg / NXCD, r = nwg % NXCD, xcd = wgid % NXCD, off = wgid / NXCD; wgid = (xcd < r ? xcd * (q + 1) : r * (q + 1) + (xcd - r) * q) + off; }
        const int nig = WGM * nN, gid = wgid / nig, fm = gid * WGM, gsz = (nM - fm) < WGM ? (nM - fm) : WGM;
        u.pm = fm + ((wgid % nig) % gsz); u.pn = (wgid % nig) / gsz; u.ord = i; return true;
    }
    __device__ __forceinline__ void a_ready(const Unit&) const {}
    static constexpr bool GATHER = false;
    __device__ __forceinline__ void fill_all() const {}
    __device__ __forceinline__ unsigned row_off(int, int) const { return 0u; }
    __device__ __forceinline__ void done(const Unit&) const {}
    __device__ __forceinline__ size_t a_off(const Unit& u, size_t tstep) const { return (size_t)u.pm * tstep; }
    __device__ __forceinline__ size_t b_off(const Unit& u, size_t tstep) const { return (size_t)u.pn * tstep; }
};
__device__ __forceinline__ unsigned cvt_pk_bf16(float lo, float hi) { unsigned r; asm volatile("v_cvt_pk_bf16_f32 %0, %1, %2" : "=v"(r) : "v"(lo), "v"(hi)); return r; }
typedef int v8i32 __attribute__((ext_vector_type(8)));
typedef int v4i32 __attribute__((ext_vector_type(4)));
__device__ __forceinline__ v8i32 cat8(bf16x8 lo, bf16x8 hi) { const v4i32 a = __builtin_bit_cast(v4i32, lo), b = __builtin_bit_cast(v4i32, hi); return __builtin_shufflevector(a, b, 0, 1, 2, 3, 4, 5, 6, 7); }
template <class Epi, class Sched, bool ALIGN_EPI = false, bool SP2 = false, bool FP8 = false, bool I8 = false>
__device__ __forceinline__ void gemm_phase(PG8_LAS unsigned char* lds, const Gemm g, const Sched& S, const Epi& E) {
    const int tid = threadIdx.x, wid = __builtin_amdgcn_readfirstlane(tid >> 6), lane = tid & 63, wr = wid >> 2, wc = wid & 3, fr = lane & 15, fq = lane >> 4;
    const int K = g.K, nt = K / BK;
    unsigned voffA[2], voffB[2];
#pragma unroll
    for (int i = 0; i < 2; ++i) { int R, C; stage_rc(tid * 16 + i * 8192, R, C); const int Rb = Epi::PERM ? ((R & ~31) + perm32(R & 31)) : R;
        voffA[i] = (unsigned)(R * K + C) * 2u; voffB[i] = (unsigned)(Rb * K + C) * 2u; }
    unsigned voffA1[2]; int rselA[2]; unsigned cselA[2];
#pragma unroll
    for (int i = 0; i < 2; ++i) { int R, C; stage_rc(tid * 16 + i * 8192, R, C); rselA[i] = R; cselA[i] = (unsigned)C * 2u; voffA1[i] = voffA[i]; }
    const size_t kstep = (size_t)(BK * 2);
    const size_t hstep = (size_t)HALF * K * 2;
    const size_t tstep = 2 * hstep;
    const size_t hstepA = Sched::GATHER ? (size_t)0 : hstep;
#define PG8_ROWS(_u) do { _Pragma("unroll") for (int _i = 0; _i < 2; ++_i) { voffA[_i] = S.row_off((_u), rselA[_i]) + cselA[_i]; voffA1[_i] = S.row_off((_u), HALF + rselA[_i]) + cselA[_i]; } } while (0)
    const unsigned ldsw = (unsigned)wid * 1024u;
    const int aoff = lds_byte(wr * 64 + fr, fq * 8), boff = lds_byte(wc * 32 + fr, fq * 8);
#define PG8_SA(b, h) (((b) * 2 + (h)) * HTB)
#define PG8_SB(b, h) ((4 + (b) * 2 + (h)) * HTB)
#define PG8_STAGE(bufoff, gbase, voff) do { _Pragma("unroll") for (int _i = 0; _i < 2; ++_i) \
        __builtin_amdgcn_global_load_lds((const unsigned*)((const char*)(gbase) + (voff)[_i]), (PG8_LAS unsigned*)(lds + (bufoff) + ldsw + _i * 8192), 16, 0, 0); } while (0)
#define PG8_LDA(dst, b, h) do { if constexpr (FP8) { _Pragma("unroll") for (int m = 0; m < 4; ++m) dst##8[m] = cat8(*(const PG8_LAS bf16x8*)(lds + PG8_SA(b, h) + aoff + m * 2048), *(const PG8_LAS bf16x8*)(lds + PG8_SA(b, h) + aoff + m * 2048 + 1024)); } \
        else { _Pragma("unroll") for (int m = 0; m < 4; ++m) _Pragma("unroll") for (int k = 0; k < 2; ++k) dst[m][k] = *(const PG8_LAS bf16x8*)(lds + PG8_SA(b, h) + aoff + m * 2048 + k * 1024); } } while (0)
#define PG8_LDB(dst, b, h) do { if constexpr (FP8) { _Pragma("unroll") for (int n = 0; n < 2; ++n) dst##8[n] = cat8(*(const PG8_LAS bf16x8*)(lds + PG8_SB(b, h) + boff + n * 2048), *(const PG8_LAS bf16x8*)(lds + PG8_SB(b, h) + boff + n * 2048 + 1024)); } \
        else { _Pragma("unroll") for (int n = 0; n < 2; ++n) _Pragma("unroll") for (int k = 0; k < 2; ++k) dst[n][k] = *(const PG8_LAS bf16x8*)(lds + PG8_SB(b, h) + boff + n * 2048 + k * 1024); } } while (0)
#define PG8_MMA(ai, bj, At, Bt) do { __builtin_amdgcn_s_setprio(1); if constexpr (FP8) { _Pragma("unroll") for (int m = 0; m < 4; ++m) _Pragma("unroll") for (int n = 0; n < 2; ++n) \
        asm volatile("v_mfma_scale_f32_16x16x128_f8f6f4 %0, %1, %2, %0, %3, %3 op_sel_hi:[0,0,0]" : "+v"(acc[ai][bj][m][n]) : "v"(Bt##8[n]), "v"(At##8[m]), "v"(f8scale)); } else { \
        _Pragma("unroll") for (int m = 0; m < 4; ++m) _Pragma("unroll") for (int n = 0; n < 2; ++n) _Pragma("unroll") for (int k = 0; k < 2; ++k) { \
        if constexpr (I8) acc[ai][bj][m][n] = __builtin_bit_cast(f32x4, __builtin_amdgcn_mfma_i32_16x16x64_i8(__builtin_bit_cast(v4i32, Bt[n][k]), __builtin_bit_cast(v4i32, At[m][k]), __builtin_bit_cast(v4i32, acc[ai][bj][m][n]), 0, 0, 0)); \
        else acc[ai][bj][m][n] = __builtin_amdgcn_mfma_f32_16x16x32_bf16(Bt[n][k], At[m][k], acc[ai][bj][m][n], 0, 0, 0); } } __builtin_amdgcn_s_setprio(0); } while (0)
#define PG8_WAIT_V(n) asm volatile("s_waitcnt vmcnt(" #n ")" ::: "memory")
#define PG8_WAIT_L(n) asm volatile("s_waitcnt lgkmcnt(" #n ")" ::: "memory")
#define PG8_BAR __builtin_amdgcn_s_barrier()
#define PG8_SCHED __builtin_amdgcn_sched_barrier(0)
    Unit cur, nxt; int ui = 0;
    if (!S.next(0, cur)) return;
    f32x4 acc[2][2][4][2];
#pragma unroll
    for (int a = 0; a < 2; ++a)
#pragma unroll
        for (int b = 0; b < 2; ++b)
#pragma unroll
            for (int m = 0; m < 4; ++m)
#pragma unroll
                for (int n = 0; n < 2; ++n) acc[a][b][m][n] = (f32x4){0.f, 0.f, 0.f, 0.f};
    const int f8scale = 0x7f7f7f7f;
    bf16x8 At[4][2], B0[2][2], B1[2][2]; v8i32 At8[4], B08[2], B18[2];
    const char* cA = (const char*)g.A + S.a_off(cur, tstep); const char* cB = (const char*)g.Bt + S.b_off(cur, tstep);
    S.a_ready(cur);
    if constexpr (Sched::GATHER) { S.fill_all(); asm volatile("s_waitcnt vmcnt(0) lgkmcnt(0)" ::: "memory"); __builtin_amdgcn_s_barrier(); asm volatile("" ::: "memory"); PG8_ROWS(0); }
    if constexpr (SP2) {
        PG8_STAGE(PG8_SB(0, 0), cB, voffB); PG8_STAGE(PG8_SB(0, 1), cB + hstep, voffB); PG8_STAGE(PG8_SA(0, 0), cA, voffA); PG8_STAGE(PG8_SA(0, 1), cA + hstepA, voffA1);
        if (wr == 1) PG8_BAR;
        PG8_WAIT_V(2); PG8_BAR;
        PG8_STAGE(PG8_SB(1, 0), cB + kstep, voffB); PG8_STAGE(PG8_SA(1, 0), cA + kstep, voffA); PG8_STAGE(PG8_SB(1, 1), cB + hstep + kstep, voffB);
        PG8_WAIT_V(6); PG8_BAR;
    } else {
        PG8_STAGE(PG8_SB(0, 0), cB, voffB); PG8_STAGE(PG8_SA(0, 0), cA, voffA); PG8_STAGE(PG8_SB(0, 1), cB + hstep, voffB); PG8_STAGE(PG8_SA(0, 1), cA + hstepA, voffA1);
        if (wr == 1) PG8_BAR;
        PG8_WAIT_V(4); PG8_BAR;
        PG8_STAGE(PG8_SB(1, 0), cB + kstep, voffB); PG8_STAGE(PG8_SA(1, 0), cA + kstep, voffA); PG8_STAGE(PG8_SB(1, 1), cB + hstep + kstep, voffB);
        PG8_WAIT_V(6); PG8_BAR;
    }
    for (;;) {
        const bool has_next = S.next(ui + 1, nxt);
        const char* nA = has_next ? (const char*)g.A + S.a_off(nxt, tstep) : cA; const char* nB = has_next ? (const char*)g.Bt + S.b_off(nxt, tstep) : cB;
        for (int t = 0; t < nt; t += 2) {
            const bool last = (t == nt - 2);
            const char* a1 = cA + (size_t)(t + 1) * kstep;
            const char* a2 = last ? nA : cA + (size_t)(t + 2) * kstep; const char* b2 = last ? nB : cB + (size_t)(t + 2) * kstep;
            const char* a3 = a2 + kstep; const char* b3 = b2 + kstep;
            if (last && has_next) S.a_ready(nxt);
            if constexpr (SP2) {
            PG8_LDB(B0, 0, 0); PG8_LDB(B1, 0, 1); PG8_SCHED; PG8_LDA(At, 0, 0); PG8_STAGE(PG8_SA(1, 1), a1 + hstepA, voffA1);
            PG8_WAIT_V(8); PG8_WAIT_L(0); PG8_BAR; PG8_MMA(0, 0, At, B0); PG8_MMA(0, 1, At, B1); PG8_BAR; PG8_SCHED;
            if constexpr (Sched::GATHER) { if (last && has_next) PG8_ROWS(ui + 1); }
            PG8_LDA(At, 0, 1); PG8_STAGE(PG8_SB(0, 0), b2, voffB); PG8_STAGE(PG8_SB(0, 1), b2 + hstep, voffB); PG8_STAGE(PG8_SA(0, 0), a2, voffA);
            PG8_WAIT_V(8); PG8_WAIT_L(0); PG8_BAR; PG8_MMA(1, 0, At, B0); PG8_MMA(1, 1, At, B1); PG8_BAR; PG8_SCHED;
            PG8_LDB(B0, 1, 0); PG8_LDB(B1, 1, 1); PG8_SCHED; PG8_LDA(At, 1, 0); PG8_STAGE(PG8_SA(0, 1), a2 + hstepA, voffA1);
            PG8_WAIT_V(8); PG8_WAIT_L(0); PG8_BAR; PG8_MMA(0, 0, At, B0); PG8_MMA(0, 1, At, B1); PG8_BAR; PG8_SCHED;
            PG8_LDA(At, 1, 1); PG8_STAGE(PG8_SB(1, 0), b3, voffB); PG8_STAGE(PG8_SB(1, 1), b3 + hstep, voffB); PG8_STAGE(PG8_SA(1, 0), a3, voffA);
            PG8_WAIT_V(8); PG8_WAIT_L(0); PG8_BAR; PG8_MMA(1, 0, At, B0); PG8_MMA(1, 1, At, B1); PG8_BAR; PG8_SCHED;
            } else {
            PG8_LDB(B0, 0, 0); PG8_SCHED; PG8_LDA(At, 0, 0); PG8_STAGE(PG8_SA(1, 1), a1 + hstepA, voffA1);
            PG8_WAIT_L(8); PG8_BAR; PG8_WAIT_L(0); PG8_MMA(0, 0, At, B0); PG8_BAR; PG8_SCHED;
            PG8_LDB(B1, 0, 1); PG8_STAGE(PG8_SB(0, 0), b2, voffB);
            PG8_BAR; PG8_WAIT_L(0); PG8_MMA(0, 1, At, B1); PG8_BAR;
            PG8_LDA(At, 0, 1); PG8_STAGE(PG8_SA(0, 0), a2, voffA);
            PG8_BAR; PG8_WAIT_L(0); PG8_MMA(1, 0, At, B0); PG8_BAR; PG8_SCHED;
            PG8_STAGE(PG8_SB(0, 1), b2 + hstep, voffB);
            PG8_WAIT_V(6); PG8_BAR; PG8_MMA(1, 1, At, B1); PG8_BAR;
            PG8_LDB(B0, 1, 0); PG8_SCHED; PG8_LDA(At, 1, 0); PG8_STAGE(PG8_SA(0, 1), a2 + hstepA, voffA1);
            PG8_WAIT_L(8); PG8_BAR; PG8_WAIT_L(0); PG8_MMA(0, 0, At, B0); PG8_BAR; PG8_SCHED;
            PG8_LDB(B1, 1, 1); PG8_STAGE(PG8_SB(1, 0), b3, voffB);
            PG8_BAR; PG8_WAIT_L(0); PG8_MMA(0, 1, At, B1); PG8_BAR;
            PG8_LDA(At, 1, 1); PG8_STAGE(PG8_SA(1, 0), a3, voffA);
            PG8_BAR; PG8_WAIT_L(0); PG8_MMA(1, 0, At, B0); PG8_BAR; PG8_SCHED;
            PG8_STAGE(PG8_SB(1, 1), b3 + hstep, voffB);
            PG8_WAIT_V(6); PG8_BAR; PG8_MMA(1, 1, At, B1); PG8_BAR;
            }
        }
        if constexpr (ALIGN_EPI) { if (wr == 0) PG8_BAR; }
        if constexpr (FP8) { asm volatile("s_nop 15\n\ts_nop 15" ::: "memory"); }
        if constexpr (!Epi::AFTER_DRAIN) { E(acc, cur, wr, wc, fr, fq); S.done(cur); }
        if (!has_next) break;
#pragma unroll
        for (int a = 0; a < 2; ++a)
#pragma unroll
            for (int b = 0; b < 2; ++b)
#pragma unroll
                for (int m = 0; m < 4; ++m)
#pragma unroll
                    for (int n = 0; n < 2; ++n) acc[a][b][m][n] = (f32x4){0.f, 0.f, 0.f, 0.f};
        cur = nxt; cA = nA; cB = nB; ++ui;
        if constexpr (ALIGN_EPI) { if (wr == 1) PG8_BAR; }
    }
    PG8_WAIT_V(0);
    if constexpr (!ALIGN_EPI) { if (wr == 0) PG8_BAR; }
    PG8_BAR;
    if constexpr (Epi::AFTER_DRAIN) { E.fused(acc, cur, wr, wc, fr, fq, lds, wid, lane); S.done(cur); }
#undef PG8_ROWS
#undef PG8_SA
#undef PG8_SB
#undef PG8_STAGE
#undef PG8_LDA
#undef PG8_LDB
#undef PG8_MMA
#undef PG8_WAIT_V
#undef PG8_WAIT_L
#undef PG8_BAR
#undef PG8_SCHED
}
}

#ifndef MK_N_LAUNCHES
#define MK_N_LAUNCHES 1
#endif
#define GAS __attribute__((address_space(1)))
#define LAS __attribute__((address_space(3)))
typedef unsigned short bf16;
typedef unsigned v4u __attribute__((ext_vector_type(4)));
typedef unsigned v2u __attribute__((ext_vector_type(2)));
typedef float f32x4 __attribute__((ext_vector_type(4)));
typedef float f32x2 __attribute__((ext_vector_type(2)));

constexpr int NWAVES = 8, NTHR = 512;
constexpr int NPH = 13;
constexpr int D = 2048, BATCH = 8, SEQ = 2048, T = BATCH * SEQ;
constexpr int NIN = 10696, NINP = 10752;
constexpr int MLO = 3520, GTO = 6600;
constexpr int RH = 16, RD = 1024;
constexpr int MH = 4;
constexpr int NE = 32, FF = 2048, ECAP = 16384, PMAX = 65536 + NE * 256, MTMAX = PMAX / 256;
constexpr float NORM_EPS = 1e-6f, GN_EPS = 64e-5f;
constexpr size_t MiB = 1u << 20;
constexpr size_t WS_CTL = 0, CTL_ZERO_BYTES = 1 * MiB;
constexpr size_t WS_WIN = 1 * MiB, WS_WA = 43 * MiB, WS_WB = 47 * MiB, WS_WO = 51 * MiB, WS_WL = 59 * MiB;
constexpr size_t WS_RLIST = 62 * MiB, WS_RW = 64 * MiB, WS_RWS = 2787 * MiB, WS_RA = 2787 * MiB + 512 * 1024;
constexpr size_t WS_WGU = 66 * MiB, WS_WDN = 578 * MiB, WS_HN = 834 * MiB, WS_P = 898 * MiB, WS_LIN = 1234 * MiB, WS_WAG = 1250 * MiB;
constexpr size_t WS_YRAW = 1442 * MiB, WS_HRAW = 1506 * MiB, WS_OA = 1570 * MiB, WS_OB = 1602 * MiB, WS_TMP = 1634 * MiB, WS_MRG = 1762 * MiB;
constexpr size_t WS_QKC = WS_TMP, WS_GLF = WS_TMP + 64 * MiB;
constexpr size_t WS_X1 = 1826 * MiB, WS_XB = 1954 * MiB, WS_ACT = 2242 * MiB, WS_YS = 2530 * MiB, WS_END = 2788 * MiB;
constexpr int CW_BAR = 4096;
constexpr int CW_CVNEXT = 8192, CW_P1DONE = 8192 + 64;
constexpr int CV_W0 = 6, CV1_W0 = 4;
constexpr int NCV = 64;
constexpr int CW_COLMAX = 32768;
constexpr int CW_CNT = 16384;
constexpr int RING_BYTES = 131072, MISC_OFF = RING_BYTES, LDS_BYTES = RING_BYTES + 8192 + 20 * 1024;
constexpr int MI_TILE_E = 64, MI_TILE_I0 = 64 + 320, MI_CNT = 64 + 640, MI_POFF = MI_CNT + 32, MI_CST = MI_POFF + 32, MI_MT = MI_CST + 40, MI_ROWOFF = 2048;

#define LDS_WAIT() asm volatile("s_waitcnt lgkmcnt(0)" ::: "memory")
#define VM_WAIT() asm volatile("s_waitcnt vmcnt(0)" ::: "memory")
__device__ __forceinline__ float bf2f(bf16 v) { return __uint_as_float(((unsigned)v) << 16); }
__device__ __forceinline__ unsigned f2bf(float f) { unsigned u = __float_as_uint(f); return (u + 0x7fffu + ((u >> 16) & 1u)) >> 16; }
typedef __bf16 bf16x2_t __attribute__((ext_vector_type(2)));
__device__ __forceinline__ unsigned pk2(float lo, float hi) { const f32x2 v = {lo, hi}; const bf16x2_t b = __builtin_convertvector(v, bf16x2_t); return __builtin_bit_cast(unsigned, b); }
__device__ __forceinline__ unsigned pk4f8(float a, float b, float c, float d) { int r = 0; r = __builtin_amdgcn_cvt_pk_fp8_f32(a, b, r, false); r = __builtin_amdgcn_cvt_pk_fp8_f32(c, d, r, true); return (unsigned)r; }
constexpr float F8_SX = 8.f, F8_SW = 256.f, F8_SA = 4.f, F8_SY = 16.f;
__device__ __forceinline__ unsigned pk4i8(float a, float b, float c, float d) {
    const int ia = (int)__builtin_rintf(a), ib = (int)__builtin_rintf(b), ic = (int)__builtin_rintf(c), id = (int)__builtin_rintf(d);
    return (unsigned)(ia & 255) | ((unsigned)(ib & 255) << 8) | ((unsigned)(ic & 255) << 16) | ((unsigned)id << 24); }
__device__ __forceinline__ float wave_max(float v) {
#pragma unroll
    for (int o = 1; o < 64; o <<= 1) v = fmaxf(v, __shfl_xor(v, o));
    return v;
}
__device__ __forceinline__ float wave_sum(float v) {
#pragma unroll
    for (int o = 1; o < 64; o <<= 1) v += __shfl_xor(v, o);
    return v;
}
#define UNP4(v) ((f32x4){__uint_as_float((v).x << 16), __uint_as_float((v).x & 0xffff0000u), __uint_as_float((v).y << 16), __uint_as_float((v).y & 0xffff0000u)})
__device__ __forceinline__ float sigm(float x) { return __builtin_amdgcn_rcpf(1.f + __expf(-x)); }
template <int CTRL> __device__ __forceinline__ float dppf(float x) { return __builtin_bit_cast(float, __builtin_amdgcn_mov_dpp(__builtin_bit_cast(int, x), CTRL, 0xf, 0xf, true)); }
__device__ __forceinline__ float allreduce16(float x) { x += dppf<0x128>(x); x += dppf<0x124>(x); x += dppf<0x4E>(x); x += dppf<0xB1>(x); return x; }

#define XB_TMO      128
#define XB_XCNT(j)  (256  + 64 * (j))
#define XB_XSUB(j)  (1280 + 64 * (j))
#define XB_XGEN(j)  (2304 + 64 * (j))
#define XB_TOP      3328
#define XB_TOPGEN   3392
#define XCD_BAR_WORDS 3456
#define XB_SPIN_CAP (1u << 18)
__device__ __forceinline__ unsigned xb_ld(unsigned* p)              { return __hip_atomic_load(p, __ATOMIC_RELAXED, __HIP_MEMORY_SCOPE_AGENT); }
__device__ __forceinline__ unsigned xb_add(unsigned* p, unsigned v) { return __hip_atomic_fetch_add(p, v, __ATOMIC_RELAXED, __HIP_MEMORY_SCOPE_AGENT); }
__device__ __forceinline__ unsigned xb_xcc_id() { return (unsigned)__builtin_amdgcn_s_getreg((3 << 11) | 20) & 0xFu; }
#define XB_SPIN(cond, bar) do { unsigned _sp = 0; while (cond) { __builtin_amdgcn_s_sleep(1); \
    if ((++_sp & 255u) == 0u) { if (xb_ld(&(bar)[XB_TMO])) break; if (_sp > XB_SPIN_CAP) { atomicAdd(&(bar)[XB_TMO], 1u); break; } } } } while (0)
struct XcdBarrier { unsigned* bar; unsigned x; volatile LAS unsigned* st; };
__device__ __forceinline__ XcdBarrier xcd_barrier_post(unsigned* bar, volatile LAS unsigned* st) {
    XcdBarrier b; b.bar = bar; b.x = xb_xcc_id(); b.st = st;
    if (threadIdx.x == 0) (void)xb_add(&bar[XB_XCNT(b.x)], 1u);
    return b;
}
__device__ __forceinline__ void xcd_barrier_complete(unsigned* bar, unsigned x, unsigned& nloc, unsigned& nx) {
    const unsigned G = gridDim.x * gridDim.y * gridDim.z;
    unsigned sum, cnt, mine, sp = 0u;
    for (;;) {
        sum = 0u; cnt = 0u; mine = 0u;
#pragma unroll
        for (unsigned j = 0; j < 16; ++j) { const unsigned c = xb_ld(&bar[XB_XCNT(j)]); sum += c; cnt += (c > 0u) ? 1u : 0u; mine = (j == x) ? c : mine; }
        if (sum == G) break;
        __builtin_amdgcn_s_sleep(1);
        if ((++sp & 255u) == 0u) { if (xb_ld(&bar[XB_TMO])) break; if (sp > XB_SPIN_CAP) { atomicAdd(&bar[XB_TMO], 1u); break; } }
    }
    nloc = mine > 0u ? mine : 1u; nx = cnt > 0u ? cnt : 1u;
}
__device__ __forceinline__ void xcd_barrier(const XcdBarrier& b) {
    asm volatile("s_waitcnt vmcnt(0)" ::: "memory");
    __syncthreads();
    if (threadIdx.x == 0) {
        unsigned* bar = b.bar;
        __builtin_amdgcn_s_waitcnt(0);
        unsigned nloc = b.st[0], nx = b.st[1];
        if (nloc == 0u) { xcd_barrier_complete(bar, b.x, nloc, nx); b.st[0] = nloc; b.st[1] = nx; }
        const unsigned old = xb_add(&bar[XB_XSUB(b.x)], 1u);
        const unsigned gen = old / nloc;
        if (old + 1u == (gen + 1u) * nloc) {
            __builtin_amdgcn_fence(__ATOMIC_RELEASE, "agent");
            asm volatile("s_waitcnt vmcnt(0)" ::: "memory");
            const unsigned og = xb_add(&bar[XB_TOP], 1u);
            const unsigned tg = og / nx;
            if (og + 1u == (tg + 1u) * nx) xb_add(&bar[XB_TOPGEN], 1u);
            else XB_SPIN(xb_ld(&bar[XB_TOPGEN]) == tg, bar);
            __builtin_amdgcn_fence(__ATOMIC_ACQUIRE, "agent");
            xb_add(&bar[XB_XGEN(b.x)], 1u);
            asm volatile("s_waitcnt vmcnt(0)" ::: "memory");
        } else {
            XB_SPIN(xb_ld(&bar[XB_XGEN(b.x)]) == gen, bar);
            __builtin_amdgcn_fence(__ATOMIC_ACQUIRE, "agent");
            asm volatile("s_waitcnt vmcnt(0)" ::: "memory");
        }
    }
    __syncthreads();
}

struct Args { const float* in[30]; float* out; unsigned char* ws; int ph_lo, ph_hi; };
enum { I_X = 0, I_N1W, I_WIN, I_BGATE, I_MU, I_W0, I_WUP, I_A0, I_AUP, I_GUP, I_KK, I_KA, I_RK, I_LNW, I_LNB, I_CONVW, I_IB, I_FB, I_MNW, I_WBA, I_WBB, I_WOUT, I_N2W, I_RTW, I_RTB, I_WGU, I_BGU, I_WDN, I_BDN, I_FNW };

struct Frame {
    LAS unsigned char* lds; volatile LAS unsigned* MISC; unsigned* ctl;
    int tid, lane, wave, G, bid;
    const float* const* in; float* out; unsigned char* ws;
};

using pg8::Unit; using pg8::HALF; using pg8::BM;
struct EpiBf16Plain {
    static constexpr bool PERM = true, AFTER_DRAIN = false;
    bf16* O; int ldc;
    __device__ __forceinline__ void operator()(const f32x4 (&acc)[2][2][4][2], const Unit& u, int wr, int wc, int fr, int fq) const {
        const int row0 = u.pm * BM + wr * 64 + fr, col0 = u.pn * BM + wc * 32 + 8 * fq;
#pragma unroll
        for (int ai = 0; ai < 2; ++ai)
#pragma unroll
            for (int m = 0; m < 4; ++m) { bf16* rowp = O + (size_t)(row0 + ai * HALF + m * 16) * ldc + col0;
#pragma unroll
                for (int bj = 0; bj < 2; ++bj) { const f32x4 v0 = acc[ai][bj][m][0], v1 = acc[ai][bj][m][1];
                    v4u w; w.x = pg8::cvt_pk_bf16(v0[0], v0[1]); w.y = pg8::cvt_pk_bf16(v0[2], v0[3]); w.z = pg8::cvt_pk_bf16(v1[0], v1[1]); w.w = pg8::cvt_pk_bf16(v1[2], v1[3]);
                    *(v4u*)(rowp + bj * HALF) = w; } }
    }
};
struct EpiP1I8 {
    static constexpr bool PERM = true, AFTER_DRAIN = false;
    bf16* O; int ldc; const float* ra; const unsigned* colmax;
    __device__ __forceinline__ void operator()(const f32x4 (&acc)[2][2][4][2], const Unit& u, int wr, int wc, int fr, int fq) const {
        const int row0 = u.pm * BM + wr * 64 + fr, col0 = u.pn * BM + wc * 32 + 8 * fq;
        f32x4 cb[2][2];
#pragma unroll
        for (int bj = 0; bj < 2; ++bj)
#pragma unroll
            for (int n = 0; n < 2; ++n) { const v4u cm = *(const v4u*)(colmax + col0 + bj * HALF + 4 * n);
                cb[bj][n] = (f32x4){__uint_as_float(cm.x), __uint_as_float(cm.y), __uint_as_float(cm.z), __uint_as_float(cm.w)} * (1.f / 127.f); }
#pragma unroll
        for (int ai = 0; ai < 2; ++ai)
#pragma unroll
            for (int m = 0; m < 4; ++m) { const int r = row0 + ai * HALF + m * 16; const float rs = ra[r]; bf16* rowp = O + (size_t)r * ldc + col0;
#pragma unroll
                for (int bj = 0; bj < 2; ++bj) { const v4u i0 = __builtin_bit_cast(v4u, acc[ai][bj][m][0]), i1 = __builtin_bit_cast(v4u, acc[ai][bj][m][1]);
                    const f32x4 v0 = (f32x4){(float)(int)i0.x, (float)(int)i0.y, (float)(int)i0.z, (float)(int)i0.w} * cb[bj][0] * rs, v1 = (f32x4){(float)(int)i1.x, (float)(int)i1.y, (float)(int)i1.z, (float)(int)i1.w} * cb[bj][1] * rs;
                    v4u w; w.x = pk2(v0[0], v0[1]); w.y = pk2(v0[2], v0[3]); w.z = pk2(v1[0], v1[1]); w.w = pk2(v1[2], v1[3]);
                    *(v4u*)(rowp + bj * HALF) = w; } }
    }
};
struct EpiLora {
    static constexpr bool PERM = false, AFTER_DRAIN = false;
    float* WLD; bf16* AG; const float* w0; const float* a0;
    __device__ __forceinline__ void operator()(const f32x4 (&acc)[2][2][4][2], const Unit& u, int wr, int wc, int fr, int fq) const {
        const int row0 = u.pm * BM + wr * 64 + fr, col0 = u.pn * BM + wc * 32 + 4 * fq, seg = u.pn >> 2;
        f32x4 bv[2][2];
#pragma unroll
        for (int bj = 0; bj < 2; ++bj)
#pragma unroll
            for (int n = 0; n < 2; ++n) { const int c = col0 + bj * HALF + n * 16;
                bv[bj][n] = seg == 0 ? *(const f32x4*)(w0 + c) : (seg == 1 ? *(const f32x4*)(a0 + (c - 1024)) : (f32x4){0.f, 0.f, 0.f, 0.f}); }
#pragma unroll
        for (int ai = 0; ai < 2; ++ai)
#pragma unroll
            for (int m = 0; m < 4; ++m) { const size_t r = (size_t)(row0 + ai * HALF + m * 16);
#pragma unroll
                for (int bj = 0; bj < 2; ++bj)
#pragma unroll
                    for (int n = 0; n < 2; ++n) { f32x4 v = acc[ai][bj][m][n] + bv[bj][n]; const int c = col0 + bj * HALF + n * 16;
                        if (seg == 0) {
#pragma unroll
                            for (int j = 0; j < 4; ++j) v[j] = -0.6065306597126334f * sigm(v[j]);
                            *(f32x4*)(WLD + r * RD + c) = v; }
                        else { if (seg == 1) {
#pragma unroll
                                for (int j = 0; j < 4; ++j) v[j] = sigm(v[j]); }
                            v2u o; o.x = pk2(v[0], v[1]); o.y = pk2(v[2], v[3]); *(v2u*)(AG + r * D + (c - 1024)) = o; } } }
    }
};
struct EpiGateA {
    static constexpr bool PERM = true, AFTER_DRAIN = false;
    bf16* TMP; const bf16* P; const float* bg;
    __device__ __forceinline__ void operator()(const f32x4 (&acc)[2][2][4][2], const Unit& u, int wr, int wc, int fr, int fq) const {
        const int row0 = u.pm * BM + wr * 64 + fr, col0 = u.pn * BM + wc * 32 + 8 * fq;
#pragma unroll
        for (int ai = 0; ai < 2; ++ai)
#pragma unroll
            for (int m = 0; m < 4; ++m) { const size_t r = (size_t)(row0 + ai * HALF + m * 16);
#pragma unroll
                for (int bj = 0; bj < 2; ++bj) { const int c = col0 + bj * HALF;
                    const v4u pg = *(const v4u*)(P + r * NINP + GTO + c); const f32x4 b0 = *(const f32x4*)(bg + c), b1 = *(const f32x4*)(bg + c + 4);
                    f32x4 g0, g1;
                    g0[0] = sigm(__uint_as_float(pg.x << 16) + b0[0]); g0[1] = sigm(__uint_as_float(pg.x & 0xffff0000u) + b0[1]);
                    g0[2] = sigm(__uint_as_float(pg.y << 16) + b0[2]); g0[3] = sigm(__uint_as_float(pg.y & 0xffff0000u) + b0[3]);
                    g1[0] = sigm(__uint_as_float(pg.z << 16) + b1[0]); g1[1] = sigm(__uint_as_float(pg.z & 0xffff0000u) + b1[1]);
                    g1[2] = sigm(__uint_as_float(pg.w << 16) + b1[2]); g1[3] = sigm(__uint_as_float(pg.w & 0xffff0000u) + b1[3]);
                    const f32x4 t0 = g0 * acc[ai][bj][m][0], t1 = g1 * acc[ai][bj][m][1]; v4u tw; tw.x = pk2(t0[0], t0[1]); tw.y = pk2(t0[2], t0[3]); tw.z = pk2(t1[0], t1[1]); tw.w = pk2(t1[2], t1[3]);
                    *(v4u*)(TMP + r * D + c) = tw; } }
    }
};
struct EpiGateB {
    static constexpr bool PERM = true, AFTER_DRAIN = false;
    const bf16* TMP; bf16* MRG; const bf16* P; const float* bg;
    __device__ __forceinline__ void operator()(const f32x4 (&acc)[2][2][4][2], const Unit& u, int wr, int wc, int fr, int fq) const {
        const int row0 = u.pm * BM + wr * 64 + fr, col0 = u.pn * BM + wc * 32 + 8 * fq;
#pragma unroll
        for (int ai = 0; ai < 2; ++ai)
#pragma unroll
            for (int m = 0; m < 4; ++m) { const size_t r = (size_t)(row0 + ai * HALF + m * 16);
#pragma unroll
                for (int bj = 0; bj < 2; ++bj) { const int c = col0 + bj * HALF;
                    const v4u pg = *(const v4u*)(P + r * NINP + GTO + D + c); const f32x4 b0 = *(const f32x4*)(bg + D + c), b1 = *(const f32x4*)(bg + D + c + 4);
                    const v4u tw = *(const v4u*)(TMP + r * D + c); const f32x4 t0 = (f32x4){__uint_as_float(tw.x << 16), __uint_as_float(tw.x & 0xffff0000u), __uint_as_float(tw.y << 16), __uint_as_float(tw.y & 0xffff0000u)}, t1 = (f32x4){__uint_as_float(tw.z << 16), __uint_as_float(tw.z & 0xffff0000u), __uint_as_float(tw.w << 16), __uint_as_float(tw.w & 0xffff0000u)};
                    f32x4 g0, g1;
                    g0[0] = sigm(__uint_as_float(pg.x << 16) + b0[0]); g0[1] = sigm(__uint_as_float(pg.x & 0xffff0000u) + b0[1]);
                    g0[2] = sigm(__uint_as_float(pg.y << 16) + b0[2]); g0[3] = sigm(__uint_as_float(pg.y & 0xffff0000u) + b0[3]);
                    g1[0] = sigm(__uint_as_float(pg.z << 16) + b1[0]); g1[1] = sigm(__uint_as_float(pg.z & 0xffff0000u) + b1[1]);
                    g1[2] = sigm(__uint_as_float(pg.w << 16) + b1[2]); g1[3] = sigm(__uint_as_float(pg.w & 0xffff0000u) + b1[3]);
                    const f32x4 v0 = t0 + g0 * acc[ai][bj][m][0], v1 = t1 + g1 * acc[ai][bj][m][1];
                    v4u w; w.x = pg8::cvt_pk_bf16(v0[0], v0[1]); w.y = pg8::cvt_pk_bf16(v0[2], v0[3]); w.z = pg8::cvt_pk_bf16(v1[0], v1[1]); w.w = pg8::cvt_pk_bf16(v1[2], v1[3]);
                    *(v4u*)(MRG + r * D + c) = w; } }
    }
};
struct EpiResid {
    static constexpr bool PERM = true, AFTER_DRAIN = false;
    const float* X; bf16* O;
    __device__ __forceinline__ void operator()(const f32x4 (&acc)[2][2][4][2], const Unit& u, int wr, int wc, int fr, int fq) const {
        const int row0 = u.pm * BM + wr * 64 + fr, col0 = u.pn * BM + wc * 32 + 8 * fq;
#pragma unroll
        for (int ai = 0; ai < 2; ++ai)
#pragma unroll
            for (int m = 0; m < 4; ++m) { const size_t off = (size_t)(row0 + ai * HALF + m * 16) * D + col0;
#pragma unroll
                for (int bj = 0; bj < 2; ++bj) { const f32x4 v0 = *(const f32x4*)(X + off + bj * HALF) + acc[ai][bj][m][0], v1 = *(const f32x4*)(X + off + bj * HALF + 4) + acc[ai][bj][m][1];
                    v4u w; w.x = pk2(v0[0], v0[1]); w.y = pk2(v0[2], v0[3]); w.z = pk2(v1[0], v1[1]); w.w = pk2(v1[2], v1[3]);
                    *(v4u*)(O + off + bj * HALF) = w; } }
    }
};
struct MoeOrder : pg8::StaticOrder {
    const LAS int* tile_e; size_t estride;
    __device__ __forceinline__ size_t b_off(const Unit& u, size_t tstep) const { return (size_t)tile_e[u.pm] * estride + (size_t)u.pn * tstep; }
};
struct MoeGatherOrder : MoeOrder {
    static constexpr bool GATHER = true;
    const LAS int* tile_i0; const LAS int* cnt; const int* rlist; LAS unsigned* rowoff; unsigned rowbytes;
    __device__ __forceinline__ size_t a_off(const Unit&, size_t) const { return 0; }
    __device__ __forceinline__ void fill_all() const { const int tid = threadIdx.x, r = tid & 255;
        for (int u0 = tid >> 8; ; u0 += 6) { Unit ua, ub, uc; const bool va = next(u0, ua), vb = next(u0 + 2, ub), vc = next(u0 + 4, uc); if (!va) break;
            int ta = 0, tb = 0, tc = 0;
            { const int e = tile_e[ua.pm], i = tile_i0[ua.pm] + r; if (i < cnt[e]) ta = rlist[e * ECAP + i]; }
            if (vb) { const int e = tile_e[ub.pm], i = tile_i0[ub.pm] + r; if (i < cnt[e]) tb = rlist[e * ECAP + i]; }
            if (vc) { const int e = tile_e[uc.pm], i = tile_i0[uc.pm] + r; if (i < cnt[e]) tc = rlist[e * ECAP + i]; }
            rowoff[u0 * 256 + r] = (unsigned)(ta >> 2) * rowbytes; if (vb) rowoff[(u0 + 2) * 256 + r] = (unsigned)(tb >> 2) * rowbytes; if (vc) rowoff[(u0 + 4) * 256 + r] = (unsigned)(tc >> 2) * rowbytes; } }
    __device__ __forceinline__ unsigned row_off(int ui, int r) const { return rowoff[ui * 256 + r]; }
};
struct EpiSwiGLU {
    static constexpr bool PERM = true, AFTER_DRAIN = false;
    unsigned char* ACT; const float* bgu; const LAS int* tile_e;
    __device__ __forceinline__ void operator()(const f32x4 (&acc)[2][2][4][2], const Unit& u, int wr, int wc, int fr, int fq) const {
        const int row0 = u.pm * BM + wr * 64 + fr, colg = u.pn * 128 + wc * 32 + 8 * fq; const int e = tile_e[u.pm];
        const float* bp = bgu + (size_t)e * 4096 + colg;
        const f32x4 bg0 = *(const f32x4*)(bp), bg1 = *(const f32x4*)(bp + 4), bu0 = *(const f32x4*)(bp + 2048), bu1 = *(const f32x4*)(bp + 2052);
#pragma unroll
        for (int ai = 0; ai < 2; ++ai)
#pragma unroll
            for (int m = 0; m < 4; ++m) { const size_t r = (size_t)(row0 + ai * HALF + m * 16);
                constexpr float DS = 1.f / (F8_SX * F8_SW);
                const f32x4 ga = acc[ai][0][m][0] * DS + bg0, gb = acc[ai][0][m][1] * DS + bg1, ua = acc[ai][1][m][0] * DS + bu0, ub = acc[ai][1][m][1] * DS + bu1;
                float o[8];
#pragma unroll
                for (int j = 0; j < 4; ++j) { const float g = fminf(ga[j], 7.f), up = fminf(fmaxf(ua[j], -7.f), 7.f); o[j] = F8_SA * (up + 1.f) * g * sigm(1.702f * g);
                                              const float g2 = fminf(gb[j], 7.f), up2 = fminf(fmaxf(ub[j], -7.f), 7.f); o[4 + j] = F8_SA * (up2 + 1.f) * g2 * sigm(1.702f * g2); }
                v2u w; w.x = pk4f8(o[0], o[1], o[2], o[3]); w.y = pk4f8(o[4], o[5], o[6], o[7]);
                *(v2u*)(ACT + r * FF + colg) = w; }
    }
};
struct EpiDown {
    static constexpr bool PERM = true, AFTER_DRAIN = false;
    unsigned char* YS; const float* bdn; const LAS int* tile_e; const LAS int* rowdst; const LAS float* rowwt;
    __device__ __forceinline__ void operator()(const f32x4 (&acc)[2][2][4][2], const Unit& u, int wr, int wc, int fr, int fq) const {
        const int e = tile_e[u.pm]; const int col0 = u.pn * BM + wc * 32 + 8 * fq;
        const float* bp = bdn + (size_t)e * D + col0; constexpr float DS = 1.f / (F8_SA * F8_SW);
#pragma unroll
        for (int bj = 0; bj < 2; ++bj) { const f32x4 b0 = *(const f32x4*)(bp + bj * HALF), b1 = *(const f32x4*)(bp + bj * HALF + 4);
#pragma unroll
            for (int ai = 0; ai < 2; ++ai)
#pragma unroll
                for (int m = 0; m < 4; ++m) { const int r = u.ord * 256 + ai * HALF + wr * 64 + m * 16 + fr;
                    const int dst = rowdst[r]; const float w = rowwt[r];
                    const f32x4 v0 = (acc[ai][bj][m][0] * DS + b0) * (w * F8_SY), v1 = (acc[ai][bj][m][1] * DS + b1) * (w * F8_SY);
                    v2u o; o.x = pk4f8(v0[0], v0[1], v0[2], v0[3]); o.y = pk4f8(v1[0], v1[1], v1[2], v1[3]);
                    *(v2u*)(YS + (size_t)dst * D + col0 + bj * HALF) = o; } }
    }
};
template <class Sched> __device__ __forceinline__ void fill_down_tables(Frame& F, const Sched& S, LAS int* rowdst, LAS float* rowwt) {
    const LAS int* MI = (const LAS int*)F.MISC; const int* rlist = (const int*)(F.ws + WS_RLIST); const float* rw = (const float*)(F.ws + WS_RW);
    const int r = F.tid & 255;
    for (int u0 = F.tid >> 8; ; u0 += 4) { Unit ua, ub; const bool va = S.next(u0, ua), vb = S.next(u0 + 2, ub); if (!va) break;
        int da = T * 4, db = T * 4; float wa = 0.f, wb = 0.f;
        { const int e = MI[MI_TILE_E + ua.pm], i = MI[MI_TILE_I0 + ua.pm] + r; if (i < MI[MI_CNT + e]) { da = rlist[e * ECAP + i]; wa = rw[e * ECAP + i]; } }
        if (vb) { const int e = MI[MI_TILE_E + ub.pm], i = MI[MI_TILE_I0 + ub.pm] + r; if (i < MI[MI_CNT + e]) { db = rlist[e * ECAP + i]; wb = rw[e * ECAP + i]; } }
        rowdst[u0 * 256 + r] = da; rowwt[u0 * 256 + r] = wa; if (vb) { rowdst[(u0 + 2) * 256 + r] = db; rowwt[(u0 + 2) * 256 + r] = wb; } }
    __syncthreads();
}

__device__ __forceinline__ void transpose_item(const float* __restrict__ W, int N, int k0, int n0, bf16* WT, int dst_row0, int ldk, LAS float* scr, int lane) {
    const int n = n0 + (lane & 31); const bool ok = n < N;
#pragma unroll 8
    for (int i = 0; i < 32; ++i) { const int kk = 2 * i + (lane >> 5); scr[kk * 33 + (lane & 31)] = ok ? W[(size_t)(k0 + kk) * N + n] : 0.f; }
    LDS_WAIT(); asm volatile("" ::: "memory");
    const int c = lane & 7;
#pragma unroll
    for (int j = 0; j < 4; ++j) { const int nn = (lane >> 3) + 8 * j; const LAS float* s = scr + (8 * c) * 33 + nn;
        v4u o; o.x = pk2(s[0 * 33], s[1 * 33]); o.y = pk2(s[2 * 33], s[3 * 33]); o.z = pk2(s[4 * 33], s[5 * 33]); o.w = pk2(s[6 * 33], s[7 * 33]);
        *(v4u*)(WT + (size_t)(dst_row0 + nn) * ldk + k0 + 8 * c) = o; }
    LDS_WAIT(); asm volatile("" ::: "memory");
}
__device__ __forceinline__ void transpose_item_i8(const float* __restrict__ W, int N, int k0, int n0, unsigned char* WT, int dst_row0, int ldk, const unsigned* colmax, LAS float* scr, int lane) {
    const int n = n0 + (lane & 31); const bool ok = n < N;
#pragma unroll 8
    for (int i = 0; i < 32; ++i) { const int kk = 2 * i + (lane >> 5); scr[kk * 33 + (lane & 31)] = ok ? W[(size_t)(k0 + kk) * N + n] : 0.f; }
    LDS_WAIT(); asm volatile("" ::: "memory");
#pragma unroll
    for (int j = 0; j < 2; ++j) { const int ch = lane + 64 * j, nn = ch >> 2, c = ch & 3; const LAS float* s = scr + (16 * c) * 33 + nn;
        const float cm = __uint_as_float(colmax[n0 + nn]); const float sc = cm > 0.f ? 127.f / cm : 0.f;
        v4u o; o.x = pk4i8(s[0 * 33] * sc, s[1 * 33] * sc, s[2 * 33] * sc, s[3 * 33] * sc); o.y = pk4i8(s[4 * 33] * sc, s[5 * 33] * sc, s[6 * 33] * sc, s[7 * 33] * sc);
        o.z = pk4i8(s[8 * 33] * sc, s[9 * 33] * sc, s[10 * 33] * sc, s[11 * 33] * sc); o.w = pk4i8(s[12 * 33] * sc, s[13 * 33] * sc, s[14 * 33] * sc, s[15 * 33] * sc);
        *(v4u*)(WT + (size_t)(dst_row0 + nn) * ldk + k0 + 16 * c) = o; }
    LDS_WAIT(); asm volatile("" ::: "memory");
}
__device__ __forceinline__ void p0b_win(Frame& F) {
    LAS float* scr = (LAS float*)(F.lds + F.wave * 16384);
    const int gw = F.bid * NWAVES + F.wave, NGW = F.G * NWAVES; unsigned char* WIN8 = F.ws + WS_WIN; const unsigned* colmax = F.ctl + CW_COLMAX;
    constexpr int NB_WIN = (NIN + 31) / 32;
    for (int it = gw; it < 32 * NB_WIN; it += NGW) { const int kb = it / NB_WIN, nb = it % NB_WIN; transpose_item_i8(F.in[I_WIN], NIN, kb * 64, nb * 32, WIN8, nb * 32, D, colmax, scr, F.lane); }
    { const int gt = F.bid * NTHR + F.tid, NGT = F.G * NTHR; constexpr int Z0 = NB_WIN * 32 * D, Z1 = NINP * D;
      for (int i = Z0 + gt * 16; i < Z1; i += NGT * 16) *(v4u*)(WIN8 + i) = (v4u){0u, 0u, 0u, 0u}; }
}
__device__ __forceinline__ void p0_prologue(Frame& F) {
    LAS float* scr = (LAS float*)(F.lds + F.wave * 16384);
    const int gw = F.bid * NWAVES + F.wave, NGW = F.G * NWAVES;
    bf16* WIN_T = (bf16*)(F.ws + WS_WIN); bf16* WA_T = (bf16*)(F.ws + WS_WA); bf16* WB_T = (bf16*)(F.ws + WS_WB); bf16* WO_T = (bf16*)(F.ws + WS_WO);
    bf16* WGU_T = (bf16*)(F.ws + WS_WGU); bf16* WDN_T = (bf16*)(F.ws + WS_WDN); bf16* WL_T = (bf16*)(F.ws + WS_WL); bf16* HN = (bf16*)(F.ws + WS_HN);
    { const float* W = F.in[I_WIN]; unsigned* colmax = F.ctl + CW_COLMAX;
      for (int task = gw; task < 168 * 16; task += NGW) { const int cb = task % 168, kc = task / 168, n = cb * 64 + F.lane; float m = 0.f;
          if (n < NIN) { const float* wp = W + (size_t)(kc * 128) * NIN + n;
#pragma unroll 1
              for (int k0 = 0; k0 < 128; k0 += 32) { float v[32];
#pragma unroll
                  for (int i = 0; i < 32; ++i) v[i] = wp[(size_t)(k0 + i) * NIN];
#pragma unroll
                  for (int i = 0; i < 32; ++i) m = fmaxf(m, fabsf(v[i])); }
              atomicMax(colmax + n, __float_as_uint(m)); } } }
    { const int gt = F.bid * NTHR + F.tid, NGT = F.G * NTHR;
      for (int i = gt; i < 3072 * 512; i += NGT) { const int n = i >> 9, k = i & 511; float v = 0.f;
          if (n < 1024) { if (k < 96) v = F.in[I_WUP][k * RD + n]; }
          else if (n < 2048) { if (k >= 128 && k < 224) v = F.in[I_AUP][(k - 128) * RD + (n - 1024)]; }
          else { if (k >= 256) v = F.in[I_GUP][(k - 256) * RD + (n - 2048)]; }
          WL_T[i] = (bf16)f2bf(v); } }
    { const int gt = F.bid * NTHR + F.tid, NGT = F.G * NTHR; float* RWS = (float*)(F.ws + WS_RWS);
      for (int i = gt; i < D * NE; i += NGT) RWS[i] = F.in[I_N2W][i >> 5] * F.in[I_RTW][i]; }
    const float* x = F.in[I_X]; const float* nw = F.in[I_N1W];
    for (int m = gw; m < T; m += NGW) {
        const f32x4* xr = (const f32x4*)(x + (size_t)m * D) + F.lane; f32x4 v[8]; float s = 0.f;
#pragma unroll
        for (int j = 0; j < 8; ++j) { v[j] = xr[64 * j]; s += (v[j][0] * v[j][0] + v[j][1] * v[j][1]) + (v[j][2] * v[j][2] + v[j][3] * v[j][3]); }
        const float rstd = __builtin_amdgcn_rsqf(wave_sum(s) * (1.f / D) + NORM_EPS);
        float am = 0.f;
#pragma unroll
        for (int j = 0; j < 8; ++j) { const f32x4 w = ((const f32x4*)nw)[F.lane + 64 * j]; v[j] = v[j] * rstd * w; am = fmaxf(fmaxf(am, fmaxf(fabsf(v[j][0]), fabsf(v[j][1]))), fmaxf(fabsf(v[j][2]), fabsf(v[j][3]))); }
        am = wave_max(am); const float sc = am > 0.f ? 127.f / am : 0.f;
        if (F.lane == 0) ((float*)(F.ws + WS_RA))[m] = am * (1.f / 127.f);
        unsigned* o4 = (unsigned*)((unsigned char*)HN + (size_t)m * D) + F.lane;
#pragma unroll
        for (int j = 0; j < 8; ++j) o4[64 * j] = pk4i8(v[j][0] * sc, v[j][1] * sc, v[j][2] * sc, v[j][3] * sc);
    }
}

__device__ __forceinline__ void p2_lora_in(Frame& F) {
    const bf16* __restrict__ P = (const bf16*)(F.ws + WS_P); bf16* __restrict__ LIN = (bf16*)(F.ws + WS_LIN); const float* __restrict__ mu = F.in[I_MU];
    const int gt = F.bid * NTHR + F.tid, NGT = F.G * NTHR;
#pragma unroll 2
    for (int i = gt; i < T * 64; i += NGT) { const int t = i >> 6, g = i & 63; int col = -1, kind = 0;
        if (g < 12) { col = 3072 + 8 * g; kind = 0; } else if (g >= 16 && g < 28) { col = 3168 + 8 * (g - 16); kind = 1; } else if (g >= 32) { col = 3264 + 8 * (g - 32); kind = 2; }
        v4u o = (v4u){0u, 0u, 0u, 0u};
        if (col >= 0) { const v4u pc = *(const v4u*)(P + (size_t)t * NINP + col); v4u pp = (v4u){0u, 0u, 0u, 0u}; if (t & (SEQ - 1)) pp = *(const v4u*)(P + (size_t)(t - 1) * NINP + col);
            const f32x4 m0 = *(const f32x4*)(mu + col), m1 = *(const f32x4*)(mu + col + 4);
            const unsigned pcs[4] = {pc.x, pc.y, pc.z, pc.w}, pps[4] = {pp.x, pp.y, pp.z, pp.w}; float x[8];
#pragma unroll
            for (int k = 0; k < 4; ++k) { const float c0 = __uint_as_float(pcs[k] << 16), c1 = __uint_as_float(pcs[k] & 0xffff0000u), q0 = __uint_as_float(pps[k] << 16), q1 = __uint_as_float(pps[k] & 0xffff0000u);
                const float ma = k < 2 ? m0[2 * k] : m1[2 * k - 4], mb = k < 2 ? m0[2 * k + 1] : m1[2 * k - 3];
                x[2 * k] = c0 + (q0 - c0) * ma; x[2 * k + 1] = c1 + (q1 - c1) * mb; }
#pragma unroll
            for (int k = 0; k < 8; ++k) x[k] = kind == 0 ? tanhf(x[k]) : (kind == 1 ? x[k] : sigm(x[k]));
            o.x = pk2(x[0], x[1]); o.y = pk2(x[2], x[3]); o.z = pk2(x[4], x[5]); o.w = pk2(x[6], x[7]); }
        *(v4u*)(LIN + (size_t)t * 512 + 8 * g) = o; }
    { bf16* __restrict__ QKC = (bf16*)(F.ws + WS_QKC); const float* __restrict__ cw = F.in[I_CONVW];
      for (int i = gt; i < T * 128; i += NGT) { const int t = i >> 7, c0 = 8 * (i & 127); const int sq = t & (SEQ - 1); float acc[8];
#pragma unroll
          for (int k = 0; k < 8; ++k) acc[k] = 0.f;
#pragma unroll
          for (int j = 0; j < 4; ++j) { if (sq - 3 + j >= 0) { const v4u pv = *(const v4u*)(P + (size_t)(t - 3 + j) * NINP + MLO + c0); const f32x4 w0 = *(const f32x4*)(cw + j * 1024 + c0), w1 = *(const f32x4*)(cw + j * 1024 + c0 + 4);
                  acc[0] += __uint_as_float(pv.x << 16) * w0[0]; acc[1] += __uint_as_float(pv.x & 0xffff0000u) * w0[1]; acc[2] += __uint_as_float(pv.y << 16) * w0[2]; acc[3] += __uint_as_float(pv.y & 0xffff0000u) * w0[3];
                  acc[4] += __uint_as_float(pv.z << 16) * w1[0]; acc[5] += __uint_as_float(pv.z & 0xffff0000u) * w1[1]; acc[6] += __uint_as_float(pv.w << 16) * w1[2]; acc[7] += __uint_as_float(pv.w & 0xffff0000u) * w1[3]; } }
          const float sc = c0 < 512 ? 0.08838834764831845f : 1.f;
#pragma unroll
          for (int k = 0; k < 8; ++k) acc[k] = acc[k] * sigm(acc[k]) * sc;
          v4u o; o.x = pk2(acc[0], acc[1]); o.y = pk2(acc[2], acc[3]); o.z = pk2(acc[4], acc[5]); o.w = pk2(acc[6], acc[7]); *(v4u*)(QKC + (size_t)t * 1024 + c0) = o; } }
    { float* __restrict__ GLF = (float*)(F.ws + WS_GLF); const int gw = F.bid * NWAVES + F.wave, NGW = F.G * NWAVES, lane = F.lane;
      for (int q = gw; q < (T / 64) * 4; q += NGW) { const int chk = q >> 2, mh = q & 3; const size_t t = (size_t)chk * 64 + lane; const bf16* pr = P + t * NINP + MLO + 2048;
          const float ip = 15.f * tanhf((bf2f(pr[mh]) + F.in[I_IB][mh]) * (1.f / 15.f)), fp = 15.f * tanhf((bf2f(pr[4 + mh]) + F.in[I_FB][mh]) * (1.f / 15.f));
          float bc = fminf(fp, 0.f) - log1pf(__expf(-fabsf(fp)));
#pragma unroll
          for (int o = 1; o < 64; o <<= 1) { const float t_ = __shfl_up(bc, o); if (lane >= o) bc += t_; }
          const float u = ip - bc; float pm = u;
#pragma unroll
          for (int o = 1; o < 64; o <<= 1) { const float t_ = __shfl_up(pm, o); if (lane >= o) pm = fmaxf(pm, t_); }
          *(f32x4*)(GLF + t * 16 + 4 * mh) = (f32x4){bc, u, pm, 0.f}; } }
}

typedef short s16x8 __attribute__((ext_vector_type(8)));
typedef short s16x4 __attribute__((ext_vector_type(4)));
__device__ __forceinline__ unsigned long long pack4bf(f32x4 v) { return (unsigned long long)pk2(v[0], v[1]) | ((unsigned long long)pk2(v[2], v[3]) << 32); }
__device__ __forceinline__ s16x8 tr_frag(const LAS bf16* img, int stride, int r0, int c0, int fr) {
    const LAS bf16* p0 = img + (r0 + (fr >> 2)) * stride + c0 + 4 * (fr & 3);
    const s16x4 lo = __builtin_bit_cast(s16x4, __builtin_amdgcn_ds_read_tr16_b64_v4i16((LAS s16x4*)p0));
    const s16x4 hi = __builtin_bit_cast(s16x4, __builtin_amdgcn_ds_read_tr16_b64_v4i16((LAS s16x4*)(p0 + 4 * stride)));
    return __builtin_shufflevector(lo, hi, 0, 1, 2, 3, 4, 5, 6, 7);
}

__device__ __forceinline__ void rw_bar(LAS unsigned* cnt, unsigned& target, int lane);
__device__ __forceinline__ void rwkv_chunk_unit(Frame& F, int unit, LAS unsigned char* regB, LAS unsigned* bcnt, unsigned& btarget) {
    const int b = unit >> 5, h = (unit >> 1) & 15, half = unit & 1;
    const bf16* P = (const bf16*)(F.ws + WS_P); const float* WAG = (const float*)(F.ws + WS_WAG); const bf16* AGp = (const bf16*)(F.ws + WS_WAG + 64 * MiB); float* YRAW = (float*)(F.ws + WS_YRAW);
    constexpr int KS = 72, LS = 40;
    LAS bf16* At = (LAS bf16*)F.lds; LAS bf16* Bt = At + 32 * KS; LAS bf16* Kt = Bt + 32 * KS; LAS bf16* Rt = Kt + 32 * KS;
    LAS bf16* Vv = Rt + 32 * KS;
    LAS bf16* Sb = Vv + 32 * LS;
    LAS bf16* G2b = Sb + 32 * KS; LAS bf16* G3b = G2b + 32 * LS; LAS bf16* G4b = G3b + 32 * LS;
    LAS bf16* Pwb = G4b + 32 * LS;
    LAS bf16* Acb = Pwb + 2 * 32 * LS;
    LAS bf16* RHt = (LAS bf16*)regB;
    LAS bf16* Ubt = RHt + 32 * LS;
    LAS float* lwf = (LAS float*)(Ubt + 32 * LS);
    LAS float* csf = lwf + 2048;
    LAS float* gtf = csf + 2048;
    LAS float* glf = gtf + 256;
    const int tid = F.tid, lane = F.lane, w = F.wave, fr = lane & 15, fq = lane >> 4;
    const int ts = tid >> 4, cs = tid & 15, c0 = h * 64 + 4 * cs;
    const int sk = tid & 63, sq = tid >> 6;
    const f32x4 mu_r = *(const f32x4*)(F.in[I_MU] + c0), mu_k = *(const f32x4*)(F.in[I_MU] + 1024 + c0), mu_v = *(const f32x4*)(F.in[I_MU] + 2048 + c0);
    const f32x4 kkc = *(const f32x4*)(F.in[I_KK] + c0), kac = *(const f32x4*)(F.in[I_KA] + c0), rkc = *(const f32x4*)(F.in[I_RK] + c0);
    bf16* BON = (bf16*)(F.ws + WS_WAG + 128 * MiB);
    for (int i = tid; i < 32 * KS; i += 256) Sb[i] = 0;
    v2u cr[2], ck[2], cv[2], qr[2], qk[2], qv[2]; f32x4 w4[2], a4[2];
#define RC_LOAD(ch) do { _Pragma("unroll") for (int p_ = 0; p_ < 2; ++p_) { const int t_ = (ch) * 32 + ts + 16 * p_; const size_t tk_ = (size_t)b * SEQ + t_; const bf16* pr_ = P + tk_ * NINP + c0; \
        cr[p_] = *(const v2u*)(pr_); ck[p_] = *(const v2u*)(pr_ + 1024); cv[p_] = *(const v2u*)(pr_ + 2048); \
        if (t_ > 0) { qr[p_] = *(const v2u*)(pr_ - NINP); qk[p_] = *(const v2u*)(pr_ - NINP + 1024); qv[p_] = *(const v2u*)(pr_ - NINP + 2048); } else { qr[p_] = (v2u){0u, 0u}; qk[p_] = qr[p_]; qv[p_] = qr[p_]; } \
        w4[p_] = *(const f32x4*)(WAG + tk_ * RD + c0); { const v2u ab_ = *(const v2u*)(AGp + tk_ * D + c0); a4[p_] = UNP4(ab_); } } } while (0)
    const int mi = w >> 1, nj = w & 1;
    f32x4 st[2]; st[0] = (f32x4){0.f, 0.f, 0.f, 0.f}; st[1] = st[0];
    RC_LOAD(0);
    rw_bar(bcnt, btarget, lane);
    for (int ch = 0; ch < SEQ / 32; ++ch) {
        f32x4 rr[2], kmod[2], vv[2], kkn[2], lw[2], al[2];
#pragma unroll
        for (int p_ = 0; p_ < 2; ++p_) { const f32x4 pr4 = UNP4(cr[p_]), pk4 = UNP4(ck[p_]), pv4 = UNP4(cv[p_]), qr4 = UNP4(qr[p_]), qk4 = UNP4(qk[p_]), qv4 = UNP4(qv[p_]); lw[p_] = w4[p_]; al[p_] = a4[p_];
            rr[p_] = pr4 + (qr4 - pr4) * mu_r; const f32x4 k1 = pk4 + (qk4 - pk4) * mu_k; vv[p_] = pv4 + (qv4 - pv4) * mu_v;
            const f32x4 kkr = k1 * kkc; const float nrm = __builtin_amdgcn_rsqf(fmaxf(allreduce16((kkr[0] * kkr[0] + kkr[1] * kkr[1]) + (kkr[2] * kkr[2] + kkr[3] * kkr[3])), 1e-24f));
            kkn[p_] = kkr * nrm; kmod[p_] = k1 * (1.f + (al[p_] - 1.f) * kac);
            { const f32x4 rk_ = rr[p_] * kmod[p_] * rkc; const float dot = allreduce16((rk_[0] + rk_[1]) + (rk_[2] + rk_[3]));
              if ((cs >> 3) == half) *(unsigned long long*)(BON + ((size_t)b * SEQ + ch * 32 + ts + 16 * p_) * RD + c0) = pack4bf(vv[p_] * dot); }
            *(LAS f32x4*)(lwf + (ts + 16 * p_) * 64 + 4 * cs) = lw[p_]; }
        if (ch + 1 < SEQ / 32) RC_LOAD(ch + 1);
        rw_bar(bcnt, btarget, lane);
        float cc[8];
#pragma unroll
        for (int i = 0; i < 8; ++i) cc[i] = lwf[(8 * sq + i) * 64 + sk] + (i ? cc[i - 1] : 0.f);
        gtf[sq * 64 + sk] = cc[7];
        rw_bar(bcnt, btarget, lane);
        { float off = 0.f;
#pragma unroll
          for (int q = 0; q < 3; ++q) off += (q < sq) ? gtf[q * 64 + sk] : 0.f;
#pragma unroll
          for (int i = 0; i < 8; ++i) csf[(8 * sq + i) * 64 + sk] = off + cc[i]; }
        rw_bar(bcnt, btarget, lane);
#pragma unroll
        for (int p_ = 0; p_ < 2; ++p_) { const int t = ts + 16 * p_; const f32x4 cg = *(const LAS f32x4*)(csf + t * 64 + 4 * cs); f32x4 g, gp, gi;
#pragma unroll
          for (int j = 0; j < 4; ++j) { g[j] = __expf(cg[j]); gp[j] = __expf(cg[j] - lw[p_][j]); gi[j] = __expf(-cg[j]); }
          *(LAS unsigned long long*)(At + t * KS + 4 * cs) = pack4bf(-(kkn[p_] * gp)); *(LAS unsigned long long*)(Bt + t * KS + 4 * cs) = pack4bf(kkn[p_] * al[p_] * gi);
          *(LAS unsigned long long*)(Kt + t * KS + 4 * cs) = pack4bf(kmod[p_] * gi); *(LAS unsigned long long*)(Rt + t * KS + 4 * cs) = pack4bf(rr[p_] * g);
          if ((cs >> 3) == half) *(LAS unsigned long long*)(Vv + t * LS + 4 * (cs & 7)) = pack4bf(vv[p_]);
          if (t == 31) *(LAS f32x4*)(glf + 4 * cs) = g; }
        rw_bar(bcnt, btarget, lane);
        f32x4 accT, pwT;
        { const int t = 16 * mi + fr, jb = 16 * nj + 4 * fq;
          f32x4 g1 = (f32x4){0.f, 0.f, 0.f, 0.f}, g2 = g1, g3 = g1, g4 = g1;
#pragma unroll
          for (int ks = 0; ks < 2; ++ks) { const s16x8 bj = *(const LAS s16x8*)(Bt + (16 * nj + fr) * KS + 32 * ks + 8 * fq), kj = *(const LAS s16x8*)(Kt + (16 * nj + fr) * KS + 32 * ks + 8 * fq);
              const s16x8 at = *(const LAS s16x8*)(At + (16 * mi + fr) * KS + 32 * ks + 8 * fq), rt = *(const LAS s16x8*)(Rt + (16 * mi + fr) * KS + 32 * ks + 8 * fq);
              g1 = __builtin_amdgcn_mfma_f32_16x16x32_bf16(bj, at, g1, 0, 0, 0); g2 = __builtin_amdgcn_mfma_f32_16x16x32_bf16(kj, at, g2, 0, 0, 0);
              g3 = __builtin_amdgcn_mfma_f32_16x16x32_bf16(bj, rt, g3, 0, 0, 0); g4 = __builtin_amdgcn_mfma_f32_16x16x32_bf16(kj, rt, g4, 0, 0, 0); }
#pragma unroll
          for (int rg_ = 0; rg_ < 4; ++rg_) { const int j = jb + rg_; g1[rg_] = (j < t) ? g1[rg_] : 0.f; g2[rg_] = (j < t) ? g2[rg_] : 0.f; g3[rg_] = (j <= t) ? g3[rg_] : 0.f; g4[rg_] = (j <= t) ? g4[rg_] : 0.f; }
          pwT = g1; *(LAS unsigned long long*)(Pwb + t * LS + jb) = pack4bf(g1);
#pragma unroll
          for (int rg_ = 0; rg_ < 4; ++rg_) accT[rg_] = g1[rg_] + ((jb + rg_ == t) ? 1.f : 0.f);
          *(LAS unsigned long long*)(Acb + 32 * LS + t * LS + jb) = pack4bf(accT);
          *(LAS unsigned long long*)(G2b + t * LS + jb) = pack4bf(g2); *(LAS unsigned long long*)(G3b + t * LS + jb) = pack4bf(g3); *(LAS unsigned long long*)(G4b + t * LS + jb) = pack4bf(g4); }
        rw_bar(bcnt, btarget, lane);
        f32x4 yv = (f32x4){0.f, 0.f, 0.f, 0.f};
#pragma unroll
        for (int s = 0; s < 5; ++s) { const LAS bf16* Pr = Pwb + (s & 1) * 32 * LS; LAS bf16* Pn = Pwb + ((s + 1) & 1) * 32 * LS; const LAS bf16* Ar = Acb + (s & 1) * 32 * LS; LAS bf16* An = Acb + ((s + 1) & 1) * 32 * LS;
            const s16x8 xrow = *(const LAS s16x8*)(Pr + (16 * mi + fr) * LS + 8 * fq);
            if (s < 4) { f32x4 z = (f32x4){0.f, 0.f, 0.f, 0.f}; z = __builtin_amdgcn_mfma_f32_16x16x32_bf16(tr_frag(Pr, LS, 8 * fq, 16 * nj, fr), xrow, z, 0, 0, 0);
                         *(LAS unsigned long long*)(Pn + (16 * mi + fr) * LS + 16 * nj + 4 * fq) = pack4bf(z); }
            if (s >= 1) { accT = __builtin_amdgcn_mfma_f32_16x16x32_bf16(tr_frag(Ar, LS, 8 * fq, 16 * nj, fr), xrow, accT, 0, 0, 0);
                          *(LAS unsigned long long*)(An + (16 * mi + fr) * LS + 16 * nj + 4 * fq) = pack4bf(accT); }
            if (s == 0) {
                f32x4 z = (f32x4){0.f, 0.f, 0.f, 0.f};
#pragma unroll
                for (int ks = 0; ks < 2; ++ks) { const s16x8 sb = *(const LAS s16x8*)(Sb + (16 * nj + fr) * KS + 32 * ks + 8 * fq);
                    z = __builtin_amdgcn_mfma_f32_16x16x32_bf16(*(const LAS s16x8*)(At + (16 * mi + fr) * KS + 32 * ks + 8 * fq), sb, z, 0, 0, 0);
                    yv = __builtin_amdgcn_mfma_f32_16x16x32_bf16(*(const LAS s16x8*)(Rt + (16 * mi + fr) * KS + 32 * ks + 8 * fq), sb, yv, 0, 0, 0); }
                const s16x8 vt_ = tr_frag(Vv, LS, 8 * fq, 16 * nj, fr);
                z = __builtin_amdgcn_mfma_f32_16x16x32_bf16(*(const LAS s16x8*)(G2b + (16 * mi + fr) * LS + 8 * fq), vt_, z, 0, 0, 0);
                yv = __builtin_amdgcn_mfma_f32_16x16x32_bf16(*(const LAS s16x8*)(G4b + (16 * mi + fr) * LS + 8 * fq), vt_, yv, 0, 0, 0);
                *(LAS unsigned long long*)(RHt + (16 * nj + fr) * LS + 16 * mi + 4 * fq) = pack4bf(z); }
            rw_bar(bcnt, btarget, lane); }
        { f32x4 z = (f32x4){0.f, 0.f, 0.f, 0.f};
          z = __builtin_amdgcn_mfma_f32_16x16x32_bf16(*(const LAS s16x8*)(Acb + 32 * LS + (16 * mi + fr) * LS + 8 * fq), *(const LAS s16x8*)(RHt + (16 * nj + fr) * LS + 8 * fq), z, 0, 0, 0);
          *(LAS unsigned long long*)(Ubt + (16 * nj + fr) * LS + 16 * mi + 4 * fq) = pack4bf(z); }
        rw_bar(bcnt, btarget, lane);
        { yv = __builtin_amdgcn_mfma_f32_16x16x32_bf16(*(const LAS s16x8*)(G3b + (16 * mi + fr) * LS + 8 * fq), *(const LAS s16x8*)(Ubt + (16 * nj + fr) * LS + 8 * fq), yv, 0, 0, 0);
          float* yp = YRAW + ((size_t)b * SEQ + ch * 32 + 16 * mi + 4 * fq) * RD + h * 64 + half * 32 + 16 * nj + fr;
#pragma unroll
          for (int rg_ = 0; rg_ < 4; ++rg_) yp[(size_t)rg_ * RD] = yv[rg_]; }
        { const int kt = w; const s16x8 bt_ = tr_frag(Bt, KS, 8 * fq, 16 * kt, fr), kt_ = tr_frag(Kt, KS, 8 * fq, 16 * kt, fr); const f32x4 gl4 = *(const LAS f32x4*)(glf + 16 * kt + 4 * fq);
#pragma unroll
          for (int vt = 0; vt < 2; ++vt) {
              st[vt] = __builtin_amdgcn_mfma_f32_16x16x32_bf16(bt_, *(const LAS s16x8*)(Ubt + (16 * vt + fr) * LS + 8 * fq), st[vt], 0, 0, 0);
              st[vt] = __builtin_amdgcn_mfma_f32_16x16x32_bf16(kt_, tr_frag(Vv, LS, 8 * fq, 16 * vt, fr), st[vt], 0, 0, 0);
              st[vt] = st[vt] * gl4;
              *(LAS unsigned long long*)(Sb + (16 * vt + fr) * KS + 16 * kt + 4 * fq) = pack4bf(st[vt]); } }
        rw_bar(bcnt, btarget, lane);
    }
#undef RC_LOAD
}

__device__ __forceinline__ float allreduce8(float x) { x += dppf<0x141>(x); x += dppf<0xB1>(x); x += dppf<0x4E>(x); return x; }
__device__ __forceinline__ void rw_bar(LAS unsigned* cnt, unsigned& target, int lane) {
    asm volatile("s_waitcnt lgkmcnt(0)" ::: "memory");
    if (lane == 0) __hip_atomic_fetch_add(cnt, 1u, __ATOMIC_RELAXED, __HIP_MEMORY_SCOPE_WORKGROUP);
    target += 4u;
    while ((unsigned)__builtin_amdgcn_readfirstlane((int)__hip_atomic_load(cnt, __ATOMIC_RELAXED, __HIP_MEMORY_SCOPE_WORKGROUP)) < target) __builtin_amdgcn_s_sleep(1);
    asm volatile("" ::: "memory");
}
constexpr int CV_BR = 8 * 32, CV_WO = 16 * 32, CV_GU = NE * 16 * 64, CV_DN = NE * 16 * 32, CV_ITEMS = 2 * CV_BR + CV_WO + CV_GU + CV_DN;
struct CvItem { const float* src; unsigned char* dst; int N; int f8; };
__device__ __forceinline__ CvItem cv_decode(Frame& F, int it) {
    CvItem c; int r = it; const int lane = F.lane;
    if (r < CV_BR) { const int kb = r >> 5, nb = r & 31; c.src = F.in[I_WBA] + (size_t)(kb * 128) * D + nb * 64 + lane; c.dst = F.ws + WS_WA + ((size_t)(nb * 64 + lane) * RD + kb * 128) * 2; c.N = D; c.f8 = 0; return c; } r -= CV_BR;
    if (r < CV_BR) { const int kb = r >> 5, nb = r & 31; c.src = F.in[I_WBB] + (size_t)(kb * 128) * D + nb * 64 + lane; c.dst = F.ws + WS_WB + ((size_t)(nb * 64 + lane) * RD + kb * 128) * 2; c.N = D; c.f8 = 0; return c; } r -= CV_BR;
    if (r < CV_WO) { const int kb = r >> 5, nb = r & 31; c.src = F.in[I_WOUT] + (size_t)(kb * 128) * D + nb * 64 + lane; c.dst = F.ws + WS_WO + ((size_t)(nb * 64 + lane) * D + kb * 128) * 2; c.N = D; c.f8 = 0; return c; } r -= CV_WO;
    if (r < CV_GU) { const int e = r >> 10, q = r & 1023, kb = q >> 6, nb = q & 63, n0 = nb * 64;
        const int dr = n0 < FF ? ((n0 >> 7) * 256 + (n0 & 127)) : (((n0 - FF) >> 7) * 256 + 128 + ((n0 - FF) & 127));
        c.src = F.in[I_WGU] + (size_t)e * D * 2 * FF + (size_t)(kb * 128) * (2 * FF) + n0 + lane; c.dst = F.ws + WS_WGU + (size_t)e * 2 * FF * D + (size_t)(dr + lane) * D + kb * 128; c.N = 2 * FF; c.f8 = 1; return c; } r -= CV_GU;
    { const int e = r >> 9, q = r & 511, kb = q >> 5, nb = q & 31;
        c.src = F.in[I_WDN] + (size_t)e * FF * D + (size_t)(kb * 128) * D + nb * 64 + lane; c.dst = F.ws + WS_WDN + (size_t)e * D * FF + (size_t)(nb * 64 + lane) * FF + kb * 128; c.N = D; c.f8 = 1; }
    return c;
}
__device__ __forceinline__ void convert_item(Frame& F, int it, LAS unsigned char* cvbuf);
__device__ __forceinline__ void convert_loop(Frame& F, unsigned* next, unsigned* p1done, unsigned ngemm, LAS unsigned char* cvbuf) {
#define CV_CLAIM(b_) do { b_ = 0xffffffffu; if (F.lane == 0) { if (!(p1done && __hip_atomic_load(p1done, __ATOMIC_RELAXED, __HIP_MEMORY_SCOPE_AGENT) >= ngemm)) b_ = __hip_atomic_fetch_add(next, 2u, __ATOMIC_RELAXED, __HIP_MEMORY_SCOPE_AGENT); } } while (0)
    unsigned nb; CV_CLAIM(nb);
    for (;;) { const unsigned base = (unsigned)__builtin_amdgcn_readfirstlane((int)nb); if (base >= (unsigned)CV_ITEMS) break;
        if (!p1done) CV_CLAIM(nb);
        for (int k = 0; k < 2; ++k) { const int it = (int)base + k; if (it < CV_ITEMS) convert_item(F, it, cvbuf); }
        if (p1done) CV_CLAIM(nb); }
#undef CV_CLAIM
}
__device__ __forceinline__ void convert_item(Frame& F, int i0, LAS unsigned char* cvbuf) {
    { const CvItem c = cv_decode(F, i0);
        float x[128];
#pragma unroll
        for (int i = 0; i < 128; ++i) x[i] = c.src[(size_t)i * c.N];
        if (c.f8) {
            const int lane = F.lane; LAS unsigned char* bw = cvbuf + lane * 144;
#pragma unroll
            for (int q = 0; q < 8; ++q) { v4u o; o.x = pk4f8(x[16 * q + 0] * F8_SW, x[16 * q + 1] * F8_SW, x[16 * q + 2] * F8_SW, x[16 * q + 3] * F8_SW); o.y = pk4f8(x[16 * q + 4] * F8_SW, x[16 * q + 5] * F8_SW, x[16 * q + 6] * F8_SW, x[16 * q + 7] * F8_SW);
                o.z = pk4f8(x[16 * q + 8] * F8_SW, x[16 * q + 9] * F8_SW, x[16 * q + 10] * F8_SW, x[16 * q + 11] * F8_SW); o.w = pk4f8(x[16 * q + 12] * F8_SW, x[16 * q + 13] * F8_SW, x[16 * q + 14] * F8_SW, x[16 * q + 15] * F8_SW);
                *(LAS v4u*)(bw + 16 * q) = o; }
            unsigned char* d0 = c.dst - (size_t)lane * 2048 + (size_t)(lane >> 3) * 2048 + (lane & 7) * 16; const LAS unsigned char* br = cvbuf + (lane >> 3) * 144 + (lane & 7) * 16;
#pragma unroll
            for (int i = 0; i < 8; ++i) { const v4u v = *(const LAS v4u*)(br + i * 8 * 144); *(v4u*)(d0 + (size_t)i * 8 * 2048) = v; } }
        else {
#pragma unroll
            for (int q = 0; q < 16; ++q) { v4u o; o.x = pk2(x[8 * q + 0], x[8 * q + 1]); o.y = pk2(x[8 * q + 2], x[8 * q + 3]); o.z = pk2(x[8 * q + 4], x[8 * q + 5]); o.w = pk2(x[8 * q + 6], x[8 * q + 7]);
                *(v4u*)(c.dst + 16 * q) = o; } } }
}

__device__ __forceinline__ void mlstm_scan_unit(Frame& F, int unit, LAS unsigned* bcnt, unsigned& btarget) {
    const int b = unit >> 5, mh = (unit >> 3) & 3, sl = unit & 7;
    const bf16* P = (const bf16*)(F.ws + WS_P); const bf16* QKC = (const bf16*)(F.ws + WS_QKC); const float* GLF = (const float*)(F.ws + WS_GLF); float* HRAW = (float*)(F.ws + WS_HRAW);
    constexpr int VS = 56;
    LAS bf16* Lq = (LAS bf16*)F.lds;
    LAS bf16* Lk = Lq + 64 * 136;
    LAS bf16* Lv = Lk + 64 * 136;
    LAS bf16* Lvs = Lv + 64 * VS;
    LAS bf16* LcT = Lvs + 64 * VS;
    LAS bf16* Ls = LcT + 2 * 48 * 136;
    LAS float* sb = (LAS float*)(Ls + 64 * 72); LAS float* su = sb + 64; LAS float* smx = su + 64; LAS float* swk = smx + 64;
    const int tid = F.tid, lane = F.lane, w = F.wave, fr = lane & 15, fq = lane >> 4;
    for (int i = tid; i < 2 * 48 * 136; i += 256) LcT[i] = 0;
    for (int i = tid; i < 64 * 16; i += 256) { const int j = i >> 4, c = 32 + (i & 15); Lv[j * VS + c] = (c == 32) ? (bf16)0x3F80 : (bf16)0; Lvs[j * VS + c] = 0; }
    const int pr0 = tid >> 4, pc = 8 * (tid & 15);
    v4u rq[4], rk[4], rv; f32x4 g3;
#define ML_LOAD(ch) do { const size_t tk0_ = (size_t)b * SEQ + (ch) * 64; \
        _Pragma("unroll") for (int i_ = 0; i_ < 4; ++i_) { const bf16* s_ = QKC + (tk0_ + pr0 + 16 * i_) * 1024 + mh * 128 + pc; rq[i_] = *(const v4u*)s_; rk[i_] = *(const v4u*)(s_ + 512); } \
        rv = *(const v4u*)(P + (tk0_ + (tid >> 2)) * NINP + MLO + 1024 + mh * 256 + sl * 32 + 8 * (tid & 3)); \
        g3 = *(const f32x4*)(GLF + (tk0_ + lane) * 16 + 4 * mh); } while (0)
    f32x4 st[2][3];
#pragma unroll
    for (int a = 0; a < 2; ++a)
#pragma unroll
        for (int n = 0; n < 3; ++n) st[a][n] = (f32x4){0.f, 0.f, 0.f, 0.f};
    float mstate = 0.f;
    ML_LOAD(0);
    rw_bar(bcnt, btarget, lane);
    for (int ch = 0; ch < SEQ / 64; ++ch) {
        const size_t tk0 = (size_t)b * SEQ + ch * 64;
        LAS bf16* cTc = LcT + (ch & 1) * 48 * 136; LAS bf16* cTn = LcT + ((ch + 1) & 1) * 48 * 136;
        float mnew, dec;
        { const float bc = g3[0], u = g3[1], pm = g3[2];
          const float gtot = __shfl(bc, 63), pmall = __shfl(pm, 63);
          mnew = gtot + fmaxf(mstate, pmall); dec = __expf(gtot + mstate - mnew);
          const float wk = __expf(u + gtot - mnew);
          sb[lane] = bc; su[lane] = u; smx[lane] = fmaxf(mstate, pm); swk[lane] = wk;
          if (w == 0) Lvs[lane * VS + 32] = (bf16)f2bf(wk); }
#pragma unroll
        for (int i = 0; i < 4; ++i) { *(LAS v4u*)(Lq + (pr0 + 16 * i) * 136 + pc) = rq[i]; *(LAS v4u*)(Lk + (pr0 + 16 * i) * 136 + pc) = rk[i]; }
        LDS_WAIT();
        { const int j = tid >> 2, d0 = 8 * (tid & 3); const float wkj = swk[j]; *(LAS v4u*)(Lv + j * VS + d0) = rv;
          const unsigned uu[4] = {rv.x, rv.y, rv.z, rv.w}; v4u sv;
          sv.x = pk2(wkj * __uint_as_float(uu[0] << 16), wkj * __uint_as_float(uu[0] & 0xffff0000u)); sv.y = pk2(wkj * __uint_as_float(uu[1] << 16), wkj * __uint_as_float(uu[1] & 0xffff0000u));
          sv.z = pk2(wkj * __uint_as_float(uu[2] << 16), wkj * __uint_as_float(uu[2] & 0xffff0000u)); sv.w = pk2(wkj * __uint_as_float(uu[3] << 16), wkj * __uint_as_float(uu[3] & 0xffff0000u));
          *(LAS v4u*)(Lvs + j * VS + d0) = sv; }
        if (ch + 1 < SEQ / 64) ML_LOAD(ch + 1);
        rw_bar(bcnt, btarget, lane);
        { const int tt = w; const int t = 16 * tt + fr; const float mxt = smx[t];
#pragma unroll
          for (int jt = 0; jt < 4; ++jt) { f32x4 acc = (f32x4){0.f, 0.f, 0.f, 0.f};
              if (jt <= tt) {
#pragma unroll
                  for (int ks = 0; ks < 4; ++ks) { const s16x8 a = *(const LAS s16x8*)(Lk + (16 * jt + fr) * 136 + 32 * ks + 8 * fq), bq = *(const LAS s16x8*)(Lq + (16 * tt + fr) * 136 + 32 * ks + 8 * fq);
                      acc = __builtin_amdgcn_mfma_f32_16x16x32_bf16(a, bq, acc, 0, 0, 0); }
                  const f32x4 u4 = *(const LAS f32x4*)(su + 16 * jt + 4 * fq);
#pragma unroll
                  for (int rg_ = 0; rg_ < 4; ++rg_) { const int j = 16 * jt + 4 * fq + rg_; acc[rg_] = (j <= t) ? acc[rg_] * __expf(u4[rg_] - mxt) : 0.f; } }
              *(LAS unsigned long long*)(Ls + t * 72 + 16 * jt + 4 * fq) = pack4bf(acc); } }
        rw_bar(bcnt, btarget, lane);
        { const int mi = w; f32x4 a1[3], a2[3];
#pragma unroll
          for (int n = 0; n < 3; ++n) { a1[n] = (f32x4){0.f, 0.f, 0.f, 0.f}; a2[n] = a1[n]; }
#pragma unroll
          for (int ks = 0; ks < 2; ++ks) { const s16x8 A = *(const LAS s16x8*)(Ls + (16 * mi + fr) * 72 + 32 * ks + 8 * fq);
#pragma unroll
              for (int n = 0; n < 3; ++n) a1[n] = __builtin_amdgcn_mfma_f32_16x16x32_bf16(A, tr_frag(Lv, VS, 32 * ks + 8 * fq, 16 * n, fr), a1[n], 0, 0, 0); }
#pragma unroll
          for (int ks = 0; ks < 4; ++ks) { const s16x8 A = *(const LAS s16x8*)(Lq + (16 * mi + fr) * 136 + 32 * ks + 8 * fq);
#pragma unroll
              for (int n = 0; n < 3; ++n) a2[n] = __builtin_amdgcn_mfma_f32_16x16x32_bf16(A, *(const LAS s16x8*)(cTc + (16 * n + fr) * 136 + 32 * ks + 8 * fq), a2[n], 0, 0, 0); }
          const f32x4 mx4 = *(const LAS f32x4*)(smx + 16 * mi + 4 * fq), b4 = *(const LAS f32x4*)(sb + 16 * mi + 4 * fq);
#pragma unroll
          for (int rg_ = 0; rg_ < 4; ++rg_) { const float wi = __expf(mstate - mx4[rg_]); float den = a1[2][rg_] + wi * a2[2][rg_]; den = __shfl(den, lane & 48);
              const float mt = b4[rg_] + mx4[rg_]; const float inv = __builtin_amdgcn_rcpf(fmaxf(fabsf(den), __expf(-mt))); float* hp = HRAW + (tk0 + 16 * mi + 4 * fq + rg_) * RD + mh * 256 + sl * 32 + fr;
              hp[0] = (a1[0][rg_] + wi * a2[0][rg_]) * inv; hp[16] = (a1[1][rg_] + wi * a2[1][rg_]) * inv; } }
        {
#pragma unroll
          for (int a = 0; a < 2; ++a) {
#pragma unroll
              for (int n = 0; n < 3; ++n) st[a][n] = st[a][n] * dec;
#pragma unroll
              for (int ks = 0; ks < 2; ++ks) { const s16x8 A = tr_frag(Lk, 136, 32 * ks + 8 * fq, 16 * (2 * w + a), fr);
#pragma unroll
                  for (int n = 0; n < 3; ++n) st[a][n] = __builtin_amdgcn_mfma_f32_16x16x32_bf16(A, tr_frag(Lvs, VS, 32 * ks + 8 * fq, 16 * n, fr), st[a][n], 0, 0, 0); }
#pragma unroll
              for (int n = 0; n < 3; ++n) *(LAS unsigned long long*)(cTn + (16 * n + fr) * 136 + 16 * (2 * w + a) + 4 * fq) = pack4bf(st[a][n]); } }
        mstate = mnew;
        rw_bar(bcnt, btarget, lane);
    }
#undef ML_LOAD
}

__device__ __forceinline__ float rowsum4(f32x4 v) { return (v[0] + v[1]) + (v[2] + v[3]); }
__device__ __forceinline__ void p5_finalize(Frame& F) {
    const bf16* __restrict__ P = (const bf16*)(F.ws + WS_P); const bf16* __restrict__ AGp = (const bf16*)(F.ws + WS_WAG + 64 * MiB); const float* __restrict__ YRAW = (const float*)(F.ws + WS_YRAW); const float* __restrict__ HRAW = (const float*)(F.ws + WS_HRAW);
    bf16* __restrict__ OA = (bf16*)(F.ws + WS_OA); bf16* __restrict__ OB = (bf16*)(F.ws + WS_OB);
    const int gw = F.bid * NWAVES + F.wave, NGW = F.G * NWAVES, lane = F.lane;
    { const int hq = gw & 3, c0 = (hq * 4 + (lane >> 4)) * 64 + 4 * (lane & 15);
      const f32x4 lnw = *(const f32x4*)(F.in[I_LNW] + c0), lnb = *(const f32x4*)(F.in[I_LNB] + c0); const bf16* __restrict__ BON = (const bf16*)(F.ws + WS_WAG + 128 * MiB);
      v2u bo, gb; f32x4 y4;
#define P5_LOAD(q_) do { const int tk_ = (q_) >> 2; bo = *(const v2u*)(BON + (size_t)tk_ * RD + c0); gb = *(const v2u*)(AGp + (size_t)tk_ * D + RD + c0); y4 = *(const f32x4*)(YRAW + (size_t)tk_ * RD + c0); } while (0)
      if (gw < T * 4) P5_LOAD(gw);
      for (int q = gw; q < T * 4; q += NGW) { const int tk = q >> 2; const f32x4 bon = UNP4(bo), g = UNP4(gb), y = y4;
          if (q + NGW < T * 4) P5_LOAD(q + NGW);
          const float mean = allreduce16(rowsum4(y)) * (1.f / 64.f); const f32x4 dl = y - mean;
          const float var = allreduce16(rowsum4(dl * dl)) * (1.f / 64.f); const float rs = __builtin_amdgcn_rsqf(var + GN_EPS);
          const f32x4 o = (dl * rs * lnw + lnb + bon) * g;
          v2u ov; ov.x = pk2(o[0], o[1]); ov.y = pk2(o[2], o[3]); *(v2u*)(OA + (size_t)tk * RD + c0) = ov; }
#undef P5_LOAD
    }
    { const int mh = gw & 3, d0 = mh * 256 + 4 * lane; const f32x4 nw = *(const f32x4*)(F.in[I_MNW] + d0);
      f32x4 hv; v2u po;
#define P5B_LOAD(q_) do { const int tk_ = (q_) >> 2; hv = *(const f32x4*)(HRAW + (size_t)tk_ * RD + d0); po = *(const v2u*)(P + (size_t)tk_ * NINP + MLO + 2056 + d0); } while (0)
      if (gw < T * 4) P5B_LOAD(gw);
      for (int q = gw; q < T * 4; q += NGW) { const int tk = q >> 2; const f32x4 h4 = hv; const v2u p2 = po;
          if (q + NGW < T * 4) P5B_LOAD(q + NGW);
          float ss = allreduce16(rowsum4(h4 * h4)); ss += __shfl_xor(ss, 16); ss += __shfl_xor(ss, 32);
          const float rs = __builtin_amdgcn_rsqf(ss * (1.f / 256.f) + NORM_EPS); const f32x4 og = UNP4(p2);
          const float o0 = h4[0] * rs * nw[0] * sigm(og[0]), o1 = h4[1] * rs * nw[1] * sigm(og[1]), o2 = h4[2] * rs * nw[2] * sigm(og[2]), o3 = h4[3] * rs * nw[3] * sigm(og[3]);
          v2u o; o.x = pk2(o0, o1); o.y = pk2(o2, o3); *(v2u*)(OB + (size_t)tk * RD + d0) = o; }
#undef P5B_LOAD
    }
}

typedef float f32x16 __attribute__((ext_vector_type(16)));
__device__ __forceinline__ void p8_route(Frame& F) {
    const bf16* X1 = (const bf16*)(F.ws + WS_X1); unsigned char* H2 = (unsigned char*)(F.ws + WS_HN); int* RLIST = (int*)(F.ws + WS_RLIST); float* RWT = (float*)(F.ws + WS_RW);
    const float* RWS = (const float*)(F.ws + WS_RWS); const float* nw = F.in[I_N2W]; const float* rtb = F.in[I_RTB];
    LAS float* part = (LAS float*)F.lds;
    LAS float* ssq = part + 8 * 32 * 33;
    LAS float* lgt = ssq + 256;
    LAS float* srs = lgt + 32 * 33;
    const int lane = F.lane, w = F.wave, i = lane & 31, h = lane >> 5, tid = F.tid;
    for (int tile = F.bid; tile < T / 32; tile += F.G) {
        const int m0 = tile * 32; const bf16* xrow = X1 + (size_t)(m0 + i) * D + 256 * w + 4 * h;
        f32x16 acc;
#pragma unroll
        for (int r_ = 0; r_ < 16; ++r_) acc[r_] = 0.f;
        float ss = 0.f; const float* bp = RWS + (size_t)(256 * w + 4 * h) * NE + i;
#pragma unroll 4
        for (int q = 0; q < 32; ++q) { const v2u xb_ = *(const v2u*)(xrow + 8 * q); const f32x4 xa = UNP4(xb_);
#pragma unroll
            for (int j = 0; j < 4; ++j) acc = __builtin_amdgcn_mfma_f32_32x32x2f32(xa[j], bp[(8 * q + j) * NE], acc, 0, 0, 0);
            ss += (xa[0] * xa[0] + xa[1] * xa[1]) + (xa[2] * xa[2] + xa[3] * xa[3]); }
        ss += __shfl_xor(ss, 32);
        if (h == 0) ssq[w * 32 + i] = ss;
#pragma unroll
        for (int r_ = 0; r_ < 16; ++r_) part[(w * 32 + (r_ & 3) + 8 * (r_ >> 2) + 4 * h) * 33 + i] = acc[r_];
        __syncthreads();
#pragma unroll
        for (int k2 = 0; k2 < 2; ++k2) { const int idx = tid + NTHR * k2, ii = idx >> 5, e = idx & 31; float sm = 0.f, sq = 0.f;
#pragma unroll
            for (int ww = 0; ww < 8; ++ww) { sm += part[(ww * 32 + ii) * 33 + e]; sq += ssq[ww * 32 + ii]; }
            const float rs = 1.f / sqrtf(sq * (1.f / D) + NORM_EPS); lgt[ii * 33 + e] = sm * rs + rtb[e]; if (e == 0) srs[ii] = rs; }
        __syncthreads();
        { const float rs = srs[i] * F8_SX; unsigned char* orow = H2 + (size_t)(m0 + i) * D + 256 * w + 4 * h;
#pragma unroll 8
          for (int q = 0; q < 32; ++q) { const f32x4 n4 = *(const f32x4*)(nw + 256 * w + 4 * h + 8 * q); const v2u xb_ = *(const v2u*)(xrow + 8 * q); const f32x4 hv = UNP4(xb_) * rs * n4; *(unsigned*)(orow + 8 * q) = pk4f8(hv[0], hv[1], hv[2], hv[3]); } }
        if (tid < 32) { const LAS float* lr = lgt + tid * 33; unsigned used = 0u; int idx[4]; float val[4];
#pragma unroll
            for (int s4 = 0; s4 < 4; ++s4) { float best = -INFINITY; int bi = 0;
                for (int e = 0; e < 32; ++e) { const float v = lr[e]; const bool ok = !((used >> e) & 1u) && (v > best); best = ok ? v : best; bi = ok ? e : bi; }
                used |= 1u << bi; idx[s4] = bi; val[s4] = best; }
            const float e1 = __expf(val[1] - val[0]), e2 = __expf(val[2] - val[0]), e3 = __expf(val[3] - val[0]); const float inv = 1.f / (1.f + e1 + e2 + e3);
            const float wv[4] = {inv, e1 * inv, e2 * inv, e3 * inv};
            unsigned pos[4];
#pragma unroll
            for (int s4 = 0; s4 < 4; ++s4) pos[s4] = atomicAdd(F.ctl + CW_CNT + 64 * idx[s4], 1u);
#pragma unroll
            for (int s4 = 0; s4 < 4; ++s4) { RLIST[idx[s4] * ECAP + pos[s4]] = (m0 + tid) * 4 + s4; RWT[idx[s4] * ECAP + pos[s4]] = wv[s4]; } }
        __syncthreads();
    }
}

__device__ __forceinline__ void build_moe_tables(Frame& F) {
    LAS int* MI = (LAS int*)F.MISC;
    __syncthreads();
    if (F.tid < NE) MI[MI_CNT + F.tid] = (int)__hip_atomic_load(F.ctl + CW_CNT + 64 * F.tid, __ATOMIC_RELAXED, __HIP_MEMORY_SCOPE_AGENT);
    __syncthreads();
    if (F.tid == 0) { int mt = 0, cs = 0;
        for (int e = 0; e < NE; ++e) { const int c = MI[MI_CNT + e]; MI[MI_POFF + e] = mt * 256; MI[MI_CST + e] = cs; cs += c;
            const int nt = (c + 255) >> 8; for (int i = 0; i < nt; ++i) { MI[MI_TILE_E + mt + i] = e; MI[MI_TILE_I0 + mt + i] = i * 256; } mt += nt; }
        MI[MI_CST + NE] = cs; MI[MI_MT] = mt; }
    __syncthreads();
}
__device__ __forceinline__ void p9_gather(Frame& F) {
    build_moe_tables(F);
    const LAS int* MI = (const LAS int*)F.MISC; const bf16* H2 = (const bf16*)(F.ws + WS_HN); bf16* XB = (bf16*)(F.ws + WS_XB); const int* RLIST = (const int*)(F.ws + WS_RLIST);
    const int gw = F.bid * NWAVES + F.wave, NGW = F.G * NWAVES, total = MI[MI_CST + NE];
    for (int q = gw; q < total; q += NGW) { int e = 0;
        for (int k = 1; k < NE; ++k) e = (MI[MI_CST + k] <= q) ? k : e;
        const int i = q - MI[MI_CST + e]; const int tok = RLIST[e * ECAP + i] >> 2;
        const v4u* src = (const v4u*)(H2 + (size_t)tok * D) + F.lane; v4u* dst = (v4u*)(XB + (size_t)(MI[MI_POFF + e] + i) * D) + F.lane;
#pragma unroll
        for (int j = 0; j < 4; ++j) dst[64 * j] = src[64 * j]; }
}
__device__ __forceinline__ void p12_final(Frame& F) {
    const bf16* X1 = (const bf16*)(F.ws + WS_X1); const unsigned char* YS = (const unsigned char*)(F.ws + WS_YS); const float* fw = F.in[I_FNW];
    const int gw = F.bid * NWAVES + F.wave, NGW = F.G * NWAVES;
    for (int m = gw; m < T; m += NGW) {
        const v2u* xr = (const v2u*)(X1 + (size_t)m * D) + F.lane; f32x4 v[8]; float s = 0.f;
#pragma unroll
        for (int j = 0; j < 8; ++j) { const v2u xb_ = xr[64 * j]; v[j] = UNP4(xb_);
#pragma unroll
            for (int sl = 0; sl < 4; ++sl) { const int y = ((const int*)(YS + ((size_t)m * 4 + sl) * D))[F.lane + 64 * j];
                const f32x2 ylo = __builtin_amdgcn_cvt_pk_f32_fp8(y, false), yhi = __builtin_amdgcn_cvt_pk_f32_fp8(y, true);
                v[j][0] += ylo[0] * (1.f / F8_SY); v[j][1] += ylo[1] * (1.f / F8_SY); v[j][2] += yhi[0] * (1.f / F8_SY); v[j][3] += yhi[1] * (1.f / F8_SY); }
            s += (v[j][0] * v[j][0] + v[j][1] * v[j][1]) + (v[j][2] * v[j][2] + v[j][3] * v[j][3]); }
        const float rstd = __builtin_amdgcn_rsqf(wave_sum(s) * (1.f / D) + NORM_EPS);
        f32x4* orow = (f32x4*)(F.out + (size_t)m * D) + F.lane;
#pragma unroll
        for (int j = 0; j < 8; ++j) { const f32x4 w = ((const f32x4*)fw)[F.lane + 64 * j]; orow[64 * j] = v[j] * rstd * w; }
    }
}

__global__ void __launch_bounds__(NTHR, 2) mk_fwd(Args args) {
    extern __shared__ __attribute__((aligned(16))) unsigned char lds[];
    Frame F;
    F.lds = (LAS unsigned char*)lds; F.MISC = (volatile LAS unsigned*)(F.lds + MISC_OFF);
    F.tid = threadIdx.x; F.lane = F.tid & 63; F.wave = __builtin_amdgcn_readfirstlane(F.tid >> 6); F.G = gridDim.x; F.bid = blockIdx.x;
    F.in = args.in; F.out = args.out; F.ws = args.ws; F.ctl = (unsigned*)(args.ws + WS_CTL);
    for (int u = F.tid; u < (LDS_BYTES - MISC_OFF) / 4; u += NTHR) ((LAS unsigned*)(F.lds + MISC_OFF))[u] = 0u;
    __syncthreads();
    XcdBarrier bar; bar.bar = F.ctl + CW_BAR; bar.x = 0; bar.st = nullptr;
    if (MK_N_LAUNCHES == 1) bar = xcd_barrier_post(F.ctl + CW_BAR, F.MISC + 8);
    const int lo = args.ph_lo, hi = args.ph_hi;
#define IN(k) (lo <= (k) && (k) < hi)
#ifndef PROBE_PHASE
#define PROBE_PHASE -1
#endif
#define REP(k) ((PROBE_PHASE) == (k) ? 2 : 1)
#define SEAM(k) do { if (IN(k) && IN((k) + 1)) xcd_barrier(bar); } while (0)
    LAS unsigned char* ring = F.lds;
    const LAS int* MI = (const LAS int*)F.MISC;

    static_assert(MK_N_LAUNCHES == 1, "the W_in quantisation needs an in-launch barrier inside phase 0");
    if (IN(0)) { p0_prologue(F); xcd_barrier(bar); p0b_win(F); } SEAM(0);
    if (IN(1)) {
        const int ng = F.G > 2 * NCV ? F.G - NCV : F.G;
        if (F.bid < ng) {
            pg8::Gemm g{(const bf16*)(F.ws + WS_HN), (const bf16*)(F.ws + WS_WIN), T, NINP, D / 2}; pg8::StaticOrder S; S.init(T, NINP, ng, F.bid);
            EpiP1I8 E{(bf16*)(F.ws + WS_P), NINP, (const float*)(F.ws + WS_RA), F.ctl + CW_COLMAX};
            pg8::gemm_phase<EpiP1I8, pg8::StaticOrder, true, true, false, true>(ring, g, S, E);
            if (F.tid == 0) __hip_atomic_fetch_add(F.ctl + CW_P1DONE, 1u, __ATOMIC_RELAXED, __HIP_MEMORY_SCOPE_AGENT);
        } else if (F.wave >= CV1_W0) convert_loop(F, F.ctl + CW_CVNEXT, F.ctl + CW_P1DONE, (unsigned)ng, F.lds + F.wave * 9216);
    } SEAM(1);
    if (IN(2)) { for (int rep = 0; rep < REP(2); ++rep) p2_lora_in(F); } SEAM(2);
    if (IN(3)) {
        pg8::Gemm g{(const bf16*)(F.ws + WS_LIN), (const bf16*)(F.ws + WS_WL), T, 3072, 512}; pg8::StaticOrder S; S.init(T, 3072, F.G, F.bid);
        EpiLora E{(float*)(F.ws + WS_WAG), (bf16*)(F.ws + WS_WAG + 64 * MiB), F.in[I_W0], F.in[I_A0]};
        pg8::gemm_phase<EpiLora, pg8::StaticOrder, true, true>(ring, g, S, E);
    } SEAM(3);
    if (IN(4)) {
        { LAS unsigned* ctl2 = (LAS unsigned*)F.MISC + 16;
          if (F.wave < 4) { unsigned bt = 0u; for (int rep = 0; rep < REP(40); ++rep) for (int u = F.bid; u < 256; u += F.G) rwkv_chunk_unit(F, u, (LAS unsigned char*)F.MISC + 256, ctl2, bt); }
          else { Frame F2 = F; F2.tid = F.tid - 256; F2.wave = F.wave - 4; F2.lds = F.lds + 45056; unsigned bt = 0u;
                 for (int rep = 0; rep < REP(41); ++rep) for (int u = F.bid; u < 256; u += F.G) mlstm_scan_unit(F2, u, ctl2 + 2, bt);
                 rw_bar(ctl2 + 2, bt, F2.lane); }
          if (F.wave >= CV_W0) convert_loop(F, F.ctl + CW_CVNEXT, nullptr, 0u, F.lds + 45056 + (F.wave - 4) * 9216);
          __syncthreads(); }
    } SEAM(4);
    if (IN(5)) { for (int rep = 0; rep < REP(5); ++rep) p5_finalize(F); } SEAM(5);
    if (IN(6)) {
        { pg8::Gemm g{(const bf16*)(F.ws + WS_OA), (const bf16*)(F.ws + WS_WA), T, D, RD}; pg8::StaticOrder S; S.init(T, D, F.G, F.bid);
          EpiGateA E{(bf16*)(F.ws + WS_TMP), (const bf16*)(F.ws + WS_P), F.in[I_BGATE]};
          pg8::gemm_phase<EpiGateA, pg8::StaticOrder, true, true>(ring, g, S, E); }
        VM_WAIT(); __syncthreads();
        { pg8::Gemm g{(const bf16*)(F.ws + WS_OB), (const bf16*)(F.ws + WS_WB), T, D, RD}; pg8::StaticOrder S; S.init(T, D, F.G, F.bid);
          EpiGateB E{(const bf16*)(F.ws + WS_TMP), (bf16*)(F.ws + WS_MRG), (const bf16*)(F.ws + WS_P), F.in[I_BGATE]};
          pg8::gemm_phase<EpiGateB, pg8::StaticOrder, true, true>(ring, g, S, E); }
    } SEAM(6);
    if (IN(7)) {
        pg8::Gemm g{(const bf16*)(F.ws + WS_MRG), (const bf16*)(F.ws + WS_WO), T, D, D}; pg8::StaticOrder S; S.init(T, D, F.G, F.bid);
        EpiResid E{F.in[I_X], (bf16*)(F.ws + WS_X1)};
        pg8::gemm_phase<EpiResid, pg8::StaticOrder, true, true>(ring, g, S, E);
    } SEAM(7);
    if (IN(8)) { p8_route(F); } SEAM(8);
    if (IN(10)) {
        build_moe_tables(F);
        const int mt = MI[MI_MT];
        pg8::Gemm g{(const bf16*)(F.ws + WS_HN), (const bf16*)(F.ws + WS_WGU), mt * 256, 2 * FF, D / 2};
        MoeGatherOrder S; S.init(mt * 256, 2 * FF, F.G, F.bid); S.tile_e = MI + MI_TILE_E; S.estride = (size_t)2 * FF * D;
        S.tile_i0 = MI + MI_TILE_I0; S.cnt = MI + MI_CNT; S.rlist = (const int*)(F.ws + WS_RLIST); S.rowoff = (LAS unsigned*)F.MISC + MI_ROWOFF; S.rowbytes = D;
        EpiSwiGLU E{(unsigned char*)(F.ws + WS_ACT), F.in[I_BGU], MI + MI_TILE_E};
        pg8::gemm_phase<EpiSwiGLU, MoeGatherOrder, true, true, true>(ring, g, S, E);
    } SEAM(10);
    if (IN(11)) {
        build_moe_tables(F);
        const int mt = MI[MI_MT];
        pg8::Gemm g{(const bf16*)(F.ws + WS_ACT), (const bf16*)(F.ws + WS_WDN), mt * 256, D, FF / 2};
        MoeOrder S; S.init(mt * 256, D, F.G, F.bid); S.tile_e = MI + MI_TILE_E; S.estride = (size_t)D * FF;
        LAS int* rowdst = (LAS int*)F.MISC + MI_ROWOFF; LAS float* rowwt = (LAS float*)F.MISC + MI_ROWOFF + 10 * 256;
        fill_down_tables(F, S, rowdst, rowwt);
        EpiDown E{(unsigned char*)(F.ws + WS_YS), F.in[I_BDN], MI + MI_TILE_E, rowdst, rowwt};
        pg8::gemm_phase<EpiDown, MoeOrder, true, true, true>(ring, g, S, E);
    } SEAM(11);
    if (IN(12)) { for (int rep = 0; rep < REP(12); ++rep) p12_final(F); }
#undef IN
#undef SEAM
}

extern "C" void kernel_launch(void* const* d_in, const int* in_sizes, int n_in, void* d_out, int out_size, void* d_ws, size_t ws_size, hipStream_t stream) {
    static int grid = 0;
    if (grid == 0) {
        if (n_in != 30 || out_size != T * D || ws_size < WS_END) { fprintf(stderr, "kernel_launch: unexpected problem (n_in %d, out %d, ws %zu)\n", n_in, out_size, ws_size); grid = -1; return; }
        int dev = 0, cus = 0, per_cu = 0;
        if (hipGetDevice(&dev) != hipSuccess || hipDeviceGetAttribute(&cus, hipDeviceAttributeMultiprocessorCount, dev) != hipSuccess) { grid = -1; return; }
        if (hipFuncSetAttribute((const void*)mk_fwd, hipFuncAttributeMaxDynamicSharedMemorySize, LDS_BYTES) != hipSuccess) { fprintf(stderr, "kernel_launch: hipFuncSetAttribute failed\n"); grid = -1; return; }
        if (hipOccupancyMaxActiveBlocksPerMultiprocessor(&per_cu, (const void*)mk_fwd, NTHR, LDS_BYTES) != hipSuccess || per_cu < 1) fprintf(stderr, "kernel_launch: occupancy query says %d\n", per_cu);
        (void)hipGetLastError();
        grid = cus;
    }
    if (grid < 0) return;
    if (hipMemsetAsync((char*)d_ws + WS_CTL, 0, CTL_ZERO_BYTES, stream) != hipSuccess) return;
    Args a{};
    for (int i = 0; i < 30; ++i) a.in[i] = (const float*)d_in[i];
    a.out = (float*)d_out; a.ws = (unsigned char*)d_ws;
    for (int li = 0; li < MK_N_LAUNCHES; ++li) {
        a.ph_lo = (MK_N_LAUNCHES == 1) ? 0 : li; a.ph_hi = (MK_N_LAUNCHES == 1) ? NPH : li + 1;
        hipLaunchKernelGGL(mk_fwd, dim3(grid), dim3(NTHR), LDS_BYTES, stream, a);
        const hipError_t le = hipPeekAtLastError();
        if (le != hipSuccess) { fprintf(stderr, "kernel_launch: launch %d failed: %s\n", li, hipGetErrorName(le)); break; }
    }
}
```

```cpp
#include <hip/hip_runtime.h>
#include <cstdio>
#include <cstdint>

#define MK_N_LAUNCHES 1
#define PROBE_PHASE -1
namespace pg8 {
#define PG8_LAS __attribute__((address_space(3)))
typedef unsigned short bf16_t;
typedef short bf16x8 __attribute__((ext_vector_type(8)));
typedef float f32x4 __attribute__((ext_vector_type(4)));
typedef unsigned u32x4 __attribute__((ext_vector_type(4)));
constexpr int BM = 256, BK = 64, HALF = 128, HTB = HALF * BK * 2  , STAGE_BYTES = 8 * HTB, NXCD = 8, WGM = 8;

__host__ __device__ __forceinline__ int lds_byte(int r, int c) { const int st = (r >> 4) * 2 + (c >> 5), rr = r & 15, cc = c & 31, ob = rr * 64 + cc * 2; return st * 1024 + (ob ^ (((ob >> 9) & 1) << 5)); }
__host__ __device__ __forceinline__ void stage_rc(int b, int& R, int& C) { const int st = b / 1024, sb = b % 1024, swz = sb ^ (((sb >> 9) & 1) << 5); R = (st >> 1) * 16 + swz / 64; C = (st & 1) * 32 + (swz % 64) / 2; }
__host__ __device__ __forceinline__ int perm32(int rho) { const int n = rho >> 4, i = rho & 15; return 8 * (i >> 2) + 4 * n + (i & 3); }

struct Unit { int pm, pn, ord; };
struct Gemm { const bf16_t* A; const bf16_t* Bt; int M, N, K; };

struct StaticOrder {
    int nM, nN, nwg, G, c;
    __host__ __device__ void init(int M, int N, int G_, int c_) { nM = M / BM; nN = N / BM; nwg = nM * nN; G = G_; c = c_; }
    __host__ __device__ bool next(int i, Unit& u) const {
        const long L = (long)i * G + c; if (L >= nwg) return false;
        int wgid = (int)L; { const int q = nwg / NXCD, r = nwg % NXCD, xcd = wgid % NXCD, off = wgid / NXCD; wgid = (xcd < r ? xcd * (q + 1) : r * (q + 1) + (xcd - r) * q) + off; }
        const int nig = WGM * nN, gid = wgid / nig, fm = gid * WGM, gsz = (nM - fm) < WGM ? (nM - fm) : WGM;
        u.pm = fm + ((wgid % nig) % gsz); u.pn = (wgid % nig) / gsz; u.ord = i; return true;
    }
    __device__ __forceinline__ void a_ready(const Unit&) const {}
    static constexpr bool GATHER = false;
    __device__ __forceinline__ void fill_all() const {}
    __device__ __forceinline__ unsigned row_off(int, int) const { return 0u; }
    __device__ __forceinline__ void done(const Unit&) const {}
    __device__ __forceinline__ size_t a_off(const Unit& u, size_t tstep) const { return (size_t)u.pm * tstep; }
    __device__ __forceinline__ size_t b_off(const Unit& u, size_t tstep) const { return (size_t)u.pn * tstep; }
};
__device__ __forceinline__ unsigned cvt_pk_bf16(float lo, float hi) { unsigned r; asm volatile("v_cvt_pk_bf16_f32 %0, %1, %2" : "=v"(r) : "v"(lo), "v"(hi)); return r; }
typedef int v8i32 __attribute__((ext_vector_type(8)));
typedef int v4i32 __attribute__((ext_vector_type(4)));
__device__ __forceinline__ v8i32 cat8(bf16x8 lo, bf16x8 hi) { const v4i32 a = __builtin_bit_cast(v4i32, lo), b = __builtin_bit_cast(v4i32, hi); return __builtin_shufflevector(a, b, 0, 1, 2, 3, 4, 5, 6, 7); }
template <class Epi, class Sched, bool ALIGN_EPI = false, bool SP2 = false, bool FP8 = false, bool I8 = false>
__device__ __forceinline__ void gemm_phase(PG8_LAS unsigned char* lds, const Gemm g, const Sched& S, const Epi& E) {
    const int tid = threadIdx.x, wid = __builtin_amdgcn_readfirstlane(tid >> 6), lane = tid & 63, wr = wid >> 2, wc = wid & 3, fr = lane & 15, fq = lane >> 4;
    const int K = g.K, nt = K / BK;
    unsigned voffA[2], voffB[2];
#pragma unroll
    for (int i = 0; i < 2; ++i) { int R, C; stage_rc(tid * 16 + i * 8192, R, C); const int Rb = Epi::PERM ? ((R & ~31) + perm32(R & 31)) : R;
        voffA[i] = (unsigned)(R * K + C) * 2u; voffB[i] = (unsigned)(Rb * K + C) * 2u; }
    unsigned voffA1[2]; int rselA[2]; unsigned cselA[2];
#pragma unroll
    for (int i = 0; i < 2; ++i) { int R, C; stage_rc(tid * 16 + i * 8192, R, C); rselA[i] = R; cselA[i] = (unsigned)C * 2u; voffA1[i] = voffA[i]; }
    const size_t kstep = (size_t)(BK * 2);
    const size_t hstep = (size_t)HALF * K * 2;
    const size_t tstep = 2 * hstep;
    const size_t hstepA = Sched::GATHER ? (size_t)0 : hstep;
#define PG8_ROWS(_u) do { _Pragma("unroll") for (int _i = 0; _i < 2; ++_i) { voffA[_i] = S.row_off((_u), rselA[_i]) + cselA[_i]; voffA1[_i] = S.row_off((_u), HALF + rselA[_i]) + cselA[_i]; } } while (0)
    const unsigned ldsw = (unsigned)wid * 1024u;
    const int aoff = lds_byte(wr * 64 + fr, fq * 8), boff = lds_byte(wc * 32 + fr, fq * 8);
#define PG8_SA(b, h) (((b) * 2 + (h)) * HTB)
#define PG8_SB(b, h) ((4 + (b) * 2 + (h)) * HTB)
#define PG8_STAGE(bufoff, gbase, voff) do { _Pragma("unroll") for (int _i = 0; _i < 2; ++_i) \
        __builtin_amdgcn_global_load_lds((const unsigned*)((const char*)(gbase) + (voff)[_i]), (PG8_LAS unsigned*)(lds + (bufoff) + ldsw + _i * 8192), 16, 0, 0); } while (0)
#define PG8_LDA(dst, b, h) do { if constexpr (FP8) { _Pragma("unroll") for (int m = 0; m < 4; ++m) dst##8[m] = cat8(*(const PG8_LAS bf16x8*)(lds + PG8_SA(b, h) + aoff + m * 2048), *(const PG8_LAS bf16x8*)(lds + PG8_SA(b, h) + aoff + m * 2048 + 1024)); } \
        else { _Pragma("unroll") for (int m = 0; m < 4; ++m) _Pragma("unroll") for (int k = 0; k < 2; ++k) dst[m][k] = *(const PG8_LAS bf16x8*)(lds + PG8_SA(b, h) + aoff + m * 2048 + k * 1024); } } while (0)
#define PG8_LDB(dst, b, h) do { if constexpr (FP8) { _Pragma("unroll") for (int n = 0; n < 2; ++n) dst##8[n] = cat8(*(const PG8_LAS bf16x8*)(lds + PG8_SB(b, h) + boff + n * 2048), *(const PG8_LAS bf16x8*)(lds + PG8_SB(b, h) + boff + n * 2048 + 1024)); } \
        else { _Pragma("unroll") for (int n = 0; n < 2; ++n) _Pragma("unroll") for (int k = 0; k < 2; ++k) dst[n][k] = *(const PG8_LAS bf16x8*)(lds + PG8_SB(b, h) + boff + n * 2048 + k * 1024); } } while (0)
#define PG8_MMA(ai, bj, At, Bt) do { __builtin_amdgcn_s_setprio(1); if constexpr (FP8) { _Pragma("unroll") for (int m = 0; m < 4; ++m) _Pragma("unroll") for (int n = 0; n < 2; ++n) \
        asm volatile("v_mfma_scale_f32_16x16x128_f8f6f4 %0, %1, %2, %0, %3, %3 op_sel_hi:[0,0,0]" : "+v"(acc[ai][bj][m][n]) : "v"(Bt##8[n]), "v"(At##8[m]), "v"(f8scale)); } else { \
        _Pragma("unroll") for (int m = 0; m < 4; ++m) _Pragma("unroll") for (int n = 0; n < 2; ++n) _Pragma("unroll") for (int k = 0; k < 2; ++k) { \
        if constexpr (I8) acc[ai][bj][m][n] = __builtin_bit_cast(f32x4, __builtin_amdgcn_mfma_i32_16x16x64_i8(__builtin_bit_cast(v4i32, Bt[n][k]), __builtin_bit_cast(v4i32, At[m][k]), __builtin_bit_cast(v4i32, acc[ai][bj][m][n]), 0, 0, 0)); \
        else acc[ai][bj][m][n] = __builtin_amdgcn_mfma_f32_16x16x32_bf16(Bt[n][k], At[m][k], acc[ai][bj][m][n], 0, 0, 0); } } __builtin_amdgcn_s_setprio(0); } while (0)
#define PG8_WAIT_V(n) asm volatile("s_waitcnt vmcnt(" #n ")" ::: "memory")
#define PG8_WAIT_L(n) asm volatile("s_waitcnt lgkmcnt(" #n ")" ::: "memory")
#define PG8_BAR __builtin_amdgcn_s_barrier()
#define PG8_SCHED __builtin_amdgcn_sched_barrier(0)
    Unit cur, nxt; int ui = 0;
    if (!S.next(0, cur)) return;
    f32x4 acc[2][2][4][2];
#pragma unroll
    for (int a = 0; a < 2; ++a)
#pragma unroll
        for (int b = 0; b < 2; ++b)
#pragma unroll
            for (int m = 0; m < 4; ++m)
#pragma unroll
                for (int n = 0; n < 2; ++n) acc[a][b][m][n] = (f32x4){0.f, 0.f, 0.f, 0.f};
    const int f8scale = 0x7f7f7f7f;
    bf16x8 At[4][2], B0[2][2], B1[2][2]; v8i32 At8[4], B08[2], B18[2];
    const char* cA = (const char*)g.A + S.a_off(cur, tstep); const char* cB = (const char*)g.Bt + S.b_off(cur, tstep);
    S.a_ready(cur);
    if constexpr (Sched::GATHER) { S.fill_all(); asm volatile("s_waitcnt vmcnt(0) lgkmcnt(0)" ::: "memory"); __builtin_amdgcn_s_barrier(); asm volatile("" ::: "memory"); PG8_ROWS(0); }
    if constexpr (SP2) {
        PG8_STAGE(PG8_SB(0, 0), cB, voffB); PG8_STAGE(PG8_SB(0, 1), cB + hstep, voffB); PG8_STAGE(PG8_SA(0, 0), cA, voffA); PG8_STAGE(PG8_SA(0, 1), cA + hstepA, voffA1);
        if (wr == 1) PG8_BAR;
        PG8_WAIT_V(2); PG8_BAR;
        PG8_STAGE(PG8_SB(1, 0), cB + kstep, voffB); PG8_STAGE(PG8_SA(1, 0), cA + kstep, voffA); PG8_STAGE(PG8_SB(1, 1), cB + hstep + kstep, voffB);
        PG8_WAIT_V(6); PG8_BAR;
    } else {
        PG8_STAGE(PG8_SB(0, 0), cB, voffB); PG8_STAGE(PG8_SA(0, 0), cA, voffA); PG8_STAGE(PG8_SB(0, 1), cB + hstep, voffB); PG8_STAGE(PG8_SA(0, 1), cA + hstepA, voffA1);
        if (wr == 1) PG8_BAR;
        PG8_WAIT_V(4); PG8_BAR;
        PG8_STAGE(PG8_SB(1, 0), cB + kstep, voffB); PG8_STAGE(PG8_SA(1, 0), cA + kstep, voffA); PG8_STAGE(PG8_SB(1, 1), cB + hstep + kstep, voffB);
        PG8_WAIT_V(6); PG8_BAR;
    }
    for (;;) {
        const bool has_next = S.next(ui + 1, nxt);
        const char* nA = has_next ? (const char*)g.A + S.a_off(nxt, tstep) : cA; const char* nB = has_next ? (const char*)g.Bt + S.b_off(nxt, tstep) : cB;
        for (int t = 0; t < nt; t += 2) {
            const bool last = (t == nt - 2);
            const char* a1 = cA + (size_t)(t + 1) * kstep;
            const char* a2 = last ? nA : cA + (size_t)(t + 2) * kstep; const char* b2 = last ? nB : cB + (size_t)(t + 2) * kstep;
            const char* a3 = a2 + kstep; const char* b3 = b2 + kstep;
            if (last && has_next) S.a_ready(nxt);
            if constexpr (SP2) {
            PG8_LDB(B0, 0, 0); PG8_LDB(B1, 0, 1); PG8_SCHED; PG8_LDA(At, 0, 0); PG8_STAGE(PG8_SA(1, 1), a1 + hstepA, voffA1);
            PG8_WAIT_V(8); PG8_WAIT_L(0); PG8_BAR; PG8_MMA(0, 0, At, B0); PG8_MMA(0, 1, At, B1); PG8_BAR; PG8_SCHED;
            if constexpr (Sched::GATHER) { if (last && has_next) PG8_ROWS(ui + 1); }
            PG8_LDA(At, 0, 1); PG8_STAGE(PG8_SB(0, 0), b2, voffB); PG8_STAGE(PG8_SB(0, 1), b2 + hstep, voffB); PG8_STAGE(PG8_SA(0, 0), a2, voffA);
            PG8_WAIT_V(8); PG8_WAIT_L(0); PG8_BAR; PG8_MMA(1, 0, At, B0); PG8_MMA(1, 1, At, B1); PG8_BAR; PG8_SCHED;
            PG8_LDB(B0, 1, 0); PG8_LDB(B1, 1, 1); PG8_SCHED; PG8_LDA(At, 1, 0); PG8_STAGE(PG8_SA(0, 1), a2 + hstepA, voffA1);
            PG8_WAIT_V(8); PG8_WAIT_L(0); PG8_BAR; PG8_MMA(0, 0, At, B0); PG8_MMA(0, 1, At, B1); PG8_BAR; PG8_SCHED;
            PG8_LDA(At, 1, 1); PG8_STAGE(PG8_SB(1, 0), b3, voffB); PG8_STAGE(PG8_SB(1, 1), b3 + hstep, voffB); PG8_STAGE(PG8_SA(1, 0), a3, voffA);
            PG8_WAIT_V(8); PG8_WAIT_L(0); PG8_BAR; PG8_MMA(1, 0, At, B0); PG8_MMA(1, 1, At, B1); PG8_BAR; PG8_SCHED;
            } else {
            PG8_LDB(B0, 0, 0); PG8_SCHED; PG8_LDA(At, 0, 0); PG8_STAGE(PG8_SA(1, 1), a1 + hstepA, voffA1);
            PG8_WAIT_L(8); PG8_BAR; PG8_WAIT_L(0); PG8_MMA(0, 0, At, B0); PG8_BAR; PG8_SCHED;
            PG8_LDB(B1, 0, 1); PG8_STAGE(PG8_SB(0, 0), b2, voffB);
            PG8_BAR; PG8_WAIT_L(0); PG8_MMA(0, 1, At, B1); PG8_BAR;
            PG8_LDA(At, 0, 1); PG8_STAGE(PG8_SA(0, 0), a2, voffA);
            PG8_BAR; PG8_WAIT_L(0); PG8_MMA(1, 0, At, B0); PG8_BAR; PG8_SCHED;
            PG8_STAGE(PG8_SB(0, 1), b2 + hstep, voffB);
            PG8_WAIT_V(6); PG8_BAR; PG8_MMA(1, 1, At, B1); PG8_BAR;
            PG8_LDB(B0, 1, 0); PG8_SCHED; PG8_LDA(At, 1, 0); PG8_STAGE(PG8_SA(0, 1), a2 + hstepA, voffA1);
            PG8_WAIT_L(8); PG8_BAR; PG8_WAIT_L(0); PG8_MMA(0, 0, At, B0); PG8_BAR; PG8_SCHED;
            PG8_LDB(B1, 1, 1); PG8_STAGE(PG8_SB(1, 0), b3, voffB);
            PG8_BAR; PG8_WAIT_L(0); PG8_MMA(0, 1, At, B1); PG8_BAR;
            PG8_LDA(At, 1, 1); PG8_STAGE(PG8_SA(1, 0), a3, voffA);
            PG8_BAR; PG8_WAIT_L(0); PG8_MMA(1, 0, At, B0); PG8_BAR; PG8_SCHED;
            PG8_STAGE(PG8_SB(1, 1), b3 + hstep, voffB);
            PG8_WAIT_V(6); PG8_BAR; PG8_MMA(1, 1, At, B1); PG8_BAR;
            }
        }
        if constexpr (ALIGN_EPI) { if (wr == 0) PG8_BAR; }
        if constexpr (FP8) { asm volatile("s_nop 15\n\ts_nop 15" ::: "memory"); }
        if constexpr (!Epi::AFTER_DRAIN) { E(acc, cur, wr, wc, fr, fq); S.done(cur); }
        if (!has_next) break;
#pragma unroll
        for (int a = 0; a < 2; ++a)
#pragma unroll
            for (int b = 0; b < 2; ++b)
#pragma unroll
                for (int m = 0; m < 4; ++m)
#pragma unroll
                    for (int n = 0; n < 2; ++n) acc[a][b][m][n] = (f32x4){0.f, 0.f, 0.f, 0.f};
        cur = nxt; cA = nA; cB = nB; ++ui;
        if constexpr (ALIGN_EPI) { if (wr == 1) PG8_BAR; }
    }
    PG8_WAIT_V(0);
    if constexpr (!ALIGN_EPI) { if (wr == 0) PG8_BAR; }
    PG8_BAR;
    if constexpr (Epi::AFTER_DRAIN) { E.fused(acc, cur, wr, wc, fr, fq, lds, wid, lane); S.done(cur); }
#undef PG8_ROWS
#undef PG8_SA
#undef PG8_SB
#undef PG8_STAGE
#undef PG8_LDA
#undef PG8_LDB
#undef PG8_MMA
#undef PG8_WAIT_V
#undef PG8_WAIT_L
#undef PG8_BAR
#undef PG8_SCHED
}
}

#ifndef MK_N_LAUNCHES
#define MK_N_LAUNCHES 1
#endif
#define GAS __attribute__((address_space(1)))
#define LAS __attribute__((address_space(3)))
typedef unsigned short bf16;
typedef unsigned v4u __attribute__((ext_vector_type(4)));
typedef unsigned v2u __attribute__((ext_vector_type(2)));
typedef float f32x4 __attribute__((ext_vector_type(4)));
typedef float f32x2 __attribute__((ext_vector_type(2)));

constexpr int NWAVES = 8, NTHR = 512;
constexpr int NPH = 13;
constexpr int D = 2048, BATCH = 8, SEQ = 2048, T = BATCH * SEQ;
constexpr int NIN = 10696, NINP = 10752;
constexpr int MLO = 3520, GTO = 6600;
constexpr int RH = 16, RD = 1024;
constexpr int MH = 4;
constexpr int NE = 32, FF = 2048, ECAP = 16384, PMAX = 65536 + NE * 256, MTMAX = PMAX / 256;
constexpr float NORM_EPS = 1e-6f, GN_EPS = 64e-5f;
constexpr size_t MiB = 1u << 20;
constexpr size_t WS_CTL = 0, CTL_ZERO_BYTES = 1 * MiB;
constexpr size_t WS_WIN = 1 * MiB, WS_WA = 43 * MiB, WS_WB = 47 * MiB, WS_WO = 51 * MiB, WS_WL = 59 * MiB;
constexpr size_t WS_RLIST = 62 * MiB, WS_RW = 64 * MiB, WS_RWS = 2787 * MiB, WS_RA = 2787 * MiB + 512 * 1024;
constexpr size_t WS_WGU = 66 * MiB, WS_WDN = 578 * MiB, WS_HN = 834 * MiB, WS_P = 898 * MiB, WS_LIN = 1234 * MiB, WS_WAG = 1250 * MiB;
constexpr size_t WS_YRAW = 1442 * MiB, WS_HRAW = 1506 * MiB, WS_OA = 1570 * MiB, WS_OB = 1602 * MiB, WS_TMP = 1634 * MiB, WS_MRG = 1762 * MiB;
constexpr size_t WS_QKC = WS_TMP, WS_GLF = WS_TMP + 64 * MiB;
constexpr size_t WS_X1 = 1826 * MiB, WS_XB = 1954 * MiB, WS_ACT = 2242 * MiB, WS_YS = 2530 * MiB, WS_END = 2788 * MiB;
constexpr int CW_BAR = 4096;
constexpr int CW_CVNEXT = 8192, CW_P1DONE = 8192 + 64, CW_CVNEXT2 = 8192 + 192;
constexpr int CV_W0 = 6, CV1_W0 = 4;
constexpr int NCV = 64;
constexpr int CW_COLMAX = 32768;
constexpr int CW_CNT = 16384;
constexpr int RING_BYTES = 131072, MISC_OFF = RING_BYTES, LDS_BYTES = RING_BYTES + 8192 + 20 * 1024;
constexpr int MI_TILE_E = 64, MI_TILE_I0 = 64 + 320, MI_CNT = 64 + 640, MI_POFF = MI_CNT + 32, MI_CST = MI_POFF + 32, MI_MT = MI_CST + 40, MI_ROWOFF = 2048;

#define LDS_WAIT() asm volatile("s_waitcnt lgkmcnt(0)" ::: "memory")
#define VM_WAIT() asm volatile("s_waitcnt vmcnt(0)" ::: "memory")
__device__ __forceinline__ float bf2f(bf16 v) { return __uint_as_float(((unsigned)v) << 16); }
__device__ __forceinline__ unsigned f2bf(float f) { unsigned u = __float_as_uint(f); return (u + 0x7fffu + ((u >> 16) & 1u)) >> 16; }
typedef __bf16 bf16x2_t __attribute__((ext_vector_type(2)));
__device__ __forceinline__ unsigned pk2(float lo, float hi) { const f32x2 v = {lo, hi}; const bf16x2_t b = __builtin_convertvector(v, bf16x2_t); return __builtin_bit_cast(unsigned, b); }
__device__ __forceinline__ unsigned pk4f8(float a, float b, float c, float d) { int r = 0; r = __builtin_amdgcn_cvt_pk_fp8_f32(a, b, r, false); r = __builtin_amdgcn_cvt_pk_fp8_f32(c, d, r, true); return (unsigned)r; }
constexpr float F8_SX = 8.f, F8_SW = 256.f, F8_SA = 4.f, F8_SY = 16.f;
__device__ __forceinline__ unsigned pk4i8(float a, float b, float c, float d) {
    const int ia = (int)__builtin_rintf(a), ib = (int)__builtin_rintf(b), ic = (int)__builtin_rintf(c), id = (int)__builtin_rintf(d);
    return (unsigned)(ia & 255) | ((unsigned)(ib & 255) << 8) | ((unsigned)(ic & 255) << 16) | ((unsigned)id << 24); }
__device__ __forceinline__ float wave_max(float v) {
#pragma unroll
    for (int o = 1; o < 64; o <<= 1) v = fmaxf(v, __shfl_xor(v, o));
    return v;
}
__device__ __forceinline__ float wave_sum(float v) {
#pragma unroll
    for (int o = 1; o < 64; o <<= 1) v += __shfl_xor(v, o);
    return v;
}
#define UNP4(v) ((f32x4){__uint_as_float((v).x << 16), __uint_as_float((v).x & 0xffff0000u), __uint_as_float((v).y << 16), __uint_as_float((v).y & 0xffff0000u)})
__device__ __forceinline__ float sigm(float x) { return __builtin_amdgcn_rcpf(1.f + __expf(-x)); }
template <int CTRL> __device__ __forceinline__ float dppf(float x) { return __builtin_bit_cast(float, __builtin_amdgcn_mov_dpp(__builtin_bit_cast(int, x), CTRL, 0xf, 0xf, true)); }
__device__ __forceinline__ float allreduce16(float x) { x += dppf<0x128>(x); x += dppf<0x124>(x); x += dppf<0x4E>(x); x += dppf<0xB1>(x); return x; }

#define XB_TMO      128
#define XB_XCNT(j)  (256  + 64 * (j))
#define XB_XSUB(j)  (1280 + 64 * (j))
#define XB_XGEN(j)  (2304 + 64 * (j))
#define XB_TOP      3328
#define XB_TOPGEN   3392
#define XCD_BAR_WORDS 3456
#define XB_SPIN_CAP (1u << 18)
__device__ __forceinline__ unsigned xb_ld(unsigned* p)              { return __hip_atomic_load(p, __ATOMIC_RELAXED, __HIP_MEMORY_SCOPE_AGENT); }
__device__ __forceinline__ unsigned xb_add(unsigned* p, unsigned v) { return __hip_atomic_fetch_add(p, v, __ATOMIC_RELAXED, __HIP_MEMORY_SCOPE_AGENT); }
__device__ __forceinline__ unsigned xb_xcc_id() { return (unsigned)__builtin_amdgcn_s_getreg((3 << 11) | 20) & 0xFu; }
#define XB_SPIN(cond, bar) do { unsigned _sp = 0; while (cond) { __builtin_amdgcn_s_sleep(1); \
    if ((++_sp & 255u) == 0u) { if (xb_ld(&(bar)[XB_TMO])) break; if (_sp > XB_SPIN_CAP) { atomicAdd(&(bar)[XB_TMO], 1u); break; } } } } while (0)
struct XcdBarrier { unsigned* bar; unsigned x; volatile LAS unsigned* st; };
__device__ __forceinline__ XcdBarrier xcd_barrier_post(unsigned* bar, volatile LAS unsigned* st) {
    XcdBarrier b; b.bar = bar; b.x = xb_xcc_id(); b.st = st;
    if (threadIdx.x == 0) (void)xb_add(&bar[XB_XCNT(b.x)], 1u);
    return b;
}
__device__ __forceinline__ void xcd_barrier_complete(unsigned* bar, unsigned x, unsigned& nloc, unsigned& nx) {
    const unsigned G = gridDim.x * gridDim.y * gridDim.z;
    unsigned sum, cnt, mine, sp = 0u;
    for (;;) {
        sum = 0u; cnt = 0u; mine = 0u;
#pragma unroll
        for (unsigned j = 0; j < 16; ++j) { const unsigned c = xb_ld(&bar[XB_XCNT(j)]); sum += c; cnt += (c > 0u) ? 1u : 0u; mine = (j == x) ? c : mine; }
        if (sum == G) break;
        __builtin_amdgcn_s_sleep(1);
        if ((++sp & 255u) == 0u) { if (xb_ld(&bar[XB_TMO])) break; if (sp > XB_SPIN_CAP) { atomicAdd(&bar[XB_TMO], 1u); break; } }
    }
    nloc = mine > 0u ? mine : 1u; nx = cnt > 0u ? cnt : 1u;
}
__device__ __forceinline__ void xcd_barrier(const XcdBarrier& b) {
    asm volatile("s_waitcnt vmcnt(0)" ::: "memory");
    __syncthreads();
    if (threadIdx.x == 0) {
        unsigned* bar = b.bar;
        __builtin_amdgcn_s_waitcnt(0);
        unsigned nloc = b.st[0], nx = b.st[1];
        if (nloc == 0u) { xcd_barrier_complete(bar, b.x, nloc, nx); b.st[0] = nloc; b.st[1] = nx; }
        const unsigned old = xb_add(&bar[XB_XSUB(b.x)], 1u);
        const unsigned gen = old / nloc;
        if (old + 1u == (gen + 1u) * nloc) {
            __builtin_amdgcn_fence(__ATOMIC_RELEASE, "agent");
            asm volatile("s_waitcnt vmcnt(0)" ::: "memory");
            const unsigned og = xb_add(&bar[XB_TOP], 1u);
            const unsigned tg = og / nx;
            if (og + 1u == (tg + 1u) * nx) xb_add(&bar[XB_TOPGEN], 1u);
            else XB_SPIN(xb_ld(&bar[XB_TOPGEN]) == tg, bar);
            __builtin_amdgcn_fence(__ATOMIC_ACQUIRE, "agent");
            xb_add(&bar[XB_XGEN(b.x)], 1u);
            asm volatile("s_waitcnt vmcnt(0)" ::: "memory");
        } else {
            XB_SPIN(xb_ld(&bar[XB_XGEN(b.x)]) == gen, bar);
            __builtin_amdgcn_fence(__ATOMIC_ACQUIRE, "agent");
            asm volatile("s_waitcnt vmcnt(0)" ::: "memory");
        }
    }
    __syncthreads();
}

struct Args { const float* in[30]; float* out; unsigned char* ws; int ph_lo, ph_hi; };
enum { I_X = 0, I_N1W, I_WIN, I_BGATE, I_MU, I_W0, I_WUP, I_A0, I_AUP, I_GUP, I_KK, I_KA, I_RK, I_LNW, I_LNB, I_CONVW, I_IB, I_FB, I_MNW, I_WBA, I_WBB, I_WOUT, I_N2W, I_RTW, I_RTB, I_WGU, I_BGU, I_WDN, I_BDN, I_FNW };

struct Frame {
    LAS unsigned char* lds; volatile LAS unsigned* MISC; unsigned* ctl;
    int tid, lane, wave, G, bid;
    const float* const* in; float* out; unsigned char* ws;
};

using pg8::Unit; using pg8::HALF; using pg8::BM;
struct EpiBf16Plain {
    static constexpr bool PERM = true, AFTER_DRAIN = false;
    bf16* O; int ldc;
    __device__ __forceinline__ void operator()(const f32x4 (&acc)[2][2][4][2], const Unit& u, int wr, int wc, int fr, int fq) const {
        const int row0 = u.pm * BM + wr * 64 + fr, col0 = u.pn * BM + wc * 32 + 8 * fq;
#pragma unroll
        for (int ai = 0; ai < 2; ++ai)
#pragma unroll
            for (int m = 0; m < 4; ++m) { bf16* rowp = O + (size_t)(row0 + ai * HALF + m * 16) * ldc + col0;
#pragma unroll
                for (int bj = 0; bj < 2; ++bj) { const f32x4 v0 = acc[ai][bj][m][0], v1 = acc[ai][bj][m][1];
                    v4u w; w.x = pg8::cvt_pk_bf16(v0[0], v0[1]); w.y = pg8::cvt_pk_bf16(v0[2], v0[3]); w.z = pg8::cvt_pk_bf16(v1[0], v1[1]); w.w = pg8::cvt_pk_bf16(v1[2], v1[3]);
                    *(v4u*)(rowp + bj * HALF) = w; } }
    }
};
struct EpiP1I8 {
    static constexpr bool PERM = true, AFTER_DRAIN = false;
    bf16* O; int ldc; const float* ra; const unsigned* colmax;
    __device__ __forceinline__ void operator()(const f32x4 (&acc)[2][2][4][2], const Unit& u, int wr, int wc, int fr, int fq) const {
        const int row0 = u.pm * BM + wr * 64 + fr, col0 = u.pn * BM + wc * 32 + 8 * fq;
        f32x4 cb[2][2];
#pragma unroll
        for (int bj = 0; bj < 2; ++bj)
#pragma unroll
            for (int n = 0; n < 2; ++n) { const v4u cm = *(const v4u*)(colmax + col0 + bj * HALF + 4 * n);
                cb[bj][n] = (f32x4){__uint_as_float(cm.x), __uint_as_float(cm.y), __uint_as_float(cm.z), __uint_as_float(cm.w)} * (1.f / 127.f); }
#pragma unroll
        for (int ai = 0; ai < 2; ++ai)
#pragma unroll
            for (int m = 0; m < 4; ++m) { const int r = row0 + ai * HALF + m * 16; const float rs = ra[r]; bf16* rowp = O + (size_t)r * ldc + col0;
#pragma unroll
                for (int bj = 0; bj < 2; ++bj) { const v4u i0 = __builtin_bit_cast(v4u, acc[ai][bj][m][0]), i1 = __builtin_bit_cast(v4u, acc[ai][bj][m][1]);
                    const f32x4 v0 = (f32x4){(float)(int)i0.x, (float)(int)i0.y, (float)(int)i0.z, (float)(int)i0.w} * cb[bj][0] * rs, v1 = (f32x4){(float)(int)i1.x, (float)(int)i1.y, (float)(int)i1.z, (float)(int)i1.w} * cb[bj][1] * rs;
                    v4u w; w.x = pk2(v0[0], v0[1]); w.y = pk2(v0[2], v0[3]); w.z = pk2(v1[0], v1[1]); w.w = pk2(v1[2], v1[3]);
                    *(v4u*)(rowp + bj * HALF) = w; } }
    }
};
struct EpiLora {
    static constexpr bool PERM = false, AFTER_DRAIN = false;
    float* WLD; bf16* AG; const float* w0; const float* a0;
    __device__ __forceinline__ void operator()(const f32x4 (&acc)[2][2][4][2], const Unit& u, int wr, int wc, int fr, int fq) const {
        const int row0 = u.pm * BM + wr * 64 + fr, col0 = u.pn * BM + wc * 32 + 4 * fq, seg = u.pn >> 2;
        f32x4 bv[2][2];
#pragma unroll
        for (int bj = 0; bj < 2; ++bj)
#pragma unroll
            for (int n = 0; n < 2; ++n) { const int c = col0 + bj * HALF + n * 16;
                bv[bj][n] = seg == 0 ? *(const f32x4*)(w0 + c) : (seg == 1 ? *(const f32x4*)(a0 + (c - 1024)) : (f32x4){0.f, 0.f, 0.f, 0.f}); }
#pragma unroll
        for (int ai = 0; ai < 2; ++ai)
#pragma unroll
            for (int m = 0; m < 4; ++m) { const size_t r = (size_t)(row0 + ai * HALF + m * 16);
#pragma unroll
                for (int bj = 0; bj < 2; ++bj)
#pragma unroll
                    for (int n = 0; n < 2; ++n) { f32x4 v = acc[ai][bj][m][n] + bv[bj][n]; const int c = col0 + bj * HALF + n * 16;
                        if (seg == 0) {
#pragma unroll
                            for (int j = 0; j < 4; ++j) v[j] = -0.6065306597126334f * sigm(v[j]);
                            *(f32x4*)(WLD + r * RD + c) = v; }
                        else { if (seg == 1) {
#pragma unroll
                                for (int j = 0; j < 4; ++j) v[j] = sigm(v[j]); }
                            v2u o; o.x = pk2(v[0], v[1]); o.y = pk2(v[2], v[3]); *(v2u*)(AG + r * D + (c - 1024)) = o; } } }
    }
};
struct EpiGateA {
    static constexpr bool PERM = true, AFTER_DRAIN = false;
    bf16* TMP; const bf16* P; const float* bg;
    __device__ __forceinline__ void operator()(const f32x4 (&acc)[2][2][4][2], const Unit& u, int wr, int wc, int fr, int fq) const {
        const int row0 = u.pm * BM + wr * 64 + fr, col0 = u.pn * BM + wc * 32 + 8 * fq;
#pragma unroll
        for (int ai = 0; ai < 2; ++ai)
#pragma unroll
            for (int m = 0; m < 4; ++m) { const size_t r = (size_t)(row0 + ai * HALF + m * 16);
#pragma unroll
                for (int bj = 0; bj < 2; ++bj) { const int c = col0 + bj * HALF;
                    const v4u pg = *(const v4u*)(P + r * NINP + GTO + c); const f32x4 b0 = *(const f32x4*)(bg + c), b1 = *(const f32x4*)(bg + c + 4);
                    f32x4 g0, g1;
                    g0[0] = sigm(__uint_as_float(pg.x << 16) + b0[0]); g0[1] = sigm(__uint_as_float(pg.x & 0xffff0000u) + b0[1]);
                    g0[2] = sigm(__uint_as_float(pg.y << 16) + b0[2]); g0[3] = sigm(__uint_as_float(pg.y & 0xffff0000u) + b0[3]);
                    g1[0] = sigm(__uint_as_float(pg.z << 16) + b1[0]); g1[1] = sigm(__uint_as_float(pg.z & 0xffff0000u) + b1[1]);
                    g1[2] = sigm(__uint_as_float(pg.w << 16) + b1[2]); g1[3] = sigm(__uint_as_float(pg.w & 0xffff0000u) + b1[3]);
                    const f32x4 t0 = g0 * acc[ai][bj][m][0], t1 = g1 * acc[ai][bj][m][1]; v4u tw; tw.x = pk2(t0[0], t0[1]); tw.y = pk2(t0[2], t0[3]); tw.z = pk2(t1[0], t1[1]); tw.w = pk2(t1[2], t1[3]);
                    *(v4u*)(TMP + r * D + c) = tw; } }
    }
};
struct EpiGateB {
    static constexpr bool PERM = true, AFTER_DRAIN = false;
    const bf16* TMP; bf16* MRG; const bf16* P; const float* bg;
    __device__ __forceinline__ void operator()(const f32x4 (&acc)[2][2][4][2], const Unit& u, int wr, int wc, int fr, int fq) const {
        const int row0 = u.pm * BM + wr * 64 + fr, col0 = u.pn * BM + wc * 32 + 8 * fq;
#pragma unroll
        for (int ai = 0; ai < 2; ++ai)
#pragma unroll
            for (int m = 0; m < 4; ++m) { const size_t r = (size_t)(row0 + ai * HALF + m * 16);
#pragma unroll
                for (int bj = 0; bj < 2; ++bj) { const int c = col0 + bj * HALF;
                    const v4u pg = *(const v4u*)(P + r * NINP + GTO + D + c); const f32x4 b0 = *(const f32x4*)(bg + D + c), b1 = *(const f32x4*)(bg + D + c + 4);
                    const v4u tw = *(const v4u*)(TMP + r * D + c); const f32x4 t0 = (f32x4){__uint_as_float(tw.x << 16), __uint_as_float(tw.x & 0xffff0000u), __uint_as_float(tw.y << 16), __uint_as_float(tw.y & 0xffff0000u)}, t1 = (f32x4){__uint_as_float(tw.z << 16), __uint_as_float(tw.z & 0xffff0000u), __uint_as_float(tw.w << 16), __uint_as_float(tw.w & 0xffff0000u)};
                    f32x4 g0, g1;
                    g0[0] = sigm(__uint_as_float(pg.x << 16) + b0[0]); g0[1] = sigm(__uint_as_float(pg.x & 0xffff0000u) + b0[1]);
                    g0[2] = sigm(__uint_as_float(pg.y << 16) + b0[2]); g0[3] = sigm(__uint_as_float(pg.y & 0xffff0000u) + b0[3]);
                    g1[0] = sigm(__uint_as_float(pg.z << 16) + b1[0]); g1[1] = sigm(__uint_as_float(pg.z & 0xffff0000u) + b1[1]);
                    g1[2] = sigm(__uint_as_float(pg.w << 16) + b1[2]); g1[3] = sigm(__uint_as_float(pg.w & 0xffff0000u) + b1[3]);
                    const f32x4 v0 = t0 + g0 * acc[ai][bj][m][0], v1 = t1 + g1 * acc[ai][bj][m][1];
                    v4u w; w.x = pg8::cvt_pk_bf16(v0[0], v0[1]); w.y = pg8::cvt_pk_bf16(v0[2], v0[3]); w.z = pg8::cvt_pk_bf16(v1[0], v1[1]); w.w = pg8::cvt_pk_bf16(v1[2], v1[3]);
                    *(v4u*)(MRG + r * D + c) = w; } }
    }
};
struct EpiResid {
    static constexpr bool PERM = true, AFTER_DRAIN = false;
    const float* X; bf16* O;
    __device__ __forceinline__ void operator()(const f32x4 (&acc)[2][2][4][2], const Unit& u, int wr, int wc, int fr, int fq) const {
        const int row0 = u.pm * BM + wr * 64 + fr, col0 = u.pn * BM + wc * 32 + 8 * fq;
#pragma unroll
        for (int ai = 0; ai < 2; ++ai)
#pragma unroll
            for (int m = 0; m < 4; ++m) { const size_t off = (size_t)(row0 + ai * HALF + m * 16) * D + col0;
#pragma unroll
                for (int bj = 0; bj < 2; ++bj) { const f32x4 v0 = *(const f32x4*)(X + off + bj * HALF) + acc[ai][bj][m][0], v1 = *(const f32x4*)(X + off + bj * HALF + 4) + acc[ai][bj][m][1];
                    v4u w; w.x = pk2(v0[0], v0[1]); w.y = pk2(v0[2], v0[3]); w.z = pk2(v1[0], v1[1]); w.w = pk2(v1[2], v1[3]);
                    *(v4u*)(O + off + bj * HALF) = w; } }
    }
};
struct MoeOrder : pg8::StaticOrder {
    const LAS int* tile_e; size_t estride;
    __device__ __forceinline__ size_t b_off(const Unit& u, size_t tstep) const { return (size_t)tile_e[u.pm] * estride + (size_t)u.pn * tstep; }
};
struct MoeGatherOrder : MoeOrder {
    static constexpr bool GATHER = true;
    const LAS int* tile_i0; const LAS int* cnt; const int* rlist; LAS unsigned* rowoff; unsigned rowbytes;
    __device__ __forceinline__ size_t a_off(const Unit&, size_t) const { return 0; }
    __device__ __forceinline__ void fill_all() const { const int tid = threadIdx.x, r = tid & 255;
        for (int u0 = tid >> 8; ; u0 += 6) { Unit ua, ub, uc; const bool va = next(u0, ua), vb = next(u0 + 2, ub), vc = next(u0 + 4, uc); if (!va) break;
            int ta = 0, tb = 0, tc = 0;
            { const int e = tile_e[ua.pm], i = tile_i0[ua.pm] + r; if (i < cnt[e]) ta = rlist[e * ECAP + i]; }
            if (vb) { const int e = tile_e[ub.pm], i = tile_i0[ub.pm] + r; if (i < cnt[e]) tb = rlist[e * ECAP + i]; }
            if (vc) { const int e = tile_e[uc.pm], i = tile_i0[uc.pm] + r; if (i < cnt[e]) tc = rlist[e * ECAP + i]; }
            rowoff[u0 * 256 + r] = (unsigned)(ta >> 2) * rowbytes; if (vb) rowoff[(u0 + 2) * 256 + r] = (unsigned)(tb >> 2) * rowbytes; if (vc) rowoff[(u0 + 4) * 256 + r] = (unsigned)(tc >> 2) * rowbytes; } }
    __device__ __forceinline__ unsigned row_off(int ui, int r) const { return rowoff[ui * 256 + r]; }
};
struct EpiSwiGLU {
    static constexpr bool PERM = true, AFTER_DRAIN = false;
    unsigned char* ACT; const float* bgu; const LAS int* tile_e;
    __device__ __forceinline__ void operator()(const f32x4 (&acc)[2][2][4][2], const Unit& u, int wr, int wc, int fr, int fq) const {
        const int row0 = u.pm * BM + wr * 64 + fr, colg = u.pn * 128 + wc * 32 + 8 * fq; const int e = tile_e[u.pm];
        const float* bp = bgu + (size_t)e * 4096 + colg;
        const f32x4 bg0 = *(const f32x4*)(bp), bg1 = *(const f32x4*)(bp + 4), bu0 = *(const f32x4*)(bp + 2048), bu1 = *(const f32x4*)(bp + 2052);
#pragma unroll
        for (int ai = 0; ai < 2; ++ai)
#pragma unroll
            for (int m = 0; m < 4; ++m) { const size_t r = (size_t)(row0 + ai * HALF + m * 16);
                constexpr float DS = 1.f / (F8_SX * F8_SW);
                const f32x4 ga = acc[ai][0][m][0] * DS + bg0, gb = acc[ai][0][m][1] * DS + bg1, ua = acc[ai][1][m][0] * DS + bu0, ub = acc[ai][1][m][1] * DS + bu1;
                float o[8];
#pragma unroll
                for (int j = 0; j < 4; ++j) { const float g = fminf(ga[j], 7.f), up = fminf(fmaxf(ua[j], -7.f), 7.f); o[j] = F8_SA * (up + 1.f) * g * sigm(1.702f * g);
                                              const float g2 = fminf(gb[j], 7.f), up2 = fminf(fmaxf(ub[j], -7.f), 7.f); o[4 + j] = F8_SA * (up2 + 1.f) * g2 * sigm(1.702f * g2); }
                v2u w; w.x = pk4f8(o[0], o[1], o[2], o[3]); w.y = pk4f8(o[4], o[5], o[6], o[7]);
                *(v2u*)(ACT + r * FF + colg) = w; }
    }
};
struct EpiDown {
    static constexpr bool PERM = true, AFTER_DRAIN = false;
    unsigned char* YS; const float* bdn; const LAS int* tile_e; const LAS int* rowdst; const LAS float* rowwt;
    __device__ __forceinline__ void operator()(const f32x4 (&acc)[2][2][4][2], const Unit& u, int wr, int wc, int fr, int fq) const {
        const int e = tile_e[u.pm]; const int col0 = u.pn * BM + wc * 32 + 8 * fq;
        const float* bp = bdn + (size_t)e * D + col0; constexpr float DS = 1.f / (F8_SA * F8_SW);
#pragma unroll
        for (int bj = 0; bj < 2; ++bj) { const f32x4 b0 = *(const f32x4*)(bp + bj * HALF), b1 = *(const f32x4*)(bp + bj * HALF + 4);
#pragma unroll
            for (int ai = 0; ai < 2; ++ai)
#pragma unroll
                for (int m = 0; m < 4; ++m) { const int r = u.ord * 256 + ai * HALF + wr * 64 + m * 16 + fr;
                    const int dst = rowdst[r]; const float w = rowwt[r];
                    const f32x4 v0 = (acc[ai][bj][m][0] * DS + b0) * (w * F8_SY), v1 = (acc[ai][bj][m][1] * DS + b1) * (w * F8_SY);
                    v2u o; o.x = pk4f8(v0[0], v0[1], v0[2], v0[3]); o.y = pk4f8(v1[0], v1[1], v1[2], v1[3]);
                    *(v2u*)(YS + (size_t)dst * D + col0 + bj * HALF) = o; } }
    }
};
template <class Sched> __device__ __forceinline__ void fill_down_tables(Frame& F, const Sched& S, LAS int* rowdst, LAS float* rowwt) {
    const LAS int* MI = (const LAS int*)F.MISC; const int* rlist = (const int*)(F.ws + WS_RLIST); const float* rw = (const float*)(F.ws + WS_RW);
    const int r = F.tid & 255;
    for (int u0 = F.tid >> 8; ; u0 += 4) { Unit ua, ub; const bool va = S.next(u0, ua), vb = S.next(u0 + 2, ub); if (!va) break;
        int da = T * 4, db = T * 4; float wa = 0.f, wb = 0.f;
        { const int e = MI[MI_TILE_E + ua.pm], i = MI[MI_TILE_I0 + ua.pm] + r; if (i < MI[MI_CNT + e]) { da = rlist[e * ECAP + i]; wa = rw[e * ECAP + i]; } }
        if (vb) { const int e = MI[MI_TILE_E + ub.pm], i = MI[MI_TILE_I0 + ub.pm] + r; if (i < MI[MI_CNT + e]) { db = rlist[e * ECAP + i]; wb = rw[e * ECAP + i]; } }
        rowdst[u0 * 256 + r] = da; rowwt[u0 * 256 + r] = wa; if (vb) { rowdst[(u0 + 2) * 256 + r] = db; rowwt[(u0 + 2) * 256 + r] = wb; } }
    __syncthreads();
}

__device__ __forceinline__ void transpose_item(const float* __restrict__ W, int N, int k0, int n0, bf16* WT, int dst_row0, int ldk, LAS float* scr, int lane) {
    const int n = n0 + (lane & 31); const bool ok = n < N;
#pragma unroll 8
    for (int i = 0; i < 32; ++i) { const int kk = 2 * i + (lane >> 5); scr[kk * 33 + (lane & 31)] = ok ? W[(size_t)(k0 + kk) * N + n] : 0.f; }
    LDS_WAIT(); asm volatile("" ::: "memory");
    const int c = lane & 7;
#pragma unroll
    for (int j = 0; j < 4; ++j) { const int nn = (lane >> 3) + 8 * j; const LAS float* s = scr + (8 * c) * 33 + nn;
        v4u o; o.x = pk2(s[0 * 33], s[1 * 33]); o.y = pk2(s[2 * 33], s[3 * 33]); o.z = pk2(s[4 * 33], s[5 * 33]); o.w = pk2(s[6 * 33], s[7 * 33]);
        *(v4u*)(WT + (size_t)(dst_row0 + nn) * ldk + k0 + 8 * c) = o; }
    LDS_WAIT(); asm volatile("" ::: "memory");
}
__device__ __forceinline__ void transpose_item_i8(const float* __restrict__ W, int N, int k0, int n0, unsigned char* WT, int dst_row0, int ldk, const unsigned* colmax, LAS float* scr, int lane) {
    const int n = n0 + (lane & 31); const bool ok = n < N;
#pragma unroll 8
    for (int i = 0; i < 32; ++i) { const int kk = 2 * i + (lane >> 5); scr[kk * 33 + (lane & 31)] = ok ? W[(size_t)(k0 + kk) * N + n] : 0.f; }
    LDS_WAIT(); asm volatile("" ::: "memory");
#pragma unroll
    for (int j = 0; j < 2; ++j) { const int ch = lane + 64 * j, nn = ch >> 2, c = ch & 3; const LAS float* s = scr + (16 * c) * 33 + nn;
        const float cm = __uint_as_float(colmax[n0 + nn]); const float sc = cm > 0.f ? 127.f / cm : 0.f;
        v4u o; o.x = pk4i8(s[0 * 33] * sc, s[1 * 33] * sc, s[2 * 33] * sc, s[3 * 33] * sc); o.y = pk4i8(s[4 * 33] * sc, s[5 * 33] * sc, s[6 * 33] * sc, s[7 * 33] * sc);
        o.z = pk4i8(s[8 * 33] * sc, s[9 * 33] * sc, s[10 * 33] * sc, s[11 * 33] * sc); o.w = pk4i8(s[12 * 33] * sc, s[13 * 33] * sc, s[14 * 33] * sc, s[15 * 33] * sc);
        *(v4u*)(WT + (size_t)(dst_row0 + nn) * ldk + k0 + 16 * c) = o; }
    LDS_WAIT(); asm volatile("" ::: "memory");
}
__device__ __forceinline__ void p0b_win(Frame& F) {
    LAS float* scr = (LAS float*)(F.lds + F.wave * 16384);
    const int gw = F.bid * NWAVES + F.wave, NGW = F.G * NWAVES; unsigned char* WIN8 = F.ws + WS_WIN; const unsigned* colmax = F.ctl + CW_COLMAX;
    constexpr int NB_WIN = (NIN + 31) / 32;
    for (int it = gw; it < 32 * NB_WIN; it += NGW) { const int kb = it / NB_WIN, nb = it % NB_WIN; transpose_item_i8(F.in[I_WIN], NIN, kb * 64, nb * 32, WIN8, nb * 32, D, colmax, scr, F.lane); }
    { const int gt = F.bid * NTHR + F.tid, NGT = F.G * NTHR; constexpr int Z0 = NB_WIN * 32 * D, Z1 = NINP * D;
      for (int i = Z0 + gt * 16; i < Z1; i += NGT * 16) *(v4u*)(WIN8 + i) = (v4u){0u, 0u, 0u, 0u}; }
}
__device__ __forceinline__ void p0_prologue(Frame& F) {
    LAS float* scr = (LAS float*)(F.lds + F.wave * 16384);
    const int gw = F.bid * NWAVES + F.wave, NGW = F.G * NWAVES;
    bf16* WIN_T = (bf16*)(F.ws + WS_WIN); bf16* WA_T = (bf16*)(F.ws + WS_WA); bf16* WB_T = (bf16*)(F.ws + WS_WB); bf16* WO_T = (bf16*)(F.ws + WS_WO);
    bf16* WGU_T = (bf16*)(F.ws + WS_WGU); bf16* WDN_T = (bf16*)(F.ws + WS_WDN); bf16* WL_T = (bf16*)(F.ws + WS_WL); bf16* HN = (bf16*)(F.ws + WS_HN);
    { const float* W = F.in[I_WIN]; unsigned* colmax = F.ctl + CW_COLMAX;
      for (int task = gw; task < 168 * 16; task += NGW) { const int cb = task % 168, kc = task / 168, n = cb * 64 + F.lane; float m = 0.f;
          if (n < NIN) { const float* wp = W + (size_t)(kc * 128) * NIN + n;
#pragma unroll 1
              for (int k0 = 0; k0 < 128; k0 += 32) { float v[32];
#pragma unroll
                  for (int i = 0; i < 32; ++i) v[i] = wp[(size_t)(k0 + i) * NIN];
#pragma unroll
                  for (int i = 0; i < 32; ++i) m = fmaxf(m, fabsf(v[i])); }
              atomicMax(colmax + n, __float_as_uint(m)); } } }
    { const int gt = F.bid * NTHR + F.tid, NGT = F.G * NTHR;
      for (int i = gt; i < 3072 * 512; i += NGT) { const int n = i >> 9, k = i & 511; float v = 0.f;
          if (n < 1024) { if (k < 96) v = F.in[I_WUP][k * RD + n]; }
          else if (n < 2048) { if (k >= 128 && k < 224) v = F.in[I_AUP][(k - 128) * RD + (n - 1024)]; }
          else { if (k >= 256) v = F.in[I_GUP][(k - 256) * RD + (n - 2048)]; }
          WL_T[i] = (bf16)f2bf(v); } }
    { const int gt = F.bid * NTHR + F.tid, NGT = F.G * NTHR; float* RWS = (float*)(F.ws + WS_RWS);
      for (int i = gt; i < D * NE; i += NGT) RWS[i] = F.in[I_N2W][i >> 5] * F.in[I_RTW][i]; }
    const float* x = F.in[I_X]; const float* nw = F.in[I_N1W];
    for (int m = gw; m < T; m += NGW) {
        const f32x4* xr = (const f32x4*)(x + (size_t)m * D) + F.lane; f32x4 v[8]; float s = 0.f;
#pragma unroll
        for (int j = 0; j < 8; ++j) { v[j] = xr[64 * j]; s += (v[j][0] * v[j][0] + v[j][1] * v[j][1]) + (v[j][2] * v[j][2] + v[j][3] * v[j][3]); }
        const float rstd = __builtin_amdgcn_rsqf(wave_sum(s) * (1.f / D) + NORM_EPS);
        float am = 0.f;
#pragma unroll
        for (int j = 0; j < 8; ++j) { const f32x4 w = ((const f32x4*)nw)[F.lane + 64 * j]; v[j] = v[j] * rstd * w; am = fmaxf(fmaxf(am, fmaxf(fabsf(v[j][0]), fabsf(v[j][1]))), fmaxf(fabsf(v[j][2]), fabsf(v[j][3]))); }
        am = wave_max(am); const float sc = am > 0.f ? 127.f / am : 0.f;
        if (F.lane == 0) ((float*)(F.ws + WS_RA))[m] = am * (1.f / 127.f);
        unsigned* o4 = (unsigned*)((unsigned char*)HN + (size_t)m * D) + F.lane;
#pragma unroll
        for (int j = 0; j < 8; ++j) o4[64 * j] = pk4i8(v[j][0] * sc, v[j][1] * sc, v[j][2] * sc, v[j][3] * sc);
    }
}

__device__ __forceinline__ void p2_lora_in(Frame& F) {
    const bf16* __restrict__ P = (const bf16*)(F.ws + WS_P); bf16* __restrict__ LIN = (bf16*)(F.ws + WS_LIN); const float* __restrict__ mu = F.in[I_MU];
    const int gt = F.bid * NTHR + F.tid, NGT = F.G * NTHR;
#pragma unroll 2
    for (int i = gt; i < T * 64; i += NGT) { const int t = i >> 6, g = i & 63; int col = -1, kind = 0;
        if (g < 12) { col = 3072 + 8 * g; kind = 0; } else if (g >= 16 && g < 28) { col = 3168 + 8 * (g - 16); kind = 1; } else if (g >= 32) { col = 3264 + 8 * (g - 32); kind = 2; }
        v4u o = (v4u){0u, 0u, 0u, 0u};
        if (col >= 0) { const v4u pc = *(const v4u*)(P + (size_t)t * NINP + col); v4u pp = (v4u){0u, 0u, 0u, 0u}; if (t & (SEQ - 1)) pp = *(const v4u*)(P + (size_t)(t - 1) * NINP + col);
            const f32x4 m0 = *(const f32x4*)(mu + col), m1 = *(const f32x4*)(mu + col + 4);
            const unsigned pcs[4] = {pc.x, pc.y, pc.z, pc.w}, pps[4] = {pp.x, pp.y, pp.z, pp.w}; float x[8];
#pragma unroll
            for (int k = 0; k < 4; ++k) { const float c0 = __uint_as_float(pcs[k] << 16), c1 = __uint_as_float(pcs[k] & 0xffff0000u), q0 = __uint_as_float(pps[k] << 16), q1 = __uint_as_float(pps[k] & 0xffff0000u);
                const float ma = k < 2 ? m0[2 * k] : m1[2 * k - 4], mb = k < 2 ? m0[2 * k + 1] : m1[2 * k - 3];
                x[2 * k] = c0 + (q0 - c0) * ma; x[2 * k + 1] = c1 + (q1 - c1) * mb; }
#pragma unroll
            for (int k = 0; k < 8; ++k) x[k] = kind == 0 ? tanhf(x[k]) : (kind == 1 ? x[k] : sigm(x[k]));
            o.x = pk2(x[0], x[1]); o.y = pk2(x[2], x[3]); o.z = pk2(x[4], x[5]); o.w = pk2(x[6], x[7]); }
        *(v4u*)(LIN + (size_t)t * 512 + 8 * g) = o; }
    { bf16* __restrict__ QKC = (bf16*)(F.ws + WS_QKC); const float* __restrict__ cw = F.in[I_CONVW];
      for (int i = gt; i < T * 128; i += NGT) { const int t = i >> 7, c0 = 8 * (i & 127); const int sq = t & (SEQ - 1); float acc[8];
#pragma unroll
          for (int k = 0; k < 8; ++k) acc[k] = 0.f;
#pragma unroll
          for (int j = 0; j < 4; ++j) { if (sq - 3 + j >= 0) { const v4u pv = *(const v4u*)(P + (size_t)(t - 3 + j) * NINP + MLO + c0); const f32x4 w0 = *(const f32x4*)(cw + j * 1024 + c0), w1 = *(const f32x4*)(cw + j * 1024 + c0 + 4);
                  acc[0] += __uint_as_float(pv.x << 16) * w0[0]; acc[1] += __uint_as_float(pv.x & 0xffff0000u) * w0[1]; acc[2] += __uint_as_float(pv.y << 16) * w0[2]; acc[3] += __uint_as_float(pv.y & 0xffff0000u) * w0[3];
                  acc[4] += __uint_as_float(pv.z << 16) * w1[0]; acc[5] += __uint_as_float(pv.z & 0xffff0000u) * w1[1]; acc[6] += __uint_as_float(pv.w << 16) * w1[2]; acc[7] += __uint_as_float(pv.w & 0xffff0000u) * w1[3]; } }
          const float sc = c0 < 512 ? 0.08838834764831845f : 1.f;
#pragma unroll
          for (int k = 0; k < 8; ++k) acc[k] = acc[k] * sigm(acc[k]) * sc;
          v4u o; o.x = pk2(acc[0], acc[1]); o.y = pk2(acc[2], acc[3]); o.z = pk2(acc[4], acc[5]); o.w = pk2(acc[6], acc[7]); *(v4u*)(QKC + (size_t)t * 1024 + c0) = o; } }
    { float* __restrict__ GLF = (float*)(F.ws + WS_GLF); const int gw = F.bid * NWAVES + F.wave, NGW = F.G * NWAVES, lane = F.lane;
      for (int q = gw; q < (T / 64) * 4; q += NGW) { const int chk = q >> 2, mh = q & 3; const size_t t = (size_t)chk * 64 + lane; const bf16* pr = P + t * NINP + MLO + 2048;
          const float ip = 15.f * tanhf((bf2f(pr[mh]) + F.in[I_IB][mh]) * (1.f / 15.f)), fp = 15.f * tanhf((bf2f(pr[4 + mh]) + F.in[I_FB][mh]) * (1.f / 15.f));
          float bc = fminf(fp, 0.f) - log1pf(__expf(-fabsf(fp)));
#pragma unroll
          for (int o = 1; o < 64; o <<= 1) { const float t_ = __shfl_up(bc, o); if (lane >= o) bc += t_; }
          const float u = ip - bc; float pm = u;
#pragma unroll
          for (int o = 1; o < 64; o <<= 1) { const float t_ = __shfl_up(pm, o); if (lane >= o) pm = fmaxf(pm, t_); }
          *(f32x4*)(GLF + t * 16 + 4 * mh) = (f32x4){bc, u, pm, 0.f}; } }
}

typedef short s16x8 __attribute__((ext_vector_type(8)));
typedef short s16x4 __attribute__((ext_vector_type(4)));
__device__ __forceinline__ unsigned long long pack4bf(f32x4 v) { return (unsigned long long)pk2(v[0], v[1]) | ((unsigned long long)pk2(v[2], v[3]) << 32); }
__device__ __forceinline__ s16x8 tr_frag(const LAS bf16* img, int stride, int r0, int c0, int fr) {
    const LAS bf16* p0 = img + (r0 + (fr >> 2)) * stride + c0 + 4 * (fr & 3);
    const s16x4 lo = __builtin_bit_cast(s16x4, __builtin_amdgcn_ds_read_tr16_b64_v4i16((LAS s16x4*)p0));
    const s16x4 hi = __builtin_bit_cast(s16x4, __builtin_amdgcn_ds_read_tr16_b64_v4i16((LAS s16x4*)(p0 + 4 * stride)));
    return __builtin_shufflevector(lo, hi, 0, 1, 2, 3, 4, 5, 6, 7);
}

__device__ __forceinline__ float scan32(float x) {
    x += dppf<0x111>(x); x += dppf<0x112>(x); x += dppf<0x114>(x); x += dppf<0x118>(x);
    x += __builtin_bit_cast(float, __builtin_amdgcn_update_dpp(0, __builtin_bit_cast(int, x), 0x142, 0xa, 0xf, false));
    return x; }
typedef float f32x16 __attribute__((ext_vector_type(16)));
__device__ __forceinline__ s16x8 accfrag(const f32x16& x, int s) { v4u p; p.x = pk2(x[8 * s], x[8 * s + 1]); p.y = pk2(x[8 * s + 2], x[8 * s + 3]); p.z = pk2(x[8 * s + 4], x[8 * s + 5]); p.w = pk2(x[8 * s + 6], x[8 * s + 7]); return __builtin_bit_cast(s16x8, p); }
#define MFMA32(a_, b_, c_) __builtin_amdgcn_mfma_f32_32x32x16_bf16((a_), (b_), (c_), 0, 0, 0)
__device__ __forceinline__ void rw_bar(LAS unsigned* cnt, unsigned& target, int lane);
__device__ __forceinline__ void rwkv_chunk_unit(Frame& F, int unit, LAS unsigned char* regB, LAS unsigned* bcnt, unsigned& btarget) {
    const int b = unit >> 5, h = (unit >> 1) & 15, half = unit & 1;
    const bf16* P = (const bf16*)(F.ws + WS_P); const float* WAG = (const float*)(F.ws + WS_WAG); const bf16* AGp = (const bf16*)(F.ws + WS_WAG + 64 * MiB); float* YRAW = (float*)(F.ws + WS_YRAW);
    constexpr int KS = 72, LS = 40;
    LAS bf16* At = (LAS bf16*)F.lds; LAS bf16* Bt = At + 32 * KS; LAS bf16* Kt = Bt + 32 * KS; LAS bf16* Rt = Kt + 32 * KS;
    LAS bf16* Vv = Rt + 32 * KS;
    LAS bf16* Sb = Vv + 32 * LS;
    LAS bf16* G2b = Sb + 32 * KS; LAS bf16* G3b = G2b + 32 * LS; LAS bf16* G4b = G3b + 32 * LS;
    LAS bf16* Pwb = G4b + 32 * LS;
    LAS bf16* Acb = Pwb + 2 * 32 * LS;
    LAS bf16* RHt = (LAS bf16*)regB;
    LAS bf16* Ubt = RHt + 32 * LS;
    LAS float* lwf = (LAS float*)(Ubt + 32 * LS);
    LAS float* csf = lwf + 2048;
    LAS float* gtf = csf + 2048;
    LAS float* glf = gtf + 256;
    const int tid = F.tid, lane = F.lane, w = F.wave, fr = lane & 15, fq = lane >> 4;
    const int ts = tid >> 4, cs = tid & 15, c0 = h * 64 + 4 * cs;
    const int sk = tid & 63, sq = tid >> 6;
    const f32x4 mu_r = *(const f32x4*)(F.in[I_MU] + c0), mu_k = *(const f32x4*)(F.in[I_MU] + 1024 + c0), mu_v = *(const f32x4*)(F.in[I_MU] + 2048 + c0);
    const f32x4 kkc = *(const f32x4*)(F.in[I_KK] + c0), kac = *(const f32x4*)(F.in[I_KA] + c0), rkc = *(const f32x4*)(F.in[I_RK] + c0);
    bf16* BON = (bf16*)(F.ws + WS_WAG + 128 * MiB);
    for (int i = tid; i < 32 * KS; i += 256) Sb[i] = 0;
    v2u cr[2], ck[2], cv[2], qr[2], qk[2], qv[2]; f32x4 a4[2], ws0, ws1;
#define RC_LOAD(ch) do { _Pragma("unroll") for (int p_ = 0; p_ < 2; ++p_) { const int t_ = (ch) * 32 + ts + 16 * p_; const size_t tk_ = (size_t)b * SEQ + t_; const bf16* pr_ = P + tk_ * NINP + c0; \
        cr[p_] = *(const v2u*)(pr_); ck[p_] = *(const v2u*)(pr_ + 1024); cv[p_] = *(const v2u*)(pr_ + 2048); \
        if (t_ > 0) { qr[p_] = *(const v2u*)(pr_ - NINP); qk[p_] = *(const v2u*)(pr_ - NINP + 1024); qv[p_] = *(const v2u*)(pr_ - NINP + 2048); } else { qr[p_] = (v2u){0u, 0u}; qk[p_] = qr[p_]; qv[p_] = qr[p_]; } \
        { const v2u ab_ = *(const v2u*)(AGp + tk_ * D + c0); a4[p_] = UNP4(ab_); } } \
        { const float* wr_ = WAG + ((size_t)b * SEQ + (ch) * 32 + (lane & 31)) * RD + h * 64 + 16 * w + 8 * (lane >> 5); ws0 = *(const f32x4*)wr_; ws1 = *(const f32x4*)(wr_ + 4); } } while (0)
    const int mi = w >> 1, nj = w & 1;
    f32x4 st[2]; st[0] = (f32x4){0.f, 0.f, 0.f, 0.f}; st[1] = st[0];
    RC_LOAD(0);
    rw_bar(bcnt, btarget, lane);
    for (int ch = 0; ch < SEQ / 32; ++ch) {
        f32x4 rr[2], kmod[2], vv[2], kkn[2], al[2];
#pragma unroll
        for (int p_ = 0; p_ < 2; ++p_) { const f32x4 pr4 = UNP4(cr[p_]), pk4 = UNP4(ck[p_]), pv4 = UNP4(cv[p_]), qr4 = UNP4(qr[p_]), qk4 = UNP4(qk[p_]), qv4 = UNP4(qv[p_]); al[p_] = a4[p_];
            rr[p_] = pr4 + (qr4 - pr4) * mu_r; const f32x4 k1 = pk4 + (qk4 - pk4) * mu_k; vv[p_] = pv4 + (qv4 - pv4) * mu_v;
            const f32x4 kkr = k1 * kkc; const float nrm = __builtin_amdgcn_rsqf(fmaxf(allreduce16((kkr[0] * kkr[0] + kkr[1] * kkr[1]) + (kkr[2] * kkr[2] + kkr[3] * kkr[3])), 1e-24f));
            kkn[p_] = kkr * nrm; kmod[p_] = k1 * (1.f + (al[p_] - 1.f) * kac);
            { const f32x4 rk_ = rr[p_] * kmod[p_] * rkc; const float dot = allreduce16((rk_[0] + rk_[1]) + (rk_[2] + rk_[3]));
              if ((cs >> 3) == half) *(unsigned long long*)(BON + ((size_t)b * SEQ + ch * 32 + ts + 16 * p_) * RD + c0) = pack4bf(vv[p_] * dot); }
            }
        { const int tq = lane & 31, hq = lane >> 5; f32x4 c0v, c1v;
#pragma unroll
          for (int j = 0; j < 4; ++j) { c0v[j] = scan32(ws0[j]); c1v[j] = scan32(ws1[j]); }
          *(LAS f32x4*)(csf + tq * 64 + 16 * w + 8 * hq) = c0v; *(LAS f32x4*)(csf + tq * 64 + 16 * w + 8 * hq + 4) = c1v; }
        if (ch + 1 < SEQ / 32) RC_LOAD(ch + 1);
        rw_bar(bcnt, btarget, lane);
#pragma unroll
        for (int p_ = 0; p_ < 2; ++p_) { const int t = ts + 16 * p_; const f32x4 cg = *(const LAS f32x4*)(csf + t * 64 + 4 * cs); f32x4 cgp = (f32x4){0.f, 0.f, 0.f, 0.f}; if (t > 0) cgp = *(const LAS f32x4*)(csf + (t - 1) * 64 + 4 * cs); f32x4 g, gp, gi;
#pragma unroll
          for (int j = 0; j < 4; ++j) { g[j] = __expf(cg[j]); gp[j] = __expf(cgp[j]); gi[j] = __expf(-cg[j]); }
          *(LAS unsigned long long*)(At + t * KS + 4 * cs) = pack4bf(-(kkn[p_] * gp)); *(LAS unsigned long long*)(Bt + t * KS + 4 * cs) = pack4bf(kkn[p_] * al[p_] * gi);
          *(LAS unsigned long long*)(Kt + t * KS + 4 * cs) = pack4bf(kmod[p_] * gi); *(LAS unsigned long long*)(Rt + t * KS + 4 * cs) = pack4bf(rr[p_] * g);
          if ((cs >> 3) == half) *(LAS unsigned long long*)(Vv + t * LS + 4 * (cs & 7)) = pack4bf(vv[p_]);
          if (t == 31) *(LAS f32x4*)(glf + 4 * cs) = g; }
        rw_bar(bcnt, btarget, lane);
        { const int t = 16 * mi + fr, jb = 16 * nj + 4 * fq;
          f32x4 g2 = (f32x4){0.f, 0.f, 0.f, 0.f}, g3 = g2, g4 = g2;
#pragma unroll
          for (int ks = 0; ks < 2; ++ks) { const s16x8 bj = *(const LAS s16x8*)(Bt + (16 * nj + fr) * KS + 32 * ks + 8 * fq), kj = *(const LAS s16x8*)(Kt + (16 * nj + fr) * KS + 32 * ks + 8 * fq);
              const s16x8 at = *(const LAS s16x8*)(At + (16 * mi + fr) * KS + 32 * ks + 8 * fq), rt = *(const LAS s16x8*)(Rt + (16 * mi + fr) * KS + 32 * ks + 8 * fq);
              g2 = __builtin_amdgcn_mfma_f32_16x16x32_bf16(kj, at, g2, 0, 0, 0); g3 = __builtin_amdgcn_mfma_f32_16x16x32_bf16(bj, rt, g3, 0, 0, 0); g4 = __builtin_amdgcn_mfma_f32_16x16x32_bf16(kj, rt, g4, 0, 0, 0); }
#pragma unroll
          for (int rg_ = 0; rg_ < 4; ++rg_) { const int j = jb + rg_; g2[rg_] = (j < t) ? g2[rg_] : 0.f; g3[rg_] = (j <= t) ? g3[rg_] : 0.f; g4[rg_] = (j <= t) ? g4[rg_] : 0.f; }
          *(LAS unsigned long long*)(G2b + t * LS + jb) = pack4bf(g2); *(LAS unsigned long long*)(G3b + t * LS + jb) = pack4bf(g3); *(LAS unsigned long long*)(G4b + t * LS + jb) = pack4bf(g4); }
        { const int tq = lane & 31, hq = lane >> 5;
          f32x16 Pm, Qm, Aq;
#pragma unroll
          for (int i = 0; i < 16; ++i) { Pm[i] = 0.f; Qm[i] = 0.f; }
#pragma unroll
          for (int s = 0; s < 4; ++s) { const s16x8 fa = *(const LAS s16x8*)(At + tq * KS + 16 * s + 8 * hq), fb = *(const LAS s16x8*)(Bt + tq * KS + 16 * s + 8 * hq);
              Pm = MFMA32(fa, fb, Pm); Qm = MFMA32(fb, fa, Qm); }
#pragma unroll
          for (int i = 0; i < 16; ++i) { const int r_ = (i & 3) + 8 * (i >> 2) + 4 * hq;
              Pm[i] = (tq < r_) ? Pm[i] : 0.f;
              Qm[i] = (r_ < tq) ? Qm[i] : 0.f;
              Aq[i] = Qm[i] + ((r_ == tq) ? 1.f : 0.f); }
#pragma unroll
          for (int st = 1; st <= 4; ++st) { const s16x8 p0 = accfrag(Pm, 0), p1 = accfrag(Pm, 1), q0 = accfrag(Qm, 0), q1 = accfrag(Qm, 1);
              f32x16 nP, nQ;
#pragma unroll
              for (int i = 0; i < 16; ++i) { nP[i] = 0.f; nQ[i] = 0.f; }
              nP = MFMA32(q0, p0, nP); nP = MFMA32(q1, p1, nP);
              if (st < 4) { nQ = MFMA32(p0, q0, nQ); nQ = MFMA32(p1, q1, nQ); }
              Pm = nP; Qm = nQ;
              const s16x8 n0 = accfrag(Pm, 0), n1 = accfrag(Pm, 1), a0 = accfrag(Aq, 0), a1 = accfrag(Aq, 1);
              Aq = MFMA32(n0, a0, Aq); Aq = MFMA32(n1, a1, Aq); }
          f32x4 tv; tv[0] = w == 0 ? Aq[0] : w == 1 ? Aq[4] : w == 2 ? Aq[8] : Aq[12]; tv[1] = w == 0 ? Aq[1] : w == 1 ? Aq[5] : w == 2 ? Aq[9] : Aq[13];
          tv[2] = w == 0 ? Aq[2] : w == 1 ? Aq[6] : w == 2 ? Aq[10] : Aq[14]; tv[3] = w == 0 ? Aq[3] : w == 1 ? Aq[7] : w == 2 ? Aq[11] : Aq[15];
          *(LAS unsigned long long*)(Acb + 32 * LS + tq * LS + 8 * w + 4 * hq) = pack4bf(tv); }
        rw_bar(bcnt, btarget, lane);
        f32x4 yv = (f32x4){0.f, 0.f, 0.f, 0.f};
        { f32x4 z = (f32x4){0.f, 0.f, 0.f, 0.f};
#pragma unroll
          for (int ks = 0; ks < 2; ++ks) { const s16x8 sb = *(const LAS s16x8*)(Sb + (16 * nj + fr) * KS + 32 * ks + 8 * fq);
              z = __builtin_amdgcn_mfma_f32_16x16x32_bf16(*(const LAS s16x8*)(At + (16 * mi + fr) * KS + 32 * ks + 8 * fq), sb, z, 0, 0, 0);
              yv = __builtin_amdgcn_mfma_f32_16x16x32_bf16(*(const LAS s16x8*)(Rt + (16 * mi + fr) * KS + 32 * ks + 8 * fq), sb, yv, 0, 0, 0); }
          const s16x8 vt_ = tr_frag(Vv, LS, 8 * fq, 16 * nj, fr);
          z = __builtin_amdgcn_mfma_f32_16x16x32_bf16(*(const LAS s16x8*)(G2b + (16 * mi + fr) * LS + 8 * fq), vt_, z, 0, 0, 0);
          yv = __builtin_amdgcn_mfma_f32_16x16x32_bf16(*(const LAS s16x8*)(G4b + (16 * mi + fr) * LS + 8 * fq), vt_, yv, 0, 0, 0);
          *(LAS unsigned long long*)(RHt + (16 * nj + fr) * LS + 16 * mi + 4 * fq) = pack4bf(z); }
        rw_bar(bcnt, btarget, lane);
        { f32x4 z = (f32x4){0.f, 0.f, 0.f, 0.f};
          z = __builtin_amdgcn_mfma_f32_16x16x32_bf16(*(const LAS s16x8*)(Acb + 32 * LS + (16 * mi + fr) * LS + 8 * fq), *(const LAS s16x8*)(RHt + (16 * nj + fr) * LS + 8 * fq), z, 0, 0, 0);
          *(LAS unsigned long long*)(Ubt + (16 * nj + fr) * LS + 16 * mi + 4 * fq) = pack4bf(z); }
        rw_bar(bcnt, btarget, lane);
        { yv = __builtin_amdgcn_mfma_f32_16x16x32_bf16(*(const LAS s16x8*)(G3b + (16 * mi + fr) * LS + 8 * fq), *(const LAS s16x8*)(Ubt + (16 * nj + fr) * LS + 8 * fq), yv, 0, 0, 0);
          float* yp = YRAW + ((size_t)b * SEQ + ch * 32 + 16 * mi + 4 * fq) * RD + h * 64 + half * 32 + 16 * nj + fr;
#pragma unroll
          for (int rg_ = 0; rg_ < 4; ++rg_) yp[(size_t)rg_ * RD] = yv[rg_]; }
        { const int kt = w; const s16x8 bt_ = tr_frag(Bt, KS, 8 * fq, 16 * kt, fr), kt_ = tr_frag(Kt, KS, 8 * fq, 16 * kt, fr); const f32x4 gl4 = *(const LAS f32x4*)(glf + 16 * kt + 4 * fq);
#pragma unroll
          for (int vt = 0; vt < 2; ++vt) {
              st[vt] = __builtin_amdgcn_mfma_f32_16x16x32_bf16(bt_, *(const LAS s16x8*)(Ubt + (16 * vt + fr) * LS + 8 * fq), st[vt], 0, 0, 0);
              st[vt] = __builtin_amdgcn_mfma_f32_16x16x32_bf16(kt_, tr_frag(Vv, LS, 8 * fq, 16 * vt, fr), st[vt], 0, 0, 0);
              st[vt] = st[vt] * gl4;
              *(LAS unsigned long long*)(Sb + (16 * vt + fr) * KS + 16 * kt + 4 * fq) = pack4bf(st[vt]); } }
    }
#undef RC_LOAD
}

__device__ __forceinline__ float allreduce8(float x) { x += dppf<0x141>(x); x += dppf<0xB1>(x); x += dppf<0x4E>(x); return x; }
__device__ __forceinline__ void rw_bar(LAS unsigned* cnt, unsigned& target, int lane) {
    asm volatile("s_waitcnt lgkmcnt(0)" ::: "memory");
    if (lane == 0) __hip_atomic_fetch_add(cnt, 1u, __ATOMIC_RELAXED, __HIP_MEMORY_SCOPE_WORKGROUP);
    target += 4u;
    while ((unsigned)__builtin_amdgcn_readfirstlane((int)__hip_atomic_load(cnt, __ATOMIC_RELAXED, __HIP_MEMORY_SCOPE_WORKGROUP)) < target) __builtin_amdgcn_s_sleep(1);
    asm volatile("" ::: "memory");
}
constexpr int CV_BR = 8 * 32, CV_WO = 16 * 32, CV_GU = NE * 16 * 64, CV_DN = NE * 16 * 32, CV_ITEMS = 2 * CV_BR + CV_WO + CV_GU + CV_DN;
constexpr int CV_SPLIT = CV_ITEMS - 0;
constexpr int P5_NW = 8;
struct CvItem { const float* src; unsigned char* dst; int N; int f8; };
__device__ __forceinline__ CvItem cv_decode(Frame& F, int it) {
    CvItem c; int r = it; const int lane = F.lane;
    if (r < CV_BR) { const int kb = r >> 5, nb = r & 31; c.src = F.in[I_WBA] + (size_t)(kb * 128) * D + nb * 64 + lane; c.dst = F.ws + WS_WA + ((size_t)(nb * 64 + lane) * RD + kb * 128) * 2; c.N = D; c.f8 = 0; return c; } r -= CV_BR;
    if (r < CV_BR) { const int kb = r >> 5, nb = r & 31; c.src = F.in[I_WBB] + (size_t)(kb * 128) * D + nb * 64 + lane; c.dst = F.ws + WS_WB + ((size_t)(nb * 64 + lane) * RD + kb * 128) * 2; c.N = D; c.f8 = 0; return c; } r -= CV_BR;
    if (r < CV_WO) { const int kb = r >> 5, nb = r & 31; c.src = F.in[I_WOUT] + (size_t)(kb * 128) * D + nb * 64 + lane; c.dst = F.ws + WS_WO + ((size_t)(nb * 64 + lane) * D + kb * 128) * 2; c.N = D; c.f8 = 0; return c; } r -= CV_WO;
    if (r < CV_GU) { const int e = r >> 10, q = r & 1023, kb = q >> 6, nb = q & 63, n0 = nb * 64;
        const int dr = n0 < FF ? ((n0 >> 7) * 256 + (n0 & 127)) : (((n0 - FF) >> 7) * 256 + 128 + ((n0 - FF) & 127));
        c.src = F.in[I_WGU] + (size_t)e * D * 2 * FF + (size_t)(kb * 128) * (2 * FF) + n0 + lane; c.dst = F.ws + WS_WGU + (size_t)e * 2 * FF * D + (size_t)(dr + lane) * D + kb * 128; c.N = 2 * FF; c.f8 = 1; return c; } r -= CV_GU;
    { const int e = r >> 9, q = r & 511, kb = q >> 5, nb = q & 31;
        c.src = F.in[I_WDN] + (size_t)e * FF * D + (size_t)(kb * 128) * D + nb * 64 + lane; c.dst = F.ws + WS_WDN + (size_t)e * D * FF + (size_t)(nb * 64 + lane) * FF + kb * 128; c.N = D; c.f8 = 1; }
    return c;
}
__device__ __forceinline__ void convert_item(Frame& F, int it, LAS unsigned char* cvbuf);
__device__ __forceinline__ void convert_loop(Frame& F, unsigned* next, unsigned* p1done, unsigned ngemm, LAS unsigned char* cvbuf, unsigned lo, unsigned hi) {
#define CV_CLAIM(b_) do { b_ = 0xffffffffu; if (F.lane == 0) { if (!(p1done && __hip_atomic_load(p1done, __ATOMIC_RELAXED, __HIP_MEMORY_SCOPE_AGENT) >= ngemm)) b_ = __hip_atomic_fetch_add(next, 2u, __ATOMIC_RELAXED, __HIP_MEMORY_SCOPE_AGENT); } } while (0)
    unsigned nb; CV_CLAIM(nb);
    for (;;) { const unsigned b0 = (unsigned)__builtin_amdgcn_readfirstlane((int)nb); if (b0 >= hi - lo) break;
        const unsigned base = b0 + lo;
        if (!p1done) CV_CLAIM(nb);
        for (int k = 0; k < 2; ++k) { const unsigned it = base + k; if (it < hi) convert_item(F, (int)it, cvbuf); }
        if (p1done) CV_CLAIM(nb); }
#undef CV_CLAIM
}
__device__ __forceinline__ void convert_item(Frame& F, int i0, LAS unsigned char* cvbuf) {
    { const CvItem c = cv_decode(F, i0);
        float x[128];
#pragma unroll
        for (int i = 0; i < 128; ++i) x[i] = c.src[(size_t)i * c.N];
        if (c.f8) {
            const int lane = F.lane; LAS unsigned char* bw = cvbuf + lane * 144;
#pragma unroll
            for (int q = 0; q < 8; ++q) { v4u o; o.x = pk4f8(x[16 * q + 0] * F8_SW, x[16 * q + 1] * F8_SW, x[16 * q + 2] * F8_SW, x[16 * q + 3] * F8_SW); o.y = pk4f8(x[16 * q + 4] * F8_SW, x[16 * q + 5] * F8_SW, x[16 * q + 6] * F8_SW, x[16 * q + 7] * F8_SW);
                o.z = pk4f8(x[16 * q + 8] * F8_SW, x[16 * q + 9] * F8_SW, x[16 * q + 10] * F8_SW, x[16 * q + 11] * F8_SW); o.w = pk4f8(x[16 * q + 12] * F8_SW, x[16 * q + 13] * F8_SW, x[16 * q + 14] * F8_SW, x[16 * q + 15] * F8_SW);
                *(LAS v4u*)(bw + 16 * q) = o; }
            unsigned char* d0 = c.dst - (size_t)lane * 2048 + (size_t)(lane >> 3) * 2048 + (lane & 7) * 16; const LAS unsigned char* br = cvbuf + (lane >> 3) * 144 + (lane & 7) * 16;
#pragma unroll
            for (int i = 0; i < 8; ++i) { const v4u v = *(const LAS v4u*)(br + i * 8 * 144); *(v4u*)(d0 + (size_t)i * 8 * 2048) = v; } }
        else {
#pragma unroll
            for (int q = 0; q < 16; ++q) { v4u o; o.x = pk2(x[8 * q + 0], x[8 * q + 1]); o.y = pk2(x[8 * q + 2], x[8 * q + 3]); o.z = pk2(x[8 * q + 4], x[8 * q + 5]); o.w = pk2(x[8 * q + 6], x[8 * q + 7]);
                *(v4u*)(c.dst + 16 * q) = o; } } }
}

__device__ __forceinline__ void mlstm_scan_unit(Frame& F, int unit, LAS unsigned* bcnt, unsigned& btarget) {
    const int b = unit >> 5, mh = (unit >> 3) & 3, sl = unit & 7;
    const bf16* P = (const bf16*)(F.ws + WS_P); const bf16* QKC = (const bf16*)(F.ws + WS_QKC); const float* GLF = (const float*)(F.ws + WS_GLF); float* HRAW = (float*)(F.ws + WS_HRAW);
    constexpr int VS = 56;
    LAS bf16* Lq = (LAS bf16*)F.lds;
    LAS bf16* Lk = Lq + 64 * 136;
    LAS bf16* Lv = Lk + 64 * 136;
    LAS bf16* Lvs = Lv + 64 * VS;
    LAS bf16* LcT = Lvs + 64 * VS;
    LAS bf16* Ls = LcT + 2 * 48 * 136;
    LAS float* sb = (LAS float*)(Ls + 64 * 72); LAS float* su = sb + 64; LAS float* smx = su + 64; LAS float* swk = smx + 64;
    const int tid = F.tid, lane = F.lane, w = F.wave, fr = lane & 15, fq = lane >> 4;
    for (int i = tid; i < 2 * 48 * 136; i += 256) LcT[i] = 0;
    for (int i = tid; i < 64 * 16; i += 256) { const int j = i >> 4, c = 32 + (i & 15); Lv[j * VS + c] = (c == 32) ? (bf16)0x3F80 : (bf16)0; Lvs[j * VS + c] = 0; }
    const int pr0 = tid >> 4, pc = 8 * (tid & 15);
    v4u rq[4], rk[4], rv; f32x4 g3;
#define ML_LOAD(ch) do { const size_t tk0_ = (size_t)b * SEQ + (ch) * 64; \
        _Pragma("unroll") for (int i_ = 0; i_ < 4; ++i_) { const bf16* s_ = QKC + (tk0_ + pr0 + 16 * i_) * 1024 + mh * 128 + pc; rq[i_] = *(const v4u*)s_; rk[i_] = *(const v4u*)(s_ + 512); } \
        rv = *(const v4u*)(P + (tk0_ + (tid >> 2)) * NINP + MLO + 1024 + mh * 256 + sl * 32 + 8 * (tid & 3)); \
        g3 = *(const f32x4*)(GLF + (tk0_ + lane) * 16 + 4 * mh); } while (0)
    f32x4 st[2][3];
#pragma unroll
    for (int a = 0; a < 2; ++a)
#pragma unroll
        for (int n = 0; n < 3; ++n) st[a][n] = (f32x4){0.f, 0.f, 0.f, 0.f};
    float mstate = 0.f;
    ML_LOAD(0);
    rw_bar(bcnt, btarget, lane);
    for (int ch = 0; ch < SEQ / 64; ++ch) {
        const size_t tk0 = (size_t)b * SEQ + ch * 64;
        LAS bf16* cTc = LcT + (ch & 1) * 48 * 136; LAS bf16* cTn = LcT + ((ch + 1) & 1) * 48 * 136;
        float mnew, dec;
        { const float bc = g3[0], u = g3[1], pm = g3[2];
          const float gtot = __shfl(bc, 63), pmall = __shfl(pm, 63);
          mnew = gtot + fmaxf(mstate, pmall); dec = __expf(gtot + mstate - mnew);
          const float wk = __expf(u + gtot - mnew);
          sb[lane] = bc; su[lane] = u; smx[lane] = fmaxf(mstate, pm); swk[lane] = wk;
          if (w == 0) Lvs[lane * VS + 32] = (bf16)f2bf(wk); }
#pragma unroll
        for (int i = 0; i < 4; ++i) { *(LAS v4u*)(Lq + (pr0 + 16 * i) * 136 + pc) = rq[i]; *(LAS v4u*)(Lk + (pr0 + 16 * i) * 136 + pc) = rk[i]; }
        LDS_WAIT();
        { const int j = tid >> 2, d0 = 8 * (tid & 3); const float wkj = swk[j]; *(LAS v4u*)(Lv + j * VS + d0) = rv;
          const unsigned uu[4] = {rv.x, rv.y, rv.z, rv.w}; v4u sv;
          sv.x = pk2(wkj * __uint_as_float(uu[0] << 16), wkj * __uint_as_float(uu[0] & 0xffff0000u)); sv.y = pk2(wkj * __uint_as_float(uu[1] << 16), wkj * __uint_as_float(uu[1] & 0xffff0000u));
          sv.z = pk2(wkj * __uint_as_float(uu[2] << 16), wkj * __uint_as_float(uu[2] & 0xffff0000u)); sv.w = pk2(wkj * __uint_as_float(uu[3] << 16), wkj * __uint_as_float(uu[3] & 0xffff0000u));
          *(LAS v4u*)(Lvs + j * VS + d0) = sv; }
        if (ch + 1 < SEQ / 64) ML_LOAD(ch + 1);
        rw_bar(bcnt, btarget, lane);
        { const int tt = w; const int t = 16 * tt + fr; const float mxt = smx[t];
#pragma unroll
          for (int jt = 0; jt < 4; ++jt) { f32x4 acc = (f32x4){0.f, 0.f, 0.f, 0.f};
              if (jt <= tt) {
#pragma unroll
                  for (int ks = 0; ks < 4; ++ks) { const s16x8 a = *(const LAS s16x8*)(Lk + (16 * jt + fr) * 136 + 32 * ks + 8 * fq), bq = *(const LAS s16x8*)(Lq + (16 * tt + fr) * 136 + 32 * ks + 8 * fq);
                      acc = __builtin_amdgcn_mfma_f32_16x16x32_bf16(a, bq, acc, 0, 0, 0); }
                  const f32x4 u4 = *(const LAS f32x4*)(su + 16 * jt + 4 * fq);
#pragma unroll
                  for (int rg_ = 0; rg_ < 4; ++rg_) { const int j = 16 * jt + 4 * fq + rg_; acc[rg_] = (j <= t) ? acc[rg_] * __expf(u4[rg_] - mxt) : 0.f; } }
              *(LAS unsigned long long*)(Ls + t * 72 + 16 * jt + 4 * fq) = pack4bf(acc); } }
        rw_bar(bcnt, btarget, lane);
        { const int mi = w; f32x4 a1[3], a2[3];
#pragma unroll
          for (int n = 0; n < 3; ++n) { a1[n] = (f32x4){0.f, 0.f, 0.f, 0.f}; a2[n] = a1[n]; }
#pragma unroll
          for (int ks = 0; ks < 2; ++ks) { const s16x8 A = *(const LAS s16x8*)(Ls + (16 * mi + fr) * 72 + 32 * ks + 8 * fq);
#pragma unroll
              for (int n = 0; n < 3; ++n) a1[n] = __builtin_amdgcn_mfma_f32_16x16x32_bf16(A, tr_frag(Lv, VS, 32 * ks + 8 * fq, 16 * n, fr), a1[n], 0, 0, 0); }
#pragma unroll
          for (int ks = 0; ks < 4; ++ks) { const s16x8 A = *(const LAS s16x8*)(Lq + (16 * mi + fr) * 136 + 32 * ks + 8 * fq);
#pragma unroll
              for (int n = 0; n < 3; ++n) a2[n] = __builtin_amdgcn_mfma_f32_16x16x32_bf16(A, *(const LAS s16x8*)(cTc + (16 * n + fr) * 136 + 32 * ks + 8 * fq), a2[n], 0, 0, 0); }
          const f32x4 mx4 = *(const LAS f32x4*)(smx + 16 * mi + 4 * fq), b4 = *(const LAS f32x4*)(sb + 16 * mi + 4 * fq);
#pragma unroll
          for (int rg_ = 0; rg_ < 4; ++rg_) { const float wi = __expf(mstate - mx4[rg_]); float den = a1[2][rg_] + wi * a2[2][rg_]; den = __shfl(den, lane & 48);
              const float mt = b4[rg_] + mx4[rg_]; const float inv = __builtin_amdgcn_rcpf(fmaxf(fabsf(den), __expf(-mt))); float* hp = HRAW + (tk0 + 16 * mi + 4 * fq + rg_) * RD + mh * 256 + sl * 32 + fr;
              hp[0] = (a1[0][rg_] + wi * a2[0][rg_]) * inv; hp[16] = (a1[1][rg_] + wi * a2[1][rg_]) * inv; } }
        {
#pragma unroll
          for (int a = 0; a < 2; ++a) {
#pragma unroll
              for (int n = 0; n < 3; ++n) st[a][n] = st[a][n] * dec;
#pragma unroll
              for (int ks = 0; ks < 2; ++ks) { const s16x8 A = tr_frag(Lk, 136, 32 * ks + 8 * fq, 16 * (2 * w + a), fr);
#pragma unroll
                  for (int n = 0; n < 3; ++n) st[a][n] = __builtin_amdgcn_mfma_f32_16x16x32_bf16(A, tr_frag(Lvs, VS, 32 * ks + 8 * fq, 16 * n, fr), st[a][n], 0, 0, 0); }
#pragma unroll
              for (int n = 0; n < 3; ++n) *(LAS unsigned long long*)(cTn + (16 * n + fr) * 136 + 16 * (2 * w + a) + 4 * fq) = pack4bf(st[a][n]); } }
        mstate = mnew;
        rw_bar(bcnt, btarget, lane);
    }
#undef ML_LOAD
}

__device__ __forceinline__ float rowsum4(f32x4 v) { return (v[0] + v[1]) + (v[2] + v[3]); }
__device__ __forceinline__ void p5_finalize(Frame& F) {
    const bf16* __restrict__ P = (const bf16*)(F.ws + WS_P); const bf16* __restrict__ AGp = (const bf16*)(F.ws + WS_WAG + 64 * MiB); const float* __restrict__ YRAW = (const float*)(F.ws + WS_YRAW); const float* __restrict__ HRAW = (const float*)(F.ws + WS_HRAW);
    bf16* __restrict__ OA = (bf16*)(F.ws + WS_OA); bf16* __restrict__ OB = (bf16*)(F.ws + WS_OB);
    const int gw = F.bid * P5_NW + F.wave, NGW = F.G * P5_NW, lane = F.lane;
    { const int hq = gw & 3, c0 = (hq * 4 + (lane >> 4)) * 64 + 4 * (lane & 15);
      const f32x4 lnw = *(const f32x4*)(F.in[I_LNW] + c0), lnb = *(const f32x4*)(F.in[I_LNB] + c0); const bf16* __restrict__ BON = (const bf16*)(F.ws + WS_WAG + 128 * MiB);
      v2u bo[2], gb[2]; f32x4 y4[2];
#define P5_LOAD(i_, q_) do { if ((q_) < T * 4) { const int tk_ = (q_) >> 2; bo[i_] = *(const v2u*)(BON + (size_t)tk_ * RD + c0); gb[i_] = *(const v2u*)(AGp + (size_t)tk_ * D + RD + c0); y4[i_] = *(const f32x4*)(YRAW + (size_t)tk_ * RD + c0); } } while (0)
      P5_LOAD(0, gw); P5_LOAD(1, gw + NGW);
      for (int q = gw; q < T * 4; q += 2 * NGW) { const v2u cb0 = bo[0], cg0 = gb[0], cb1 = bo[1], cg1 = gb[1]; const f32x4 cy0 = y4[0], cy1 = y4[1];
          P5_LOAD(0, q + 2 * NGW); P5_LOAD(1, q + 3 * NGW);
#pragma unroll
          for (int i = 0; i < 2; ++i) { const int qq = q + i * NGW; if (qq < T * 4) { const int tk = qq >> 2; const f32x4 bon = i ? UNP4(cb1) : UNP4(cb0), g = i ? UNP4(cg1) : UNP4(cg0), y = i ? cy1 : cy0;
              const float mean = allreduce16(rowsum4(y)) * (1.f / 64.f); const f32x4 dl = y - mean;
              const float var = allreduce16(rowsum4(dl * dl)) * (1.f / 64.f); const float rs = __builtin_amdgcn_rsqf(var + GN_EPS);
              const f32x4 o = (dl * rs * lnw + lnb + bon) * g;
              v2u ov; ov.x = pk2(o[0], o[1]); ov.y = pk2(o[2], o[3]); *(v2u*)(OA + (size_t)tk * RD + c0) = ov; } } }
#undef P5_LOAD
    }
    { const int mh = gw & 3, d0 = mh * 256 + 4 * lane; const f32x4 nw = *(const f32x4*)(F.in[I_MNW] + d0);
      f32x4 hv[2]; v2u po[2];
#define P5B_LOAD(i_, q_) do { if ((q_) < T * 4) { const int tk_ = (q_) >> 2; hv[i_] = *(const f32x4*)(HRAW + (size_t)tk_ * RD + d0); po[i_] = *(const v2u*)(P + (size_t)tk_ * NINP + MLO + 2056 + d0); } } while (0)
      P5B_LOAD(0, gw); P5B_LOAD(1, gw + NGW);
      for (int q = gw; q < T * 4; q += 2 * NGW) { const f32x4 ch0 = hv[0], ch1 = hv[1]; const v2u cp0 = po[0], cp1 = po[1];
          P5B_LOAD(0, q + 2 * NGW); P5B_LOAD(1, q + 3 * NGW);
#pragma unroll
          for (int i = 0; i < 2; ++i) { const int qq = q + i * NGW; if (qq < T * 4) { const int tk = qq >> 2; const f32x4 h4 = i ? ch1 : ch0; const v2u p2 = i ? cp1 : cp0;
              float ss = allreduce16(rowsum4(h4 * h4)); ss += __shfl_xor(ss, 16); ss += __shfl_xor(ss, 32);
              const float rs = __builtin_amdgcn_rsqf(ss * (1.f / 256.f) + NORM_EPS); const f32x4 og = UNP4(p2);
              const float o0 = h4[0] * rs * nw[0] * sigm(og[0]), o1 = h4[1] * rs * nw[1] * sigm(og[1]), o2 = h4[2] * rs * nw[2] * sigm(og[2]), o3 = h4[3] * rs * nw[3] * sigm(og[3]);
              v2u o; o.x = pk2(o0, o1); o.y = pk2(o2, o3); *(v2u*)(OB + (size_t)tk * RD + d0) = o; } } }
#undef P5B_LOAD
    }
}

typedef float f32x16 __attribute__((ext_vector_type(16)));
__device__ __forceinline__ void p8_route(Frame& F) {
    const bf16* X1 = (const bf16*)(F.ws + WS_X1); unsigned char* H2 = (unsigned char*)(F.ws + WS_HN); int* RLIST = (int*)(F.ws + WS_RLIST); float* RWT = (float*)(F.ws + WS_RW);
    const float* RWS = (const float*)(F.ws + WS_RWS); const float* nw = F.in[I_N2W]; const float* rtb = F.in[I_RTB];
    LAS float* part = (LAS float*)F.lds;
    LAS float* ssq = part + 8 * 32 * 33;
    LAS float* lgt = ssq + 256;
    LAS float* srs = lgt + 32 * 33;
    const int lane = F.lane, w = F.wave, i = lane & 31, h = lane >> 5, tid = F.tid;
    for (int tile = F.bid; tile < T / 32; tile += F.G) {
        const int m0 = tile * 32; const bf16* xrow = X1 + (size_t)(m0 + i) * D + 256 * w + 4 * h;
        f32x16 acc;
#pragma unroll
        for (int r_ = 0; r_ < 16; ++r_) acc[r_] = 0.f;
        float ss = 0.f; const float* bp = RWS + (size_t)(256 * w + 4 * h) * NE + i;
#pragma unroll 4
        for (int q = 0; q < 32; ++q) { const v2u xb_ = *(const v2u*)(xrow + 8 * q); const f32x4 xa = UNP4(xb_);
#pragma unroll
            for (int j = 0; j < 4; ++j) acc = __builtin_amdgcn_mfma_f32_32x32x2f32(xa[j], bp[(8 * q + j) * NE], acc, 0, 0, 0);
            ss += (xa[0] * xa[0] + xa[1] * xa[1]) + (xa[2] * xa[2] + xa[3] * xa[3]); }
        ss += __shfl_xor(ss, 32);
        if (h == 0) ssq[w * 32 + i] = ss;
#pragma unroll
        for (int r_ = 0; r_ < 16; ++r_) part[(w * 32 + (r_ & 3) + 8 * (r_ >> 2) + 4 * h) * 33 + i] = acc[r_];
        __syncthreads();
#pragma unroll
        for (int k2 = 0; k2 < 2; ++k2) { const int idx = tid + NTHR * k2, ii = idx >> 5, e = idx & 31; float sm = 0.f, sq = 0.f;
#pragma unroll
            for (int ww = 0; ww < 8; ++ww) { sm += part[(ww * 32 + ii) * 33 + e]; sq += ssq[ww * 32 + ii]; }
            const float rs = 1.f / sqrtf(sq * (1.f / D) + NORM_EPS); lgt[ii * 33 + e] = sm * rs + rtb[e]; if (e == 0) srs[ii] = rs; }
        __syncthreads();
        { const float rs = srs[i] * F8_SX; unsigned char* orow = H2 + (size_t)(m0 + i) * D + 256 * w + 4 * h;
#pragma unroll 8
          for (int q = 0; q < 32; ++q) { const f32x4 n4 = *(const f32x4*)(nw + 256 * w + 4 * h + 8 * q); const v2u xb_ = *(const v2u*)(xrow + 8 * q); const f32x4 hv = UNP4(xb_) * rs * n4; *(unsigned*)(orow + 8 * q) = pk4f8(hv[0], hv[1], hv[2], hv[3]); } }
        if (tid < 32) { const LAS float* lr = lgt + tid * 33; unsigned used = 0u; int idx[4]; float val[4];
#pragma unroll
            for (int s4 = 0; s4 < 4; ++s4) { float best = -INFINITY; int bi = 0;
                for (int e = 0; e < 32; ++e) { const float v = lr[e]; const bool ok = !((used >> e) & 1u) && (v > best); best = ok ? v : best; bi = ok ? e : bi; }
                used |= 1u << bi; idx[s4] = bi; val[s4] = best; }
            const float e1 = __expf(val[1] - val[0]), e2 = __expf(val[2] - val[0]), e3 = __expf(val[3] - val[0]); const float inv = 1.f / (1.f + e1 + e2 + e3);
            const float wv[4] = {inv, e1 * inv, e2 * inv, e3 * inv};
            unsigned pos[4];
#pragma unroll
            for (int s4 = 0; s4 < 4; ++s4) pos[s4] = atomicAdd(F.ctl + CW_CNT + 64 * idx[s4], 1u);
#pragma unroll
            for (int s4 = 0; s4 < 4; ++s4) { RLIST[idx[s4] * ECAP + pos[s4]] = (m0 + tid) * 4 + s4; RWT[idx[s4] * ECAP + pos[s4]] = wv[s4]; } }
        __syncthreads();
    }
}

__device__ __forceinline__ void build_moe_tables(Frame& F) {
    LAS int* MI = (LAS int*)F.MISC;
    __syncthreads();
    if (F.tid < NE) MI[MI_CNT + F.tid] = (int)__hip_atomic_load(F.ctl + CW_CNT + 64 * F.tid, __ATOMIC_RELAXED, __HIP_MEMORY_SCOPE_AGENT);
    __syncthreads();
    if (F.tid == 0) { int mt = 0, cs = 0;
        for (int e = 0; e < NE; ++e) { const int c = MI[MI_CNT + e]; MI[MI_POFF + e] = mt * 256; MI[MI_CST + e] = cs; cs += c;
            const int nt = (c + 255) >> 8; for (int i = 0; i < nt; ++i) { MI[MI_TILE_E + mt + i] = e; MI[MI_TILE_I0 + mt + i] = i * 256; } mt += nt; }
        MI[MI_CST + NE] = cs; MI[MI_MT] = mt; }
    __syncthreads();
}
__device__ __forceinline__ void p9_gather(Frame& F) {
    build_moe_tables(F);
    const LAS int* MI = (const LAS int*)F.MISC; const bf16* H2 = (const bf16*)(F.ws + WS_HN); bf16* XB = (bf16*)(F.ws + WS_XB); const int* RLIST = (const int*)(F.ws + WS_RLIST);
    const int gw = F.bid * NWAVES + F.wave, NGW = F.G * NWAVES, total = MI[MI_CST + NE];
    for (int q = gw; q < total; q += NGW) { int e = 0;
        for (int k = 1; k < NE; ++k) e = (MI[MI_CST + k] <= q) ? k : e;
        const int i = q - MI[MI_CST + e]; const int tok = RLIST[e * ECAP + i] >> 2;
        const v4u* src = (const v4u*)(H2 + (size_t)tok * D) + F.lane; v4u* dst = (v4u*)(XB + (size_t)(MI[MI_POFF + e] + i) * D) + F.lane;
#pragma unroll
        for (int j = 0; j < 4; ++j) dst[64 * j] = src[64 * j]; }
}
__device__ __forceinline__ void p12_final(Frame& F) {
    const bf16* X1 = (const bf16*)(F.ws + WS_X1); const unsigned char* YS = (const unsigned char*)(F.ws + WS_YS); const float* fw = F.in[I_FNW];
    const int gw = F.bid * NWAVES + F.wave, NGW = F.G * NWAVES;
    for (int m = gw; m < T; m += NGW) {
        const v2u* xr = (const v2u*)(X1 + (size_t)m * D) + F.lane; f32x4 v[8]; float s = 0.f;
#pragma unroll
        for (int j = 0; j < 8; ++j) { const v2u xb_ = xr[64 * j]; v[j] = UNP4(xb_);
#pragma unroll
            for (int sl = 0; sl < 4; ++sl) { const int y = ((const int*)(YS + ((size_t)m * 4 + sl) * D))[F.lane + 64 * j];
                const f32x2 ylo = __builtin_amdgcn_cvt_pk_f32_fp8(y, false), yhi = __builtin_amdgcn_cvt_pk_f32_fp8(y, true);
                v[j][0] += ylo[0] * (1.f / F8_SY); v[j][1] += ylo[1] * (1.f / F8_SY); v[j][2] += yhi[0] * (1.f / F8_SY); v[j][3] += yhi[1] * (1.f / F8_SY); }
            s += (v[j][0] * v[j][0] + v[j][1] * v[j][1]) + (v[j][2] * v[j][2] + v[j][3] * v[j][3]); }
        const float rstd = __builtin_amdgcn_rsqf(wave_sum(s) * (1.f / D) + NORM_EPS);
        f32x4* orow = (f32x4*)(F.out + (size_t)m * D) + F.lane;
#pragma unroll
        for (int j = 0; j < 8; ++j) { const f32x4 w = ((const f32x4*)fw)[F.lane + 64 * j]; orow[64 * j] = v[j] * rstd * w; }
    }
}

__global__ void __launch_bounds__(NTHR, 2) mk_fwd(Args args) {
    extern __shared__ __attribute__((aligned(16))) unsigned char lds[];
    Frame F;
    F.lds = (LAS unsigned char*)lds; F.MISC = (volatile LAS unsigned*)(F.lds + MISC_OFF);
    F.tid = threadIdx.x; F.lane = F.tid & 63; F.wave = __builtin_amdgcn_readfirstlane(F.tid >> 6); F.G = gridDim.x; F.bid = blockIdx.x;
    F.in = args.in; F.out = args.out; F.ws = args.ws; F.ctl = (unsigned*)(args.ws + WS_CTL);
    for (int u = F.tid; u < (LDS_BYTES - MISC_OFF) / 4; u += NTHR) ((LAS unsigned*)(F.lds + MISC_OFF))[u] = 0u;
    __syncthreads();
    XcdBarrier bar; bar.bar = F.ctl + CW_BAR; bar.x = 0; bar.st = nullptr;
    if (MK_N_LAUNCHES == 1) bar = xcd_barrier_post(F.ctl + CW_BAR, F.MISC + 8);
    const int lo = args.ph_lo, hi = args.ph_hi;
#define IN(k) (lo <= (k) && (k) < hi)
#ifndef PROBE_PHASE
#define PROBE_PHASE -1
#endif
#define REP(k) ((PROBE_PHASE) == (k) ? 2 : 1)
#ifndef TPROBE
#define TPROBE -1
#endif
#if TPROBE >= 0
    unsigned long long tpA = 0, tpB = 0;
#define TP_A(k) do { if ((k) == TPROBE / 100) tpA = __builtin_amdgcn_s_memrealtime(); } while (0)
#define TP_B(k) do { if ((k) == TPROBE % 100) tpB = __builtin_amdgcn_s_memrealtime(); } while (0)
#else
#define TP_A(k) do {} while (0)
#define TP_B(k) do {} while (0)
#endif
#define SEAM(k) do { if (IN(k) && IN((k) + 1)) xcd_barrier(bar); TP_B(k); } while (0)
    LAS unsigned char* ring = F.lds;
    const LAS int* MI = (const LAS int*)F.MISC;

    static_assert(MK_N_LAUNCHES == 1, "the W_in quantisation needs an in-launch barrier inside phase 0");
    TP_A(0); if (IN(0)) { p0_prologue(F); xcd_barrier(bar); p0b_win(F); } SEAM(0);
    TP_A(1); if (IN(1)) {
        const int ng = F.G > 2 * NCV ? F.G - NCV : F.G;
        if (F.bid < ng) {
            pg8::Gemm g{(const bf16*)(F.ws + WS_HN), (const bf16*)(F.ws + WS_WIN), T, NINP, D / 2}; pg8::StaticOrder S; S.init(T, NINP, ng, F.bid);
            EpiP1I8 E{(bf16*)(F.ws + WS_P), NINP, (const float*)(F.ws + WS_RA), F.ctl + CW_COLMAX};
            pg8::gemm_phase<EpiP1I8, pg8::StaticOrder, true, true, false, true>(ring, g, S, E);
            if (F.tid == 0) __hip_atomic_fetch_add(F.ctl + CW_P1DONE, 1u, __ATOMIC_RELAXED, __HIP_MEMORY_SCOPE_AGENT);
        } else if (F.wave >= CV1_W0) convert_loop(F, F.ctl + CW_CVNEXT, F.ctl + CW_P1DONE, (unsigned)ng, F.lds + F.wave * 9216, 0u, (unsigned)CV_SPLIT);
    } SEAM(1);
    TP_A(2); if (IN(2)) { for (int rep = 0; rep < REP(2); ++rep) p2_lora_in(F); } SEAM(2);
    TP_A(3); if (IN(3)) {
        pg8::Gemm g{(const bf16*)(F.ws + WS_LIN), (const bf16*)(F.ws + WS_WL), T, 3072, 512}; pg8::StaticOrder S; S.init(T, 3072, F.G, F.bid);
        EpiLora E{(float*)(F.ws + WS_WAG), (bf16*)(F.ws + WS_WAG + 64 * MiB), F.in[I_W0], F.in[I_A0]};
        pg8::gemm_phase<EpiLora, pg8::StaticOrder, true, true>(ring, g, S, E);
    } SEAM(3);
    TP_A(4); if (IN(4)) {
        { LAS unsigned* ctl2 = (LAS unsigned*)F.MISC + 16;
          TP_A(14); TP_A(15); TP_A(16); if (F.wave < 4) { TP_B(14); TP_B(16); unsigned bt = 0u; for (int rep = 0; rep < REP(40); ++rep) for (int u = F.bid; u < 256; u += F.G) rwkv_chunk_unit(F, u, (LAS unsigned char*)F.MISC + 256, ctl2, bt); TP_B(15); }
          else { Frame F2 = F; F2.tid = F.tid - 256; F2.wave = F.wave - 4; F2.lds = F.lds + 45056; unsigned bt = 0u;
                 for (int rep = 0; rep < REP(41); ++rep) for (int u = F.bid; u < 256; u += F.G) mlstm_scan_unit(F2, u, ctl2 + 2, bt);
                 rw_bar(ctl2 + 2, bt, F2.lane); TP_B(15); TP_B(16); }
          if (F.wave >= CV_W0) convert_loop(F, F.ctl + CW_CVNEXT, nullptr, 0u, F.lds + 45056 + (F.wave - 4) * 9216, 0u, (unsigned)CV_SPLIT);
          if (F.wave >= 4) TP_B(14);
          __syncthreads(); }
    } SEAM(4);
    TP_A(5); if (IN(5)) { if (F.wave < P5_NW) { for (int rep = 0; rep < REP(5); ++rep) p5_finalize(F); }
                 else convert_loop(F, F.ctl + CW_CVNEXT2, nullptr, 0u, F.lds + F.wave * 9216, (unsigned)CV_SPLIT, (unsigned)CV_ITEMS); }     SEAM(5);
    TP_A(6); if (IN(6)) {
        { pg8::Gemm g{(const bf16*)(F.ws + WS_OA), (const bf16*)(F.ws + WS_WA), T, D, RD}; pg8::StaticOrder S; S.init(T, D, F.G, F.bid);
          EpiGateA E{(bf16*)(F.ws + WS_TMP), (const bf16*)(F.ws + WS_P), F.in[I_BGATE]};
          pg8::gemm_phase<EpiGateA, pg8::StaticOrder, true, true>(ring, g, S, E); }
        VM_WAIT(); __syncthreads();
        { pg8::Gemm g{(const bf16*)(F.ws + WS_OB), (const bf16*)(F.ws + WS_WB), T, D, RD}; pg8::StaticOrder S; S.init(T, D, F.G, F.bid);
          EpiGateB E{(const bf16*)(F.ws + WS_TMP), (bf16*)(F.ws + WS_MRG), (const bf16*)(F.ws + WS_P), F.in[I_BGATE]};
          pg8::gemm_phase<EpiGateB, pg8::StaticOrder, true, true>(ring, g, S, E); }
    } SEAM(6);
    TP_A(7); if (IN(7)) {
        pg8::Gemm g{(const bf16*)(F.ws + WS_MRG), (const bf16*)(F.ws + WS_WO), T, D, D}; pg8::StaticOrder S; S.init(T, D, F.G, F.bid);
        EpiResid E{F.in[I_X], (bf16*)(F.ws + WS_X1)};
        pg8::gemm_phase<EpiResid, pg8::StaticOrder, true, true>(ring, g, S, E);
    } SEAM(7);
    TP_A(8); if (IN(8)) { p8_route(F); } SEAM(8);
    TP_A(10); if (IN(10)) {
        build_moe_tables(F);
        const int mt = MI[MI_MT];
        pg8::Gemm g{(const bf16*)(F.ws + WS_HN), (const bf16*)(F.ws + WS_WGU), mt * 256, 2 * FF, D / 2};
        MoeGatherOrder S; S.init(mt * 256, 2 * FF, F.G, F.bid); S.tile_e = MI + MI_TILE_E; S.estride = (size_t)2 * FF * D;
        S.tile_i0 = MI + MI_TILE_I0; S.cnt = MI + MI_CNT; S.rlist = (const int*)(F.ws + WS_RLIST); S.rowoff = (LAS unsigned*)F.MISC + MI_ROWOFF; S.rowbytes = D;
        EpiSwiGLU E{(unsigned char*)(F.ws + WS_ACT), F.in[I_BGU], MI + MI_TILE_E};
        pg8::gemm_phase<EpiSwiGLU, MoeGatherOrder, true, true, true>(ring, g, S, E);
    } SEAM(10);
    TP_A(11); if (IN(11)) {
        build_moe_tables(F);
        const int mt = MI[MI_MT];
        pg8::Gemm g{(const bf16*)(F.ws + WS_ACT), (const bf16*)(F.ws + WS_WDN), mt * 256, D, FF / 2};
        MoeOrder S; S.init(mt * 256, D, F.G, F.bid); S.tile_e = MI + MI_TILE_E; S.estride = (size_t)D * FF;
        LAS int* rowdst = (LAS int*)F.MISC + MI_ROWOFF; LAS float* rowwt = (LAS float*)F.MISC + MI_ROWOFF + 10 * 256;
        fill_down_tables(F, S, rowdst, rowwt);
        EpiDown E{(unsigned char*)(F.ws + WS_YS), F.in[I_BDN], MI + MI_TILE_E, rowdst, rowwt};
        pg8::gemm_phase<EpiDown, MoeOrder, true, true, true>(ring, g, S, E);
    } SEAM(11);
    TP_A(12); if (IN(12)) { for (int rep = 0; rep < REP(12); ++rep) p12_final(F); } TP_B(12);
#if TPROBE >= 0
    { const unsigned long long tend = __builtin_amdgcn_s_memrealtime() + 4ull * (tpB - tpA); while (__builtin_amdgcn_s_memrealtime() < tend) __builtin_amdgcn_s_sleep(8); }
#endif
#undef IN
#undef SEAM
}

extern "C" void kernel_launch(void* const* d_in, const int* in_sizes, int n_in, void* d_out, int out_size, void* d_ws, size_t ws_size, hipStream_t stream) {
    static int grid = 0;
    if (grid == 0) {
        if (n_in != 30 || out_size != T * D || ws_size < WS_END) { fprintf(stderr, "kernel_launch: unexpected problem (n_in %d, out %d, ws %zu)\n", n_in, out_size, ws_size); grid = -1; return; }
        int dev = 0, cus = 0, per_cu = 0;
        if (hipGetDevice(&dev) != hipSuccess || hipDeviceGetAttribute(&cus, hipDeviceAttributeMultiprocessorCount, dev) != hipSuccess) { grid = -1; return; }
        if (hipFuncSetAttribute((const void*)mk_fwd, hipFuncAttributeMaxDynamicSharedMemorySize, LDS_BYTES) != hipSuccess) { fprintf(stderr, "kernel_launch: hipFuncSetAttribute failed\n"); grid = -1; return; }
        if (hipOccupancyMaxActiveBlocksPerMultiprocessor(&per_cu, (const void*)mk_fwd, NTHR, LDS_BYTES) != hipSuccess || per_cu < 1) fprintf(stderr, "kernel_launch: occupancy query says %d\n", per_cu);
        (void)hipGetLastError();
        grid = cus;
    }
    if (grid < 0) return;
    if (hipMemsetAsync((char*)d_ws + WS_CTL, 0, CTL_ZERO_BYTES, stream) != hipSuccess) return;
    Args a{};
    for (int i = 0; i < 30; ++i) a.in[i] = (const float*)d_in[i];
    a.out = (float*)d_out; a.ws = (unsigned char*)d_ws;
    for (int li = 0; li < MK_N_LAUNCHES; ++li) {
        a.ph_lo = (MK_N_LAUNCHES == 1) ? 0 : li; a.ph_hi = (MK_N_LAUNCHES == 1) ? NPH : li + 1;
        hipLaunchKernelGGL(mk_fwd, dim3(grid), dim3(NTHR), LDS_BYTES, stream, a);
        const hipError_t le = hipPeekAtLastError();
        if (le != hipSuccess) { fprintf(stderr, "kernel_launch: launch %d failed: %s\n", li, hipGetErrorName(le)); break; }
    }
}
```

```cpp
#include <hip/hip_runtime.h>
#include <cstdio>
#include <cstdint>

#define MK_N_LAUNCHES 1
#define PROBE_PHASE -1
namespace pg8 {
#define PG8_LAS __attribute__((address_space(3)))
typedef unsigned short bf16_t;
typedef short bf16x8 __attribute__((ext_vector_type(8)));
typedef float f32x4 __attribute__((ext_vector_type(4)));
typedef unsigned u32x4 __attribute__((ext_vector_type(4)));
constexpr int BM = 256, BK = 64, HALF = 128, HTB = HALF * BK * 2  , STAGE_BYTES = 8 * HTB, NXCD = 8, WGM = 8;

__host__ __device__ __forceinline__ int lds_byte(int r, int c) { const int st = (r >> 4) * 2 + (c >> 5), rr = r & 15, cc = c & 31, ob = rr * 64 + cc * 2; return st * 1024 + (ob ^ (((ob >> 9) & 1) << 5)); }
__host__ __device__ __forceinline__ void stage_rc(int b, int& R, int& C) { const int st = b / 1024, sb = b % 1024, swz = sb ^ (((sb >> 9) & 1) << 5); R = (st >> 1) * 16 + swz / 64; C = (st & 1) * 32 + (swz % 64) / 2; }
__host__ __device__ __forceinline__ int perm32(int rho) { const int n = rho >> 4, i = rho & 15; return 8 * (i >> 2) + 4 * n + (i & 3); }

struct Unit { int pm, pn, ord; };
struct Gemm { const bf16_t* A; const bf16_t* Bt; int M, N, K; };

struct StaticOrder {
    int nM, nN, nwg, G, c;
    __host__ __device__ void init(int M, int N, int G_, int c_) { nM = M / BM; nN = N / BM; nwg = nM * nN; G = G_; c = c_; }
    __host__ __device__ bool next(int i, Unit& u) const {
        const long L = (long)i * G + c; if (L >= nwg) return false;
        int wgid = (int)L; { const int q = nwg / NXCD, r = nwg % NXCD, xcd = wgid % NXCD, off = wgid / NXCD; wgid = (xcd < r ? xcd * (q + 1) : r * (q + 1) + (xcd - r) * q) + off; }
        const int nig = WGM * nN, gid = wgid / nig, fm = gid * WGM, gsz = (nM - fm) < WGM ? (nM - fm) : WGM;
        u.pm = fm + ((wgid % nig) % gsz); u.pn = (wgid % nig) / gsz; u.ord = i; return true;
    }
    __device__ __forceinline__ void a_ready(const Unit&) const {}
    static constexpr bool GATHER = false;
    __device__ __forceinline__ void fill_all() const {}
    __device__ __forceinline__ unsigned row_off(int, int) const { return 0u; }
    __device__ __forceinline__ void done(const Unit&) const {}
    __device__ __forceinline__ size_t a_off(const Unit& u, size_t tstep) const { return (size_t)u.pm * tstep; }
    __device__ __forceinline__ size_t b_off(const Unit& u, size_t tstep) const { return (size_t)u.pn * tstep; }
};
__device__ __forceinline__ unsigned cvt_pk_bf16(float lo, float hi) { unsigned r; asm volatile("v_cvt_pk_bf16_f32 %0, %1, %2" : "=v"(r) : "v"(lo), "v"(hi)); return r; }
typedef int v8i32 __attribute__((ext_vector_type(8)));
typedef int v4i32 __attribute__((ext_vector_type(4)));
__device__ __forceinline__ v8i32 cat8(bf16x8 lo, bf16x8 hi) { const v4i32 a = __builtin_bit_cast(v4i32, lo), b = __builtin_bit_cast(v4i32, hi); return __builtin_shufflevector(a, b, 0, 1, 2, 3, 4, 5, 6, 7); }
template <class Epi, class Sched, bool ALIGN_EPI = false, bool SP2 = false, bool FP8 = false, bool I8 = false>
__device__ __forceinline__ void gemm_phase(PG8_LAS unsigned char* lds, const Gemm g, const Sched& S, const Epi& E) {
    const int tid = threadIdx.x, wid = __builtin_amdgcn_readfirstlane(tid >> 6), lane = tid & 63, wr = wid >> 2, wc = wid & 3, fr = lane & 15, fq = lane >> 4;
    const int K = g.K, nt = K / BK;
    unsigned voffA[2], voffB[2];
#pragma unroll
    for (int i = 0; i < 2; ++i) { int R, C; stage_rc(tid * 16 + i * 8192, R, C); const int Rb = Epi::PERM ? ((R & ~31) + perm32(R & 31)) : R;
        voffA[i] = (unsigned)(R * K + C) * 2u; voffB[i] = (unsigned)(Rb * K + C) * 2u; }
    unsigned voffA1[2]; int rselA[2]; unsigned cselA[2];
#pragma unroll
    for (int i = 0; i < 2; ++i) { int R, C; stage_rc(tid * 16 + i * 8192, R, C); rselA[i] = R; cselA[i] = (unsigned)C * 2u; voffA1[i] = voffA[i]; }
    const size_t kstep = (size_t)(BK * 2);
    const size_t hstep = (size_t)HALF * K * 2;
    const size_t tstep = 2 * hstep;
    const size_t hstepA = Sched::GATHER ? (size_t)0 : hstep;
#define PG8_ROWS(_u) do { _Pragma("unroll") for (int _i = 0; _i < 2; ++_i) { voffA[_i] = S.row_off((_u), rselA[_i]) + cselA[_i]; voffA1[_i] = S.row_off((_u), HALF + rselA[_i]) + cselA[_i]; } } while (0)
    const unsigned ldsw = (unsigned)wid * 1024u;
    const int aoff = lds_byte(wr * 64 + fr, fq * 8), boff = lds_byte(wc * 32 + fr, fq * 8);
#define PG8_SA(b, h) (((b) * 2 + (h)) * HTB)
#define PG8_SB(b, h) ((4 + (b) * 2 + (h)) * HTB)
#define PG8_STAGE(bufoff, gbase, voff) do { _Pragma("unroll") for (int _i = 0; _i < 2; ++_i) \
        __builtin_amdgcn_global_load_lds((const unsigned*)((const char*)(gbase) + (voff)[_i]), (PG8_LAS unsigned*)(lds + (bufoff) + ldsw + _i * 8192), 16, 0, 0); } while (0)
#define PG8_LDA(dst, b, h) do { if constexpr (FP8) { _Pragma("unroll") for (int m = 0; m < 4; ++m) dst##8[m] = cat8(*(const PG8_LAS bf16x8*)(lds + PG8_SA(b, h) + aoff + m * 2048), *(const PG8_LAS bf16x8*)(lds + PG8_SA(b, h) + aoff + m * 2048 + 1024)); } \
        else { _Pragma("unroll") for (int m = 0; m < 4; ++m) _Pragma("unroll") for (int k = 0; k < 2; ++k) dst[m][k] = *(const PG8_LAS bf16x8*)(lds + PG8_SA(b, h) + aoff + m * 2048 + k * 1024); } } while (0)
#define PG8_LDB(dst, b, h) do { if constexpr (FP8) { _Pragma("unroll") for (int n = 0; n < 2; ++n) dst##8[n] = cat8(*(const PG8_LAS bf16x8*)(lds + PG8_SB(b, h) + boff + n * 2048), *(const PG8_LAS bf16x8*)(lds + PG8_SB(b, h) + boff + n * 2048 + 1024)); } \
        else { _Pragma("unroll") for (int n = 0; n < 2; ++n) _Pragma("unroll") for (int k = 0; k < 2; ++k) dst[n][k] = *(const PG8_LAS bf16x8*)(lds + PG8_SB(b, h) + boff + n * 2048 + k * 1024); } } while (0)
#define PG8_MMA(ai, bj, At, Bt) do { __builtin_amdgcn_s_setprio(1); if constexpr (FP8) { _Pragma("unroll") for (int m = 0; m < 4; ++m) _Pragma("unroll") for (int n = 0; n < 2; ++n) \
        asm volatile("v_mfma_scale_f32_16x16x128_f8f6f4 %0, %1, %2, %0, %3, %3 op_sel_hi:[0,0,0]" : "+v"(acc[ai][bj][m][n]) : "v"(Bt##8[n]), "v"(At##8[m]), "v"(f8scale)); } else { \
        _Pragma("unroll") for (int m = 0; m < 4; ++m) _Pragma("unroll") for (int n = 0; n < 2; ++n) _Pragma("unroll") for (int k = 0; k < 2; ++k) { \
        if constexpr (I8) acc[ai][bj][m][n] = __builtin_bit_cast(f32x4, __builtin_amdgcn_mfma_i32_16x16x64_i8(__builtin_bit_cast(v4i32, Bt[n][k]), __builtin_bit_cast(v4i32, At[m][k]), __builtin_bit_cast(v4i32, acc[ai][bj][m][n]), 0, 0, 0)); \
        else acc[ai][bj][m][n] = __builtin_amdgcn_mfma_f32_16x16x32_bf16(Bt[n][k], At[m][k], acc[ai][bj][m][n], 0, 0, 0); } } __builtin_amdgcn_s_setprio(0); } while (0)
#define PG8_WAIT_V(n) asm volatile("s_waitcnt vmcnt(" #n ")" ::: "memory")
#define PG8_WAIT_L(n) asm volatile("s_waitcnt lgkmcnt(" #n ")" ::: "memory")
#define PG8_BAR __builtin_amdgcn_s_barrier()
#define PG8_SCHED __builtin_amdgcn_sched_barrier(0)
    Unit cur, nxt; int ui = 0;
    if (!S.next(0, cur)) return;
    f32x4 acc[2][2][4][2];
#pragma unroll
    for (int a = 0; a < 2; ++a)
#pragma unroll
        for (int b = 0; b < 2; ++b)
#pragma unroll
            for (int m = 0; m < 4; ++m)
#pragma unroll
                for (int n = 0; n < 2; ++n) acc[a][b][m][n] = (f32x4){0.f, 0.f, 0.f, 0.f};
    const int f8scale = 0x7f7f7f7f;
    bf16x8 At[4][2], B0[2][2], B1[2][2]; v8i32 At8[4], B08[2], B18[2];
    const char* cA = (const char*)g.A + S.a_off(cur, tstep); const char* cB = (const char*)g.Bt + S.b_off(cur, tstep);
    S.a_ready(cur);
    if constexpr (Sched::GATHER) { S.fill_all(); asm volatile("s_waitcnt vmcnt(0) lgkmcnt(0)" ::: "memory"); __builtin_amdgcn_s_barrier(); asm volatile("" ::: "memory"); PG8_ROWS(0); }
    if constexpr (SP2) {
        PG8_STAGE(PG8_SB(0, 0), cB, voffB); PG8_STAGE(PG8_SB(0, 1), cB + hstep, voffB); PG8_STAGE(PG8_SA(0, 0), cA, voffA); PG8_STAGE(PG8_SA(0, 1), cA + hstepA, voffA1);
        if (wr == 1) PG8_BAR;
        PG8_WAIT_V(2); PG8_BAR;
        PG8_STAGE(PG8_SB(1, 0), cB + kstep, voffB); PG8_STAGE(PG8_SA(1, 0), cA + kstep, voffA); PG8_STAGE(PG8_SB(1, 1), cB + hstep + kstep, voffB);
        PG8_WAIT_V(6); PG8_BAR;
    } else {
        PG8_STAGE(PG8_SB(0, 0), cB, voffB); PG8_STAGE(PG8_SA(0, 0), cA, voffA); PG8_STAGE(PG8_SB(0, 1), cB + hstep, voffB); PG8_STAGE(PG8_SA(0, 1), cA + hstepA, voffA1);
        if (wr == 1) PG8_BAR;
        PG8_WAIT_V(4); PG8_BAR;
        PG8_STAGE(PG8_SB(1, 0), cB + kstep, voffB); PG8_STAGE(PG8_SA(1, 0), cA + kstep, voffA); PG8_STAGE(PG8_SB(1, 1), cB + hstep + kstep, voffB);
        PG8_WAIT_V(6); PG8_BAR;
    }
    for (;;) {
        const bool has_next = S.next(ui + 1, nxt);
        const char* nA = has_next ? (const char*)g.A + S.a_off(nxt, tstep) : cA; const char* nB = has_next ? (const char*)g.Bt + S.b_off(nxt, tstep) : cB;
        for (int t = 0; t < nt; t += 2) {
            const bool last = (t == nt - 2);
            const char* a1 = cA + (size_t)(t + 1) * kstep;
            const char* a2 = last ? nA : cA + (size_t)(t + 2) * kstep; const char* b2 = last ? nB : cB + (size_t)(t + 2) * kstep;
            const char* a3 = a2 + kstep; const char* b3 = b2 + kstep;
            if (last && has_next) S.a_ready(nxt);
            if constexpr (SP2) {
            PG8_LDB(B0, 0, 0); PG8_LDB(B1, 0, 1); PG8_SCHED; PG8_LDA(At, 0, 0); PG8_STAGE(PG8_SA(1, 1), a1 + hstepA, voffA1);
            PG8_WAIT_V(8); PG8_WAIT_L(0); PG8_BAR; PG8_MMA(0, 0, At, B0); PG8_MMA(0, 1, At, B1); PG8_BAR; PG8_SCHED;
            if constexpr (Sched::GATHER) { if (last && has_next) PG8_ROWS(ui + 1); }
            PG8_LDA(At, 0, 1); PG8_STAGE(PG8_SB(0, 0), b2, voffB); PG8_STAGE(PG8_SB(0, 1), b2 + hstep, voffB); PG8_STAGE(PG8_SA(0, 0), a2, voffA);
            PG8_WAIT_V(8); PG8_WAIT_L(0); PG8_BAR; PG8_MMA(1, 0, At, B0); PG8_MMA(1, 1, At, B1); PG8_BAR; PG8_SCHED;
            PG8_LDB(B0, 1, 0); PG8_LDB(B1, 1, 1); PG8_SCHED; PG8_LDA(At, 1, 0); PG8_STAGE(PG8_SA(0, 1), a2 + hstepA, voffA1);
            PG8_WAIT_V(8); PG8_WAIT_L(0); PG8_BAR; PG8_MMA(0, 0, At, B0); PG8_MMA(0, 1, At, B1); PG8_BAR; PG8_SCHED;
            PG8_LDA(At, 1, 1); PG8_STAGE(PG8_SB(1, 0), b3, voffB); PG8_STAGE(PG8_SB(1, 1), b3 + hstep, voffB); PG8_STAGE(PG8_SA(1, 0), a3, voffA);
            PG8_WAIT_V(8); PG8_WAIT_L(0); PG8_BAR; PG8_MMA(1, 0, At, B0); PG8_MMA(1, 1, At, B1); PG8_BAR; PG8_SCHED;
            } else {
            PG8_LDB(B0, 0, 0); PG8_SCHED; PG8_LDA(At, 0, 0); PG8_STAGE(PG8_SA(1, 1), a1 + hstepA, voffA1);
            PG8_WAIT_L(8); PG8_BAR; PG8_WAIT_L(0); PG8_MMA(0, 0, At, B0); PG8_BAR; PG8_SCHED;
            PG8_LDB(B1, 0, 1); PG8_STAGE(PG8_SB(0, 0), b2, voffB);
            PG8_BAR; PG8_WAIT_L(0); PG8_MMA(0, 1, At, B1); PG8_BAR;
            PG8_LDA(At, 0, 1); PG8_STAGE(PG8_SA(0, 0), a2, voffA);
            PG8_BAR; PG8_WAIT_L(0); PG8_MMA(1, 0, At, B0); PG8_BAR; PG8_SCHED;
            PG8_STAGE(PG8_SB(0, 1), b2 + hstep, voffB);
            PG8_WAIT_V(6); PG8_BAR; PG8_MMA(1, 1, At, B1); PG8_BAR;
            PG8_LDB(B0, 1, 0); PG8_SCHED; PG8_LDA(At, 1, 0); PG8_STAGE(PG8_SA(0, 1), a2 + hstepA, voffA1);
            PG8_WAIT_L(8); PG8_BAR; PG8_WAIT_L(0); PG8_MMA(0, 0, At, B0); PG8_BAR; PG8_SCHED;
            PG8_LDB(B1, 1, 1); PG8_STAGE(PG8_SB(1, 0), b3, voffB);
            PG8_BAR; PG8_WAIT_L(0); PG8_MMA(0, 1, At, B1); PG8_BAR;
            PG8_LDA(At, 1, 1); PG8_STAGE(PG8_SA(1, 0), a3, voffA);
            PG8_BAR; PG8_WAIT_L(0); PG8_MMA(1, 0, At, B0); PG8_BAR; PG8_SCHED;
            PG8_STAGE(PG8_SB(1, 1), b3 + hstep, voffB);
            PG8_WAIT_V(6); PG8_BAR; PG8_MMA(1, 1, At, B1); PG8_BAR;
            }
        }
        if constexpr (ALIGN_EPI) { if (wr == 0) PG8_BAR; }
        if constexpr (FP8) { asm volatile("s_nop 15\n\ts_nop 15" ::: "memory"); }
        if constexpr (!Epi::AFTER_DRAIN) { E(acc, cur, wr, wc, fr, fq); S.done(cur); }
        if (!has_next) break;
#pragma unroll
        for (int a = 0; a < 2; ++a)
#pragma unroll
            for (int b = 0; b < 2; ++b)
#pragma unroll
                for (int m = 0; m < 4; ++m)
#pragma unroll
                    for (int n = 0; n < 2; ++n) acc[a][b][m][n] = (f32x4){0.f, 0.f, 0.f, 0.f};
        cur = nxt; cA = nA; cB = nB; ++ui;
        if constexpr (ALIGN_EPI) { if (wr == 1) PG8_BAR; }
    }
    PG8_WAIT_V(0);
    if constexpr (!ALIGN_EPI) { if (wr == 0) PG8_BAR; }
    PG8_BAR;
    if constexpr (Epi::AFTER_DRAIN) { E.fused(acc, cur, wr, wc, fr, fq, lds, wid, lane); S.done(cur); }
#undef PG8_ROWS
#undef PG8_SA
#undef PG8_SB
#undef PG8_STAGE
#undef PG8_LDA
#undef PG8_LDB
#undef PG8_MMA
#undef PG8_WAIT_V
#undef PG8_WAIT_L
#undef PG8_BAR
#undef PG8_SCHED
}
}

#ifndef MK_N_LAUNCHES
#define MK_N_LAUNCHES 1
#endif
#define GAS __attribute__((address_space(1)))
#define LAS __attribute__((address_space(3)))
typedef unsigned short bf16;
typedef unsigned v4u __attribute__((ext_vector_type(4)));
typedef unsigned v2u __attribute__((ext_vector_type(2)));
typedef float f32x4 __attribute__((ext_vector_type(4)));
typedef float f32x2 __attribute__((ext_vector_type(2)));

constexpr int NWAVES = 8, NTHR = 512;
constexpr int NPH = 13;
constexpr int D = 2048, BATCH = 8, SEQ = 2048, T = BATCH * SEQ;
constexpr int NIN = 10696, NINP = 10752;
constexpr int MLO = 3520, GTO = 6600;
constexpr int RH = 16, RD = 1024;
constexpr int MH = 4;
constexpr int NE = 32, FF = 2048, ECAP = 16384, PMAX = 65536 + NE * 256, MTMAX = PMAX / 256;
constexpr float NORM_EPS = 1e-6f, GN_EPS = 64e-5f;
constexpr size_t MiB = 1u << 20;
constexpr size_t WS_CTL = 0, CTL_ZERO_BYTES = 1 * MiB;
constexpr size_t WS_WIN = 1 * MiB, WS_WA = 43 * MiB, WS_WB = 47 * MiB, WS_WO = 51 * MiB, WS_WL = 59 * MiB;
constexpr size_t WS_RLIST = 62 * MiB, WS_RW = 64 * MiB, WS_RWS = 2787 * MiB, WS_RA = 2787 * MiB + 512 * 1024;
constexpr size_t WS_WGU = 66 * MiB, WS_WDN = 578 * MiB, WS_HN = 834 * MiB, WS_P = 898 * MiB, WS_LIN = 1234 * MiB, WS_WAG = 1250 * MiB;
constexpr size_t WS_YRAW = 1442 * MiB, WS_HRAW = 1506 * MiB, WS_OA = 1570 * MiB, WS_OB = 1602 * MiB, WS_TMP = 1634 * MiB, WS_MRG = 1762 * MiB;
constexpr size_t WS_QKC = WS_TMP, WS_GLF = WS_TMP + 64 * MiB;
constexpr size_t WS_X1 = 1826 * MiB, WS_XB = 1954 * MiB, WS_ACT = 2242 * MiB, WS_YS = 2530 * MiB, WS_END = 2788 * MiB;
constexpr int CW_BAR = 4096;
constexpr int CW_CVNEXT = 8192, CW_P1DONE = 8192 + 64, CW_CVNEXT2 = 8192 + 192;
constexpr int CV_W0 = 6, CV1_W0 = 4;
constexpr int NCV = 64;
constexpr int CW_COLMAX = 32768;
constexpr int CW_CNT = 16384;
constexpr int RING_BYTES = 131072, MISC_OFF = RING_BYTES, LDS_BYTES = RING_BYTES + 8192 + 20 * 1024;
constexpr int MI_TILE_E = 64, MI_TILE_I0 = 64 + 320, MI_CNT = 64 + 640, MI_POFF = MI_CNT + 32, MI_CST = MI_POFF + 32, MI_MT = MI_CST + 40, MI_ROWOFF = 2048;

#define LDS_WAIT() asm volatile("s_waitcnt lgkmcnt(0)" ::: "memory")
#define VM_WAIT() asm volatile("s_waitcnt vmcnt(0)" ::: "memory")
__device__ __forceinline__ float bf2f(bf16 v) { return __uint_as_float(((unsigned)v) << 16); }
__device__ __forceinline__ unsigned f2bf(float f) { unsigned u = __float_as_uint(f); return (u + 0x7fffu + ((u >> 16) & 1u)) >> 16; }
typedef __bf16 bf16x2_t __attribute__((ext_vector_type(2)));
__device__ __forceinline__ unsigned pk2(float lo, float hi) { const f32x2 v = {lo, hi}; const bf16x2_t b = __builtin_convertvector(v, bf16x2_t); return __builtin_bit_cast(unsigned, b); }
__device__ __forceinline__ unsigned pk4f8(float a, float b, float c, float d) { int r = 0; r = __builtin_amdgcn_cvt_pk_fp8_f32(a, b, r, false); r = __builtin_amdgcn_cvt_pk_fp8_f32(c, d, r, true); return (unsigned)r; }
constexpr float F8_SX = 8.f, F8_SW = 256.f, F8_SA = 4.f, F8_SY = 16.f;
__device__ __forceinline__ unsigned pk4i8(float a, float b, float c, float d) {
    const int ia = (int)__builtin_rintf(a), ib = (int)__builtin_rintf(b), ic = (int)__builtin_rintf(c), id = (int)__builtin_rintf(d);
    return (unsigned)(ia & 255) | ((unsigned)(ib & 255) << 8) | ((unsigned)(ic & 255) << 16) | ((unsigned)id << 24); }
__device__ __forceinline__ float wave_max(float v) {
#pragma unroll
    for (int o = 1; o < 64; o <<= 1) v = fmaxf(v, __shfl_xor(v, o));
    return v;
}
__device__ __forceinline__ float wave_sum(float v) {
#pragma unroll
    for (int o = 1; o < 64; o <<= 1) v += __shfl_xor(v, o);
    return v;
}
#define UNP4(v) ((f32x4){__uint_as_float((v).x << 16), __uint_as_float((v).x & 0xffff0000u), __uint_as_float((v).y << 16), __uint_as_float((v).y & 0xffff0000u)})
__device__ __forceinline__ float sigm(float x) { return __builtin_amdgcn_rcpf(1.f + __expf(-x)); }
template <int CTRL> __device__ __forceinline__ float dppf(float x) { return __builtin_bit_cast(float, __builtin_amdgcn_mov_dpp(__builtin_bit_cast(int, x), CTRL, 0xf, 0xf, true)); }
__device__ __forceinline__ float allreduce16(float x) { x += dppf<0x128>(x); x += dppf<0x124>(x); x += dppf<0x4E>(x); x += dppf<0xB1>(x); return x; }

#define XB_TMO      128
#define XB_XCNT(j)  (256  + 64 * (j))
#define XB_XSUB(j)  (1280 + 64 * (j))
#define XB_XGEN(j)  (2304 + 64 * (j))
#define XB_TOP      3328
#define XB_TOPGEN   3392
#define XCD_BAR_WORDS 3456
#define XB_SPIN_CAP (1u << 18)
__device__ __forceinline__ unsigned xb_ld(unsigned* p)              { return __hip_atomic_load(p, __ATOMIC_RELAXED, __HIP_MEMORY_SCOPE_AGENT); }
__device__ __forceinline__ unsigned xb_add(unsigned* p, unsigned v) { return __hip_atomic_fetch_add(p, v, __ATOMIC_RELAXED, __HIP_MEMORY_SCOPE_AGENT); }
__device__ __forceinline__ unsigned xb_xcc_id() { return (unsigned)__builtin_amdgcn_s_getreg((3 << 11) | 20) & 0xFu; }
#define XB_SPIN(cond, bar) do { unsigned _sp = 0; while (cond) { __builtin_amdgcn_s_sleep(1); \
    if ((++_sp & 255u) == 0u) { if (xb_ld(&(bar)[XB_TMO])) break; if (_sp > XB_SPIN_CAP) { atomicAdd(&(bar)[XB_TMO], 1u); break; } } } } while (0)
struct XcdBarrier { unsigned* bar; unsigned x; volatile LAS unsigned* st; };
__device__ __forceinline__ XcdBarrier xcd_barrier_post(unsigned* bar, volatile LAS unsigned* st) {
    XcdBarrier b; b.bar = bar; b.x = xb_xcc_id(); b.st = st;
    if (threadIdx.x == 0) (void)xb_add(&bar[XB_XCNT(b.x)], 1u);
    return b;
}
__device__ __forceinline__ void xcd_barrier_complete(unsigned* bar, unsigned x, unsigned& nloc, unsigned& nx) {
    const unsigned G = gridDim.x * gridDim.y * gridDim.z;
    unsigned sum, cnt, mine, sp = 0u;
    for (;;) {
        sum = 0u; cnt = 0u; mine = 0u;
#pragma unroll
        for (unsigned j = 0; j < 16; ++j) { const unsigned c = xb_ld(&bar[XB_XCNT(j)]); sum += c; cnt += (c > 0u) ? 1u : 0u; mine = (j == x) ? c : mine; }
        if (sum == G) break;
        __builtin_amdgcn_s_sleep(1);
        if ((++sp & 255u) == 0u) { if (xb_ld(&bar[XB_TMO])) break; if (sp > XB_SPIN_CAP) { atomicAdd(&bar[XB_TMO], 1u); break; } }
    }
    nloc = mine > 0u ? mine : 1u; nx = cnt > 0u ? cnt : 1u;
}
__device__ __forceinline__ void xcd_barrier(const XcdBarrier& b) {
    asm volatile("s_waitcnt vmcnt(0)" ::: "memory");
    __syncthreads();
    if (threadIdx.x == 0) {
        unsigned* bar = b.bar;
        __builtin_amdgcn_s_waitcnt(0);
        unsigned nloc = b.st[0], nx = b.st[1];
        if (nloc == 0u) { xcd_barrier_complete(bar, b.x, nloc, nx); b.st[0] = nloc; b.st[1] = nx; }
        const unsigned old = xb_add(&bar[XB_XSUB(b.x)], 1u);
        const unsigned gen = old / nloc;
        if (old + 1u == (gen + 1u) * nloc) {
            __builtin_amdgcn_fence(__ATOMIC_RELEASE, "agent");
            asm volatile("s_waitcnt vmcnt(0)" ::: "memory");
            const unsigned og = xb_add(&bar[XB_TOP], 1u);
            const unsigned tg = og / nx;
            if (og + 1u == (tg + 1u) * nx) xb_add(&bar[XB_TOPGEN], 1u);
            else XB_SPIN(xb_ld(&bar[XB_TOPGEN]) == tg, bar);
            __builtin_amdgcn_fence(__ATOMIC_ACQUIRE, "agent");
            xb_add(&bar[XB_XGEN(b.x)], 1u);
            asm volatile("s_waitcnt vmcnt(0)" ::: "memory");
        } else {
            XB_SPIN(xb_ld(&bar[XB_XGEN(b.x)]) == gen, bar);
            __builtin_amdgcn_fence(__ATOMIC_ACQUIRE, "agent");
            asm volatile("s_waitcnt vmcnt(0)" ::: "memory");
        }
    }
    __syncthreads();
}

struct Args { const float* in[30]; float* out; unsigned char* ws; int ph_lo, ph_hi; };
enum { I_X = 0, I_N1W, I_WIN, I_BGATE, I_MU, I_W0, I_WUP, I_A0, I_AUP, I_GUP, I_KK, I_KA, I_RK, I_LNW, I_LNB, I_CONVW, I_IB, I_FB, I_MNW, I_WBA, I_WBB, I_WOUT, I_N2W, I_RTW, I_RTB, I_WGU, I_BGU, I_WDN, I_BDN, I_FNW };

struct Frame {
    LAS unsigned char* lds; volatile LAS unsigned* MISC; unsigned* ctl;
    int tid, lane, wave, G, bid;
    const float* const* in; float* out; unsigned char* ws;
};

using pg8::Unit; using pg8::HALF; using pg8::BM;
struct EpiBf16Plain {
    static constexpr bool PERM = true, AFTER_DRAIN = false;
    bf16* O; int ldc;
    __device__ __forceinline__ void operator()(const f32x4 (&acc)[2][2][4][2], const Unit& u, int wr, int wc, int fr, int fq) const {
        const int row0 = u.pm * BM + wr * 64 + fr, col0 = u.pn * BM + wc * 32 + 8 * fq;
#pragma unroll
        for (int ai = 0; ai < 2; ++ai)
#pragma unroll
            for (int m = 0; m < 4; ++m) { bf16* rowp = O + (size_t)(row0 + ai * HALF + m * 16) * ldc + col0;
#pragma unroll
                for (int bj = 0; bj < 2; ++bj) { const f32x4 v0 = acc[ai][bj][m][0], v1 = acc[ai][bj][m][1];
                    v4u w; w.x = pg8::cvt_pk_bf16(v0[0], v0[1]); w.y = pg8::cvt_pk_bf16(v0[2], v0[3]); w.z = pg8::cvt_pk_bf16(v1[0], v1[1]); w.w = pg8::cvt_pk_bf16(v1[2], v1[3]);
                    *(v4u*)(rowp + bj * HALF) = w; } }
    }
};
struct EpiP1I8 {
    static constexpr bool PERM = true, AFTER_DRAIN = false;
    bf16* O; int ldc; const float* ra; const unsigned* colmax;
    __device__ __forceinline__ void operator()(const f32x4 (&acc)[2][2][4][2], const Unit& u, int wr, int wc, int fr, int fq) const {
        const int row0 = u.pm * BM + wr * 64 + fr, col0 = u.pn * BM + wc * 32 + 8 * fq;
        f32x4 cb[2][2];
#pragma unroll
        for (int bj = 0; bj < 2; ++bj)
#pragma unroll
            for (int n = 0; n < 2; ++n) { const v4u cm = *(const v4u*)(colmax + col0 + bj * HALF + 4 * n);
                cb[bj][n] = (f32x4){__uint_as_float(cm.x), __uint_as_float(cm.y), __uint_as_float(cm.z), __uint_as_float(cm.w)} * (1.f / 127.f); }
#pragma unroll
        for (int ai = 0; ai < 2; ++ai)
#pragma unroll
            for (int m = 0; m < 4; ++m) { const int r = row0 + ai * HALF + m * 16; const float rs = ra[r]; bf16* rowp = O + (size_t)r * ldc + col0;
#pragma unroll
                for (int bj = 0; bj < 2; ++bj) { const v4u i0 = __builtin_bit_cast(v4u, acc[ai][bj][m][0]), i1 = __builtin_bit_cast(v4u, acc[ai][bj][m][1]);
                    const f32x4 v0 = (f32x4){(float)(int)i0.x, (float)(int)i0.y, (float)(int)i0.z, (float)(int)i0.w} * cb[bj][0] * rs, v1 = (f32x4){(float)(int)i1.x, (float)(int)i1.y, (float)(int)i1.z, (float)(int)i1.w} * cb[bj][1] * rs;
                    v4u w; w.x = pk2(v0[0], v0[1]); w.y = pk2(v0[2], v0[3]); w.z = pk2(v1[0], v1[1]); w.w = pk2(v1[2], v1[3]);
                    *(v4u*)(rowp + bj * HALF) = w; } }
    }
};
struct EpiLora {
    static constexpr bool PERM = false, AFTER_DRAIN = false;
    float* WLD; bf16* AG; const float* w0; const float* a0;
    __device__ __forceinline__ void operator()(const f32x4 (&acc)[2][2][4][2], const Unit& u, int wr, int wc, int fr, int fq) const {
        const int row0 = u.pm * BM + wr * 64 + fr, col0 = u.pn * BM + wc * 32 + 4 * fq, seg = u.pn >> 2;
        f32x4 bv[2][2];
#pragma unroll
        for (int bj = 0; bj < 2; ++bj)
#pragma unroll
            for (int n = 0; n < 2; ++n) { const int c = col0 + bj * HALF + n * 16;
                bv[bj][n] = seg == 0 ? *(const f32x4*)(w0 + c) : (seg == 1 ? *(const f32x4*)(a0 + (c - 1024)) : (f32x4){0.f, 0.f, 0.f, 0.f}); }
#pragma unroll
        for (int ai = 0; ai < 2; ++ai)
#pragma unroll
            for (int m = 0; m < 4; ++m) { const size_t r = (size_t)(row0 + ai * HALF + m * 16);
#pragma unroll
                for (int bj = 0; bj < 2; ++bj)
#pragma unroll
                    for (int n = 0; n < 2; ++n) { f32x4 v = acc[ai][bj][m][n] + bv[bj][n]; const int c = col0 + bj * HALF + n * 16;
                        if (seg == 0) {
#pragma unroll
                            for (int j = 0; j < 4; ++j) v[j] = -0.6065306597126334f * sigm(v[j]);
                            *(f32x4*)(WLD + r * RD + c) = v; }
                        else { if (seg == 1) {
#pragma unroll
                                for (int j = 0; j < 4; ++j) v[j] = sigm(v[j]); }
                            v2u o; o.x = pk2(v[0], v[1]); o.y = pk2(v[2], v[3]); *(v2u*)(AG + r * D + (c - 1024)) = o; } } }
    }
};
struct EpiGateA {
    static constexpr bool PERM = true, AFTER_DRAIN = false;
    bf16* TMP; const bf16* P; const float* bg;
    __device__ __forceinline__ void operator()(const f32x4 (&acc)[2][2][4][2], const Unit& u, int wr, int wc, int fr, int fq) const {
        const int row0 = u.pm * BM + wr * 64 + fr, col0 = u.pn * BM + wc * 32 + 8 * fq;
#pragma unroll
        for (int ai = 0; ai < 2; ++ai)
#pragma unroll
            for (int m = 0; m < 4; ++m) { const size_t r = (size_t)(row0 + ai * HALF + m * 16);
#pragma unroll
                for (int bj = 0; bj < 2; ++bj) { const int c = col0 + bj * HALF;
                    const v4u pg = *(const v4u*)(P + r * NINP + GTO + c); const f32x4 b0 = *(const f32x4*)(bg + c), b1 = *(const f32x4*)(bg + c + 4);
                    f32x4 g0, g1;
                    g0[0] = sigm(__uint_as_float(pg.x << 16) + b0[0]); g0[1] = sigm(__uint_as_float(pg.x & 0xffff0000u) + b0[1]);
                    g0[2] = sigm(__uint_as_float(pg.y << 16) + b0[2]); g0[3] = sigm(__uint_as_float(pg.y & 0xffff0000u) + b0[3]);
                    g1[0] = sigm(__uint_as_float(pg.z << 16) + b1[0]); g1[1] = sigm(__uint_as_float(pg.z & 0xffff0000u) + b1[1]);
                    g1[2] = sigm(__uint_as_float(pg.w << 16) + b1[2]); g1[3] = sigm(__uint_as_float(pg.w & 0xffff0000u) + b1[3]);
                    const f32x4 t0 = g0 * acc[ai][bj][m][0], t1 = g1 * acc[ai][bj][m][1]; v4u tw; tw.x = pk2(t0[0], t0[1]); tw.y = pk2(t0[2], t0[3]); tw.z = pk2(t1[0], t1[1]); tw.w = pk2(t1[2], t1[3]);
                    *(v4u*)(TMP + r * D + c) = tw; } }
    }
};
struct EpiGateB {
    static constexpr bool PERM = true, AFTER_DRAIN = false;
    const bf16* TMP; bf16* MRG; const bf16* P; const float* bg;
    __device__ __forceinline__ void operator()(const f32x4 (&acc)[2][2][4][2], const Unit& u, int wr, int wc, int fr, int fq) const {
        const int row0 = u.pm * BM + wr * 64 + fr, col0 = u.pn * BM + wc * 32 + 8 * fq;
#pragma unroll
        for (int ai = 0; ai < 2; ++ai)
#pragma unroll
            for (int m = 0; m < 4; ++m) { const size_t r = (size_t)(row0 + ai * HALF + m * 16);
#pragma unroll
                for (int bj = 0; bj < 2; ++bj) { const int c = col0 + bj * HALF;
                    const v4u pg = *(const v4u*)(P + r * NINP + GTO + D + c); const f32x4 b0 = *(const f32x4*)(bg + D + c), b1 = *(const f32x4*)(bg + D + c + 4);
                    const v4u tw = *(const v4u*)(TMP + r * D + c); const f32x4 t0 = (f32x4){__uint_as_float(tw.x << 16), __uint_as_float(tw.x & 0xffff0000u), __uint_as_float(tw.y << 16), __uint_as_float(tw.y & 0xffff0000u)}, t1 = (f32x4){__uint_as_float(tw.z << 16), __uint_as_float(tw.z & 0xffff0000u), __uint_as_float(tw.w << 16), __uint_as_float(tw.w & 0xffff0000u)};
                    f32x4 g0, g1;
                    g0[0] = sigm(__uint_as_float(pg.x << 16) + b0[0]); g0[1] = sigm(__uint_as_float(pg.x & 0xffff0000u) + b0[1]);
                    g0[2] = sigm(__uint_as_float(pg.y << 16) + b0[2]); g0[3] = sigm(__uint_as_float(pg.y & 0xffff0000u) + b0[3]);
                    g1[0] = sigm(__uint_as_float(pg.z << 16) + b1[0]); g1[1] = sigm(__uint_as_float(pg.z & 0xffff0000u) + b1[1]);
                    g1[2] = sigm(__uint_as_float(pg.w << 16) + b1[2]); g1[3] = sigm(__uint_as_float(pg.w & 0xffff0000u) + b1[3]);
                    const f32x4 v0 = t0 + g0 * acc[ai][bj][m][0], v1 = t1 + g1 * acc[ai][bj][m][1];
                    v4u w; w.x = pg8::cvt_pk_bf16(v0[0], v0[1]); w.y = pg8::cvt_pk_bf16(v0[2], v0[3]); w.z = pg8::cvt_pk_bf16(v1[0], v1[1]); w.w = pg8::cvt_pk_bf16(v1[2], v1[3]);
                    *(v4u*)(MRG + r * D + c) = w; } }
    }
};
struct EpiResid {
    static constexpr bool PERM = true, AFTER_DRAIN = false;
    const float* X; bf16* O;
    __device__ __forceinline__ void operator()(const f32x4 (&acc)[2][2][4][2], const Unit& u, int wr, int wc, int fr, int fq) const {
        const int row0 = u.pm * BM + wr * 64 + fr, col0 = u.pn * BM + wc * 32 + 8 * fq;
#pragma unroll
        for (int ai = 0; ai < 2; ++ai)
#pragma unroll
            for (int m = 0; m < 4; ++m) { const size_t off = (size_t)(row0 + ai * HALF + m * 16) * D + col0;
#pragma unroll
                for (int bj = 0; bj < 2; ++bj) { const f32x4 v0 = *(const f32x4*)(X + off + bj * HALF) + acc[ai][bj][m][0], v1 = *(const f32x4*)(X + off + bj * HALF + 4) + acc[ai][bj][m][1];
                    v4u w; w.x = pk2(v0[0], v0[1]); w.y = pk2(v0[2], v0[3]); w.z = pk2(v1[0], v1[1]); w.w = pk2(v1[2], v1[3]);
                    *(v4u*)(O + off + bj * HALF) = w; } }
    }
};
struct MoeOrder : pg8::StaticOrder {
    const LAS int* tile_e; size_t estride;
    __device__ __forceinline__ size_t b_off(const Unit& u, size_t tstep) const { return (size_t)tile_e[u.pm] * estride + (size_t)u.pn * tstep; }
};
struct MoeGatherOrder : MoeOrder {
    static constexpr bool GATHER = true;
    const LAS int* tile_i0; const LAS int* cnt; const int* rlist; LAS unsigned* rowoff; unsigned rowbytes;
    __device__ __forceinline__ size_t a_off(const Unit&, size_t) const { return 0; }
    __device__ __forceinline__ void fill_all() const { const int tid = threadIdx.x, r = tid & 255;
        for (int u0 = tid >> 8; ; u0 += 6) { Unit ua, ub, uc; const bool va = next(u0, ua), vb = next(u0 + 2, ub), vc = next(u0 + 4, uc); if (!va) break;
            int ta = 0, tb = 0, tc = 0;
            { const int e = tile_e[ua.pm], i = tile_i0[ua.pm] + r; if (i < cnt[e]) ta = rlist[e * ECAP + i]; }
            if (vb) { const int e = tile_e[ub.pm], i = tile_i0[ub.pm] + r; if (i < cnt[e]) tb = rlist[e * ECAP + i]; }
            if (vc) { const int e = tile_e[uc.pm], i = tile_i0[uc.pm] + r; if (i < cnt[e]) tc = rlist[e * ECAP + i]; }
            rowoff[u0 * 256 + r] = (unsigned)(ta >> 2) * rowbytes; if (vb) rowoff[(u0 + 2) * 256 + r] = (unsigned)(tb >> 2) * rowbytes; if (vc) rowoff[(u0 + 4) * 256 + r] = (unsigned)(tc >> 2) * rowbytes; } }
    __device__ __forceinline__ unsigned row_off(int ui, int r) const { return rowoff[ui * 256 + r]; }
};
struct EpiSwiGLU {
    static constexpr bool PERM = true, AFTER_DRAIN = false;
    unsigned char* ACT; const float* bgu; const LAS int* tile_e;
    __device__ __forceinline__ void operator()(const f32x4 (&acc)[2][2][4][2], const Unit& u, int wr, int wc, int fr, int fq) const {
        const int row0 = u.pm * BM + wr * 64 + fr, colg = u.pn * 128 + wc * 32 + 8 * fq; const int e = tile_e[u.pm];
        const float* bp = bgu + (size_t)e * 4096 + colg;
        const f32x4 bg0 = *(const f32x4*)(bp), bg1 = *(const f32x4*)(bp + 4), bu0 = *(const f32x4*)(bp + 2048), bu1 = *(const f32x4*)(bp + 2052);
#pragma unroll
        for (int ai = 0; ai < 2; ++ai)
#pragma unroll
            for (int m = 0; m < 4; ++m) { const size_t r = (size_t)(row0 + ai * HALF + m * 16);
                constexpr float DS = 1.f / (F8_SX * F8_SW);
                const f32x4 ga = acc[ai][0][m][0] * DS + bg0, gb = acc[ai][0][m][1] * DS + bg1, ua = acc[ai][1][m][0] * DS + bu0, ub = acc[ai][1][m][1] * DS + bu1;
                float o[8];
#pragma unroll
                for (int j = 0; j < 4; ++j) { const float g = fminf(ga[j], 7.f), up = fminf(fmaxf(ua[j], -7.f), 7.f); o[j] = F8_SA * (up + 1.f) * g * sigm(1.702f * g);
                                              const float g2 = fminf(gb[j], 7.f), up2 = fminf(fmaxf(ub[j], -7.f), 7.f); o[4 + j] = F8_SA * (up2 + 1.f) * g2 * sigm(1.702f * g2); }
                v2u w; w.x = pk4f8(o[0], o[1], o[2], o[3]); w.y = pk4f8(o[4], o[5], o[6], o[7]);
                *(v2u*)(ACT + r * FF + colg) = w; }
    }
};
struct EpiDown {
    static constexpr bool PERM = true, AFTER_DRAIN = false;
    unsigned char* YS; const float* bdn; const LAS int* tile_e; const LAS int* rowdst; const LAS float* rowwt;
    __device__ __forceinline__ void operator()(const f32x4 (&acc)[2][2][4][2], const Unit& u, int wr, int wc, int fr, int fq) const {
        const int e = tile_e[u.pm]; const int col0 = u.pn * BM + wc * 32 + 8 * fq;
        const float* bp = bdn + (size_t)e * D + col0; constexpr float DS = 1.f / (F8_SA * F8_SW);
#pragma unroll
        for (int bj = 0; bj < 2; ++bj) { const f32x4 b0 = *(const f32x4*)(bp + bj * HALF), b1 = *(const f32x4*)(bp + bj * HALF + 4);
#pragma unroll
            for (int ai = 0; ai < 2; ++ai)
#pragma unroll
                for (int m = 0; m < 4; ++m) { const int r = u.ord * 256 + ai * HALF + wr * 64 + m * 16 + fr;
                    const int dst = rowdst[r]; const float w = rowwt[r];
                    const f32x4 v0 = (acc[ai][bj][m][0] * DS + b0) * (w * F8_SY), v1 = (acc[ai][bj][m][1] * DS + b1) * (w * F8_SY);
                    v2u o; o.x = pk4f8(v0[0], v0[1], v0[2], v0[3]); o.y = pk4f8(v1[0], v1[1], v1[2], v1[3]);
                    *(v2u*)(YS + (size_t)dst * D + col0 + bj * HALF) = o; } }
    }
};
template <class Sched> __device__ __forceinline__ void fill_down_tables(Frame& F, const Sched& S, LAS int* rowdst, LAS float* rowwt) {
    const LAS int* MI = (const LAS int*)F.MISC; const int* rlist = (const int*)(F.ws + WS_RLIST); const float* rw = (const float*)(F.ws + WS_RW);
    const int r = F.tid & 255;
    for (int u0 = F.tid >> 8; ; u0 += 4) { Unit ua, ub; const bool va = S.next(u0, ua), vb = S.next(u0 + 2, ub); if (!va) break;
        int da = T * 4, db = T * 4; float wa = 0.f, wb = 0.f;
        { const int e = MI[MI_TILE_E + ua.pm], i = MI[MI_TILE_I0 + ua.pm] + r; if (i < MI[MI_CNT + e]) { da = rlist[e * ECAP + i]; wa = rw[e * ECAP + i]; } }
        if (vb) { const int e = MI[MI_TILE_E + ub.pm], i = MI[MI_TILE_I0 + ub.pm] + r; if (i < MI[MI_CNT + e]) { db = rlist[e * ECAP + i]; wb = rw[e * ECAP + i]; } }
        rowdst[u0 * 256 + r] = da; rowwt[u0 * 256 + r] = wa; if (vb) { rowdst[(u0 + 2) * 256 + r] = db; rowwt[(u0 + 2) * 256 + r] = wb; } }
    __syncthreads();
}

__device__ __forceinline__ void transpose_item(const float* __restrict__ W, int N, int k0, int n0, bf16* WT, int dst_row0, int ldk, LAS float* scr, int lane) {
    const int n = n0 + (lane & 31); const bool ok = n < N;
#pragma unroll 8
    for (int i = 0; i < 32; ++i) { const int kk = 2 * i + (lane >> 5); scr[kk * 33 + (lane & 31)] = ok ? W[(size_t)(k0 + kk) * N + n] : 0.f; }
    LDS_WAIT(); asm volatile("" ::: "memory");
    const int c = lane & 7;
#pragma unroll
    for (int j = 0; j < 4; ++j) { const int nn = (lane >> 3) + 8 * j; const LAS float* s = scr + (8 * c) * 33 + nn;
        v4u o; o.x = pk2(s[0 * 33], s[1 * 33]); o.y = pk2(s[2 * 33], s[3 * 33]); o.z = pk2(s[4 * 33], s[5 * 33]); o.w = pk2(s[6 * 33], s[7 * 33]);
        *(v4u*)(WT + (size_t)(dst_row0 + nn) * ldk + k0 + 8 * c) = o; }
    LDS_WAIT(); asm volatile("" ::: "memory");
}
__device__ __forceinline__ void transpose_item_i8(const float* __restrict__ W, int N, int k0, int n0, unsigned char* WT, int dst_row0, int ldk, const unsigned* colmax, LAS float* scr, int lane) {
    const int n = n0 + (lane & 31); const bool ok = n < N;
#pragma unroll 8
    for (int i = 0; i < 32; ++i) { const int kk = 2 * i + (lane >> 5); scr[kk * 33 + (lane & 31)] = ok ? W[(size_t)(k0 + kk) * N + n] : 0.f; }
    LDS_WAIT(); asm volatile("" ::: "memory");
#pragma unroll
    for (int j = 0; j < 2; ++j) { const int ch = lane + 64 * j, nn = ch >> 2, c = ch & 3; const LAS float* s = scr + (16 * c) * 33 + nn;
        const float cm = __uint_as_float(colmax[n0 + nn]); const float sc = cm > 0.f ? 127.f / cm : 0.f;
        v4u o; o.x = pk4i8(s[0 * 33] * sc, s[1 * 33] * sc, s[2 * 33] * sc, s[3 * 33] * sc); o.y = pk4i8(s[4 * 33] * sc, s[5 * 33] * sc, s[6 * 33] * sc, s[7 * 33] * sc);
        o.z = pk4i8(s[8 * 33] * sc, s[9 * 33] * sc, s[10 * 33] * sc, s[11 * 33] * sc); o.w = pk4i8(s[12 * 33] * sc, s[13 * 33] * sc, s[14 * 33] * sc, s[15 * 33] * sc);
        *(v4u*)(WT + (size_t)(dst_row0 + nn) * ldk + k0 + 16 * c) = o; }
    LDS_WAIT(); asm volatile("" ::: "memory");
}
__device__ __forceinline__ void p0b_win(Frame& F) {
    LAS float* scr = (LAS float*)(F.lds + F.wave * 16384);
    const int gw = F.bid * NWAVES + F.wave, NGW = F.G * NWAVES; unsigned char* WIN8 = F.ws + WS_WIN; const unsigned* colmax = F.ctl + CW_COLMAX;
    constexpr int NB_WIN = (NIN + 31) / 32;
    for (int it = gw; it < 32 * NB_WIN; it += NGW) { const int kb = it / NB_WIN, nb = it % NB_WIN; transpose_item_i8(F.in[I_WIN], NIN, kb * 64, nb * 32, WIN8, nb * 32, D, colmax, scr, F.lane); }
    { const int gt = F.bid * NTHR + F.tid, NGT = F.G * NTHR; constexpr int Z0 = NB_WIN * 32 * D, Z1 = NINP * D;
      for (int i = Z0 + gt * 16; i < Z1; i += NGT * 16) *(v4u*)(WIN8 + i) = (v4u){0u, 0u, 0u, 0u}; }
}
__device__ __forceinline__ void p0_prologue(Frame& F) {
    LAS float* scr = (LAS float*)(F.lds + F.wave * 16384);
    const int gw = F.bid * NWAVES + F.wave, NGW = F.G * NWAVES;
    bf16* WIN_T = (bf16*)(F.ws + WS_WIN); bf16* WA_T = (bf16*)(F.ws + WS_WA); bf16* WB_T = (bf16*)(F.ws + WS_WB); bf16* WO_T = (bf16*)(F.ws + WS_WO);
    bf16* WGU_T = (bf16*)(F.ws + WS_WGU); bf16* WDN_T = (bf16*)(F.ws + WS_WDN); bf16* WL_T = (bf16*)(F.ws + WS_WL); bf16* HN = (bf16*)(F.ws + WS_HN);
    { const float* W = F.in[I_WIN]; unsigned* colmax = F.ctl + CW_COLMAX;
      for (int task = gw; task < 168 * 16; task += NGW) { const int cb = task % 168, kc = task / 168, n = cb * 64 + F.lane; float m = 0.f;
          if (n < NIN) { const float* wp = W + (size_t)(kc * 128) * NIN + n;
#pragma unroll 1
              for (int k0 = 0; k0 < 128; k0 += 32) { float v[32];
#pragma unroll
                  for (int i = 0; i < 32; ++i) v[i] = wp[(size_t)(k0 + i) * NIN];
#pragma unroll
                  for (int i = 0; i < 32; ++i) m = fmaxf(m, fabsf(v[i])); }
              atomicMax(colmax + n, __float_as_uint(m)); } } }
    { const int gt = F.bid * NTHR + F.tid, NGT = F.G * NTHR;
      for (int i = gt; i < 3072 * 512; i += NGT) { const int n = i >> 9, k = i & 511; float v = 0.f;
          if (n < 1024) { if (k < 96) v = F.in[I_WUP][k * RD + n]; }
          else if (n < 2048) { if (k >= 128 && k < 224) v = F.in[I_AUP][(k - 128) * RD + (n - 1024)]; }
          else { if (k >= 256) v = F.in[I_GUP][(k - 256) * RD + (n - 2048)]; }
          WL_T[i] = (bf16)f2bf(v); } }
    { const int gt = F.bid * NTHR + F.tid, NGT = F.G * NTHR; float* RWS = (float*)(F.ws + WS_RWS);
      for (int i = gt; i < D * NE; i += NGT) RWS[i] = F.in[I_N2W][i >> 5] * F.in[I_RTW][i]; }
    const float* x = F.in[I_X]; const float* nw = F.in[I_N1W];
    for (int m = gw; m < T; m += NGW) {
        const f32x4* xr = (const f32x4*)(x + (size_t)m * D) + F.lane; f32x4 v[8]; float s = 0.f;
#pragma unroll
        for (int j = 0; j < 8; ++j) { v[j] = xr[64 * j]; s += (v[j][0] * v[j][0] + v[j][1] * v[j][1]) + (v[j][2] * v[j][2] + v[j][3] * v[j][3]); }
        const float rstd = __builtin_amdgcn_rsqf(wave_sum(s) * (1.f / D) + NORM_EPS);
        float am = 0.f;
#pragma unroll
        for (int j = 0; j < 8; ++j) { const f32x4 w = ((const f32x4*)nw)[F.lane + 64 * j]; v[j] = v[j] * rstd * w; am = fmaxf(fmaxf(am, fmaxf(fabsf(v[j][0]), fabsf(v[j][1]))), fmaxf(fabsf(v[j][2]), fabsf(v[j][3]))); }
        am = wave_max(am); const float sc = am > 0.f ? 127.f / am : 0.f;
        if (F.lane == 0) ((float*)(F.ws + WS_RA))[m] = am * (1.f / 127.f);
        unsigned* o4 = (unsigned*)((unsigned char*)HN + (size_t)m * D) + F.lane;
#pragma unroll
        for (int j = 0; j < 8; ++j) o4[64 * j] = pk4i8(v[j][0] * sc, v[j][1] * sc, v[j][2] * sc, v[j][3] * sc);
    }
}

__device__ __forceinline__ void p2_lora_in(Frame& F) {
    const bf16* __restrict__ P = (const bf16*)(F.ws + WS_P); bf16* __restrict__ LIN = (bf16*)(F.ws + WS_LIN); const float* __restrict__ mu = F.in[I_MU];
    const int gt = F.bid * NTHR + F.tid, NGT = F.G * NTHR;
    for (int i = gt; i < T * 64; i += 2 * NGT) { const int g = i & 63; int col = -1, kind = 0;
        if (g < 12) { col = 3072 + 8 * g; kind = 0; } else if (g >= 16 && g < 28) { col = 3168 + 8 * (g - 16); kind = 1; } else if (g >= 32) { col = 3264 + 8 * (g - 32); kind = 2; }
        const int ce = col >= 0 ? col : 3072;
        v4u pc[2], pp[2];
#pragma unroll
        for (int u = 0; u < 2; ++u) { const int ii = i + u * NGT < T * 64 ? i + u * NGT : i; const int t = ii >> 6; pc[u] = *(const v4u*)(P + (size_t)t * NINP + ce); pp[u] = *(const v4u*)(P + (size_t)((t & (SEQ - 1)) ? t - 1 : t) * NINP + ce); }
        const f32x4 m0 = *(const f32x4*)(mu + ce), m1 = *(const f32x4*)(mu + ce + 4);
#pragma unroll
        for (int u = 0; u < 2; ++u) { const int ii = i + u * NGT; if (ii < T * 64) { const int t = ii >> 6; v4u o = (v4u){0u, 0u, 0u, 0u};
            if (col >= 0) { const float pm = (t & (SEQ - 1)) ? 1.f : 0.f;
                const unsigned pcs[4] = {pc[u].x, pc[u].y, pc[u].z, pc[u].w}, pps[4] = {pp[u].x, pp[u].y, pp[u].z, pp[u].w}; float x[8];
#pragma unroll
                for (int k = 0; k < 4; ++k) { const float c0 = __uint_as_float(pcs[k] << 16), c1 = __uint_as_float(pcs[k] & 0xffff0000u), q0 = pm * __uint_as_float(pps[k] << 16), q1 = pm * __uint_as_float(pps[k] & 0xffff0000u);
                    const float ma = k < 2 ? m0[2 * k] : m1[2 * k - 4], mb = k < 2 ? m0[2 * k + 1] : m1[2 * k - 3];
                    x[2 * k] = c0 + (q0 - c0) * ma; x[2 * k + 1] = c1 + (q1 - c1) * mb; }
#pragma unroll
                for (int k = 0; k < 8; ++k) x[k] = kind == 0 ? tanhf(x[k]) : (kind == 1 ? x[k] : sigm(x[k]));
                o.x = pk2(x[0], x[1]); o.y = pk2(x[2], x[3]); o.z = pk2(x[4], x[5]); o.w = pk2(x[6], x[7]); }
            *(v4u*)(LIN + (size_t)t * 512 + 8 * g) = o; } } }
    { bf16* __restrict__ QKC = (bf16*)(F.ws + WS_QKC); const float* __restrict__ cw = F.in[I_CONVW];
      for (int i = gt; i < T * 128; i += 2 * NGT) { v4u pv[2][4]; f32x4 w0[4], w1[4]; const int c0 = 8 * (i & 127);
#pragma unroll
          for (int u = 0; u < 2; ++u) { const int ii = i + u * NGT < T * 128 ? i + u * NGT : i; const int t = ii >> 7, sq = t & (SEQ - 1);
#pragma unroll
              for (int j = 0; j < 4; ++j) { const int tj = sq - 3 + j >= 0 ? t - 3 + j : t; pv[u][j] = *(const v4u*)(P + (size_t)tj * NINP + MLO + c0); } }
#pragma unroll
          for (int j = 0; j < 4; ++j) { w0[j] = *(const f32x4*)(cw + j * 1024 + c0); w1[j] = *(const f32x4*)(cw + j * 1024 + c0 + 4); }
          const float sc = c0 < 512 ? 0.08838834764831845f : 1.f;
#pragma unroll
          for (int u = 0; u < 2; ++u) { const int ii = i + u * NGT; if (ii < T * 128) { const int t = ii >> 7, sq = t & (SEQ - 1); float acc[8];
#pragma unroll
              for (int k = 0; k < 8; ++k) acc[k] = 0.f;
#pragma unroll
              for (int j = 0; j < 4; ++j) { const float m = sq - 3 + j >= 0 ? 1.f : 0.f; const v4u q = pv[u][j]; const f32x4 a0 = w0[j] * m, a1 = w1[j] * m;
                  acc[0] += __uint_as_float(q.x << 16) * a0[0]; acc[1] += __uint_as_float(q.x & 0xffff0000u) * a0[1]; acc[2] += __uint_as_float(q.y << 16) * a0[2]; acc[3] += __uint_as_float(q.y & 0xffff0000u) * a0[3];
                  acc[4] += __uint_as_float(q.z << 16) * a1[0]; acc[5] += __uint_as_float(q.z & 0xffff0000u) * a1[1]; acc[6] += __uint_as_float(q.w << 16) * a1[2]; acc[7] += __uint_as_float(q.w & 0xffff0000u) * a1[3]; }
#pragma unroll
              for (int k = 0; k < 8; ++k) acc[k] = acc[k] * sigm(acc[k]) * sc;
              v4u o; o.x = pk2(acc[0], acc[1]); o.y = pk2(acc[2], acc[3]); o.z = pk2(acc[4], acc[5]); o.w = pk2(acc[6], acc[7]); *(v4u*)(QKC + (size_t)t * 1024 + c0) = o; } } } }
    { float* __restrict__ GLF = (float*)(F.ws + WS_GLF); const int gw = F.bid * NWAVES + F.wave, NGW = F.G * NWAVES, lane = F.lane;
      for (int q = gw; q < (T / 64) * 4; q += NGW) { const int chk = q >> 2, mh = q & 3; const size_t t = (size_t)chk * 64 + lane; const bf16* pr = P + t * NINP + MLO + 2048;
          const float ip = 15.f * tanhf((bf2f(pr[mh]) + F.in[I_IB][mh]) * (1.f / 15.f)), fp = 15.f * tanhf((bf2f(pr[4 + mh]) + F.in[I_FB][mh]) * (1.f / 15.f));
          float bc = fminf(fp, 0.f) - log1pf(__expf(-fabsf(fp)));
#pragma unroll
          for (int o = 1; o < 64; o <<= 1) { const float t_ = __shfl_up(bc, o); if (lane >= o) bc += t_; }
          const float u = ip - bc; float pm = u;
#pragma unroll
          for (int o = 1; o < 64; o <<= 1) { const float t_ = __shfl_up(pm, o); if (lane >= o) pm = fmaxf(pm, t_); }
          *(f32x4*)(GLF + t * 16 + 4 * mh) = (f32x4){bc, u, pm, 0.f}; } }
}

typedef short s16x8 __attribute__((ext_vector_type(8)));
typedef short s16x4 __attribute__((ext_vector_type(4)));
__device__ __forceinline__ unsigned long long pack4bf(f32x4 v) { return (unsigned long long)pk2(v[0], v[1]) | ((unsigned long long)pk2(v[2], v[3]) << 32); }
__device__ __forceinline__ s16x8 tr_frag(const LAS bf16* img, int stride, int r0, int c0, int fr) {
    const LAS bf16* p0 = img + (r0 + (fr >> 2)) * stride + c0 + 4 * (fr & 3);
    const s16x4 lo = __builtin_bit_cast(s16x4, __builtin_amdgcn_ds_read_tr16_b64_v4i16((LAS s16x4*)p0));
    const s16x4 hi = __builtin_bit_cast(s16x4, __builtin_amdgcn_ds_read_tr16_b64_v4i16((LAS s16x4*)(p0 + 4 * stride)));
    return __builtin_shufflevector(lo, hi, 0, 1, 2, 3, 4, 5, 6, 7);
}

__device__ __forceinline__ float scan32(float x) {
    x += dppf<0x111>(x); x += dppf<0x112>(x); x += dppf<0x114>(x); x += dppf<0x118>(x);
    x += __builtin_bit_cast(float, __builtin_amdgcn_update_dpp(0, __builtin_bit_cast(int, x), 0x142, 0xa, 0xf, false));
    return x; }
typedef float f32x16 __attribute__((ext_vector_type(16)));
__device__ __forceinline__ s16x8 accfrag(const f32x16& x, int s) { v4u p; p.x = pk2(x[8 * s], x[8 * s + 1]); p.y = pk2(x[8 * s + 2], x[8 * s + 3]); p.z = pk2(x[8 * s + 4], x[8 * s + 5]); p.w = pk2(x[8 * s + 6], x[8 * s + 7]); return __builtin_bit_cast(s16x8, p); }
#define MFMA32(a_, b_, c_) __builtin_amdgcn_mfma_f32_32x32x16_bf16((a_), (b_), (c_), 0, 0, 0)
__device__ __forceinline__ void rw_bar(LAS unsigned* cnt, unsigned& target, int lane);
__device__ __forceinline__ void rwkv_chunk_unit(Frame& F, int unit, LAS unsigned char* regB, LAS unsigned* bcnt, unsigned& btarget) {
    const int b = unit >> 5, h = (unit >> 1) & 15, half = unit & 1;
    const bf16* P = (const bf16*)(F.ws + WS_P); const float* WAG = (const float*)(F.ws + WS_WAG); const bf16* AGp = (const bf16*)(F.ws + WS_WAG + 64 * MiB); float* YRAW = (float*)(F.ws + WS_YRAW);
    constexpr int KS = 72, LS = 40;
    LAS bf16* At = (LAS bf16*)F.lds; LAS bf16* Bt = At + 32 * KS; LAS bf16* Kt = Bt + 32 * KS; LAS bf16* Rt = Kt + 32 * KS;
    LAS bf16* Vv = Rt + 32 * KS;
    LAS bf16* Sb = Vv + 32 * LS;
    LAS bf16* G2b = Sb + 32 * KS; LAS bf16* G3b = G2b + 32 * LS; LAS bf16* G4b = G3b + 32 * LS;
    LAS bf16* Pwb = G4b + 32 * LS;
    LAS bf16* Acb = Pwb + 2 * 32 * LS;
    LAS bf16* RHt = (LAS bf16*)regB;
    LAS bf16* Ubt = RHt + 32 * LS;
    LAS float* lwf = (LAS float*)(Ubt + 32 * LS);
    LAS float* csf = lwf + 2048;
    LAS float* gtf = csf + 2048;
    LAS float* glf = gtf + 256;
    const int tid = F.tid, lane = F.lane, w = F.wave, fr = lane & 15, fq = lane >> 4;
    const int ts = tid >> 4, cs = tid & 15, c0 = h * 64 + 4 * cs;
    const int sk = tid & 63, sq = tid >> 6;
    const f32x4 mu_r = *(const f32x4*)(F.in[I_MU] + c0), mu_k = *(const f32x4*)(F.in[I_MU] + 1024 + c0), mu_v = *(const f32x4*)(F.in[I_MU] + 2048 + c0);
    const f32x4 kkc = *(const f32x4*)(F.in[I_KK] + c0), kac = *(const f32x4*)(F.in[I_KA] + c0), rkc = *(const f32x4*)(F.in[I_RK] + c0);
    bf16* BON = (bf16*)(F.ws + WS_WAG + 128 * MiB);
    for (int i = tid; i < 32 * KS; i += 256) Sb[i] = 0;
    v2u cr[2], ck[2], cv[2], qr[2], qk[2], qv[2]; f32x4 a4[2], ws0, ws1;
#define RC_LOAD(ch) do { _Pragma("unroll") for (int p_ = 0; p_ < 2; ++p_) { const int t_ = (ch) * 32 + ts + 16 * p_; const size_t tk_ = (size_t)b * SEQ + t_; const bf16* pr_ = P + tk_ * NINP + c0; \
        cr[p_] = *(const v2u*)(pr_); ck[p_] = *(const v2u*)(pr_ + 1024); cv[p_] = *(const v2u*)(pr_ + 2048); \
        if (t_ > 0) { qr[p_] = *(const v2u*)(pr_ - NINP); qk[p_] = *(const v2u*)(pr_ - NINP + 1024); qv[p_] = *(const v2u*)(pr_ - NINP + 2048); } else { qr[p_] = (v2u){0u, 0u}; qk[p_] = qr[p_]; qv[p_] = qr[p_]; } \
        { const v2u ab_ = *(const v2u*)(AGp + tk_ * D + c0); a4[p_] = UNP4(ab_); } } \
        { const float* wr_ = WAG + ((size_t)b * SEQ + (ch) * 32 + (lane & 31)) * RD + h * 64 + 16 * w + 8 * (lane >> 5); ws0 = *(const f32x4*)wr_; ws1 = *(const f32x4*)(wr_ + 4); } } while (0)
    const int mi = w >> 1, nj = w & 1;
    f32x4 st[2]; st[0] = (f32x4){0.f, 0.f, 0.f, 0.f}; st[1] = st[0];
    RC_LOAD(0);
    rw_bar(bcnt, btarget, lane);
    for (int ch = 0; ch < SEQ / 32; ++ch) {
        f32x4 rr[2], kmod[2], vv[2], kkn[2], al[2];
#pragma unroll
        for (int p_ = 0; p_ < 2; ++p_) { const f32x4 pr4 = UNP4(cr[p_]), pk4 = UNP4(ck[p_]), pv4 = UNP4(cv[p_]), qr4 = UNP4(qr[p_]), qk4 = UNP4(qk[p_]), qv4 = UNP4(qv[p_]); al[p_] = a4[p_];
            rr[p_] = pr4 + (qr4 - pr4) * mu_r; const f32x4 k1 = pk4 + (qk4 - pk4) * mu_k; vv[p_] = pv4 + (qv4 - pv4) * mu_v;
            const f32x4 kkr = k1 * kkc; const float nrm = __builtin_amdgcn_rsqf(fmaxf(allreduce16((kkr[0] * kkr[0] + kkr[1] * kkr[1]) + (kkr[2] * kkr[2] + kkr[3] * kkr[3])), 1e-24f));
            kkn[p_] = kkr * nrm; kmod[p_] = k1 * (1.f + (al[p_] - 1.f) * kac);
            { const f32x4 rk_ = rr[p_] * kmod[p_] * rkc; const float dot = allreduce16((rk_[0] + rk_[1]) + (rk_[2] + rk_[3]));
              if ((cs >> 3) == half) *(unsigned long long*)(BON + ((size_t)b * SEQ + ch * 32 + ts + 16 * p_) * RD + c0) = pack4bf(vv[p_] * dot); }
            }
        { const int tq = lane & 31, hq = lane >> 5; f32x4 c0v, c1v;
#pragma unroll
          for (int j = 0; j < 4; ++j) { c0v[j] = scan32(ws0[j]); c1v[j] = scan32(ws1[j]); }
          *(LAS f32x4*)(csf + tq * 64 + 16 * w + 8 * hq) = c0v; *(LAS f32x4*)(csf + tq * 64 + 16 * w + 8 * hq + 4) = c1v; }
        if (ch + 1 < SEQ / 32) RC_LOAD(ch + 1);
        rw_bar(bcnt, btarget, lane);
#pragma unroll
        for (int p_ = 0; p_ < 2; ++p_) { const int t = ts + 16 * p_; const f32x4 cg = *(const LAS f32x4*)(csf + t * 64 + 4 * cs); f32x4 cgp = (f32x4){0.f, 0.f, 0.f, 0.f}; if (t > 0) cgp = *(const LAS f32x4*)(csf + (t - 1) * 64 + 4 * cs); f32x4 g, gp, gi;
#pragma unroll
          for (int j = 0; j < 4; ++j) { g[j] = __expf(cg[j]); gp[j] = __expf(cgp[j]); gi[j] = __expf(-cg[j]); }
          *(LAS unsigned long long*)(At + t * KS + 4 * cs) = pack4bf(-(kkn[p_] * gp)); *(LAS unsigned long long*)(Bt + t * KS + 4 * cs) = pack4bf(kkn[p_] * al[p_] * gi);
          *(LAS unsigned long long*)(Kt + t * KS + 4 * cs) = pack4bf(kmod[p_] * gi); *(LAS unsigned long long*)(Rt + t * KS + 4 * cs) = pack4bf(rr[p_] * g);
          if ((cs >> 3) == half) *(LAS unsigned long long*)(Vv + t * LS + 4 * (cs & 7)) = pack4bf(vv[p_]);
          if (t == 31) *(LAS f32x4*)(glf + 4 * cs) = g; }
        rw_bar(bcnt, btarget, lane);
        { const int t = 16 * mi + fr, jb = 16 * nj + 4 * fq;
          f32x4 g2 = (f32x4){0.f, 0.f, 0.f, 0.f}, g3 = g2, g4 = g2;
#pragma unroll
          for (int ks = 0; ks < 2; ++ks) { const s16x8 bj = *(const LAS s16x8*)(Bt + (16 * nj + fr) * KS + 32 * ks + 8 * fq), kj = *(const LAS s16x8*)(Kt + (16 * nj + fr) * KS + 32 * ks + 8 * fq);
              const s16x8 at = *(const LAS s16x8*)(At + (16 * mi + fr) * KS + 32 * ks + 8 * fq), rt = *(const LAS s16x8*)(Rt + (16 * mi + fr) * KS + 32 * ks + 8 * fq);
              g2 = __builtin_amdgcn_mfma_f32_16x16x32_bf16(kj, at, g2, 0, 0, 0); g3 = __builtin_amdgcn_mfma_f32_16x16x32_bf16(bj, rt, g3, 0, 0, 0); g4 = __builtin_amdgcn_mfma_f32_16x16x32_bf16(kj, rt, g4, 0, 0, 0); }
#pragma unroll
          for (int rg_ = 0; rg_ < 4; ++rg_) { const int j = jb + rg_; g2[rg_] = (j < t) ? g2[rg_] : 0.f; g3[rg_] = (j <= t) ? g3[rg_] : 0.f; g4[rg_] = (j <= t) ? g4[rg_] : 0.f; }
          *(LAS unsigned long long*)(G2b + t * LS + jb) = pack4bf(g2); *(LAS unsigned long long*)(G3b + t * LS + jb) = pack4bf(g3); *(LAS unsigned long long*)(G4b + t * LS + jb) = pack4bf(g4); }
        { const int tq = lane & 31, hq = lane >> 5;
          f32x16 Pm, Qm, Aq;
#pragma unroll
          for (int i = 0; i < 16; ++i) { Pm[i] = 0.f; Qm[i] = 0.f; }
#pragma unroll
          for (int s = 0; s < 4; ++s) { const s16x8 fa = *(const LAS s16x8*)(At + tq * KS + 16 * s + 8 * hq), fb = *(const LAS s16x8*)(Bt + tq * KS + 16 * s + 8 * hq);
              Pm = MFMA32(fa, fb, Pm); Qm = MFMA32(fb, fa, Qm); }
#pragma unroll
          for (int i = 0; i < 16; ++i) { const int r_ = (i & 3) + 8 * (i >> 2) + 4 * hq;
              Pm[i] = (tq < r_) ? Pm[i] : 0.f;
              Qm[i] = (r_ < tq) ? Qm[i] : 0.f;
              Aq[i] = Qm[i] + ((r_ == tq) ? 1.f : 0.f); }
#pragma unroll
          for (int st = 1; st <= 4; ++st) { const s16x8 p0 = accfrag(Pm, 0), p1 = accfrag(Pm, 1), q0 = accfrag(Qm, 0), q1 = accfrag(Qm, 1);
              f32x16 nP, nQ;
#pragma unroll
              for (int i = 0; i < 16; ++i) { nP[i] = 0.f; nQ[i] = 0.f; }
              nP = MFMA32(q0, p0, nP); nP = MFMA32(q1, p1, nP);
              if (st < 4) { nQ = MFMA32(p0, q0, nQ); nQ = MFMA32(p1, q1, nQ); }
              Pm = nP; Qm = nQ;
              const s16x8 n0 = accfrag(Pm, 0), n1 = accfrag(Pm, 1), a0 = accfrag(Aq, 0), a1 = accfrag(Aq, 1);
              Aq = MFMA32(n0, a0, Aq); Aq = MFMA32(n1, a1, Aq); }
          f32x4 tv; tv[0] = w == 0 ? Aq[0] : w == 1 ? Aq[4] : w == 2 ? Aq[8] : Aq[12]; tv[1] = w == 0 ? Aq[1] : w == 1 ? Aq[5] : w == 2 ? Aq[9] : Aq[13];
          tv[2] = w == 0 ? Aq[2] : w == 1 ? Aq[6] : w == 2 ? Aq[10] : Aq[14]; tv[3] = w == 0 ? Aq[3] : w == 1 ? Aq[7] : w == 2 ? Aq[11] : Aq[15];
          *(LAS unsigned long long*)(Acb + 32 * LS + tq * LS + 8 * w + 4 * hq) = pack4bf(tv); }
        rw_bar(bcnt, btarget, lane);
        f32x4 yv = (f32x4){0.f, 0.f, 0.f, 0.f};
        { f32x4 z = (f32x4){0.f, 0.f, 0.f, 0.f};
#pragma unroll
          for (int ks = 0; ks < 2; ++ks) { const s16x8 sb = *(const LAS s16x8*)(Sb + (16 * nj + fr) * KS + 32 * ks + 8 * fq);
              z = __builtin_amdgcn_mfma_f32_16x16x32_bf16(*(const LAS s16x8*)(At + (16 * mi + fr) * KS + 32 * ks + 8 * fq), sb, z, 0, 0, 0);
              yv = __builtin_amdgcn_mfma_f32_16x16x32_bf16(*(const LAS s16x8*)(Rt + (16 * mi + fr) * KS + 32 * ks + 8 * fq), sb, yv, 0, 0, 0); }
          const s16x8 vt_ = tr_frag(Vv, LS, 8 * fq, 16 * nj, fr);
          z = __builtin_amdgcn_mfma_f32_16x16x32_bf16(*(const LAS s16x8*)(G2b + (16 * mi + fr) * LS + 8 * fq), vt_, z, 0, 0, 0);
          yv = __builtin_amdgcn_mfma_f32_16x16x32_bf16(*(const LAS s16x8*)(G4b + (16 * mi + fr) * LS + 8 * fq), vt_, yv, 0, 0, 0);
          *(LAS unsigned long long*)(RHt + (16 * nj + fr) * LS + 16 * mi + 4 * fq) = pack4bf(z); }
        rw_bar(bcnt, btarget, lane);
        { f32x4 z = (f32x4){0.f, 0.f, 0.f, 0.f};
          z = __builtin_amdgcn_mfma_f32_16x16x32_bf16(*(const LAS s16x8*)(Acb + 32 * LS + (16 * mi + fr) * LS + 8 * fq), *(const LAS s16x8*)(RHt + (16 * nj + fr) * LS + 8 * fq), z, 0, 0, 0);
          *(LAS unsigned long long*)(Ubt + (16 * nj + fr) * LS + 16 * mi + 4 * fq) = pack4bf(z); }
        rw_bar(bcnt, btarget, lane);
        { yv = __builtin_amdgcn_mfma_f32_16x16x32_bf16(*(const LAS s16x8*)(G3b + (16 * mi + fr) * LS + 8 * fq), *(const LAS s16x8*)(Ubt + (16 * nj + fr) * LS + 8 * fq), yv, 0, 0, 0);
          float* yp = YRAW + ((size_t)b * SEQ + ch * 32 + 16 * mi + 4 * fq) * RD + h * 64 + half * 32 + 16 * nj + fr;
#pragma unroll
          for (int rg_ = 0; rg_ < 4; ++rg_) yp[(size_t)rg_ * RD] = yv[rg_]; }
        { const int kt = w; const s16x8 bt_ = tr_frag(Bt, KS, 8 * fq, 16 * kt, fr), kt_ = tr_frag(Kt, KS, 8 * fq, 16 * kt, fr); const f32x4 gl4 = *(const LAS f32x4*)(glf + 16 * kt + 4 * fq);
#pragma unroll
          for (int vt = 0; vt < 2; ++vt) {
              st[vt] = __builtin_amdgcn_mfma_f32_16x16x32_bf16(bt_, *(const LAS s16x8*)(Ubt + (16 * vt + fr) * LS + 8 * fq), st[vt], 0, 0, 0);
              st[vt] = __builtin_amdgcn_mfma_f32_16x16x32_bf16(kt_, tr_frag(Vv, LS, 8 * fq, 16 * vt, fr), st[vt], 0, 0, 0);
              st[vt] = st[vt] * gl4;
              *(LAS unsigned long long*)(Sb + (16 * vt + fr) * KS + 16 * kt + 4 * fq) = pack4bf(st[vt]); } }
    }
#undef RC_LOAD
}

__device__ __forceinline__ float allreduce8(float x) { x += dppf<0x141>(x); x += dppf<0xB1>(x); x += dppf<0x4E>(x); return x; }
__device__ __forceinline__ void rw_bar(LAS unsigned* cnt, unsigned& target, int lane) {
    asm volatile("s_waitcnt lgkmcnt(0)" ::: "memory");
    if (lane == 0) __hip_atomic_fetch_add(cnt, 1u, __ATOMIC_RELAXED, __HIP_MEMORY_SCOPE_WORKGROUP);
    target += 4u;
    while ((unsigned)__builtin_amdgcn_readfirstlane((int)__hip_atomic_load(cnt, __ATOMIC_RELAXED, __HIP_MEMORY_SCOPE_WORKGROUP)) < target) __builtin_amdgcn_s_sleep(1);
    asm volatile("" ::: "memory");
}
constexpr int CV_BR = 8 * 32, CV_WO = 16 * 32, CV_GU = NE * 16 * 64, CV_DN = NE * 16 * 32, CV_ITEMS = 2 * CV_BR + CV_WO + CV_GU + CV_DN;
constexpr int CV_SPLIT = CV_ITEMS - 0;
constexpr int P5_NW = 8;
struct CvItem { const float* src; unsigned char* dst; int N; int f8; };
__device__ __forceinline__ CvItem cv_decode(Frame& F, int it) {
    CvItem c; int r = it; const int lane = F.lane;
    if (r < CV_BR) { const int kb = r >> 5, nb = r & 31; c.src = F.in[I_WBA] + (size_t)(kb * 128) * D + nb * 64 + lane; c.dst = F.ws + WS_WA + ((size_t)(nb * 64 + lane) * RD + kb * 128) * 2; c.N = D; c.f8 = 0; return c; } r -= CV_BR;
    if (r < CV_BR) { const int kb = r >> 5, nb = r & 31; c.src = F.in[I_WBB] + (size_t)(kb * 128) * D + nb * 64 + lane; c.dst = F.ws + WS_WB + ((size_t)(nb * 64 + lane) * RD + kb * 128) * 2; c.N = D; c.f8 = 0; return c; } r -= CV_BR;
    if (r < CV_WO) { const int kb = r >> 5, nb = r & 31; c.src = F.in[I_WOUT] + (size_t)(kb * 128) * D + nb * 64 + lane; c.dst = F.ws + WS_WO + ((size_t)(nb * 64 + lane) * D + kb * 128) * 2; c.N = D; c.f8 = 0; return c; } r -= CV_WO;
    if (r < CV_GU) { const int e = r >> 10, q = r & 1023, kb = q >> 6, nb = q & 63, n0 = nb * 64;
        const int dr = n0 < FF ? ((n0 >> 7) * 256 + (n0 & 127)) : (((n0 - FF) >> 7) * 256 + 128 + ((n0 - FF) & 127));
        c.src = F.in[I_WGU] + (size_t)e * D * 2 * FF + (size_t)(kb * 128) * (2 * FF) + n0 + lane; c.dst = F.ws + WS_WGU + (size_t)e * 2 * FF * D + (size_t)(dr + lane) * D + kb * 128; c.N = 2 * FF; c.f8 = 1; return c; } r -= CV_GU;
    { const int e = r >> 9, q = r & 511, kb = q >> 5, nb = q & 31;
        c.src = F.in[I_WDN] + (size_t)e * FF * D + (size_t)(kb * 128) * D + nb * 64 + lane; c.dst = F.ws + WS_WDN + (size_t)e * D * FF + (size_t)(nb * 64 + lane) * FF + kb * 128; c.N = D; c.f8 = 1; }
    return c;
}
__device__ __forceinline__ void convert_item(Frame& F, int it, LAS unsigned char* cvbuf);
__device__ __forceinline__ void convert_loop(Frame& F, unsigned* next, unsigned* p1done, unsigned ngemm, LAS unsigned char* cvbuf, unsigned lo, unsigned hi) {
#define CV_CLAIM(b_) do { b_ = 0xffffffffu; if (F.lane == 0) { if (!(p1done && __hip_atomic_load(p1done, __ATOMIC_RELAXED, __HIP_MEMORY_SCOPE_AGENT) >= ngemm)) b_ = __hip_atomic_fetch_add(next, 2u, __ATOMIC_RELAXED, __HIP_MEMORY_SCOPE_AGENT); } } while (0)
    unsigned nb; CV_CLAIM(nb);
    for (;;) { const unsigned b0 = (unsigned)__builtin_amdgcn_readfirstlane((int)nb); if (b0 >= hi - lo) break;
        const unsigned base = b0 + lo;
        if (!p1done) CV_CLAIM(nb);
        for (int k = 0; k < 2; ++k) { const unsigned it = base + k; if (it < hi) convert_item(F, (int)it, cvbuf); }
        if (p1done) CV_CLAIM(nb); }
#undef CV_CLAIM
}
__device__ __forceinline__ void convert_item(Frame& F, int i0, LAS unsigned char* cvbuf) {
    { const CvItem c = cv_decode(F, i0);
        float x[128];
#pragma unroll
        for (int i = 0; i < 128; ++i) x[i] = c.src[(size_t)i * c.N];
        if (c.f8) {
            const int lane = F.lane; LAS unsigned char* bw = cvbuf + lane * 144;
#pragma unroll
            for (int q = 0; q < 8; ++q) { v4u o; o.x = pk4f8(x[16 * q + 0] * F8_SW, x[16 * q + 1] * F8_SW, x[16 * q + 2] * F8_SW, x[16 * q + 3] * F8_SW); o.y = pk4f8(x[16 * q + 4] * F8_SW, x[16 * q + 5] * F8_SW, x[16 * q + 6] * F8_SW, x[16 * q + 7] * F8_SW);
                o.z = pk4f8(x[16 * q + 8] * F8_SW, x[16 * q + 9] * F8_SW, x[16 * q + 10] * F8_SW, x[16 * q + 11] * F8_SW); o.w = pk4f8(x[16 * q + 12] * F8_SW, x[16 * q + 13] * F8_SW, x[16 * q + 14] * F8_SW, x[16 * q + 15] * F8_SW);
                *(LAS v4u*)(bw + 16 * q) = o; }
            unsigned char* d0 = c.dst - (size_t)lane * 2048 + (size_t)(lane >> 3) * 2048 + (lane & 7) * 16; const LAS unsigned char* br = cvbuf + (lane >> 3) * 144 + (lane & 7) * 16;
#pragma unroll
            for (int i = 0; i < 8; ++i) { const v4u v = *(const LAS v4u*)(br + i * 8 * 144); *(v4u*)(d0 + (size_t)i * 8 * 2048) = v; } }
        else {
#pragma unroll
            for (int q = 0; q < 16; ++q) { v4u o; o.x = pk2(x[8 * q + 0], x[8 * q + 1]); o.y = pk2(x[8 * q + 2], x[8 * q + 3]); o.z = pk2(x[8 * q + 4], x[8 * q + 5]); o.w = pk2(x[8 * q + 6], x[8 * q + 7]);
                *(v4u*)(c.dst + 16 * q) = o; } } }
}

__device__ __forceinline__ void mlstm_scan_unit(Frame& F, int unit, LAS unsigned* bcnt, unsigned& btarget) {
    const int b = unit >> 5, mh = (unit >> 3) & 3, sl = unit & 7;
    const bf16* P = (const bf16*)(F.ws + WS_P); const bf16* QKC = (const bf16*)(F.ws + WS_QKC); const float* GLF = (const float*)(F.ws + WS_GLF); float* HRAW = (float*)(F.ws + WS_HRAW);
    constexpr int VS = 56;
    LAS bf16* Lq = (LAS bf16*)F.lds;
    LAS bf16* Lk = Lq + 64 * 136;
    LAS bf16* Lv = Lk + 64 * 136;
    LAS bf16* Lvs = Lv + 64 * VS;
    LAS bf16* LcT = Lvs + 64 * VS;
    LAS bf16* Ls = LcT + 2 * 48 * 136;
    LAS float* sb = (LAS float*)(Ls + 64 * 72); LAS float* su = sb + 64; LAS float* smx = su + 64; LAS float* swk = smx + 64;
    const int tid = F.tid, lane = F.lane, w = F.wave, fr = lane & 15, fq = lane >> 4;
    for (int i = tid; i < 2 * 48 * 136; i += 256) LcT[i] = 0;
    for (int i = tid; i < 64 * 16; i += 256) { const int j = i >> 4, c = 32 + (i & 15); Lv[j * VS + c] = (c == 32) ? (bf16)0x3F80 : (bf16)0; Lvs[j * VS + c] = 0; }
    const int pr0 = tid >> 4, pc = 8 * (tid & 15);
    v4u rq[4], rk[4], rv; f32x4 g3;
#define ML_LOAD(ch) do { const size_t tk0_ = (size_t)b * SEQ + (ch) * 64; \
        _Pragma("unroll") for (int i_ = 0; i_ < 4; ++i_) { const bf16* s_ = QKC + (tk0_ + pr0 + 16 * i_) * 1024 + mh * 128 + pc; rq[i_] = *(const v4u*)s_; rk[i_] = *(const v4u*)(s_ + 512); } \
        rv = *(const v4u*)(P + (tk0_ + (tid >> 2)) * NINP + MLO + 1024 + mh * 256 + sl * 32 + 8 * (tid & 3)); \
        g3 = *(const f32x4*)(GLF + (tk0_ + lane) * 16 + 4 * mh); } while (0)
    f32x4 st[2][3];
#pragma unroll
    for (int a = 0; a < 2; ++a)
#pragma unroll
        for (int n = 0; n < 3; ++n) st[a][n] = (f32x4){0.f, 0.f, 0.f, 0.f};
    float mstate = 0.f;
    ML_LOAD(0);
    rw_bar(bcnt, btarget, lane);
    for (int ch = 0; ch < SEQ / 64; ++ch) {
        const size_t tk0 = (size_t)b * SEQ + ch * 64;
        LAS bf16* cTc = LcT + (ch & 1) * 48 * 136; LAS bf16* cTn = LcT + ((ch + 1) & 1) * 48 * 136;
        float mnew, dec;
        { const float bc = g3[0], u = g3[1], pm = g3[2];
          const float gtot = __shfl(bc, 63), pmall = __shfl(pm, 63);
          mnew = gtot + fmaxf(mstate, pmall); dec = __expf(gtot + mstate - mnew);
          const float wk = __expf(u + gtot - mnew);
          sb[lane] = bc; su[lane] = u; smx[lane] = fmaxf(mstate, pm); swk[lane] = wk;
          if (w == 0) Lvs[lane * VS + 32] = (bf16)f2bf(wk); }
#pragma unroll
        for (int i = 0; i < 4; ++i) { *(LAS v4u*)(Lq + (pr0 + 16 * i) * 136 + pc) = rq[i]; *(LAS v4u*)(Lk + (pr0 + 16 * i) * 136 + pc) = rk[i]; }
        LDS_WAIT();
        { const int j = tid >> 2, d0 = 8 * (tid & 3); const float wkj = swk[j]; *(LAS v4u*)(Lv + j * VS + d0) = rv;
          const unsigned uu[4] = {rv.x, rv.y, rv.z, rv.w}; v4u sv;
          sv.x = pk2(wkj * __uint_as_float(uu[0] << 16), wkj * __uint_as_float(uu[0] & 0xffff0000u)); sv.y = pk2(wkj * __uint_as_float(uu[1] << 16), wkj * __uint_as_float(uu[1] & 0xffff0000u));
          sv.z = pk2(wkj * __uint_as_float(uu[2] << 16), wkj * __uint_as_float(uu[2] & 0xffff0000u)); sv.w = pk2(wkj * __uint_as_float(uu[3] << 16), wkj * __uint_as_float(uu[3] & 0xffff0000u));
          *(LAS v4u*)(Lvs + j * VS + d0) = sv; }
        if (ch + 1 < SEQ / 64) ML_LOAD(ch + 1);
        rw_bar(bcnt, btarget, lane);
        { const int tt = w; const int t = 16 * tt + fr; const float mxt = smx[t];
#pragma unroll
          for (int jt = 0; jt < 4; ++jt) { f32x4 acc = (f32x4){0.f, 0.f, 0.f, 0.f};
              if (jt <= tt) {
#pragma unroll
                  for (int ks = 0; ks < 4; ++ks) { const s16x8 a = *(const LAS s16x8*)(Lk + (16 * jt + fr) * 136 + 32 * ks + 8 * fq), bq = *(const LAS s16x8*)(Lq + (16 * tt + fr) * 136 + 32 * ks + 8 * fq);
                      acc = __builtin_amdgcn_mfma_f32_16x16x32_bf16(a, bq, acc, 0, 0, 0); }
                  const f32x4 u4 = *(const LAS f32x4*)(su + 16 * jt + 4 * fq);
#pragma unroll
                  for (int rg_ = 0; rg_ < 4; ++rg_) { const int j = 16 * jt + 4 * fq + rg_; acc[rg_] = (j <= t) ? acc[rg_] * __expf(u4[rg_] - mxt) : 0.f; } }
              *(LAS unsigned long long*)(Ls + t * 72 + 16 * jt + 4 * fq) = pack4bf(acc); } }
        rw_bar(bcnt, btarget, lane);
        { const int mi = w; f32x4 a1[3], a2[3];
#pragma unroll
          for (int n = 0; n < 3; ++n) { a1[n] = (f32x4){0.f, 0.f, 0.f, 0.f}; a2[n] = a1[n]; }
#pragma unroll
          for (int ks = 0; ks < 2; ++ks) { const s16x8 A = *(const LAS s16x8*)(Ls + (16 * mi + fr) * 72 + 32 * ks + 8 * fq);
#pragma unroll
              for (int n = 0; n < 3; ++n) a1[n] = __builtin_amdgcn_mfma_f32_16x16x32_bf16(A, tr_frag(Lv, VS, 32 * ks + 8 * fq, 16 * n, fr), a1[n], 0, 0, 0); }
#pragma unroll
          for (int ks = 0; ks < 4; ++ks) { const s16x8 A = *(const LAS s16x8*)(Lq + (16 * mi + fr) * 136 + 32 * ks + 8 * fq);
#pragma unroll
              for (int n = 0; n < 3; ++n) a2[n] = __builtin_amdgcn_mfma_f32_16x16x32_bf16(A, *(const LAS s16x8*)(cTc + (16 * n + fr) * 136 + 32 * ks + 8 * fq), a2[n], 0, 0, 0); }
          const f32x4 mx4 = *(const LAS f32x4*)(smx + 16 * mi + 4 * fq), b4 = *(const LAS f32x4*)(sb + 16 * mi + 4 * fq);
#pragma unroll
          for (int rg_ = 0; rg_ < 4; ++rg_) { const float wi = __expf(mstate - mx4[rg_]); float den = a1[2][rg_] + wi * a2[2][rg_]; den = __shfl(den, lane & 48);
              const float mt = b4[rg_] + mx4[rg_]; const float inv = __builtin_amdgcn_rcpf(fmaxf(fabsf(den), __expf(-mt))); float* hp = HRAW + (tk0 + 16 * mi + 4 * fq + rg_) * RD + mh * 256 + sl * 32 + fr;
              hp[0] = (a1[0][rg_] + wi * a2[0][rg_]) * inv; hp[16] = (a1[1][rg_] + wi * a2[1][rg_]) * inv; } }
        {
#pragma unroll
          for (int a = 0; a < 2; ++a) {
#pragma unroll
              for (int n = 0; n < 3; ++n) st[a][n] = st[a][n] * dec;
#pragma unroll
              for (int ks = 0; ks < 2; ++ks) { const s16x8 A = tr_frag(Lk, 136, 32 * ks + 8 * fq, 16 * (2 * w + a), fr);
#pragma unroll
                  for (int n = 0; n < 3; ++n) st[a][n] = __builtin_amdgcn_mfma_f32_16x16x32_bf16(A, tr_frag(Lvs, VS, 32 * ks + 8 * fq, 16 * n, fr), st[a][n], 0, 0, 0); }
#pragma unroll
              for (int n = 0; n < 3; ++n) *(LAS unsigned long long*)(cTn + (16 * n + fr) * 136 + 16 * (2 * w + a) + 4 * fq) = pack4bf(st[a][n]); } }
        mstate = mnew;
        rw_bar(bcnt, btarget, lane);
    }
#undef ML_LOAD
}

__device__ __forceinline__ float rowsum4(f32x4 v) { return (v[0] + v[1]) + (v[2] + v[3]); }
__device__ __forceinline__ void p5_finalize(Frame& F) {
    const bf16* __restrict__ P = (const bf16*)(F.ws + WS_P); const bf16* __restrict__ AGp = (const bf16*)(F.ws + WS_WAG + 64 * MiB); const float* __restrict__ YRAW = (const float*)(F.ws + WS_YRAW); const float* __restrict__ HRAW = (const float*)(F.ws + WS_HRAW);
    bf16* __restrict__ OA = (bf16*)(F.ws + WS_OA); bf16* __restrict__ OB = (bf16*)(F.ws + WS_OB);
    const int gw = F.bid * P5_NW + F.wave, NGW = F.G * P5_NW, lane = F.lane;
    { const int hq = gw & 3, c0 = (hq * 4 + (lane >> 4)) * 64 + 4 * (lane & 15);
      const f32x4 lnw = *(const f32x4*)(F.in[I_LNW] + c0), lnb = *(const f32x4*)(F.in[I_LNB] + c0); const bf16* __restrict__ BON = (const bf16*)(F.ws + WS_WAG + 128 * MiB);
      v2u bo[2], gb[2]; f32x4 y4[2];
#define P5_LOAD(i_, q_) do { if ((q_) < T * 4) { const int tk_ = (q_) >> 2; bo[i_] = *(const v2u*)(BON + (size_t)tk_ * RD + c0); gb[i_] = *(const v2u*)(AGp + (size_t)tk_ * D + RD + c0); y4[i_] = *(const f32x4*)(YRAW + (size_t)tk_ * RD + c0); } } while (0)
      P5_LOAD(0, gw); P5_LOAD(1, gw + NGW);
      for (int q = gw; q < T * 4; q += 2 * NGW) { const v2u cb0 = bo[0], cg0 = gb[0], cb1 = bo[1], cg1 = gb[1]; const f32x4 cy0 = y4[0], cy1 = y4[1];
          P5_LOAD(0, q + 2 * NGW); P5_LOAD(1, q + 3 * NGW);
#pragma unroll
          for (int i = 0; i < 2; ++i) { const int qq = q + i * NGW; if (qq < T * 4) { const int tk = qq >> 2; const f32x4 bon = i ? UNP4(cb1) : UNP4(cb0), g = i ? UNP4(cg1) : UNP4(cg0), y = i ? cy1 : cy0;
              const float mean = allreduce16(rowsum4(y)) * (1.f / 64.f); const f32x4 dl = y - mean;
              const float var = allreduce16(rowsum4(dl * dl)) * (1.f / 64.f); const float rs = __builtin_amdgcn_rsqf(var + GN_EPS);
              const f32x4 o = (dl * rs * lnw + lnb + bon) * g;
              v2u ov; ov.x = pk2(o[0], o[1]); ov.y = pk2(o[2], o[3]); *(v2u*)(OA + (size_t)tk * RD + c0) = ov; } } }
#undef P5_LOAD
    }
    { const int mh = gw & 3, d0 = mh * 256 + 4 * lane; const f32x4 nw = *(const f32x4*)(F.in[I_MNW] + d0);
      f32x4 hv[2]; v2u po[2];
#define P5B_LOAD(i_, q_) do { if ((q_) < T * 4) { const int tk_ = (q_) >> 2; hv[i_] = *(const f32x4*)(HRAW + (size_t)tk_ * RD + d0); po[i_] = *(const v2u*)(P + (size_t)tk_ * NINP + MLO + 2056 + d0); } } while (0)
      P5B_LOAD(0, gw); P5B_LOAD(1, gw + NGW);
      for (int q = gw; q < T * 4; q += 2 * NGW) { const f32x4 ch0 = hv[0], ch1 = hv[1]; const v2u cp0 = po[0], cp1 = po[1];
          P5B_LOAD(0, q + 2 * NGW); P5B_LOAD(1, q + 3 * NGW);
#pragma unroll
          for (int i = 0; i < 2; ++i) { const int qq = q + i * NGW; if (qq < T * 4) { const int tk = qq >> 2; const f32x4 h4 = i ? ch1 : ch0; const v2u p2 = i ? cp1 : cp0;
              float ss = allreduce16(rowsum4(h4 * h4)); ss += __shfl_xor(ss, 16); ss += __shfl_xor(ss, 32);
              const float rs = __builtin_amdgcn_rsqf(ss * (1.f / 256.f) + NORM_EPS); const f32x4 og = UNP4(p2);
              const float o0 = h4[0] * rs * nw[0] * sigm(og[0]), o1 = h4[1] * rs * nw[1] * sigm(og[1]), o2 = h4[2] * rs * nw[2] * sigm(og[2]), o3 = h4[3] * rs * nw[3] * sigm(og[3]);
              v2u o; o.x = pk2(o0, o1); o.y = pk2(o2, o3); *(v2u*)(OB + (size_t)tk * RD + d0) = o; } } }
#undef P5B_LOAD
    }
}

typedef float f32x16 __attribute__((ext_vector_type(16)));
__device__ __forceinline__ void p8_route(Frame& F) {
    const bf16* X1 = (const bf16*)(F.ws + WS_X1); unsigned char* H2 = (unsigned char*)(F.ws + WS_HN); int* RLIST = (int*)(F.ws + WS_RLIST); float* RWT = (float*)(F.ws + WS_RW);
    const float* RWS = (const float*)(F.ws + WS_RWS); const float* nw = F.in[I_N2W]; const float* rtb = F.in[I_RTB];
    LAS float* part = (LAS float*)F.lds;
    LAS float* ssq = part + 8 * 32 * 33;
    LAS float* lgt = ssq + 256;
    LAS float* srs = lgt + 32 * 33;
    const int lane = F.lane, w = F.wave, i = lane & 31, h = lane >> 5, tid = F.tid;
    for (int tile = F.bid; tile < T / 32; tile += F.G) {
        const int m0 = tile * 32; const bf16* xrow = X1 + (size_t)(m0 + i) * D + 256 * w + 4 * h;
        f32x16 acc;
#pragma unroll
        for (int r_ = 0; r_ < 16; ++r_) acc[r_] = 0.f;
        float ss = 0.f; const float* bp = RWS + (size_t)(256 * w + 4 * h) * NE + i;
#pragma unroll 4
        for (int q = 0; q < 32; ++q) { const v2u xb_ = *(const v2u*)(xrow + 8 * q); const f32x4 xa = UNP4(xb_);
#pragma unroll
            for (int j = 0; j < 4; ++j) acc = __builtin_amdgcn_mfma_f32_32x32x2f32(xa[j], bp[(8 * q + j) * NE], acc, 0, 0, 0);
            ss += (xa[0] * xa[0] + xa[1] * xa[1]) + (xa[2] * xa[2] + xa[3] * xa[3]); }
        ss += __shfl_xor(ss, 32);
        if (h == 0) ssq[w * 32 + i] = ss;
#pragma unroll
        for (int r_ = 0; r_ < 16; ++r_) part[(w * 32 + (r_ & 3) + 8 * (r_ >> 2) + 4 * h) * 33 + i] = acc[r_];
        __syncthreads();
#pragma unroll
        for (int k2 = 0; k2 < 2; ++k2) { const int idx = tid + NTHR * k2, ii = idx >> 5, e = idx & 31; float sm = 0.f, sq = 0.f;
#pragma unroll
            for (int ww = 0; ww < 8; ++ww) { sm += part[(ww * 32 + ii) * 33 + e]; sq += ssq[ww * 32 + ii]; }
            const float rs = 1.f / sqrtf(sq * (1.f / D) + NORM_EPS); lgt[ii * 33 + e] = sm * rs + rtb[e]; if (e == 0) srs[ii] = rs; }
        __syncthreads();
        { const float rs = srs[i] * F8_SX; unsigned char* orow = H2 + (size_t)(m0 + i) * D + 256 * w + 4 * h;
#pragma unroll 8
          for (int q = 0; q < 32; ++q) { const f32x4 n4 = *(const f32x4*)(nw + 256 * w + 4 * h + 8 * q); const v2u xb_ = *(const v2u*)(xrow + 8 * q); const f32x4 hv = UNP4(xb_) * rs * n4; *(unsigned*)(orow + 8 * q) = pk4f8(hv[0], hv[1], hv[2], hv[3]); } }
        if (tid < 32) { const LAS float* lr = lgt + tid * 33; unsigned used = 0u; int idx[4]; float val[4];
#pragma unroll
            for (int s4 = 0; s4 < 4; ++s4) { float best = -INFINITY; int bi = 0;
                for (int e = 0; e < 32; ++e) { const float v = lr[e]; const bool ok = !((used >> e) & 1u) && (v > best); best = ok ? v : best; bi = ok ? e : bi; }
                used |= 1u << bi; idx[s4] = bi; val[s4] = best; }
            const float e1 = __expf(val[1] - val[0]), e2 = __expf(val[2] - val[0]), e3 = __expf(val[3] - val[0]); const float inv = 1.f / (1.f + e1 + e2 + e3);
            const float wv[4] = {inv, e1 * inv, e2 * inv, e3 * inv};
            unsigned pos[4];
#pragma unroll
            for (int s4 = 0; s4 < 4; ++s4) pos[s4] = atomicAdd(F.ctl + CW_CNT + 64 * idx[s4], 1u);
#pragma unroll
            for (int s4 = 0; s4 < 4; ++s4) { RLIST[idx[s4] * ECAP + pos[s4]] = (m0 + tid) * 4 + s4; RWT[idx[s4] * ECAP + pos[s4]] = wv[s4]; } }
        __syncthreads();
    }
}

__device__ __forceinline__ void build_moe_tables(Frame& F) {
    LAS int* MI = (LAS int*)F.MISC;
    __syncthreads();
    if (F.tid < NE) MI[MI_CNT + F.tid] = (int)__hip_atomic_load(F.ctl + CW_CNT + 64 * F.tid, __ATOMIC_RELAXED, __HIP_MEMORY_SCOPE_AGENT);
    __syncthreads();
    if (F.tid == 0) { int mt = 0, cs = 0;
        for (int e = 0; e < NE; ++e) { const int c = MI[MI_CNT + e]; MI[MI_POFF + e] = mt * 256; MI[MI_CST + e] = cs; cs += c;
            const int nt = (c + 255) >> 8; for (int i = 0; i < nt; ++i) { MI[MI_TILE_E + mt + i] = e; MI[MI_TILE_I0 + mt + i] = i * 256; } mt += nt; }
        MI[MI_CST + NE] = cs; MI[MI_MT] = mt; }
    __syncthreads();
}
__device__ __forceinline__ void p9_gather(Frame& F) {
    build_moe_tables(F);
    const LAS int* MI = (const LAS int*)F.MISC; const bf16* H2 = (const bf16*)(F.ws + WS_HN); bf16* XB = (bf16*)(F.ws + WS_XB); const int* RLIST = (const int*)(F.ws + WS_RLIST);
    const int gw = F.bid * NWAVES + F.wave, NGW = F.G * NWAVES, total = MI[MI_CST + NE];
    for (int q = gw; q < total; q += NGW) { int e = 0;
        for (int k = 1; k < NE; ++k) e = (MI[MI_CST + k] <= q) ? k : e;
        const int i = q - MI[MI_CST + e]; const int tok = RLIST[e * ECAP + i] >> 2;
        const v4u* src = (const v4u*)(H2 + (size_t)tok * D) + F.lane; v4u* dst = (v4u*)(XB + (size_t)(MI[MI_POFF + e] + i) * D) + F.lane;
#pragma unroll
        for (int j = 0; j < 4; ++j) dst[64 * j] = src[64 * j]; }
}
__device__ __forceinline__ void p12_final(Frame& F) {
    const bf16* X1 = (const bf16*)(F.ws + WS_X1); const unsigned char* YS = (const unsigned char*)(F.ws + WS_YS); const float* fw = F.in[I_FNW];
    const int gw = F.bid * NWAVES + F.wave, NGW = F.G * NWAVES;
    for (int m = gw; m < T; m += NGW) {
        const v2u* xr = (const v2u*)(X1 + (size_t)m * D) + F.lane; f32x4 v[8]; float s = 0.f;
#pragma unroll
        for (int j = 0; j < 8; ++j) { const v2u xb_ = xr[64 * j]; v[j] = UNP4(xb_);
#pragma unroll
            for (int sl = 0; sl < 4; ++sl) { const int y = ((const int*)(YS + ((size_t)m * 4 + sl) * D))[F.lane + 64 * j];
                const f32x2 ylo = __builtin_amdgcn_cvt_pk_f32_fp8(y, false), yhi = __builtin_amdgcn_cvt_pk_f32_fp8(y, true);
                v[j][0] += ylo[0] * (1.f / F8_SY); v[j][1] += ylo[1] * (1.f / F8_SY); v[j][2] += yhi[0] * (1.f / F8_SY); v[j][3] += yhi[1] * (1.f / F8_SY); }
            s += (v[j][0] * v[j][0] + v[j][1] * v[j][1]) + (v[j][2] * v[j][2] + v[j][3] * v[j][3]); }
        const float rstd = __builtin_amdgcn_rsqf(wave_sum(s) * (1.f / D) + NORM_EPS);
        f32x4* orow = (f32x4*)(F.out + (size_t)m * D) + F.lane;
#pragma unroll
        for (int j = 0; j < 8; ++j) { const f32x4 w = ((const f32x4*)fw)[F.lane + 64 * j]; orow[64 * j] = v[j] * rstd * w; }
    }
}

__global__ void __launch_bounds__(NTHR, 2) mk_fwd(Args args) {
    extern __shared__ __attribute__((aligned(16))) unsigned char lds[];
    Frame F;
    F.lds = (LAS unsigned char*)lds; F.MISC = (volatile LAS unsigned*)(F.lds + MISC_OFF);
    F.tid = threadIdx.x; F.lane = F.tid & 63; F.wave = __builtin_amdgcn_readfirstlane(F.tid >> 6); F.G = gridDim.x; F.bid = blockIdx.x;
    F.in = args.in; F.out = args.out; F.ws = args.ws; F.ctl = (unsigned*)(args.ws + WS_CTL);
    for (int u = F.tid; u < (LDS_BYTES - MISC_OFF) / 4; u += NTHR) ((LAS unsigned*)(F.lds + MISC_OFF))[u] = 0u;
    __syncthreads();
    XcdBarrier bar; bar.bar = F.ctl + CW_BAR; bar.x = 0; bar.st = nullptr;
    if (MK_N_LAUNCHES == 1) bar = xcd_barrier_post(F.ctl + CW_BAR, F.MISC + 8);
    const int lo = args.ph_lo, hi = args.ph_hi;
#define IN(k) (lo <= (k) && (k) < hi)
#ifndef PROBE_PHASE
#define PROBE_PHASE -1
#endif
#define REP(k) ((PROBE_PHASE) == (k) ? 2 : 1)
#ifndef TPROBE
#define TPROBE -1
#endif
#if TPROBE >= 0
    unsigned long long tpA = 0, tpB = 0;
#define TP_A(k) do { if ((k) == TPROBE / 100) tpA = __builtin_amdgcn_s_memrealtime(); } while (0)
#define TP_B(k) do { if ((k) == TPROBE % 100) tpB = __builtin_amdgcn_s_memrealtime(); } while (0)
#else
#define TP_A(k) do {} while (0)
#define TP_B(k) do {} while (0)
#endif
#define SEAM(k) do { if (IN(k) && IN((k) + 1)) xcd_barrier(bar); TP_B(k); } while (0)
    LAS unsigned char* ring = F.lds;
    const LAS int* MI = (const LAS int*)F.MISC;

    static_assert(MK_N_LAUNCHES == 1, "the W_in quantisation needs an in-launch barrier inside phase 0");
    TP_A(0); if (IN(0)) { p0_prologue(F); xcd_barrier(bar); p0b_win(F); } SEAM(0);
    TP_A(1); if (IN(1)) {
        const int ng = F.G > 2 * NCV ? F.G - NCV : F.G;
        if (F.bid < ng) {
            pg8::Gemm g{(const bf16*)(F.ws + WS_HN), (const bf16*)(F.ws + WS_WIN), T, NINP, D / 2}; pg8::StaticOrder S; S.init(T, NINP, ng, F.bid);
            EpiP1I8 E{(bf16*)(F.ws + WS_P), NINP, (const float*)(F.ws + WS_RA), F.ctl + CW_COLMAX};
            pg8::gemm_phase<EpiP1I8, pg8::StaticOrder, true, true, false, true>(ring, g, S, E);
            if (F.tid == 0) __hip_atomic_fetch_add(F.ctl + CW_P1DONE, 1u, __ATOMIC_RELAXED, __HIP_MEMORY_SCOPE_AGENT);
        } else if (F.wave >= CV1_W0) convert_loop(F, F.ctl + CW_CVNEXT, F.ctl + CW_P1DONE, (unsigned)ng, F.lds + F.wave * 9216, 0u, (unsigned)CV_SPLIT);
    } SEAM(1);
    TP_A(2); if (IN(2)) { for (int rep = 0; rep < REP(2); ++rep) p2_lora_in(F); } SEAM(2);
    TP_A(3); if (IN(3)) {
        pg8::Gemm g{(const bf16*)(F.ws + WS_LIN), (const bf16*)(F.ws + WS_WL), T, 3072, 512}; pg8::StaticOrder S; S.init(T, 3072, F.G, F.bid);
        EpiLora E{(float*)(F.ws + WS_WAG), (bf16*)(F.ws + WS_WAG + 64 * MiB), F.in[I_W0], F.in[I_A0]};
        pg8::gemm_phase<EpiLora, pg8::StaticOrder, true, true>(ring, g, S, E);
    } SEAM(3);
    TP_A(4); if (IN(4)) {
        { LAS unsigned* ctl2 = (LAS unsigned*)F.MISC + 16;
          TP_A(14); TP_A(15); TP_A(16); if (F.wave < 4) { TP_B(14); TP_B(16); unsigned bt = 0u; for (int rep = 0; rep < REP(40); ++rep) for (int u = F.bid; u < 256; u += F.G) rwkv_chunk_unit(F, u, (LAS unsigned char*)F.MISC + 256, ctl2, bt); TP_B(15); }
          else { Frame F2 = F; F2.tid = F.tid - 256; F2.wave = F.wave - 4; F2.lds = F.lds + 45056; unsigned bt = 0u;
                 for (int rep = 0; rep < REP(41); ++rep) for (int u = F.bid; u < 256; u += F.G) mlstm_scan_unit(F2, u, ctl2 + 2, bt);
                 rw_bar(ctl2 + 2, bt, F2.lane); TP_B(15); TP_B(16); }
          if (F.wave >= CV_W0) convert_loop(F, F.ctl + CW_CVNEXT, nullptr, 0u, F.lds + 45056 + (F.wave - 4) * 9216, 0u, (unsigned)CV_SPLIT);
          if (F.wave >= 4) TP_B(14);
          __syncthreads(); }
    } SEAM(4);
    TP_A(5); if (IN(5)) { if (F.wave < P5_NW) { for (int rep = 0; rep < REP(5); ++rep) p5_finalize(F); }
                 else convert_loop(F, F.ctl + CW_CVNEXT2, nullptr, 0u, F.lds + F.wave * 9216, (unsigned)CV_SPLIT, (unsigned)CV_ITEMS); }     SEAM(5);
    TP_A(6); if (IN(6)) {
        { pg8::Gemm g{(const bf16*)(F.ws + WS_OA), (const bf16*)(F.ws + WS_WA), T, D, RD}; pg8::StaticOrder S; S.init(T, D, F.G, F.bid);
          EpiGateA E{(bf16*)(F.ws + WS_TMP), (const bf16*)(F.ws + WS_P), F.in[I_BGATE]};
          pg8::gemm_phase<EpiGateA, pg8::StaticOrder, true, true>(ring, g, S, E); }
        VM_WAIT(); __syncthreads();
        { pg8::Gemm g{(const bf16*)(F.ws + WS_OB), (const bf16*)(F.ws + WS_WB), T, D, RD}; pg8::StaticOrder S; S.init(T, D, F.G, F.bid);
          EpiGateB E{(const bf16*)(F.ws + WS_TMP), (bf16*)(F.ws + WS_MRG), (const bf16*)(F.ws + WS_P), F.in[I_BGATE]};
          pg8::gemm_phase<EpiGateB, pg8::StaticOrder, true, true>(ring, g, S, E); }
    } SEAM(6);
    TP_A(7); if (IN(7)) {
        pg8::Gemm g{(const bf16*)(F.ws + WS_MRG), (const bf16*)(F.ws + WS_WO), T, D, D}; pg8::StaticOrder S; S.init(T, D, F.G, F.bid);
        EpiResid E{F.in[I_X], (bf16*)(F.ws + WS_X1)};
        pg8::gemm_phase<EpiResid, pg8::StaticOrder, true, true>(ring, g, S, E);
    } SEAM(7);
    TP_A(8); if (IN(8)) { p8_route(F); } SEAM(8);
    TP_A(10); if (IN(10)) {
        build_moe_tables(F);
        const int mt = MI[MI_MT];
        pg8::Gemm g{(const bf16*)(F.ws + WS_HN), (const bf16*)(F.ws + WS_WGU), mt * 256, 2 * FF, D / 2};
        MoeGatherOrder S; S.init(mt * 256, 2 * FF, F.G, F.bid); S.tile_e = MI + MI_TILE_E; S.estride = (size_t)2 * FF * D;
        S.tile_i0 = MI + MI_TILE_I0; S.cnt = MI + MI_CNT; S.rlist = (const int*)(F.ws + WS_RLIST); S.rowoff = (LAS unsigned*)F.MISC + MI_ROWOFF; S.rowbytes = D;
        EpiSwiGLU E{(unsigned char*)(F.ws + WS_ACT), F.in[I_BGU], MI + MI_TILE_E};
        pg8::gemm_phase<EpiSwiGLU, MoeGatherOrder, true, true, true>(ring, g, S, E);
    } SEAM(10);
    TP_A(11); if (IN(11)) {
        build_moe_tables(F);
        const int mt = MI[MI_MT];
        pg8::Gemm g{(const bf16*)(F.ws + WS_ACT), (const bf16*)(F.ws + WS_WDN), mt * 256, D, FF / 2};
        MoeOrder S; S.init(mt * 256, D, F.G, F.bid); S.tile_e = MI + MI_TILE_E; S.estride = (size_t)D * FF;
        LAS int* rowdst = (LAS int*)F.MISC + MI_ROWOFF; LAS float* rowwt = (LAS float*)F.MISC + MI_ROWOFF + 10 * 256;
        fill_down_tables(F, S, rowdst, rowwt);
        EpiDown E{(unsigned char*)(F.ws + WS_YS), F.in[I_BDN], MI + MI_TILE_E, rowdst, rowwt};
        pg8::gemm_phase<EpiDown, MoeOrder, true, true, true>(ring, g, S, E);
    } SEAM(11);
    TP_A(12); if (IN(12)) { for (int rep = 0; rep < REP(12); ++rep) p12_final(F); } TP_B(12);
#if TPROBE >= 0
    { const unsigned long long tend = __builtin_amdgcn_s_memrealtime() + 4ull * (tpB - tpA); while (__builtin_amdgcn_s_memrealtime() < tend) __builtin_amdgcn_s_sleep(8); }
#endif
#undef IN
#undef SEAM
}

extern "C" void kernel_launch(void* const* d_in, const int* in_sizes, int n_in, void* d_out, int out_size, void* d_ws, size_t ws_size, hipStream_t stream) {
    static int grid = 0;
    if (grid == 0) {
        if (n_in != 30 || out_size != T * D || ws_size < WS_END) { fprintf(stderr, "kernel_launch: unexpected problem (n_in %d, out %d, ws %zu)\n", n_in, out_size, ws_size); grid = -1; return; }
        int dev = 0, cus = 0, per_cu = 0;
        if (hipGetDevice(&dev) != hipSuccess || hipDeviceGetAttribute(&cus, hipDeviceAttributeMultiprocessorCount, dev) != hipSuccess) { grid = -1; return; }
        if (hipFuncSetAttribute((const void*)mk_fwd, hipFuncAttributeMaxDynamicSharedMemorySize, LDS_BYTES) != hipSuccess) { fprintf(stderr, "kernel_launch: hipFuncSetAttribute failed\n"); grid = -1; return; }
        if (hipOccupancyMaxActiveBlocksPerMultiprocessor(&per_cu, (const void*)mk_fwd, NTHR, LDS_BYTES) != hipSuccess || per_cu < 1) fprintf(stderr, "kernel_launch: occupancy query says %d\n", per_cu);
        (void)hipGetLastError();
        grid = cus;
    }
    if (grid < 0) return;
    if (hipMemsetAsync((char*)d_ws + WS_CTL, 0, CTL_ZERO_BYTES, stream) != hipSuccess) return;
    Args a{};
    for (int i = 0; i < 30; ++i) a.in[i] = (const float*)d_in[i];
    a.out = (float*)d_out; a.ws = (unsigned char*)d_ws;
    for (int li = 0; li < MK_N_LAUNCHES; ++li) {
        a.ph_lo = (MK_N_LAUNCHES == 1) ? 0 : li; a.ph_hi = (MK_N_LAUNCHES == 1) ? NPH : li + 1;
        hipLaunchKernelGGL(mk_fwd, dim3(grid), dim3(NTHR), LDS_BYTES, stream, a);
        const hipError_t le = hipPeekAtLastError();
        if (le != hipSuccess) { fprintf(stderr, "kernel_launch: launch %d failed: %s\n", li, hipGetErrorName(le)); break; }
    }
}
```

```cpp
#include <hip/hip_runtime.h>
#include <cstdio>
#include <cstdint>

#define MK_N_LAUNCHES 1
#define PROBE_PHASE -1
namespace pg8 {
#define PG8_LAS __attribute__((address_space(3)))
typedef unsigned short bf16_t;
typedef short bf16x8 __attribute__((ext_vector_type(8)));
typedef float f32x4 __attribute__((ext_vector_type(4)));
typedef unsigned u32x4 __attribute__((ext_vector_type(4)));
constexpr int BM = 256, BK = 64, HALF = 128, HTB = HALF * BK * 2  , STAGE_BYTES = 8 * HTB, NXCD = 8, WGM = 8;

__host__ __device__ __forceinline__ int lds_byte(int r, int c) { const int st = (r >> 4) * 2 + (c >> 5), rr = r & 15, cc = c & 31, ob = rr * 64 + cc * 2; return st * 1024 + (ob ^ (((ob >> 9) & 1) << 5)); }
__host__ __device__ __forceinline__ void stage_rc(int b, int& R, int& C) { const int st = b / 1024, sb = b % 1024, swz = sb ^ (((sb >> 9) & 1) << 5); R = (st >> 1) * 16 + swz / 64; C = (st & 1) * 32 + (swz % 64) / 2; }
__host__ __device__ __forceinline__ int perm32(int rho) { const int n = rho >> 4, i = rho & 15; return 8 * (i >> 2) + 4 * n + (i & 3); }

struct Unit { int pm, pn, ord; };
struct Gemm { const bf16_t* A; const bf16_t* Bt; int M, N, K; };

struct StaticOrder {
    int nM, nN, nwg, G, c;
    __host__ __device__ void init(int M, int N, int G_, int c_) { nM = M / BM; nN = N / BM; nwg = nM * nN; G = G_; c = c_; }
    __host__ __device__ bool next(int i, Unit& u) const {
        const long L = (long)i * G + c; if (L >= nwg) return false;
        int wgid = (int)L; { const int q = nwg / NXCD, r = nwg % NXCD, xcd = wgid % NXCD, off = wgid / NXCD; wgid = (xcd < r ? xcd * (q + 1) : r * (q + 1) + (xcd - r) * q) + off; }
        const int nig = WGM * nN, gid = wgid / nig, fm = gid * WGM, gsz = (nM - fm) < WGM ? (nM - fm) : WGM;
        u.pm = fm + ((wgid % nig) % gsz); u.pn = (wgid % nig) / gsz; u.ord = i; return true;
    }
    __device__ __forceinline__ void a_ready(const Unit&) const {}
    static constexpr bool GATHER = false;
    __device__ __forceinline__ void fill_all() const {}
    __device__ __forceinline__ unsigned row_off(int, int) const { return 0u; }
    __device__ __forceinline__ void done(const Unit&) const {}
    __device__ __forceinline__ size_t a_off(const Unit& u, size_t tstep) const { return (size_t)u.pm * tstep; }
    __device__ __forceinline__ size_t b_off(const Unit& u, size_t tstep) const { return (size_t)u.pn * tstep; }
};
__device__ __forceinline__ unsigned cvt_pk_bf16(float lo, float hi) { unsigned r; asm volatile("v_cvt_pk_bf16_f32 %0, %1, %2" : "=v"(r) : "v"(lo), "v"(hi)); return r; }
typedef int v8i32 __attribute__((ext_vector_type(8)));
typedef int v4i32 __attribute__((ext_vector_type(4)));
__device__ __forceinline__ v8i32 cat8(bf16x8 lo, bf16x8 hi) { const v4i32 a = __builtin_bit_cast(v4i32, lo), b = __builtin_bit_cast(v4i32, hi); return __builtin_shufflevector(a, b, 0, 1, 2, 3, 4, 5, 6, 7); }
template <class Epi, class Sched, bool ALIGN_EPI = false, bool SP2 = false, bool FP8 = false, bool I8 = false>
__device__ __forceinline__ void gemm_phase(PG8_LAS unsigned char* lds, const Gemm g, const Sched& S, const Epi& E) {
    const int tid = threadIdx.x, wid = __builtin_amdgcn_readfirstlane(tid >> 6), lane = tid & 63, wr = wid >> 2, wc = wid & 3, fr = lane & 15, fq = lane >> 4;
    const int K = g.K, nt = K / BK;
    unsigned voffA[2], voffB[2];
#pragma unroll
    for (int i = 0; i < 2; ++i) { int R, C; stage_rc(tid * 16 + i * 8192, R, C); const int Rb = Epi::PERM ? ((R & ~31) + perm32(R & 31)) : R;
        voffA[i] = (unsigned)(R * K + C) * 2u; voffB[i] = (unsigned)(Rb * K + C) * 2u; }
    unsigned voffA1[2]; int rselA[2]; unsigned cselA[2];
#pragma unroll
    for (int i = 0; i < 2; ++i) { int R, C; stage_rc(tid * 16 + i * 8192, R, C); rselA[i] = R; cselA[i] = (unsigned)C * 2u; voffA1[i] = voffA[i]; }
    const size_t kstep = (size_t)(BK * 2);
    const size_t hstep = (size_t)HALF * K * 2;
    const size_t tstep = 2 * hstep;
    const size_t hstepA = Sched::GATHER ? (size_t)0 : hstep;
#define PG8_ROWS(_u) do { _Pragma("unroll") for (int _i = 0; _i < 2; ++_i) { voffA[_i] = S.row_off((_u), rselA[_i]) + cselA[_i]; voffA1[_i] = S.row_off((_u), HALF + rselA[_i]) + cselA[_i]; } } while (0)
    const unsigned ldsw = (unsigned)wid * 1024u;
    const int aoff = lds_byte(wr * 64 + fr, fq * 8), boff = lds_byte(wc * 32 + fr, fq * 8);
#define PG8_SA(b, h) (((b) * 2 + (h)) * HTB)
#define PG8_SB(b, h) ((4 + (b) * 2 + (h)) * HTB)
#define PG8_STAGE(bufoff, gbase, voff) do { _Pragma("unroll") for (int _i = 0; _i < 2; ++_i) \
        __builtin_amdgcn_global_load_lds((const unsigned*)((const char*)(gbase) + (voff)[_i]), (PG8_LAS unsigned*)(lds + (bufoff) + ldsw + _i * 8192), 16, 0, 0); } while (0)
#define PG8_LDA(dst, b, h) do { if constexpr (FP8) { _Pragma("unroll") for (int m = 0; m < 4; ++m) dst##8[m] = cat8(*(const PG8_LAS bf16x8*)(lds + PG8_SA(b, h) + aoff + m * 2048), *(const PG8_LAS bf16x8*)(lds + PG8_SA(b, h) + aoff + m * 2048 + 1024)); } \
        else { _Pragma("unroll") for (int m = 0; m < 4; ++m) _Pragma("unroll") for (int k = 0; k < 2; ++k) dst[m][k] = *(const PG8_LAS bf16x8*)(lds + PG8_SA(b, h) + aoff + m * 2048 + k * 1024); } } while (0)
#define PG8_LDB(dst, b, h) do { if constexpr (FP8) { _Pragma("unroll") for (int n = 0; n < 2; ++n) dst##8[n] = cat8(*(const PG8_LAS bf16x8*)(lds + PG8_SB(b, h) + boff + n * 2048), *(const PG8_LAS bf16x8*)(lds + PG8_SB(b, h) + boff + n * 2048 + 1024)); } \
        else { _Pragma("unroll") for (int n = 0; n < 2; ++n) _Pragma("unroll") for (int k = 0; k < 2; ++k) dst[n][k] = *(const PG8_LAS bf16x8*)(lds + PG8_SB(b, h) + boff + n * 2048 + k * 1024); } } while (0)
#define PG8_MMA(ai, bj, At, Bt) do { __builtin_amdgcn_s_setprio(1); if constexpr (FP8) { _Pragma("unroll") for (int m = 0; m < 4; ++m) _Pragma("unroll") for (int n = 0; n < 2; ++n) \
        asm volatile("v_mfma_scale_f32_16x16x128_f8f6f4 %0, %1, %2, %0, %3, %3 op_sel_hi:[0,0,0]" : "+v"(acc[ai][bj][m][n]) : "v"(Bt##8[n]), "v"(At##8[m]), "v"(f8scale)); } else { \
        _Pragma("unroll") for (int m = 0; m < 4; ++m) _Pragma("unroll") for (int n = 0; n < 2; ++n) _Pragma("unroll") for (int k = 0; k < 2; ++k) { \
        if constexpr (I8) acc[ai][bj][m][n] = __builtin_bit_cast(f32x4, __builtin_amdgcn_mfma_i32_16x16x64_i8(__builtin_bit_cast(v4i32, Bt[n][k]), __builtin_bit_cast(v4i32, At[m][k]), __builtin_bit_cast(v4i32, acc[ai][bj][m][n]), 0, 0, 0)); \
        else acc[ai][bj][m][n] = __builtin_amdgcn_mfma_f32_16x16x32_bf16(Bt[n][k], At[m][k], acc[ai][bj][m][n], 0, 0, 0); } } __builtin_amdgcn_s_setprio(0); } while (0)
#define PG8_WAIT_V(n) asm volatile("s_waitcnt vmcnt(" #n ")" ::: "memory")
#define PG8_WAIT_L(n) asm volatile("s_waitcnt lgkmcnt(" #n ")" ::: "memory")
#define PG8_BAR __builtin_amdgcn_s_barrier()
#define PG8_SCHED __builtin_amdgcn_sched_barrier(0)
    Unit cur, nxt; int ui = 0;
    if (!S.next(0, cur)) return;
    f32x4 acc[2][2][4][2];
#pragma unroll
    for (int a = 0; a < 2; ++a)
#pragma unroll
        for (int b = 0; b < 2; ++b)
#pragma unroll
            for (int m = 0; m < 4; ++m)
#pragma unroll
                for (int n = 0; n < 2; ++n) acc[a][b][m][n] = (f32x4){0.f, 0.f, 0.f, 0.f};
    const int f8scale = 0x7f7f7f7f;
    bf16x8 At[4][2], B0[2][2], B1[2][2]; v8i32 At8[4], B08[2], B18[2];
    const char* cA = (const char*)g.A + S.a_off(cur, tstep); const char* cB = (const char*)g.Bt + S.b_off(cur, tstep);
    S.a_ready(cur);
    if constexpr (Sched::GATHER) { S.fill_all(); asm volatile("s_waitcnt vmcnt(0) lgkmcnt(0)" ::: "memory"); __builtin_amdgcn_s_barrier(); asm volatile("" ::: "memory"); PG8_ROWS(0); }
    if constexpr (SP2) {
        PG8_STAGE(PG8_SB(0, 0), cB, voffB); PG8_STAGE(PG8_SB(0, 1), cB + hstep, voffB); PG8_STAGE(PG8_SA(0, 0), cA, voffA); PG8_STAGE(PG8_SA(0, 1), cA + hstepA, voffA1);
        if (wr == 1) PG8_BAR;
        PG8_WAIT_V(2); PG8_BAR;
        PG8_STAGE(PG8_SB(1, 0), cB + kstep, voffB); PG8_STAGE(PG8_SA(1, 0), cA + kstep, voffA); PG8_STAGE(PG8_SB(1, 1), cB + hstep + kstep, voffB);
        PG8_WAIT_V(6); PG8_BAR;
    } else {
        PG8_STAGE(PG8_SB(0, 0), cB, voffB); PG8_STAGE(PG8_SA(0, 0), cA, voffA); PG8_STAGE(PG8_SB(0, 1), cB + hstep, voffB); PG8_STAGE(PG8_SA(0, 1), cA + hstepA, voffA1);
        if (wr == 1) PG8_BAR;
        PG8_WAIT_V(4); PG8_BAR;
        PG8_STAGE(PG8_SB(1, 0), cB + kstep, voffB); PG8_STAGE(PG8_SA(1, 0), cA + kstep, voffA); PG8_STAGE(PG8_SB(1, 1), cB + hstep + kstep, voffB);
        PG8_WAIT_V(6); PG8_BAR;
    }
    for (;;) {
        const bool has_next = S.next(ui + 1, nxt);
        const char* nA = has_next ? (const char*)g.A + S.a_off(nxt, tstep) : cA; const char* nB = has_next ? (const char*)g.Bt + S.b_off(nxt, tstep) : cB;
        for (int t = 0; t < nt; t += 2) {
            const bool last = (t == nt - 2);
            const char* a1 = cA + (size_t)(t + 1) * kstep;
            const char* a2 = last ? nA : cA + (size_t)(t + 2) * kstep; const char* b2 = last ? nB : cB + (size_t)(t + 2) * kstep;
            const char* a3 = a2 + kstep; const char* b3 = b2 + kstep;
            if (last && has_next) S.a_ready(nxt);
            if constexpr (SP2) {
            PG8_LDB(B0, 0, 0); PG8_LDB(B1, 0, 1); PG8_SCHED; PG8_LDA(At, 0, 0); PG8_STAGE(PG8_SA(1, 1), a1 + hstepA, voffA1);
            PG8_WAIT_V(8); PG8_WAIT_L(0); PG8_BAR; PG8_MMA(0, 0, At, B0); PG8_MMA(0, 1, At, B1); PG8_BAR; PG8_SCHED;
            if constexpr (Sched::GATHER) { if (last && has_next) PG8_ROWS(ui + 1); }
            PG8_LDA(At, 0, 1); PG8_STAGE(PG8_SB(0, 0), b2, voffB); PG8_STAGE(PG8_SB(0, 1), b2 + hstep, voffB); PG8_STAGE(PG8_SA(0, 0), a2, voffA);
            PG8_WAIT_V(8); PG8_WAIT_L(0); PG8_BAR; PG8_MMA(1, 0, At, B0); PG8_MMA(1, 1, At, B1); PG8_BAR; PG8_SCHED;
            PG8_LDB(B0, 1, 0); PG8_LDB(B1, 1, 1); PG8_SCHED; PG8_LDA(At, 1, 0); PG8_STAGE(PG8_SA(0, 1), a2 + hstepA, voffA1);
            PG8_WAIT_V(8); PG8_WAIT_L(0); PG8_BAR; PG8_MMA(0, 0, At, B0); PG8_MMA(0, 1, At, B1); PG8_BAR; PG8_SCHED;
            PG8_LDA(At, 1, 1); PG8_STAGE(PG8_SB(1, 0), b3, voffB); PG8_STAGE(PG8_SB(1, 1), b3 + hstep, voffB); PG8_STAGE(PG8_SA(1, 0), a3, voffA);
            PG8_WAIT_V(8); PG8_WAIT_L(0); PG8_BAR; PG8_MMA(1, 0, At, B0); PG8_MMA(1, 1, At, B1); PG8_BAR; PG8_SCHED;
            } else {
            PG8_LDB(B0, 0, 0); PG8_SCHED; PG8_LDA(At, 0, 0); PG8_STAGE(PG8_SA(1, 1), a1 + hstepA, voffA1);
            PG8_WAIT_L(8); PG8_BAR; PG8_WAIT_L(0); PG8_MMA(0, 0, At, B0); PG8_BAR; PG8_SCHED;
            PG8_LDB(B1, 0, 1); PG8_STAGE(PG8_SB(0, 0), b2, voffB);
            PG8_BAR; PG8_WAIT_L(0); PG8_MMA(0, 1, At, B1); PG8_BAR;
            PG8_LDA(At, 0, 1); PG8_STAGE(PG8_SA(0, 0), a2, voffA);
            PG8_BAR; PG8_WAIT_L(0); PG8_MMA(1, 0, At, B0); PG8_BAR; PG8_SCHED;
            PG8_STAGE(PG8_SB(0, 1), b2 + hstep, voffB);
            PG8_WAIT_V(6); PG8_BAR; PG8_MMA(1, 1, At, B1); PG8_BAR;
            PG8_LDB(B0, 1, 0); PG8_SCHED; PG8_LDA(At, 1, 0); PG8_STAGE(PG8_SA(0, 1), a2 + hstepA, voffA1);
            PG8_WAIT_L(8); PG8_BAR; PG8_WAIT_L(0); PG8_MMA(0, 0, At, B0); PG8_BAR; PG8_SCHED;
            PG8_LDB(B1, 1, 1); PG8_STAGE(PG8_SB(1, 0), b3, voffB);
            PG8_BAR; PG8_WAIT_L(0); PG8_MMA(0, 1, At, B1); PG8_BAR;
            PG8_LDA(At, 1, 1); PG8_STAGE(PG8_SA(1, 0), a3, voffA);
            PG8_BAR; PG8_WAIT_L(0); PG8_MMA(1, 0, At, B0); PG8_BAR; PG8_SCHED;
            PG8_STAGE(PG8_SB(1, 1), b3 + hstep, voffB);
            PG8_WAIT_V(6); PG8_BAR; PG8_MMA(1, 1, At, B1); PG8_BAR;
            }
        }
        if constexpr (ALIGN_EPI) { if (wr == 0) PG8_BAR; }
        if constexpr (FP8) { asm volatile("s_nop 15\n\ts_nop 15" ::: "memory"); }
        if constexpr (!Epi::AFTER_DRAIN) { E(acc, cur, wr, wc, fr, fq); S.done(cur); }
        if (!has_next) break;
#pragma unroll
        for (int a = 0; a < 2; ++a)
#pragma unroll
            for (int b = 0; b < 2; ++b)
#pragma unroll
                for (int m = 0; m < 4; ++m)
#pragma unroll
                    for (int n = 0; n < 2; ++n) acc[a][b][m][n] = (f32x4){0.f, 0.f, 0.f, 0.f};
        cur = nxt; cA = nA; cB = nB; ++ui;
        if constexpr (ALIGN_EPI) { if (wr == 1) PG8_BAR; }
    }
    PG8_WAIT_V(0);
    if constexpr (!ALIGN_EPI) { if (wr == 0) PG8_BAR; }
    PG8_BAR;
    if constexpr (Epi::AFTER_DRAIN) { E.fused(acc, cur, wr, wc, fr, fq, lds, wid, lane); S.done(cur); }
#undef PG8_ROWS
#undef PG8_SA
#undef PG8_SB
#undef PG8_STAGE
#undef PG8_LDA
#undef PG8_LDB
#undef PG8_MMA
#undef PG8_WAIT_V
#undef PG8_WAIT_L
#undef PG8_BAR
#undef PG8_SCHED
}
}

#ifndef MK_N_LAUNCHES
#define MK_N_LAUNCHES 1
#endif
#define GAS __attribute__((address_space(1)))
#define LAS __attribute__((address_space(3)))
typedef unsigned short bf16;
typedef unsigned v4u __attribute__((ext_vector_type(4)));
typedef unsigned v2u __attribute__((ext_vector_type(2)));
typedef float f32x4 __attribute__((ext_vector_type(4)));
typedef float f32x2 __attribute__((ext_vector_type(2)));

constexpr int NWAVES = 8, NTHR = 512;
constexpr int NPH = 13;
constexpr int D = 2048, BATCH = 8, SEQ = 2048, T = BATCH * SEQ;
constexpr int NIN = 10696, NINP = 10752;
constexpr int MLO = 3520, GTO = 6600;
constexpr int RH = 16, RD = 1024;
constexpr int MH = 4;
constexpr int NE = 32, FF = 2048, ECAP = 16384, PMAX = 65536 + NE * 256, MTMAX = PMAX / 256;
constexpr float NORM_EPS = 1e-6f, GN_EPS = 64e-5f;
constexpr size_t MiB = 1u << 20;
constexpr size_t WS_CTL = 0, CTL_ZERO_BYTES = 1 * MiB;
constexpr size_t WS_WIN = 1 * MiB, WS_WA = 43 * MiB, WS_WB = 47 * MiB, WS_WO = 51 * MiB, WS_WL = 59 * MiB;
constexpr size_t WS_RLIST = 62 * MiB, WS_RW = 64 * MiB, WS_RWS = 2787 * MiB, WS_RA = 2787 * MiB + 512 * 1024;
constexpr size_t WS_WGU = 66 * MiB, WS_WDN = 578 * MiB, WS_HN = 834 * MiB, WS_P = 898 * MiB, WS_LIN = 1234 * MiB, WS_WAG = 1250 * MiB;
constexpr size_t WS_YRAW = 1442 * MiB, WS_HRAW = 1506 * MiB, WS_OA = 1570 * MiB, WS_OB = 1602 * MiB, WS_TMP = 1634 * MiB, WS_MRG = 1762 * MiB;
constexpr size_t WS_QKC = WS_TMP, WS_GLF = WS_TMP + 64 * MiB;
constexpr size_t WS_X1 = 1826 * MiB, WS_XB = 1954 * MiB, WS_ACT = 2242 * MiB, WS_YS = 2530 * MiB, WS_END = 2788 * MiB;
constexpr int CW_BAR = 4096;
constexpr int CW_CVNEXT = 8192, CW_P1DONE = 8192 + 64, CW_CVNEXT2 = 8192 + 192;
constexpr int CV_W0 = 6, CV1_W0 = 4;
constexpr int NCV = 64;
constexpr int CW_COLMAX = 32768;
constexpr int CW_CNT = 16384;
constexpr int RING_BYTES = 131072, MISC_OFF = RING_BYTES, LDS_BYTES = RING_BYTES + 8192 + 20 * 1024;
constexpr int MI_TILE_E = 64, MI_TILE_I0 = 64 + 320, MI_CNT = 64 + 640, MI_POFF = MI_CNT + 32, MI_CST = MI_POFF + 32, MI_MT = MI_CST + 40, MI_ROWOFF = 2048;

#define LDS_WAIT() asm volatile("s_waitcnt lgkmcnt(0)" ::: "memory")
#define VM_WAIT() asm volatile("s_waitcnt vmcnt(0)" ::: "memory")
__device__ __forceinline__ float bf2f(bf16 v) { return __uint_as_float(((unsigned)v) << 16); }
__device__ __forceinline__ unsigned f2bf(float f) { unsigned u = __float_as_uint(f); return (u + 0x7fffu + ((u >> 16) & 1u)) >> 16; }
typedef __bf16 bf16x2_t __attribute__((ext_vector_type(2)));
__device__ __forceinline__ unsigned pk2(float lo, float hi) { const f32x2 v = {lo, hi}; const bf16x2_t b = __builtin_convertvector(v, bf16x2_t); return __builtin_bit_cast(unsigned, b); }
__device__ __forceinline__ unsigned pk4f8(float a, float b, float c, float d) { int r = 0; r = __builtin_amdgcn_cvt_pk_fp8_f32(a, b, r, false); r = __builtin_amdgcn_cvt_pk_fp8_f32(c, d, r, true); return (unsigned)r; }
constexpr float F8_SX = 8.f, F8_SW = 256.f, F8_SA = 4.f, F8_SY = 16.f;
__device__ __forceinline__ unsigned pk4i8(float a, float b, float c, float d) {
    const int ia = (int)__builtin_rintf(a), ib = (int)__builtin_rintf(b), ic = (int)__builtin_rintf(c), id = (int)__builtin_rintf(d);
    return (unsigned)(ia & 255) | ((unsigned)(ib & 255) << 8) | ((unsigned)(ic & 255) << 16) | ((unsigned)id << 24); }
__device__ __forceinline__ float wave_max(float v) {
#pragma unroll
    for (int o = 1; o < 64; o <<= 1) v = fmaxf(v, __shfl_xor(v, o));
    return v;
}
__device__ __forceinline__ float wave_sum(float v) {
#pragma unroll
    for (int o = 1; o < 64; o <<= 1) v += __shfl_xor(v, o);
    return v;
}
#define UNP4(v) ((f32x4){__uint_as_float((v).x << 16), __uint_as_float((v).x & 0xffff0000u), __uint_as_float((v).y << 16), __uint_as_float((v).y & 0xffff0000u)})
__device__ __forceinline__ float sigm(float x) { return __builtin_amdgcn_rcpf(1.f + __expf(-x)); }
template <int CTRL> __device__ __forceinline__ float dppf(float x) { return __builtin_bit_cast(float, __builtin_amdgcn_mov_dpp(__builtin_bit_cast(int, x), CTRL, 0xf, 0xf, true)); }
__device__ __forceinline__ float allreduce16(float x) { x += dppf<0x128>(x); x += dppf<0x124>(x); x += dppf<0x4E>(x); x += dppf<0xB1>(x); return x; }

#define XB_TMO      128
#define XB_XCNT(j)  (256  + 64 * (j))
#define XB_XSUB(j)  (1280 + 64 * (j))
#define XB_XGEN(j)  (2304 + 64 * (j))
#define XB_TOP      3328
#define XB_TOPGEN   3392
#define XCD_BAR_WORDS 3456
#define XB_SPIN_CAP (1u << 18)
__device__ __forceinline__ unsigned xb_ld(unsigned* p)              { return __hip_atomic_load(p, __ATOMIC_RELAXED, __HIP_MEMORY_SCOPE_AGENT); }
__device__ __forceinline__ unsigned xb_add(unsigned* p, unsigned v) { return __hip_atomic_fetch_add(p, v, __ATOMIC_RELAXED, __HIP_MEMORY_SCOPE_AGENT); }
__device__ __forceinline__ unsigned xb_xcc_id() { return (unsigned)__builtin_amdgcn_s_getreg((3 << 11) | 20) & 0xFu; }
#define XB_SPIN(cond, bar) do { unsigned _sp = 0; while (cond) { __builtin_amdgcn_s_sleep(1); \
    if ((++_sp & 255u) == 0u) { if (xb_ld(&(bar)[XB_TMO])) break; if (_sp > XB_SPIN_CAP) { atomicAdd(&(bar)[XB_TMO], 1u); break; } } } } while (0)
struct XcdBarrier { unsigned* bar; unsigned x; volatile LAS unsigned* st; };
__device__ __forceinline__ XcdBarrier xcd_barrier_post(unsigned* bar, volatile LAS unsigned* st) {
    XcdBarrier b; b.bar = bar; b.x = xb_xcc_id(); b.st = st;
    if (threadIdx.x == 0) (void)xb_add(&bar[XB_XCNT(b.x)], 1u);
    return b;
}
__device__ __forceinline__ void xcd_barrier_complete(unsigned* bar, unsigned x, unsigned& nloc, unsigned& nx) {
    const unsigned G = gridDim.x * gridDim.y * gridDim.z;
    unsigned sum, cnt, mine, sp = 0u;
    for (;;) {
        sum = 0u; cnt = 0u; mine = 0u;
#pragma unroll
        for (unsigned j = 0; j < 16; ++j) { const unsigned c = xb_ld(&bar[XB_XCNT(j)]); sum += c; cnt += (c > 0u) ? 1u : 0u; mine = (j == x) ? c : mine; }
        if (sum == G) break;
        __builtin_amdgcn_s_sleep(1);
        if ((++sp & 255u) == 0u) { if (xb_ld(&bar[XB_TMO])) break; if (sp > XB_SPIN_CAP) { atomicAdd(&bar[XB_TMO], 1u); break; } }
    }
    nloc = mine > 0u ? mine : 1u; nx = cnt > 0u ? cnt : 1u;
}
__device__ __forceinline__ void xcd_barrier(const XcdBarrier& b) {
    asm volatile("s_waitcnt vmcnt(0)" ::: "memory");
    __syncthreads();
    if (threadIdx.x == 0) {
        unsigned* bar = b.bar;
        __builtin_amdgcn_s_waitcnt(0);
        unsigned nloc = b.st[0], nx = b.st[1];
        if (nloc == 0u) { xcd_barrier_complete(bar, b.x, nloc, nx); b.st[0] = nloc; b.st[1] = nx; }
        const unsigned old = xb_add(&bar[XB_XSUB(b.x)], 1u);
        const unsigned gen = old / nloc;
        if (old + 1u == (gen + 1u) * nloc) {
            __builtin_amdgcn_fence(__ATOMIC_RELEASE, "agent");
            asm volatile("s_waitcnt vmcnt(0)" ::: "memory");
            const unsigned og = xb_add(&bar[XB_TOP], 1u);
            const unsigned tg = og / nx;
            if (og + 1u == (tg + 1u) * nx) xb_add(&bar[XB_TOPGEN], 1u);
            else XB_SPIN(xb_ld(&bar[XB_TOPGEN]) == tg, bar);
            __builtin_amdgcn_fence(__ATOMIC_ACQUIRE, "agent");
            xb_add(&bar[XB_XGEN(b.x)], 1u);
            asm volatile("s_waitcnt vmcnt(0)" ::: "memory");
        } else {
            XB_SPIN(xb_ld(&bar[XB_XGEN(b.x)]) == gen, bar);
            __builtin_amdgcn_fence(__ATOMIC_ACQUIRE, "agent");
            asm volatile("s_waitcnt vmcnt(0)" ::: "memory");
        }
    }
    __syncthreads();
}

struct Args { const float* in[30]; float* out; unsigned char* ws; int ph_lo, ph_hi; };
enum { I_X = 0, I_N1W, I_WIN, I_BGATE, I_MU, I_W0, I_WUP, I_A0, I_AUP, I_GUP, I_KK, I_KA, I_RK, I_LNW, I_LNB, I_CONVW, I_IB, I_FB, I_MNW, I_WBA, I_WBB, I_WOUT, I_N2W, I_RTW, I_RTB, I_WGU, I_BGU, I_WDN, I_BDN, I_FNW };

struct Frame {
    LAS unsigned char* lds; volatile LAS unsigned* MISC; unsigned* ctl;
    int tid, lane, wave, G, bid;
    const float* const* in; float* out; unsigned char* ws;
};

using pg8::Unit; using pg8::HALF; using pg8::BM;
struct EpiBf16Plain {
    static constexpr bool PERM = true, AFTER_DRAIN = false;
    bf16* O; int ldc;
    __device__ __forceinline__ void operator()(const f32x4 (&acc)[2][2][4][2], const Unit& u, int wr, int wc, int fr, int fq) const {
        const int row0 = u.pm * BM + wr * 64 + fr, col0 = u.pn * BM + wc * 32 + 8 * fq;
#pragma unroll
        for (int ai = 0; ai < 2; ++ai)
#pragma unroll
            for (int m = 0; m < 4; ++m) { bf16* rowp = O + (size_t)(row0 + ai * HALF + m * 16) * ldc + col0;
#pragma unroll
                for (int bj = 0; bj < 2; ++bj) { const f32x4 v0 = acc[ai][bj][m][0], v1 = acc[ai][bj][m][1];
                    v4u w; w.x = pg8::cvt_pk_bf16(v0[0], v0[1]); w.y = pg8::cvt_pk_bf16(v0[2], v0[3]); w.z = pg8::cvt_pk_bf16(v1[0], v1[1]); w.w = pg8::cvt_pk_bf16(v1[2], v1[3]);
                    *(v4u*)(rowp + bj * HALF) = w; } }
    }
};
struct EpiP1I8 {
    static constexpr bool PERM = true, AFTER_DRAIN = false;
    bf16* O; int ldc; const float* ra; const unsigned* colmax;
    __device__ __forceinline__ void operator()(const f32x4 (&acc)[2][2][4][2], const Unit& u, int wr, int wc, int fr, int fq) const {
        const int row0 = u.pm * BM + wr * 64 + fr, col0 = u.pn * BM + wc * 32 + 8 * fq;
        f32x4 cb[2][2];
#pragma unroll
        for (int bj = 0; bj < 2; ++bj)
#pragma unroll
            for (int n = 0; n < 2; ++n) { const v4u cm = *(const v4u*)(colmax + col0 + bj * HALF + 4 * n);
                cb[bj][n] = (f32x4){__uint_as_float(cm.x), __uint_as_float(cm.y), __uint_as_float(cm.z), __uint_as_float(cm.w)} * (1.f / 127.f); }
#pragma unroll
        for (int ai = 0; ai < 2; ++ai)
#pragma unroll
            for (int m = 0; m < 4; ++m) { const int r = row0 + ai * HALF + m * 16; const float rs = ra[r]; bf16* rowp = O + (size_t)r * ldc + col0;
#pragma unroll
                for (int bj = 0; bj < 2; ++bj) { const v4u i0 = __builtin_bit_cast(v4u, acc[ai][bj][m][0]), i1 = __builtin_bit_cast(v4u, acc[ai][bj][m][1]);
                    const f32x4 v0 = (f32x4){(float)(int)i0.x, (float)(int)i0.y, (float)(int)i0.z, (float)(int)i0.w} * cb[bj][0] * rs, v1 = (f32x4){(float)(int)i1.x, (float)(int)i1.y, (float)(int)i1.z, (float)(int)i1.w} * cb[bj][1] * rs;
                    v4u w; w.x = pk2(v0[0], v0[1]); w.y = pk2(v0[2], v0[3]); w.z = pk2(v1[0], v1[1]); w.w = pk2(v1[2], v1[3]);
                    *(v4u*)(rowp + bj * HALF) = w; } }
    }
};
struct EpiLora {
    static constexpr bool PERM = false, AFTER_DRAIN = false;
    float* WLD; bf16* AG; const float* w0; const float* a0;
    __device__ __forceinline__ void operator()(const f32x4 (&acc)[2][2][4][2], const Unit& u, int wr, int wc, int fr, int fq) const {
        const int row0 = u.pm * BM + wr * 64 + fr, col0 = u.pn * BM + wc * 32 + 4 * fq, seg = u.pn >> 2;
        f32x4 bv[2][2];
#pragma unroll
        for (int bj = 0; bj < 2; ++bj)
#pragma unroll
            for (int n = 0; n < 2; ++n) { const int c = col0 + bj * HALF + n * 16;
                bv[bj][n] = seg == 0 ? *(const f32x4*)(w0 + c) : (seg == 1 ? *(const f32x4*)(a0 + (c - 1024)) : (f32x4){0.f, 0.f, 0.f, 0.f}); }
#pragma unroll
        for (int ai = 0; ai < 2; ++ai)
#pragma unroll
            for (int m = 0; m < 4; ++m) { const size_t r = (size_t)(row0 + ai * HALF + m * 16);
#pragma unroll
                for (int bj = 0; bj < 2; ++bj)
#pragma unroll
                    for (int n = 0; n < 2; ++n) { f32x4 v = acc[ai][bj][m][n] + bv[bj][n]; const int c = col0 + bj * HALF + n * 16;
                        if (seg == 0) {
#pragma unroll
                            for (int j = 0; j < 4; ++j) v[j] = -0.6065306597126334f * sigm(v[j]);
                            *(f32x4*)(WLD + r * RD + c) = v; }
                        else { if (seg == 1) {
#pragma unroll
                                for (int j = 0; j < 4; ++j) v[j] = sigm(v[j]); }
                            v2u o; o.x = pk2(v[0], v[1]); o.y = pk2(v[2], v[3]); *(v2u*)(AG + r * D + (c - 1024)) = o; } } }
    }
};
struct EpiGateA {
    static constexpr bool PERM = true, AFTER_DRAIN = false;
    bf16* TMP; const bf16* P; const float* bg;
    __device__ __forceinline__ void operator()(const f32x4 (&acc)[2][2][4][2], const Unit& u, int wr, int wc, int fr, int fq) const {
        const int row0 = u.pm * BM + wr * 64 + fr, col0 = u.pn * BM + wc * 32 + 8 * fq;
#pragma unroll
        for (int ai = 0; ai < 2; ++ai)
#pragma unroll
            for (int m = 0; m < 4; ++m) { const size_t r = (size_t)(row0 + ai * HALF + m * 16);
#pragma unroll
                for (int bj = 0; bj < 2; ++bj) { const int c = col0 + bj * HALF;
                    const v4u pg = *(const v4u*)(P + r * NINP + GTO + c); const f32x4 b0 = *(const f32x4*)(bg + c), b1 = *(const f32x4*)(bg + c + 4);
                    f32x4 g0, g1;
                    g0[0] = sigm(__uint_as_float(pg.x << 16) + b0[0]); g0[1] = sigm(__uint_as_float(pg.x & 0xffff0000u) + b0[1]);
                    g0[2] = sigm(__uint_as_float(pg.y << 16) + b0[2]); g0[3] = sigm(__uint_as_float(pg.y & 0xffff0000u) + b0[3]);
                    g1[0] = sigm(__uint_as_float(pg.z << 16) + b1[0]); g1[1] = sigm(__uint_as_float(pg.z & 0xffff0000u) + b1[1]);
                    g1[2] = sigm(__uint_as_float(pg.w << 16) + b1[2]); g1[3] = sigm(__uint_as_float(pg.w & 0xffff0000u) + b1[3]);
                    const f32x4 t0 = g0 * acc[ai][bj][m][0], t1 = g1 * acc[ai][bj][m][1]; v4u tw; tw.x = pk2(t0[0], t0[1]); tw.y = pk2(t0[2], t0[3]); tw.z = pk2(t1[0], t1[1]); tw.w = pk2(t1[2], t1[3]);
                    *(v4u*)(TMP + r * D + c) = tw; } }
    }
};
struct EpiGateB {
    static constexpr bool PERM = true, AFTER_DRAIN = false;
    const bf16* TMP; bf16* MRG; const bf16* P; const float* bg;
    __device__ __forceinline__ void operator()(const f32x4 (&acc)[2][2][4][2], const Unit& u, int wr, int wc, int fr, int fq) const {
        const int row0 = u.pm * BM + wr * 64 + fr, col0 = u.pn * BM + wc * 32 + 8 * fq;
#pragma unroll
        for (int ai = 0; ai < 2; ++ai)
#pragma unroll
            for (int m = 0; m < 4; ++m) { const size_t r = (size_t)(row0 + ai * HALF + m * 16);
#pragma unroll
                for (int bj = 0; bj < 2; ++bj) { const int c = col0 + bj * HALF;
                    const v4u pg = *(const v4u*)(P + r * NINP + GTO + D + c); const f32x4 b0 = *(const f32x4*)(bg + D + c), b1 = *(const f32x4*)(bg + D + c + 4);
                    const v4u tw = *(const v4u*)(TMP + r * D + c); const f32x4 t0 = (f32x4){__uint_as_float(tw.x << 16), __uint_as_float(tw.x & 0xffff0000u), __uint_as_float(tw.y << 16), __uint_as_float(tw.y & 0xffff0000u)}, t1 = (f32x4){__uint_as_float(tw.z << 16), __uint_as_float(tw.z & 0xffff0000u), __uint_as_float(tw.w << 16), __uint_as_float(tw.w & 0xffff0000u)};
                    f32x4 g0, g1;
                    g0[0] = sigm(__uint_as_float(pg.x << 16) + b0[0]); g0[1] = sigm(__uint_as_float(pg.x & 0xffff0000u) + b0[1]);
                    g0[2] = sigm(__uint_as_float(pg.y << 16) + b0[2]); g0[3] = sigm(__uint_as_float(pg.y & 0xffff0000u) + b0[3]);
                    g1[0] = sigm(__uint_as_float(pg.z << 16) + b1[0]); g1[1] = sigm(__uint_as_float(pg.z & 0xffff0000u) + b1[1]);
                    g1[2] = sigm(__uint_as_float(pg.w << 16) + b1[2]); g1[3] = sigm(__uint_as_float(pg.w & 0xffff0000u) + b1[3]);
                    const f32x4 v0 = t0 + g0 * acc[ai][bj][m][0], v1 = t1 + g1 * acc[ai][bj][m][1];
                    v4u w; w.x = pg8::cvt_pk_bf16(v0[0], v0[1]); w.y = pg8::cvt_pk_bf16(v0[2], v0[3]); w.z = pg8::cvt_pk_bf16(v1[0], v1[1]); w.w = pg8::cvt_pk_bf16(v1[2], v1[3]);
                    *(v4u*)(MRG + r * D + c) = w; } }
    }
};
struct EpiResid {
    static constexpr bool PERM = true, AFTER_DRAIN = false;
    const float* X; bf16* O;
    __device__ __forceinline__ void operator()(const f32x4 (&acc)[2][2][4][2], const Unit& u, int wr, int wc, int fr, int fq) const {
        const int row0 = u.pm * BM + wr * 64 + fr, col0 = u.pn * BM + wc * 32 + 8 * fq;
#pragma unroll
        for (int ai = 0; ai < 2; ++ai)
#pragma unroll
            for (int m = 0; m < 4; ++m) { const size_t off = (size_t)(row0 + ai * HALF + m * 16) * D + col0;
#pragma unroll
                for (int bj = 0; bj < 2; ++bj) { const f32x4 v0 = *(const f32x4*)(X + off + bj * HALF) + acc[ai][bj][m][0], v1 = *(const f32x4*)(X + off + bj * HALF + 4) + acc[ai][bj][m][1];
                    v4u w; w.x = pk2(v0[0], v0[1]); w.y = pk2(v0[2], v0[3]); w.z = pk2(v1[0], v1[1]); w.w = pk2(v1[2], v1[3]);
                    *(v4u*)(O + off + bj * HALF) = w; } }
    }
};
struct MoeOrder : pg8::StaticOrder {
    const LAS int* tile_e; size_t estride;
    __device__ __forceinline__ size_t b_off(const Unit& u, size_t tstep) const { return (size_t)tile_e[u.pm] * estride + (size_t)u.pn * tstep; }
};
struct MoeGatherOrder : MoeOrder {
    static constexpr bool GATHER = true;
    const LAS int* tile_i0; const LAS int* cnt; const int* rlist; LAS unsigned* rowoff; unsigned rowbytes;
    __device__ __forceinline__ size_t a_off(const Unit&, size_t) const { return 0; }
    __device__ __forceinline__ void fill_all() const { const int tid = threadIdx.x, r = tid & 255;
        for (int u0 = tid >> 8; ; u0 += 6) { Unit ua, ub, uc; const bool va = next(u0, ua), vb = next(u0 + 2, ub), vc = next(u0 + 4, uc); if (!va) break;
            int ta = 0, tb = 0, tc = 0;
            { const int e = tile_e[ua.pm], i = tile_i0[ua.pm] + r; if (i < cnt[e]) ta = rlist[e * ECAP + i]; }
            if (vb) { const int e = tile_e[ub.pm], i = tile_i0[ub.pm] + r; if (i < cnt[e]) tb = rlist[e * ECAP + i]; }
            if (vc) { const int e = tile_e[uc.pm], i = tile_i0[uc.pm] + r; if (i < cnt[e]) tc = rlist[e * ECAP + i]; }
            rowoff[u0 * 256 + r] = (unsigned)(ta >> 2) * rowbytes; if (vb) rowoff[(u0 + 2) * 256 + r] = (unsigned)(tb >> 2) * rowbytes; if (vc) rowoff[(u0 + 4) * 256 + r] = (unsigned)(tc >> 2) * rowbytes; } }
    __device__ __forceinline__ unsigned row_off(int ui, int r) const { return rowoff[ui * 256 + r]; }
};
struct EpiSwiGLU {
    static constexpr bool PERM = true, AFTER_DRAIN = false;
    unsigned char* ACT; const float* bgu; const LAS int* tile_e;
    __device__ __forceinline__ void operator()(const f32x4 (&acc)[2][2][4][2], const Unit& u, int wr, int wc, int fr, int fq) const {
        const int row0 = u.pm * BM + wr * 64 + fr, colg = u.pn * 128 + wc * 32 + 8 * fq; const int e = tile_e[u.pm];
        const float* bp = bgu + (size_t)e * 4096 + colg;
        const f32x4 bg0 = *(const f32x4*)(bp), bg1 = *(const f32x4*)(bp + 4), bu0 = *(const f32x4*)(bp + 2048), bu1 = *(const f32x4*)(bp + 2052);
#pragma unroll
        for (int ai = 0; ai < 2; ++ai)
#pragma unroll
            for (int m = 0; m < 4; ++m) { const size_t r = (size_t)(row0 + ai * HALF + m * 16);
                constexpr float DS = 1.f / (F8_SX * F8_SW);
                const f32x4 ga = acc[ai][0][m][0] * DS + bg0, gb = acc[ai][0][m][1] * DS + bg1, ua = acc[ai][1][m][0] * DS + bu0, ub = acc[ai][1][m][1] * DS + bu1;
                float o[8];
#pragma unroll
                for (int j = 0; j < 4; ++j) { const float g = fminf(ga[j], 7.f), up = fminf(fmaxf(ua[j], -7.f), 7.f); o[j] = F8_SA * (up + 1.f) * g * sigm(1.702f * g);
                                              const float g2 = fminf(gb[j], 7.f), up2 = fminf(fmaxf(ub[j], -7.f), 7.f); o[4 + j] = F8_SA * (up2 + 1.f) * g2 * sigm(1.702f * g2); }
                v2u w; w.x = pk4f8(o[0], o[1], o[2], o[3]); w.y = pk4f8(o[4], o[5], o[6], o[7]);
                *(v2u*)(ACT + r * FF + colg) = w; }
    }
};
struct EpiDown {
    static constexpr bool PERM = true, AFTER_DRAIN = false;
    unsigned char* YS; const float* bdn; const LAS int* tile_e; const LAS int* rowdst; const LAS float* rowwt;
    __device__ __forceinline__ void operator()(const f32x4 (&acc)[2][2][4][2], const Unit& u, int wr, int wc, int fr, int fq) const {
        const int e = tile_e[u.pm]; const int col0 = u.pn * BM + wc * 32 + 8 * fq;
        const float* bp = bdn + (size_t)e * D + col0; constexpr float DS = 1.f / (F8_SA * F8_SW);
#pragma unroll
        for (int bj = 0; bj < 2; ++bj) { const f32x4 b0 = *(const f32x4*)(bp + bj * HALF), b1 = *(const f32x4*)(bp + bj * HALF + 4);
#pragma unroll
            for (int ai = 0; ai < 2; ++ai)
#pragma unroll
                for (int m = 0; m < 4; ++m) { const int r = u.ord * 256 + ai * HALF + wr * 64 + m * 16 + fr;
                    const int dst = rowdst[r]; const float w = rowwt[r];
                    const f32x4 v0 = (acc[ai][bj][m][0] * DS + b0) * (w * F8_SY), v1 = (acc[ai][bj][m][1] * DS + b1) * (w * F8_SY);
                    v2u o; o.x = pk4f8(v0[0], v0[1], v0[2], v0[3]); o.y = pk4f8(v1[0], v1[1], v1[2], v1[3]);
                    *(v2u*)(YS + (size_t)dst * D + col0 + bj * HALF) = o; } }
    }
};
template <class Sched> __device__ __forceinline__ void fill_down_tables(Frame& F, const Sched& S, LAS int* rowdst, LAS float* rowwt) {
    const LAS int* MI = (const LAS int*)F.MISC; const int* rlist = (const int*)(F.ws + WS_RLIST); const float* rw = (const float*)(F.ws + WS_RW);
    const int r = F.tid & 255;
    for (int u0 = F.tid >> 8; ; u0 += 4) { Unit ua, ub; const bool va = S.next(u0, ua), vb = S.next(u0 + 2, ub); if (!va) break;
        int da = T * 4, db = T * 4; float wa = 0.f, wb = 0.f;
        { const int e = MI[MI_TILE_E + ua.pm], i = MI[MI_TILE_I0 + ua.pm] + r; if (i < MI[MI_CNT + e]) { da = rlist[e * ECAP + i]; wa = rw[e * ECAP + i]; } }
        if (vb) { const int e = MI[MI_TILE_E + ub.pm], i = MI[MI_TILE_I0 + ub.pm] + r; if (i < MI[MI_CNT + e]) { db = rlist[e * ECAP + i]; wb = rw[e * ECAP + i]; } }
        rowdst[u0 * 256 + r] = da; rowwt[u0 * 256 + r] = wa; if (vb) { rowdst[(u0 + 2) * 256 + r] = db; rowwt[(u0 + 2) * 256 + r] = wb; } }
    __syncthreads();
}

__device__ __forceinline__ void transpose_item(const float* __restrict__ W, int N, int k0, int n0, bf16* WT, int dst_row0, int ldk, LAS float* scr, int lane) {
    const int n = n0 + (lane & 31); const bool ok = n < N;
#pragma unroll 8
    for (int i = 0; i < 32; ++i) { const int kk = 2 * i + (lane >> 5); scr[kk * 33 + (lane & 31)] = ok ? W[(size_t)(k0 + kk) * N + n] : 0.f; }
    LDS_WAIT(); asm volatile("" ::: "memory");
    const int c = lane & 7;
#pragma unroll
    for (int j = 0; j < 4; ++j) { const int nn = (lane >> 3) + 8 * j; const LAS float* s = scr + (8 * c) * 33 + nn;
        v4u o; o.x = pk2(s[0 * 33], s[1 * 33]); o.y = pk2(s[2 * 33], s[3 * 33]); o.z = pk2(s[4 * 33], s[5 * 33]); o.w = pk2(s[6 * 33], s[7 * 33]);
        *(v4u*)(WT + (size_t)(dst_row0 + nn) * ldk + k0 + 8 * c) = o; }
    LDS_WAIT(); asm volatile("" ::: "memory");
}
__device__ __forceinline__ void transpose_item_i8(const float* __restrict__ W, int N, int k0, int n0, unsigned char* WT, int dst_row0, int ldk, const unsigned* colmax, LAS float* scr, int lane) {
    const int n = n0 + (lane & 31); const bool ok = n < N;
#pragma unroll 8
    for (int i = 0; i < 32; ++i) { const int kk = 2 * i + (lane >> 5); scr[kk * 33 + (lane & 31)] = ok ? W[(size_t)(k0 + kk) * N + n] : 0.f; }
    LDS_WAIT(); asm volatile("" ::: "memory");
#pragma unroll
    for (int j = 0; j < 2; ++j) { const int ch = lane + 64 * j, nn = ch >> 2, c = ch & 3; const LAS float* s = scr + (16 * c) * 33 + nn;
        const float cm = __uint_as_float(colmax[n0 + nn]); const float sc = cm > 0.f ? 127.f / cm : 0.f;
        v4u o; o.x = pk4i8(s[0 * 33] * sc, s[1 * 33] * sc, s[2 * 33] * sc, s[3 * 33] * sc); o.y = pk4i8(s[4 * 33] * sc, s[5 * 33] * sc, s[6 * 33] * sc, s[7 * 33] * sc);
        o.z = pk4i8(s[8 * 33] * sc, s[9 * 33] * sc, s[10 * 33] * sc, s[11 * 33] * sc); o.w = pk4i8(s[12 * 33] * sc, s[13 * 33] * sc, s[14 * 33] * sc, s[15 * 33] * sc);
        *(v4u*)(WT + (size_t)(dst_row0 + nn) * ldk + k0 + 16 * c) = o; }
    LDS_WAIT(); asm volatile("" ::: "memory");
}
__device__ __forceinline__ void p0b_win(Frame& F) {
    LAS float* scr = (LAS float*)(F.lds + F.wave * 16384);
    const int gw = F.bid * NWAVES + F.wave, NGW = F.G * NWAVES; unsigned char* WIN8 = F.ws + WS_WIN; const unsigned* colmax = F.ctl + CW_COLMAX;
    constexpr int NB_WIN = (NIN + 31) / 32;
    for (int it = gw; it < 32 * NB_WIN; it += NGW) { const int kb = it / NB_WIN, nb = it % NB_WIN; transpose_item_i8(F.in[I_WIN], NIN, kb * 64, nb * 32, WIN8, nb * 32, D, colmax, scr, F.lane); }
    { const int gt = F.bid * NTHR + F.tid, NGT = F.G * NTHR; constexpr int Z0 = NB_WIN * 32 * D, Z1 = NINP * D;
      for (int i = Z0 + gt * 16; i < Z1; i += NGT * 16) *(v4u*)(WIN8 + i) = (v4u){0u, 0u, 0u, 0u}; }
}
__device__ __forceinline__ void p0_prologue(Frame& F) {
    LAS float* scr = (LAS float*)(F.lds + F.wave * 16384);
    const int gw = F.bid * NWAVES + F.wave, NGW = F.G * NWAVES;
    bf16* WIN_T = (bf16*)(F.ws + WS_WIN); bf16* WA_T = (bf16*)(F.ws + WS_WA); bf16* WB_T = (bf16*)(F.ws + WS_WB); bf16* WO_T = (bf16*)(F.ws + WS_WO);
    bf16* WGU_T = (bf16*)(F.ws + WS_WGU); bf16* WDN_T = (bf16*)(F.ws + WS_WDN); bf16* WL_T = (bf16*)(F.ws + WS_WL); bf16* HN = (bf16*)(F.ws + WS_HN);
    { const float* W = F.in[I_WIN]; unsigned* colmax = F.ctl + CW_COLMAX;
      for (int task = gw; task < 168 * 16; task += NGW) { const int cb = task % 168, kc = task / 168, n = cb * 64 + F.lane; float m = 0.f;
          if (n < NIN) { const float* wp = W + (size_t)(kc * 128) * NIN + n;
#pragma unroll 1
              for (int k0 = 0; k0 < 128; k0 += 32) { float v[32];
#pragma unroll
                  for (int i = 0; i < 32; ++i) v[i] = wp[(size_t)(k0 + i) * NIN];
#pragma unroll
                  for (int i = 0; i < 32; ++i) m = fmaxf(m, fabsf(v[i])); }
              atomicMax(colmax + n, __float_as_uint(m)); } } }
    { const int gt = F.bid * NTHR + F.tid, NGT = F.G * NTHR;
      for (int i = gt; i < 3072 * 512; i += NGT) { const int n = i >> 9, k = i & 511; float v = 0.f;
          if (n < 1024) { if (k < 96) v = F.in[I_WUP][k * RD + n]; }
          else if (n < 2048) { if (k >= 128 && k < 224) v = F.in[I_AUP][(k - 128) * RD + (n - 1024)]; }
          else { if (k >= 256) v = F.in[I_GUP][(k - 256) * RD + (n - 2048)]; }
          WL_T[i] = (bf16)f2bf(v); } }
    { const int gt = F.bid * NTHR + F.tid, NGT = F.G * NTHR; float* RWS = (float*)(F.ws + WS_RWS);
      for (int i = gt; i < D * NE; i += NGT) RWS[i] = F.in[I_N2W][i >> 5] * F.in[I_RTW][i]; }
    const float* x = F.in[I_X]; const float* nw = F.in[I_N1W];
    f32x4 nv[8];
    if (gw < T) { const f32x4* xr = (const f32x4*)(x + (size_t)gw * D) + F.lane;
#pragma unroll
        for (int j = 0; j < 8; ++j) nv[j] = xr[64 * j]; }
    for (int m = gw; m < T; m += NGW) {
        f32x4 v[8]; float s = 0.f;
#pragma unroll
        for (int j = 0; j < 8; ++j) v[j] = nv[j];
        if (m + NGW < T) { const f32x4* xr = (const f32x4*)(x + (size_t)(m + NGW) * D) + F.lane;
#pragma unroll
            for (int j = 0; j < 8; ++j) nv[j] = xr[64 * j]; }
#pragma unroll
        for (int j = 0; j < 8; ++j) s += (v[j][0] * v[j][0] + v[j][1] * v[j][1]) + (v[j][2] * v[j][2] + v[j][3] * v[j][3]);
        const float rstd = __builtin_amdgcn_rsqf(wave_sum(s) * (1.f / D) + NORM_EPS);
        float am = 0.f;
#pragma unroll
        for (int j = 0; j < 8; ++j) { const f32x4 w = ((const f32x4*)nw)[F.lane + 64 * j]; v[j] = v[j] * rstd * w; am = fmaxf(fmaxf(am, fmaxf(fabsf(v[j][0]), fabsf(v[j][1]))), fmaxf(fabsf(v[j][2]), fabsf(v[j][3]))); }
        am = wave_max(am); const float sc = am > 0.f ? 127.f / am : 0.f;
        if (F.lane == 0) ((float*)(F.ws + WS_RA))[m] = am * (1.f / 127.f);
        unsigned* o4 = (unsigned*)((unsigned char*)HN + (size_t)m * D) + F.lane;
#pragma unroll
        for (int j = 0; j < 8; ++j) o4[64 * j] = pk4i8(v[j][0] * sc, v[j][1] * sc, v[j][2] * sc, v[j][3] * sc);
    }
}

__device__ __forceinline__ void p2_lora_in(Frame& F) {
    const bf16* __restrict__ P = (const bf16*)(F.ws + WS_P); bf16* __restrict__ LIN = (bf16*)(F.ws + WS_LIN); const float* __restrict__ mu = F.in[I_MU];
    const int gt = F.bid * NTHR + F.tid, NGT = F.G * NTHR;
    for (int i = gt; i < T * 64; i += 2 * NGT) { const int g = i & 63; int col = -1, kind = 0;
        if (g < 12) { col = 3072 + 8 * g; kind = 0; } else if (g >= 16 && g < 28) { col = 3168 + 8 * (g - 16); kind = 1; } else if (g >= 32) { col = 3264 + 8 * (g - 32); kind = 2; }
        const int ce = col >= 0 ? col : 3072;
        v4u pc[2], pp[2];
#pragma unroll
        for (int u = 0; u < 2; ++u) { const int ii = i + u * NGT < T * 64 ? i + u * NGT : i; const int t = ii >> 6; pc[u] = *(const v4u*)(P + (size_t)t * NINP + ce); pp[u] = *(const v4u*)(P + (size_t)((t & (SEQ - 1)) ? t - 1 : t) * NINP + ce); }
        const f32x4 m0 = *(const f32x4*)(mu + ce), m1 = *(const f32x4*)(mu + ce + 4);
#pragma unroll
        for (int u = 0; u < 2; ++u) { const int ii = i + u * NGT; if (ii < T * 64) { const int t = ii >> 6; v4u o = (v4u){0u, 0u, 0u, 0u};
            if (col >= 0) { const float pm = (t & (SEQ - 1)) ? 1.f : 0.f;
                const unsigned pcs[4] = {pc[u].x, pc[u].y, pc[u].z, pc[u].w}, pps[4] = {pp[u].x, pp[u].y, pp[u].z, pp[u].w}; float x[8];
#pragma unroll
                for (int k = 0; k < 4; ++k) { const float c0 = __uint_as_float(pcs[k] << 16), c1 = __uint_as_float(pcs[k] & 0xffff0000u), q0 = pm * __uint_as_float(pps[k] << 16), q1 = pm * __uint_as_float(pps[k] & 0xffff0000u);
                    const float ma = k < 2 ? m0[2 * k] : m1[2 * k - 4], mb = k < 2 ? m0[2 * k + 1] : m1[2 * k - 3];
                    x[2 * k] = c0 + (q0 - c0) * ma; x[2 * k + 1] = c1 + (q1 - c1) * mb; }
#pragma unroll
                for (int k = 0; k < 8; ++k) x[k] = kind == 0 ? tanhf(x[k]) : (kind == 1 ? x[k] : sigm(x[k]));
                o.x = pk2(x[0], x[1]); o.y = pk2(x[2], x[3]); o.z = pk2(x[4], x[5]); o.w = pk2(x[6], x[7]); }
            *(v4u*)(LIN + (size_t)t * 512 + 8 * g) = o; } } }
    { bf16* __restrict__ QKC = (bf16*)(F.ws + WS_QKC); const float* __restrict__ cw = F.in[I_CONVW];
      for (int i = gt; i < T * 128; i += 2 * NGT) { v4u pv[2][4]; f32x4 w0[4], w1[4]; const int c0 = 8 * (i & 127);
#pragma unroll
          for (int u = 0; u < 2; ++u) { const int ii = i + u * NGT < T * 128 ? i + u * NGT : i; const int t = ii >> 7, sq = t & (SEQ - 1);
#pragma unroll
              for (int j = 0; j < 4; ++j) { const int tj = sq - 3 + j >= 0 ? t - 3 + j : t; pv[u][j] = *(const v4u*)(P + (size_t)tj * NINP + MLO + c0); } }
#pragma unroll
          for (int j = 0; j < 4; ++j) { w0[j] = *(const f32x4*)(cw + j * 1024 + c0); w1[j] = *(const f32x4*)(cw + j * 1024 + c0 + 4); }
          const float sc = c0 < 512 ? 0.08838834764831845f : 1.f;
#pragma unroll
          for (int u = 0; u < 2; ++u) { const int ii = i + u * NGT; if (ii < T * 128) { const int t = ii >> 7, sq = t & (SEQ - 1); float acc[8];
#pragma unroll
              for (int k = 0; k < 8; ++k) acc[k] = 0.f;
#pragma unroll
              for (int j = 0; j < 4; ++j) { const float m = sq - 3 + j >= 0 ? 1.f : 0.f; const v4u q = pv[u][j]; const f32x4 a0 = w0[j] * m, a1 = w1[j] * m;
                  acc[0] += __uint_as_float(q.x << 16) * a0[0]; acc[1] += __uint_as_float(q.x & 0xffff0000u) * a0[1]; acc[2] += __uint_as_float(q.y << 16) * a0[2]; acc[3] += __uint_as_float(q.y & 0xffff0000u) * a0[3];
                  acc[4] += __uint_as_float(q.z << 16) * a1[0]; acc[5] += __uint_as_float(q.z & 0xffff0000u) * a1[1]; acc[6] += __uint_as_float(q.w << 16) * a1[2]; acc[7] += __uint_as_float(q.w & 0xffff0000u) * a1[3]; }
#pragma unroll
              for (int k = 0; k < 8; ++k) acc[k] = acc[k] * sigm(acc[k]) * sc;
              v4u o; o.x = pk2(acc[0], acc[1]); o.y = pk2(acc[2], acc[3]); o.z = pk2(acc[4], acc[5]); o.w = pk2(acc[6], acc[7]); *(v4u*)(QKC + (size_t)t * 1024 + c0) = o; } } } }
    { float* __restrict__ GLF = (float*)(F.ws + WS_GLF); const int gw = F.bid * NWAVES + F.wave, NGW = F.G * NWAVES, lane = F.lane;
      for (int q = gw; q < (T / 64) * 4; q += NGW) { const int chk = q >> 2, mh = q & 3; const size_t t = (size_t)chk * 64 + lane; const bf16* pr = P + t * NINP + MLO + 2048;
          const float ip = 15.f * tanhf((bf2f(pr[mh]) + F.in[I_IB][mh]) * (1.f / 15.f)), fp = 15.f * tanhf((bf2f(pr[4 + mh]) + F.in[I_FB][mh]) * (1.f / 15.f));
          float bc = fminf(fp, 0.f) - log1pf(__expf(-fabsf(fp)));
#pragma unroll
          for (int o = 1; o < 64; o <<= 1) { const float t_ = __shfl_up(bc, o); if (lane >= o) bc += t_; }
          const float u = ip - bc; float pm = u;
#pragma unroll
          for (int o = 1; o < 64; o <<= 1) { const float t_ = __shfl_up(pm, o); if (lane >= o) pm = fmaxf(pm, t_); }
          *(f32x4*)(GLF + t * 16 + 4 * mh) = (f32x4){bc, u, pm, 0.f}; } }
}

typedef short s16x8 __attribute__((ext_vector_type(8)));
typedef short s16x4 __attribute__((ext_vector_type(4)));
__device__ __forceinline__ unsigned long long pack4bf(f32x4 v) { return (unsigned long long)pk2(v[0], v[1]) | ((unsigned long long)pk2(v[2], v[3]) << 32); }
__device__ __forceinline__ s16x8 tr_frag(const LAS bf16* img, int stride, int r0, int c0, int fr) {
    const LAS bf16* p0 = img + (r0 + (fr >> 2)) * stride + c0 + 4 * (fr & 3);
    const s16x4 lo = __builtin_bit_cast(s16x4, __builtin_amdgcn_ds_read_tr16_b64_v4i16((LAS s16x4*)p0));
    const s16x4 hi = __builtin_bit_cast(s16x4, __builtin_amdgcn_ds_read_tr16_b64_v4i16((LAS s16x4*)(p0 + 4 * stride)));
    return __builtin_shufflevector(lo, hi, 0, 1, 2, 3, 4, 5, 6, 7);
}

__device__ __forceinline__ float scan32(float x) {
    x += dppf<0x111>(x); x += dppf<0x112>(x); x += dppf<0x114>(x); x += dppf<0x118>(x);
    x += __builtin_bit_cast(float, __builtin_amdgcn_update_dpp(0, __builtin_bit_cast(int, x), 0x142, 0xa, 0xf, false));
    return x; }
typedef float f32x16 __attribute__((ext_vector_type(16)));
__device__ __forceinline__ s16x8 accfrag(const f32x16& x, int s) { v4u p; p.x = pk2(x[8 * s], x[8 * s + 1]); p.y = pk2(x[8 * s + 2], x[8 * s + 3]); p.z = pk2(x[8 * s + 4], x[8 * s + 5]); p.w = pk2(x[8 * s + 6], x[8 * s + 7]); return __builtin_bit_cast(s16x8, p); }
#define MFMA32(a_, b_, c_) __builtin_amdgcn_mfma_f32_32x32x16_bf16((a_), (b_), (c_), 0, 0, 0)
__device__ __forceinline__ void rw_bar(LAS unsigned* cnt, unsigned& target, int lane);
__device__ __forceinline__ void rwkv_chunk_unit(Frame& F, int unit, LAS unsigned char* regB, LAS unsigned* bcnt, unsigned& btarget) {
    const int b = unit >> 5, h = (unit >> 1) & 15, half = unit & 1;
    const bf16* P = (const bf16*)(F.ws + WS_P); const float* WAG = (const float*)(F.ws + WS_WAG); const bf16* AGp = (const bf16*)(F.ws + WS_WAG + 64 * MiB); float* YRAW = (float*)(F.ws + WS_YRAW);
    constexpr int KS = 72, LS = 40;
    LAS bf16* At = (LAS bf16*)F.lds; LAS bf16* Bt = At + 32 * KS; LAS bf16* Kt = Bt + 32 * KS; LAS bf16* Rt = Kt + 32 * KS;
    LAS bf16* Vv = Rt + 32 * KS;
    LAS bf16* Sb = Vv + 32 * LS;
    LAS bf16* G2b = Sb + 32 * KS; LAS bf16* G3b = G2b + 32 * LS; LAS bf16* G4b = G3b + 32 * LS;
    LAS bf16* Pwb = G4b + 32 * LS;
    LAS bf16* Acb = Pwb + 2 * 32 * LS;
    LAS bf16* RHt = (LAS bf16*)regB;
    LAS bf16* Ubt = RHt + 32 * LS;
    LAS float* lwf = (LAS float*)(Ubt + 32 * LS);
    LAS float* csf = lwf + 2048;
    LAS float* gtf = csf + 2048;
    LAS float* glf = gtf + 256;
    const int tid = F.tid, lane = F.lane, w = F.wave, fr = lane & 15, fq = lane >> 4;
    const int ts = tid >> 4, cs = tid & 15, c0 = h * 64 + 4 * cs;
    const int sk = tid & 63, sq = tid >> 6;
    const f32x4 mu_r = *(const f32x4*)(F.in[I_MU] + c0), mu_k = *(const f32x4*)(F.in[I_MU] + 1024 + c0), mu_v = *(const f32x4*)(F.in[I_MU] + 2048 + c0);
    const f32x4 kkc = *(const f32x4*)(F.in[I_KK] + c0), kac = *(const f32x4*)(F.in[I_KA] + c0), rkc = *(const f32x4*)(F.in[I_RK] + c0);
    bf16* BON = (bf16*)(F.ws + WS_WAG + 128 * MiB);
    for (int i = tid; i < 32 * KS; i += 256) Sb[i] = 0;
    v2u cr[2], ck[2], cv[2], qr[2], qk[2], qv[2]; f32x4 a4[2], ws0, ws1;
#define RC_LOAD(ch) do { _Pragma("unroll") for (int p_ = 0; p_ < 2; ++p_) { const int t_ = (ch) * 32 + ts + 16 * p_; const size_t tk_ = (size_t)b * SEQ + t_; const bf16* pr_ = P + tk_ * NINP + c0; \
        cr[p_] = *(const v2u*)(pr_); ck[p_] = *(const v2u*)(pr_ + 1024); cv[p_] = *(const v2u*)(pr_ + 2048); \
        if (t_ > 0) { qr[p_] = *(const v2u*)(pr_ - NINP); qk[p_] = *(const v2u*)(pr_ - NINP + 1024); qv[p_] = *(const v2u*)(pr_ - NINP + 2048); } else { qr[p_] = (v2u){0u, 0u}; qk[p_] = qr[p_]; qv[p_] = qr[p_]; } \
        { const v2u ab_ = *(const v2u*)(AGp + tk_ * D + c0); a4[p_] = UNP4(ab_); } } \
        { const float* wr_ = WAG + ((size_t)b * SEQ + (ch) * 32 + (lane & 31)) * RD + h * 64 + 16 * w + 8 * (lane >> 5); ws0 = *(const f32x4*)wr_; ws1 = *(const f32x4*)(wr_ + 4); } } while (0)
    const int mi = w >> 1, nj = w & 1;
    f32x4 st[2]; st[0] = (f32x4){0.f, 0.f, 0.f, 0.f}; st[1] = st[0];
    RC_LOAD(0);
    rw_bar(bcnt, btarget, lane);
    for (int ch = 0; ch < SEQ / 32; ++ch) {
        f32x4 rr[2], kmod[2], vv[2], kkn[2], al[2];
#pragma unroll
        for (int p_ = 0; p_ < 2; ++p_) { const f32x4 pr4 = UNP4(cr[p_]), pk4 = UNP4(ck[p_]), pv4 = UNP4(cv[p_]), qr4 = UNP4(qr[p_]), qk4 = UNP4(qk[p_]), qv4 = UNP4(qv[p_]); al[p_] = a4[p_];
            rr[p_] = pr4 + (qr4 - pr4) * mu_r; const f32x4 k1 = pk4 + (qk4 - pk4) * mu_k; vv[p_] = pv4 + (qv4 - pv4) * mu_v;
            const f32x4 kkr = k1 * kkc; const float nrm = __builtin_amdgcn_rsqf(fmaxf(allreduce16((kkr[0] * kkr[0] + kkr[1] * kkr[1]) + (kkr[2] * kkr[2] + kkr[3] * kkr[3])), 1e-24f));
            kkn[p_] = kkr * nrm; kmod[p_] = k1 * (1.f + (al[p_] - 1.f) * kac);
            { const f32x4 rk_ = rr[p_] * kmod[p_] * rkc; const float dot = allreduce16((rk_[0] + rk_[1]) + (rk_[2] + rk_[3]));
              if ((cs >> 3) == half) *(unsigned long long*)(BON + ((size_t)b * SEQ + ch * 32 + ts + 16 * p_) * RD + c0) = pack4bf(vv[p_] * dot); }
            }
        { const int tq = lane & 31, hq = lane >> 5; f32x4 c0v, c1v;
#pragma unroll
          for (int j = 0; j < 4; ++j) { c0v[j] = scan32(ws0[j]); c1v[j] = scan32(ws1[j]); }
          *(LAS f32x4*)(csf + tq * 64 + 16 * w + 8 * hq) = c0v; *(LAS f32x4*)(csf + tq * 64 + 16 * w + 8 * hq + 4) = c1v; }
        if (ch + 1 < SEQ / 32) RC_LOAD(ch + 1);
        rw_bar(bcnt, btarget, lane);
#pragma unroll
        for (int p_ = 0; p_ < 2; ++p_) { const int t = ts + 16 * p_; const f32x4 cg = *(const LAS f32x4*)(csf + t * 64 + 4 * cs); f32x4 cgp = (f32x4){0.f, 0.f, 0.f, 0.f}; if (t > 0) cgp = *(const LAS f32x4*)(csf + (t - 1) * 64 + 4 * cs); f32x4 g, gp, gi;
#pragma unroll
          for (int j = 0; j < 4; ++j) { g[j] = __expf(cg[j]); gp[j] = __expf(cgp[j]); gi[j] = __expf(-cg[j]); }
          *(LAS unsigned long long*)(At + t * KS + 4 * cs) = pack4bf(-(kkn[p_] * gp)); *(LAS unsigned long long*)(Bt + t * KS + 4 * cs) = pack4bf(kkn[p_] * al[p_] * gi);
          *(LAS unsigned long long*)(Kt + t * KS + 4 * cs) = pack4bf(kmod[p_] * gi); *(LAS unsigned long long*)(Rt + t * KS + 4 * cs) = pack4bf(rr[p_] * g);
          if ((cs >> 3) == half) *(LAS unsigned long long*)(Vv + t * LS + 4 * (cs & 7)) = pack4bf(vv[p_]);
          if (t == 31) *(LAS f32x4*)(glf + 4 * cs) = g; }
        rw_bar(bcnt, btarget, lane);
        { const int t = 16 * mi + fr, jb = 16 * nj + 4 * fq;
          f32x4 g2 = (f32x4){0.f, 0.f, 0.f, 0.f}, g3 = g2, g4 = g2;
#pragma unroll
          for (int ks = 0; ks < 2; ++ks) { const s16x8 bj = *(const LAS s16x8*)(Bt + (16 * nj + fr) * KS + 32 * ks + 8 * fq), kj = *(const LAS s16x8*)(Kt + (16 * nj + fr) * KS + 32 * ks + 8 * fq);
              const s16x8 at = *(const LAS s16x8*)(At + (16 * mi + fr) * KS + 32 * ks + 8 * fq), rt = *(const LAS s16x8*)(Rt + (16 * mi + fr) * KS + 32 * ks + 8 * fq);
              g2 = __builtin_amdgcn_mfma_f32_16x16x32_bf16(kj, at, g2, 0, 0, 0); g3 = __builtin_amdgcn_mfma_f32_16x16x32_bf16(bj, rt, g3, 0, 0, 0); g4 = __builtin_amdgcn_mfma_f32_16x16x32_bf16(kj, rt, g4, 0, 0, 0); }
#pragma unroll
          for (int rg_ = 0; rg_ < 4; ++rg_) { const int j = jb + rg_; g2[rg_] = (j < t) ? g2[rg_] : 0.f; g3[rg_] = (j <= t) ? g3[rg_] : 0.f; g4[rg_] = (j <= t) ? g4[rg_] : 0.f; }
          *(LAS unsigned long long*)(G2b + t * LS + jb) = pack4bf(g2); *(LAS unsigned long long*)(G3b + t * LS + jb) = pack4bf(g3); *(LAS unsigned long long*)(G4b + t * LS + jb) = pack4bf(g4); }
        { const int tq = lane & 31, hq = lane >> 5;
          f32x16 Pm, Qm, Aq;
#pragma unroll
          for (int i = 0; i < 16; ++i) { Pm[i] = 0.f; Qm[i] = 0.f; }
#pragma unroll
          for (int s = 0; s < 4; ++s) { const s16x8 fa = *(const LAS s16x8*)(At + tq * KS + 16 * s + 8 * hq), fb = *(const LAS s16x8*)(Bt + tq * KS + 16 * s + 8 * hq);
              Pm = MFMA32(fa, fb, Pm); Qm = MFMA32(fb, fa, Qm); }
#pragma unroll
          for (int i = 0; i < 16; ++i) { const int r_ = (i & 3) + 8 * (i >> 2) + 4 * hq;
              Pm[i] = (tq < r_) ? Pm[i] : 0.f;
              Qm[i] = (r_ < tq) ? Qm[i] : 0.f;
              Aq[i] = Qm[i] + ((r_ == tq) ? 1.f : 0.f); }
#pragma unroll
          for (int st = 1; st <= 4; ++st) { const s16x8 p0 = accfrag(Pm, 0), p1 = accfrag(Pm, 1), q0 = accfrag(Qm, 0), q1 = accfrag(Qm, 1);
              f32x16 nP, nQ;
#pragma unroll
              for (int i = 0; i < 16; ++i) { nP[i] = 0.f; nQ[i] = 0.f; }
              nP = MFMA32(q0, p0, nP); nP = MFMA32(q1, p1, nP);
              if (st < 4) { nQ = MFMA32(p0, q0, nQ); nQ = MFMA32(p1, q1, nQ); }
              Pm = nP; Qm = nQ;
              const s16x8 n0 = accfrag(Pm, 0), n1 = accfrag(Pm, 1), a0 = accfrag(Aq, 0), a1 = accfrag(Aq, 1);
              Aq = MFMA32(n0, a0, Aq); Aq = MFMA32(n1, a1, Aq); }
          f32x4 tv; tv[0] = w == 0 ? Aq[0] : w == 1 ? Aq[4] : w == 2 ? Aq[8] : Aq[12]; tv[1] = w == 0 ? Aq[1] : w == 1 ? Aq[5] : w == 2 ? Aq[9] : Aq[13];
          tv[2] = w == 0 ? Aq[2] : w == 1 ? Aq[6] : w == 2 ? Aq[10] : Aq[14]; tv[3] = w == 0 ? Aq[3] : w == 1 ? Aq[7] : w == 2 ? Aq[11] : Aq[15];
          *(LAS unsigned long long*)(Acb + 32 * LS + tq * LS + 8 * w + 4 * hq) = pack4bf(tv); }
        rw_bar(bcnt, btarget, lane);
        f32x4 yv = (f32x4){0.f, 0.f, 0.f, 0.f};
        { f32x4 z = (f32x4){0.f, 0.f, 0.f, 0.f};
#pragma unroll
          for (int ks = 0; ks < 2; ++ks) { const s16x8 sb = *(const LAS s16x8*)(Sb + (16 * nj + fr) * KS + 32 * ks + 8 * fq);
              z = __builtin_amdgcn_mfma_f32_16x16x32_bf16(*(const LAS s16x8*)(At + (16 * mi + fr) * KS + 32 * ks + 8 * fq), sb, z, 0, 0, 0);
              yv = __builtin_amdgcn_mfma_f32_16x16x32_bf16(*(const LAS s16x8*)(Rt + (16 * mi + fr) * KS + 32 * ks + 8 * fq), sb, yv, 0, 0, 0); }
          const s16x8 vt_ = tr_frag(Vv, LS, 8 * fq, 16 * nj, fr);
          z = __builtin_amdgcn_mfma_f32_16x16x32_bf16(*(const LAS s16x8*)(G2b + (16 * mi + fr) * LS + 8 * fq), vt_, z, 0, 0, 0);
          yv = __builtin_amdgcn_mfma_f32_16x16x32_bf16(*(const LAS s16x8*)(G4b + (16 * mi + fr) * LS + 8 * fq), vt_, yv, 0, 0, 0);
          *(LAS unsigned long long*)(RHt + (16 * nj + fr) * LS + 16 * mi + 4 * fq) = pack4bf(z); }
        rw_bar(bcnt, btarget, lane);
        { f32x4 z = (f32x4){0.f, 0.f, 0.f, 0.f};
          z = __builtin_amdgcn_mfma_f32_16x16x32_bf16(*(const LAS s16x8*)(Acb + 32 * LS + (16 * mi + fr) * LS + 8 * fq), *(const LAS s16x8*)(RHt + (16 * nj + fr) * LS + 8 * fq), z, 0, 0, 0);
          *(LAS unsigned long long*)(Ubt + (16 * nj + fr) * LS + 16 * mi + 4 * fq) = pack4bf(z); }
        rw_bar(bcnt, btarget, lane);
        { yv = __builtin_amdgcn_mfma_f32_16x16x32_bf16(*(const LAS s16x8*)(G3b + (16 * mi + fr) * LS + 8 * fq), *(const LAS s16x8*)(Ubt + (16 * nj + fr) * LS + 8 * fq), yv, 0, 0, 0);
          float* yp = YRAW + ((size_t)b * SEQ + ch * 32 + 16 * mi + 4 * fq) * RD + h * 64 + half * 32 + 16 * nj + fr;
#pragma unroll
          for (int rg_ = 0; rg_ < 4; ++rg_) yp[(size_t)rg_ * RD] = yv[rg_]; }
        { const int kt = w; const s16x8 bt_ = tr_frag(Bt, KS, 8 * fq, 16 * kt, fr), kt_ = tr_frag(Kt, KS, 8 * fq, 16 * kt, fr); const f32x4 gl4 = *(const LAS f32x4*)(glf + 16 * kt + 4 * fq);
#pragma unroll
          for (int vt = 0; vt < 2; ++vt) {
              st[vt] = __builtin_amdgcn_mfma_f32_16x16x32_bf16(bt_, *(const LAS s16x8*)(Ubt + (16 * vt + fr) * LS + 8 * fq), st[vt], 0, 0, 0);
              st[vt] = __builtin_amdgcn_mfma_f32_16x16x32_bf16(kt_, tr_frag(Vv, LS, 8 * fq, 16 * vt, fr), st[vt], 0, 0, 0);
              st[vt] = st[vt] * gl4;
              *(LAS unsigned long long*)(Sb + (16 * vt + fr) * KS + 16 * kt + 4 * fq) = pack4bf(st[vt]); } }
    }
#undef RC_LOAD
}

__device__ __forceinline__ float allreduce8(float x) { x += dppf<0x141>(x); x += dppf<0xB1>(x); x += dppf<0x4E>(x); return x; }
__device__ __forceinline__ void rw_bar(LAS unsigned* cnt, unsigned& target, int lane) {
    asm volatile("s_waitcnt lgkmcnt(0)" ::: "memory");
    if (lane == 0) __hip_atomic_fetch_add(cnt, 1u, __ATOMIC_RELAXED, __HIP_MEMORY_SCOPE_WORKGROUP);
    target += 4u;
    while ((unsigned)__builtin_amdgcn_readfirstlane((int)__hip_atomic_load(cnt, __ATOMIC_RELAXED, __HIP_MEMORY_SCOPE_WORKGROUP)) < target) __builtin_amdgcn_s_sleep(1);
    asm volatile("" ::: "memory");
}
constexpr int CV_BR = 8 * 32, CV_WO = 16 * 32, CV_GU = NE * 16 * 64, CV_DN = NE * 16 * 32, CV_ITEMS = 2 * CV_BR + CV_WO + CV_GU + CV_DN;
constexpr int CV_SPLIT = CV_ITEMS - 0;
constexpr int P5_NW = 8;
struct CvItem { const float* src; unsigned char* dst; int N; int f8; };
__device__ __forceinline__ CvItem cv_decode(Frame& F, int it) {
    CvItem c; int r = it; const int lane = F.lane;
    if (r < CV_BR) { const int kb = r >> 5, nb = r & 31; c.src = F.in[I_WBA] + (size_t)(kb * 128) * D + nb * 64 + lane; c.dst = F.ws + WS_WA + ((size_t)(nb * 64 + lane) * RD + kb * 128) * 2; c.N = D; c.f8 = 0; return c; } r -= CV_BR;
    if (r < CV_BR) { const int kb = r >> 5, nb = r & 31; c.src = F.in[I_WBB] + (size_t)(kb * 128) * D + nb * 64 + lane; c.dst = F.ws + WS_WB + ((size_t)(nb * 64 + lane) * RD + kb * 128) * 2; c.N = D; c.f8 = 0; return c; } r -= CV_BR;
    if (r < CV_WO) { const int kb = r >> 5, nb = r & 31; c.src = F.in[I_WOUT] + (size_t)(kb * 128) * D + nb * 64 + lane; c.dst = F.ws + WS_WO + ((size_t)(nb * 64 + lane) * D + kb * 128) * 2; c.N = D; c.f8 = 0; return c; } r -= CV_WO;
    if (r < CV_GU) { const int e = r >> 10, q = r & 1023, kb = q >> 6, nb = q & 63, n0 = nb * 64;
        const int dr = n0 < FF ? ((n0 >> 7) * 256 + (n0 & 127)) : (((n0 - FF) >> 7) * 256 + 128 + ((n0 - FF) & 127));
        c.src = F.in[I_WGU] + (size_t)e * D * 2 * FF + (size_t)(kb * 128) * (2 * FF) + n0 + lane; c.dst = F.ws + WS_WGU + (size_t)e * 2 * FF * D + (size_t)(dr + lane) * D + kb * 128; c.N = 2 * FF; c.f8 = 1; return c; } r -= CV_GU;
    { const int e = r >> 9, q = r & 511, kb = q >> 5, nb = q & 31;
        c.src = F.in[I_WDN] + (size_t)e * FF * D + (size_t)(kb * 128) * D + nb * 64 + lane; c.dst = F.ws + WS_WDN + (size_t)e * D * FF + (size_t)(nb * 64 + lane) * FF + kb * 128; c.N = D; c.f8 = 1; }
    return c;
}
__device__ __forceinline__ void convert_item(Frame& F, int it, LAS unsigned char* cvbuf);
__device__ __forceinline__ void convert_loop(Frame& F, unsigned* next, unsigned* p1done, unsigned ngemm, LAS unsigned char* cvbuf, unsigned lo, unsigned hi) {
#define CV_CLAIM(b_) do { b_ = 0xffffffffu; if (F.lane == 0) { if (!(p1done && __hip_atomic_load(p1done, __ATOMIC_RELAXED, __HIP_MEMORY_SCOPE_AGENT) >= ngemm)) b_ = __hip_atomic_fetch_add(next, 2u, __ATOMIC_RELAXED, __HIP_MEMORY_SCOPE_AGENT); } } while (0)
    unsigned nb; CV_CLAIM(nb);
    for (;;) { const unsigned b0 = (unsigned)__builtin_amdgcn_readfirstlane((int)nb); if (b0 >= hi - lo) break;
        const unsigned base = b0 + lo;
        if (!p1done) CV_CLAIM(nb);
        for (int k = 0; k < 2; ++k) { const unsigned it = base + k; if (it < hi) convert_item(F, (int)it, cvbuf); }
        if (p1done) CV_CLAIM(nb); }
#undef CV_CLAIM
}
__device__ __forceinline__ void convert_item(Frame& F, int i0, LAS unsigned char* cvbuf) {
    { const CvItem c = cv_decode(F, i0);
        float x[128];
#pragma unroll
        for (int i = 0; i < 128; ++i) x[i] = c.src[(size_t)i * c.N];
        if (c.f8) {
            const int lane = F.lane; LAS unsigned char* bw = cvbuf + lane * 144;
#pragma unroll
            for (int q = 0; q < 8; ++q) { v4u o; o.x = pk4f8(x[16 * q + 0] * F8_SW, x[16 * q + 1] * F8_SW, x[16 * q + 2] * F8_SW, x[16 * q + 3] * F8_SW); o.y = pk4f8(x[16 * q + 4] * F8_SW, x[16 * q + 5] * F8_SW, x[16 * q + 6] * F8_SW, x[16 * q + 7] * F8_SW);
                o.z = pk4f8(x[16 * q + 8] * F8_SW, x[16 * q + 9] * F8_SW, x[16 * q + 10] * F8_SW, x[16 * q + 11] * F8_SW); o.w = pk4f8(x[16 * q + 12] * F8_SW, x[16 * q + 13] * F8_SW, x[16 * q + 14] * F8_SW, x[16 * q + 15] * F8_SW);
                *(LAS v4u*)(bw + 16 * q) = o; }
            unsigned char* d0 = c.dst - (size_t)lane * 2048 + (size_t)(lane >> 3) * 2048 + (lane & 7) * 16; const LAS unsigned char* br = cvbuf + (lane >> 3) * 144 + (lane & 7) * 16;
#pragma unroll
            for (int i = 0; i < 8; ++i) { const v4u v = *(const LAS v4u*)(br + i * 8 * 144); *(v4u*)(d0 + (size_t)i * 8 * 2048) = v; } }
        else {
#pragma unroll
            for (int q = 0; q < 16; ++q) { v4u o; o.x = pk2(x[8 * q + 0], x[8 * q + 1]); o.y = pk2(x[8 * q + 2], x[8 * q + 3]); o.z = pk2(x[8 * q + 4], x[8 * q + 5]); o.w = pk2(x[8 * q + 6], x[8 * q + 7]);
                *(v4u*)(c.dst + 16 * q) = o; } } }
}

__device__ __forceinline__ void mlstm_scan_unit(Frame& F, int unit, LAS unsigned* bcnt, unsigned& btarget) {
    const int b = unit >> 5, mh = (unit >> 3) & 3, sl = unit & 7;
    const bf16* P = (const bf16*)(F.ws + WS_P); const bf16* QKC = (const bf16*)(F.ws + WS_QKC); const float* GLF = (const float*)(F.ws + WS_GLF); float* HRAW = (float*)(F.ws + WS_HRAW);
    constexpr int VS = 56;
    LAS bf16* Lq = (LAS bf16*)F.lds;
    LAS bf16* Lk = Lq + 64 * 136;
    LAS bf16* Lv = Lk + 64 * 136;
    LAS bf16* Lvs = Lv + 64 * VS;
    LAS bf16* LcT = Lvs + 64 * VS;
    LAS bf16* Ls = LcT + 2 * 48 * 136;
    LAS float* sb = (LAS float*)(Ls + 64 * 72); LAS float* su = sb + 64; LAS float* smx = su + 64; LAS float* swk = smx + 64;
    const int tid = F.tid, lane = F.lane, w = F.wave, fr = lane & 15, fq = lane >> 4;
    for (int i = tid; i < 2 * 48 * 136; i += 256) LcT[i] = 0;
    for (int i = tid; i < 64 * 16; i += 256) { const int j = i >> 4, c = 32 + (i & 15); Lv[j * VS + c] = (c == 32) ? (bf16)0x3F80 : (bf16)0; Lvs[j * VS + c] = 0; }
    const int pr0 = tid >> 4, pc = 8 * (tid & 15);
    v4u rq[4], rk[4], rv; f32x4 g3;
#define ML_LOAD(ch) do { const size_t tk0_ = (size_t)b * SEQ + (ch) * 64; \
        _Pragma("unroll") for (int i_ = 0; i_ < 4; ++i_) { const bf16* s_ = QKC + (tk0_ + pr0 + 16 * i_) * 1024 + mh * 128 + pc; rq[i_] = *(const v4u*)s_; rk[i_] = *(const v4u*)(s_ + 512); } \
        rv = *(const v4u*)(P + (tk0_ + (tid >> 2)) * NINP + MLO + 1024 + mh * 256 + sl * 32 + 8 * (tid & 3)); \
        g3 = *(const f32x4*)(GLF + (tk0_ + lane) * 16 + 4 * mh); } while (0)
    f32x4 st[2][3];
#pragma unroll
    for (int a = 0; a < 2; ++a)
#pragma unroll
        for (int n = 0; n < 3; ++n) st[a][n] = (f32x4){0.f, 0.f, 0.f, 0.f};
    float mstate = 0.f;
    ML_LOAD(0);
    rw_bar(bcnt, btarget, lane);
    for (int ch = 0; ch < SEQ / 64; ++ch) {
        const size_t tk0 = (size_t)b * SEQ + ch * 64;
        LAS bf16* cTc = LcT + (ch & 1) * 48 * 136; LAS bf16* cTn = LcT + ((ch + 1) & 1) * 48 * 136;
        float mnew, dec;
        { const float bc = g3[0], u = g3[1], pm = g3[2];
          const float gtot = __shfl(bc, 63), pmall = __shfl(pm, 63);
          mnew = gtot + fmaxf(mstate, pmall); dec = __expf(gtot + mstate - mnew);
          const float wk = __expf(u + gtot - mnew);
          sb[lane] = bc; su[lane] = u; smx[lane] = fmaxf(mstate, pm); swk[lane] = wk;
          if (w == 0) Lvs[lane * VS + 32] = (bf16)f2bf(wk); }
#pragma unroll
        for (int i = 0; i < 4; ++i) { *(LAS v4u*)(Lq + (pr0 + 16 * i) * 136 + pc) = rq[i]; *(LAS v4u*)(Lk + (pr0 + 16 * i) * 136 + pc) = rk[i]; }
        LDS_WAIT();
        { const int j = tid >> 2, d0 = 8 * (tid & 3); const float wkj = swk[j]; *(LAS v4u*)(Lv + j * VS + d0) = rv;
          const unsigned uu[4] = {rv.x, rv.y, rv.z, rv.w}; v4u sv;
          sv.x = pk2(wkj * __uint_as_float(uu[0] << 16), wkj * __uint_as_float(uu[0] & 0xffff0000u)); sv.y = pk2(wkj * __uint_as_float(uu[1] << 16), wkj * __uint_as_float(uu[1] & 0xffff0000u));
          sv.z = pk2(wkj * __uint_as_float(uu[2] << 16), wkj * __uint_as_float(uu[2] & 0xffff0000u)); sv.w = pk2(wkj * __uint_as_float(uu[3] << 16), wkj * __uint_as_float(uu[3] & 0xffff0000u));
          *(LAS v4u*)(Lvs + j * VS + d0) = sv; }
        if (ch + 1 < SEQ / 64) ML_LOAD(ch + 1);
        rw_bar(bcnt, btarget, lane);
        { const int tt = w; const int t = 16 * tt + fr; const float mxt = smx[t];
#pragma unroll
          for (int jt = 0; jt < 4; ++jt) { f32x4 acc = (f32x4){0.f, 0.f, 0.f, 0.f};
              if (jt <= tt) {
#pragma unroll
                  for (int ks = 0; ks < 4; ++ks) { const s16x8 a = *(const LAS s16x8*)(Lk + (16 * jt + fr) * 136 + 32 * ks + 8 * fq), bq = *(const LAS s16x8*)(Lq + (16 * tt + fr) * 136 + 32 * ks + 8 * fq);
                      acc = __builtin_amdgcn_mfma_f32_16x16x32_bf16(a, bq, acc, 0, 0, 0); }
                  const f32x4 u4 = *(const LAS f32x4*)(su + 16 * jt + 4 * fq);
#pragma unroll
                  for (int rg_ = 0; rg_ < 4; ++rg_) { const int j = 16 * jt + 4 * fq + rg_; acc[rg_] = (j <= t) ? acc[rg_] * __expf(u4[rg_] - mxt) : 0.f; } }
              *(LAS unsigned long long*)(Ls + t * 72 + 16 * jt + 4 * fq) = pack4bf(acc); } }
        rw_bar(bcnt, btarget, lane);
        { const int mi = w; f32x4 a1[3], a2[3];
#pragma unroll
          for (int n = 0; n < 3; ++n) { a1[n] = (f32x4){0.f, 0.f, 0.f, 0.f}; a2[n] = a1[n]; }
#pragma unroll
          for (int ks = 0; ks < 2; ++ks) { const s16x8 A = *(const LAS s16x8*)(Ls + (16 * mi + fr) * 72 + 32 * ks + 8 * fq);
#pragma unroll
              for (int n = 0; n < 3; ++n) a1[n] = __builtin_amdgcn_mfma_f32_16x16x32_bf16(A, tr_frag(Lv, VS, 32 * ks + 8 * fq, 16 * n, fr), a1[n], 0, 0, 0); }
#pragma unroll
          for (int ks = 0; ks < 4; ++ks) { const s16x8 A = *(const LAS s16x8*)(Lq + (16 * mi + fr) * 136 + 32 * ks + 8 * fq);
#pragma unroll
              for (int n = 0; n < 3; ++n) a2[n] = __builtin_amdgcn_mfma_f32_16x16x32_bf16(A, *(const LAS s16x8*)(cTc + (16 * n + fr) * 136 + 32 * ks + 8 * fq), a2[n], 0, 0, 0); }
          const f32x4 mx4 = *(const LAS f32x4*)(smx + 16 * mi + 4 * fq), b4 = *(const LAS f32x4*)(sb + 16 * mi + 4 * fq);
#pragma unroll
          for (int rg_ = 0; rg_ < 4; ++rg_) { const float wi = __expf(mstate - mx4[rg_]); float den = a1[2][rg_] + wi * a2[2][rg_]; den = __shfl(den, lane & 48);
              const float mt = b4[rg_] + mx4[rg_]; const float inv = __builtin_amdgcn_rcpf(fmaxf(fabsf(den), __expf(-mt))); float* hp = HRAW + (tk0 + 16 * mi + 4 * fq + rg_) * RD + mh * 256 + sl * 32 + fr;
              hp[0] = (a1[0][rg_] + wi * a2[0][rg_]) * inv; hp[16] = (a1[1][rg_] + wi * a2[1][rg_]) * inv; } }
        {
#pragma unroll
          for (int a = 0; a < 2; ++a) {
#pragma unroll
              for (int n = 0; n < 3; ++n) st[a][n] = st[a][n] * dec;
#pragma unroll
              for (int ks = 0; ks < 2; ++ks) { const s16x8 A = tr_frag(Lk, 136, 32 * ks + 8 * fq, 16 * (2 * w + a), fr);
#pragma unroll
                  for (int n = 0; n < 3; ++n) st[a][n] = __builtin_amdgcn_mfma_f32_16x16x32_bf16(A, tr_frag(Lvs, VS, 32 * ks + 8 * fq, 16 * n, fr), st[a][n], 0, 0, 0); }
#pragma unroll
              for (int n = 0; n < 3; ++n) *(LAS unsigned long long*)(cTn + (16 * n + fr) * 136 + 16 * (2 * w + a) + 4 * fq) = pack4bf(st[a][n]); } }
        mstate = mnew;
        rw_bar(bcnt, btarget, lane);
    }
#undef ML_LOAD
}

__device__ __forceinline__ float rowsum4(f32x4 v) { return (v[0] + v[1]) + (v[2] + v[3]); }
__device__ __forceinline__ void p5_finalize(Frame& F) {
    const bf16* __restrict__ P = (const bf16*)(F.ws + WS_P); const bf16* __restrict__ AGp = (const bf16*)(F.ws + WS_WAG + 64 * MiB); const float* __restrict__ YRAW = (const float*)(F.ws + WS_YRAW); const float* __restrict__ HRAW = (const float*)(F.ws + WS_HRAW);
    bf16* __restrict__ OA = (bf16*)(F.ws + WS_OA); bf16* __restrict__ OB = (bf16*)(F.ws + WS_OB);
    const int gw = F.bid * P5_NW + F.wave, NGW = F.G * P5_NW, lane = F.lane;
    { const int hq = gw & 3, c0 = (hq * 4 + (lane >> 4)) * 64 + 4 * (lane & 15);
      const f32x4 lnw = *(const f32x4*)(F.in[I_LNW] + c0), lnb = *(const f32x4*)(F.in[I_LNB] + c0); const bf16* __restrict__ BON = (const bf16*)(F.ws + WS_WAG + 128 * MiB);
      v2u bo[2], gb[2]; f32x4 y4[2];
#define P5_LOAD(i_, q_) do { if ((q_) < T * 4) { const int tk_ = (q_) >> 2; bo[i_] = *(const v2u*)(BON + (size_t)tk_ * RD + c0); gb[i_] = *(const v2u*)(AGp + (size_t)tk_ * D + RD + c0); y4[i_] = *(const f32x4*)(YRAW + (size_t)tk_ * RD + c0); } } while (0)
      P5_LOAD(0, gw); P5_LOAD(1, gw + NGW);
      for (int q = gw; q < T * 4; q += 2 * NGW) { const v2u cb0 = bo[0], cg0 = gb[0], cb1 = bo[1], cg1 = gb[1]; const f32x4 cy0 = y4[0], cy1 = y4[1];
          P5_LOAD(0, q + 2 * NGW); P5_LOAD(1, q + 3 * NGW);
#pragma unroll
          for (int i = 0; i < 2; ++i) { const int qq = q + i * NGW; if (qq < T * 4) { const int tk = qq >> 2; const f32x4 bon = i ? UNP4(cb1) : UNP4(cb0), g = i ? UNP4(cg1) : UNP4(cg0), y = i ? cy1 : cy0;
              const float mean = allreduce16(rowsum4(y)) * (1.f / 64.f); const f32x4 dl = y - mean;
              const float var = allreduce16(rowsum4(dl * dl)) * (1.f / 64.f); const float rs = __builtin_amdgcn_rsqf(var + GN_EPS);
              const f32x4 o = (dl * rs * lnw + lnb + bon) * g;
              v2u ov; ov.x = pk2(o[0], o[1]); ov.y = pk2(o[2], o[3]); *(v2u*)(OA + (size_t)tk * RD + c0) = ov; } } }
#undef P5_LOAD
    }
    { const int mh = gw & 3, d0 = mh * 256 + 4 * lane; const f32x4 nw = *(const f32x4*)(F.in[I_MNW] + d0);
      f32x4 hv[2]; v2u po[2];
#define P5B_LOAD(i_, q_) do { if ((q_) < T * 4) { const int tk_ = (q_) >> 2; hv[i_] = *(const f32x4*)(HRAW + (size_t)tk_ * RD + d0); po[i_] = *(const v2u*)(P + (size_t)tk_ * NINP + MLO + 2056 + d0); } } while (0)
      P5B_LOAD(0, gw); P5B_LOAD(1, gw + NGW);
      for (int q = gw; q < T * 4; q += 2 * NGW) { const f32x4 ch0 = hv[0], ch1 = hv[1]; const v2u cp0 = po[0], cp1 = po[1];
          P5B_LOAD(0, q + 2 * NGW); P5B_LOAD(1, q + 3 * NGW);
#pragma unroll
          for (int i = 0; i < 2; ++i) { const int qq = q + i * NGW; if (qq < T * 4) { const int tk = qq >> 2; const f32x4 h4 = i ? ch1 : ch0; const v2u p2 = i ? cp1 : cp0;
              float ss = allreduce16(rowsum4(h4 * h4)); ss += __shfl_xor(ss, 16); ss += __shfl_xor(ss, 32);
              const float rs = __builtin_amdgcn_rsqf(ss * (1.f / 256.f) + NORM_EPS); const f32x4 og = UNP4(p2);
              const float o0 = h4[0] * rs * nw[0] * sigm(og[0]), o1 = h4[1] * rs * nw[1] * sigm(og[1]), o2 = h4[2] * rs * nw[2] * sigm(og[2]), o3 = h4[3] * rs * nw[3] * sigm(og[3]);
              v2u o; o.x = pk2(o0, o1); o.y = pk2(o2, o3); *(v2u*)(OB + (size_t)tk * RD + d0) = o; } } }
#undef P5B_LOAD
    }
}

typedef float f32x16 __attribute__((ext_vector_type(16)));
__device__ __forceinline__ void p8_route(Frame& F) {
    const bf16* X1 = (const bf16*)(F.ws + WS_X1); unsigned char* H2 = (unsigned char*)(F.ws + WS_HN); int* RLIST = (int*)(F.ws + WS_RLIST); float* RWT = (float*)(F.ws + WS_RW);
    const float* RWS = (const float*)(F.ws + WS_RWS); const float* nw = F.in[I_N2W]; const float* rtb = F.in[I_RTB];
    LAS float* part = (LAS float*)F.lds;
    LAS float* ssq = part + 8 * 32 * 33;
    LAS float* lgt = ssq + 256;
    LAS float* srs = lgt + 32 * 33;
    const int lane = F.lane, w = F.wave, i = lane & 31, h = lane >> 5, tid = F.tid;
    for (int tile = F.bid; tile < T / 32; tile += F.G) {
        const int m0 = tile * 32; const bf16* xrow = X1 + (size_t)(m0 + i) * D + 256 * w + 4 * h;
        f32x16 acc;
#pragma unroll
        for (int r_ = 0; r_ < 16; ++r_) acc[r_] = 0.f;
        float ss = 0.f; const float* bp = RWS + (size_t)(256 * w + 4 * h) * NE + i;
#pragma unroll 4
        for (int q = 0; q < 32; ++q) { const v2u xb_ = *(const v2u*)(xrow + 8 * q); const f32x4 xa = UNP4(xb_);
#pragma unroll
            for (int j = 0; j < 4; ++j) acc = __builtin_amdgcn_mfma_f32_32x32x2f32(xa[j], bp[(8 * q + j) * NE], acc, 0, 0, 0);
            ss += (xa[0] * xa[0] + xa[1] * xa[1]) + (xa[2] * xa[2] + xa[3] * xa[3]); }
        ss += __shfl_xor(ss, 32);
        if (h == 0) ssq[w * 32 + i] = ss;
#pragma unroll
        for (int r_ = 0; r_ < 16; ++r_) part[(w * 32 + (r_ & 3) + 8 * (r_ >> 2) + 4 * h) * 33 + i] = acc[r_];
        __syncthreads();
#pragma unroll
        for (int k2 = 0; k2 < 2; ++k2) { const int idx = tid + NTHR * k2, ii = idx >> 5, e = idx & 31; float sm = 0.f, sq = 0.f;
#pragma unroll
            for (int ww = 0; ww < 8; ++ww) { sm += part[(ww * 32 + ii) * 33 + e]; sq += ssq[ww * 32 + ii]; }
            const float rs = 1.f / sqrtf(sq * (1.f / D) + NORM_EPS); lgt[ii * 33 + e] = sm * rs + rtb[e]; if (e == 0) srs[ii] = rs; }
        __syncthreads();
        { const float rs = srs[i] * F8_SX; unsigned char* orow = H2 + (size_t)(m0 + i) * D + 256 * w + 4 * h;
#pragma unroll 8
          for (int q = 0; q < 32; ++q) { const f32x4 n4 = *(const f32x4*)(nw + 256 * w + 4 * h + 8 * q); const v2u xb_ = *(const v2u*)(xrow + 8 * q); const f32x4 hv = UNP4(xb_) * rs * n4; *(unsigned*)(orow + 8 * q) = pk4f8(hv[0], hv[1], hv[2], hv[3]); } }
        if (tid < 32) { const LAS float* lr = lgt + tid * 33; unsigned used = 0u; int idx[4]; float val[4];
#pragma unroll
            for (int s4 = 0; s4 < 4; ++s4) { float best = -INFINITY; int bi = 0;
                for (int e = 0; e < 32; ++e) { const float v = lr[e]; const bool ok = !((used >> e) & 1u) && (v > best); best = ok ? v : best; bi = ok ? e : bi; }
                used |= 1u << bi; idx[s4] = bi; val[s4] = best; }
            const float e1 = __expf(val[1] - val[0]), e2 = __expf(val[2] - val[0]), e3 = __expf(val[3] - val[0]); const float inv = 1.f / (1.f + e1 + e2 + e3);
            const float wv[4] = {inv, e1 * inv, e2 * inv, e3 * inv};
            unsigned pos[4];
#pragma unroll
            for (int s4 = 0; s4 < 4; ++s4) pos[s4] = atomicAdd(F.ctl + CW_CNT + 64 * idx[s4], 1u);
#pragma unroll
            for (int s4 = 0; s4 < 4; ++s4) { RLIST[idx[s4] * ECAP + pos[s4]] = (m0 + tid) * 4 + s4; RWT[idx[s4] * ECAP + pos[s4]] = wv[s4]; } }
        __syncthreads();
    }
}

__device__ __forceinline__ void build_moe_tables(Frame& F) {
    LAS int* MI = (LAS int*)F.MISC;
    __syncthreads();
    if (F.tid < NE) MI[MI_CNT + F.tid] = (int)__hip_atomic_load(F.ctl + CW_CNT + 64 * F.tid, __ATOMIC_RELAXED, __HIP_MEMORY_SCOPE_AGENT);
    __syncthreads();
    if (F.tid == 0) { int mt = 0, cs = 0;
        for (int e = 0; e < NE; ++e) { const int c = MI[MI_CNT + e]; MI[MI_POFF + e] = mt * 256; MI[MI_CST + e] = cs; cs += c;
            const int nt = (c + 255) >> 8; for (int i = 0; i < nt; ++i) { MI[MI_TILE_E + mt + i] = e; MI[MI_TILE_I0 + mt + i] = i * 256; } mt += nt; }
        MI[MI_CST + NE] = cs; MI[MI_MT] = mt; }
    __syncthreads();
}
__device__ __forceinline__ void p9_gather(Frame& F) {
    build_moe_tables(F);
    const LAS int* MI = (const LAS int*)F.MISC; const bf16* H2 = (const bf16*)(F.ws + WS_HN); bf16* XB = (bf16*)(F.ws + WS_XB); const int* RLIST = (const int*)(F.ws + WS_RLIST);
    const int gw = F.bid * NWAVES + F.wave, NGW = F.G * NWAVES, total = MI[MI_CST + NE];
    for (int q = gw; q < total; q += NGW) { int e = 0;
        for (int k = 1; k < NE; ++k) e = (MI[MI_CST + k] <= q) ? k : e;
        const int i = q - MI[MI_CST + e]; const int tok = RLIST[e * ECAP + i] >> 2;
        const v4u* src = (const v4u*)(H2 + (size_t)tok * D) + F.lane; v4u* dst = (v4u*)(XB + (size_t)(MI[MI_POFF + e] + i) * D) + F.lane;
#pragma unroll
        for (int j = 0; j < 4; ++j) dst[64 * j] = src[64 * j]; }
}
__device__ __forceinline__ void p12_final(Frame& F) {
    const bf16* X1 = (const bf16*)(F.ws + WS_X1); const unsigned char* YS = (const unsigned char*)(F.ws + WS_YS); const float* fw = F.in[I_FNW];
    const int gw = F.bid * NWAVES + F.wave, NGW = F.G * NWAVES;
    for (int m = gw; m < T; m += NGW) {
        const v2u* xr = (const v2u*)(X1 + (size_t)m * D) + F.lane; f32x4 v[8]; float s = 0.f;
#pragma unroll
        for (int j = 0; j < 8; ++j) { const v2u xb_ = xr[64 * j]; v[j] = UNP4(xb_);
#pragma unroll
            for (int sl = 0; sl < 4; ++sl) { const int y = ((const int*)(YS + ((size_t)m * 4 + sl) * D))[F.lane + 64 * j];
                const f32x2 ylo = __builtin_amdgcn_cvt_pk_f32_fp8(y, false), yhi = __builtin_amdgcn_cvt_pk_f32_fp8(y, true);
                v[j][0] += ylo[0] * (1.f / F8_SY); v[j][1] += ylo[1] * (1.f / F8_SY); v[j][2] += yhi[0] * (1.f / F8_SY); v[j][3] += yhi[1] * (1.f / F8_SY); }
            s += (v[j][0] * v[j][0] + v[j][1] * v[j][1]) + (v[j][2] * v[j][2] + v[j][3] * v[j][3]); }
        const float rstd = __builtin_amdgcn_rsqf(wave_sum(s) * (1.f / D) + NORM_EPS);
        f32x4* orow = (f32x4*)(F.out + (size_t)m * D) + F.lane;
#pragma unroll
        for (int j = 0; j < 8; ++j) { const f32x4 w = ((const f32x4*)fw)[F.lane + 64 * j]; orow[64 * j] = v[j] * rstd * w; }
    }
}

__global__ void __launch_bounds__(NTHR, 2) mk_fwd(Args args) {
    extern __shared__ __attribute__((aligned(16))) unsigned char lds[];
    Frame F;
    F.lds = (LAS unsigned char*)lds; F.MISC = (volatile LAS unsigned*)(F.lds + MISC_OFF);
    F.tid = threadIdx.x; F.lane = F.tid & 63; F.wave = __builtin_amdgcn_readfirstlane(F.tid >> 6); F.G = gridDim.x; F.bid = blockIdx.x;
    F.in = args.in; F.out = args.out; F.ws = args.ws; F.ctl = (unsigned*)(args.ws + WS_CTL);
    for (int u = F.tid; u < (LDS_BYTES - MISC_OFF) / 4; u += NTHR) ((LAS unsigned*)(F.lds + MISC_OFF))[u] = 0u;
    __syncthreads();
    XcdBarrier bar; bar.bar = F.ctl + CW_BAR; bar.x = 0; bar.st = nullptr;
    if (MK_N_LAUNCHES == 1) bar = xcd_barrier_post(F.ctl + CW_BAR, F.MISC + 8);
    const int lo = args.ph_lo, hi = args.ph_hi;
#define IN(k) (lo <= (k) && (k) < hi)
#ifndef PROBE_PHASE
#define PROBE_PHASE -1
#endif
#define REP(k) ((PROBE_PHASE) == (k) ? 2 : 1)
#ifndef TPROBE
#define TPROBE -1
#endif
#if TPROBE >= 0
    unsigned long long tpA = 0, tpB = 0;
#define TP_A(k) do { if ((k) == TPROBE / 100) tpA = __builtin_amdgcn_s_memrealtime(); } while (0)
#define TP_B(k) do { if ((k) == TPROBE % 100) tpB = __builtin_amdgcn_s_memrealtime(); } while (0)
#else
#define TP_A(k) do {} while (0)
#define TP_B(k) do {} while (0)
#endif
#define SEAM(k) do { if (IN(k) && IN((k) + 1)) xcd_barrier(bar); TP_B(k); } while (0)
    LAS unsigned char* ring = F.lds;
    const LAS int* MI = (const LAS int*)F.MISC;

    static_assert(MK_N_LAUNCHES == 1, "the W_in quantisation needs an in-launch barrier inside phase 0");
    TP_A(0); if (IN(0)) { p0_prologue(F); xcd_barrier(bar); p0b_win(F); } SEAM(0);
    TP_A(1); if (IN(1)) {
        const int ng = F.G > 2 * NCV ? F.G - NCV : F.G;
        if (F.bid < ng) {
            pg8::Gemm g{(const bf16*)(F.ws + WS_HN), (const bf16*)(F.ws + WS_WIN), T, NINP, D / 2}; pg8::StaticOrder S; S.init(T, NINP, ng, F.bid);
            EpiP1I8 E{(bf16*)(F.ws + WS_P), NINP, (const float*)(F.ws + WS_RA), F.ctl + CW_COLMAX};
            pg8::gemm_phase<EpiP1I8, pg8::StaticOrder, true, true, false, true>(ring, g, S, E);
            if (F.tid == 0) __hip_atomic_fetch_add(F.ctl + CW_P1DONE, 1u, __ATOMIC_RELAXED, __HIP_MEMORY_SCOPE_AGENT);
        } else if (F.wave >= CV1_W0) convert_loop(F, F.ctl + CW_CVNEXT, F.ctl + CW_P1DONE, (unsigned)ng, F.lds + F.wave * 9216, 0u, (unsigned)CV_SPLIT);
    } SEAM(1);
    TP_A(2); if (IN(2)) { for (int rep = 0; rep < REP(2); ++rep) p2_lora_in(F); } SEAM(2);
    TP_A(3); if (IN(3)) {
        pg8::Gemm g{(const bf16*)(F.ws + WS_LIN), (const bf16*)(F.ws + WS_WL), T, 3072, 512}; pg8::StaticOrder S; S.init(T, 3072, F.G, F.bid);
        EpiLora E{(float*)(F.ws + WS_WAG), (bf16*)(F.ws + WS_WAG + 64 * MiB), F.in[I_W0], F.in[I_A0]};
        pg8::gemm_phase<EpiLora, pg8::StaticOrder, true, true>(ring, g, S, E);
    } SEAM(3);
    TP_A(4); if (IN(4)) {
        { LAS unsigned* ctl2 = (LAS unsigned*)F.MISC + 16;
          TP_A(14); TP_A(15); TP_A(16); if (F.wave < 4) { TP_B(14); TP_B(16); unsigned bt = 0u; for (int rep = 0; rep < REP(40); ++rep) for (int u = F.bid; u < 256; u += F.G) rwkv_chunk_unit(F, u, (LAS unsigned char*)F.MISC + 256, ctl2, bt); TP_B(15); }
          else { Frame F2 = F; F2.tid = F.tid - 256; F2.wave = F.wave - 4; F2.lds = F.lds + 45056; unsigned bt = 0u;
                 for (int rep = 0; rep < REP(41); ++rep) for (int u = F.bid; u < 256; u += F.G) mlstm_scan_unit(F2, u, ctl2 + 2, bt);
                 rw_bar(ctl2 + 2, bt, F2.lane); TP_B(15); TP_B(16); }
          if (F.wave >= CV_W0) convert_loop(F, F.ctl + CW_CVNEXT, nullptr, 0u, F.lds + 45056 + (F.wave - 4) * 9216, 0u, (unsigned)CV_SPLIT);
          if (F.wave >= 4) TP_B(14);
          __syncthreads(); }
    } SEAM(4);
    TP_A(5); if (IN(5)) { if (F.wave < P5_NW) { for (int rep = 0; rep < REP(5); ++rep) p5_finalize(F); }
                 else convert_loop(F, F.ctl + CW_CVNEXT2, nullptr, 0u, F.lds + F.wave * 9216, (unsigned)CV_SPLIT, (unsigned)CV_ITEMS); }     SEAM(5);
    TP_A(6); if (IN(6)) {
        { pg8::Gemm g{(const bf16*)(F.ws + WS_OA), (const bf16*)(F.ws + WS_WA), T, D, RD}; pg8::StaticOrder S; S.init(T, D, F.G, F.bid);
          EpiGateA E{(bf16*)(F.ws + WS_TMP), (const bf16*)(F.ws + WS_P), F.in[I_BGATE]};
          pg8::gemm_phase<EpiGateA, pg8::StaticOrder, true, true>(ring, g, S, E); }
        VM_WAIT(); __syncthreads();
        { pg8::Gemm g{(const bf16*)(F.ws + WS_OB), (const bf16*)(F.ws + WS_WB), T, D, RD}; pg8::StaticOrder S; S.init(T, D, F.G, F.bid);
          EpiGateB E{(const bf16*)(F.ws + WS_TMP), (bf16*)(F.ws + WS_MRG), (const bf16*)(F.ws + WS_P), F.in[I_BGATE]};
          pg8::gemm_phase<EpiGateB, pg8::StaticOrder, true, true>(ring, g, S, E); }
    } SEAM(6);
    TP_A(7); if (IN(7)) {
        pg8::Gemm g{(const bf16*)(F.ws + WS_MRG), (const bf16*)(F.ws + WS_WO), T, D, D}; pg8::StaticOrder S; S.init(T, D, F.G, F.bid);
        EpiResid E{F.in[I_X], (bf16*)(F.ws + WS_X1)};
        pg8::gemm_phase<EpiResid, pg8::StaticOrder, true, true>(ring, g, S, E);
    } SEAM(7);
    TP_A(8); if (IN(8)) { p8_route(F); } SEAM(8);
    TP_A(10); if (IN(10)) {
        build_moe_tables(F);
        const int mt = MI[MI_MT];
        pg8::Gemm g{(const bf16*)(F.ws + WS_HN), (const bf16*)(F.ws + WS_WGU), mt * 256, 2 * FF, D / 2};
        MoeGatherOrder S; S.init(mt * 256, 2 * FF, F.G, F.bid); S.tile_e = MI + MI_TILE_E; S.estride = (size_t)2 * FF * D;
        S.tile_i0 = MI + MI_TILE_I0; S.cnt = MI + MI_CNT; S.rlist = (const int*)(F.ws + WS_RLIST); S.rowoff = (LAS unsigned*)F.MISC + MI_ROWOFF; S.rowbytes = D;
        EpiSwiGLU E{(unsigned char*)(F.ws + WS_ACT), F.in[I_BGU], MI + MI_TILE_E};
        pg8::gemm_phase<EpiSwiGLU, MoeGatherOrder, true, true, true>(ring, g, S, E);
    } SEAM(10);
    TP_A(11); if (IN(11)) {
        build_moe_tables(F);
        const int mt = MI[MI_MT];
        pg8::Gemm g{(const bf16*)(F.ws + WS_ACT), (const bf16*)(F.ws + WS_WDN), mt * 256, D, FF / 2};
        MoeOrder S; S.init(mt * 256, D, F.G, F.bid); S.tile_e = MI + MI_TILE_E; S.estride = (size_t)D * FF;
        LAS int* rowdst = (LAS int*)F.MISC + MI_ROWOFF; LAS float* rowwt = (LAS float*)F.MISC + MI_ROWOFF + 10 * 256;
        fill_down_tables(F, S, rowdst, rowwt);
        EpiDown E{(unsigned char*)(F.ws + WS_YS), F.in[I_BDN], MI + MI_TILE_E, rowdst, rowwt};
        pg8::gemm_phase<EpiDown, MoeOrder, true, true, true>(ring, g, S, E);
    } SEAM(11);
    TP_A(12); if (IN(12)) { for (int rep = 0; rep < REP(12); ++rep) p12_final(F); } TP_B(12);
#if TPROBE >= 0
    { const unsigned long long tend = __builtin_amdgcn_s_memrealtime() + 4ull * (tpB - tpA); while (__builtin_amdgcn_s_memrealtime() < tend) __builtin_amdgcn_s_sleep(8); }
#endif
#undef IN
#undef SEAM
}

extern "C" void kernel_launch(void* const* d_in, const int* in_sizes, int n_in, void* d_out, int out_size, void* d_ws, size_t ws_size, hipStream_t stream) {
    static int grid = 0;
    if (grid == 0) {
        if (n_in != 30 || out_size != T * D || ws_size < WS_END) { fprintf(stderr, "kernel_launch: unexpected problem (n_in %d, out %d, ws %zu)\n", n_in, out_size, ws_size); grid = -1; return; }
        int dev = 0, cus = 0, per_cu = 0;
        if (hipGetDevice(&dev) != hipSuccess || hipDeviceGetAttribute(&cus, hipDeviceAttributeMultiprocessorCount, dev) != hipSuccess) { grid = -1; return; }
        if (hipFuncSetAttribute((const void*)mk_fwd, hipFuncAttributeMaxDynamicSharedMemorySize, LDS_BYTES) != hipSuccess) { fprintf(stderr, "kernel_launch: hipFuncSetAttribute failed\n"); grid = -1; return; }
        if (hipOccupancyMaxActiveBlocksPerMultiprocessor(&per_cu, (const void*)mk_fwd, NTHR, LDS_BYTES) != hipSuccess || per_cu < 1) fprintf(stderr, "kernel_launch: occupancy query says %d\n", per_cu);
        (void)hipGetLastError();
        grid = cus;
    }
    if (grid < 0) return;
    if (hipMemsetAsync((char*)d_ws + WS_CTL, 0, CTL_ZERO_BYTES, stream) != hipSuccess) return;
    Args a{};
    for (int i = 0; i < 30; ++i) a.in[i] = (const float*)d_in[i];
    a.out = (float*)d_out; a.ws = (unsigned char*)d_ws;
    for (int li = 0; li < MK_N_LAUNCHES; ++li) {
        a.ph_lo = (MK_N_LAUNCHES == 1) ? 0 : li; a.ph_hi = (MK_N_LAUNCHES == 1) ? NPH : li + 1;
        hipLaunchKernelGGL(mk_fwd, dim3(grid), dim3(NTHR), LDS_BYTES, stream, a);
        const hipError_t le = hipPeekAtLastError();
        if (le != hipSuccess) { fprintf(stderr, "kernel_launch: launch %d failed: %s\n", li, hipGetErrorName(le)); break; }
    }
}
```

```cpp
#include <hip/hip_runtime.h>
#include <cstdio>
#include <cstdint>

#define MK_N_LAUNCHES 1
#define PROBE_PHASE -1
namespace pg8 {
#define PG8_LAS __attribute__((address_space(3)))
typedef unsigned short bf16_t;
typedef short bf16x8 __attribute__((ext_vector_type(8)));
typedef float f32x4 __attribute__((ext_vector_type(4)));
typedef unsigned u32x4 __attribute__((ext_vector_type(4)));
constexpr int BM = 256, BK = 64, HALF = 128, HTB = HALF * BK * 2  , STAGE_BYTES = 8 * HTB, NXCD = 8, WGM = 8;

__host__ __device__ __forceinline__ int lds_byte(int r, int c) { const int st = (r >> 4) * 2 + (c >> 5), rr = r & 15, cc = c & 31, ob = rr * 64 + cc * 2; return st * 1024 + (ob ^ (((ob >> 9) & 1) << 5)); }
__host__ __device__ __forceinline__ void stage_rc(int b, int& R, int& C) { const int st = b / 1024, sb = b % 1024, swz = sb ^ (((sb >> 9) & 1) << 5); R = (st >> 1) * 16 + swz / 64; C = (st & 1) * 32 + (swz % 64) / 2; }
__host__ __device__ __forceinline__ int perm32(int rho) { const int n = rho >> 4, i = rho & 15; return 8 * (i >> 2) + 4 * n + (i & 3); }

struct Unit { int pm, pn, ord; };
struct Gemm { const bf16_t* A; const bf16_t* Bt; int M, N, K; };

struct StaticOrder {
    int nM, nN, nwg, G, c;
    __host__ __device__ void init(int M, int N, int G_, int c_) { nM = M / BM; nN = N / BM; nwg = nM * nN; G = G_; c = c_; }
    __host__ __device__ bool next(int i, Unit& u) const {
        const long L = (long)i * G + c; if (L >= nwg) return false;
        int wgid = (int)L; { const int q = nwg / NXCD, r = nwg % NXCD, xcd = wgid % NXCD, off = wgid / NXCD; wgid = (xcd < r ? xcd * (q + 1) : r * (q + 1) + (xcd - r) * q) + off; }
        const int nig = WGM * nN, gid = wgid / nig, fm = gid * WGM, gsz = (nM - fm) < WGM ? (nM - fm) : WGM;
        u.pm = fm + ((wgid % nig) % gsz); u.pn = (wgid % nig) / gsz; u.ord = i; return true;
    }
    __device__ __forceinline__ void a_ready(const Unit&) const {}
    static constexpr bool GATHER = false;
    __device__ __forceinline__ void fill_all() const {}
    __device__ __forceinline__ unsigned row_off(int, int) const { return 0u; }
    __device__ __forceinline__ void done(const Unit&) const {}
    __device__ __forceinline__ size_t a_off(const Unit& u, size_t tstep) const { return (size_t)u.pm * tstep; }
    __device__ __forceinline__ size_t b_off(const Unit& u, size_t tstep) const { return (size_t)u.pn * tstep; }
};
__device__ __forceinline__ unsigned cvt_pk_bf16(float lo, float hi) { unsigned r; asm volatile("v_cvt_pk_bf16_f32 %0, %1, %2" : "=v"(r) : "v"(lo), "v"(hi)); return r; }
typedef int v8i32 __attribute__((ext_vector_type(8)));
typedef int v4i32 __attribute__((ext_vector_type(4)));
__device__ __forceinline__ v8i32 cat8(bf16x8 lo, bf16x8 hi) { const v4i32 a = __builtin_bit_cast(v4i32, lo), b = __builtin_bit_cast(v4i32, hi); return __builtin_shufflevector(a, b, 0, 1, 2, 3, 4, 5, 6, 7); }
template <class Epi, class Sched, bool ALIGN_EPI = false, bool SP2 = false, bool FP8 = false, bool I8 = false>
__device__ __forceinline__ void gemm_phase(PG8_LAS unsigned char* lds, const Gemm g, const Sched& S, const Epi& E) {
    const int tid = threadIdx.x, wid = __builtin_amdgcn_readfirstlane(tid >> 6), lane = tid & 63, wr = wid >> 2, wc = wid & 3, fr = lane & 15, fq = lane >> 4;
    const int K = g.K, nt = K / BK;
    unsigned voffA[2], voffB[2];
#pragma unroll
    for (int i = 0; i < 2; ++i) { int R, C; stage_rc(tid * 16 + i * 8192, R, C); const int Rb = Epi::PERM ? ((R & ~31) + perm32(R & 31)) : R;
        voffA[i] = (unsigned)(R * K + C) * 2u; voffB[i] = (unsigned)(Rb * K + C) * 2u; }
    unsigned voffA1[2]; int rselA[2]; unsigned cselA[2];
#pragma unroll
    for (int i = 0; i < 2; ++i) { int R, C; stage_rc(tid * 16 + i * 8192, R, C); rselA[i] = R; cselA[i] = (unsigned)C * 2u; voffA1[i] = voffA[i]; }
    const size_t kstep = (size_t)(BK * 2);
    const size_t hstep = (size_t)HALF * K * 2;
    const size_t tstep = 2 * hstep;
    const size_t hstepA = Sched::GATHER ? (size_t)0 : hstep;
#define PG8_ROWS(_u) do { _Pragma("unroll") for (int _i = 0; _i < 2; ++_i) { voffA[_i] = S.row_off((_u), rselA[_i]) + cselA[_i]; voffA1[_i] = S.row_off((_u), HALF + rselA[_i]) + cselA[_i]; } } while (0)
    const unsigned ldsw = (unsigned)wid * 1024u;
    const int aoff = lds_byte(wr * 64 + fr, fq * 8), boff = lds_byte(wc * 32 + fr, fq * 8);
#define PG8_SA(b, h) (((b) * 2 + (h)) * HTB)
#define PG8_SB(b, h) ((4 + (b) * 2 + (h)) * HTB)
#define PG8_STAGE(bufoff, gbase, voff) do { _Pragma("unroll") for (int _i = 0; _i < 2; ++_i) \
        __builtin_amdgcn_global_load_lds((const unsigned*)((const char*)(gbase) + (voff)[_i]), (PG8_LAS unsigned*)(lds + (bufoff) + ldsw + _i * 8192), 16, 0, 0); } while (0)
#define PG8_LDA(dst, b, h) do { if constexpr (FP8) { _Pragma("unroll") for (int m = 0; m < 4; ++m) dst##8[m] = cat8(*(const PG8_LAS bf16x8*)(lds + PG8_SA(b, h) + aoff + m * 2048), *(const PG8_LAS bf16x8*)(lds + PG8_SA(b, h) + aoff + m * 2048 + 1024)); } \
        else { _Pragma("unroll") for (int m = 0; m < 4; ++m) _Pragma("unroll") for (int k = 0; k < 2; ++k) dst[m][k] = *(const PG8_LAS bf16x8*)(lds + PG8_SA(b, h) + aoff + m * 2048 + k * 1024); } } while (0)
#define PG8_LDB(dst, b, h) do { if constexpr (FP8) { _Pragma("unroll") for (int n = 0; n < 2; ++n) dst##8[n] = cat8(*(const PG8_LAS bf16x8*)(lds + PG8_SB(b, h) + boff + n * 2048), *(const PG8_LAS bf16x8*)(lds + PG8_SB(b, h) + boff + n * 2048 + 1024)); } \
        else { _Pragma("unroll") for (int n = 0; n < 2; ++n) _Pragma("unroll") for (int k = 0; k < 2; ++k) dst[n][k] = *(const PG8_LAS bf16x8*)(lds + PG8_SB(b, h) + boff + n * 2048 + k * 1024); } } while (0)
#define PG8_MMA(ai, bj, At, Bt) do { __builtin_amdgcn_s_setprio(1); if constexpr (FP8) { _Pragma("unroll") for (int m = 0; m < 4; ++m) _Pragma("unroll") for (int n = 0; n < 2; ++n) \
        asm volatile("v_mfma_scale_f32_16x16x128_f8f6f4 %0, %1, %2, %0, %3, %3 op_sel_hi:[0,0,0]" : "+v"(acc[ai][bj][m][n]) : "v"(Bt##8[n]), "v"(At##8[m]), "v"(f8scale)); } else { \
        _Pragma("unroll") for (int m = 0; m < 4; ++m) _Pragma("unroll") for (int n = 0; n < 2; ++n) _Pragma("unroll") for (int k = 0; k < 2; ++k) { \
        if constexpr (I8) acc[ai][bj][m][n] = __builtin_bit_cast(f32x4, __builtin_amdgcn_mfma_i32_16x16x64_i8(__builtin_bit_cast(v4i32, Bt[n][k]), __builtin_bit_cast(v4i32, At[m][k]), __builtin_bit_cast(v4i32, acc[ai][bj][m][n]), 0, 0, 0)); \
        else acc[ai][bj][m][n] = __builtin_amdgcn_mfma_f32_16x16x32_bf16(Bt[n][k], At[m][k], acc[ai][bj][m][n], 0, 0, 0); } } __builtin_amdgcn_s_setprio(0); } while (0)
#define PG8_WAIT_V(n) asm volatile("s_waitcnt vmcnt(" #n ")" ::: "memory")
#define PG8_WAIT_L(n) asm volatile("s_waitcnt lgkmcnt(" #n ")" ::: "memory")
#define PG8_BAR __builtin_amdgcn_s_barrier()
#define PG8_SCHED __builtin_amdgcn_sched_barrier(0)
    Unit cur, nxt; int ui = 0;
    if (!S.next(0, cur)) return;
    f32x4 acc[2][2][4][2];
#pragma unroll
    for (int a = 0; a < 2; ++a)
#pragma unroll
        for (int b = 0; b < 2; ++b)
#pragma unroll
            for (int m = 0; m < 4; ++m)
#pragma unroll
                for (int n = 0; n < 2; ++n) acc[a][b][m][n] = (f32x4){0.f, 0.f, 0.f, 0.f};
    const int f8scale = 0x7f7f7f7f;
    bf16x8 At[4][2], B0[2][2], B1[2][2]; v8i32 At8[4], B08[2], B18[2];
    const char* cA = (const char*)g.A + S.a_off(cur, tstep); const char* cB = (const char*)g.Bt + S.b_off(cur, tstep);
    S.a_ready(cur);
    if constexpr (Sched::GATHER) { S.fill_all(); asm volatile("s_waitcnt vmcnt(0) lgkmcnt(0)" ::: "memory"); __builtin_amdgcn_s_barrier(); asm volatile("" ::: "memory"); PG8_ROWS(0); }
    if constexpr (SP2) {
        PG8_STAGE(PG8_SB(0, 0), cB, voffB); PG8_STAGE(PG8_SB(0, 1), cB + hstep, voffB); PG8_STAGE(PG8_SA(0, 0), cA, voffA); PG8_STAGE(PG8_SA(0, 1), cA + hstepA, voffA1);
        if (wr == 1) PG8_BAR;
        PG8_WAIT_V(2); PG8_BAR;
        PG8_STAGE(PG8_SB(1, 0), cB + kstep, voffB); PG8_STAGE(PG8_SA(1, 0), cA + kstep, voffA); PG8_STAGE(PG8_SB(1, 1), cB + hstep + kstep, voffB);
        PG8_WAIT_V(6); PG8_BAR;
    } else {
        PG8_STAGE(PG8_SB(0, 0), cB, voffB); PG8_STAGE(PG8_SA(0, 0), cA, voffA); PG8_STAGE(PG8_SB(0, 1), cB + hstep, voffB); PG8_STAGE(PG8_SA(0, 1), cA + hstepA, voffA1);
        if (wr == 1) PG8_BAR;
        PG8_WAIT_V(4); PG8_BAR;
        PG8_STAGE(PG8_SB(1, 0), cB + kstep, voffB); PG8_STAGE(PG8_SA(1, 0), cA + kstep, voffA); PG8_STAGE(PG8_SB(1, 1), cB + hstep + kstep, voffB);
        PG8_WAIT_V(6); PG8_BAR;
    }
    for (;;) {
        const bool has_next = S.next(ui + 1, nxt);
        const char* nA = has_next ? (const char*)g.A + S.a_off(nxt, tstep) : cA; const char* nB = has_next ? (const char*)g.Bt + S.b_off(nxt, tstep) : cB;
        for (int t = 0; t < nt; t += 2) {
            const bool last = (t == nt - 2);
            const char* a1 = cA + (size_t)(t + 1) * kstep;
            const char* a2 = last ? nA : cA + (size_t)(t + 2) * kstep; const char* b2 = last ? nB : cB + (size_t)(t + 2) * kstep;
            const char* a3 = a2 + kstep; const char* b3 = b2 + kstep;
            if (last && has_next) S.a_ready(nxt);
            if constexpr (SP2) {
            PG8_LDB(B0, 0, 0); PG8_LDB(B1, 0, 1); PG8_SCHED; PG8_LDA(At, 0, 0); PG8_STAGE(PG8_SA(1, 1), a1 + hstepA, voffA1);
            PG8_WAIT_V(8); PG8_WAIT_L(0); PG8_BAR; PG8_MMA(0, 0, At, B0); PG8_MMA(0, 1, At, B1); PG8_BAR; PG8_SCHED;
            if constexpr (Sched::GATHER) { if (last && has_next) PG8_ROWS(ui + 1); }
            PG8_LDA(At, 0, 1); PG8_STAGE(PG8_SB(0, 0), b2, voffB); PG8_STAGE(PG8_SB(0, 1), b2 + hstep, voffB); PG8_STAGE(PG8_SA(0, 0), a2, voffA);
            PG8_WAIT_V(8); PG8_WAIT_L(0); PG8_BAR; PG8_MMA(1, 0, At, B0); PG8_MMA(1, 1, At, B1); PG8_BAR; PG8_SCHED;
            PG8_LDB(B0, 1, 0); PG8_LDB(B1, 1, 1); PG8_SCHED; PG8_LDA(At, 1, 0); PG8_STAGE(PG8_SA(0, 1), a2 + hstepA, voffA1);
            PG8_WAIT_V(8); PG8_WAIT_L(0); PG8_BAR; PG8_MMA(0, 0, At, B0); PG8_MMA(0, 1, At, B1); PG8_BAR; PG8_SCHED;
            PG8_LDA(At, 1, 1); PG8_STAGE(PG8_SB(1, 0), b3, voffB); PG8_STAGE(PG8_SB(1, 1), b3 + hstep, voffB); PG8_STAGE(PG8_SA(1, 0), a3, voffA);
            PG8_WAIT_V(8); PG8_WAIT_L(0); PG8_BAR; PG8_MMA(1, 0, At, B0); PG8_MMA(1, 1, At, B1); PG8_BAR; PG8_SCHED;
            } else {
            PG8_LDB(B0, 0, 0); PG8_SCHED; PG8_LDA(At, 0, 0); PG8_STAGE(PG8_SA(1, 1), a1 + hstepA, voffA1);
            PG8_WAIT_L(8); PG8_BAR; PG8_WAIT_L(0); PG8_MMA(0, 0, At, B0); PG8_BAR; PG8_SCHED;
            PG8_LDB(B1, 0, 1); PG8_STAGE(PG8_SB(0, 0), b2, voffB);
            PG8_BAR; PG8_WAIT_L(0); PG8_MMA(0, 1, At, B1); PG8_BAR;
            PG8_LDA(At, 0, 1); PG8_STAGE(PG8_SA(0, 0), a2, voffA);
            PG8_BAR; PG8_WAIT_L(0); PG8_MMA(1, 0, At, B0); PG8_BAR; PG8_SCHED;
            PG8_STAGE(PG8_SB(0, 1), b2 + hstep, voffB);
            PG8_WAIT_V(6); PG8_BAR; PG8_MMA(1, 1, At, B1); PG8_BAR;
            PG8_LDB(B0, 1, 0); PG8_SCHED; PG8_LDA(At, 1, 0); PG8_STAGE(PG8_SA(0, 1), a2 + hstepA, voffA1);
            PG8_WAIT_L(8); PG8_BAR; PG8_WAIT_L(0); PG8_MMA(0, 0, At, B0); PG8_BAR; PG8_SCHED;
            PG8_LDB(B1, 1, 1); PG8_STAGE(PG8_SB(1, 0), b3, voffB);
            PG8_BAR; PG8_WAIT_L(0); PG8_MMA(0, 1, At, B1); PG8_BAR;
            PG8_LDA(At, 1, 1); PG8_STAGE(PG8_SA(1, 0), a3, voffA);
            PG8_BAR; PG8_WAIT_L(0); PG8_MMA(1, 0, At, B0); PG8_BAR; PG8_SCHED;
            PG8_STAGE(PG8_SB(1, 1), b3 + hstep, voffB);
            PG8_WAIT_V(6); PG8_BAR; PG8_MMA(1, 1, At, B1); PG8_BAR;
            }
        }
        if constexpr (ALIGN_EPI) { if (wr == 0) PG8_BAR; }
        if constexpr (FP8) { asm volatile("s_nop 15\n\ts_nop 15" ::: "memory"); }
        if constexpr (!Epi::AFTER_DRAIN) { E(acc, cur, wr, wc, fr, fq); S.done(cur); }
        if (!has_next) break;
#pragma unroll
        for (int a = 0; a < 2; ++a)
#pragma unroll
            for (int b = 0; b < 2; ++b)
#pragma unroll
                for (int m = 0; m < 4; ++m)
#pragma unroll
                    for (int n = 0; n < 2; ++n) acc[a][b][m][n] = (f32x4){0.f, 0.f, 0.f, 0.f};
        cur = nxt; cA = nA; cB = nB; ++ui;
        if constexpr (ALIGN_EPI) { if (wr == 1) PG8_BAR; }
    }
    PG8_WAIT_V(0);
    if constexpr (!ALIGN_EPI) { if (wr == 0) PG8_BAR; }
    PG8_BAR;
    if constexpr (Epi::AFTER_DRAIN) { E.fused(acc, cur, wr, wc, fr, fq, lds, wid, lane); S.done(cur); }
#undef PG8_ROWS
#undef PG8_SA
#undef PG8_SB
#undef PG8_STAGE
#undef PG8_LDA
#undef PG8_LDB
#undef PG8_MMA
#undef PG8_WAIT_V
#undef PG8_WAIT_L
#undef PG8_BAR
#undef PG8_SCHED
}
}

#ifndef MK_N_LAUNCHES
#define MK_N_LAUNCHES 1
#endif
#define GAS __attribute__((address_space(1)))
#define LAS __attribute__((address_space(3)))
typedef unsigned short bf16;
typedef unsigned v4u __attribute__((ext_vector_type(4)));
typedef unsigned v2u __attribute__((ext_vector_type(2)));
typedef float f32x4 __attribute__((ext_vector_type(4)));
typedef float f32x2 __attribute__((ext_vector_type(2)));

constexpr int NWAVES = 8, NTHR = 512;
constexpr int NPH = 13;
constexpr int D = 2048, BATCH = 8, SEQ = 2048, T = BATCH * SEQ;
constexpr int NIN = 10696, NINP = 10752;
constexpr int MLO = 3520, GTO = 6600;
constexpr int RH = 16, RD = 1024;
constexpr int MH = 4;
constexpr int NE = 32, FF = 2048, ECAP = 16384, PMAX = 65536 + NE * 256, MTMAX = PMAX / 256;
constexpr float NORM_EPS = 1e-6f, GN_EPS = 64e-5f;
constexpr size_t MiB = 1u << 20;
constexpr size_t WS_CTL = 0, CTL_ZERO_BYTES = 1 * MiB;
constexpr size_t WS_WIN = 1 * MiB, WS_WA = 43 * MiB, WS_WB = 47 * MiB, WS_WO = 51 * MiB, WS_WL = 59 * MiB;
constexpr size_t WS_RLIST = 62 * MiB, WS_RW = 64 * MiB, WS_RWS = 2787 * MiB, WS_RA = 2787 * MiB + 512 * 1024;
constexpr size_t WS_WGU = 66 * MiB, WS_WDN = 578 * MiB, WS_HN = 834 * MiB, WS_P = 898 * MiB, WS_LIN = 1234 * MiB, WS_WAG = 1250 * MiB;
constexpr size_t WS_YRAW = 1442 * MiB, WS_HRAW = 1506 * MiB, WS_OA = 1570 * MiB, WS_OB = 1602 * MiB, WS_TMP = 1634 * MiB, WS_MRG = 1762 * MiB;
constexpr size_t WS_QKC = WS_TMP, WS_GLF = WS_TMP + 64 * MiB;
constexpr size_t WS_X1 = 1826 * MiB, WS_XB = 1954 * MiB, WS_ACT = 2242 * MiB, WS_YS = 2530 * MiB, WS_END = 2788 * MiB;
constexpr int CW_BAR = 4096;
constexpr int CW_CVNEXT = 8192, CW_P1DONE = 8192 + 64, CW_CVNEXT2 = 8192 + 192;
constexpr int CV_W0 = 6, CV1_W0 = 4;
constexpr int NCV = 64;
constexpr int CW_COLMAX = 32768;
constexpr int CW_CNT = 16384;
constexpr int RING_BYTES = 131072, MISC_OFF = RING_BYTES, LDS_BYTES = RING_BYTES + 8192 + 20 * 1024;
constexpr int MI_TILE_E = 64, MI_TILE_I0 = 64 + 320, MI_CNT = 64 + 640, MI_POFF = MI_CNT + 32, MI_CST = MI_POFF + 32, MI_MT = MI_CST + 40, MI_ROWOFF = 2048;

#define LDS_WAIT() asm volatile("s_waitcnt lgkmcnt(0)" ::: "memory")
#define VM_WAIT() asm volatile("s_waitcnt vmcnt(0)" ::: "memory")
__device__ __forceinline__ float bf2f(bf16 v) { return __uint_as_float(((unsigned)v) << 16); }
__device__ __forceinline__ unsigned f2bf(float f) { unsigned u = __float_as_uint(f); return (u + 0x7fffu + ((u >> 16) & 1u)) >> 16; }
typedef __bf16 bf16x2_t __attribute__((ext_vector_type(2)));
__device__ __forceinline__ unsigned pk2(float lo, float hi) { const f32x2 v = {lo, hi}; const bf16x2_t b = __builtin_convertvector(v, bf16x2_t); return __builtin_bit_cast(unsigned, b); }
__device__ __forceinline__ unsigned pk4f8(float a, float b, float c, float d) { int r = 0; r = __builtin_amdgcn_cvt_pk_fp8_f32(a, b, r, false); r = __builtin_amdgcn_cvt_pk_fp8_f32(c, d, r, true); return (unsigned)r; }
constexpr float F8_SX = 8.f, F8_SW = 256.f, F8_SA = 4.f, F8_SY = 16.f;
__device__ __forceinline__ unsigned pk4i8(float a, float b, float c, float d) {
    const int ia = (int)__builtin_rintf(a), ib = (int)__builtin_rintf(b), ic = (int)__builtin_rintf(c), id = (int)__builtin_rintf(d);
    return (unsigned)(ia & 255) | ((unsigned)(ib & 255) << 8) | ((unsigned)(ic & 255) << 16) | ((unsigned)id << 24); }
__device__ __forceinline__ float wave_max(float v) {
#pragma unroll
    for (int o = 1; o < 64; o <<= 1) v = fmaxf(v, __shfl_xor(v, o));
    return v;
}
__device__ __forceinline__ float wave_sum(float v) {
#pragma unroll
    for (int o = 1; o < 64; o <<= 1) v += __shfl_xor(v, o);
    return v;
}
#define UNP4(v) ((f32x4){__uint_as_float((v).x << 16), __uint_as_float((v).x & 0xffff0000u), __uint_as_float((v).y << 16), __uint_as_float((v).y & 0xffff0000u)})
__device__ __forceinline__ float sigm(float x) { return __builtin_amdgcn_rcpf(1.f + __expf(-x)); }
template <int CTRL> __device__ __forceinline__ float dppf(float x) { return __builtin_bit_cast(float, __builtin_amdgcn_mov_dpp(__builtin_bit_cast(int, x), CTRL, 0xf, 0xf, true)); }
__device__ __forceinline__ float allreduce16(float x) { x += dppf<0x128>(x); x += dppf<0x124>(x); x += dppf<0x4E>(x); x += dppf<0xB1>(x); return x; }

#define XB_TMO      128
#define XB_XCNT(j)  (256  + 64 * (j))
#define XB_XSUB(j)  (1280 + 64 * (j))
#define XB_XGEN(j)  (2304 + 64 * (j))
#define XB_TOP      3328
#define XB_TOPGEN   3392
#define XCD_BAR_WORDS 3456
#define XB_SPIN_CAP (1u << 18)
__device__ __forceinline__ unsigned xb_ld(unsigned* p)              { return __hip_atomic_load(p, __ATOMIC_RELAXED, __HIP_MEMORY_SCOPE_AGENT); }
__device__ __forceinline__ unsigned xb_add(unsigned* p, unsigned v) { return __hip_atomic_fetch_add(p, v, __ATOMIC_RELAXED, __HIP_MEMORY_SCOPE_AGENT); }
__device__ __forceinline__ unsigned xb_xcc_id() { return (unsigned)__builtin_amdgcn_s_getreg((3 << 11) | 20) & 0xFu; }
#define XB_SPIN(cond, bar) do { unsigned _sp = 0; while (cond) { __builtin_amdgcn_s_sleep(1); \
    if ((++_sp & 255u) == 0u) { if (xb_ld(&(bar)[XB_TMO])) break; if (_sp > XB_SPIN_CAP) { atomicAdd(&(bar)[XB_TMO], 1u); break; } } } } while (0)
struct XcdBarrier { unsigned* bar; unsigned x; volatile LAS unsigned* st; };
__device__ __forceinline__ XcdBarrier xcd_barrier_post(unsigned* bar, volatile LAS unsigned* st) {
    XcdBarrier b; b.bar = bar; b.x = xb_xcc_id(); b.st = st;
    if (threadIdx.x == 0) (void)xb_add(&bar[XB_XCNT(b.x)], 1u);
    return b;
}
__device__ __forceinline__ void xcd_barrier_complete(unsigned* bar, unsigned x, unsigned& nloc, unsigned& nx) {
    const unsigned G = gridDim.x * gridDim.y * gridDim.z;
    unsigned sum, cnt, mine, sp = 0u;
    for (;;) {
        sum = 0u; cnt = 0u; mine = 0u;
#pragma unroll
        for (unsigned j = 0; j < 16; ++j) { const unsigned c = xb_ld(&bar[XB_XCNT(j)]); sum += c; cnt += (c > 0u) ? 1u : 0u; mine = (j == x) ? c : mine; }
        if (sum == G) break;
        __builtin_amdgcn_s_sleep(1);
        if ((++sp & 255u) == 0u) { if (xb_ld(&bar[XB_TMO])) break; if (sp > XB_SPIN_CAP) { atomicAdd(&bar[XB_TMO], 1u); break; } }
    }
    nloc = mine > 0u ? mine : 1u; nx = cnt > 0u ? cnt : 1u;
}
__device__ __forceinline__ void xcd_barrier(const XcdBarrier& b) {
    asm volatile("s_waitcnt vmcnt(0)" ::: "memory");
    __syncthreads();
    if (threadIdx.x == 0) {
        unsigned* bar = b.bar;
        __builtin_amdgcn_s_waitcnt(0);
        unsigned nloc = b.st[0], nx = b.st[1];
        if (nloc == 0u) { xcd_barrier_complete(bar, b.x, nloc, nx); b.st[0] = nloc; b.st[1] = nx; }
        const unsigned old = xb_add(&bar[XB_XSUB(b.x)], 1u);
        const unsigned gen = old / nloc;
        if (old + 1u == (gen + 1u) * nloc) {
            __builtin_amdgcn_fence(__ATOMIC_RELEASE, "agent");
            asm volatile("s_waitcnt vmcnt(0)" ::: "memory");
            const unsigned og = xb_add(&bar[XB_TOP], 1u);
            const unsigned tg = og / nx;
            if (og + 1u == (tg + 1u) * nx) xb_add(&bar[XB_TOPGEN], 1u);
            else XB_SPIN(xb_ld(&bar[XB_TOPGEN]) == tg, bar);
            __builtin_amdgcn_fence(__ATOMIC_ACQUIRE, "agent");
            xb_add(&bar[XB_XGEN(b.x)], 1u);
            asm volatile("s_waitcnt vmcnt(0)" ::: "memory");
        } else {
            XB_SPIN(xb_ld(&bar[XB_XGEN(b.x)]) == gen, bar);
            __builtin_amdgcn_fence(__ATOMIC_ACQUIRE, "agent");
            asm volatile("s_waitcnt vmcnt(0)" ::: "memory");
        }
    }
    __syncthreads();
}

struct Args { const float* in[30]; float* out; unsigned char* ws; int ph_lo, ph_hi; };
enum { I_X = 0, I_N1W, I_WIN, I_BGATE, I_MU, I_W0, I_WUP, I_A0, I_AUP, I_GUP, I_KK, I_KA, I_RK, I_LNW, I_LNB, I_CONVW, I_IB, I_FB, I_MNW, I_WBA, I_WBB, I_WOUT, I_N2W, I_RTW, I_RTB, I_WGU, I_BGU, I_WDN, I_BDN, I_FNW };

struct Frame {
    LAS unsigned char* lds; volatile LAS unsigned* MISC; unsigned* ctl;
    int tid, lane, wave, G, bid;
    const float* const* in; float* out; unsigned char* ws;
};

using pg8::Unit; using pg8::HALF; using pg8::BM;
struct EpiBf16Plain {
    static constexpr bool PERM = true, AFTER_DRAIN = false;
    bf16* O; int ldc;
    __device__ __forceinline__ void operator()(const f32x4 (&acc)[2][2][4][2], const Unit& u, int wr, int wc, int fr, int fq) const {
        const int row0 = u.pm * BM + wr * 64 + fr, col0 = u.pn * BM + wc * 32 + 8 * fq;
#pragma unroll
        for (int ai = 0; ai < 2; ++ai)
#pragma unroll
            for (int m = 0; m < 4; ++m) { bf16* rowp = O + (size_t)(row0 + ai * HALF + m * 16) * ldc + col0;
#pragma unroll
                for (int bj = 0; bj < 2; ++bj) { const f32x4 v0 = acc[ai][bj][m][0], v1 = acc[ai][bj][m][1];
                    v4u w; w.x = pg8::cvt_pk_bf16(v0[0], v0[1]); w.y = pg8::cvt_pk_bf16(v0[2], v0[3]); w.z = pg8::cvt_pk_bf16(v1[0], v1[1]); w.w = pg8::cvt_pk_bf16(v1[2], v1[3]);
                    *(v4u*)(rowp + bj * HALF) = w; } }
    }
};
struct EpiP1I8 {
    static constexpr bool PERM = true, AFTER_DRAIN = false;
    bf16* O; int ldc; const float* ra; const unsigned* colmax;
    __device__ __forceinline__ void operator()(const f32x4 (&acc)[2][2][4][2], const Unit& u, int wr, int wc, int fr, int fq) const {
        const int row0 = u.pm * BM + wr * 64 + fr, col0 = u.pn * BM + wc * 32 + 8 * fq;
        f32x4 cb[2][2];
#pragma unroll
        for (int bj = 0; bj < 2; ++bj)
#pragma unroll
            for (int n = 0; n < 2; ++n) { const v4u cm = *(const v4u*)(colmax + col0 + bj * HALF + 4 * n);
                cb[bj][n] = (f32x4){__uint_as_float(cm.x), __uint_as_float(cm.y), __uint_as_float(cm.z), __uint_as_float(cm.w)} * (1.f / 127.f); }
#pragma unroll
        for (int ai = 0; ai < 2; ++ai)
#pragma unroll
            for (int m = 0; m < 4; ++m) { const int r = row0 + ai * HALF + m * 16; const float rs = ra[r]; bf16* rowp = O + (size_t)r * ldc + col0;
#pragma unroll
                for (int bj = 0; bj < 2; ++bj) { const v4u i0 = __builtin_bit_cast(v4u, acc[ai][bj][m][0]), i1 = __builtin_bit_cast(v4u, acc[ai][bj][m][1]);
                    const f32x4 v0 = (f32x4){(float)(int)i0.x, (float)(int)i0.y, (float)(int)i0.z, (float)(int)i0.w} * cb[bj][0] * rs, v1 = (f32x4){(float)(int)i1.x, (float)(int)i1.y, (float)(int)i1.z, (float)(int)i1.w} * cb[bj][1] * rs;
                    v4u w; w.x = pk2(v0[0], v0[1]); w.y = pk2(v0[2], v0[3]); w.z = pk2(v1[0], v1[1]); w.w = pk2(v1[2], v1[3]);
                    *(v4u*)(rowp + bj * HALF) = w; } }
    }
};
struct EpiLora {
    static constexpr bool PERM = false, AFTER_DRAIN = false;
    float* WLD; bf16* AG; const float* w0; const float* a0;
    __device__ __forceinline__ void operator()(const f32x4 (&acc)[2][2][4][2], const Unit& u, int wr, int wc, int fr, int fq) const {
        const int row0 = u.pm * BM + wr * 64 + fr, col0 = u.pn * BM + wc * 32 + 4 * fq, seg = u.pn >> 2;
        f32x4 bv[2][2];
#pragma unroll
        for (int bj = 0; bj < 2; ++bj)
#pragma unroll
            for (int n = 0; n < 2; ++n) { const int c = col0 + bj * HALF + n * 16;
                bv[bj][n] = seg == 0 ? *(const f32x4*)(w0 + c) : (seg == 1 ? *(const f32x4*)(a0 + (c - 1024)) : (f32x4){0.f, 0.f, 0.f, 0.f}); }
#pragma unroll
        for (int ai = 0; ai < 2; ++ai)
#pragma unroll
            for (int m = 0; m < 4; ++m) { const size_t r = (size_t)(row0 + ai * HALF + m * 16);
#pragma unroll
                for (int bj = 0; bj < 2; ++bj)
#pragma unroll
                    for (int n = 0; n < 2; ++n) { f32x4 v = acc[ai][bj][m][n] + bv[bj][n]; const int c = col0 + bj * HALF + n * 16;
                        if (seg == 0) {
#pragma unroll
                            for (int j = 0; j < 4; ++j) v[j] = -0.6065306597126334f * sigm(v[j]);
                            *(f32x4*)(WLD + r * RD + c) = v; }
                        else { if (seg == 1) {
#pragma unroll
                                for (int j = 0; j < 4; ++j) v[j] = sigm(v[j]); }
                            v2u o; o.x = pk2(v[0], v[1]); o.y = pk2(v[2], v[3]); *(v2u*)(AG + r * D + (c - 1024)) = o; } } }
    }
};
struct EpiGateA {
    static constexpr bool PERM = true, AFTER_DRAIN = false;
    bf16* TMP; const bf16* P; const float* bg;
    __device__ __forceinline__ void operator()(const f32x4 (&acc)[2][2][4][2], const Unit& u, int wr, int wc, int fr, int fq) const {
        const int row0 = u.pm * BM + wr * 64 + fr, col0 = u.pn * BM + wc * 32 + 8 * fq;
#pragma unroll
        for (int ai = 0; ai < 2; ++ai)
#pragma unroll
            for (int m = 0; m < 4; ++m) { const size_t r = (size_t)(row0 + ai * HALF + m * 16);
#pragma unroll
                for (int bj = 0; bj < 2; ++bj) { const int c = col0 + bj * HALF;
                    const v4u pg = *(const v4u*)(P + r * NINP + GTO + c); const f32x4 b0 = *(const f32x4*)(bg + c), b1 = *(const f32x4*)(bg + c + 4);
                    f32x4 g0, g1;
                    g0[0] = sigm(__uint_as_float(pg.x << 16) + b0[0]); g0[1] = sigm(__uint_as_float(pg.x & 0xffff0000u) + b0[1]);
                    g0[2] = sigm(__uint_as_float(pg.y << 16) + b0[2]); g0[3] = sigm(__uint_as_float(pg.y & 0xffff0000u) + b0[3]);
                    g1[0] = sigm(__uint_as_float(pg.z << 16) + b1[0]); g1[1] = sigm(__uint_as_float(pg.z & 0xffff0000u) + b1[1]);
                    g1[2] = sigm(__uint_as_float(pg.w << 16) + b1[2]); g1[3] = sigm(__uint_as_float(pg.w & 0xffff0000u) + b1[3]);
                    const f32x4 t0 = g0 * acc[ai][bj][m][0], t1 = g1 * acc[ai][bj][m][1]; v4u tw; tw.x = pk2(t0[0], t0[1]); tw.y = pk2(t0[2], t0[3]); tw.z = pk2(t1[0], t1[1]); tw.w = pk2(t1[2], t1[3]);
                    *(v4u*)(TMP + r * D + c) = tw; } }
    }
};
struct EpiGateB {
    static constexpr bool PERM = true, AFTER_DRAIN = false;
    const bf16* TMP; bf16* MRG; const bf16* P; const float* bg;
    __device__ __forceinline__ void operator()(const f32x4 (&acc)[2][2][4][2], const Unit& u, int wr, int wc, int fr, int fq) const {
        const int row0 = u.pm * BM + wr * 64 + fr, col0 = u.pn * BM + wc * 32 + 8 * fq;
#pragma unroll
        for (int ai = 0; ai < 2; ++ai)
#pragma unroll
            for (int m = 0; m < 4; ++m) { const size_t r = (size_t)(row0 + ai * HALF + m * 16);
#pragma unroll
                for (int bj = 0; bj < 2; ++bj) { const int c = col0 + bj * HALF;
                    const v4u pg = *(const v4u*)(P + r * NINP + GTO + D + c); const f32x4 b0 = *(const f32x4*)(bg + D + c), b1 = *(const f32x4*)(bg + D + c + 4);
                    const v4u tw = *(const v4u*)(TMP + r * D + c); const f32x4 t0 = (f32x4){__uint_as_float(tw.x << 16), __uint_as_float(tw.x & 0xffff0000u), __uint_as_float(tw.y << 16), __uint_as_float(tw.y & 0xffff0000u)}, t1 = (f32x4){__uint_as_float(tw.z << 16), __uint_as_float(tw.z & 0xffff0000u), __uint_as_float(tw.w << 16), __uint_as_float(tw.w & 0xffff0000u)};
                    f32x4 g0, g1;
                    g0[0] = sigm(__uint_as_float(pg.x << 16) + b0[0]); g0[1] = sigm(__uint_as_float(pg.x & 0xffff0000u) + b0[1]);
                    g0[2] = sigm(__uint_as_float(pg.y << 16) + b0[2]); g0[3] = sigm(__uint_as_float(pg.y & 0xffff0000u) + b0[3]);
                    g1[0] = sigm(__uint_as_float(pg.z << 16) + b1[0]); g1[1] = sigm(__uint_as_float(pg.z & 0xffff0000u) + b1[1]);
                    g1[2] = sigm(__uint_as_float(pg.w << 16) + b1[2]); g1[3] = sigm(__uint_as_float(pg.w & 0xffff0000u) + b1[3]);
                    const f32x4 v0 = t0 + g0 * acc[ai][bj][m][0], v1 = t1 + g1 * acc[ai][bj][m][1];
                    v4u w; w.x = pg8::cvt_pk_bf16(v0[0], v0[1]); w.y = pg8::cvt_pk_bf16(v0[2], v0[3]); w.z = pg8::cvt_pk_bf16(v1[0], v1[1]); w.w = pg8::cvt_pk_bf16(v1[2], v1[3]);
                    *(v4u*)(MRG + r * D + c) = w; } }
    }
};
struct EpiResid {
    static constexpr bool PERM = true, AFTER_DRAIN = false;
    const float* X; bf16* O;
    __device__ __forceinline__ void operator()(const f32x4 (&acc)[2][2][4][2], const Unit& u, int wr, int wc, int fr, int fq) const {
        const int row0 = u.pm * BM + wr * 64 + fr, col0 = u.pn * BM + wc * 32 + 8 * fq;
#pragma unroll
        for (int ai = 0; ai < 2; ++ai)
#pragma unroll
            for (int m = 0; m < 4; ++m) { const size_t off = (size_t)(row0 + ai * HALF + m * 16) * D + col0;
#pragma unroll
                for (int bj = 0; bj < 2; ++bj) { const f32x4 v0 = *(const f32x4*)(X + off + bj * HALF) + acc[ai][bj][m][0], v1 = *(const f32x4*)(X + off + bj * HALF + 4) + acc[ai][bj][m][1];
                    v4u w; w.x = pk2(v0[0], v0[1]); w.y = pk2(v0[2], v0[3]); w.z = pk2(v1[0], v1[1]); w.w = pk2(v1[2], v1[3]);
                    *(v4u*)(O + off + bj * HALF) = w; } }
    }
};
struct MoeOrder : pg8::StaticOrder {
    const LAS int* tile_e; size_t estride;
    __device__ __forceinline__ size_t b_off(const Unit& u, size_t tstep) const { return (size_t)tile_e[u.pm] * estride + (size_t)u.pn * tstep; }
};
struct MoeGatherOrder : MoeOrder {
    static constexpr bool GATHER = true;
    const LAS int* tile_i0; const LAS int* cnt; const int* rlist; LAS unsigned* rowoff; unsigned rowbytes;
    __device__ __forceinline__ size_t a_off(const Unit&, size_t) const { return 0; }
    __device__ __forceinline__ void fill_all() const { const int tid = threadIdx.x, r = tid & 255;
        for (int u0 = tid >> 8; ; u0 += 6) { Unit ua, ub, uc; const bool va = next(u0, ua), vb = next(u0 + 2, ub), vc = next(u0 + 4, uc); if (!va) break;
            int ta = 0, tb = 0, tc = 0;
            { const int e = tile_e[ua.pm], i = tile_i0[ua.pm] + r; if (i < cnt[e]) ta = rlist[e * ECAP + i]; }
            if (vb) { const int e = tile_e[ub.pm], i = tile_i0[ub.pm] + r; if (i < cnt[e]) tb = rlist[e * ECAP + i]; }
            if (vc) { const int e = tile_e[uc.pm], i = tile_i0[uc.pm] + r; if (i < cnt[e]) tc = rlist[e * ECAP + i]; }
            rowoff[u0 * 256 + r] = (unsigned)(ta >> 2) * rowbytes; if (vb) rowoff[(u0 + 2) * 256 + r] = (unsigned)(tb >> 2) * rowbytes; if (vc) rowoff[(u0 + 4) * 256 + r] = (unsigned)(tc >> 2) * rowbytes; } }
    __device__ __forceinline__ unsigned row_off(int ui, int r) const { return rowoff[ui * 256 + r]; }
};
struct EpiSwiGLU {
    static constexpr bool PERM = true, AFTER_DRAIN = false;
    unsigned char* ACT; const float* bgu; const LAS int* tile_e;
    __device__ __forceinline__ void operator()(const f32x4 (&acc)[2][2][4][2], const Unit& u, int wr, int wc, int fr, int fq) const {
        const int row0 = u.pm * BM + wr * 64 + fr, colg = u.pn * 128 + wc * 32 + 8 * fq; const int e = tile_e[u.pm];
        const float* bp = bgu + (size_t)e * 4096 + colg;
        const f32x4 bg0 = *(const f32x4*)(bp), bg1 = *(const f32x4*)(bp + 4), bu0 = *(const f32x4*)(bp + 2048), bu1 = *(const f32x4*)(bp + 2052);
#pragma unroll
        for (int ai = 0; ai < 2; ++ai)
#pragma unroll
            for (int m = 0; m < 4; ++m) { const size_t r = (size_t)(row0 + ai * HALF + m * 16);
                constexpr float DS = 1.f / (F8_SX * F8_SW);
                const f32x4 ga = acc[ai][0][m][0] * DS + bg0, gb = acc[ai][0][m][1] * DS + bg1, ua = acc[ai][1][m][0] * DS + bu0, ub = acc[ai][1][m][1] * DS + bu1;
                float o[8];
#pragma unroll
                for (int j = 0; j < 4; ++j) { const float g = fminf(ga[j], 7.f), up = fminf(fmaxf(ua[j], -7.f), 7.f); o[j] = F8_SA * (up + 1.f) * g * sigm(1.702f * g);
                                              const float g2 = fminf(gb[j], 7.f), up2 = fminf(fmaxf(ub[j], -7.f), 7.f); o[4 + j] = F8_SA * (up2 + 1.f) * g2 * sigm(1.702f * g2); }
                v2u w; w.x = pk4f8(o[0], o[1], o[2], o[3]); w.y = pk4f8(o[4], o[5], o[6], o[7]);
                *(v2u*)(ACT + r * FF + colg) = w; }
    }
};
struct EpiDown {
    static constexpr bool PERM = true, AFTER_DRAIN = false;
    unsigned char* YS; const float* bdn; const LAS int* tile_e; const LAS int* rowdst; const LAS float* rowwt;
    __device__ __forceinline__ void operator()(const f32x4 (&acc)[2][2][4][2], const Unit& u, int wr, int wc, int fr, int fq) const {
        const int e = tile_e[u.pm]; const int col0 = u.pn * BM + wc * 32 + 8 * fq;
        const float* bp = bdn + (size_t)e * D + col0; constexpr float DS = 1.f / (F8_SA * F8_SW);
#pragma unroll
        for (int bj = 0; bj < 2; ++bj) { const f32x4 b0 = *(const f32x4*)(bp + bj * HALF), b1 = *(const f32x4*)(bp + bj * HALF + 4);
#pragma unroll
            for (int ai = 0; ai < 2; ++ai)
#pragma unroll
                for (int m = 0; m < 4; ++m) { const int r = u.ord * 256 + ai * HALF + wr * 64 + m * 16 + fr;
                    const int dst = rowdst[r]; const float w = rowwt[r];
                    const f32x4 v0 = (acc[ai][bj][m][0] * DS + b0) * (w * F8_SY), v1 = (acc[ai][bj][m][1] * DS + b1) * (w * F8_SY);
                    v2u o; o.x = pk4f8(v0[0], v0[1], v0[2], v0[3]); o.y = pk4f8(v1[0], v1[1], v1[2], v1[3]);
                    *(v2u*)(YS + (size_t)dst * D + col0 + bj * HALF) = o; } }
    }
};
template <class Sched> __device__ __forceinline__ void fill_down_tables(Frame& F, const Sched& S, LAS int* rowdst, LAS float* rowwt) {
    const LAS int* MI = (const LAS int*)F.MISC; const int* rlist = (const int*)(F.ws + WS_RLIST); const float* rw = (const float*)(F.ws + WS_RW);
    const int r = F.tid & 255;
    for (int u0 = F.tid >> 8; ; u0 += 4) { Unit ua, ub; const bool va = S.next(u0, ua), vb = S.next(u0 + 2, ub); if (!va) break;
        int da = T * 4, db = T * 4; float wa = 0.f, wb = 0.f;
        { const int e = MI[MI_TILE_E + ua.pm], i = MI[MI_TILE_I0 + ua.pm] + r; if (i < MI[MI_CNT + e]) { da = rlist[e * ECAP + i]; wa = rw[e * ECAP + i]; } }
        if (vb) { const int e = MI[MI_TILE_E + ub.pm], i = MI[MI_TILE_I0 + ub.pm] + r; if (i < MI[MI_CNT + e]) { db = rlist[e * ECAP + i]; wb = rw[e * ECAP + i]; } }
        rowdst[u0 * 256 + r] = da; rowwt[u0 * 256 + r] = wa; if (vb) { rowdst[(u0 + 2) * 256 + r] = db; rowwt[(u0 + 2) * 256 + r] = wb; } }
    __syncthreads();
}

__device__ __forceinline__ void transpose_item(const float* __restrict__ W, int N, int k0, int n0, bf16* WT, int dst_row0, int ldk, LAS float* scr, int lane) {
    const int n = n0 + (lane & 31); const bool ok = n < N;
#pragma unroll 8
    for (int i = 0; i < 32; ++i) { const int kk = 2 * i + (lane >> 5); scr[kk * 33 + (lane & 31)] = ok ? W[(size_t)(k0 + kk) * N + n] : 0.f; }
    LDS_WAIT(); asm volatile("" ::: "memory");
    const int c = lane & 7;
#pragma unroll
    for (int j = 0; j < 4; ++j) { const int nn = (lane >> 3) + 8 * j; const LAS float* s = scr + (8 * c) * 33 + nn;
        v4u o; o.x = pk2(s[0 * 33], s[1 * 33]); o.y = pk2(s[2 * 33], s[3 * 33]); o.z = pk2(s[4 * 33], s[5 * 33]); o.w = pk2(s[6 * 33], s[7 * 33]);
        *(v4u*)(WT + (size_t)(dst_row0 + nn) * ldk + k0 + 8 * c) = o; }
    LDS_WAIT(); asm volatile("" ::: "memory");
}
__device__ __forceinline__ void transpose_item_i8(const float* __restrict__ W, int N, int k0, int n0, unsigned char* WT, int dst_row0, int ldk, const unsigned* colmax, LAS float* scr, int lane) {
    const int n = n0 + (lane & 31); const bool ok = n < N;
    float r[32];
#pragma unroll
    for (int i = 0; i < 32; ++i) { const int kk = 2 * i + (lane >> 5); r[i] = ok ? W[(size_t)(k0 + kk) * N + n] : 0.f; }
#pragma unroll
    for (int i = 0; i < 32; ++i) { const int kk = 2 * i + (lane >> 5); scr[kk * 33 + (lane & 31)] = r[i]; }
    LDS_WAIT(); asm volatile("" ::: "memory");
#pragma unroll
    for (int j = 0; j < 2; ++j) { const int ch = lane + 64 * j, nn = ch >> 2, c = ch & 3; const LAS float* s = scr + (16 * c) * 33 + nn;
        const float cm = __uint_as_float(colmax[n0 + nn]); const float sc = cm > 0.f ? 127.f / cm : 0.f;
        v4u o; o.x = pk4i8(s[0 * 33] * sc, s[1 * 33] * sc, s[2 * 33] * sc, s[3 * 33] * sc); o.y = pk4i8(s[4 * 33] * sc, s[5 * 33] * sc, s[6 * 33] * sc, s[7 * 33] * sc);
        o.z = pk4i8(s[8 * 33] * sc, s[9 * 33] * sc, s[10 * 33] * sc, s[11 * 33] * sc); o.w = pk4i8(s[12 * 33] * sc, s[13 * 33] * sc, s[14 * 33] * sc, s[15 * 33] * sc);
        *(v4u*)(WT + (size_t)(dst_row0 + nn) * ldk + k0 + 16 * c) = o; }
    LDS_WAIT(); asm volatile("" ::: "memory");
}
__device__ __forceinline__ void p0b_win(Frame& F) {
    LAS float* scr = (LAS float*)(F.lds + F.wave * 16384);
    const int gw = F.bid * NWAVES + F.wave, NGW = F.G * NWAVES; unsigned char* WIN8 = F.ws + WS_WIN; const unsigned* colmax = F.ctl + CW_COLMAX;
    constexpr int NB_WIN = (NIN + 31) / 32;
    for (int it = gw; it < 32 * NB_WIN; it += NGW) { const int kb = it / NB_WIN, nb = it % NB_WIN; transpose_item_i8(F.in[I_WIN], NIN, kb * 64, nb * 32, WIN8, nb * 32, D, colmax, scr, F.lane); }
    { const int gt = F.bid * NTHR + F.tid, NGT = F.G * NTHR; constexpr int Z0 = NB_WIN * 32 * D, Z1 = NINP * D;
      for (int i = Z0 + gt * 16; i < Z1; i += NGT * 16) *(v4u*)(WIN8 + i) = (v4u){0u, 0u, 0u, 0u}; }
}
__device__ __forceinline__ void p0_prologue(Frame& F) {
    LAS float* scr = (LAS float*)(F.lds + F.wave * 16384);
    const int gw = F.bid * NWAVES + F.wave, NGW = F.G * NWAVES;
    bf16* WIN_T = (bf16*)(F.ws + WS_WIN); bf16* WA_T = (bf16*)(F.ws + WS_WA); bf16* WB_T = (bf16*)(F.ws + WS_WB); bf16* WO_T = (bf16*)(F.ws + WS_WO);
    bf16* WGU_T = (bf16*)(F.ws + WS_WGU); bf16* WDN_T = (bf16*)(F.ws + WS_WDN); bf16* WL_T = (bf16*)(F.ws + WS_WL); bf16* HN = (bf16*)(F.ws + WS_HN);
    { const float* W = F.in[I_WIN]; unsigned* colmax = F.ctl + CW_COLMAX;
      for (int task = gw; task < 168 * 16; task += NGW) { const int cb = task % 168, kc = task / 168, n = cb * 64 + F.lane; float m = 0.f;
          if (n < NIN) { const float* wp = W + (size_t)(kc * 128) * NIN + n;
#pragma unroll 1
              for (int k0 = 0; k0 < 128; k0 += 32) { float v[32];
#pragma unroll
                  for (int i = 0; i < 32; ++i) v[i] = wp[(size_t)(k0 + i) * NIN];
#pragma unroll
                  for (int i = 0; i < 32; ++i) m = fmaxf(m, fabsf(v[i])); }
              atomicMax(colmax + n, __float_as_uint(m)); } } }
    { const int gt = F.bid * NTHR + F.tid, NGT = F.G * NTHR;
      for (int i = gt; i < 3072 * 512; i += NGT) { const int n = i >> 9, k = i & 511; float v = 0.f;
          if (n < 1024) { if (k < 96) v = F.in[I_WUP][k * RD + n]; }
          else if (n < 2048) { if (k >= 128 && k < 224) v = F.in[I_AUP][(k - 128) * RD + (n - 1024)]; }
          else { if (k >= 256) v = F.in[I_GUP][(k - 256) * RD + (n - 2048)]; }
          WL_T[i] = (bf16)f2bf(v); } }
    { const int gt = F.bid * NTHR + F.tid, NGT = F.G * NTHR; float* RWS = (float*)(F.ws + WS_RWS);
      for (int i = gt; i < D * NE; i += NGT) RWS[i] = F.in[I_N2W][i >> 5] * F.in[I_RTW][i]; }
    const float* x = F.in[I_X]; const float* nw = F.in[I_N1W];
    f32x4 nv[8];
    if (gw < T) { const f32x4* xr = (const f32x4*)(x + (size_t)gw * D) + F.lane;
#pragma unroll
        for (int j = 0; j < 8; ++j) nv[j] = xr[64 * j]; }
    for (int m = gw; m < T; m += NGW) {
        f32x4 v[8]; float s = 0.f;
#pragma unroll
        for (int j = 0; j < 8; ++j) v[j] = nv[j];
        if (m + NGW < T) { const f32x4* xr = (const f32x4*)(x + (size_t)(m + NGW) * D) + F.lane;
#pragma unroll
            for (int j = 0; j < 8; ++j) nv[j] = xr[64 * j]; }
#pragma unroll
        for (int j = 0; j < 8; ++j) s += (v[j][0] * v[j][0] + v[j][1] * v[j][1]) + (v[j][2] * v[j][2] + v[j][3] * v[j][3]);
        const float rstd = __builtin_amdgcn_rsqf(wave_sum(s) * (1.f / D) + NORM_EPS);
        float am = 0.f;
#pragma unroll
        for (int j = 0; j < 8; ++j) { const f32x4 w = ((const f32x4*)nw)[F.lane + 64 * j]; v[j] = v[j] * rstd * w; am = fmaxf(fmaxf(am, fmaxf(fabsf(v[j][0]), fabsf(v[j][1]))), fmaxf(fabsf(v[j][2]), fabsf(v[j][3]))); }
        am = wave_max(am); const float sc = am > 0.f ? 127.f / am : 0.f;
        if (F.lane == 0) ((float*)(F.ws + WS_RA))[m] = am * (1.f / 127.f);
        unsigned* o4 = (unsigned*)((unsigned char*)HN + (size_t)m * D) + F.lane;
#pragma unroll
        for (int j = 0; j < 8; ++j) o4[64 * j] = pk4i8(v[j][0] * sc, v[j][1] * sc, v[j][2] * sc, v[j][3] * sc);
    }
}

__device__ __forceinline__ void p2_lora_in(Frame& F) {
    const bf16* __restrict__ P = (const bf16*)(F.ws + WS_P); bf16* __restrict__ LIN = (bf16*)(F.ws + WS_LIN); const float* __restrict__ mu = F.in[I_MU];
    const int gt = F.bid * NTHR + F.tid, NGT = F.G * NTHR;
    for (int i = gt; i < T * 64; i += 2 * NGT) { const int g = i & 63; int col = -1, kind = 0;
        if (g < 12) { col = 3072 + 8 * g; kind = 0; } else if (g >= 16 && g < 28) { col = 3168 + 8 * (g - 16); kind = 1; } else if (g >= 32) { col = 3264 + 8 * (g - 32); kind = 2; }
        const int ce = col >= 0 ? col : 3072;
        v4u pc[2], pp[2];
#pragma unroll
        for (int u = 0; u < 2; ++u) { const int ii = i + u * NGT < T * 64 ? i + u * NGT : i; const int t = ii >> 6; pc[u] = *(const v4u*)(P + (size_t)t * NINP + ce); pp[u] = *(const v4u*)(P + (size_t)((t & (SEQ - 1)) ? t - 1 : t) * NINP + ce); }
        const f32x4 m0 = *(const f32x4*)(mu + ce), m1 = *(const f32x4*)(mu + ce + 4);
#pragma unroll
        for (int u = 0; u < 2; ++u) { const int ii = i + u * NGT; if (ii < T * 64) { const int t = ii >> 6; v4u o = (v4u){0u, 0u, 0u, 0u};
            if (col >= 0) { const float pm = (t & (SEQ - 1)) ? 1.f : 0.f;
                const unsigned pcs[4] = {pc[u].x, pc[u].y, pc[u].z, pc[u].w}, pps[4] = {pp[u].x, pp[u].y, pp[u].z, pp[u].w}; float x[8];
#pragma unroll
                for (int k = 0; k < 4; ++k) { const float c0 = __uint_as_float(pcs[k] << 16), c1 = __uint_as_float(pcs[k] & 0xffff0000u), q0 = pm * __uint_as_float(pps[k] << 16), q1 = pm * __uint_as_float(pps[k] & 0xffff0000u);
                    const float ma = k < 2 ? m0[2 * k] : m1[2 * k - 4], mb = k < 2 ? m0[2 * k + 1] : m1[2 * k - 3];
                    x[2 * k] = c0 + (q0 - c0) * ma; x[2 * k + 1] = c1 + (q1 - c1) * mb; }
#pragma unroll
                for (int k = 0; k < 8; ++k) x[k] = kind == 0 ? tanhf(x[k]) : (kind == 1 ? x[k] : sigm(x[k]));
                o.x = pk2(x[0], x[1]); o.y = pk2(x[2], x[3]); o.z = pk2(x[4], x[5]); o.w = pk2(x[6], x[7]); }
            *(v4u*)(LIN + (size_t)t * 512 + 8 * g) = o; } } }
    { bf16* __restrict__ QKC = (bf16*)(F.ws + WS_QKC); const float* __restrict__ cw = F.in[I_CONVW];
      for (int i = gt; i < T * 128; i += 2 * NGT) { v4u pv[2][4]; f32x4 w0[4], w1[4]; const int c0 = 8 * (i & 127);
#pragma unroll
          for (int u = 0; u < 2; ++u) { const int ii = i + u * NGT < T * 128 ? i + u * NGT : i; const int t = ii >> 7, sq = t & (SEQ - 1);
#pragma unroll
              for (int j = 0; j < 4; ++j) { const int tj = sq - 3 + j >= 0 ? t - 3 + j : t; pv[u][j] = *(const v4u*)(P + (size_t)tj * NINP + MLO + c0); } }
#pragma unroll
          for (int j = 0; j < 4; ++j) { w0[j] = *(const f32x4*)(cw + j * 1024 + c0); w1[j] = *(const f32x4*)(cw + j * 1024 + c0 + 4); }
          const float sc = c0 < 512 ? 0.08838834764831845f : 1.f;
#pragma unroll
          for (int u = 0; u < 2; ++u) { const int ii = i + u * NGT; if (ii < T * 128) { const int t = ii >> 7, sq = t & (SEQ - 1); float acc[8];
#pragma unroll
              for (int k = 0; k < 8; ++k) acc[k] = 0.f;
#pragma unroll
              for (int j = 0; j < 4; ++j) { const float m = sq - 3 + j >= 0 ? 1.f : 0.f; const v4u q = pv[u][j]; const f32x4 a0 = w0[j] * m, a1 = w1[j] * m;
                  acc[0] += __uint_as_float(q.x << 16) * a0[0]; acc[1] += __uint_as_float(q.x & 0xffff0000u) * a0[1]; acc[2] += __uint_as_float(q.y << 16) * a0[2]; acc[3] += __uint_as_float(q.y & 0xffff0000u) * a0[3];
                  acc[4] += __uint_as_float(q.z << 16) * a1[0]; acc[5] += __uint_as_float(q.z & 0xffff0000u) * a1[1]; acc[6] += __uint_as_float(q.w << 16) * a1[2]; acc[7] += __uint_as_float(q.w & 0xffff0000u) * a1[3]; }
#pragma unroll
              for (int k = 0; k < 8; ++k) acc[k] = acc[k] * sigm(acc[k]) * sc;
              v4u o; o.x = pk2(acc[0], acc[1]); o.y = pk2(acc[2], acc[3]); o.z = pk2(acc[4], acc[5]); o.w = pk2(acc[6], acc[7]); *(v4u*)(QKC + (size_t)t * 1024 + c0) = o; } } } }
    { float* __restrict__ GLF = (float*)(F.ws + WS_GLF); const int gw = F.bid * NWAVES + F.wave, NGW = F.G * NWAVES, lane = F.lane;
      for (int q = gw; q < (T / 64) * 4; q += NGW) { const int chk = q >> 2, mh = q & 3; const size_t t = (size_t)chk * 64 + lane; const bf16* pr = P + t * NINP + MLO + 2048;
          const float ip = 15.f * tanhf((bf2f(pr[mh]) + F.in[I_IB][mh]) * (1.f / 15.f)), fp = 15.f * tanhf((bf2f(pr[4 + mh]) + F.in[I_FB][mh]) * (1.f / 15.f));
          float bc = fminf(fp, 0.f) - log1pf(__expf(-fabsf(fp)));
#pragma unroll
          for (int o = 1; o < 64; o <<= 1) { const float t_ = __shfl_up(bc, o); if (lane >= o) bc += t_; }
          const float u = ip - bc; float pm = u;
#pragma unroll
          for (int o = 1; o < 64; o <<= 1) { const float t_ = __shfl_up(pm, o); if (lane >= o) pm = fmaxf(pm, t_); }
          *(f32x4*)(GLF + t * 16 + 4 * mh) = (f32x4){bc, u, pm, 0.f}; } }
}

typedef short s16x8 __attribute__((ext_vector_type(8)));
typedef short s16x4 __attribute__((ext_vector_type(4)));
__device__ __forceinline__ unsigned long long pack4bf(f32x4 v) { return (unsigned long long)pk2(v[0], v[1]) | ((unsigned long long)pk2(v[2], v[3]) << 32); }
__device__ __forceinline__ s16x8 tr_frag(const LAS bf16* img, int stride, int r0, int c0, int fr) {
    const LAS bf16* p0 = img + (r0 + (fr >> 2)) * stride + c0 + 4 * (fr & 3);
    const s16x4 lo = __builtin_bit_cast(s16x4, __builtin_amdgcn_ds_read_tr16_b64_v4i16((LAS s16x4*)p0));
    const s16x4 hi = __builtin_bit_cast(s16x4, __builtin_amdgcn_ds_read_tr16_b64_v4i16((LAS s16x4*)(p0 + 4 * stride)));
    return __builtin_shufflevector(lo, hi, 0, 1, 2, 3, 4, 5, 6, 7);
}

__device__ __forceinline__ float scan32(float x) {
    x += dppf<0x111>(x); x += dppf<0x112>(x); x += dppf<0x114>(x); x += dppf<0x118>(x);
    x += __builtin_bit_cast(float, __builtin_amdgcn_update_dpp(0, __builtin_bit_cast(int, x), 0x142, 0xa, 0xf, false));
    return x; }
typedef float f32x16 __attribute__((ext_vector_type(16)));
__device__ __forceinline__ s16x8 accfrag(const f32x16& x, int s) { v4u p; p.x = pk2(x[8 * s], x[8 * s + 1]); p.y = pk2(x[8 * s + 2], x[8 * s + 3]); p.z = pk2(x[8 * s + 4], x[8 * s + 5]); p.w = pk2(x[8 * s + 6], x[8 * s + 7]); return __builtin_bit_cast(s16x8, p); }
#define MFMA32(a_, b_, c_) __builtin_amdgcn_mfma_f32_32x32x16_bf16((a_), (b_), (c_), 0, 0, 0)
__device__ __forceinline__ void rw_bar(LAS unsigned* cnt, unsigned& target, int lane);
__device__ __forceinline__ void rwkv_chunk_unit(Frame& F, int unit, LAS unsigned char* regB, LAS unsigned* bcnt, unsigned& btarget) {
    const int b = unit >> 5, h = (unit >> 1) & 15, half = unit & 1;
    const bf16* P = (const bf16*)(F.ws + WS_P); const float* WAG = (const float*)(F.ws + WS_WAG); const bf16* AGp = (const bf16*)(F.ws + WS_WAG + 64 * MiB); float* YRAW = (float*)(F.ws + WS_YRAW);
    constexpr int KS = 72, LS = 40;
    LAS bf16* At = (LAS bf16*)F.lds; LAS bf16* Bt = At + 32 * KS; LAS bf16* Kt = Bt + 32 * KS; LAS bf16* Rt = Kt + 32 * KS;
    LAS bf16* Vv = Rt + 32 * KS;
    LAS bf16* Sb = Vv + 32 * LS;
    LAS bf16* G2b = Sb + 32 * KS; LAS bf16* G3b = G2b + 32 * LS; LAS bf16* G4b = G3b + 32 * LS;
    LAS bf16* Pwb = G4b + 32 * LS;
    LAS bf16* Acb = Pwb + 2 * 32 * LS;
    LAS bf16* RHt = (LAS bf16*)regB;
    LAS bf16* Ubt = RHt + 32 * LS;
    LAS float* lwf = (LAS float*)(Ubt + 32 * LS);
    LAS float* csf = lwf + 2048;
    LAS float* gtf = csf + 2048;
    LAS float* glf = gtf + 256;
    const int tid = F.tid, lane = F.lane, w = F.wave, fr = lane & 15, fq = lane >> 4;
    const int ts = tid >> 4, cs = tid & 15, c0 = h * 64 + 4 * cs;
    const int sk = tid & 63, sq = tid >> 6;
    const f32x4 mu_r = *(const f32x4*)(F.in[I_MU] + c0), mu_k = *(const f32x4*)(F.in[I_MU] + 1024 + c0), mu_v = *(const f32x4*)(F.in[I_MU] + 2048 + c0);
    const f32x4 kkc = *(const f32x4*)(F.in[I_KK] + c0), kac = *(const f32x4*)(F.in[I_KA] + c0), rkc = *(const f32x4*)(F.in[I_RK] + c0);
    bf16* BON = (bf16*)(F.ws + WS_WAG + 128 * MiB);
    for (int i = tid; i < 32 * KS; i += 256) Sb[i] = 0;
    v2u cr[2], ck[2], cv[2], qr[2], qk[2], qv[2]; f32x4 a4[2], ws0, ws1;
#define RC_LOAD(ch) do { _Pragma("unroll") for (int p_ = 0; p_ < 2; ++p_) { const int t_ = (ch) * 32 + ts + 16 * p_; const size_t tk_ = (size_t)b * SEQ + t_; const bf16* pr_ = P + tk_ * NINP + c0; \
        cr[p_] = *(const v2u*)(pr_); ck[p_] = *(const v2u*)(pr_ + 1024); cv[p_] = *(const v2u*)(pr_ + 2048); \
        if (t_ > 0) { qr[p_] = *(const v2u*)(pr_ - NINP); qk[p_] = *(const v2u*)(pr_ - NINP + 1024); qv[p_] = *(const v2u*)(pr_ - NINP + 2048); } else { qr[p_] = (v2u){0u, 0u}; qk[p_] = qr[p_]; qv[p_] = qr[p_]; } \
        { const v2u ab_ = *(const v2u*)(AGp + tk_ * D + c0); a4[p_] = UNP4(ab_); } } \
        { const float* wr_ = WAG + ((size_t)b * SEQ + (ch) * 32 + (lane & 31)) * RD + h * 64 + 16 * w + 8 * (lane >> 5); ws0 = *(const f32x4*)wr_; ws1 = *(const f32x4*)(wr_ + 4); } } while (0)
    const int mi = w >> 1, nj = w & 1;
    f32x4 st[2]; st[0] = (f32x4){0.f, 0.f, 0.f, 0.f}; st[1] = st[0];
    RC_LOAD(0);
    rw_bar(bcnt, btarget, lane);
    for (int ch = 0; ch < SEQ / 32; ++ch) {
        f32x4 rr[2], kmod[2], vv[2], kkn[2], al[2];
#pragma unroll
        for (int p_ = 0; p_ < 2; ++p_) { const f32x4 pr4 = UNP4(cr[p_]), pk4 = UNP4(ck[p_]), pv4 = UNP4(cv[p_]), qr4 = UNP4(qr[p_]), qk4 = UNP4(qk[p_]), qv4 = UNP4(qv[p_]); al[p_] = a4[p_];
            rr[p_] = pr4 + (qr4 - pr4) * mu_r; const f32x4 k1 = pk4 + (qk4 - pk4) * mu_k; vv[p_] = pv4 + (qv4 - pv4) * mu_v;
            const f32x4 kkr = k1 * kkc; const float nrm = __builtin_amdgcn_rsqf(fmaxf(allreduce16((kkr[0] * kkr[0] + kkr[1] * kkr[1]) + (kkr[2] * kkr[2] + kkr[3] * kkr[3])), 1e-24f));
            kkn[p_] = kkr * nrm; kmod[p_] = k1 * (1.f + (al[p_] - 1.f) * kac);
            { const f32x4 rk_ = rr[p_] * kmod[p_] * rkc; const float dot = allreduce16((rk_[0] + rk_[1]) + (rk_[2] + rk_[3]));
              if ((cs >> 3) == half) *(unsigned long long*)(BON + ((size_t)b * SEQ + ch * 32 + ts + 16 * p_) * RD + c0) = pack4bf(vv[p_] * dot); }
            }
        { const int tq = lane & 31, hq = lane >> 5; f32x4 c0v, c1v;
#pragma unroll
          for (int j = 0; j < 4; ++j) { c0v[j] = scan32(ws0[j]); c1v[j] = scan32(ws1[j]); }
          *(LAS f32x4*)(csf + tq * 64 + 16 * w + 8 * hq) = c0v; *(LAS f32x4*)(csf + tq * 64 + 16 * w + 8 * hq + 4) = c1v; }
        if (ch + 1 < SEQ / 32) RC_LOAD(ch + 1);
        rw_bar(bcnt, btarget, lane);
#pragma unroll
        for (int p_ = 0; p_ < 2; ++p_) { const int t = ts + 16 * p_; const f32x4 cg = *(const LAS f32x4*)(csf + t * 64 + 4 * cs); f32x4 cgp = (f32x4){0.f, 0.f, 0.f, 0.f}; if (t > 0) cgp = *(const LAS f32x4*)(csf + (t - 1) * 64 + 4 * cs); f32x4 g, gp, gi;
#pragma unroll
          for (int j = 0; j < 4; ++j) { g[j] = __expf(cg[j]); gp[j] = __expf(cgp[j]); gi[j] = __expf(-cg[j]); }
          *(LAS unsigned long long*)(At + t * KS + 4 * cs) = pack4bf(-(kkn[p_] * gp)); *(LAS unsigned long long*)(Bt + t * KS + 4 * cs) = pack4bf(kkn[p_] * al[p_] * gi);
          *(LAS unsigned long long*)(Kt + t * KS + 4 * cs) = pack4bf(kmod[p_] * gi); *(LAS unsigned long long*)(Rt + t * KS + 4 * cs) = pack4bf(rr[p_] * g);
          if ((cs >> 3) == half) *(LAS unsigned long long*)(Vv + t * LS + 4 * (cs & 7)) = pack4bf(vv[p_]);
          if (t == 31) *(LAS f32x4*)(glf + 4 * cs) = g; }
        rw_bar(bcnt, btarget, lane);
        { const int t = 16 * mi + fr, jb = 16 * nj + 4 * fq;
          f32x4 g2 = (f32x4){0.f, 0.f, 0.f, 0.f}, g3 = g2, g4 = g2;
#pragma unroll
          for (int ks = 0; ks < 2; ++ks) { const s16x8 bj = *(const LAS s16x8*)(Bt + (16 * nj + fr) * KS + 32 * ks + 8 * fq), kj = *(const LAS s16x8*)(Kt + (16 * nj + fr) * KS + 32 * ks + 8 * fq);
              const s16x8 at = *(const LAS s16x8*)(At + (16 * mi + fr) * KS + 32 * ks + 8 * fq), rt = *(const LAS s16x8*)(Rt + (16 * mi + fr) * KS + 32 * ks + 8 * fq);
              g2 = __builtin_amdgcn_mfma_f32_16x16x32_bf16(kj, at, g2, 0, 0, 0); g3 = __builtin_amdgcn_mfma_f32_16x16x32_bf16(bj, rt, g3, 0, 0, 0); g4 = __builtin_amdgcn_mfma_f32_16x16x32_bf16(kj, rt, g4, 0, 0, 0); }
#pragma unroll
          for (int rg_ = 0; rg_ < 4; ++rg_) { const int j = jb + rg_; g2[rg_] = (j < t) ? g2[rg_] : 0.f; g3[rg_] = (j <= t) ? g3[rg_] : 0.f; g4[rg_] = (j <= t) ? g4[rg_] : 0.f; }
          *(LAS unsigned long long*)(G2b + t * LS + jb) = pack4bf(g2); *(LAS unsigned long long*)(G3b + t * LS + jb) = pack4bf(g3); *(LAS unsigned long long*)(G4b + t * LS + jb) = pack4bf(g4); }
        { const int tq = lane & 31, hq = lane >> 5;
          f32x16 Pm, Qm, Aq;
#pragma unroll
          for (int i = 0; i < 16; ++i) { Pm[i] = 0.f; Qm[i] = 0.f; }
#pragma unroll
          for (int s = 0; s < 4; ++s) { const s16x8 fa = *(const LAS s16x8*)(At + tq * KS + 16 * s + 8 * hq), fb = *(const LAS s16x8*)(Bt + tq * KS + 16 * s + 8 * hq);
              Pm = MFMA32(fa, fb, Pm); Qm = MFMA32(fb, fa, Qm); }
#pragma unroll
          for (int i = 0; i < 16; ++i) { const int r_ = (i & 3) + 8 * (i >> 2) + 4 * hq;
              Pm[i] = (tq < r_) ? Pm[i] : 0.f;
              Qm[i] = (r_ < tq) ? Qm[i] : 0.f;
              Aq[i] = Qm[i] + ((r_ == tq) ? 1.f : 0.f); }
#pragma unroll
          for (int st = 1; st <= 4; ++st) { const s16x8 p0 = accfrag(Pm, 0), p1 = accfrag(Pm, 1), q0 = accfrag(Qm, 0), q1 = accfrag(Qm, 1);
              f32x16 nP, nQ;
#pragma unroll
              for (int i = 0; i < 16; ++i) { nP[i] = 0.f; nQ[i] = 0.f; }
              nP = MFMA32(q0, p0, nP); nP = MFMA32(q1, p1, nP);
              if (st < 4) { nQ = MFMA32(p0, q0, nQ); nQ = MFMA32(p1, q1, nQ); }
              Pm = nP; Qm = nQ;
              const s16x8 n0 = accfrag(Pm, 0), n1 = accfrag(Pm, 1), a0 = accfrag(Aq, 0), a1 = accfrag(Aq, 1);
              Aq = MFMA32(n0, a0, Aq); Aq = MFMA32(n1, a1, Aq); }
          f32x4 tv; tv[0] = w == 0 ? Aq[0] : w == 1 ? Aq[4] : w == 2 ? Aq[8] : Aq[12]; tv[1] = w == 0 ? Aq[1] : w == 1 ? Aq[5] : w == 2 ? Aq[9] : Aq[13];
          tv[2] = w == 0 ? Aq[2] : w == 1 ? Aq[6] : w == 2 ? Aq[10] : Aq[14]; tv[3] = w == 0 ? Aq[3] : w == 1 ? Aq[7] : w == 2 ? Aq[11] : Aq[15];
          *(LAS unsigned long long*)(Acb + 32 * LS + tq * LS + 8 * w + 4 * hq) = pack4bf(tv); }
        rw_bar(bcnt, btarget, lane);
        f32x4 yv = (f32x4){0.f, 0.f, 0.f, 0.f};
        { f32x4 z = (f32x4){0.f, 0.f, 0.f, 0.f};
#pragma unroll
          for (int ks = 0; ks < 2; ++ks) { const s16x8 sb = *(const LAS s16x8*)(Sb + (16 * nj + fr) * KS + 32 * ks + 8 * fq);
              z = __builtin_amdgcn_mfma_f32_16x16x32_bf16(*(const LAS s16x8*)(At + (16 * mi + fr) * KS + 32 * ks + 8 * fq), sb, z, 0, 0, 0);
              yv = __builtin_amdgcn_mfma_f32_16x16x32_bf16(*(const LAS s16x8*)(Rt + (16 * mi + fr) * KS + 32 * ks + 8 * fq), sb, yv, 0, 0, 0); }
          const s16x8 vt_ = tr_frag(Vv, LS, 8 * fq, 16 * nj, fr);
          z = __builtin_amdgcn_mfma_f32_16x16x32_bf16(*(const LAS s16x8*)(G2b + (16 * mi + fr) * LS + 8 * fq), vt_, z, 0, 0, 0);
          yv = __builtin_amdgcn_mfma_f32_16x16x32_bf16(*(const LAS s16x8*)(G4b + (16 * mi + fr) * LS + 8 * fq), vt_, yv, 0, 0, 0);
          *(LAS unsigned long long*)(RHt + (16 * nj + fr) * LS + 16 * mi + 4 * fq) = pack4bf(z); }
        rw_bar(bcnt, btarget, lane);
        { f32x4 z = (f32x4){0.f, 0.f, 0.f, 0.f};
          z = __builtin_amdgcn_mfma_f32_16x16x32_bf16(*(const LAS s16x8*)(Acb + 32 * LS + (16 * mi + fr) * LS + 8 * fq), *(const LAS s16x8*)(RHt + (16 * nj + fr) * LS + 8 * fq), z, 0, 0, 0);
          *(LAS unsigned long long*)(Ubt + (16 * nj + fr) * LS + 16 * mi + 4 * fq) = pack4bf(z); }
        rw_bar(bcnt, btarget, lane);
        { yv = __builtin_amdgcn_mfma_f32_16x16x32_bf16(*(const LAS s16x8*)(G3b + (16 * mi + fr) * LS + 8 * fq), *(const LAS s16x8*)(Ubt + (16 * nj + fr) * LS + 8 * fq), yv, 0, 0, 0);
          float* yp = YRAW + ((size_t)b * SEQ + ch * 32 + 16 * mi + 4 * fq) * RD + h * 64 + half * 32 + 16 * nj + fr;
#pragma unroll
          for (int rg_ = 0; rg_ < 4; ++rg_) yp[(size_t)rg_ * RD] = yv[rg_]; }
        { const int kt = w; const s16x8 bt_ = tr_frag(Bt, KS, 8 * fq, 16 * kt, fr), kt_ = tr_frag(Kt, KS, 8 * fq, 16 * kt, fr); const f32x4 gl4 = *(const LAS f32x4*)(glf + 16 * kt + 4 * fq);
#pragma unroll
          for (int vt = 0; vt < 2; ++vt) {
              st[vt] = __builtin_amdgcn_mfma_f32_16x16x32_bf16(bt_, *(const LAS s16x8*)(Ubt + (16 * vt + fr) * LS + 8 * fq), st[vt], 0, 0, 0);
              st[vt] = __builtin_amdgcn_mfma_f32_16x16x32_bf16(kt_, tr_frag(Vv, LS, 8 * fq, 16 * vt, fr), st[vt], 0, 0, 0);
              st[vt] = st[vt] * gl4;
              *(LAS unsigned long long*)(Sb + (16 * vt + fr) * KS + 16 * kt + 4 * fq) = pack4bf(st[vt]); } }
    }
#undef RC_LOAD
}

__device__ __forceinline__ float allreduce8(float x) { x += dppf<0x141>(x); x += dppf<0xB1>(x); x += dppf<0x4E>(x); return x; }
__device__ __forceinline__ void rw_bar(LAS unsigned* cnt, unsigned& target, int lane) {
    asm volatile("s_waitcnt lgkmcnt(0)" ::: "memory");
    if (lane == 0) __hip_atomic_fetch_add(cnt, 1u, __ATOMIC_RELAXED, __HIP_MEMORY_SCOPE_WORKGROUP);
    target += 4u;
    while ((unsigned)__builtin_amdgcn_readfirstlane((int)__hip_atomic_load(cnt, __ATOMIC_RELAXED, __HIP_MEMORY_SCOPE_WORKGROUP)) < target) __builtin_amdgcn_s_sleep(1);
    asm volatile("" ::: "memory");
}
constexpr int CV_BR = 8 * 32, CV_WO = 16 * 32, CV_GU = NE * 16 * 64, CV_DN = NE * 16 * 32, CV_ITEMS = 2 * CV_BR + CV_WO + CV_GU + CV_DN;
constexpr int CV_SPLIT = CV_ITEMS - 0;
constexpr int P5_NW = 8;
struct CvItem { const float* src; unsigned char* dst; int N; int f8; };
__device__ __forceinline__ CvItem cv_decode(Frame& F, int it) {
    CvItem c; int r = it; const int lane = F.lane;
    if (r < CV_BR) { const int kb = r >> 5, nb = r & 31; c.src = F.in[I_WBA] + (size_t)(kb * 128) * D + nb * 64 + lane; c.dst = F.ws + WS_WA + ((size_t)(nb * 64 + lane) * RD + kb * 128) * 2; c.N = D; c.f8 = 0; return c; } r -= CV_BR;
    if (r < CV_BR) { const int kb = r >> 5, nb = r & 31; c.src = F.in[I_WBB] + (size_t)(kb * 128) * D + nb * 64 + lane; c.dst = F.ws + WS_WB + ((size_t)(nb * 64 + lane) * RD + kb * 128) * 2; c.N = D; c.f8 = 0; return c; } r -= CV_BR;
    if (r < CV_WO) { const int kb = r >> 5, nb = r & 31; c.src = F.in[I_WOUT] + (size_t)(kb * 128) * D + nb * 64 + lane; c.dst = F.ws + WS_WO + ((size_t)(nb * 64 + lane) * D + kb * 128) * 2; c.N = D; c.f8 = 0; return c; } r -= CV_WO;
    if (r < CV_GU) { const int e = r >> 10, q = r & 1023, kb = q >> 6, nb = q & 63, n0 = nb * 64;
        const int dr = n0 < FF ? ((n0 >> 7) * 256 + (n0 & 127)) : (((n0 - FF) >> 7) * 256 + 128 + ((n0 - FF) & 127));
        c.src = F.in[I_WGU] + (size_t)e * D * 2 * FF + (size_t)(kb * 128) * (2 * FF) + n0 + lane; c.dst = F.ws + WS_WGU + (size_t)e * 2 * FF * D + (size_t)(dr + lane) * D + kb * 128; c.N = 2 * FF; c.f8 = 1; return c; } r -= CV_GU;
    { const int e = r >> 9, q = r & 511, kb = q >> 5, nb = q & 31;
        c.src = F.in[I_WDN] + (size_t)e * FF * D + (size_t)(kb * 128) * D + nb * 64 + lane; c.dst = F.ws + WS_WDN + (size_t)e * D * FF + (size_t)(nb * 64 + lane) * FF + kb * 128; c.N = D; c.f8 = 1; }
    return c;
}
__device__ __forceinline__ void convert_item(Frame& F, int it, LAS unsigned char* cvbuf);
__device__ __forceinline__ void convert_loop(Frame& F, unsigned* next, unsigned* p1done, unsigned ngemm, LAS unsigned char* cvbuf, unsigned lo, unsigned hi) {
#define CV_CLAIM(b_) do { b_ = 0xffffffffu; if (F.lane == 0) { if (!(p1done && __hip_atomic_load(p1done, __ATOMIC_RELAXED, __HIP_MEMORY_SCOPE_AGENT) >= ngemm)) b_ = __hip_atomic_fetch_add(next, 2u, __ATOMIC_RELAXED, __HIP_MEMORY_SCOPE_AGENT); } } while (0)
    unsigned nb; CV_CLAIM(nb);
    for (;;) { const unsigned b0 = (unsigned)__builtin_amdgcn_readfirstlane((int)nb); if (b0 >= hi - lo) break;
        const unsigned base = b0 + lo;
        if (!p1done) CV_CLAIM(nb);
        for (int k = 0; k < 2; ++k) { const unsigned it = base + k; if (it < hi) convert_item(F, (int)it, cvbuf); }
        if (p1done) CV_CLAIM(nb); }
#undef CV_CLAIM
}
__device__ __forceinline__ void convert_item(Frame& F, int i0, LAS unsigned char* cvbuf) {
    { const CvItem c = cv_decode(F, i0);
        float x[128];
#pragma unroll
        for (int i = 0; i < 128; ++i) x[i] = c.src[(size_t)i * c.N];
        if (c.f8) {
            const int lane = F.lane; LAS unsigned char* bw = cvbuf + lane * 144;
#pragma unroll
            for (int q = 0; q < 8; ++q) { v4u o; o.x = pk4f8(x[16 * q + 0] * F8_SW, x[16 * q + 1] * F8_SW, x[16 * q + 2] * F8_SW, x[16 * q + 3] * F8_SW); o.y = pk4f8(x[16 * q + 4] * F8_SW, x[16 * q + 5] * F8_SW, x[16 * q + 6] * F8_SW, x[16 * q + 7] * F8_SW);
                o.z = pk4f8(x[16 * q + 8] * F8_SW, x[16 * q + 9] * F8_SW, x[16 * q + 10] * F8_SW, x[16 * q + 11] * F8_SW); o.w = pk4f8(x[16 * q + 12] * F8_SW, x[16 * q + 13] * F8_SW, x[16 * q + 14] * F8_SW, x[16 * q + 15] * F8_SW);
                *(LAS v4u*)(bw + 16 * q) = o; }
            unsigned char* d0 = c.dst - (size_t)lane * 2048 + (size_t)(lane >> 3) * 2048 + (lane & 7) * 16; const LAS unsigned char* br = cvbuf + (lane >> 3) * 144 + (lane & 7) * 16;
#pragma unroll
            for (int i = 0; i < 8; ++i) { const v4u v = *(const LAS v4u*)(br + i * 8 * 144); *(v4u*)(d0 + (size_t)i * 8 * 2048) = v; } }
        else {
#pragma unroll
            for (int q = 0; q < 16; ++q) { v4u o; o.x = pk2(x[8 * q + 0], x[8 * q + 1]); o.y = pk2(x[8 * q + 2], x[8 * q + 3]); o.z = pk2(x[8 * q + 4], x[8 * q + 5]); o.w = pk2(x[8 * q + 6], x[8 * q + 7]);
                *(v4u*)(c.dst + 16 * q) = o; } } }
}

__device__ __forceinline__ void mlstm_scan_unit(Frame& F, int unit, LAS unsigned* bcnt, unsigned& btarget) {
    const int b = unit >> 5, mh = (unit >> 3) & 3, sl = unit & 7;
    const bf16* P = (const bf16*)(F.ws + WS_P); const bf16* QKC = (const bf16*)(F.ws + WS_QKC); const float* GLF = (const float*)(F.ws + WS_GLF); float* HRAW = (float*)(F.ws + WS_HRAW);
    constexpr int VS = 56;
    LAS bf16* Lq = (LAS bf16*)F.lds;
    LAS bf16* Lk = Lq + 64 * 136;
    LAS bf16* Lv = Lk + 64 * 136;
    LAS bf16* Lvs = Lv + 64 * VS;
    LAS bf16* LcT = Lvs + 64 * VS;
    LAS bf16* Ls = LcT + 2 * 48 * 136;
    LAS float* sb = (LAS float*)(Ls + 64 * 72); LAS float* su = sb + 64; LAS float* smx = su + 64; LAS float* swk = smx + 64;
    const int tid = F.tid, lane = F.lane, w = F.wave, fr = lane & 15, fq = lane >> 4;
    for (int i = tid; i < 2 * 48 * 136; i += 256) LcT[i] = 0;
    for (int i = tid; i < 64 * 16; i += 256) { const int j = i >> 4, c = 32 + (i & 15); Lv[j * VS + c] = (c == 32) ? (bf16)0x3F80 : (bf16)0; Lvs[j * VS + c] = 0; }
    const int pr0 = tid >> 4, pc = 8 * (tid & 15);
    v4u rq[4], rk[4], rv; f32x4 g3;
#define ML_LOAD(ch) do { const size_t tk0_ = (size_t)b * SEQ + (ch) * 64; \
        _Pragma("unroll") for (int i_ = 0; i_ < 4; ++i_) { const bf16* s_ = QKC + (tk0_ + pr0 + 16 * i_) * 1024 + mh * 128 + pc; rq[i_] = *(const v4u*)s_; rk[i_] = *(const v4u*)(s_ + 512); } \
        rv = *(const v4u*)(P + (tk0_ + (tid >> 2)) * NINP + MLO + 1024 + mh * 256 + sl * 32 + 8 * (tid & 3)); \
        g3 = *(const f32x4*)(GLF + (tk0_ + lane) * 16 + 4 * mh); } while (0)
    f32x4 st[2][3];
#pragma unroll
    for (int a = 0; a < 2; ++a)
#pragma unroll
        for (int n = 0; n < 3; ++n) st[a][n] = (f32x4){0.f, 0.f, 0.f, 0.f};
    float mstate = 0.f;
    ML_LOAD(0);
    rw_bar(bcnt, btarget, lane);
    for (int ch = 0; ch < SEQ / 64; ++ch) {
        const size_t tk0 = (size_t)b * SEQ + ch * 64;
        LAS bf16* cTc = LcT + (ch & 1) * 48 * 136; LAS bf16* cTn = LcT + ((ch + 1) & 1) * 48 * 136;
        float mnew, dec;
        { const float bc = g3[0], u = g3[1], pm = g3[2];
          const float gtot = __shfl(bc, 63), pmall = __shfl(pm, 63);
          mnew = gtot + fmaxf(mstate, pmall); dec = __expf(gtot + mstate - mnew);
          const float wk = __expf(u + gtot - mnew);
          sb[lane] = bc; su[lane] = u; smx[lane] = fmaxf(mstate, pm); swk[lane] = wk;
          if (w == 0) Lvs[lane * VS + 32] = (bf16)f2bf(wk); }
#pragma unroll
        for (int i = 0; i < 4; ++i) { *(LAS v4u*)(Lq + (pr0 + 16 * i) * 136 + pc) = rq[i]; *(LAS v4u*)(Lk + (pr0 + 16 * i) * 136 + pc) = rk[i]; }
        LDS_WAIT();
        { const int j = tid >> 2, d0 = 8 * (tid & 3); const float wkj = swk[j]; *(LAS v4u*)(Lv + j * VS + d0) = rv;
          const unsigned uu[4] = {rv.x, rv.y, rv.z, rv.w}; v4u sv;
          sv.x = pk2(wkj * __uint_as_float(uu[0] << 16), wkj * __uint_as_float(uu[0] & 0xffff0000u)); sv.y = pk2(wkj * __uint_as_float(uu[1] << 16), wkj * __uint_as_float(uu[1] & 0xffff0000u));
          sv.z = pk2(wkj * __uint_as_float(uu[2] << 16), wkj * __uint_as_float(uu[2] & 0xffff0000u)); sv.w = pk2(wkj * __uint_as_float(uu[3] << 16), wkj * __uint_as_float(uu[3] & 0xffff0000u));
          *(LAS v4u*)(Lvs + j * VS + d0) = sv; }
        if (ch + 1 < SEQ / 64) ML_LOAD(ch + 1);
        rw_bar(bcnt, btarget, lane);
        { const int tt = w; const int t = 16 * tt + fr; const float mxt = smx[t];
#pragma unroll
          for (int jt = 0; jt < 4; ++jt) { f32x4 acc = (f32x4){0.f, 0.f, 0.f, 0.f};
              if (jt <= tt) {
#pragma unroll
                  for (int ks = 0; ks < 4; ++ks) { const s16x8 a = *(const LAS s16x8*)(Lk + (16 * jt + fr) * 136 + 32 * ks + 8 * fq), bq = *(const LAS s16x8*)(Lq + (16 * tt + fr) * 136 + 32 * ks + 8 * fq);
                      acc = __builtin_amdgcn_mfma_f32_16x16x32_bf16(a, bq, acc, 0, 0, 0); }
                  const f32x4 u4 = *(const LAS f32x4*)(su + 16 * jt + 4 * fq);
#pragma unroll
                  for (int rg_ = 0; rg_ < 4; ++rg_) { const int j = 16 * jt + 4 * fq + rg_; acc[rg_] = (j <= t) ? acc[rg_] * __expf(u4[rg_] - mxt) : 0.f; } }
              *(LAS unsigned long long*)(Ls + t * 72 + 16 * jt + 4 * fq) = pack4bf(acc); } }
        rw_bar(bcnt, btarget, lane);
        { const int mi = w; f32x4 a1[3], a2[3];
#pragma unroll
          for (int n = 0; n < 3; ++n) { a1[n] = (f32x4){0.f, 0.f, 0.f, 0.f}; a2[n] = a1[n]; }
#pragma unroll
          for (int ks = 0; ks < 2; ++ks) { const s16x8 A = *(const LAS s16x8*)(Ls + (16 * mi + fr) * 72 + 32 * ks + 8 * fq);
#pragma unroll
              for (int n = 0; n < 3; ++n) a1[n] = __builtin_amdgcn_mfma_f32_16x16x32_bf16(A, tr_frag(Lv, VS, 32 * ks + 8 * fq, 16 * n, fr), a1[n], 0, 0, 0); }
#pragma unroll
          for (int ks = 0; ks < 4; ++ks) { const s16x8 A = *(const LAS s16x8*)(Lq + (16 * mi + fr) * 136 + 32 * ks + 8 * fq);
#pragma unroll
              for (int n = 0; n < 3; ++n) a2[n] = __builtin_amdgcn_mfma_f32_16x16x32_bf16(A, *(const LAS s16x8*)(cTc + (16 * n + fr) * 136 + 32 * ks + 8 * fq), a2[n], 0, 0, 0); }
          const f32x4 mx4 = *(const LAS f32x4*)(smx + 16 * mi + 4 * fq), b4 = *(const LAS f32x4*)(sb + 16 * mi + 4 * fq);
#pragma unroll
          for (int rg_ = 0; rg_ < 4; ++rg_) { const float wi = __expf(mstate - mx4[rg_]); float den = a1[2][rg_] + wi * a2[2][rg_]; den = __shfl(den, lane & 48);
              const float mt = b4[rg_] + mx4[rg_]; const float inv = __builtin_amdgcn_rcpf(fmaxf(fabsf(den), __expf(-mt))); float* hp = HRAW + (tk0 + 16 * mi + 4 * fq + rg_) * RD + mh * 256 + sl * 32 + fr;
              hp[0] = (a1[0][rg_] + wi * a2[0][rg_]) * inv; hp[16] = (a1[1][rg_] + wi * a2[1][rg_]) * inv; } }
        {
#pragma unroll
          for (int a = 0; a < 2; ++a) {
#pragma unroll
              for (int n = 0; n < 3; ++n) st[a][n] = st[a][n] * dec;
#pragma unroll
              for (int ks = 0; ks < 2; ++ks) { const s16x8 A = tr_frag(Lk, 136, 32 * ks + 8 * fq, 16 * (2 * w + a), fr);
#pragma unroll
                  for (int n = 0; n < 3; ++n) st[a][n] = __builtin_amdgcn_mfma_f32_16x16x32_bf16(A, tr_frag(Lvs, VS, 32 * ks + 8 * fq, 16 * n, fr), st[a][n], 0, 0, 0); }
#pragma unroll
              for (int n = 0; n < 3; ++n) *(LAS unsigned long long*)(cTn + (16 * n + fr) * 136 + 16 * (2 * w + a) + 4 * fq) = pack4bf(st[a][n]); } }
        mstate = mnew;
        rw_bar(bcnt, btarget, lane);
    }
#undef ML_LOAD
}

__device__ __forceinline__ float rowsum4(f32x4 v) { return (v[0] + v[1]) + (v[2] + v[3]); }
__device__ __forceinline__ void p5_finalize(Frame& F) {
    const bf16* __restrict__ P = (const bf16*)(F.ws + WS_P); const bf16* __restrict__ AGp = (const bf16*)(F.ws + WS_WAG + 64 * MiB); const float* __restrict__ YRAW = (const float*)(F.ws + WS_YRAW); const float* __restrict__ HRAW = (const float*)(F.ws + WS_HRAW);
    bf16* __restrict__ OA = (bf16*)(F.ws + WS_OA); bf16* __restrict__ OB = (bf16*)(F.ws + WS_OB);
    const int gw = F.bid * P5_NW + F.wave, NGW = F.G * P5_NW, lane = F.lane;
    { const int hq = gw & 3, c0 = (hq * 4 + (lane >> 4)) * 64 + 4 * (lane & 15);
      const f32x4 lnw = *(const f32x4*)(F.in[I_LNW] + c0), lnb = *(const f32x4*)(F.in[I_LNB] + c0); const bf16* __restrict__ BON = (const bf16*)(F.ws + WS_WAG + 128 * MiB);
      v2u bo[2], gb[2]; f32x4 y4[2];
#define P5_LOAD(i_, q_) do { if ((q_) < T * 4) { const int tk_ = (q_) >> 2; bo[i_] = *(const v2u*)(BON + (size_t)tk_ * RD + c0); gb[i_] = *(const v2u*)(AGp + (size_t)tk_ * D + RD + c0); y4[i_] = *(const f32x4*)(YRAW + (size_t)tk_ * RD + c0); } } while (0)
      P5_LOAD(0, gw); P5_LOAD(1, gw + NGW);
      for (int q = gw; q < T * 4; q += 2 * NGW) { const v2u cb0 = bo[0], cg0 = gb[0], cb1 = bo[1], cg1 = gb[1]; const f32x4 cy0 = y4[0], cy1 = y4[1];
          P5_LOAD(0, q + 2 * NGW); P5_LOAD(1, q + 3 * NGW);
#pragma unroll
          for (int i = 0; i < 2; ++i) { const int qq = q + i * NGW; if (qq < T * 4) { const int tk = qq >> 2; const f32x4 bon = i ? UNP4(cb1) : UNP4(cb0), g = i ? UNP4(cg1) : UNP4(cg0), y = i ? cy1 : cy0;
              const float mean = allreduce16(rowsum4(y)) * (1.f / 64.f); const f32x4 dl = y - mean;
              const float var = allreduce16(rowsum4(dl * dl)) * (1.f / 64.f); const float rs = __builtin_amdgcn_rsqf(var + GN_EPS);
              const f32x4 o = (dl * rs * lnw + lnb + bon) * g;
              v2u ov; ov.x = pk2(o[0], o[1]); ov.y = pk2(o[2], o[3]); *(v2u*)(OA + (size_t)tk * RD + c0) = ov; } } }
#undef P5_LOAD
    }
    { const int mh = gw & 3, d0 = mh * 256 + 4 * lane; const f32x4 nw = *(const f32x4*)(F.in[I_MNW] + d0);
      f32x4 hv[2]; v2u po[2];
#define P5B_LOAD(i_, q_) do { if ((q_) < T * 4) { const int tk_ = (q_) >> 2; hv[i_] = *(const f32x4*)(HRAW + (size_t)tk_ * RD + d0); po[i_] = *(const v2u*)(P + (size_t)tk_ * NINP + MLO + 2056 + d0); } } while (0)
      P5B_LOAD(0, gw); P5B_LOAD(1, gw + NGW);
      for (int q = gw; q < T * 4; q += 2 * NGW) { const f32x4 ch0 = hv[0], ch1 = hv[1]; const v2u cp0 = po[0], cp1 = po[1];
          P5B_LOAD(0, q + 2 * NGW); P5B_LOAD(1, q + 3 * NGW);
#pragma unroll
          for (int i = 0; i < 2; ++i) { const int qq = q + i * NGW; if (qq < T * 4) { const int tk = qq >> 2; const f32x4 h4 = i ? ch1 : ch0; const v2u p2 = i ? cp1 : cp0;
              float ss = allreduce16(rowsum4(h4 * h4)); ss += __shfl_xor(ss, 16); ss += __shfl_xor(ss, 32);
              const float rs = __builtin_amdgcn_rsqf(ss * (1.f / 256.f) + NORM_EPS); const f32x4 og = UNP4(p2);
              const float o0 = h4[0] * rs * nw[0] * sigm(og[0]), o1 = h4[1] * rs * nw[1] * sigm(og[1]), o2 = h4[2] * rs * nw[2] * sigm(og[2]), o3 = h4[3] * rs * nw[3] * sigm(og[3]);
              v2u o; o.x = pk2(o0, o1); o.y = pk2(o2, o3); *(v2u*)(OB + (size_t)tk * RD + d0) = o; } } }
#undef P5B_LOAD
    }
}

typedef float f32x16 __attribute__((ext_vector_type(16)));
__device__ __forceinline__ void p8_route(Frame& F) {
    const bf16* X1 = (const bf16*)(F.ws + WS_X1); unsigned char* H2 = (unsigned char*)(F.ws + WS_HN); int* RLIST = (int*)(F.ws + WS_RLIST); float* RWT = (float*)(F.ws + WS_RW);
    const float* RWS = (const float*)(F.ws + WS_RWS); const float* nw = F.in[I_N2W]; const float* rtb = F.in[I_RTB];
    LAS float* part = (LAS float*)F.lds;
    LAS float* ssq = part + 8 * 32 * 33;
    LAS float* lgt = ssq + 256;
    LAS float* srs = lgt + 32 * 33;
    const int lane = F.lane, w = F.wave, i = lane & 31, h = lane >> 5, tid = F.tid;
    for (int tile = F.bid; tile < T / 32; tile += F.G) {
        const int m0 = tile * 32; const bf16* xrow = X1 + (size_t)(m0 + i) * D + 256 * w + 4 * h;
        f32x16 acc;
#pragma unroll
        for (int r_ = 0; r_ < 16; ++r_) acc[r_] = 0.f;
        float ss = 0.f; const float* bp = RWS + (size_t)(256 * w + 4 * h) * NE + i;
#pragma unroll 4
        for (int q = 0; q < 32; ++q) { const v2u xb_ = *(const v2u*)(xrow + 8 * q); const f32x4 xa = UNP4(xb_);
#pragma unroll
            for (int j = 0; j < 4; ++j) acc = __builtin_amdgcn_mfma_f32_32x32x2f32(xa[j], bp[(8 * q + j) * NE], acc, 0, 0, 0);
            ss += (xa[0] * xa[0] + xa[1] * xa[1]) + (xa[2] * xa[2] + xa[3] * xa[3]); }
        ss += __shfl_xor(ss, 32);
        if (h == 0) ssq[w * 32 + i] = ss;
#pragma unroll
        for (int r_ = 0; r_ < 16; ++r_) part[(w * 32 + (r_ & 3) + 8 * (r_ >> 2) + 4 * h) * 33 + i] = acc[r_];
        __syncthreads();
#pragma unroll
        for (int k2 = 0; k2 < 2; ++k2) { const int idx = tid + NTHR * k2, ii = idx >> 5, e = idx & 31; float sm = 0.f, sq = 0.f;
#pragma unroll
            for (int ww = 0; ww < 8; ++ww) { sm += part[(ww * 32 + ii) * 33 + e]; sq += ssq[ww * 32 + ii]; }
            const float rs = 1.f / sqrtf(sq * (1.f / D) + NORM_EPS); lgt[ii * 33 + e] = sm * rs + rtb[e]; if (e == 0) srs[ii] = rs; }
        __syncthreads();
        { const float rs = srs[i] * F8_SX; unsigned char* orow = H2 + (size_t)(m0 + i) * D + 256 * w + 4 * h;
#pragma unroll 8
          for (int q = 0; q < 32; ++q) { const f32x4 n4 = *(const f32x4*)(nw + 256 * w + 4 * h + 8 * q); const v2u xb_ = *(const v2u*)(xrow + 8 * q); const f32x4 hv = UNP4(xb_) * rs * n4; *(unsigned*)(orow + 8 * q) = pk4f8(hv[0], hv[1], hv[2], hv[3]); } }
        if (tid < 32) { const LAS float* lr = lgt + tid * 33; unsigned used = 0u; int idx[4]; float val[4];
#pragma unroll
            for (int s4 = 0; s4 < 4; ++s4) { float best = -INFINITY; int bi = 0;
                for (int e = 0; e < 32; ++e) { const float v = lr[e]; const bool ok = !((used >> e) & 1u) && (v > best); best = ok ? v : best; bi = ok ? e : bi; }
                used |= 1u << bi; idx[s4] = bi; val[s4] = best; }
            const float e1 = __expf(val[1] - val[0]), e2 = __expf(val[2] - val[0]), e3 = __expf(val[3] - val[0]); const float inv = 1.f / (1.f + e1 + e2 + e3);
            const float wv[4] = {inv, e1 * inv, e2 * inv, e3 * inv};
            unsigned pos[4];
#pragma unroll
            for (int s4 = 0; s4 < 4; ++s4) pos[s4] = atomicAdd(F.ctl + CW_CNT + 64 * idx[s4], 1u);
#pragma unroll
            for (int s4 = 0; s4 < 4; ++s4) { RLIST[idx[s4] * ECAP + pos[s4]] = (m0 + tid) * 4 + s4; RWT[idx[s4] * ECAP + pos[s4]] = wv[s4]; } }
        __syncthreads();
    }
}

__device__ __forceinline__ void build_moe_tables(Frame& F) {
    LAS int* MI = (LAS int*)F.MISC;
    __syncthreads();
    if (F.tid < NE) MI[MI_CNT + F.tid] = (int)__hip_atomic_load(F.ctl + CW_CNT + 64 * F.tid, __ATOMIC_RELAXED, __HIP_MEMORY_SCOPE_AGENT);
    __syncthreads();
    if (F.tid == 0) { int mt = 0, cs = 0;
        for (int e = 0; e < NE; ++e) { const int c = MI[MI_CNT + e]; MI[MI_POFF + e] = mt * 256; MI[MI_CST + e] = cs; cs += c;
            const int nt = (c + 255) >> 8; for (int i = 0; i < nt; ++i) { MI[MI_TILE_E + mt + i] = e; MI[MI_TILE_I0 + mt + i] = i * 256; } mt += nt; }
        MI[MI_CST + NE] = cs; MI[MI_MT] = mt; }
    __syncthreads();
}
__device__ __forceinline__ void p9_gather(Frame& F) {
    build_moe_tables(F);
    const LAS int* MI = (const LAS int*)F.MISC; const bf16* H2 = (const bf16*)(F.ws + WS_HN); bf16* XB = (bf16*)(F.ws + WS_XB); const int* RLIST = (const int*)(F.ws + WS_RLIST);
    const int gw = F.bid * NWAVES + F.wave, NGW = F.G * NWAVES, total = MI[MI_CST + NE];
    for (int q = gw; q < total; q += NGW) { int e = 0;
        for (int k = 1; k < NE; ++k) e = (MI[MI_CST + k] <= q) ? k : e;
        const int i = q - MI[MI_CST + e]; const int tok = RLIST[e * ECAP + i] >> 2;
        const v4u* src = (const v4u*)(H2 + (size_t)tok * D) + F.lane; v4u* dst = (v4u*)(XB + (size_t)(MI[MI_POFF + e] + i) * D) + F.lane;
#pragma unroll
        for (int j = 0; j < 4; ++j) dst[64 * j] = src[64 * j]; }
}
__device__ __forceinline__ void p12_final(Frame& F) {
    const bf16* X1 = (const bf16*)(F.ws + WS_X1); const unsigned char* YS = (const unsigned char*)(F.ws + WS_YS); const float* fw = F.in[I_FNW];
    const int gw = F.bid * NWAVES + F.wave, NGW = F.G * NWAVES;
    for (int m = gw; m < T; m += NGW) {
        const v2u* xr = (const v2u*)(X1 + (size_t)m * D) + F.lane; f32x4 v[8]; float s = 0.f;
#pragma unroll
        for (int j = 0; j < 8; ++j) { const v2u xb_ = xr[64 * j]; v[j] = UNP4(xb_);
#pragma unroll
            for (int sl = 0; sl < 4; ++sl) { const int y = ((const int*)(YS + ((size_t)m * 4 + sl) * D))[F.lane + 64 * j];
                const f32x2 ylo = __builtin_amdgcn_cvt_pk_f32_fp8(y, false), yhi = __builtin_amdgcn_cvt_pk_f32_fp8(y, true);
                v[j][0] += ylo[0] * (1.f / F8_SY); v[j][1] += ylo[1] * (1.f / F8_SY); v[j][2] += yhi[0] * (1.f / F8_SY); v[j][3] += yhi[1] * (1.f / F8_SY); }
            s += (v[j][0] * v[j][0] + v[j][1] * v[j][1]) + (v[j][2] * v[j][2] + v[j][3] * v[j][3]); }
        const float rstd = __builtin_amdgcn_rsqf(wave_sum(s) * (1.f / D) + NORM_EPS);
        f32x4* orow = (f32x4*)(F.out + (size_t)m * D) + F.lane;
#pragma unroll
        for (int j = 0; j < 8; ++j) { const f32x4 w = ((const f32x4*)fw)[F.lane + 64 * j]; orow[64 * j] = v[j] * rstd * w; }
    }
}

__global__ void __launch_bounds__(NTHR, 2) mk_fwd(Args args) {
    extern __shared__ __attribute__((aligned(16))) unsigned char lds[];
    Frame F;
    F.lds = (LAS unsigned char*)lds; F.MISC = (volatile LAS unsigned*)(F.lds + MISC_OFF);
    F.tid = threadIdx.x; F.lane = F.tid & 63; F.wave = __builtin_amdgcn_readfirstlane(F.tid >> 6); F.G = gridDim.x; F.bid = blockIdx.x;
    F.in = args.in; F.out = args.out; F.ws = args.ws; F.ctl = (unsigned*)(args.ws + WS_CTL);
    for (int u = F.tid; u < (LDS_BYTES - MISC_OFF) / 4; u += NTHR) ((LAS unsigned*)(F.lds + MISC_OFF))[u] = 0u;
    __syncthreads();
    XcdBarrier bar; bar.bar = F.ctl + CW_BAR; bar.x = 0; bar.st = nullptr;
    if (MK_N_LAUNCHES == 1) bar = xcd_barrier_post(F.ctl + CW_BAR, F.MISC + 8);
    const int lo = args.ph_lo, hi = args.ph_hi;
#define IN(k) (lo <= (k) && (k) < hi)
#ifndef PROBE_PHASE
#define PROBE_PHASE -1
#endif
#define REP(k) ((PROBE_PHASE) == (k) ? 2 : 1)
#ifndef TPROBE
#define TPROBE -1
#endif
#if TPROBE >= 0
    unsigned long long tpA = 0, tpB = 0;
#define TP_A(k) do { if ((k) == TPROBE / 100) tpA = __builtin_amdgcn_s_memrealtime(); } while (0)
#define TP_B(k) do { if ((k) == TPROBE % 100) tpB = __builtin_amdgcn_s_memrealtime(); } while (0)
#else
#define TP_A(k) do {} while (0)
#define TP_B(k) do {} while (0)
#endif
#define SEAM(k) do { if (IN(k) && IN((k) + 1)) xcd_barrier(bar); TP_B(k); } while (0)
    LAS unsigned char* ring = F.lds;
    const LAS int* MI = (const LAS int*)F.MISC;

    static_assert(MK_N_LAUNCHES == 1, "the W_in quantisation needs an in-launch barrier inside phase 0");
    TP_A(0); if (IN(0)) { p0_prologue(F); xcd_barrier(bar); p0b_win(F); } SEAM(0);
    TP_A(1); if (IN(1)) {
        const int ng = F.G > 2 * NCV ? F.G - NCV : F.G;
        if (F.bid < ng) {
            pg8::Gemm g{(const bf16*)(F.ws + WS_HN), (const bf16*)(F.ws + WS_WIN), T, NINP, D / 2}; pg8::StaticOrder S; S.init(T, NINP, ng, F.bid);
            EpiP1I8 E{(bf16*)(F.ws + WS_P), NINP, (const float*)(F.ws + WS_RA), F.ctl + CW_COLMAX};
            pg8::gemm_phase<EpiP1I8, pg8::StaticOrder, true, true, false, true>(ring, g, S, E);
            if (F.tid == 0) __hip_atomic_fetch_add(F.ctl + CW_P1DONE, 1u, __ATOMIC_RELAXED, __HIP_MEMORY_SCOPE_AGENT);
        } else if (F.wave >= CV1_W0) convert_loop(F, F.ctl + CW_CVNEXT, F.ctl + CW_P1DONE, (unsigned)ng, F.lds + F.wave * 9216, 0u, (unsigned)CV_SPLIT);
    } SEAM(1);
    TP_A(2); if (IN(2)) { for (int rep = 0; rep < REP(2); ++rep) p2_lora_in(F); } SEAM(2);
    TP_A(3); if (IN(3)) {
        pg8::Gemm g{(const bf16*)(F.ws + WS_LIN), (const bf16*)(F.ws + WS_WL), T, 3072, 512}; pg8::StaticOrder S; S.init(T, 3072, F.G, F.bid);
        EpiLora E{(float*)(F.ws + WS_WAG), (bf16*)(F.ws + WS_WAG + 64 * MiB), F.in[I_W0], F.in[I_A0]};
        pg8::gemm_phase<EpiLora, pg8::StaticOrder, true, true>(ring, g, S, E);
    } SEAM(3);
    TP_A(4); if (IN(4)) {
        { LAS unsigned* ctl2 = (LAS unsigned*)F.MISC + 16;
          TP_A(14); TP_A(15); TP_A(16); if (F.wave < 4) { TP_B(14); TP_B(16); unsigned bt = 0u; for (int rep = 0; rep < REP(40); ++rep) for (int u = F.bid; u < 256; u += F.G) rwkv_chunk_unit(F, u, (LAS unsigned char*)F.MISC + 256, ctl2, bt); TP_B(15); }
          else { Frame F2 = F; F2.tid = F.tid - 256; F2.wave = F.wave - 4; F2.lds = F.lds + 45056; unsigned bt = 0u;
                 for (int rep = 0; rep < REP(41); ++rep) for (int u = F.bid; u < 256; u += F.G) mlstm_scan_unit(F2, u, ctl2 + 2, bt);
                 rw_bar(ctl2 + 2, bt, F2.lane); TP_B(15); TP_B(16); }
          if (F.wave >= CV_W0) convert_loop(F, F.ctl + CW_CVNEXT, nullptr, 0u, F.lds + 45056 + (F.wave - 4) * 9216, 0u, (unsigned)CV_SPLIT);
          if (F.wave >= 4) TP_B(14);
          __syncthreads(); }
    } SEAM(4);
    TP_A(5); if (IN(5)) { if (F.wave < P5_NW) { for (int rep = 0; rep < REP(5); ++rep) p5_finalize(F); }
                 else convert_loop(F, F.ctl + CW_CVNEXT2, nullptr, 0u, F.lds + F.wave * 9216, (unsigned)CV_SPLIT, (unsigned)CV_ITEMS); }     SEAM(5);
    TP_A(6); if (IN(6)) {
        { pg8::Gemm g{(const bf16*)(F.ws + WS_OA), (const bf16*)(F.ws + WS_WA), T, D, RD}; pg8::StaticOrder S; S.init(T, D, F.G, F.bid);
          EpiGateA E{(bf16*)(F.ws + WS_TMP), (const bf16*)(F.ws + WS_P), F.in[I_BGATE]};
          pg8::gemm_phase<EpiGateA, pg8::StaticOrder, true, true>(ring, g, S, E); }
        VM_WAIT(); __syncthreads();
        { pg8::Gemm g{(const bf16*)(F.ws + WS_OB), (const bf16*)(F.ws + WS_WB), T, D, RD}; pg8::StaticOrder S; S.init(T, D, F.G, F.bid);
          EpiGateB E{(const bf16*)(F.ws + WS_TMP), (bf16*)(F.ws + WS_MRG), (const bf16*)(F.ws + WS_P), F.in[I_BGATE]};
          pg8::gemm_phase<EpiGateB, pg8::StaticOrder, true, true>(ring, g, S, E); }
    } SEAM(6);
    TP_A(7); if (IN(7)) {
        pg8::Gemm g{(const bf16*)(F.ws + WS_MRG), (const bf16*)(F.ws + WS_WO), T, D, D}; pg8::StaticOrder S; S.init(T, D, F.G, F.bid);
        EpiResid E{F.in[I_X], (bf16*)(F.ws + WS_X1)};
        pg8::gemm_phase<EpiResid, pg8::StaticOrder, true, true>(ring, g, S, E);
    } SEAM(7);
    TP_A(8); if (IN(8)) { p8_route(F); } SEAM(8);
    TP_A(10); if (IN(10)) {
        build_moe_tables(F);
        const int mt = MI[MI_MT];
        pg8::Gemm g{(const bf16*)(F.ws + WS_HN), (const bf16*)(F.ws + WS_WGU), mt * 256, 2 * FF, D / 2};
        MoeGatherOrder S; S.init(mt * 256, 2 * FF, F.G, F.bid); S.tile_e = MI + MI_TILE_E; S.estride = (size_t)2 * FF * D;
        S.tile_i0 = MI + MI_TILE_I0; S.cnt = MI + MI_CNT; S.rlist = (const int*)(F.ws + WS_RLIST); S.rowoff = (LAS unsigned*)F.MISC + MI_ROWOFF; S.rowbytes = D;
        EpiSwiGLU E{(unsigned char*)(F.ws + WS_ACT), F.in[I_BGU], MI + MI_TILE_E};
        pg8::gemm_phase<EpiSwiGLU, MoeGatherOrder, true, true, true>(ring, g, S, E);
    } SEAM(10);
    TP_A(11); if (IN(11)) {
        build_moe_tables(F);
        const int mt = MI[MI_MT];
        pg8::Gemm g{(const bf16*)(F.ws + WS_ACT), (const bf16*)(F.ws + WS_WDN), mt * 256, D, FF / 2};
        MoeOrder S; S.init(mt * 256, D, F.G, F.bid); S.tile_e = MI + MI_TILE_E; S.estride = (size_t)D * FF;
        LAS int* rowdst = (LAS int*)F.MISC + MI_ROWOFF; LAS float* rowwt = (LAS float*)F.MISC + MI_ROWOFF + 10 * 256;
        fill_down_tables(F, S, rowdst, rowwt);
        EpiDown E{(unsigned char*)(F.ws + WS_YS), F.in[I_BDN], MI + MI_TILE_E, rowdst, rowwt};
        pg8::gemm_phase<EpiDown, MoeOrder, true, true, true>(ring, g, S, E);
    } SEAM(11);
    TP_A(12); if (IN(12)) { for (int rep = 0; rep < REP(12); ++rep) p12_final(F); } TP_B(12);
#if TPROBE >= 0
    { const unsigned long long tend = __builtin_amdgcn_s_memrealtime() + 4ull * (tpB - tpA); while (__builtin_amdgcn_s_memrealtime() < tend) __builtin_amdgcn_s_sleep(8); }
#endif
#undef IN
#undef SEAM
}

extern "C" void kernel_launch(void* const* d_in, const int* in_sizes, int n_in, void* d_out, int out_size, void* d_ws, size_t ws_size, hipStream_t stream) {
    static int grid = 0;
    if (grid == 0) {
        if (n_in != 30 || out_size != T * D || ws_size < WS_END) { fprintf(stderr, "kernel_launch: unexpected problem (n_in %d, out %d, ws %zu)\n", n_in, out_size, ws_size); grid = -1; return; }
        int dev = 0, cus = 0, per_cu = 0;
        if (hipGetDevice(&dev) != hipSuccess || hipDeviceGetAttribute(&cus, hipDeviceAttributeMultiprocessorCount, dev) != hipSuccess) { grid = -1; return; }
        if (hipFuncSetAttribute((const void*)mk_fwd, hipFuncAttributeMaxDynamicSharedMemorySize, LDS_BYTES) != hipSuccess) { fprintf(stderr, "kernel_launch: hipFuncSetAttribute failed\n"); grid = -1; return; }
        if (hipOccupancyMaxActiveBlocksPerMultiprocessor(&per_cu, (const void*)mk_fwd, NTHR, LDS_BYTES) != hipSuccess || per_cu < 1) fprintf(stderr, "kernel_launch: occupancy query says %d\n", per_cu);
        (void)hipGetLastError();
        grid = cus;
    }
    if (grid < 0) return;
    if (hipMemsetAsync((char*)d_ws + WS_CTL, 0, CTL_ZERO_BYTES, stream) != hipSuccess) return;
    Args a{};
    for (int i = 0; i < 30; ++i) a.in[i] = (const float*)d_in[i];
    a.out = (float*)d_out; a.ws = (unsigned char*)d_ws;
    for (int li = 0; li < MK_N_LAUNCHES; ++li) {
        a.ph_lo = (MK_N_LAUNCHES == 1) ? 0 : li; a.ph_hi = (MK_N_LAUNCHES == 1) ? NPH : li + 1;
        hipLaunchKernelGGL(mk_fwd, dim3(grid), dim3(NTHR), LDS_BYTES, stream, a);
        const hipError_t le = hipPeekAtLastError();
        if (le != hipSuccess) { fprintf(stderr, "kernel_launch: launch %d failed: %s\n", li, hipGetErrorName(le)); break; }
    }
}
```

```cpp
#include <hip/hip_runtime.h>
#include <cstdio>
#include <cstdint>

#define MK_N_LAUNCHES 1
#define PROBE_PHASE -1
namespace pg8 {
#define PG8_LAS __attribute__((address_space(3)))
typedef unsigned short bf16_t;
typedef short bf16x8 __attribute__((ext_vector_type(8)));
typedef float f32x4 __attribute__((ext_vector_type(4)));
typedef unsigned u32x4 __attribute__((ext_vector_type(4)));
constexpr int BM = 256, BK = 64, HALF = 128, HTB = HALF * BK * 2  , STAGE_BYTES = 8 * HTB, NXCD = 8, WGM = 8;

__host__ __device__ __forceinline__ int lds_byte(int r, int c) { const int st = (r >> 4) * 2 + (c >> 5), rr = r & 15, cc = c & 31, ob = rr * 64 + cc * 2; return st * 1024 + (ob ^ (((ob >> 9) & 1) << 5)); }
__host__ __device__ __forceinline__ void stage_rc(int b, int& R, int& C) { const int st = b / 1024, sb = b % 1024, swz = sb ^ (((sb >> 9) & 1) << 5); R = (st >> 1) * 16 + swz / 64; C = (st & 1) * 32 + (swz % 64) / 2; }
__host__ __device__ __forceinline__ int perm32(int rho) { const int n = rho >> 4, i = rho & 15; return 8 * (i >> 2) + 4 * n + (i & 3); }

struct Unit { int pm, pn, ord; };
struct Gemm { const bf16_t* A; const bf16_t* Bt; int M, N, K; };

struct StaticOrder {
    int nM, nN, nwg, G, c;
    __host__ __device__ void init(int M, int N, int G_, int c_) { nM = M / BM; nN = N / BM; nwg = nM * nN; G = G_; c = c_; }
    __host__ __device__ bool next(int i, Unit& u) const {
        const long L = (long)i * G + c; if (L >= nwg) return false;
        int wgid = (int)L; { const int q = nwg / NXCD, r = nwg % NXCD, xcd = wgid % NXCD, off = wgid / NXCD; wgid = (xcd < r ? xcd * (q + 1) : r * (q + 1) + (xcd - r) * q) + off; }
        const int nig = WGM * nN, gid = wgid / nig, fm = gid * WGM, gsz = (nM - fm) < WGM ? (nM - fm) : WGM;
        u.pm = fm + ((wgid % nig) % gsz); u.pn = (wgid % nig) / gsz; u.ord = i; return true;
    }
    __device__ __forceinline__ void a_ready(const Unit&) const {}
    static constexpr bool GATHER = false;
    __device__ __forceinline__ void fill_all() const {}
    __device__ __forceinline__ unsigned row_off(int, int) const { return 0u; }
    __device__ __forceinline__ void done(const Unit&) const {}
    __device__ __forceinline__ size_t a_off(const Unit& u, size_t tstep) const { return (size_t)u.pm * tstep; }
    __device__ __forceinline__ size_t b_off(const Unit& u, size_t tstep) const { return (size_t)u.pn * tstep; }
};
__device__ __forceinline__ unsigned cvt_pk_bf16(float lo, float hi) { unsigned r; asm volatile("v_cvt_pk_bf16_f32 %0, %1, %2" : "=v"(r) : "v"(lo), "v"(hi)); return r; }
typedef int v8i32 __attribute__((ext_vector_type(8)));
typedef int v4i32 __attribute__((ext_vector_type(4)));
__device__ __forceinline__ v8i32 cat8(bf16x8 lo, bf16x8 hi) { const v4i32 a = __builtin_bit_cast(v4i32, lo), b = __builtin_bit_cast(v4i32, hi); return __builtin_shufflevector(a, b, 0, 1, 2, 3, 4, 5, 6, 7); }
template <class Epi, class Sched, bool ALIGN_EPI = false, bool SP2 = false, bool FP8 = false, bool I8 = false>
__device__ __forceinline__ void gemm_phase(PG8_LAS unsigned char* lds, const Gemm g, const Sched& S, const Epi& E) {
    const int tid = threadIdx.x, wid = __builtin_amdgcn_readfirstlane(tid >> 6), lane = tid & 63, wr = wid >> 2, wc = wid & 3, fr = lane & 15, fq = lane >> 4;
    const int K = g.K, nt = K / BK;
    unsigned voffA[2], voffB[2];
#pragma unroll
    for (int i = 0; i < 2; ++i) { int R, C; stage_rc(tid * 16 + i * 8192, R, C); const int Rb = Epi::PERM ? ((R & ~31) + perm32(R & 31)) : R;
        voffA[i] = (unsigned)(R * K + C) * 2u; voffB[i] = (unsigned)(Rb * K + C) * 2u; }
    unsigned voffA1[2]; int rselA[2]; unsigned cselA[2];
#pragma unroll
    for (int i = 0; i < 2; ++i) { int R, C; stage_rc(tid * 16 + i * 8192, R, C); rselA[i] = R; cselA[i] = (unsigned)C * 2u; voffA1[i] = voffA[i]; }
    const size_t kstep = (size_t)(BK * 2);
    const size_t hstep = (size_t)HALF * K * 2;
    const size_t tstep = 2 * hstep;
    const size_t hstepA = Sched::GATHER ? (size_t)0 : hstep;
#define PG8_ROWS(_u) do { _Pragma("unroll") for (int _i = 0; _i < 2; ++_i) { voffA[_i] = S.row_off((_u), rselA[_i]) + cselA[_i]; voffA1[_i] = S.row_off((_u), HALF + rselA[_i]) + cselA[_i]; } } while (0)
    const unsigned ldsw = (unsigned)wid * 1024u;
    const int aoff = lds_byte(wr * 64 + fr, fq * 8), boff = lds_byte(wc * 32 + fr, fq * 8);
#define PG8_SA(b, h) (((b) * 2 + (h)) * HTB)
#define PG8_SB(b, h) ((4 + (b) * 2 + (h)) * HTB)
#define PG8_STAGE(bufoff, gbase, voff) do { _Pragma("unroll") for (int _i = 0; _i < 2; ++_i) \
        __builtin_amdgcn_global_load_lds((const unsigned*)((const char*)(gbase) + (voff)[_i]), (PG8_LAS unsigned*)(lds + (bufoff) + ldsw + _i * 8192), 16, 0, 0); } while (0)
#define PG8_LDA(dst, b, h) do { if constexpr (FP8) { _Pragma("unroll") for (int m = 0; m < 4; ++m) dst##8[m] = cat8(*(const PG8_LAS bf16x8*)(lds + PG8_SA(b, h) + aoff + m * 2048), *(const PG8_LAS bf16x8*)(lds + PG8_SA(b, h) + aoff + m * 2048 + 1024)); } \
        else { _Pragma("unroll") for (int m = 0; m < 4; ++m) _Pragma("unroll") for (int k = 0; k < 2; ++k) dst[m][k] = *(const PG8_LAS bf16x8*)(lds + PG8_SA(b, h) + aoff + m * 2048 + k * 1024); } } while (0)
#define PG8_LDB(dst, b, h) do { if constexpr (FP8) { _Pragma("unroll") for (int n = 0; n < 2; ++n) dst##8[n] = cat8(*(const PG8_LAS bf16x8*)(lds + PG8_SB(b, h) + boff + n * 2048), *(const PG8_LAS bf16x8*)(lds + PG8_SB(b, h) + boff + n * 2048 + 1024)); } \
        else { _Pragma("unroll") for (int n = 0; n < 2; ++n) _Pragma("unroll") for (int k = 0; k < 2; ++k) dst[n][k] = *(const PG8_LAS bf16x8*)(lds + PG8_SB(b, h) + boff + n * 2048 + k * 1024); } } while (0)
#define PG8_MMA(ai, bj, At, Bt) do { __builtin_amdgcn_s_setprio(1); if constexpr (FP8) { _Pragma("unroll") for (int m = 0; m < 4; ++m) _Pragma("unroll") for (int n = 0; n < 2; ++n) \
        asm volatile("v_mfma_scale_f32_16x16x128_f8f6f4 %0, %1, %2, %0, %3, %3 op_sel_hi:[0,0,0]" : "+v"(acc[ai][bj][m][n]) : "v"(Bt##8[n]), "v"(At##8[m]), "v"(f8scale)); } else { \
        _Pragma("unroll") for (int m = 0; m < 4; ++m) _Pragma("unroll") for (int n = 0; n < 2; ++n) _Pragma("unroll") for (int k = 0; k < 2; ++k) { \
        if constexpr (I8) acc[ai][bj][m][n] = __builtin_bit_cast(f32x4, __builtin_amdgcn_mfma_i32_16x16x64_i8(__builtin_bit_cast(v4i32, Bt[n][k]), __builtin_bit_cast(v4i32, At[m][k]), __builtin_bit_cast(v4i32, acc[ai][bj][m][n]), 0, 0, 0)); \
        else acc[ai][bj][m][n] = __builtin_amdgcn_mfma_f32_16x16x32_bf16(Bt[n][k], At[m][k], acc[ai][bj][m][n], 0, 0, 0); } } __builtin_amdgcn_s_setprio(0); } while (0)
#define PG8_WAIT_V(n) asm volatile("s_waitcnt vmcnt(" #n ")" ::: "memory")
#define PG8_WAIT_L(n) asm volatile("s_waitcnt lgkmcnt(" #n ")" ::: "memory")
#define PG8_BAR __builtin_amdgcn_s_barrier()
#define PG8_SCHED __builtin_amdgcn_sched_barrier(0)
    Unit cur, nxt; int ui = 0;
    if (!S.next(0, cur)) return;
    f32x4 acc[2][2][4][2];
#pragma unroll
    for (int a = 0; a < 2; ++a)
#pragma unroll
        for (int b = 0; b < 2; ++b)
#pragma unroll
            for (int m = 0; m < 4; ++m)
#pragma unroll
                for (int n = 0; n < 2; ++n) acc[a][b][m][n] = (f32x4){0.f, 0.f, 0.f, 0.f};
    const int f8scale = 0x7f7f7f7f;
    bf16x8 At[4][2], B0[2][2], B1[2][2]; v8i32 At8[4], B08[2], B18[2];
    const char* cA = (const char*)g.A + S.a_off(cur, tstep); const char* cB = (const char*)g.Bt + S.b_off(cur, tstep);
    S.a_ready(cur);
    if constexpr (Sched::GATHER) { S.fill_all(); asm volatile("s_waitcnt vmcnt(0) lgkmcnt(0)" ::: "memory"); __builtin_amdgcn_s_barrier(); asm volatile("" ::: "memory"); PG8_ROWS(0); }
    if constexpr (SP2) {
        PG8_STAGE(PG8_SB(0, 0), cB, voffB); PG8_STAGE(PG8_SB(0, 1), cB + hstep, voffB); PG8_STAGE(PG8_SA(0, 0), cA, voffA); PG8_STAGE(PG8_SA(0, 1), cA + hstepA, voffA1);
        if (wr == 1) PG8_BAR;
        PG8_WAIT_V(2); PG8_BAR;
        PG8_STAGE(PG8_SB(1, 0), cB + kstep, voffB); PG8_STAGE(PG8_SA(1, 0), cA + kstep, voffA); PG8_STAGE(PG8_SB(1, 1), cB + hstep + kstep, voffB);
        PG8_WAIT_V(6); PG8_BAR;
    } else {
        PG8_STAGE(PG8_SB(0, 0), cB, voffB); PG8_STAGE(PG8_SA(0, 0), cA, voffA); PG8_STAGE(PG8_SB(0, 1), cB + hstep, voffB); PG8_STAGE(PG8_SA(0, 1), cA + hstepA, voffA1);
        if (wr == 1) PG8_BAR;
        PG8_WAIT_V(4); PG8_BAR;
        PG8_STAGE(PG8_SB(1, 0), cB + kstep, voffB); PG8_STAGE(PG8_SA(1, 0), cA + kstep, voffA); PG8_STAGE(PG8_SB(1, 1), cB + hstep + kstep, voffB);
        PG8_WAIT_V(6); PG8_BAR;
    }
    for (;;) {
        const bool has_next = S.next(ui + 1, nxt);
        const char* nA = has_next ? (const char*)g.A + S.a_off(nxt, tstep) : cA; const char* nB = has_next ? (const char*)g.Bt + S.b_off(nxt, tstep) : cB;
        for (int t = 0; t < nt; t += 2) {
            const bool last = (t == nt - 2);
            const char* a1 = cA + (size_t)(t + 1) * kstep;
            const char* a2 = last ? nA : cA + (size_t)(t + 2) * kstep; const char* b2 = last ? nB : cB + (size_t)(t + 2) * kstep;
            const char* a3 = a2 + kstep; const char* b3 = b2 + kstep;
            if (last && has_next) S.a_ready(nxt);
            if constexpr (SP2) {
            PG8_LDB(B0, 0, 0); PG8_LDB(B1, 0, 1); PG8_SCHED; PG8_LDA(At, 0, 0); PG8_STAGE(PG8_SA(1, 1), a1 + hstepA, voffA1);
            PG8_WAIT_V(8); PG8_WAIT_L(0); PG8_BAR; PG8_MMA(0, 0, At, B0); PG8_MMA(0, 1, At, B1); PG8_BAR; PG8_SCHED;
            if constexpr (Sched::GATHER) { if (last && has_next) PG8_ROWS(ui + 1); }
            PG8_LDA(At, 0, 1); PG8_STAGE(PG8_SB(0, 0), b2, voffB); PG8_STAGE(PG8_SB(0, 1), b2 + hstep, voffB); PG8_STAGE(PG8_SA(0, 0), a2, voffA);
            PG8_WAIT_V(8); PG8_WAIT_L(0); PG8_BAR; PG8_MMA(1, 0, At, B0); PG8_MMA(1, 1, At, B1); PG8_BAR; PG8_SCHED;
            PG8_LDB(B0, 1, 0); PG8_LDB(B1, 1, 1); PG8_SCHED; PG8_LDA(At, 1, 0); PG8_STAGE(PG8_SA(0, 1), a2 + hstepA, voffA1);
            PG8_WAIT_V(8); PG8_WAIT_L(0); PG8_BAR; PG8_MMA(0, 0, At, B0); PG8_MMA(0, 1, At, B1); PG8_BAR; PG8_SCHED;
            PG8_LDA(At, 1, 1); PG8_STAGE(PG8_SB(1, 0), b3, voffB); PG8_STAGE(PG8_SB(1, 1), b3 + hstep, voffB); PG8_STAGE(PG8_SA(1, 0), a3, voffA);
            PG8_WAIT_V(8); PG8_WAIT_L(0); PG8_BAR; PG8_MMA(1, 0, At, B0); PG8_MMA(1, 1, At, B1); PG8_BAR; PG8_SCHED;
            } else {
            PG8_LDB(B0, 0, 0); PG8_SCHED; PG8_LDA(At, 0, 0); PG8_STAGE(PG8_SA(1, 1), a1 + hstepA, voffA1);
            PG8_WAIT_L(8); PG8_BAR; PG8_WAIT_L(0); PG8_MMA(0, 0, At, B0); PG8_BAR; PG8_SCHED;
            PG8_LDB(B1, 0, 1); PG8_STAGE(PG8_SB(0, 0), b2, voffB);
            PG8_BAR; PG8_WAIT_L(0); PG8_MMA(0, 1, At, B1); PG8_BAR;
            PG8_LDA(At, 0, 1); PG8_STAGE(PG8_SA(0, 0), a2, voffA);
            PG8_BAR; PG8_WAIT_L(0); PG8_MMA(1, 0, At, B0); PG8_BAR; PG8_SCHED;
            PG8_STAGE(PG8_SB(0, 1), b2 + hstep, voffB);
            PG8_WAIT_V(6); PG8_BAR; PG8_MMA(1, 1, At, B1); PG8_BAR;
            PG8_LDB(B0, 1, 0); PG8_SCHED; PG8_LDA(At, 1, 0); PG8_STAGE(PG8_SA(0, 1), a2 + hstepA, voffA1);
            PG8_WAIT_L(8); PG8_BAR; PG8_WAIT_L(0); PG8_MMA(0, 0, At, B0); PG8_BAR; PG8_SCHED;
            PG8_LDB(B1, 1, 1); PG8_STAGE(PG8_SB(1, 0), b3, voffB);
            PG8_BAR; PG8_WAIT_L(0); PG8_MMA(0, 1, At, B1); PG8_BAR;
            PG8_LDA(At, 1, 1); PG8_STAGE(PG8_SA(1, 0), a3, voffA);
            PG8_BAR; PG8_WAIT_L(0); PG8_MMA(1, 0, At, B0); PG8_BAR; PG8_SCHED;
            PG8_STAGE(PG8_SB(1, 1), b3 + hstep, voffB);
            PG8_WAIT_V(6); PG8_BAR; PG8_MMA(1, 1, At, B1); PG8_BAR;
            }
        }
        if constexpr (ALIGN_EPI) { if (wr == 0) PG8_BAR; }
        if constexpr (FP8) { asm volatile("s_nop 15\n\ts_nop 15" ::: "memory"); }
        if constexpr (!Epi::AFTER_DRAIN) { E(acc, cur, wr, wc, fr, fq); S.done(cur); }
        if (!has_next) break;
#pragma unroll
        for (int a = 0; a < 2; ++a)
#pragma unroll
            for (int b = 0; b < 2; ++b)
#pragma unroll
                for (int m = 0; m < 4; ++m)
#pragma unroll
                    for (int n = 0; n < 2; ++n) acc[a][b][m][n] = (f32x4){0.f, 0.f, 0.f, 0.f};
        cur = nxt; cA = nA; cB = nB; ++ui;
        if constexpr (ALIGN_EPI) { if (wr == 1) PG8_BAR; }
    }
    PG8_WAIT_V(0);
    if constexpr (!ALIGN_EPI) { if (wr == 0) PG8_BAR; }
    PG8_BAR;
    if constexpr (Epi::AFTER_DRAIN) { E.fused(acc, cur, wr, wc, fr, fq, lds, wid, lane); S.done(cur); }
#undef PG8_ROWS
#undef PG8_SA
#undef PG8_SB
#undef PG8_STAGE
#undef PG8_LDA
#undef PG8_LDB
#undef PG8_MMA
#undef PG8_WAIT_V
#undef PG8_WAIT_L
#undef PG8_BAR
#undef PG8_SCHED
}
}

#ifndef MK_N_LAUNCHES
#define MK_N_LAUNCHES 1
#endif
#define GAS __attribute__((address_space(1)))
#define LAS __attribute__((address_space(3)))
typedef unsigned short bf16;
typedef unsigned v4u __attribute__((ext_vector_type(4)));
typedef unsigned v2u __attribute__((ext_vector_type(2)));
typedef float f32x4 __attribute__((ext_vector_type(4)));
typedef float f32x2 __attribute__((ext_vector_type(2)));

constexpr int NWAVES = 8, NTHR = 512;
constexpr int NPH = 13;
constexpr int D = 2048, BATCH = 8, SEQ = 2048, T = BATCH * SEQ;
constexpr int NIN = 10696, NINP = 10752;
constexpr int MLO = 3520, GTO = 6600;
constexpr int RH = 16, RD = 1024;
constexpr int MH = 4;
constexpr int NE = 32, FF = 2048, ECAP = 16384, PMAX = 65536 + NE * 256, MTMAX = PMAX / 256;
constexpr float NORM_EPS = 1e-6f, GN_EPS = 64e-5f;
constexpr size_t MiB = 1u << 20;
constexpr size_t WS_CTL = 0, CTL_ZERO_BYTES = 1 * MiB;
constexpr size_t WS_WIN = 1 * MiB, WS_WA = 43 * MiB, WS_WB = 47 * MiB, WS_WO = 51 * MiB, WS_WL = 59 * MiB;
constexpr size_t WS_RLIST = 62 * MiB, WS_RW = 64 * MiB, WS_RWS = 2787 * MiB, WS_RA = 2787 * MiB + 512 * 1024;
constexpr size_t WS_WGU = 66 * MiB, WS_WDN = 578 * MiB, WS_HN = 834 * MiB, WS_P = 898 * MiB, WS_LIN = 1234 * MiB, WS_WAG = 1250 * MiB;
constexpr size_t WS_YRAW = 1442 * MiB, WS_HRAW = 1506 * MiB, WS_OA = 1570 * MiB, WS_OB = 1602 * MiB, WS_TMP = 1634 * MiB, WS_MRG = 1762 * MiB;
constexpr size_t WS_QKC = WS_TMP, WS_GLF = WS_TMP + 64 * MiB;
constexpr size_t WS_X1 = 1826 * MiB, WS_XB = 1954 * MiB, WS_ACT = 2242 * MiB, WS_YS = 2530 * MiB, WS_END = 2788 * MiB;
constexpr int CW_BAR = 4096;
constexpr int CW_CVNEXT = 8192, CW_P1DONE = 8192 + 64, CW_CVNEXT2 = 8192 + 192;
constexpr int CV_W0 = 6, CV1_W0 = 4;
constexpr int NCV = 64;
constexpr int CW_COLMAX = 32768;
constexpr int CW_CNT = 16384;
constexpr int RING_BYTES = 131072, MISC_OFF = RING_BYTES, LDS_BYTES = RING_BYTES + 8192 + 20 * 1024;
constexpr int MI_TILE_E = 64, MI_TILE_I0 = 64 + 320, MI_CNT = 64 + 640, MI_POFF = MI_CNT + 32, MI_CST = MI_POFF + 32, MI_MT = MI_CST + 40, MI_ROWOFF = 2048;

#define LDS_WAIT() asm volatile("s_waitcnt lgkmcnt(0)" ::: "memory")
#define VM_WAIT() asm volatile("s_waitcnt vmcnt(0)" ::: "memory")
__device__ __forceinline__ float bf2f(bf16 v) { return __uint_as_float(((unsigned)v) << 16); }
__device__ __forceinline__ unsigned f2bf(float f) { unsigned u = __float_as_uint(f); return (u + 0x7fffu + ((u >> 16) & 1u)) >> 16; }
typedef __bf16 bf16x2_t __attribute__((ext_vector_type(2)));
__device__ __forceinline__ unsigned pk2(float lo, float hi) { const f32x2 v = {lo, hi}; const bf16x2_t b = __builtin_convertvector(v, bf16x2_t); return __builtin_bit_cast(unsigned, b); }
__device__ __forceinline__ unsigned pk4f8(float a, float b, float c, float d) { int r = 0; r = __builtin_amdgcn_cvt_pk_fp8_f32(a, b, r, false); r = __builtin_amdgcn_cvt_pk_fp8_f32(c, d, r, true); return (unsigned)r; }
constexpr float F8_SX = 8.f, F8_SW = 256.f, F8_SA = 4.f, F8_SY = 16.f;
__device__ __forceinline__ unsigned pk4i8(float a, float b, float c, float d) {
    const int ia = (int)__builtin_rintf(a), ib = (int)__builtin_rintf(b), ic = (int)__builtin_rintf(c), id = (int)__builtin_rintf(d);
    return (unsigned)(ia & 255) | ((unsigned)(ib & 255) << 8) | ((unsigned)(ic & 255) << 16) | ((unsigned)id << 24); }
__device__ __forceinline__ float wave_max(float v) {
#pragma unroll
    for (int o = 1; o < 64; o <<= 1) v = fmaxf(v, __shfl_xor(v, o));
    return v;
}
__device__ __forceinline__ float wave_sum(float v) {
#pragma unroll
    for (int o = 1; o < 64; o <<= 1) v += __shfl_xor(v, o);
    return v;
}
#define UNP4(v) ((f32x4){__uint_as_float((v).x << 16), __uint_as_float((v).x & 0xffff0000u), __uint_as_float((v).y << 16), __uint_as_float((v).y & 0xffff0000u)})
__device__ __forceinline__ float sigm(float x) { return __builtin_amdgcn_rcpf(1.f + __expf(-x)); }
template <int CTRL> __device__ __forceinline__ float dppf(float x) { return __builtin_bit_cast(float, __builtin_amdgcn_mov_dpp(__builtin_bit_cast(int, x), CTRL, 0xf, 0xf, true)); }
__device__ __forceinline__ float allreduce16(float x) { x += dppf<0x128>(x); x += dppf<0x124>(x); x += dppf<0x4E>(x); x += dppf<0xB1>(x); return x; }

#define XB_TMO      128
#define XB_XCNT(j)  (256  + 64 * (j))
#define XB_XSUB(j)  (1280 + 64 * (j))
#define XB_XGEN(j)  (2304 + 64 * (j))
#define XB_TOP      3328
#define XB_TOPGEN   3392
#define XCD_BAR_WORDS 3456
#define XB_SPIN_CAP (1u << 18)
__device__ __forceinline__ unsigned xb_ld(unsigned* p)              { return __hip_atomic_load(p, __ATOMIC_RELAXED, __HIP_MEMORY_SCOPE_AGENT); }
__device__ __forceinline__ unsigned xb_add(unsigned* p, unsigned v) { return __hip_atomic_fetch_add(p, v, __ATOMIC_RELAXED, __HIP_MEMORY_SCOPE_AGENT); }
__device__ __forceinline__ unsigned xb_xcc_id() { return (unsigned)__builtin_amdgcn_s_getreg((3 << 11) | 20) & 0xFu; }
#define XB_SPIN(cond, bar) do { unsigned _sp = 0; while (cond) { __builtin_amdgcn_s_sleep(1); \
    if ((++_sp & 255u) == 0u) { if (xb_ld(&(bar)[XB_TMO])) break; if (_sp > XB_SPIN_CAP) { atomicAdd(&(bar)[XB_TMO], 1u); break; } } } } while (0)
struct XcdBarrier { unsigned* bar; unsigned x; volatile LAS unsigned* st; };
__device__ __forceinline__ XcdBarrier xcd_barrier_post(unsigned* bar, volatile LAS unsigned* st) {
    XcdBarrier b; b.bar = bar; b.x = xb_xcc_id(); b.st = st;
    if (threadIdx.x == 0) (void)xb_add(&bar[XB_XCNT(b.x)], 1u);
    return b;
}
__device__ __forceinline__ void xcd_barrier_complete(unsigned* bar, unsigned x, unsigned& nloc, unsigned& nx) {
    const unsigned G = gridDim.x * gridDim.y * gridDim.z;
    unsigned sum, cnt, mine, sp = 0u;
    for (;;) {
        sum = 0u; cnt = 0u; mine = 0u;
#pragma unroll
        for (unsigned j = 0; j < 16; ++j) { const unsigned c = xb_ld(&bar[XB_XCNT(j)]); sum += c; cnt += (c > 0u) ? 1u : 0u; mine = (j == x) ? c : mine; }
        if (sum == G) break;
        __builtin_amdgcn_s_sleep(1);
        if ((++sp & 255u) == 0u) { if (xb_ld(&bar[XB_TMO])) break; if (sp > XB_SPIN_CAP) { atomicAdd(&bar[XB_TMO], 1u); break; } }
    }
    nloc = mine > 0u ? mine : 1u; nx = cnt > 0u ? cnt : 1u;
}
__device__ __forceinline__ void xcd_barrier(const XcdBarrier& b) {
    asm volatile("s_waitcnt vmcnt(0)" ::: "memory");
    __syncthreads();
    if (threadIdx.x == 0) {
        unsigned* bar = b.bar;
        __builtin_amdgcn_s_waitcnt(0);
        unsigned nloc = b.st[0], nx = b.st[1];
        if (nloc == 0u) { xcd_barrier_complete(bar, b.x, nloc, nx); b.st[0] = nloc; b.st[1] = nx; }
        const unsigned old = xb_add(&bar[XB_XSUB(b.x)], 1u);
        const unsigned gen = old / nloc;
        if (old + 1u == (gen + 1u) * nloc) {
            __builtin_amdgcn_fence(__ATOMIC_RELEASE, "agent");
            asm volatile("s_waitcnt vmcnt(0)" ::: "memory");
            const unsigned og = xb_add(&bar[XB_TOP], 1u);
            const unsigned tg = og / nx;
            if (og + 1u == (tg + 1u) * nx) xb_add(&bar[XB_TOPGEN], 1u);
            else XB_SPIN(xb_ld(&bar[XB_TOPGEN]) == tg, bar);
            __builtin_amdgcn_fence(__ATOMIC_ACQUIRE, "agent");
            xb_add(&bar[XB_XGEN(b.x)], 1u);
            asm volatile("s_waitcnt vmcnt(0)" ::: "memory");
        } else {
            XB_SPIN(xb_ld(&bar[XB_XGEN(b.x)]) == gen, bar);
            __builtin_amdgcn_fence(__ATOMIC_ACQUIRE, "agent");
            asm volatile("s_waitcnt vmcnt(0)" ::: "memory");
        }
    }
    __syncthreads();
}

struct Args { const float* in[30]; float* out; unsigned char* ws; int ph_lo, ph_hi; };
enum { I_X = 0, I_N1W, I_WIN, I_BGATE, I_MU, I_W0, I_WUP, I_A0, I_AUP, I_GUP, I_KK, I_KA, I_RK, I_LNW, I_LNB, I_CONVW, I_IB, I_FB, I_MNW, I_WBA, I_WBB, I_WOUT, I_N2W, I_RTW, I_RTB, I_WGU, I_BGU, I_WDN, I_BDN, I_FNW };

struct Frame {
    LAS unsigned char* lds; volatile LAS unsigned* MISC; unsigned* ctl;
    int tid, lane, wave, G, bid;
    const float* const* in; float* out; unsigned char* ws;
};

using pg8::Unit; using pg8::HALF; using pg8::BM;
struct EpiBf16Plain {
    static constexpr bool PERM = true, AFTER_DRAIN = false;
    bf16* O; int ldc;
    __device__ __forceinline__ void operator()(const f32x4 (&acc)[2][2][4][2], const Unit& u, int wr, int wc, int fr, int fq) const {
        const int row0 = u.pm * BM + wr * 64 + fr, col0 = u.pn * BM + wc * 32 + 8 * fq;
#pragma unroll
        for (int ai = 0; ai < 2; ++ai)
#pragma unroll
            for (int m = 0; m < 4; ++m) { bf16* rowp = O + (size_t)(row0 + ai * HALF + m * 16) * ldc + col0;
#pragma unroll
                for (int bj = 0; bj < 2; ++bj) { const f32x4 v0 = acc[ai][bj][m][0], v1 = acc[ai][bj][m][1];
                    v4u w; w.x = pg8::cvt_pk_bf16(v0[0], v0[1]); w.y = pg8::cvt_pk_bf16(v0[2], v0[3]); w.z = pg8::cvt_pk_bf16(v1[0], v1[1]); w.w = pg8::cvt_pk_bf16(v1[2], v1[3]);
                    *(v4u*)(rowp + bj * HALF) = w; } }
    }
};
struct EpiP1I8 {
    static constexpr bool PERM = true, AFTER_DRAIN = false;
    bf16* O; int ldc; const float* ra; const unsigned* colmax;
    __device__ __forceinline__ void operator()(const f32x4 (&acc)[2][2][4][2], const Unit& u, int wr, int wc, int fr, int fq) const {
        const int row0 = u.pm * BM + wr * 64 + fr, col0 = u.pn * BM + wc * 32 + 8 * fq;
        f32x4 cb[2][2];
#pragma unroll
        for (int bj = 0; bj < 2; ++bj)
#pragma unroll
            for (int n = 0; n < 2; ++n) { const v4u cm = *(const v4u*)(colmax + col0 + bj * HALF + 4 * n);
                cb[bj][n] = (f32x4){__uint_as_float(cm.x), __uint_as_float(cm.y), __uint_as_float(cm.z), __uint_as_float(cm.w)} * (1.f / 127.f); }
#pragma unroll
        for (int ai = 0; ai < 2; ++ai)
#pragma unroll
            for (int m = 0; m < 4; ++m) { const int r = row0 + ai * HALF + m * 16; const float rs = ra[r]; bf16* rowp = O + (size_t)r * ldc + col0;
#pragma unroll
                for (int bj = 0; bj < 2; ++bj) { const v4u i0 = __builtin_bit_cast(v4u, acc[ai][bj][m][0]), i1 = __builtin_bit_cast(v4u, acc[ai][bj][m][1]);
                    const f32x4 v0 = (f32x4){(float)(int)i0.x, (float)(int)i0.y, (float)(int)i0.z, (float)(int)i0.w} * cb[bj][0] * rs, v1 = (f32x4){(float)(int)i1.x, (float)(int)i1.y, (float)(int)i1.z, (float)(int)i1.w} * cb[bj][1] * rs;
                    v4u w; w.x = pk2(v0[0], v0[1]); w.y = pk2(v0[2], v0[3]); w.z = pk2(v1[0], v1[1]); w.w = pk2(v1[2], v1[3]);
                    *(v4u*)(rowp + bj * HALF) = w; } }
    }
};
struct EpiLora {
    static constexpr bool PERM = false, AFTER_DRAIN = false;
    float* WLD; bf16* AG; const float* w0; const float* a0;
    __device__ __forceinline__ void operator()(const f32x4 (&acc)[2][2][4][2], const Unit& u, int wr, int wc, int fr, int fq) const {
        const int row0 = u.pm * BM + wr * 64 + fr, col0 = u.pn * BM + wc * 32 + 4 * fq, seg = u.pn >> 2;
        f32x4 bv[2][2];
#pragma unroll
        for (int bj = 0; bj < 2; ++bj)
#pragma unroll
            for (int n = 0; n < 2; ++n) { const int c = col0 + bj * HALF + n * 16;
                bv[bj][n] = seg == 0 ? *(const f32x4*)(w0 + c) : (seg == 1 ? *(const f32x4*)(a0 + (c - 1024)) : (f32x4){0.f, 0.f, 0.f, 0.f}); }
#pragma unroll
        for (int ai = 0; ai < 2; ++ai)
#pragma unroll
            for (int m = 0; m < 4; ++m) { const size_t r = (size_t)(row0 + ai * HALF + m * 16);
#pragma unroll
                for (int bj = 0; bj < 2; ++bj)
#pragma unroll
                    for (int n = 0; n < 2; ++n) { f32x4 v = acc[ai][bj][m][n] + bv[bj][n]; const int c = col0 + bj * HALF + n * 16;
                        if (seg == 0) {
#pragma unroll
                            for (int j = 0; j < 4; ++j) v[j] = -0.6065306597126334f * sigm(v[j]);
                            *(f32x4*)(WLD + r * RD + c) = v; }
                        else { if (seg == 1) {
#pragma unroll
                                for (int j = 0; j < 4; ++j) v[j] = sigm(v[j]); }
                            v2u o; o.x = pk2(v[0], v[1]); o.y = pk2(v[2], v[3]); *(v2u*)(AG + r * D + (c - 1024)) = o; } } }
    }
};
struct EpiGateA {
    static constexpr bool PERM = true, AFTER_DRAIN = false;
    bf16* TMP; const bf16* P; const float* bg;
    __device__ __forceinline__ void operator()(const f32x4 (&acc)[2][2][4][2], const Unit& u, int wr, int wc, int fr, int fq) const {
        const int row0 = u.pm * BM + wr * 64 + fr, col0 = u.pn * BM + wc * 32 + 8 * fq;
#pragma unroll
        for (int ai = 0; ai < 2; ++ai)
#pragma unroll
            for (int m = 0; m < 4; ++m) { const size_t r = (size_t)(row0 + ai * HALF + m * 16);
#pragma unroll
                for (int bj = 0; bj < 2; ++bj) { const int c = col0 + bj * HALF;
                    const v4u pg = *(const v4u*)(P + r * NINP + GTO + c); const f32x4 b0 = *(const f32x4*)(bg + c), b1 = *(const f32x4*)(bg + c + 4);
                    f32x4 g0, g1;
                    g0[0] = sigm(__uint_as_float(pg.x << 16) + b0[0]); g0[1] = sigm(__uint_as_float(pg.x & 0xffff0000u) + b0[1]);
                    g0[2] = sigm(__uint_as_float(pg.y << 16) + b0[2]); g0[3] = sigm(__uint_as_float(pg.y & 0xffff0000u) + b0[3]);
                    g1[0] = sigm(__uint_as_float(pg.z << 16) + b1[0]); g1[1] = sigm(__uint_as_float(pg.z & 0xffff0000u) + b1[1]);
                    g1[2] = sigm(__uint_as_float(pg.w << 16) + b1[2]); g1[3] = sigm(__uint_as_float(pg.w & 0xffff0000u) + b1[3]);
                    const f32x4 t0 = g0 * acc[ai][bj][m][0], t1 = g1 * acc[ai][bj][m][1]; v4u tw; tw.x = pk2(t0[0], t0[1]); tw.y = pk2(t0[2], t0[3]); tw.z = pk2(t1[0], t1[1]); tw.w = pk2(t1[2], t1[3]);
                    *(v4u*)(TMP + r * D + c) = tw; } }
    }
};
struct EpiGateB {
    static constexpr bool PERM = true, AFTER_DRAIN = false;
    const bf16* TMP; bf16* MRG; const bf16* P; const float* bg;
    __device__ __forceinline__ void operator()(const f32x4 (&acc)[2][2][4][2], const Unit& u, int wr, int wc, int fr, int fq) const {
        const int row0 = u.pm * BM + wr * 64 + fr, col0 = u.pn * BM + wc * 32 + 8 * fq;
#pragma unroll
        for (int ai = 0; ai < 2; ++ai)
#pragma unroll
            for (int m = 0; m < 4; ++m) { const size_t r = (size_t)(row0 + ai * HALF + m * 16);
#pragma unroll
                for (int bj = 0; bj < 2; ++bj) { const int c = col0 + bj * HALF;
                    const v4u pg = *(const v4u*)(P + r * NINP + GTO + D + c); const f32x4 b0 = *(const f32x4*)(bg + D + c), b1 = *(const f32x4*)(bg + D + c + 4);
                    const v4u tw = *(const v4u*)(TMP + r * D + c); const f32x4 t0 = (f32x4){__uint_as_float(tw.x << 16), __uint_as_float(tw.x & 0xffff0000u), __uint_as_float(tw.y << 16), __uint_as_float(tw.y & 0xffff0000u)}, t1 = (f32x4){__uint_as_float(tw.z << 16), __uint_as_float(tw.z & 0xffff0000u), __uint_as_float(tw.w << 16), __uint_as_float(tw.w & 0xffff0000u)};
                    f32x4 g0, g1;
                    g0[0] = sigm(__uint_as_float(pg.x << 16) + b0[0]); g0[1] = sigm(__uint_as_float(pg.x & 0xffff0000u) + b0[1]);
                    g0[2] = sigm(__uint_as_float(pg.y << 16) + b0[2]); g0[3] = sigm(__uint_as_float(pg.y & 0xffff0000u) + b0[3]);
                    g1[0] = sigm(__uint_as_float(pg.z << 16) + b1[0]); g1[1] = sigm(__uint_as_float(pg.z & 0xffff0000u) + b1[1]);
                    g1[2] = sigm(__uint_as_float(pg.w << 16) + b1[2]); g1[3] = sigm(__uint_as_float(pg.w & 0xffff0000u) + b1[3]);
                    const f32x4 v0 = t0 + g0 * acc[ai][bj][m][0], v1 = t1 + g1 * acc[ai][bj][m][1];
                    v4u w; w.x = pg8::cvt_pk_bf16(v0[0], v0[1]); w.y = pg8::cvt_pk_bf16(v0[2], v0[3]); w.z = pg8::cvt_pk_bf16(v1[0], v1[1]); w.w = pg8::cvt_pk_bf16(v1[2], v1[3]);
                    *(v4u*)(MRG + r * D + c) = w; } }
    }
};
struct EpiResid {
    static constexpr bool PERM = true, AFTER_DRAIN = false;
    const float* X; bf16* O;
    __device__ __forceinline__ void operator()(const f32x4 (&acc)[2][2][4][2], const Unit& u, int wr, int wc, int fr, int fq) const {
        const int row0 = u.pm * BM + wr * 64 + fr, col0 = u.pn * BM + wc * 32 + 8 * fq;
#pragma unroll
        for (int ai = 0; ai < 2; ++ai)
#pragma unroll
            for (int m = 0; m < 4; ++m) { const size_t off = (size_t)(row0 + ai * HALF + m * 16) * D + col0;
#pragma unroll
                for (int bj = 0; bj < 2; ++bj) { const f32x4 v0 = *(const f32x4*)(X + off + bj * HALF) + acc[ai][bj][m][0], v1 = *(const f32x4*)(X + off + bj * HALF + 4) + acc[ai][bj][m][1];
                    v4u w; w.x = pk2(v0[0], v0[1]); w.y = pk2(v0[2], v0[3]); w.z = pk2(v1[0], v1[1]); w.w = pk2(v1[2], v1[3]);
                    *(v4u*)(O + off + bj * HALF) = w; } }
    }
};
struct MoeOrder : pg8::StaticOrder {
    const LAS int* tile_e; size_t estride;
    __device__ __forceinline__ size_t b_off(const Unit& u, size_t tstep) const { return (size_t)tile_e[u.pm] * estride + (size_t)u.pn * tstep; }
};
struct MoeGatherOrder : MoeOrder {
    static constexpr bool GATHER = true;
    const LAS int* tile_i0; const LAS int* cnt; const int* rlist; LAS unsigned* rowoff; unsigned rowbytes;
    __device__ __forceinline__ size_t a_off(const Unit&, size_t) const { return 0; }
    __device__ __forceinline__ void fill_all() const { const int tid = threadIdx.x, r = tid & 255;
        for (int u0 = tid >> 8; ; u0 += 6) { Unit ua, ub, uc; const bool va = next(u0, ua), vb = next(u0 + 2, ub), vc = next(u0 + 4, uc); if (!va) break;
            int ta = 0, tb = 0, tc = 0;
            { const int e = tile_e[ua.pm], i = tile_i0[ua.pm] + r; if (i < cnt[e]) ta = rlist[e * ECAP + i]; }
            if (vb) { const int e = tile_e[ub.pm], i = tile_i0[ub.pm] + r; if (i < cnt[e]) tb = rlist[e * ECAP + i]; }
            if (vc) { const int e = tile_e[uc.pm], i = tile_i0[uc.pm] + r; if (i < cnt[e]) tc = rlist[e * ECAP + i]; }
            rowoff[u0 * 256 + r] = (unsigned)(ta >> 2) * rowbytes; if (vb) rowoff[(u0 + 2) * 256 + r] = (unsigned)(tb >> 2) * rowbytes; if (vc) rowoff[(u0 + 4) * 256 + r] = (unsigned)(tc >> 2) * rowbytes; } }
    __device__ __forceinline__ unsigned row_off(int ui, int r) const { return rowoff[ui * 256 + r]; }
};
struct EpiSwiGLU {
    static constexpr bool PERM = true, AFTER_DRAIN = false;
    unsigned char* ACT; const float* bgu; const LAS int* tile_e;
    __device__ __forceinline__ void operator()(const f32x4 (&acc)[2][2][4][2], const Unit& u, int wr, int wc, int fr, int fq) const {
        const int row0 = u.pm * BM + wr * 64 + fr, colg = u.pn * 128 + wc * 32 + 8 * fq; const int e = tile_e[u.pm];
        const float* bp = bgu + (size_t)e * 4096 + colg;
        const f32x4 bg0 = *(const f32x4*)(bp), bg1 = *(const f32x4*)(bp + 4), bu0 = *(const f32x4*)(bp + 2048), bu1 = *(const f32x4*)(bp + 2052);
#pragma unroll
        for (int ai = 0; ai < 2; ++ai)
#pragma unroll
            for (int m = 0; m < 4; ++m) { const size_t r = (size_t)(row0 + ai * HALF + m * 16);
                constexpr float DS = 1.f / (F8_SX * F8_SW);
                const f32x4 ga = acc[ai][0][m][0] * DS + bg0, gb = acc[ai][0][m][1] * DS + bg1, ua = acc[ai][1][m][0] * DS + bu0, ub = acc[ai][1][m][1] * DS + bu1;
                float o[8];
#pragma unroll
                for (int j = 0; j < 4; ++j) { const float g = fminf(ga[j], 7.f), up = fminf(fmaxf(ua[j], -7.f), 7.f); o[j] = F8_SA * (up + 1.f) * g * sigm(1.702f * g);
                                              const float g2 = fminf(gb[j], 7.f), up2 = fminf(fmaxf(ub[j], -7.f), 7.f); o[4 + j] = F8_SA * (up2 + 1.f) * g2 * sigm(1.702f * g2); }
                v2u w; w.x = pk4f8(o[0], o[1], o[2], o[3]); w.y = pk4f8(o[4], o[5], o[6], o[7]);
                *(v2u*)(ACT + r * FF + colg) = w; }
    }
};
struct EpiDown {
    static constexpr bool PERM = true, AFTER_DRAIN = false;
    unsigned char* YS; const float* bdn; const LAS int* tile_e; const LAS int* rowdst; const LAS float* rowwt;
    __device__ __forceinline__ void operator()(const f32x4 (&acc)[2][2][4][2], const Unit& u, int wr, int wc, int fr, int fq) const {
        const int e = tile_e[u.pm]; const int col0 = u.pn * BM + wc * 32 + 8 * fq;
        const float* bp = bdn + (size_t)e * D + col0; constexpr float DS = 1.f / (F8_SA * F8_SW);
#pragma unroll
        for (int bj = 0; bj < 2; ++bj) { const f32x4 b0 = *(const f32x4*)(bp + bj * HALF), b1 = *(const f32x4*)(bp + bj * HALF + 4);
#pragma unroll
            for (int ai = 0; ai < 2; ++ai)
#pragma unroll
                for (int m = 0; m < 4; ++m) { const int r = u.ord * 256 + ai * HALF + wr * 64 + m * 16 + fr;
                    const int dst = rowdst[r]; const float w = rowwt[r];
                    const f32x4 v0 = (acc[ai][bj][m][0] * DS + b0) * (w * F8_SY), v1 = (acc[ai][bj][m][1] * DS + b1) * (w * F8_SY);
                    v2u o; o.x = pk4f8(v0[0], v0[1], v0[2], v0[3]); o.y = pk4f8(v1[0], v1[1], v1[2], v1[3]);
                    *(v2u*)(YS + (size_t)dst * D + col0 + bj * HALF) = o; } }
    }
};
template <class Sched> __device__ __forceinline__ void fill_down_tables(Frame& F, const Sched& S, LAS int* rowdst, LAS float* rowwt) {
    const LAS int* MI = (const LAS int*)F.MISC; const int* rlist = (const int*)(F.ws + WS_RLIST); const float* rw = (const float*)(F.ws + WS_RW);
    const int r = F.tid & 255;
    for (int u0 = F.tid >> 8; ; u0 += 4) { Unit ua, ub; const bool va = S.next(u0, ua), vb = S.next(u0 + 2, ub); if (!va) break;
        int da = T * 4, db = T * 4; float wa = 0.f, wb = 0.f;
        { const int e = MI[MI_TILE_E + ua.pm], i = MI[MI_TILE_I0 + ua.pm] + r; if (i < MI[MI_CNT + e]) { da = rlist[e * ECAP + i]; wa = rw[e * ECAP + i]; } }
        if (vb) { const int e = MI[MI_TILE_E + ub.pm], i = MI[MI_TILE_I0 + ub.pm] + r; if (i < MI[MI_CNT + e]) { db = rlist[e * ECAP + i]; wb = rw[e * ECAP + i]; } }
        rowdst[u0 * 256 + r] = da; rowwt[u0 * 256 + r] = wa; if (vb) { rowdst[(u0 + 2) * 256 + r] = db; rowwt[(u0 + 2) * 256 + r] = wb; } }
    __syncthreads();
}

__device__ __forceinline__ void transpose_item(const float* __restrict__ W, int N, int k0, int n0, bf16* WT, int dst_row0, int ldk, LAS float* scr, int lane) {
    const int n = n0 + (lane & 31); const bool ok = n < N;
    float r[32];
#pragma unroll
    for (int i = 0; i < 32; ++i) { const int kk = 2 * i + (lane >> 5); r[i] = ok ? W[(size_t)(k0 + kk) * N + n] : 0.f; }
#pragma unroll
    for (int i = 0; i < 32; ++i) { const int kk = 2 * i + (lane >> 5); scr[kk * 33 + (lane & 31)] = r[i]; }
    LDS_WAIT(); asm volatile("" ::: "memory");
    const int c = lane & 7;
#pragma unroll
    for (int j = 0; j < 4; ++j) { const int nn = (lane >> 3) + 8 * j; const LAS float* s = scr + (8 * c) * 33 + nn;
        v4u o; o.x = pk2(s[0 * 33], s[1 * 33]); o.y = pk2(s[2 * 33], s[3 * 33]); o.z = pk2(s[4 * 33], s[5 * 33]); o.w = pk2(s[6 * 33], s[7 * 33]);
        *(v4u*)(WT + (size_t)(dst_row0 + nn) * ldk + k0 + 8 * c) = o; }
    LDS_WAIT(); asm volatile("" ::: "memory");
}
__device__ __forceinline__ void transpose_item_i8(const float* __restrict__ W, int N, int k0, int n0, unsigned char* WT, int dst_row0, int ldk, const unsigned* colmax, LAS float* scr, int lane) {
    const int n = n0 + (lane & 31); const bool ok = n < N;
    float r[32];
#pragma unroll
    for (int i = 0; i < 32; ++i) { const int kk = 2 * i + (lane >> 5); r[i] = ok ? W[(size_t)(k0 + kk) * N + n] : 0.f; }
#pragma unroll
    for (int i = 0; i < 32; ++i) { const int kk = 2 * i + (lane >> 5); scr[kk * 33 + (lane & 31)] = r[i]; }
    LDS_WAIT(); asm volatile("" ::: "memory");
#pragma unroll
    for (int j = 0; j < 2; ++j) { const int ch = lane + 64 * j, nn = ch >> 2, c = ch & 3; const LAS float* s = scr + (16 * c) * 33 + nn;
        const float cm = __uint_as_float(colmax[n0 + nn]); const float sc = cm > 0.f ? 127.f / cm : 0.f;
        v4u o; o.x = pk4i8(s[0 * 33] * sc, s[1 * 33] * sc, s[2 * 33] * sc, s[3 * 33] * sc); o.y = pk4i8(s[4 * 33] * sc, s[5 * 33] * sc, s[6 * 33] * sc, s[7 * 33] * sc);
        o.z = pk4i8(s[8 * 33] * sc, s[9 * 33] * sc, s[10 * 33] * sc, s[11 * 33] * sc); o.w = pk4i8(s[12 * 33] * sc, s[13 * 33] * sc, s[14 * 33] * sc, s[15 * 33] * sc);
        *(v4u*)(WT + (size_t)(dst_row0 + nn) * ldk + k0 + 16 * c) = o; }
    LDS_WAIT(); asm volatile("" ::: "memory");
}
__device__ __forceinline__ void p0b_win(Frame& F) {
    LAS float* scr = (LAS float*)(F.lds + F.wave * 16384);
    const int gw = F.bid * NWAVES + F.wave, NGW = F.G * NWAVES; unsigned char* WIN8 = F.ws + WS_WIN; const unsigned* colmax = F.ctl + CW_COLMAX;
    constexpr int NB_WIN = (NIN + 31) / 32;
    for (int it = gw; it < 32 * NB_WIN; it += NGW) { const int kb = it / NB_WIN, nb = it % NB_WIN; transpose_item_i8(F.in[I_WIN], NIN, kb * 64, nb * 32, WIN8, nb * 32, D, colmax, scr, F.lane); }
    { const int gt = F.bid * NTHR + F.tid, NGT = F.G * NTHR; constexpr int Z0 = NB_WIN * 32 * D, Z1 = NINP * D;
      for (int i = Z0 + gt * 16; i < Z1; i += NGT * 16) *(v4u*)(WIN8 + i) = (v4u){0u, 0u, 0u, 0u}; }
}
__device__ __forceinline__ void p0_prologue(Frame& F) {
    LAS float* scr = (LAS float*)(F.lds + F.wave * 16384);
    const int gw = F.bid * NWAVES + F.wave, NGW = F.G * NWAVES;
    bf16* WIN_T = (bf16*)(F.ws + WS_WIN); bf16* WA_T = (bf16*)(F.ws + WS_WA); bf16* WB_T = (bf16*)(F.ws + WS_WB); bf16* WO_T = (bf16*)(F.ws + WS_WO);
    bf16* WGU_T = (bf16*)(F.ws + WS_WGU); bf16* WDN_T = (bf16*)(F.ws + WS_WDN); bf16* WL_T = (bf16*)(F.ws + WS_WL); bf16* HN = (bf16*)(F.ws + WS_HN);
    { const float* W = F.in[I_WIN]; unsigned* colmax = F.ctl + CW_COLMAX;
      for (int task = gw; task < 168 * 16; task += NGW) { const int cb = task % 168, kc = task / 168, n = cb * 64 + F.lane; float m = 0.f;
          if (n < NIN) { const float* wp = W + (size_t)(kc * 128) * NIN + n;
#pragma unroll 1
              for (int k0 = 0; k0 < 128; k0 += 32) { float v[32];
#pragma unroll
                  for (int i = 0; i < 32; ++i) v[i] = wp[(size_t)(k0 + i) * NIN];
#pragma unroll
                  for (int i = 0; i < 32; ++i) m = fmaxf(m, fabsf(v[i])); }
              atomicMax(colmax + n, __float_as_uint(m)); } } }
    { const int gt = F.bid * NTHR + F.tid, NGT = F.G * NTHR;
      for (int i = gt; i < 3072 * 512; i += NGT) { const int n = i >> 9, k = i & 511; float v = 0.f;
          if (n < 1024) { if (k < 96) v = F.in[I_WUP][k * RD + n]; }
          else if (n < 2048) { if (k >= 128 && k < 224) v = F.in[I_AUP][(k - 128) * RD + (n - 1024)]; }
          else { if (k >= 256) v = F.in[I_GUP][(k - 256) * RD + (n - 2048)]; }
          WL_T[i] = (bf16)f2bf(v); } }
    { const int gt = F.bid * NTHR + F.tid, NGT = F.G * NTHR; float* RWS = (float*)(F.ws + WS_RWS);
      for (int i = gt; i < D * NE; i += NGT) RWS[i] = F.in[I_N2W][i >> 5] * F.in[I_RTW][i]; }
    const float* x = F.in[I_X]; const float* nw = F.in[I_N1W];
    f32x4 nv[8];
    if (gw < T) { const f32x4* xr = (const f32x4*)(x + (size_t)gw * D) + F.lane;
#pragma unroll
        for (int j = 0; j < 8; ++j) nv[j] = xr[64 * j]; }
    for (int m = gw; m < T; m += NGW) {
        f32x4 v[8]; float s = 0.f;
#pragma unroll
        for (int j = 0; j < 8; ++j) v[j] = nv[j];
        if (m + NGW < T) { const f32x4* xr = (const f32x4*)(x + (size_t)(m + NGW) * D) + F.lane;
#pragma unroll
            for (int j = 0; j < 8; ++j) nv[j] = xr[64 * j]; }
#pragma unroll
        for (int j = 0; j < 8; ++j) s += (v[j][0] * v[j][0] + v[j][1] * v[j][1]) + (v[j][2] * v[j][2] + v[j][3] * v[j][3]);
        const float rstd = __builtin_amdgcn_rsqf(wave_sum(s) * (1.f / D) + NORM_EPS);
        float am = 0.f;
#pragma unroll
        for (int j = 0; j < 8; ++j) { const f32x4 w = ((const f32x4*)nw)[F.lane + 64 * j]; v[j] = v[j] * rstd * w; am = fmaxf(fmaxf(am, fmaxf(fabsf(v[j][0]), fabsf(v[j][1]))), fmaxf(fabsf(v[j][2]), fabsf(v[j][3]))); }
        am = wave_max(am); const float sc = am > 0.f ? 127.f / am : 0.f;
        if (F.lane == 0) ((float*)(F.ws + WS_RA))[m] = am * (1.f / 127.f);
        unsigned* o4 = (unsigned*)((unsigned char*)HN + (size_t)m * D) + F.lane;
#pragma unroll
        for (int j = 0; j < 8; ++j) o4[64 * j] = pk4i8(v[j][0] * sc, v[j][1] * sc, v[j][2] * sc, v[j][3] * sc);
    }
}

__device__ __forceinline__ void p2_lora_in(Frame& F) {
    const bf16* __restrict__ P = (const bf16*)(F.ws + WS_P); bf16* __restrict__ LIN = (bf16*)(F.ws + WS_LIN); const float* __restrict__ mu = F.in[I_MU];
    const int gt = F.bid * NTHR + F.tid, NGT = F.G * NTHR;
    for (int i = gt; i < T * 64; i += 2 * NGT) { const int g = i & 63; int col = -1, kind = 0;
        if (g < 12) { col = 3072 + 8 * g; kind = 0; } else if (g >= 16 && g < 28) { col = 3168 + 8 * (g - 16); kind = 1; } else if (g >= 32) { col = 3264 + 8 * (g - 32); kind = 2; }
        const int ce = col >= 0 ? col : 3072;
        v4u pc[2], pp[2];
#pragma unroll
        for (int u = 0; u < 2; ++u) { const int ii = i + u * NGT < T * 64 ? i + u * NGT : i; const int t = ii >> 6; pc[u] = *(const v4u*)(P + (size_t)t * NINP + ce); pp[u] = *(const v4u*)(P + (size_t)((t & (SEQ - 1)) ? t - 1 : t) * NINP + ce); }
        const f32x4 m0 = *(const f32x4*)(mu + ce), m1 = *(const f32x4*)(mu + ce + 4);
#pragma unroll
        for (int u = 0; u < 2; ++u) { const int ii = i + u * NGT; if (ii < T * 64) { const int t = ii >> 6; v4u o = (v4u){0u, 0u, 0u, 0u};
            if (col >= 0) { const float pm = (t & (SEQ - 1)) ? 1.f : 0.f;
                const unsigned pcs[4] = {pc[u].x, pc[u].y, pc[u].z, pc[u].w}, pps[4] = {pp[u].x, pp[u].y, pp[u].z, pp[u].w}; float x[8];
#pragma unroll
                for (int k = 0; k < 4; ++k) { const float c0 = __uint_as_float(pcs[k] << 16), c1 = __uint_as_float(pcs[k] & 0xffff0000u), q0 = pm * __uint_as_float(pps[k] << 16), q1 = pm * __uint_as_float(pps[k] & 0xffff0000u);
                    const float ma = k < 2 ? m0[2 * k] : m1[2 * k - 4], mb = k < 2 ? m0[2 * k + 1] : m1[2 * k - 3];
                    x[2 * k] = c0 + (q0 - c0) * ma; x[2 * k + 1] = c1 + (q1 - c1) * mb; }
#pragma unroll
                for (int k = 0; k < 8; ++k) x[k] = kind == 0 ? tanhf(x[k]) : (kind == 1 ? x[k] : sigm(x[k]));
                o.x = pk2(x[0], x[1]); o.y = pk2(x[2], x[3]); o.z = pk2(x[4], x[5]); o.w = pk2(x[6], x[7]); }
            *(v4u*)(LIN + (size_t)t * 512 + 8 * g) = o; } } }
    { bf16* __restrict__ QKC = (bf16*)(F.ws + WS_QKC); const float* __restrict__ cw = F.in[I_CONVW];
      for (int i = gt; i < T * 128; i += 2 * NGT) { v4u pv[2][4]; f32x4 w0[4], w1[4]; const int c0 = 8 * (i & 127);
#pragma unroll
          for (int u = 0; u < 2; ++u) { const int ii = i + u * NGT < T * 128 ? i + u * NGT : i; const int t = ii >> 7, sq = t & (SEQ - 1);
#pragma unroll
              for (int j = 0; j < 4; ++j) { const int tj = sq - 3 + j >= 0 ? t - 3 + j : t; pv[u][j] = *(const v4u*)(P + (size_t)tj * NINP + MLO + c0); } }
#pragma unroll
          for (int j = 0; j < 4; ++j) { w0[j] = *(const f32x4*)(cw + j * 1024 + c0); w1[j] = *(const f32x4*)(cw + j * 1024 + c0 + 4); }
          const float sc = c0 < 512 ? 0.08838834764831845f : 1.f;
#pragma unroll
          for (int u = 0; u < 2; ++u) { const int ii = i + u * NGT; if (ii < T * 128) { const int t = ii >> 7, sq = t & (SEQ - 1); float acc[8];
#pragma unroll
              for (int k = 0; k < 8; ++k) acc[k] = 0.f;
#pragma unroll
              for (int j = 0; j < 4; ++j) { const float m = sq - 3 + j >= 0 ? 1.f : 0.f; const v4u q = pv[u][j]; const f32x4 a0 = w0[j] * m, a1 = w1[j] * m;
                  acc[0] += __uint_as_float(q.x << 16) * a0[0]; acc[1] += __uint_as_float(q.x & 0xffff0000u) * a0[1]; acc[2] += __uint_as_float(q.y << 16) * a0[2]; acc[3] += __uint_as_float(q.y & 0xffff0000u) * a0[3];
                  acc[4] += __uint_as_float(q.z << 16) * a1[0]; acc[5] += __uint_as_float(q.z & 0xffff0000u) * a1[1]; acc[6] += __uint_as_float(q.w << 16) * a1[2]; acc[7] += __uint_as_float(q.w & 0xffff0000u) * a1[3]; }
#pragma unroll
              for (int k = 0; k < 8; ++k) acc[k] = acc[k] * sigm(acc[k]) * sc;
              v4u o; o.x = pk2(acc[0], acc[1]); o.y = pk2(acc[2], acc[3]); o.z = pk2(acc[4], acc[5]); o.w = pk2(acc[6], acc[7]); *(v4u*)(QKC + (size_t)t * 1024 + c0) = o; } } } }
    { float* __restrict__ GLF = (float*)(F.ws + WS_GLF); const int gw = F.bid * NWAVES + F.wave, NGW = F.G * NWAVES, lane = F.lane;
      for (int q = gw; q < (T / 64) * 4; q += NGW) { const int chk = q >> 2, mh = q & 3; const size_t t = (size_t)chk * 64 + lane; const bf16* pr = P + t * NINP + MLO + 2048;
          const float ip = 15.f * tanhf((bf2f(pr[mh]) + F.in[I_IB][mh]) * (1.f / 15.f)), fp = 15.f * tanhf((bf2f(pr[4 + mh]) + F.in[I_FB][mh]) * (1.f / 15.f));
          float bc = fminf(fp, 0.f) - log1pf(__expf(-fabsf(fp)));
#pragma unroll
          for (int o = 1; o < 64; o <<= 1) { const float t_ = __shfl_up(bc, o); if (lane >= o) bc += t_; }
          const float u = ip - bc; float pm = u;
#pragma unroll
          for (int o = 1; o < 64; o <<= 1) { const float t_ = __shfl_up(pm, o); if (lane >= o) pm = fmaxf(pm, t_); }
          *(f32x4*)(GLF + t * 16 + 4 * mh) = (f32x4){bc, u, pm, 0.f}; } }
}

typedef short s16x8 __attribute__((ext_vector_type(8)));
typedef short s16x4 __attribute__((ext_vector_type(4)));
__device__ __forceinline__ unsigned long long pack4bf(f32x4 v) { return (unsigned long long)pk2(v[0], v[1]) | ((unsigned long long)pk2(v[2], v[3]) << 32); }
__device__ __forceinline__ s16x8 tr_frag(const LAS bf16* img, int stride, int r0, int c0, int fr) {
    const LAS bf16* p0 = img + (r0 + (fr >> 2)) * stride + c0 + 4 * (fr & 3);
    const s16x4 lo = __builtin_bit_cast(s16x4, __builtin_amdgcn_ds_read_tr16_b64_v4i16((LAS s16x4*)p0));
    const s16x4 hi = __builtin_bit_cast(s16x4, __builtin_amdgcn_ds_read_tr16_b64_v4i16((LAS s16x4*)(p0 + 4 * stride)));
    return __builtin_shufflevector(lo, hi, 0, 1, 2, 3, 4, 5, 6, 7);
}

__device__ __forceinline__ float scan32(float x) {
    x += dppf<0x111>(x); x += dppf<0x112>(x); x += dppf<0x114>(x); x += dppf<0x118>(x);
    x += __builtin_bit_cast(float, __builtin_amdgcn_update_dpp(0, __builtin_bit_cast(int, x), 0x142, 0xa, 0xf, false));
    return x; }
typedef float f32x16 __attribute__((ext_vector_type(16)));
__device__ __forceinline__ s16x8 accfrag(const f32x16& x, int s) { v4u p; p.x = pk2(x[8 * s], x[8 * s + 1]); p.y = pk2(x[8 * s + 2], x[8 * s + 3]); p.z = pk2(x[8 * s + 4], x[8 * s + 5]); p.w = pk2(x[8 * s + 6], x[8 * s + 7]); return __builtin_bit_cast(s16x8, p); }
#define MFMA32(a_, b_, c_) __builtin_amdgcn_mfma_f32_32x32x16_bf16((a_), (b_), (c_), 0, 0, 0)
__device__ __forceinline__ void rw_bar(LAS unsigned* cnt, unsigned& target, int lane);
__device__ __forceinline__ void rwkv_chunk_unit(Frame& F, int unit, LAS unsigned char* regB, LAS unsigned* bcnt, unsigned& btarget) {
    const int b = unit >> 5, h = (unit >> 1) & 15, half = unit & 1;
    const bf16* P = (const bf16*)(F.ws + WS_P); const float* WAG = (const float*)(F.ws + WS_WAG); const bf16* AGp = (const bf16*)(F.ws + WS_WAG + 64 * MiB); float* YRAW = (float*)(F.ws + WS_YRAW);
    constexpr int KS = 72, LS = 40;
    LAS bf16* At = (LAS bf16*)F.lds; LAS bf16* Bt = At + 32 * KS; LAS bf16* Kt = Bt + 32 * KS; LAS bf16* Rt = Kt + 32 * KS;
    LAS bf16* Vv = Rt + 32 * KS;
    LAS bf16* Sb = Vv + 32 * LS;
    LAS bf16* G2b = Sb + 32 * KS; LAS bf16* G3b = G2b + 32 * LS; LAS bf16* G4b = G3b + 32 * LS;
    LAS bf16* Pwb = G4b + 32 * LS;
    LAS bf16* Acb = Pwb + 2 * 32 * LS;
    LAS bf16* RHt = (LAS bf16*)regB;
    LAS bf16* Ubt = RHt + 32 * LS;
    LAS float* lwf = (LAS float*)(Ubt + 32 * LS);
    LAS float* csf = lwf + 2048;
    LAS float* gtf = csf + 2048;
    LAS float* glf = gtf + 256;
    const int tid = F.tid, lane = F.lane, w = F.wave, fr = lane & 15, fq = lane >> 4;
    const int ts = tid >> 4, cs = tid & 15, c0 = h * 64 + 4 * cs;
    const int sk = tid & 63, sq = tid >> 6;
    const f32x4 mu_r = *(const f32x4*)(F.in[I_MU] + c0), mu_k = *(const f32x4*)(F.in[I_MU] + 1024 + c0), mu_v = *(const f32x4*)(F.in[I_MU] + 2048 + c0);
    const f32x4 kkc = *(const f32x4*)(F.in[I_KK] + c0), kac = *(const f32x4*)(F.in[I_KA] + c0), rkc = *(const f32x4*)(F.in[I_RK] + c0);
    bf16* BON = (bf16*)(F.ws + WS_WAG + 128 * MiB);
    for (int i = tid; i < 32 * KS; i += 256) Sb[i] = 0;
    v2u cr[2], ck[2], cv[2], qr[2], qk[2], qv[2]; f32x4 a4[2], ws0, ws1;
#define RC_LOAD(ch) do { _Pragma("unroll") for (int p_ = 0; p_ < 2; ++p_) { const int t_ = (ch) * 32 + ts + 16 * p_; const size_t tk_ = (size_t)b * SEQ + t_; const bf16* pr_ = P + tk_ * NINP + c0; \
        cr[p_] = *(const v2u*)(pr_); ck[p_] = *(const v2u*)(pr_ + 1024); cv[p_] = *(const v2u*)(pr_ + 2048); \
        if (t_ > 0) { qr[p_] = *(const v2u*)(pr_ - NINP); qk[p_] = *(const v2u*)(pr_ - NINP + 1024); qv[p_] = *(const v2u*)(pr_ - NINP + 2048); } else { qr[p_] = (v2u){0u, 0u}; qk[p_] = qr[p_]; qv[p_] = qr[p_]; } \
        { const v2u ab_ = *(const v2u*)(AGp + tk_ * D + c0); a4[p_] = UNP4(ab_); } } \
        { const float* wr_ = WAG + ((size_t)b * SEQ + (ch) * 32 + (lane & 31)) * RD + h * 64 + 16 * w + 8 * (lane >> 5); ws0 = *(const f32x4*)wr_; ws1 = *(const f32x4*)(wr_ + 4); } } while (0)
    const int mi = w >> 1, nj = w & 1;
    f32x4 st[2]; st[0] = (f32x4){0.f, 0.f, 0.f, 0.f}; st[1] = st[0];
    RC_LOAD(0);
    rw_bar(bcnt, btarget, lane);
    for (int ch = 0; ch < SEQ / 32; ++ch) {
        f32x4 rr[2], kmod[2], vv[2], kkn[2], al[2];
#pragma unroll
        for (int p_ = 0; p_ < 2; ++p_) { const f32x4 pr4 = UNP4(cr[p_]), pk4 = UNP4(ck[p_]), pv4 = UNP4(cv[p_]), qr4 = UNP4(qr[p_]), qk4 = UNP4(qk[p_]), qv4 = UNP4(qv[p_]); al[p_] = a4[p_];
            rr[p_] = pr4 + (qr4 - pr4) * mu_r; const f32x4 k1 = pk4 + (qk4 - pk4) * mu_k; vv[p_] = pv4 + (qv4 - pv4) * mu_v;
            const f32x4 kkr = k1 * kkc; const float nrm = __builtin_amdgcn_rsqf(fmaxf(allreduce16((kkr[0] * kkr[0] + kkr[1] * kkr[1]) + (kkr[2] * kkr[2] + kkr[3] * kkr[3])), 1e-24f));
            kkn[p_] = kkr * nrm; kmod[p_] = k1 * (1.f + (al[p_] - 1.f) * kac);
            { const f32x4 rk_ = rr[p_] * kmod[p_] * rkc; const float dot = allreduce16((rk_[0] + rk_[1]) + (rk_[2] + rk_[3]));
              if ((cs >> 3) == half) *(unsigned long long*)(BON + ((size_t)b * SEQ + ch * 32 + ts + 16 * p_) * RD + c0) = pack4bf(vv[p_] * dot); }
            }
        { const int tq = lane & 31, hq = lane >> 5; f32x4 c0v, c1v;
#pragma unroll
          for (int j = 0; j < 4; ++j) { c0v[j] = scan32(ws0[j]); c1v[j] = scan32(ws1[j]); }
          *(LAS f32x4*)(csf + tq * 64 + 16 * w + 8 * hq) = c0v; *(LAS f32x4*)(csf + tq * 64 + 16 * w + 8 * hq + 4) = c1v; }
        if (ch + 1 < SEQ / 32) RC_LOAD(ch + 1);
        rw_bar(bcnt, btarget, lane);
#pragma unroll
        for (int p_ = 0; p_ < 2; ++p_) { const int t = ts + 16 * p_; const f32x4 cg = *(const LAS f32x4*)(csf + t * 64 + 4 * cs); f32x4 cgp = (f32x4){0.f, 0.f, 0.f, 0.f}; if (t > 0) cgp = *(const LAS f32x4*)(csf + (t - 1) * 64 + 4 * cs); f32x4 g, gp, gi;
#pragma unroll
          for (int j = 0; j < 4; ++j) { g[j] = __expf(cg[j]); gp[j] = __expf(cgp[j]); gi[j] = __expf(-cg[j]); }
          *(LAS unsigned long long*)(At + t * KS + 4 * cs) = pack4bf(-(kkn[p_] * gp)); *(LAS unsigned long long*)(Bt + t * KS + 4 * cs) = pack4bf(kkn[p_] * al[p_] * gi);
          *(LAS unsigned long long*)(Kt + t * KS + 4 * cs) = pack4bf(kmod[p_] * gi); *(LAS unsigned long long*)(Rt + t * KS + 4 * cs) = pack4bf(rr[p_] * g);
          if ((cs >> 3) == half) *(LAS unsigned long long*)(Vv + t * LS + 4 * (cs & 7)) = pack4bf(vv[p_]);
          if (t == 31) *(LAS f32x4*)(glf + 4 * cs) = g; }
        rw_bar(bcnt, btarget, lane);
        { const int t = 16 * mi + fr, jb = 16 * nj + 4 * fq;
          f32x4 g2 = (f32x4){0.f, 0.f, 0.f, 0.f}, g3 = g2, g4 = g2;
#pragma unroll
          for (int ks = 0; ks < 2; ++ks) { const s16x8 bj = *(const LAS s16x8*)(Bt + (16 * nj + fr) * KS + 32 * ks + 8 * fq), kj = *(const LAS s16x8*)(Kt + (16 * nj + fr) * KS + 32 * ks + 8 * fq);
              const s16x8 at = *(const LAS s16x8*)(At + (16 * mi + fr) * KS + 32 * ks + 8 * fq), rt = *(const LAS s16x8*)(Rt + (16 * mi + fr) * KS + 32 * ks + 8 * fq);
              g2 = __builtin_amdgcn_mfma_f32_16x16x32_bf16(kj, at, g2, 0, 0, 0); g3 = __builtin_amdgcn_mfma_f32_16x16x32_bf16(bj, rt, g3, 0, 0, 0); g4 = __builtin_amdgcn_mfma_f32_16x16x32_bf16(kj, rt, g4, 0, 0, 0); }
#pragma unroll
          for (int rg_ = 0; rg_ < 4; ++rg_) { const int j = jb + rg_; g2[rg_] = (j < t) ? g2[rg_] : 0.f; g3[rg_] = (j <= t) ? g3[rg_] : 0.f; g4[rg_] = (j <= t) ? g4[rg_] : 0.f; }
          *(LAS unsigned long long*)(G2b + t * LS + jb) = pack4bf(g2); *(LAS unsigned long long*)(G3b + t * LS + jb) = pack4bf(g3); *(LAS unsigned long long*)(G4b + t * LS + jb) = pack4bf(g4); }
        { const int tq = lane & 31, hq = lane >> 5;
          f32x16 Pm, Qm, Aq;
#pragma unroll
          for (int i = 0; i < 16; ++i) { Pm[i] = 0.f; Qm[i] = 0.f; }
#pragma unroll
          for (int s = 0; s < 4; ++s) { const s16x8 fa = *(const LAS s16x8*)(At + tq * KS + 16 * s + 8 * hq), fb = *(const LAS s16x8*)(Bt + tq * KS + 16 * s + 8 * hq);
              Pm = MFMA32(fa, fb, Pm); Qm = MFMA32(fb, fa, Qm); }
#pragma unroll
          for (int i = 0; i < 16; ++i) { const int r_ = (i & 3) + 8 * (i >> 2) + 4 * hq;
              Pm[i] = (tq < r_) ? Pm[i] : 0.f;
              Qm[i] = (r_ < tq) ? Qm[i] : 0.f;
              Aq[i] = Qm[i] + ((r_ == tq) ? 1.f : 0.f); }
#pragma unroll
          for (int st = 1; st <= 4; ++st) { const s16x8 p0 = accfrag(Pm, 0), p1 = accfrag(Pm, 1), q0 = accfrag(Qm, 0), q1 = accfrag(Qm, 1);
              f32x16 nP, nQ;
#pragma unroll
              for (int i = 0; i < 16; ++i) { nP[i] = 0.f; nQ[i] = 0.f; }
              nP = MFMA32(q0, p0, nP); nP = MFMA32(q1, p1, nP);
              if (st < 4) { nQ = MFMA32(p0, q0, nQ); nQ = MFMA32(p1, q1, nQ); }
              Pm = nP; Qm = nQ;
              const s16x8 n0 = accfrag(Pm, 0), n1 = accfrag(Pm, 1), a0 = accfrag(Aq, 0), a1 = accfrag(Aq, 1);
              Aq = MFMA32(n0, a0, Aq); Aq = MFMA32(n1, a1, Aq); }
          f32x4 tv; tv[0] = w == 0 ? Aq[0] : w == 1 ? Aq[4] : w == 2 ? Aq[8] : Aq[12]; tv[1] = w == 0 ? Aq[1] : w == 1 ? Aq[5] : w == 2 ? Aq[9] : Aq[13];
          tv[2] = w == 0 ? Aq[2] : w == 1 ? Aq[6] : w == 2 ? Aq[10] : Aq[14]; tv[3] = w == 0 ? Aq[3] : w == 1 ? Aq[7] : w == 2 ? Aq[11] : Aq[15];
          *(LAS unsigned long long*)(Acb + 32 * LS + tq * LS + 8 * w + 4 * hq) = pack4bf(tv); }
        rw_bar(bcnt, btarget, lane);
        f32x4 yv = (f32x4){0.f, 0.f, 0.f, 0.f};
        { f32x4 z = (f32x4){0.f, 0.f, 0.f, 0.f};
#pragma unroll
          for (int ks = 0; ks < 2; ++ks) { const s16x8 sb = *(const LAS s16x8*)(Sb + (16 * nj + fr) * KS + 32 * ks + 8 * fq);
              z = __builtin_amdgcn_mfma_f32_16x16x32_bf16(*(const LAS s16x8*)(At + (16 * mi + fr) * KS + 32 * ks + 8 * fq), sb, z, 0, 0, 0);
              yv = __builtin_amdgcn_mfma_f32_16x16x32_bf16(*(const LAS s16x8*)(Rt + (16 * mi + fr) * KS + 32 * ks + 8 * fq), sb, yv, 0, 0, 0); }
          const s16x8 vt_ = tr_frag(Vv, LS, 8 * fq, 16 * nj, fr);
          z = __builtin_amdgcn_mfma_f32_16x16x32_bf16(*(const LAS s16x8*)(G2b + (16 * mi + fr) * LS + 8 * fq), vt_, z, 0, 0, 0);
          yv = __builtin_amdgcn_mfma_f32_16x16x32_bf16(*(const LAS s16x8*)(G4b + (16 * mi + fr) * LS + 8 * fq), vt_, yv, 0, 0, 0);
          *(LAS unsigned long long*)(RHt + (16 * nj + fr) * LS + 16 * mi + 4 * fq) = pack4bf(z); }
        rw_bar(bcnt, btarget, lane);
        { f32x4 z = (f32x4){0.f, 0.f, 0.f, 0.f};
          z = __builtin_amdgcn_mfma_f32_16x16x32_bf16(*(const LAS s16x8*)(Acb + 32 * LS + (16 * mi + fr) * LS + 8 * fq), *(const LAS s16x8*)(RHt + (16 * nj + fr) * LS + 8 * fq), z, 0, 0, 0);
          *(LAS unsigned long long*)(Ubt + (16 * nj + fr) * LS + 16 * mi + 4 * fq) = pack4bf(z); }
        rw_bar(bcnt, btarget, lane);
        { yv = __builtin_amdgcn_mfma_f32_16x16x32_bf16(*(const LAS s16x8*)(G3b + (16 * mi + fr) * LS + 8 * fq), *(const LAS s16x8*)(Ubt + (16 * nj + fr) * LS + 8 * fq), yv, 0, 0, 0);
          float* yp = YRAW + ((size_t)b * SEQ + ch * 32 + 16 * mi + 4 * fq) * RD + h * 64 + half * 32 + 16 * nj + fr;
#pragma unroll
          for (int rg_ = 0; rg_ < 4; ++rg_) yp[(size_t)rg_ * RD] = yv[rg_]; }
        { const int kt = w; const s16x8 bt_ = tr_frag(Bt, KS, 8 * fq, 16 * kt, fr), kt_ = tr_frag(Kt, KS, 8 * fq, 16 * kt, fr); const f32x4 gl4 = *(const LAS f32x4*)(glf + 16 * kt + 4 * fq);
#pragma unroll
          for (int vt = 0; vt < 2; ++vt) {
              st[vt] = __builtin_amdgcn_mfma_f32_16x16x32_bf16(bt_, *(const LAS s16x8*)(Ubt + (16 * vt + fr) * LS + 8 * fq), st[vt], 0, 0, 0);
              st[vt] = __builtin_amdgcn_mfma_f32_16x16x32_bf16(kt_, tr_frag(Vv, LS, 8 * fq, 16 * vt, fr), st[vt], 0, 0, 0);
              st[vt] = st[vt] * gl4;
              *(LAS unsigned long long*)(Sb + (16 * vt + fr) * KS + 16 * kt + 4 * fq) = pack4bf(st[vt]); } }
    }
#undef RC_LOAD
}

__device__ __forceinline__ float allreduce8(float x) { x += dppf<0x141>(x); x += dppf<0xB1>(x); x += dppf<0x4E>(x); return x; }
__device__ __forceinline__ void rw_bar(LAS unsigned* cnt, unsigned& target, int lane) {
    asm volatile("s_waitcnt lgkmcnt(0)" ::: "memory");
    if (lane == 0) __hip_atomic_fetch_add(cnt, 1u, __ATOMIC_RELAXED, __HIP_MEMORY_SCOPE_WORKGROUP);
    target += 4u;
    while ((unsigned)__builtin_amdgcn_readfirstlane((int)__hip_atomic_load(cnt, __ATOMIC_RELAXED, __HIP_MEMORY_SCOPE_WORKGROUP)) < target) __builtin_amdgcn_s_sleep(1);
    asm volatile("" ::: "memory");
}
constexpr int CV_BR = 8 * 32, CV_WO = 16 * 32, CV_GU = NE * 16 * 64, CV_DN = NE * 16 * 32, CV_ITEMS = 2 * CV_BR + CV_WO + CV_GU + CV_DN;
constexpr int CV_SPLIT = CV_ITEMS - 0;
constexpr int P5_NW = 8;
struct CvItem { const float* src; unsigned char* dst; int N; int f8; };
__device__ __forceinline__ CvItem cv_decode(Frame& F, int it) {
    CvItem c; int r = it; const int lane = F.lane;
    if (r < CV_BR) { const int kb = r >> 5, nb = r & 31; c.src = F.in[I_WBA] + (size_t)(kb * 128) * D + nb * 64 + lane; c.dst = F.ws + WS_WA + ((size_t)(nb * 64 + lane) * RD + kb * 128) * 2; c.N = D; c.f8 = 0; return c; } r -= CV_BR;
    if (r < CV_BR) { const int kb = r >> 5, nb = r & 31; c.src = F.in[I_WBB] + (size_t)(kb * 128) * D + nb * 64 + lane; c.dst = F.ws + WS_WB + ((size_t)(nb * 64 + lane) * RD + kb * 128) * 2; c.N = D; c.f8 = 0; return c; } r -= CV_BR;
    if (r < CV_WO) { const int kb = r >> 5, nb = r & 31; c.src = F.in[I_WOUT] + (size_t)(kb * 128) * D + nb * 64 + lane; c.dst = F.ws + WS_WO + ((size_t)(nb * 64 + lane) * D + kb * 128) * 2; c.N = D; c.f8 = 0; return c; } r -= CV_WO;
    if (r < CV_GU) { const int e = r >> 10, q = r & 1023, kb = q >> 6, nb = q & 63, n0 = nb * 64;
        const int dr = n0 < FF ? ((n0 >> 7) * 256 + (n0 & 127)) : (((n0 - FF) >> 7) * 256 + 128 + ((n0 - FF) & 127));
        c.src = F.in[I_WGU] + (size_t)e * D * 2 * FF + (size_t)(kb * 128) * (2 * FF) + n0 + lane; c.dst = F.ws + WS_WGU + (size_t)e * 2 * FF * D + (size_t)(dr + lane) * D + kb * 128; c.N = 2 * FF; c.f8 = 1; return c; } r -= CV_GU;
    { const int e = r >> 9, q = r & 511, kb = q >> 5, nb = q & 31;
        c.src = F.in[I_WDN] + (size_t)e * FF * D + (size_t)(kb * 128) * D + nb * 64 + lane; c.dst = F.ws + WS_WDN + (size_t)e * D * FF + (size_t)(nb * 64 + lane) * FF + kb * 128; c.N = D; c.f8 = 1; }
    return c;
}
__device__ __forceinline__ void convert_item(Frame& F, int it, LAS unsigned char* cvbuf);
__device__ __forceinline__ void convert_loop(Frame& F, unsigned* next, unsigned* p1done, unsigned ngemm, LAS unsigned char* cvbuf, unsigned lo, unsigned hi) {
#define CV_CLAIM(b_) do { b_ = 0xffffffffu; if (F.lane == 0) { if (!(p1done && __hip_atomic_load(p1done, __ATOMIC_RELAXED, __HIP_MEMORY_SCOPE_AGENT) >= ngemm)) b_ = __hip_atomic_fetch_add(next, 2u, __ATOMIC_RELAXED, __HIP_MEMORY_SCOPE_AGENT); } } while (0)
    unsigned nb; CV_CLAIM(nb);
    for (;;) { const unsigned b0 = (unsigned)__builtin_amdgcn_readfirstlane((int)nb); if (b0 >= hi - lo) break;
        const unsigned base = b0 + lo;
        if (!p1done) CV_CLAIM(nb);
        for (int k = 0; k < 2; ++k) { const unsigned it = base + k; if (it < hi) convert_item(F, (int)it, cvbuf); }
        if (p1done) CV_CLAIM(nb); }
#undef CV_CLAIM
}
__device__ __forceinline__ void convert_item(Frame& F, int i0, LAS unsigned char* cvbuf) {
    { const CvItem c = cv_decode(F, i0);
        float x[128];
#pragma unroll
        for (int i = 0; i < 128; ++i) x[i] = c.src[(size_t)i * c.N];
        if (c.f8) {
            const int lane = F.lane; LAS unsigned char* bw = cvbuf + lane * 144;
#pragma unroll
            for (int q = 0; q < 8; ++q) { v4u o; o.x = pk4f8(x[16 * q + 0] * F8_SW, x[16 * q + 1] * F8_SW, x[16 * q + 2] * F8_SW, x[16 * q + 3] * F8_SW); o.y = pk4f8(x[16 * q + 4] * F8_SW, x[16 * q + 5] * F8_SW, x[16 * q + 6] * F8_SW, x[16 * q + 7] * F8_SW);
                o.z = pk4f8(x[16 * q + 8] * F8_SW, x[16 * q + 9] * F8_SW, x[16 * q + 10] * F8_SW, x[16 * q + 11] * F8_SW); o.w = pk4f8(x[16 * q + 12] * F8_SW, x[16 * q + 13] * F8_SW, x[16 * q + 14] * F8_SW, x[16 * q + 15] * F8_SW);
                *(LAS v4u*)(bw + 16 * q) = o; }
            unsigned char* d0 = c.dst - (size_t)lane * 2048 + (size_t)(lane >> 3) * 2048 + (lane & 7) * 16; const LAS unsigned char* br = cvbuf + (lane >> 3) * 144 + (lane & 7) * 16;
#pragma unroll
            for (int i = 0; i < 8; ++i) { const v4u v = *(const LAS v4u*)(br + i * 8 * 144); *(v4u*)(d0 + (size_t)i * 8 * 2048) = v; } }
        else {
#pragma unroll
            for (int q = 0; q < 16; ++q) { v4u o; o.x = pk2(x[8 * q + 0], x[8 * q + 1]); o.y = pk2(x[8 * q + 2], x[8 * q + 3]); o.z = pk2(x[8 * q + 4], x[8 * q + 5]); o.w = pk2(x[8 * q + 6], x[8 * q + 7]);
                *(v4u*)(c.dst + 16 * q) = o; } } }
}

__device__ __forceinline__ void mlstm_scan_unit(Frame& F, int unit, LAS unsigned* bcnt, unsigned& btarget) {
    const int b = unit >> 5, mh = (unit >> 3) & 3, sl = unit & 7;
    const bf16* P = (const bf16*)(F.ws + WS_P); const bf16* QKC = (const bf16*)(F.ws + WS_QKC); const float* GLF = (const float*)(F.ws + WS_GLF); float* HRAW = (float*)(F.ws + WS_HRAW);
    constexpr int VS = 56;
    LAS bf16* Lq = (LAS bf16*)F.lds;
    LAS bf16* Lk = Lq + 64 * 136;
    LAS bf16* Lv = Lk + 64 * 136;
    LAS bf16* Lvs = Lv + 64 * VS;
    LAS bf16* LcT = Lvs + 64 * VS;
    LAS bf16* Ls = LcT + 2 * 48 * 136;
    LAS float* sb = (LAS float*)(Ls + 64 * 72); LAS float* su = sb + 64; LAS float* smx = su + 64; LAS float* swk = smx + 64;
    const int tid = F.tid, lane = F.lane, w = F.wave, fr = lane & 15, fq = lane >> 4;
    for (int i = tid; i < 2 * 48 * 136; i += 256) LcT[i] = 0;
    for (int i = tid; i < 64 * 16; i += 256) { const int j = i >> 4, c = 32 + (i & 15); Lv[j * VS + c] = (c == 32) ? (bf16)0x3F80 : (bf16)0; Lvs[j * VS + c] = 0; }
    const int pr0 = tid >> 4, pc = 8 * (tid & 15);
    v4u rq[4], rk[4], rv; f32x4 g3;
#define ML_LOAD(ch) do { const size_t tk0_ = (size_t)b * SEQ + (ch) * 64; \
        _Pragma("unroll") for (int i_ = 0; i_ < 4; ++i_) { const bf16* s_ = QKC + (tk0_ + pr0 + 16 * i_) * 1024 + mh * 128 + pc; rq[i_] = *(const v4u*)s_; rk[i_] = *(const v4u*)(s_ + 512); } \
        rv = *(const v4u*)(P + (tk0_ + (tid >> 2)) * NINP + MLO + 1024 + mh * 256 + sl * 32 + 8 * (tid & 3)); \
        g3 = *(const f32x4*)(GLF + (tk0_ + lane) * 16 + 4 * mh); } while (0)
    f32x4 st[2][3];
#pragma unroll
    for (int a = 0; a < 2; ++a)
#pragma unroll
        for (int n = 0; n < 3; ++n) st[a][n] = (f32x4){0.f, 0.f, 0.f, 0.f};
    float mstate = 0.f;
    ML_LOAD(0);
    rw_bar(bcnt, btarget, lane);
    for (int ch = 0; ch < SEQ / 64; ++ch) {
        const size_t tk0 = (size_t)b * SEQ + ch * 64;
        LAS bf16* cTc = LcT + (ch & 1) * 48 * 136; LAS bf16* cTn = LcT + ((ch + 1) & 1) * 48 * 136;
        float mnew, dec;
        { const float bc = g3[0], u = g3[1], pm = g3[2];
          const float gtot = __shfl(bc, 63), pmall = __shfl(pm, 63);
          mnew = gtot + fmaxf(mstate, pmall); dec = __expf(gtot + mstate - mnew);
          const float wk = __expf(u + gtot - mnew);
          sb[lane] = bc; su[lane] = u; smx[lane] = fmaxf(mstate, pm); swk[lane] = wk;
          if (w == 0) Lvs[lane * VS + 32] = (bf16)f2bf(wk); }
#pragma unroll
        for (int i = 0; i < 4; ++i) { *(LAS v4u*)(Lq + (pr0 + 16 * i) * 136 + pc) = rq[i]; *(LAS v4u*)(Lk + (pr0 + 16 * i) * 136 + pc) = rk[i]; }
        LDS_WAIT();
        { const int j = tid >> 2, d0 = 8 * (tid & 3); const float wkj = swk[j]; *(LAS v4u*)(Lv + j * VS + d0) = rv;
          const unsigned uu[4] = {rv.x, rv.y, rv.z, rv.w}; v4u sv;
          sv.x = pk2(wkj * __uint_as_float(uu[0] << 16), wkj * __uint_as_float(uu[0] & 0xffff0000u)); sv.y = pk2(wkj * __uint_as_float(uu[1] << 16), wkj * __uint_as_float(uu[1] & 0xffff0000u));
          sv.z = pk2(wkj * __uint_as_float(uu[2] << 16), wkj * __uint_as_float(uu[2] & 0xffff0000u)); sv.w = pk2(wkj * __uint_as_float(uu[3] << 16), wkj * __uint_as_float(uu[3] & 0xffff0000u));
          *(LAS v4u*)(Lvs + j * VS + d0) = sv; }
        if (ch + 1 < SEQ / 64) ML_LOAD(ch + 1);
        rw_bar(bcnt, btarget, lane);
        { const int tt = w; const int t = 16 * tt + fr; const float mxt = smx[t];
#pragma unroll
          for (int jt = 0; jt < 4; ++jt) { f32x4 acc = (f32x4){0.f, 0.f, 0.f, 0.f};
              if (jt <= tt) {
#pragma unroll
                  for (int ks = 0; ks < 4; ++ks) { const s16x8 a = *(const LAS s16x8*)(Lk + (16 * jt + fr) * 136 + 32 * ks + 8 * fq), bq = *(const LAS s16x8*)(Lq + (16 * tt + fr) * 136 + 32 * ks + 8 * fq);
                      acc = __builtin_amdgcn_mfma_f32_16x16x32_bf16(a, bq, acc, 0, 0, 0); }
                  const f32x4 u4 = *(const LAS f32x4*)(su + 16 * jt + 4 * fq);
#pragma unroll
                  for (int rg_ = 0; rg_ < 4; ++rg_) { const int j = 16 * jt + 4 * fq + rg_; acc[rg_] = (j <= t) ? acc[rg_] * __expf(u4[rg_] - mxt) : 0.f; } }
              *(LAS unsigned long long*)(Ls + t * 72 + 16 * jt + 4 * fq) = pack4bf(acc); } }
        rw_bar(bcnt, btarget, lane);
        { const int mi = w; f32x4 a1[3], a2[3];
#pragma unroll
          for (int n = 0; n < 3; ++n) { a1[n] = (f32x4){0.f, 0.f, 0.f, 0.f}; a2[n] = a1[n]; }
#pragma unroll
          for (int ks = 0; ks < 2; ++ks) { const s16x8 A = *(const LAS s16x8*)(Ls + (16 * mi + fr) * 72 + 32 * ks + 8 * fq);
#pragma unroll
              for (int n = 0; n < 3; ++n) a1[n] = __builtin_amdgcn_mfma_f32_16x16x32_bf16(A, tr_frag(Lv, VS, 32 * ks + 8 * fq, 16 * n, fr), a1[n], 0, 0, 0); }
#pragma unroll
          for (int ks = 0; ks < 4; ++ks) { const s16x8 A = *(const LAS s16x8*)(Lq + (16 * mi + fr) * 136 + 32 * ks + 8 * fq);
#pragma unroll
              for (int n = 0; n < 3; ++n) a2[n] = __builtin_amdgcn_mfma_f32_16x16x32_bf16(A, *(const LAS s16x8*)(cTc + (16 * n + fr) * 136 + 32 * ks + 8 * fq), a2[n], 0, 0, 0); }
          const f32x4 mx4 = *(const LAS f32x4*)(smx + 16 * mi + 4 * fq), b4 = *(const LAS f32x4*)(sb + 16 * mi + 4 * fq);
#pragma unroll
          for (int rg_ = 0; rg_ < 4; ++rg_) { const float wi = __expf(mstate - mx4[rg_]); float den = a1[2][rg_] + wi * a2[2][rg_]; den = __shfl(den, lane & 48);
              const float mt = b4[rg_] + mx4[rg_]; const float inv = __builtin_amdgcn_rcpf(fmaxf(fabsf(den), __expf(-mt))); float* hp = HRAW + (tk0 + 16 * mi + 4 * fq + rg_) * RD + mh * 256 + sl * 32 + fr;
              hp[0] = (a1[0][rg_] + wi * a2[0][rg_]) * inv; hp[16] = (a1[1][rg_] + wi * a2[1][rg_]) * inv; } }
        {
#pragma unroll
          for (int a = 0; a < 2; ++a) {
#pragma unroll
              for (int n = 0; n < 3; ++n) st[a][n] = st[a][n] * dec;
#pragma unroll
              for (int ks = 0; ks < 2; ++ks) { const s16x8 A = tr_frag(Lk, 136, 32 * ks + 8 * fq, 16 * (2 * w + a), fr);
#pragma unroll
                  for (int n = 0; n < 3; ++n) st[a][n] = __builtin_amdgcn_mfma_f32_16x16x32_bf16(A, tr_frag(Lvs, VS, 32 * ks + 8 * fq, 16 * n, fr), st[a][n], 0, 0, 0); }
#pragma unroll
              for (int n = 0; n < 3; ++n) *(LAS unsigned long long*)(cTn + (16 * n + fr) * 136 + 16 * (2 * w + a) + 4 * fq) = pack4bf(st[a][n]); } }
        mstate = mnew;
        rw_bar(bcnt, btarget, lane);
    }
#undef ML_LOAD
}

__device__ __forceinline__ float rowsum4(f32x4 v) { return (v[0] + v[1]) + (v[2] + v[3]); }
__device__ __forceinline__ void p5_finalize(Frame& F) {
    const bf16* __restrict__ P = (const bf16*)(F.ws + WS_P); const bf16* __restrict__ AGp = (const bf16*)(F.ws + WS_WAG + 64 * MiB); const float* __restrict__ YRAW = (const float*)(F.ws + WS_YRAW); const float* __restrict__ HRAW = (const float*)(F.ws + WS_HRAW);
    bf16* __restrict__ OA = (bf16*)(F.ws + WS_OA); bf16* __restrict__ OB = (bf16*)(F.ws + WS_OB);
    const int gw = F.bid * P5_NW + F.wave, NGW = F.G * P5_NW, lane = F.lane;
    { const int hq = gw & 3, c0 = (hq * 4 + (lane >> 4)) * 64 + 4 * (lane & 15);
      const f32x4 lnw = *(const f32x4*)(F.in[I_LNW] + c0), lnb = *(const f32x4*)(F.in[I_LNB] + c0); const bf16* __restrict__ BON = (const bf16*)(F.ws + WS_WAG + 128 * MiB);
      v2u bo[2], gb[2]; f32x4 y4[2];
#define P5_LOAD(i_, q_) do { if ((q_) < T * 4) { const int tk_ = (q_) >> 2; bo[i_] = *(const v2u*)(BON + (size_t)tk_ * RD + c0); gb[i_] = *(const v2u*)(AGp + (size_t)tk_ * D + RD + c0); y4[i_] = *(const f32x4*)(YRAW + (size_t)tk_ * RD + c0); } } while (0)
      P5_LOAD(0, gw); P5_LOAD(1, gw + NGW);
      for (int q = gw; q < T * 4; q += 2 * NGW) { const v2u cb0 = bo[0], cg0 = gb[0], cb1 = bo[1], cg1 = gb[1]; const f32x4 cy0 = y4[0], cy1 = y4[1];
          P5_LOAD(0, q + 2 * NGW); P5_LOAD(1, q + 3 * NGW);
#pragma unroll
          for (int i = 0; i < 2; ++i) { const int qq = q + i * NGW; if (qq < T * 4) { const int tk = qq >> 2; const f32x4 bon = i ? UNP4(cb1) : UNP4(cb0), g = i ? UNP4(cg1) : UNP4(cg0), y = i ? cy1 : cy0;
              const float mean = allreduce16(rowsum4(y)) * (1.f / 64.f); const f32x4 dl = y - mean;
              const float var = allreduce16(rowsum4(dl * dl)) * (1.f / 64.f); const float rs = __builtin_amdgcn_rsqf(var + GN_EPS);
              const f32x4 o = (dl * rs * lnw + lnb + bon) * g;
              v2u ov; ov.x = pk2(o[0], o[1]); ov.y = pk2(o[2], o[3]); *(v2u*)(OA + (size_t)tk * RD + c0) = ov; } } }
#undef P5_LOAD
    }
    { const int mh = gw & 3, d0 = mh * 256 + 4 * lane; const f32x4 nw = *(const f32x4*)(F.in[I_MNW] + d0);
      f32x4 hv[2]; v2u po[2];
#define P5B_LOAD(i_, q_) do { if ((q_) < T * 4) { const int tk_ = (q_) >> 2; hv[i_] = *(const f32x4*)(HRAW + (size_t)tk_ * RD + d0); po[i_] = *(const v2u*)(P + (size_t)tk_ * NINP + MLO + 2056 + d0); } } while (0)
      P5B_LOAD(0, gw); P5B_LOAD(1, gw + NGW);
      for (int q = gw; q < T * 4; q += 2 * NGW) { const f32x4 ch0 = hv[0], ch1 = hv[1]; const v2u cp0 = po[0], cp1 = po[1];
          P5B_LOAD(0, q + 2 * NGW); P5B_LOAD(1, q + 3 * NGW);
#pragma unroll
          for (int i = 0; i < 2; ++i) { const int qq = q + i * NGW; if (qq < T * 4) { const int tk = qq >> 2; const f32x4 h4 = i ? ch1 : ch0; const v2u p2 = i ? cp1 : cp0;
              float ss = allreduce16(rowsum4(h4 * h4)); ss += __shfl_xor(ss, 16); ss += __shfl_xor(ss, 32);
              const float rs = __builtin_amdgcn_rsqf(ss * (1.f / 256.f) + NORM_EPS); const f32x4 og = UNP4(p2);
              const float o0 = h4[0] * rs * nw[0] * sigm(og[0]), o1 = h4[1] * rs * nw[1] * sigm(og[1]), o2 = h4[2] * rs * nw[2] * sigm(og[2]), o3 = h4[3] * rs * nw[3] * sigm(og[3]);
              v2u o; o.x = pk2(o0, o1); o.y = pk2(o2, o3); *(v2u*)(OB + (size_t)tk * RD + d0) = o; } } }
#undef P5B_LOAD
    }
}

typedef float f32x16 __attribute__((ext_vector_type(16)));
__device__ __forceinline__ void p8_route(Frame& F) {
    const bf16* X1 = (const bf16*)(F.ws + WS_X1); unsigned char* H2 = (unsigned char*)(F.ws + WS_HN); int* RLIST = (int*)(F.ws + WS_RLIST); float* RWT = (float*)(F.ws + WS_RW);
    const float* RWS = (const float*)(F.ws + WS_RWS); const float* nw = F.in[I_N2W]; const float* rtb = F.in[I_RTB];
    LAS float* part = (LAS float*)F.lds;
    LAS float* ssq = part + 8 * 32 * 33;
    LAS float* lgt = ssq + 256;
    LAS float* srs = lgt + 32 * 33;
    const int lane = F.lane, w = F.wave, i = lane & 31, h = lane >> 5, tid = F.tid;
    for (int tile = F.bid; tile < T / 32; tile += F.G) {
        const int m0 = tile * 32; const bf16* xrow = X1 + (size_t)(m0 + i) * D + 256 * w + 4 * h;
        f32x16 acc;
#pragma unroll
        for (int r_ = 0; r_ < 16; ++r_) acc[r_] = 0.f;
        float ss = 0.f; const float* bp = RWS + (size_t)(256 * w + 4 * h) * NE + i;
#pragma unroll 4
        for (int q = 0; q < 32; ++q) { const v2u xb_ = *(const v2u*)(xrow + 8 * q); const f32x4 xa = UNP4(xb_);
#pragma unroll
            for (int j = 0; j < 4; ++j) acc = __builtin_amdgcn_mfma_f32_32x32x2f32(xa[j], bp[(8 * q + j) * NE], acc, 0, 0, 0);
            ss += (xa[0] * xa[0] + xa[1] * xa[1]) + (xa[2] * xa[2] + xa[3] * xa[3]); }
        ss += __shfl_xor(ss, 32);
        if (h == 0) ssq[w * 32 + i] = ss;
#pragma unroll
        for (int r_ = 0; r_ < 16; ++r_) part[(w * 32 + (r_ & 3) + 8 * (r_ >> 2) + 4 * h) * 33 + i] = acc[r_];
        __syncthreads();
#pragma unroll
        for (int k2 = 0; k2 < 2; ++k2) { const int idx = tid + NTHR * k2, ii = idx >> 5, e = idx & 31; float sm = 0.f, sq = 0.f;
#pragma unroll
            for (int ww = 0; ww < 8; ++ww) { sm += part[(ww * 32 + ii) * 33 + e]; sq += ssq[ww * 32 + ii]; }
            const float rs = 1.f / sqrtf(sq * (1.f / D) + NORM_EPS); lgt[ii * 33 + e] = sm * rs + rtb[e]; if (e == 0) srs[ii] = rs; }
        __syncthreads();
        { const float rs = srs[i] * F8_SX; unsigned char* orow = H2 + (size_t)(m0 + i) * D + 256 * w + 4 * h;
#pragma unroll 8
          for (int q = 0; q < 32; ++q) { const f32x4 n4 = *(const f32x4*)(nw + 256 * w + 4 * h + 8 * q); const v2u xb_ = *(const v2u*)(xrow + 8 * q); const f32x4 hv = UNP4(xb_) * rs * n4; *(unsigned*)(orow + 8 * q) = pk4f8(hv[0], hv[1], hv[2], hv[3]); } }
        if (tid < 32) { const LAS float* lr = lgt + tid * 33; unsigned used = 0u; int idx[4]; float val[4];
#pragma unroll
            for (int s4 = 0; s4 < 4; ++s4) { float best = -INFINITY; int bi = 0;
                for (int e = 0; e < 32; ++e) { const float v = lr[e]; const bool ok = !((used >> e) & 1u) && (v > best); best = ok ? v : best; bi = ok ? e : bi; }
                used |= 1u << bi; idx[s4] = bi; val[s4] = best; }
            const float e1 = __expf(val[1] - val[0]), e2 = __expf(val[2] - val[0]), e3 = __expf(val[3] - val[0]); const float inv = 1.f / (1.f + e1 + e2 + e3);
            const float wv[4] = {inv, e1 * inv, e2 * inv, e3 * inv};
            unsigned pos[4];
#pragma unroll
            for (int s4 = 0; s4 < 4; ++s4) pos[s4] = atomicAdd(F.ctl + CW_CNT + 64 * idx[s4], 1u);
#pragma unroll
            for (int s4 = 0; s4 < 4; ++s4) { RLIST[idx[s4] * ECAP + pos[s4]] = (m0 + tid) * 4 + s4; RWT[idx[s4] * ECAP + pos[s4]] = wv[s4]; } }
        __syncthreads();
    }
}

__device__ __forceinline__ void build_moe_tables(Frame& F) {
    LAS int* MI = (LAS int*)F.MISC;
    __syncthreads();
    if (F.tid < NE) MI[MI_CNT + F.tid] = (int)__hip_atomic_load(F.ctl + CW_CNT + 64 * F.tid, __ATOMIC_RELAXED, __HIP_MEMORY_SCOPE_AGENT);
    __syncthreads();
    if (F.tid == 0) { int mt = 0, cs = 0;
        for (int e = 0; e < NE; ++e) { const int c = MI[MI_CNT + e]; MI[MI_POFF + e] = mt * 256; MI[MI_CST + e] = cs; cs += c;
            const int nt = (c + 255) >> 8; for (int i = 0; i < nt; ++i) { MI[MI_TILE_E + mt + i] = e; MI[MI_TILE_I0 + mt + i] = i * 256; } mt += nt; }
        MI[MI_CST + NE] = cs; MI[MI_MT] = mt; }
    __syncthreads();
}
__device__ __forceinline__ void p9_gather(Frame& F) {
    build_moe_tables(F);
    const LAS int* MI = (const LAS int*)F.MISC; const bf16* H2 = (const bf16*)(F.ws + WS_HN); bf16* XB = (bf16*)(F.ws + WS_XB); const int* RLIST = (const int*)(F.ws + WS_RLIST);
    const int gw = F.bid * NWAVES + F.wave, NGW = F.G * NWAVES, total = MI[MI_CST + NE];
    for (int q = gw; q < total; q += NGW) { int e = 0;
        for (int k = 1; k < NE; ++k) e = (MI[MI_CST + k] <= q) ? k : e;
        const int i = q - MI[MI_CST + e]; const int tok = RLIST[e * ECAP + i] >> 2;
        const v4u* src = (const v4u*)(H2 + (size_t)tok * D) + F.lane; v4u* dst = (v4u*)(XB + (size_t)(MI[MI_POFF + e] + i) * D) + F.lane;
#pragma unroll
        for (int j = 0; j < 4; ++j) dst[64 * j] = src[64 * j]; }
}
__device__ __forceinline__ void p12_final(Frame& F) {
    const bf16* X1 = (const bf16*)(F.ws + WS_X1); const unsigned char* YS = (const unsigned char*)(F.ws + WS_YS); const float* fw = F.in[I_FNW];
    const int gw = F.bid * NWAVES + F.wave, NGW = F.G * NWAVES;
    for (int m = gw; m < T; m += NGW) {
        const v2u* xr = (const v2u*)(X1 + (size_t)m * D) + F.lane; f32x4 v[8]; float s = 0.f;
#pragma unroll
        for (int j = 0; j < 8; ++j) { const v2u xb_ = xr[64 * j]; v[j] = UNP4(xb_);
#pragma unroll
            for (int sl = 0; sl < 4; ++sl) { const int y = ((const int*)(YS + ((size_t)m * 4 + sl) * D))[F.lane + 64 * j];
                const f32x2 ylo = __builtin_amdgcn_cvt_pk_f32_fp8(y, false), yhi = __builtin_amdgcn_cvt_pk_f32_fp8(y, true);
                v[j][0] += ylo[0] * (1.f / F8_SY); v[j][1] += ylo[1] * (1.f / F8_SY); v[j][2] += yhi[0] * (1.f / F8_SY); v[j][3] += yhi[1] * (1.f / F8_SY); }
            s += (v[j][0] * v[j][0] + v[j][1] * v[j][1]) + (v[j][2] * v[j][2] + v[j][3] * v[j][3]); }
        const float rstd = __builtin_amdgcn_rsqf(wave_sum(s) * (1.f / D) + NORM_EPS);
        f32x4* orow = (f32x4*)(F.out + (size_t)m * D) + F.lane;
#pragma unroll
        for (int j = 0; j < 8; ++j) { const f32x4 w = ((const f32x4*)fw)[F.lane + 64 * j]; orow[64 * j] = v[j] * rstd * w; }
    }
}

__global__ void __launch_bounds__(NTHR, 2) mk_fwd(Args args) {
    extern __shared__ __attribute__((aligned(16))) unsigned char lds[];
    Frame F;
    F.lds = (LAS unsigned char*)lds; F.MISC = (volatile LAS unsigned*)(F.lds + MISC_OFF);
    F.tid = threadIdx.x; F.lane = F.tid & 63; F.wave = __builtin_amdgcn_readfirstlane(F.tid >> 6); F.G = gridDim.x; F.bid = blockIdx.x;
    F.in = args.in; F.out = args.out; F.ws = args.ws; F.ctl = (unsigned*)(args.ws + WS_CTL);
    for (int u = F.tid; u < (LDS_BYTES - MISC_OFF) / 4; u += NTHR) ((LAS unsigned*)(F.lds + MISC_OFF))[u] = 0u;
    __syncthreads();
    XcdBarrier bar; bar.bar = F.ctl + CW_BAR; bar.x = 0; bar.st = nullptr;
    if (MK_N_LAUNCHES == 1) bar = xcd_barrier_post(F.ctl + CW_BAR, F.MISC + 8);
    const int lo = args.ph_lo, hi = args.ph_hi;
#define IN(k) (lo <= (k) && (k) < hi)
#ifndef PROBE_PHASE
#define PROBE_PHASE -1
#endif
#define REP(k) ((PROBE_PHASE) == (k) ? 2 : 1)
#ifndef TPROBE
#define TPROBE -1
#endif
#if TPROBE >= 0
    unsigned long long tpA = 0, tpB = 0;
#define TP_A(k) do { if ((k) == TPROBE / 100) tpA = __builtin_amdgcn_s_memrealtime(); } while (0)
#define TP_B(k) do { if ((k) == TPROBE % 100) tpB = __builtin_amdgcn_s_memrealtime(); } while (0)
#else
#define TP_A(k) do {} while (0)
#define TP_B(k) do {} while (0)
#endif
#define SEAM(k) do { if (IN(k) && IN((k) + 1)) xcd_barrier(bar); TP_B(k); } while (0)
    LAS unsigned char* ring = F.lds;
    const LAS int* MI = (const LAS int*)F.MISC;

    static_assert(MK_N_LAUNCHES == 1, "the W_in quantisation needs an in-launch barrier inside phase 0");
    TP_A(0); if (IN(0)) { p0_prologue(F); xcd_barrier(bar); p0b_win(F); } SEAM(0);
    TP_A(1); if (IN(1)) {
        const int ng = F.G > 2 * NCV ? F.G - NCV : F.G;
        if (F.bid < ng) {
            pg8::Gemm g{(const bf16*)(F.ws + WS_HN), (const bf16*)(F.ws + WS_WIN), T, NINP, D / 2}; pg8::StaticOrder S; S.init(T, NINP, ng, F.bid);
            EpiP1I8 E{(bf16*)(F.ws + WS_P), NINP, (const float*)(F.ws + WS_RA), F.ctl + CW_COLMAX};
            pg8::gemm_phase<EpiP1I8, pg8::StaticOrder, true, true, false, true>(ring, g, S, E);
            if (F.tid == 0) __hip_atomic_fetch_add(F.ctl + CW_P1DONE, 1u, __ATOMIC_RELAXED, __HIP_MEMORY_SCOPE_AGENT);
        } else if (F.wave >= CV1_W0) convert_loop(F, F.ctl + CW_CVNEXT, F.ctl + CW_P1DONE, (unsigned)ng, F.lds + F.wave * 9216, 0u, (unsigned)CV_SPLIT);
    } SEAM(1);
    TP_A(2); if (IN(2)) { for (int rep = 0; rep < REP(2); ++rep) p2_lora_in(F); } SEAM(2);
    TP_A(3); if (IN(3)) {
        pg8::Gemm g{(const bf16*)(F.ws + WS_LIN), (const bf16*)(F.ws + WS_WL), T, 3072, 512}; pg8::StaticOrder S; S.init(T, 3072, F.G, F.bid);
        EpiLora E{(float*)(F.ws + WS_WAG), (bf16*)(F.ws + WS_WAG + 64 * MiB), F.in[I_W0], F.in[I_A0]};
        pg8::gemm_phase<EpiLora, pg8::StaticOrder, true, true>(ring, g, S, E);
    } SEAM(3);
    TP_A(4); if (IN(4)) {
        { LAS unsigned* ctl2 = (LAS unsigned*)F.MISC + 16;
          TP_A(14); TP_A(15); TP_A(16); if (F.wave < 4) { TP_B(14); TP_B(16); unsigned bt = 0u; for (int rep = 0; rep < REP(40); ++rep) for (int u = F.bid; u < 256; u += F.G) rwkv_chunk_unit(F, u, (LAS unsigned char*)F.MISC + 256, ctl2, bt); TP_B(15); }
          else { Frame F2 = F; F2.tid = F.tid - 256; F2.wave = F.wave - 4; F2.lds = F.lds + 45056; unsigned bt = 0u;
                 for (int rep = 0; rep < REP(41); ++rep) for (int u = F.bid; u < 256; u += F.G) mlstm_scan_unit(F2, u, ctl2 + 2, bt);
                 rw_bar(ctl2 + 2, bt, F2.lane); TP_B(15); TP_B(16); }
          if (F.wave >= CV_W0) convert_loop(F, F.ctl + CW_CVNEXT, nullptr, 0u, F.lds + 45056 + (F.wave - 4) * 9216, 0u, (unsigned)CV_SPLIT);
          if (F.wave >= 4) TP_B(14);
          __syncthreads(); }
    } SEAM(4);
    TP_A(5); if (IN(5)) { if (F.wave < P5_NW) { for (int rep = 0; rep < REP(5); ++rep) p5_finalize(F); }
                 else convert_loop(F, F.ctl + CW_CVNEXT2, nullptr, 0u, F.lds + F.wave * 9216, (unsigned)CV_SPLIT, (unsigned)CV_ITEMS); }     SEAM(5);
    TP_A(6); if (IN(6)) {
        { pg8::Gemm g{(const bf16*)(F.ws + WS_OA), (const bf16*)(F.ws + WS_WA), T, D, RD}; pg8::StaticOrder S; S.init(T, D, F.G, F.bid);
          EpiGateA E{(bf16*)(F.ws + WS_TMP), (const bf16*)(F.ws + WS_P), F.in[I_BGATE]};
          pg8::gemm_phase<EpiGateA, pg8::StaticOrder, true, true>(ring, g, S, E); }
        VM_WAIT(); __syncthreads();
        { pg8::Gemm g{(const bf16*)(F.ws + WS_OB), (const bf16*)(F.ws + WS_WB), T, D, RD}; pg8::StaticOrder S; S.init(T, D, F.G, F.bid);
          EpiGateB E{(const bf16*)(F.ws + WS_TMP), (bf16*)(F.ws + WS_MRG), (const bf16*)(F.ws + WS_P), F.in[I_BGATE]};
          pg8::gemm_phase<EpiGateB, pg8::StaticOrder, true, true>(ring, g, S, E); }
    } SEAM(6);
    TP_A(7); if (IN(7)) {
        pg8::Gemm g{(const bf16*)(F.ws + WS_MRG), (const bf16*)(F.ws + WS_WO), T, D, D}; pg8::StaticOrder S; S.init(T, D, F.G, F.bid);
        EpiResid E{F.in[I_X], (bf16*)(F.ws + WS_X1)};
        pg8::gemm_phase<EpiResid, pg8::StaticOrder, true, true>(ring, g, S, E);
    } SEAM(7);
    TP_A(8); if (IN(8)) { p8_route(F); } SEAM(8);
    TP_A(10); if (IN(10)) {
        build_moe_tables(F);
        const int mt = MI[MI_MT];
        pg8::Gemm g{(const bf16*)(F.ws + WS_HN), (const bf16*)(F.ws + WS_WGU), mt * 256, 2 * FF, D / 2};
        MoeGatherOrder S; S.init(mt * 256, 2 * FF, F.G, F.bid); S.tile_e = MI + MI_TILE_E; S.estride = (size_t)2 * FF * D;
        S.tile_i0 = MI + MI_TILE_I0; S.cnt = MI + MI_CNT; S.rlist = (const int*)(F.ws + WS_RLIST); S.rowoff = (LAS unsigned*)F.MISC + MI_ROWOFF; S.rowbytes = D;
        EpiSwiGLU E{(unsigned char*)(F.ws + WS_ACT), F.in[I_BGU], MI + MI_TILE_E};
        pg8::gemm_phase<EpiSwiGLU, MoeGatherOrder, true, true, true>(ring, g, S, E);
    } SEAM(10);
    TP_A(11); if (IN(11)) {
        build_moe_tables(F);
        const int mt = MI[MI_MT];
        pg8::Gemm g{(const bf16*)(F.ws + WS_ACT), (const bf16*)(F.ws + WS_WDN), mt * 256, D, FF / 2};
        MoeOrder S; S.init(mt * 256, D, F.G, F.bid); S.tile_e = MI + MI_TILE_E; S.estride = (size_t)D * FF;
        LAS int* rowdst = (LAS int*)F.MISC + MI_ROWOFF; LAS float* rowwt = (LAS float*)F.MISC + MI_ROWOFF + 10 * 256;
        fill_down_tables(F, S, rowdst, rowwt);
        EpiDown E{(unsigned char*)(F.ws + WS_YS), F.in[I_BDN], MI + MI_TILE_E, rowdst, rowwt};
        pg8::gemm_phase<EpiDown, MoeOrder, true, true, true>(ring, g, S, E);
    } SEAM(11);
    TP_A(12); if (IN(12)) { for (int rep = 0; rep < REP(12); ++rep) p12_final(F); } TP_B(12);
#if TPROBE >= 0
    { const unsigned long long tend = __builtin_amdgcn_s_memrealtime() + 4ull * (tpB - tpA); while (__builtin_amdgcn_s_memrealtime() < tend) __builtin_amdgcn_s_sleep(8); }
#endif
#undef IN
#undef SEAM
}

extern "C" void kernel_launch(void* const* d_in, const int* in_sizes, int n_in, void* d_out, int out_size, void* d_ws, size_t ws_size, hipStream_t stream) {
    static int grid = 0;
    if (grid == 0) {
        if (n_in != 30 || out_size != T * D || ws_size < WS_END) { fprintf(stderr, "kernel_launch: unexpected problem (n_in %d, out %d, ws %zu)\n", n_in, out_size, ws_size); grid = -1; return; }
        int dev = 0, cus = 0, per_cu = 0;
        if (hipGetDevice(&dev) != hipSuccess || hipDeviceGetAttribute(&cus, hipDeviceAttributeMultiprocessorCount, dev) != hipSuccess) { grid = -1; return; }
        if (hipFuncSetAttribute((const void*)mk_fwd, hipFuncAttributeMaxDynamicSharedMemorySize, LDS_BYTES) != hipSuccess) { fprintf(stderr, "kernel_launch: hipFuncSetAttribute failed\n"); grid = -1; return; }
        if (hipOccupancyMaxActiveBlocksPerMultiprocessor(&per_cu, (const void*)mk_fwd, NTHR, LDS_BYTES) != hipSuccess || per_cu < 1) fprintf(stderr, "kernel_launch: occupancy query says %d\n", per_cu);
        (void)hipGetLastError();
        grid = cus;
    }
    if (grid < 0) return;
    if (hipMemsetAsync((char*)d_ws + WS_CTL, 0, CTL_ZERO_BYTES, stream) != hipSuccess) return;
    Args a{};
    for (int i = 0; i < 30; ++i) a.in[i] = (const float*)d_in[i];
    a.out = (float*)d_out; a.ws = (unsigned char*)d_ws;
    for (int li = 0; li < MK_N_LAUNCHES; ++li) {
        a.ph_lo = (MK_N_LAUNCHES == 1) ? 0 : li; a.ph_hi = (MK_N_LAUNCHES == 1) ? NPH : li + 1;
        hipLaunchKernelGGL(mk_fwd, dim3(grid), dim3(NTHR), LDS_BYTES, stream, a);
        const hipError_t le = hipPeekAtLastError();
        if (le != hipSuccess) { fprintf(stderr, "kernel_launch: launch %d failed: %s\n", li, hipGetErrorName(le)); break; }
    }
}
```
